# Optimizing an MI355X kernel written in HIP

```python
import jax, jax.numpy as jnp
from jax import lax
import numpy as np

D_MODEL = 1024
BATCH = 8
SEQ = 2048
DEPTH = 2

GRID_W = 64
CTX_LEN = 256
N_MIXERS = 2
N_ATTN_LAYERS = (DEPTH + N_MIXERS - 1) // N_MIXERS
N_LRU_LAYERS = DEPTH // N_MIXERS
HEAD_DIM = 64
N_HEADS = D_MODEL // HEAD_DIM
N_KV_HEADS = 4
GQA_GROUP = N_HEADS // N_KV_HEADS
WINDOW = 128
BLOCK = 128
ROPE_BASE = 10000.0
D_RNN = 1280
LRU_BLOCK_W = 256
N_LRU_BLOCKS = D_RNN // LRU_BLOCK_W
CONV_W = 4
CONV_LEFT = 2
LRU_C = 8.0
D_FF = 4 * D_MODEL
N_MOD = 6
EPS = 1e-6
NEG_INF = -1e30

kernel_name = 'hybrid_swa_rglru_diffusion_block'


def rms_norm(x, g):
    xf = x.astype(jnp.float32)
    y = xf * lax.rsqrt(jnp.mean(xf * xf, axis=-1, keepdims=True) + EPS)
    return (y * g.astype(jnp.float32)).astype(x.dtype)


def modulate(h, shift, scale):
    return h * (1 + scale) + shift


def sqrelu_mlp(h, w1, w2):
    return jnp.square(jax.nn.relu(h @ w1)) @ w2


def axial_rope_tables(n):
    rows = n // GRID_W
    row = jnp.repeat(jnp.arange(rows, dtype=jnp.float32), GRID_W)
    col = jnp.tile(jnp.arange(GRID_W, dtype=jnp.float32), rows)
    half = HEAD_DIM // 2
    inv = ROPE_BASE ** (-jnp.arange(0, half, 2, dtype=jnp.float32) / half)
    ang_r = row[:, None] * inv[None, :]
    ang_c = col[:, None] * inv[None, :]
    ang = jnp.concatenate([ang_r, ang_r, ang_c, ang_c], axis=-1)
    return jnp.cos(ang), jnp.sin(ang)


def rotate_half_axial(x):
    a1, a2, b1, b2 = jnp.split(x, 4, axis=-1)
    return jnp.concatenate([-a2, a1, -b2, b1], axis=-1)


def apply_rope(x, cos, sin):
    xf = x.astype(jnp.float32)
    out = xf * cos[None, :, None, :] + rotate_half_axial(xf) * sin[None, :, None, :]
    return out.astype(x.dtype)


def banded_window_attention(q, k, v, k_ctx, v_ctx, sink):
    B, S = q.shape[0], q.shape[1]
    nb = S // BLOCK
    f32 = jnp.float32
    qb = (q.astype(f32) * (HEAD_DIM ** -0.5)).reshape(B, nb, BLOCK, N_KV_HEADS, GQA_GROUP, HEAD_DIM)

    def band(t):
        tp = jnp.pad(t.astype(f32), ((0, 0), (BLOCK, BLOCK), (0, 0), (0, 0)))
        tp = tp.reshape(B, nb + 2, BLOCK, N_KV_HEADS, HEAD_DIM)
        return jnp.concatenate([tp[:, :-2], tp[:, 1:-1], tp[:, 2:]], axis=2)

    kb, vb = band(k), band(v)
    blk = jnp.arange(nb)[:, None, None]
    qpos = blk * BLOCK + jnp.arange(BLOCK)[None, :, None]
    kpos = blk * BLOCK - BLOCK + jnp.arange(3 * BLOCK)[None, None, :]
    valid = (kpos >= 0) & (kpos < S) & (jnp.abs(kpos - qpos) <= WINDOW)
    kc = k_ctx.astype(f32)
    vc = v_ctx.astype(f32)
    n_ctx = kc.shape[1]
    n_loc = 3 * BLOCK
    sink_col = jnp.broadcast_to(sink.astype(f32).reshape(1, N_KV_HEADS, GQA_GROUP, 1, 1),
                                (B, N_KV_HEADS, GQA_GROUP, BLOCK, 1))

    def one_block(args):
        qi, ki, vi, mi = args
        s_loc = jnp.where(mi, jnp.einsum('bqkgd,bskd->bkgqs', qi, ki), NEG_INF)
        s_ctx = jnp.einsum('bqkgd,bckd->bkgqc', qi, kc)
        p = jax.nn.softmax(jnp.concatenate([s_loc, s_ctx, sink_col], axis=-1), axis=-1)
        return (jnp.einsum('bkgqs,bskd->bqkgd', p[..., :n_loc], vi)
                + jnp.einsum('bkgqc,bckd->bqkgd', p[..., n_loc:n_loc + n_ctx], vc))

    out = lax.map(one_block, (jnp.moveaxis(qb, 1, 0), jnp.moveaxis(kb, 1, 0),
                              jnp.moveaxis(vb, 1, 0), valid))
    out = jnp.moveaxis(out, 0, 1).reshape(B, S, N_HEADS * HEAD_DIM)
    return out.astype(q.dtype)


def context_attention(q_c, k_c, v_c, sink):
    B, C = q_c.shape[0], q_c.shape[1]
    f32 = jnp.float32
    qf = (q_c.astype(f32) * (HEAD_DIM ** -0.5)).reshape(B, C, N_KV_HEADS, GQA_GROUP, HEAD_DIM)
    s = jnp.einsum('bqkgd,bckd->bkgqc', qf, k_c.astype(f32))
    sink_col = jnp.broadcast_to(sink.astype(f32).reshape(1, N_KV_HEADS, GQA_GROUP, 1, 1),
                                (B, N_KV_HEADS, GQA_GROUP, C, 1))
    p = jax.nn.softmax(jnp.concatenate([s, sink_col], axis=-1), axis=-1)
    out = jnp.einsum('bkgqc,bckd->bqkgd', p[..., :C], v_c.astype(f32))
    return out.reshape(B, C, N_HEADS * HEAD_DIM).astype(q_c.dtype)


def attention_mixer(h_x, h_c, w_qkv, w_o, sink, cos, sin, need_ctx):
    nq = N_HEADS * HEAD_DIM
    w_q, w_kv = w_qkv[:, :nq], w_qkv[:, nq:]

    def kv(h):
        kvh = (h @ w_kv).reshape(h.shape[0], h.shape[1], 2, N_KV_HEADS, HEAD_DIM)
        return kvh[:, :, 0], kvh[:, :, 1]

    B, S = h_x.shape[0], h_x.shape[1]
    q_x = apply_rope((h_x @ w_q).reshape(B, S, N_HEADS, HEAD_DIM), cos, sin)
    k_x, v_x = kv(h_x)
    k_x = apply_rope(k_x, cos, sin)
    k_c, v_c = kv(h_c)
    y_x = banded_window_attention(q_x, k_x, v_x, k_c, v_c, sink) @ w_o
    y_c = None
    if need_ctx:
        q_c = (h_c @ w_q).reshape(h_c.shape[0], h_c.shape[1], N_HEADS, HEAD_DIM)
        y_c = context_attention(q_c, k_c, v_c, sink) @ w_o
    return y_x, y_c


def centred_dwconv(u, w, b):
    T = u.shape[1]
    up = jnp.pad(u, ((0, 0), (CONV_LEFT, CONV_W - 1 - CONV_LEFT), (0, 0)))
    out = b
    for tap in range(CONV_W):
        out = out + up[:, tap:tap + T] * w[tap]
    return out


def rglru_coeffs(u, w_a, b_a, w_i, b_i, lam):
    B, T, W = u.shape
    f32 = jnp.float32
    uf = u.astype(f32)
    ub = uf.reshape(B, T, N_LRU_BLOCKS, LRU_BLOCK_W)
    r = jax.nn.sigmoid(jnp.einsum('btnk,nkj->btnj', ub, w_a.astype(f32)).reshape(B, T, W) + b_a.astype(f32))
    i = jax.nn.sigmoid(jnp.einsum('btnk,nkj->btnj', ub, w_i.astype(f32)).reshape(B, T, W) + b_i.astype(f32))
    log_a = -LRU_C * jax.nn.softplus(-lam.astype(f32)) * r
    a = jnp.exp(log_a)
    bx = jnp.sqrt(-jnp.expm1(2 * log_a)) * (i * uf)
    return a, bx


def linear_scan(a, bx, h0, reverse, emit):
    def step(h, ab):
        a_t, b_t = ab
        h = a_t * h + b_t
        return h, (h if emit else None)

    h_last, ys = lax.scan(step, h0, (jnp.swapaxes(a, 0, 1), jnp.swapaxes(bx, 0, 1)), reverse=reverse)
    ys = jnp.swapaxes(ys, 0, 1) if emit else None
    return ys, h_last


def rglru_mixer(h_x, h_c, w_in, conv_w, conv_b, w_a, b_a, w_i, b_i, lam, w_out, need_ctx):
    w_gate, w_rec = w_in[:, :D_RNN], w_in[:, D_RNN:]
    u_x = centred_dwconv(h_x @ w_rec, conv_w, conv_b)
    u_c = centred_dwconv(h_c @ w_rec, conv_w, conv_b)
    B = h_x.shape[0]
    rec_x, rec_c = [], []
    for d in range(2):
        rev = d == 1
        a_c, bx_c = rglru_coeffs(u_c, w_a[d], b_a[d], w_i[d], b_i[d], lam[d])
        ys_c, hc_last = linear_scan(a_c, bx_c, jnp.zeros((B, D_RNN), jnp.float32), rev, need_ctx)
        a_x, bx_x = rglru_coeffs(u_x, w_a[d], b_a[d], w_i[d], b_i[d], lam[d])
        ys_x, _ = linear_scan(a_x, bx_x, hc_last, rev, True)
        rec_x.append(ys_x)
        rec_c.append(ys_c)
    y_x = (jax.nn.gelu(h_x @ w_gate) * (rec_x[0] + rec_x[1]).astype(h_x.dtype)) @ w_out
    y_c = None
    if need_ctx:
        y_c = (jax.nn.gelu(h_c @ w_gate) * (rec_c[0] + rec_c[1]).astype(h_c.dtype)) @ w_out
    return y_x, y_c


def setup_inputs(seed: int = 0) -> dict:
    key = jax.random.key(seed)
    ks = jax.random.split(key, 24)
    f32 = jnp.float32
    nrm = lambda k, shape, s: jax.random.normal(k, shape, f32) * s
    nqkv = (N_HEADS + 2 * N_KV_HEADS) * HEAD_DIM
    u = jax.random.uniform(ks[20], (N_LRU_LAYERS, 2, D_RNN), f32, 0.9, 0.999)
    s = u ** (1.0 / LRU_C)
    lam = jnp.log(s) - jnp.log1p(-s)
    return {
        'x': nrm(ks[0], (BATCH, SEQ, D_MODEL), 1.0),
        'c': nrm(ks[1], (BATCH, D_MODEL), 1.0),
        'ctx': nrm(ks[2], (BATCH, CTX_LEN, D_MODEL), 1.0),
        'c_ctx': nrm(ks[3], (D_MODEL,), 1.0),
        'ada_w': nrm(ks[4], (DEPTH, D_MODEL, N_MOD * D_MODEL), 0.5 * D_MODEL ** -0.5),
        'ada_b': nrm(ks[5], (DEPTH, N_MOD * D_MODEL), 0.01),
        'norm_g': 1.0 + nrm(ks[6], (DEPTH, 4, D_MODEL), 0.05),
        'mlp_w1': nrm(ks[7], (DEPTH, D_MODEL, D_FF), D_MODEL ** -0.5),
        'mlp_w2': nrm(ks[8], (DEPTH, D_FF, D_MODEL), D_FF ** -0.5),
        'attn_w_qkv': nrm(ks[9], (N_ATTN_LAYERS, D_MODEL, nqkv), D_MODEL ** -0.5),
        'attn_w_o': nrm(ks[10], (N_ATTN_LAYERS, N_HEADS * HEAD_DIM, D_MODEL), (N_HEADS * HEAD_DIM) ** -0.5),
        'attn_sink': nrm(ks[11], (N_ATTN_LAYERS, N_HEADS), 0.5),
        'lru_w_in': nrm(ks[12], (N_LRU_LAYERS, D_MODEL, 2 * D_RNN), D_MODEL ** -0.5),
        'lru_conv_w': nrm(ks[13], (N_LRU_LAYERS, CONV_W, D_RNN), CONV_W ** -0.5),
        'lru_conv_b': nrm(ks[14], (N_LRU_LAYERS, D_RNN), 0.01),
        'lru_w_a': nrm(ks[15], (N_LRU_LAYERS, 2, N_LRU_BLOCKS, LRU_BLOCK_W, LRU_BLOCK_W), LRU_BLOCK_W ** -0.5),
        'lru_b_a': nrm(ks[16], (N_LRU_LAYERS, 2, D_RNN), 0.01),
        'lru_w_i': nrm(ks[17], (N_LRU_LAYERS, 2, N_LRU_BLOCKS, LRU_BLOCK_W, LRU_BLOCK_W), LRU_BLOCK_W ** -0.5),
        'lru_b_i': nrm(ks[18], (N_LRU_LAYERS, 2, D_RNN), 0.01),
        'lru_lam': lam,
        'lru_w_out': nrm(ks[19], (N_LRU_LAYERS, D_RNN, D_MODEL), D_RNN ** -0.5),
    }


def reference(x, c, ctx, c_ctx, ada_w, ada_b, norm_g, mlp_w1, mlp_w2, attn_w_qkv, attn_w_o, attn_sink,
              lru_w_in, lru_conv_w, lru_conv_b, lru_w_a, lru_b_a, lru_w_i, lru_b_i, lru_lam, lru_w_out):
    n = x.shape[1]
    cos, sin = axial_rope_tables(n)
    silu_c = jax.nn.silu(c)
    silu_cc = jax.nn.silu(c_ctx)
    for i in range(DEPTH):
        last = i == DEPTH - 1
        mx = jnp.split((silu_c @ ada_w[i] + ada_b[i])[:, None, :], N_MOD, axis=-1)
        mc = jnp.split(silu_cc @ ada_w[i] + ada_b[i], N_MOD, axis=-1)
        g = norm_g[i]
        h_x = modulate(rms_norm(x, g[0]), mx[0], mx[1])
        h_c = modulate(rms_norm(ctx, g[0]), mc[0], mc[1])
        j = i // N_MIXERS
        if i % N_MIXERS == 0:
            y_x, y_c = attention_mixer(h_x, h_c, attn_w_qkv[j], attn_w_o[j], attn_sink[j], cos, sin, not last)
        else:
            y_x, y_c = rglru_mixer(h_x, h_c, lru_w_in[j], lru_conv_w[j], lru_conv_b[j], lru_w_a[j], lru_b_a[j],
                                   lru_w_i[j], lru_b_i[j], lru_lam[j], lru_w_out[j], not last)
        x = x + mx[2] * rms_norm(y_x, g[1])
        x = x + mx[5] * rms_norm(sqrelu_mlp(modulate(rms_norm(x, g[2]), mx[3], mx[4]), mlp_w1[i], mlp_w2[i]), g[3])
        if not last:
            ctx = ctx + mc[2] * rms_norm(y_c, g[1])
            ctx = ctx + mc[5] * rms_norm(sqrelu_mlp(modulate(rms_norm(ctx, g[2]), mc[3], mc[4]),
                                                    mlp_w1[i], mlp_w2[i]), g[3])
    return x
```

```cpp
#include <hip/hip_runtime.h>
#include <hip/hip_cooperative_groups.h>
#include <cstdio>
#include <cstdint>
namespace cg = cooperative_groups;

#define LAS __attribute__((address_space(3)))
typedef unsigned short bf16_t;
typedef short bf16x8 __attribute__((ext_vector_type(8)));
typedef float f32x4 __attribute__((ext_vector_type(4)));
typedef float f32x2 __attribute__((ext_vector_type(2)));
typedef unsigned u32x4 __attribute__((ext_vector_type(4)));
typedef unsigned u32x2 __attribute__((ext_vector_type(2)));

constexpr int DM = 1024, NB = 8, SEQ = 2048, CTX = 256;
constexpr int ML = NB * SEQ;
constexpr int MC = NB * CTX;
constexpr int MT = ML + MC;
constexpr int NQKV = 1536, DFF = 4096, DRNN = 1280;
constexpr float EPS = 1e-6f;
constexpr float LOG2E = 1.4426950408889634f;

constexpr size_t MiB = 1u << 20;
constexpr size_t WS_MOD = 0;
constexpr size_t WS_ROPE = 448 * 1024;
constexpr size_t WS_NLS = 460 * 1024;
constexpr size_t WS_WQKV = 1 * MiB, WS_WO = 4 * MiB, WS_W1 = 6 * MiB, WS_W2 = 14 * MiB;
constexpr size_t WS_WIN = 38 * MiB, WS_WG = 43 * MiB, WS_WOUT = 46 * MiB;
constexpr size_t WS_CTXRES = 49 * MiB;
constexpr size_t WS_H = 57 * MiB;
constexpr size_t WS_R3 = 93 * MiB;
constexpr size_t WS_Q = WS_R3, WS_K = 129 * MiB, WS_VT = 138 * MiB, WS_VTC = 146 * MiB;
constexpr size_t WS_ACT = WS_R3;
constexpr size_t WS_U = WS_R3;
constexpr size_t WS_LA = 138 * MiB;
constexpr size_t WS_BX = 183 * MiB;
constexpr size_t WS_RPRE = 138 * MiB;
constexpr size_t WS_SP = 228 * MiB, WS_SH = 231 * MiB, WS_CIN = 234 * MiB;
constexpr size_t WS_END = 256 * MiB;
constexpr int LDS_BYTES = 135168;

__device__ __forceinline__ unsigned f2bf(float f) { unsigned u = __builtin_bit_cast(unsigned, f); return (u + 0x7fffu + ((u >> 16) & 1u)) >> 16; }
__device__ __forceinline__ unsigned cvt_pk_bf16(float lo, float hi) { unsigned r; asm volatile("v_cvt_pk_bf16_f32 %0, %1, %2" : "=v"(r) : "v"(lo), "v"(hi)); return r; }
__device__ __forceinline__ float bf_lo(unsigned w) { return __builtin_bit_cast(float, w << 16); }
__device__ __forceinline__ float bf_hi(unsigned w) { return __builtin_bit_cast(float, w & 0xffff0000u); }
__device__ __forceinline__ f32x4 bf4_to_f32(u32x2 w) { return (f32x4){bf_lo(w.x), bf_hi(w.x), bf_lo(w.y), bf_hi(w.y)}; }
__device__ __forceinline__ u32x2 f32_to_bf4(f32x4 v) { u32x2 w; w.x = cvt_pk_bf16(v[0], v[1]); w.y = cvt_pk_bf16(v[2], v[3]); return w; }
__device__ __forceinline__ float wave_sum(float v) {
#pragma unroll
    for (int o = 1; o < 64; o <<= 1) v += __shfl_xor(v, o);
    return v;
}
__device__ __forceinline__ float fsigmoid(float x) { return __builtin_amdgcn_rcpf(1.0f + __expf(-x)); }

namespace pg8 {
constexpr int BM = 256, BK = 64, HALF = 128, HTB = HALF * BK * 2, STAGE_BYTES = 8 * HTB, NXCD = 8, WGM = 8;
__device__ __forceinline__ int lds_byte(int r, int c) { const int st = (r >> 4) * 2 + (c >> 5), rr = r & 15, cc = c & 31, ob = rr * 64 + cc * 2; return st * 1024 + (ob ^ (((ob >> 9) & 1) << 5)); }
__device__ __forceinline__ void stage_rc(int b, int& R, int& C) { const int st = b / 1024, sb = b % 1024, swz = sb ^ (((sb >> 9) & 1) << 5); R = (st >> 1) * 16 + swz / 64; C = (st & 1) * 32 + (swz % 64) / 2; }

struct Unit { int pm, pn, koff, po; };
struct Gemm { const bf16_t* A; const bf16_t* Bt; int lda, ldb, K; };

struct Sched {
    int nM, nN, nwg, G, c, mode, half;
    __device__ void init(int nM_, int nN_, int G_, int c_, int mode_ = 0, int half_ = 0) { nM = nM_; nN = nN_; nwg = nM * nN; G = G_; c = c_; mode = mode_; half = half_; }
    __device__ bool next(int i, Unit& u) const {
        const long L = (long)i * G + c; if (L >= nwg) return false;
        int wgid = (int)L; { const int q = nwg / NXCD, r = nwg % NXCD, xcd = wgid % NXCD, off = wgid / NXCD; wgid = (xcd < r ? xcd * (q + 1) : r * (q + 1) + (xcd - r) * q) + off; }
        const int nig = WGM * nN, gid = wgid / nig, fm = gid * WGM, gsz = (nM - fm) < WGM ? (nM - fm) : WGM;
        const int pmi = fm + ((wgid % nig) % gsz), pn = (wgid % nig) / gsz;
        u.pm = pmi; u.pn = pn; u.koff = 0; u.po = pmi;
        if (mode == 1) { u.pm = pmi < 32 ? 32 * half + pmi : 64 + 4 * half + (pmi - 32); u.koff = ((pn >> 1) % 5) * 256; }
        return true;
    }
};

template <class Epi, bool ALIGN_EPI, bool SP2>
__device__ __forceinline__ void gemm_phase(LAS unsigned char* lds, const Gemm g, const Sched& S, const Epi& E) {
    int tid = threadIdx.x; asm volatile("" : "+v"(tid));
    const int wid = __builtin_amdgcn_readfirstlane(tid >> 6), lane = tid & 63, wr = wid >> 2, wc = wid & 3, fr = lane & 15, fq = lane >> 4;
    const int K = g.K, nt = K / BK;
    unsigned voffA[2], voffB[2];
#pragma unroll
    for (int i = 0; i < 2; ++i) { int R, C; stage_rc(tid * 16 + i * 8192, R, C);
        voffA[i] = (unsigned)(R * g.lda + C) * 2u; voffB[i] = (unsigned)(R * g.ldb + C) * 2u; }
    const size_t kstep = (size_t)(BK * 2);
    const size_t hstepA = (size_t)HALF * g.lda * 2, hstepB = (size_t)HALF * g.ldb * 2;
    const unsigned ldsw = (unsigned)wid * 1024u;
    const int aoff = lds_byte(wr * 64 + fr, fq * 8), boff = lds_byte(wc * 32 + fr, fq * 8);
#define PG8_SA(b, h) (((b) * 2 + (h)) * HTB)
#define PG8_SB(b, h) ((4 + (b) * 2 + (h)) * HTB)
#define PG8_STAGE(bufoff, gbase, voff) do { _Pragma("unroll") for (int _i = 0; _i < 2; ++_i) \
        __builtin_amdgcn_global_load_lds((const unsigned*)((const char*)(gbase) + (voff)[_i]), (LAS unsigned*)(lds + (bufoff) + ldsw + _i * 8192), 16, 0, 0); } while (0)
#define PG8_LDA(dst, b, h) do { _Pragma("unroll") for (int m = 0; m < 4; ++m) _Pragma("unroll") for (int k = 0; k < 2; ++k) dst[m][k] = *(const LAS bf16x8*)(lds + PG8_SA(b, h) + aoff + m * 2048 + k * 1024); } while (0)
#define PG8_LDB(dst, b, h) do { _Pragma("unroll") for (int n = 0; n < 2; ++n) _Pragma("unroll") for (int k = 0; k < 2; ++k) dst[n][k] = *(const LAS bf16x8*)(lds + PG8_SB(b, h) + boff + n * 2048 + k * 1024); } while (0)
#define PG8_MMA(ai, bj, At, Bt) do { __builtin_amdgcn_s_setprio(1); _Pragma("unroll") for (int m = 0; m < 4; ++m) _Pragma("unroll") for (int n = 0; n < 2; ++n) _Pragma("unroll") for (int k = 0; k < 2; ++k) \
        acc[ai][bj][m][n] = __builtin_amdgcn_mfma_f32_16x16x32_bf16(Bt[n][k], At[m][k], acc[ai][bj][m][n], 0, 0, 0); __builtin_amdgcn_s_setprio(0); } while (0)
#define PG8_WAIT_V(n) asm volatile("s_waitcnt vmcnt(" #n ")" ::: "memory")
#define PG8_WAIT_L(n) asm volatile("s_waitcnt lgkmcnt(" #n ")" ::: "memory")
#define PG8_BAR __builtin_amdgcn_s_barrier()
#define PG8_SCHED __builtin_amdgcn_sched_barrier(0)
    Unit cur, nxt; int ui = 0;
    if (!S.next(0, cur)) return;
    f32x4 acc[2][2][4][2];
#pragma unroll
    for (int a = 0; a < 2; ++a)
#pragma unroll
        for (int b = 0; b < 2; ++b)
#pragma unroll
            for (int m = 0; m < 4; ++m)
#pragma unroll
                for (int n = 0; n < 2; ++n) acc[a][b][m][n] = (f32x4){0.f, 0.f, 0.f, 0.f};
    bf16x8 At[4][2], B0[2][2], B1[2][2];
    const char* cA = (const char*)g.A + ((size_t)cur.pm * BM * g.lda + cur.koff) * 2; const char* cB = (const char*)g.Bt + (size_t)cur.pn * BM * g.ldb * 2;
    if constexpr (SP2) {
        PG8_STAGE(PG8_SB(0, 0), cB, voffB); PG8_STAGE(PG8_SB(0, 1), cB + hstepB, voffB); PG8_STAGE(PG8_SA(0, 0), cA, voffA); PG8_STAGE(PG8_SA(0, 1), cA + hstepA, voffA);
        if (wr == 1) PG8_BAR;
        PG8_WAIT_V(2); PG8_BAR;
        PG8_STAGE(PG8_SB(1, 0), cB + kstep, voffB); PG8_STAGE(PG8_SA(1, 0), cA + kstep, voffA); PG8_STAGE(PG8_SB(1, 1), cB + hstepB + kstep, voffB);
        PG8_WAIT_V(6); PG8_BAR;
    } else {
        PG8_STAGE(PG8_SB(0, 0), cB, voffB); PG8_STAGE(PG8_SA(0, 0), cA, voffA); PG8_STAGE(PG8_SB(0, 1), cB + hstepB, voffB); PG8_STAGE(PG8_SA(0, 1), cA + hstepA, voffA);
        if (wr == 1) PG8_BAR;
        PG8_WAIT_V(4); PG8_BAR;
        PG8_STAGE(PG8_SB(1, 0), cB + kstep, voffB); PG8_STAGE(PG8_SA(1, 0), cA + kstep, voffA); PG8_STAGE(PG8_SB(1, 1), cB + hstepB + kstep, voffB);
        PG8_WAIT_V(6); PG8_BAR;
    }
    for (;;) {
        const bool has_next = S.next(ui + 1, nxt);
        const char* nA = has_next ? (const char*)g.A + ((size_t)nxt.pm * BM * g.lda + nxt.koff) * 2 : cA;
        const char* nB = has_next ? (const char*)g.Bt + (size_t)nxt.pn * BM * g.ldb * 2 : cB;
#pragma unroll 1
        for (int t = 0; t < nt; t += 2) {
            const bool last = (t == nt - 2);
            const char* a1 = cA + (size_t)(t + 1) * kstep;
            const char* a2 = last ? nA : cA + (size_t)(t + 2) * kstep; const char* b2 = last ? nB : cB + (size_t)(t + 2) * kstep;
            const char* a3 = a2 + kstep; const char* b3 = b2 + kstep;
            if constexpr (SP2) {
            PG8_LDB(B0, 0, 0); PG8_LDB(B1, 0, 1); PG8_SCHED; PG8_LDA(At, 0, 0); PG8_STAGE(PG8_SA(1, 1), a1 + hstepA, voffA);
            PG8_WAIT_V(8); PG8_WAIT_L(0); PG8_BAR; PG8_MMA(0, 0, At, B0); PG8_MMA(0, 1, At, B1); PG8_BAR; PG8_SCHED;
            PG8_LDA(At, 0, 1); PG8_STAGE(PG8_SB(0, 0), b2, voffB); PG8_STAGE(PG8_SB(0, 1), b2 + hstepB, voffB); PG8_STAGE(PG8_SA(0, 0), a2, voffA);
            PG8_WAIT_V(8); PG8_WAIT_L(0); PG8_BAR; PG8_MMA(1, 0, At, B0); PG8_MMA(1, 1, At, B1); PG8_BAR; PG8_SCHED;
            PG8_LDB(B0, 1, 0); PG8_LDB(B1, 1, 1); PG8_SCHED; PG8_LDA(At, 1, 0); PG8_STAGE(PG8_SA(0, 1), a2 + hstepA, voffA);
            PG8_WAIT_V(8); PG8_WAIT_L(0); PG8_BAR; PG8_MMA(0, 0, At, B0); PG8_MMA(0, 1, At, B1); PG8_BAR; PG8_SCHED;
            PG8_LDA(At, 1, 1); PG8_STAGE(PG8_SB(1, 0), b3, voffB); PG8_STAGE(PG8_SB(1, 1), b3 + hstepB, voffB); PG8_STAGE(PG8_SA(1, 0), a3, voffA);
            PG8_WAIT_V(8); PG8_WAIT_L(0); PG8_BAR; PG8_MMA(1, 0, At, B0); PG8_MMA(1, 1, At, B1); PG8_BAR; PG8_SCHED;
            } else {
            PG8_LDB(B0, 0, 0); PG8_SCHED; PG8_LDA(At, 0, 0); PG8_STAGE(PG8_SA(1, 1), a1 + hstepA, voffA);
            PG8_WAIT_L(8); PG8_BAR; PG8_WAIT_L(0); PG8_MMA(0, 0, At, B0); PG8_BAR; PG8_SCHED;
            PG8_LDB(B1, 0, 1); PG8_STAGE(PG8_SB(0, 0), b2, voffB);
            PG8_BAR; PG8_WAIT_L(0); PG8_MMA(0, 1, At, B1); PG8_BAR;
            PG8_LDA(At, 0, 1); PG8_STAGE(PG8_SA(0, 0), a2, voffA);
            PG8_BAR; PG8_WAIT_L(0); PG8_MMA(1, 0, At, B0); PG8_BAR; PG8_SCHED;
            PG8_STAGE(PG8_SB(0, 1), b2 + hstepB, voffB);
            PG8_WAIT_V(6); PG8_BAR; PG8_MMA(1, 1, At, B1); PG8_BAR;
            PG8_LDB(B0, 1, 0); PG8_SCHED; PG8_LDA(At, 1, 0); PG8_STAGE(PG8_SA(0, 1), a2 + hstepA, voffA);
            PG8_WAIT_L(8); PG8_BAR; PG8_WAIT_L(0); PG8_MMA(0, 0, At, B0); PG8_BAR; PG8_SCHED;
            PG8_LDB(B1, 1, 1); PG8_STAGE(PG8_SB(1, 0), b3, voffB);
            PG8_BAR; PG8_WAIT_L(0); PG8_MMA(0, 1, At, B1); PG8_BAR;
            PG8_LDA(At, 1, 1); PG8_STAGE(PG8_SA(1, 0), a3, voffA);
            PG8_BAR; PG8_WAIT_L(0); PG8_MMA(1, 0, At, B0); PG8_BAR; PG8_SCHED;
            PG8_STAGE(PG8_SB(1, 1), b3 + hstepB, voffB);
            PG8_WAIT_V(6); PG8_BAR; PG8_MMA(1, 1, At, B1); PG8_BAR;
            }
        }
        if constexpr (ALIGN_EPI) { if (wr == 0) PG8_BAR; }
        E(acc, cur, wr, wc, fr, fq);
        if (!has_next) break;
#pragma unroll
        for (int a = 0; a < 2; ++a)
#pragma unroll
            for (int b = 0; b < 2; ++b)
#pragma unroll
                for (int m = 0; m < 4; ++m)
#pragma unroll
                    for (int n = 0; n < 2; ++n) acc[a][b][m][n] = (f32x4){0.f, 0.f, 0.f, 0.f};
        cur = nxt; cA = nA; cB = nB; ++ui;
        if constexpr (ALIGN_EPI) { if (wr == 1) PG8_BAR; }
    }
    PG8_WAIT_V(0);
    if constexpr (!ALIGN_EPI) { if (wr == 0) PG8_BAR; }
    PG8_BAR;
#undef PG8_SA
#undef PG8_SB
#undef PG8_STAGE
#undef PG8_LDA
#undef PG8_LDB
#undef PG8_MMA
#undef PG8_WAIT_V
#undef PG8_WAIT_L
#undef PG8_BAR
#undef PG8_SCHED
}

template <int ACT> struct EpiPlain {
    bf16_t* O; int ldc;
    __device__ __forceinline__ void operator()(const f32x4 (&acc)[2][2][4][2], const Unit& u, int wr, int wc, int fr_, int fq_) const {
        int fr = fr_, fq = fq_; asm volatile("" : "+v"(fr), "+v"(fq));
        const int col0 = u.pn * BM + wc * 32 + fq * 4;
#pragma unroll
        for (int ai = 0; ai < 2; ++ai)
#pragma unroll
            for (int m = 0; m < 4; ++m) { bf16_t* rowp = O + (size_t)(u.pm * BM + ai * HALF + wr * 64 + m * 16 + fr) * ldc + col0;
#pragma unroll
                for (int bj = 0; bj < 2; ++bj)
#pragma unroll
                    for (int n = 0; n < 2; ++n) { f32x4 v = acc[ai][bj][m][n];
                        if (ACT == 1) { v = __builtin_elementwise_max(v, (f32x4){0.f, 0.f, 0.f, 0.f}); v = v * v; }
                        *(u32x2*)(rowp + bj * HALF + n * 16) = f32_to_bf4(v); } }
    }
};

struct EpiQKV {
    bf16_t* Q; bf16_t* Kb; bf16_t* VT; bf16_t* VTC; const float* rope;
    __device__ __forceinline__ void operator()(const f32x4 (&acc)[2][2][4][2], const Unit& u, int wr, int wc, int fr_, int fq_) const {
        int fr = fr_, fq = fq_; asm volatile("" : "+v"(fr), "+v"(fq));
        const bool lat = u.pm < 64;
        if (u.pn < 5) {
#pragma unroll
            for (int ai = 0; ai < 2; ++ai)
#pragma unroll
                for (int m = 0; m < 4; ++m) {
                    const int row = u.pm * BM + ai * HALF + wr * 64 + m * 16 + fr;
                    f32x4 cs0 = {1.f, 0.f, 1.f, 0.f}, cs1 = {1.f, 0.f, 1.f, 0.f};
                    if (lat) { const int t = row & 2047; const int pos = (wc & 1) ? (t & 63) : (t >> 6); const f32x4* pp = (const f32x4*)(rope + (pos * 16 + 4 * fq) * 2); cs0 = pp[0]; cs1 = pp[1]; }
                    const f32x4 cv = {cs0[0], cs0[2], cs1[0], cs1[2]}, sv = {cs0[1], cs0[3], cs1[1], cs1[3]};
#pragma unroll
                    for (int bj = 0; bj < 2; ++bj) {
                        const f32x4 a = acc[ai][bj][m][0], b = acc[ai][bj][m][1];
                        f32x4 na = a * cv - b * sv, nb = b * cv + a * sv;
                        if (u.pn < 4) { na = na * 0.125f; nb = nb * 0.125f;
                            bf16_t* d = Q + (size_t)row * 1024 + u.pn * 256 + bj * HALF + wc * 32 + fq * 4;
                            *(u32x2*)d = f32_to_bf4(na); *(u32x2*)(d + 16) = f32_to_bf4(nb);
                        } else {
                            bf16_t* d = Kb + (size_t)row * 256 + bj * HALF + wc * 32 + fq * 4;
                            *(u32x2*)d = f32_to_bf4(na); *(u32x2*)(d + 16) = f32_to_bf4(nb);
                        }
                    }
                }
        } else {
#pragma unroll
            for (int ai = 0; ai < 2; ++ai)
#pragma unroll
                for (int m = 0; m < 4; ++m) {
                    const int row = u.pm * BM + ai * HALF + wr * 64 + m * 16 + fr;
                    bf16_t* base; size_t stride;
                    if (lat) { const int b = row >> 11, t = row & 2047; base = VT + (size_t)b * 256 * 2048 + t; stride = 2048; }
                    else { const int rc = row - ML; const int b = rc >> 8, t = rc & 255; base = VTC + (size_t)b * 256 * 256 + t; stride = 256; }
#pragma unroll
                    for (int bj = 0; bj < 2; ++bj)
#pragma unroll
                        for (int n = 0; n < 2; ++n)
#pragma unroll
                            for (int j = 0; j < 4; ++j) { const int vc = bj * HALF + wc * 32 + n * 16 + fq * 4 + j; base[(size_t)vc * stride] = (bf16_t)f2bf(acc[ai][bj][m][n][j]); }
                }
        }
    }
};

struct EpiGates {
    const bf16_t* U; bf16_t* LA; bf16_t* BX; const float* ba; const float* bi; const float* nls;
    __device__ __forceinline__ void operator()(const f32x4 (&acc)[2][2][4][2], const Unit& u, int wr, int wc, int fr_, int fq_) const {
        int fr = fr_, fq = fq_; asm volatile("" : "+v"(fr), "+v"(fq));
        const int tile = u.pn >> 1, dir = tile / 5, blk = tile % 5, chalf = u.pn & 1;
        const int ch0 = blk * 256 + chalf * 128 + wc * 32 + fq * 4;
#pragma unroll
        for (int n = 0; n < 2; ++n) {
            const int ch = ch0 + n * 16;
            const f32x4 bav = *(const f32x4*)(ba + dir * DRNN + ch), biv = *(const f32x4*)(bi + dir * DRNN + ch), nl = *(const f32x4*)(nls + dir * DRNN + ch);
#pragma unroll
            for (int ai = 0; ai < 2; ++ai)
#pragma unroll
                for (int m = 0; m < 4; ++m) {
                    const int rin = ai * HALF + wr * 64 + m * 16 + fr;
                    const size_t rowg = (size_t)u.pm * BM + rin, rowl = (size_t)u.po * BM + rin;
                    const f32x4 uv = bf4_to_f32(*(const u32x2*)(U + rowg * DRNN + ch));
                    f32x4 lav, bxv;
#pragma unroll
                    for (int j = 0; j < 4; ++j) {
                        const float r = fsigmoid(acc[ai][0][m][n][j] + bav[j]);
                        const float ig = fsigmoid(acc[ai][1][m][n][j] + biv[j]);
                        const float la = nl[j] * r, x = 2.0f * la;
                        float om;
                        if (x > -0.5f) { float q = 1.0f / 720.0f; q = q * x + 1.0f / 120.0f; q = q * x + 1.0f / 24.0f; q = q * x + 1.0f / 6.0f; q = q * x + 0.5f; q = q * x + 1.0f; om = -x * q; }
                        else om = 1.0f - __expf(x);
                        lav[j] = la; bxv[j] = __builtin_amdgcn_sqrtf(om) * (ig * uv[j]);
                    }
                    const size_t o = ((size_t)dir * 9216 + rowl) * DRNN + ch;
                    *(u32x2*)(LA + o) = f32_to_bf4(lav); *(u32x2*)(BX + o) = f32_to_bf4(bxv);
                    asm volatile("" ::: "memory");
                }
        }
    }
};

struct EpiGateMul {
    bf16_t* Z;
    __device__ __forceinline__ void operator()(const f32x4 (&acc)[2][2][4][2], const Unit& u, int wr, int wc, int fr_, int fq_) const {
        int fr = fr_, fq = fq_; asm volatile("" : "+v"(fr), "+v"(fq));
        const int col0 = u.pn * BM + wc * 32 + fq * 4;
#pragma unroll
        for (int ai = 0; ai < 2; ++ai)
#pragma unroll
            for (int m = 0; m < 4; ++m) { bf16_t* rowp = Z + (size_t)(u.pm * BM + ai * HALF + wr * 64 + m * 16 + fr) * DRNN + col0;
#pragma unroll
                for (int bj = 0; bj < 2; ++bj)
#pragma unroll
                    for (int n = 0; n < 2; ++n) { const f32x4 v = acc[ai][bj][m][n]; const f32x4 rc = bf4_to_f32(*(const u32x2*)(rowp + bj * HALF + n * 16)); f32x4 o;
#pragma unroll
                        for (int j = 0; j < 4; ++j) { const float x = v[j]; const float z2 = 1.5957691216057308f * (x + 0.044715f * x * x * x); o[j] = x * fsigmoid(z2) * rc[j]; }
                        *(u32x2*)(rowp + bj * HALF + n * 16) = f32_to_bf4(o); }
                asm volatile("" ::: "memory"); }
    }
};
}

struct Params {
    const float *x, *c, *ctx, *c_ctx, *ada_w, *ada_b, *norm_g, *mlp_w1, *mlp_w2, *w_qkv, *w_o, *sink;
    const float *w_in, *conv_w, *conv_b, *w_a, *b_a, *w_i, *b_i, *lam, *w_out;
    float* out; unsigned char* ws;
};

__device__ __forceinline__ void transpose_item(const float* W, int ldw, bf16_t* WT, int ldwt, int k0, int n0, int dst_row0, LAS float* scr, int lane) {
#pragma unroll 8
    for (int i = 0; i < 32; ++i) { const int kk = 2 * i + (lane >> 5); scr[kk * 33 + (lane & 31)] = W[(size_t)(k0 + kk) * ldw + n0 + (lane & 31)]; }
    asm volatile("s_waitcnt lgkmcnt(0)" ::: "memory");
    const int c = lane & 7;
#pragma unroll
    for (int j = 0; j < 4; ++j) { const int n = (lane >> 3) + 8 * j; const LAS float* s = scr + (8 * c) * 33 + n;
        u32x4 o; o.x = cvt_pk_bf16(s[0 * 33], s[1 * 33]); o.y = cvt_pk_bf16(s[2 * 33], s[3 * 33]); o.z = cvt_pk_bf16(s[4 * 33], s[5 * 33]); o.w = cvt_pk_bf16(s[6 * 33], s[7 * 33]);
        *(u32x4*)(WT + (size_t)(dst_row0 + n) * ldwt + k0 + 8 * c) = o; }
    asm volatile("s_waitcnt lgkmcnt(0)" ::: "memory");
}
__device__ __forceinline__ void transpose_plain(const float* W, int K, int N, bf16_t* WT, int r, LAS float* scr, int lane) {
    const int nblk = N / 32, kb = r / nblk, nb = r % nblk;
    transpose_item(W, N, WT, K, 64 * kb, 32 * nb, 32 * nb, scr, lane);
}

__device__ __forceinline__ void prologue(const Params& p, LAS unsigned char* lds, int tid, int lane, int wave) {
    unsigned char* ws = p.ws;
    float* MOD = (float*)(ws + WS_MOD);
    if (blockIdx.x < 96) {
        LAS float* sl = (LAS float*)lds;
        LAS float* red = (LAS float*)(lds + 36864);
        for (int idx = tid; idx < 9216; idx += 512) { const int w = idx >> 10, k = idx & 1023; const float v = (w < 8) ? p.c[w * 1024 + k] : p.c_ctx[k]; sl[idx] = v / (1.0f + __expf(-v)); }
        __syncthreads();
        const int l = blockIdx.x / 48, n0 = (blockIdx.x % 48) * 128, kg = tid >> 5, cq = tid & 31;
        f32x4 acc[9];
#pragma unroll
        for (int w = 0; w < 9; ++w) acc[w] = (f32x4){0.f, 0.f, 0.f, 0.f};
        const float* wb = p.ada_w + (size_t)l * 1024 * 6144 + n0 + cq * 4;
#pragma unroll 4
        for (int it = 0; it < 64; ++it) { const int k = it * 16 + kg; const f32x4 w4 = *(const f32x4*)(wb + (size_t)k * 6144);
#pragma unroll
            for (int w = 0; w < 9; ++w) acc[w] += sl[w * 1024 + k] * w4; }
#pragma unroll
        for (int w = 0; w < 9; ++w) *(LAS f32x4*)(red + (kg * 9 + w) * 128 + cq * 4) = acc[w];
        __syncthreads();
        for (int idx = tid; idx < 9 * 128; idx += 512) { const int w = idx >> 7, n = idx & 127; float s = 0.f;
#pragma unroll
            for (int g = 0; g < 16; ++g) s += red[(g * 9 + w) * 128 + n];
            MOD[(size_t)(l * 9 + w) * 6144 + n0 + n] = s + p.ada_b[l * 6144 + n0 + n]; }
        __syncthreads();
    }
    if (blockIdx.x == gridDim.x - 1) {
        float* rope = (float*)(ws + WS_ROPE); float* nls = (float*)(ws + WS_NLS);
        for (int idx = tid; idx < 1024; idx += 512) { const int pos = idx >> 4, i = idx & 15;
            const float inv = __builtin_exp2f(-(float)i * (13.287712379549449f / 16.0f));
            const float angf = (float)pos * inv; const double ang = (double)angf;
            const double twopi = 6.283185307179586476925287; const double r = ang - twopi * __builtin_rint(ang / twopi);
            const double r2 = r * r; double cterm = 1.0, sterm = r, cs = 1.0, sn = r;
            for (int k = 1; k <= 14; ++k) { cterm *= -r2 / (double)((2 * k - 1) * (2 * k)); sterm *= -r2 / (double)((2 * k) * (2 * k + 1)); cs += cterm; sn += sterm; }
            rope[idx * 2] = (float)cs; rope[idx * 2 + 1] = (float)sn; }
        for (int idx = tid; idx < 2 * DRNN; idx += 512) { const float lm = p.lam[idx]; nls[idx] = -8.0f * log1pf(__expf(-lm)); }
    }
    LAS float* scr = (LAS float*)(lds + wave * 16384);
    const int gw = blockIdx.x * 8 + wave, NGW = gridDim.x * 8;
    constexpr int I_QKV = 16 * 48, I_O = 16 * 32, I_1 = 16 * 128, I_2 = 64 * 32, I_IN = 16 * 80, I_OUT = 20 * 32, I_G = 40 * 16;
    constexpr int NITEMS = I_QKV + I_O + 2 * I_1 + 2 * I_2 + I_IN + I_OUT + I_G;
    for (int it = gw; it < NITEMS; it += NGW) {
        int r = it;
        if (r < I_QKV) { transpose_plain(p.w_qkv, 1024, NQKV, (bf16_t*)(ws + WS_WQKV), r, scr, lane); continue; } r -= I_QKV;
        if (r < I_O) { transpose_plain(p.w_o, 1024, 1024, (bf16_t*)(ws + WS_WO), r, scr, lane); continue; } r -= I_O;
        if (r < 2 * I_1) { const int l = r / I_1; transpose_plain(p.mlp_w1 + (size_t)l * 1024 * DFF, 1024, DFF, (bf16_t*)(ws + WS_W1 + (size_t)l * 16 * MiB), r % I_1, scr, lane); continue; } r -= 2 * I_1;
        if (r < 2 * I_2) { const int l = r / I_2; transpose_plain(p.mlp_w2 + (size_t)l * 1024 * DFF, DFF, 1024, (bf16_t*)(ws + WS_W2 + (size_t)l * 16 * MiB), r % I_2, scr, lane); continue; } r -= 2 * I_2;
        if (r < I_IN) { transpose_plain(p.w_in, 1024, 2 * DRNN, (bf16_t*)(ws + WS_WIN), r, scr, lane); continue; } r -= I_IN;
        if (r < I_OUT) { transpose_plain(p.w_out, DRNN, 1024, (bf16_t*)(ws + WS_WOUT), r, scr, lane); continue; } r -= I_OUT;
        {
            const int sm = r >> 4, ii = r & 15, kb = ii >> 2, nb = ii & 3;
            const int chalf = sm & 1, blk = (sm >> 1) % 5, dg = (sm >> 1) / 5, gate = dg & 1, dir = dg >> 1;
            const float* W = (gate ? p.w_i : p.w_a) + (size_t)(dir * 5 + blk) * 256 * 256;
            const int dst_row0 = ((dir * 5 + blk) * 2 + chalf) * 256 + gate * 128 + nb * 32;
            transpose_item(W, 256, (bf16_t*)(ws + WS_WG), 256, 64 * kb, chalf * 128 + nb * 32, dst_row0, scr, lane);
        }
    }
}

template <bool HAS_Y, bool HAS_H>
__device__ __forceinline__ void row_phase(const float* xin_lat, const float* xin_ctx, float* xout_lat, float* xout_ctx, const bf16_t* Y, bf16_t* H,
                                          const float* gy, const float* gh, const float* mod_g, int gate_idx, const float* mod_h, int shift_idx, int scale_idx,
                                          int nrows, int gw, int ngw, int lane) {
    for (int row = gw; row < nrows; row += ngw) {
        const bool lat = row < ML; const int who = lat ? (row >> 11) : 8;
        const float* xi = lat ? xin_lat + (size_t)row * DM : xin_ctx + (size_t)(row - ML) * DM;
        f32x4 xv[4];
#pragma unroll
        for (int j = 0; j < 4; ++j) xv[j] = *(const f32x4*)(xi + lane * 4 + 256 * j);
        if (HAS_Y) {
            f32x4 yv[4]; float s = 0.f;
#pragma unroll
            for (int j = 0; j < 4; ++j) { yv[j] = bf4_to_f32(*(const u32x2*)(Y + (size_t)row * DM + lane * 4 + 256 * j)); s += (yv[j][0] * yv[j][0] + yv[j][1] * yv[j][1]) + (yv[j][2] * yv[j][2] + yv[j][3] * yv[j][3]); }
            const float rstd = 1.0f / sqrtf(wave_sum(s) * (1.0f / DM) + EPS);
            float* xo = lat ? xout_lat + (size_t)row * DM : xout_ctx + (size_t)(row - ML) * DM;
#pragma unroll
            for (int j = 0; j < 4; ++j) { const int col = lane * 4 + 256 * j;
                const f32x4 g = *(const f32x4*)(gy + col), gt = *(const f32x4*)(mod_g + (size_t)who * 6144 + gate_idx * 1024 + col);
                xv[j] = xv[j] + gt * (yv[j] * rstd * g);
                *(f32x4*)(xo + col) = xv[j]; }
        }
        if (HAS_H) {
            float s = 0.f;
#pragma unroll
            for (int j = 0; j < 4; ++j) s += (xv[j][0] * xv[j][0] + xv[j][1] * xv[j][1]) + (xv[j][2] * xv[j][2] + xv[j][3] * xv[j][3]);
            const float rstd = 1.0f / sqrtf(wave_sum(s) * (1.0f / DM) + EPS);
#pragma unroll
            for (int j = 0; j < 4; ++j) { const int col = lane * 4 + 256 * j;
                const f32x4 g = *(const f32x4*)(gh + col), sh = *(const f32x4*)(mod_h + (size_t)who * 6144 + shift_idx * 1024 + col), sc = *(const f32x4*)(mod_h + (size_t)who * 6144 + scale_idx * 1024 + col);
                const f32x4 hv = (xv[j] * rstd * g) * (1.0f + sc) + sh;
                *(u32x2*)(H + (size_t)row * DM + col) = f32_to_bf4(hv); }
        }
    }
}

__device__ __forceinline__ void attn_phase(LAS unsigned char* lds, bf16_t* Q, const bf16_t* Kb, const bf16_t* VT, const bf16_t* VTC, const float* sink, int tid, int lane, int wave) {
    constexpr int PITCH = 72;
    LAS bf16_t* Ks = (LAS bf16_t*)lds;
    LAS bf16_t* Vs = (LAS bf16_t*)(lds + 2 * 64 * PITCH * 2);
    const int lr = lane & 15, lg = lane >> 4;
    const int skey = tid >> 3, spiece = tid & 7;
    for (int unit = blockIdx.x; unit < 576; unit += gridDim.x) {
        int b, kvh, qrow0, qblk, nloc, lt0; bool latu = unit < 512;
        if (latu) { b = unit >> 6; const int rem = unit & 63; qblk = rem >> 2; kvh = rem & 3; qrow0 = b * SEQ + qblk * 128; lt0 = (qblk == 0) ? 2 : 0; nloc = ((qblk == 15) ? 4 : 6) - lt0; }
        else { const int cu = unit - 512; b = cu >> 3; kvh = (cu & 7) >> 1; qblk = 0; qrow0 = ML + b * CTX + (cu & 1) * 128; lt0 = 0; nloc = 0; }
        const int nT = nloc + 4;
        const int head = kvh * 4 + (wave >> 1);
        const int qr0 = qrow0 + (wave & 1) * 64;
        LAS unsigned char* Qs = lds + 40960 + wave * 8192;
#pragma unroll
        for (int qt = 0; qt < 4; ++qt)
#pragma unroll
            for (int dh = 0; dh < 2; ++dh) *(LAS bf16x8*)(Qs + (qt * 2 + dh) * 1024 + lane * 16) = *(const bf16x8*)(Q + (size_t)(qr0 + qt * 16 + lr) * 1024 + head * 64 + dh * 32 + lg * 8);
        f32x4 o[4][4];
#pragma unroll
        for (int qt = 0; qt < 4; ++qt)
#pragma unroll
            for (int dt = 0; dt < 4; ++dt) o[qt][dt] = (f32x4){0.f, 0.f, 0.f, 0.f};
        float m2[4], ls[4];
        { const float sk = sink[head] * LOG2E;
#pragma unroll
          for (int qt = 0; qt < 4; ++qt) { m2[qt] = sk; ls[qt] = (lg == 0) ? 1.0f : 0.0f; } }
        u32x4 kreg, vreg;
#define ATT_LOAD(j) do { const int _j = (j); if (_j < nloc) { const int tok0 = (qblk - 1) * 128 + (lt0 + _j) * 64; \
                const bf16_t* kb_ = Kb + (size_t)(b * SEQ + tok0) * 256 + kvh * 64; const bf16_t* vb_ = VT + (size_t)(b * 4 + kvh) * 64 * SEQ + tok0; \
                kreg = *(const u32x4*)(kb_ + (unsigned)(skey * 256 + spiece * 8)); vreg = *(const u32x4*)(vb_ + (unsigned)(skey * SEQ + spiece * 8)); } \
            else { const int tok0 = (_j - nloc) * 64; \
                const bf16_t* kb_ = Kb + (size_t)(ML + b * CTX + tok0) * 256 + kvh * 64; const bf16_t* vb_ = VTC + (size_t)(b * 4 + kvh) * 64 * CTX + tok0; \
                kreg = *(const u32x4*)(kb_ + (unsigned)(skey * 256 + spiece * 8)); vreg = *(const u32x4*)(vb_ + (unsigned)(skey * CTX + spiece * 8)); } } while (0)
#define ATT_STORE(buf) do { *(LAS u32x4*)(Ks + (buf) * 64 * PITCH + skey * PITCH + spiece * 8) = kreg; *(LAS u32x4*)(Vs + (buf) * 64 * PITCH + skey * PITCH + spiece * 8) = vreg; } while (0)
        __syncthreads();
        ATT_LOAD(0); ATT_STORE(0);
        __syncthreads();
        for (int j = 0; j < nT; ++j) {
            const int buf = j & 1;
            if (j + 1 < nT) ATT_LOAD(j + 1);
            const LAS bf16_t* Kt = Ks + buf * 64 * PITCH; const LAS bf16_t* Vt = Vs + buf * 64 * PITCH;
            int mmode = 0, ktok0 = 0;
            if (j < nloc) { const int lt = lt0 + j; ktok0 = (qblk - 1) * 128 + lt * 64; mmode = (lt < 2) ? 1 : ((lt >= 4) ? 2 : 0); }
            bf16x8 kf[4][2];
#pragma unroll
            for (int ks = 0; ks < 4; ++ks)
#pragma unroll
                for (int dh = 0; dh < 2; ++dh) kf[ks][dh] = *(const LAS bf16x8*)(Kt + (ks * 16 + lr) * PITCH + dh * 32 + lg * 8);
#pragma unroll
            for (int hq = 0; hq < 2; ++hq) {
            bf16x8 pb[2][2];
#pragma unroll
            for (int q2 = 0; q2 < 2; ++q2) {
                const int qt = hq * 2 + q2;
                f32x4 s[4];
                const bf16x8 qf0 = *(const LAS bf16x8*)(Qs + (qt * 2 + 0) * 1024 + lane * 16), qf1 = *(const LAS bf16x8*)(Qs + (qt * 2 + 1) * 1024 + lane * 16);
#pragma unroll
                for (int ks = 0; ks < 4; ++ks) { s[ks] = __builtin_amdgcn_mfma_f32_16x16x32_bf16(kf[ks][0], qf0, (f32x4){0.f, 0.f, 0.f, 0.f}, 0, 0, 0);
                    s[ks] = __builtin_amdgcn_mfma_f32_16x16x32_bf16(kf[ks][1], qf1, s[ks], 0, 0, 0); }
                if (mmode) { const int qp = qblk * 128 + (wave & 1) * 64 + qt * 16 + lr;
#pragma unroll
                    for (int ks = 0; ks < 4; ++ks)
#pragma unroll
                        for (int jj = 0; jj < 4; ++jj) { const int kp = ktok0 + ks * 16 + lg * 4 + jj; const bool ok = (mmode == 1) ? (kp >= qp - 128) : (kp <= qp + 128); s[ks][jj] = ok ? s[ks][jj] : -1e30f; } }
                float mx = -3e38f;
#pragma unroll
                for (int ks = 0; ks < 4; ++ks) mx = fmaxf(mx, fmaxf(fmaxf(s[ks][0], s[ks][1]), fmaxf(s[ks][2], s[ks][3])));
                mx = fmaxf(mx, __shfl_xor(mx, 16)); mx = fmaxf(mx, __shfl_xor(mx, 32));
                const float mnew = fmaxf(m2[qt], mx * LOG2E);
                const float alpha = __builtin_amdgcn_exp2f(m2[qt] - mnew);
                m2[qt] = mnew;
                float rs = 0.f;
#pragma unroll
                for (int ks = 0; ks < 4; ++ks)
#pragma unroll
                    for (int jj = 0; jj < 4; ++jj) { const float pv = __builtin_amdgcn_exp2f(s[ks][jj] * LOG2E - mnew); s[ks][jj] = pv; rs += pv; }
                ls[qt] = ls[qt] * alpha + rs;
#pragma unroll
                for (int dt = 0; dt < 4; ++dt) o[qt][dt] = o[qt][dt] * alpha;
#pragma unroll
                for (int c2 = 0; c2 < 2; ++c2) { u32x4 w; w.x = cvt_pk_bf16(s[2 * c2][0], s[2 * c2][1]); w.y = cvt_pk_bf16(s[2 * c2][2], s[2 * c2][3]); w.z = cvt_pk_bf16(s[2 * c2 + 1][0], s[2 * c2 + 1][1]); w.w = cvt_pk_bf16(s[2 * c2 + 1][2], s[2 * c2 + 1][3]);
                    pb[q2][c2] = __builtin_bit_cast(bf16x8, w); }
            }
#pragma unroll
            for (int c2 = 0; c2 < 2; ++c2)
#pragma unroll
                for (int dt = 0; dt < 4; ++dt) {
                    const LAS bf16_t* vp = Vt + (dt * 16 + lr) * PITCH + c2 * 32 + lg * 4;
                    const u32x2 v0 = *(const LAS u32x2*)vp, v1 = *(const LAS u32x2*)(vp + 16);
                    const u32x4 vv = {v0.x, v0.y, v1.x, v1.y};
                    const bf16x8 vf = __builtin_bit_cast(bf16x8, vv);
#pragma unroll
                    for (int q2 = 0; q2 < 2; ++q2) o[hq * 2 + q2][dt] = __builtin_amdgcn_mfma_f32_16x16x32_bf16(vf, pb[q2][c2], o[hq * 2 + q2][dt], 0, 0, 0);
                }
            }
            if (j + 1 < nT) ATT_STORE(buf ^ 1);
            __syncthreads();
        }
#pragma unroll
        for (int qt = 0; qt < 4; ++qt) {
            float l = ls[qt]; l += __shfl_xor(l, 16); l += __shfl_xor(l, 32);
            const float inv = 1.0f / l;
            bf16_t* op = Q + (size_t)(qr0 + qt * 16 + lr) * 1024 + head * 64 + lg * 4;
#pragma unroll
            for (int dt = 0; dt < 4; ++dt) *(u32x2*)(op + dt * 16) = f32_to_bf4(o[qt][dt] * inv);
        }
    }
#undef ATT_LOAD
#undef ATT_STORE
}

__device__ __forceinline__ void conv_phase(const bf16_t* R, bf16_t* U, const float* cw, const float* cb, int gtid, int nthreads) {
    for (int idx = gtid; idx < MT * 160; idx += nthreads) {
        const int row = idx / 160, ch = (idx % 160) * 8;
        int t, T; if (row < ML) { t = row & 2047; T = SEQ; } else { t = (row - ML) & 255; T = CTX; }
        float acc[8];
        { const f32x4 b0 = *(const f32x4*)(cb + ch), b1 = *(const f32x4*)(cb + ch + 4); acc[0] = b0[0]; acc[1] = b0[1]; acc[2] = b0[2]; acc[3] = b0[3]; acc[4] = b1[0]; acc[5] = b1[1]; acc[6] = b1[2]; acc[7] = b1[3]; }
#pragma unroll
        for (int tap = 0; tap < 4; ++tap) { const int tt = t + tap - 2;
            if (tt >= 0 && tt < T) { const u32x4 rv = *(const u32x4*)(R + (size_t)(row + tap - 2) * DRNN + ch);
                const f32x4 w0 = *(const f32x4*)(cw + tap * DRNN + ch), w1 = *(const f32x4*)(cw + tap * DRNN + ch + 4);
                acc[0] += w0[0] * bf_lo(rv.x); acc[1] += w0[1] * bf_hi(rv.x); acc[2] += w0[2] * bf_lo(rv.y); acc[3] += w0[3] * bf_hi(rv.y);
                acc[4] += w1[0] * bf_lo(rv.z); acc[5] += w1[1] * bf_hi(rv.z); acc[6] += w1[2] * bf_lo(rv.w); acc[7] += w1[3] * bf_hi(rv.w); } }
        u32x4 o; o.x = cvt_pk_bf16(acc[0], acc[1]); o.y = cvt_pk_bf16(acc[2], acc[3]); o.z = cvt_pk_bf16(acc[4], acc[5]); o.w = cvt_pk_bf16(acc[6], acc[7]);
        *(u32x4*)(U + (size_t)row * DRNN + ch) = o;
    }
}
__device__ __forceinline__ int scan_row0(int bl, int c) { return (c < 8) ? (8192 + bl * CTX + c * 32) : (bl * SEQ + (c - 8) * 32); }
__device__ __forceinline__ void scanA_phase(const bf16_t* LA, const bf16_t* BX, float* SP, float* SH, int gtid, int nthreads) {
    for (int idx = gtid; idx < 2 * 4 * 72 * 640; idx += nthreads) {
        const int cp = idx % 640, r1 = idx / 640, c = r1 % 72, r2 = r1 / 72, bl = r2 & 3, dir = r2 >> 2;
        const int row0 = scan_row0(bl, c);
        const size_t base = ((size_t)dir * 9216 + row0) * DRNN + cp * 2;
        float P0 = 1.f, P1 = 1.f, H0 = 0.f, H1 = 0.f;
#pragma unroll 8
        for (int i = 0; i < 32; ++i) { const int ii = dir ? (31 - i) : i;
            const unsigned lw = *(const unsigned*)(LA + base + (size_t)ii * DRNN), bw = *(const unsigned*)(BX + base + (size_t)ii * DRNN);
            const float a0 = __expf(bf_lo(lw)), a1 = __expf(bf_hi(lw));
            P0 *= a0; P1 *= a1; H0 = a0 * H0 + bf_lo(bw); H1 = a1 * H1 + bf_hi(bw); }
        const size_t so = ((size_t)(dir * 4 + bl) * 72 + c) * DRNN + cp * 2;
        *(f32x2*)(SP + so) = (f32x2){P0, P1}; *(f32x2*)(SH + so) = (f32x2){H0, H1};
    }
}
__device__ __forceinline__ void scanB_phase(const float* SP, const float* SH, float* CIN, int gtid, int nthreads) {
    for (int idx = gtid; idx < 2 * 4 * DRNN; idx += nthreads) {
        const int ch = idx % DRNN, r = idx / DRNN, bl = r & 3, dir = r >> 2;
        const size_t base = ((size_t)(dir * 4 + bl) * 72) * DRNN + ch;
        float carry = 0.f;
#pragma unroll 1
        for (int s0 = 0; s0 < 72; s0 += 24) {
            float pv[24], hv[24];
#pragma unroll
            for (int s = 0; s < 24; ++s) { const int sq = s0 + s; const int c = dir ? (sq < 8 ? 7 - sq : 79 - sq) : sq; pv[s] = SP[base + (size_t)c * DRNN]; hv[s] = SH[base + (size_t)c * DRNN]; }
#pragma unroll
            for (int s = 0; s < 24; ++s) { const int sq = s0 + s; const int c = dir ? (sq < 8 ? 7 - sq : 79 - sq) : sq; CIN[base + (size_t)c * DRNN] = carry; carry = pv[s] * carry + hv[s]; }
        }
    }
}
__device__ __forceinline__ void scanC_phase(const bf16_t* LA, const bf16_t* BX, const float* CIN, bf16_t* REC, int half, int gtid, int nthreads) {
    for (int idx = gtid; idx < 4 * 64 * 640; idx += nthreads) {
        const int cp = idx % 640, r1 = idx / 640, lc = r1 & 63, bl = r1 >> 6;
        const int row0 = bl * SEQ + lc * 32;
        const size_t b0 = ((size_t)row0) * DRNN + cp * 2, b1 = ((size_t)9216 + row0) * DRNN + cp * 2;
        const f32x2 cf = *(const f32x2*)(CIN + ((size_t)(0 * 4 + bl) * 72 + 8 + lc) * DRNN + cp * 2);
        const f32x2 cbk = *(const f32x2*)(CIN + ((size_t)(1 * 4 + bl) * 72 + 8 + lc) * DRNN + cp * 2);
        float hf0[32], hf1[32];
        float h0 = cf[0], h1 = cf[1];
#pragma unroll
        for (int i = 0; i < 32; ++i) { const unsigned lw = *(const unsigned*)(LA + b0 + (size_t)i * DRNN), bw = *(const unsigned*)(BX + b0 + (size_t)i * DRNN);
            h0 = __expf(bf_lo(lw)) * h0 + bf_lo(bw); h1 = __expf(bf_hi(lw)) * h1 + bf_hi(bw); hf0[i] = h0; hf1[i] = h1; }
        h0 = cbk[0]; h1 = cbk[1];
        bf16_t* out = REC + ((size_t)(half * 4 + bl) * SEQ + lc * 32) * DRNN + cp * 2;
#pragma unroll
        for (int i = 31; i >= 0; --i) { const unsigned lw = *(const unsigned*)(LA + b1 + (size_t)i * DRNN), bw = *(const unsigned*)(BX + b1 + (size_t)i * DRNN);
            h0 = __expf(bf_lo(lw)) * h0 + bf_lo(bw); h1 = __expf(bf_hi(lw)) * h1 + bf_hi(bw);
            *(unsigned*)(out + (size_t)i * DRNN) = cvt_pk_bf16(hf0[i] + h0, hf1[i] + h1); }
    }
}

#ifndef PH_MASK
#define PH_MASK 0xFFFFFFFFu
#endif
#define PH(k) ((PH_MASK >> (k)) & 1u)
__global__ void __launch_bounds__(512, 2) fwd_megakernel(Params p) {
    extern __shared__ __attribute__((aligned(16))) unsigned char lds_raw[];
    LAS unsigned char* lds = (LAS unsigned char*)lds_raw;
    cg::grid_group grid = cg::this_grid();
    const int G = gridDim.x, bid = blockIdx.x;
    const int ngw = G * 8, nthreads = G * 512;
#define TIDS int tid = threadIdx.x; asm volatile("" : "+v"(tid)); const int lane = tid & 63, wave = __builtin_amdgcn_readfirstlane(tid >> 6); const int gw = bid * 8 + wave, gtid = bid * 512 + tid; (void)lane; (void)gw; (void)gtid;
    unsigned char* ws = p.ws;
    float* MOD0 = (float*)(ws + WS_MOD); float* MOD1 = MOD0 + 9 * 6144;
    float* CTXRES = (float*)(ws + WS_CTXRES);
    bf16_t* H = (bf16_t*)(ws + WS_H);
    bf16_t* Qb = (bf16_t*)(ws + WS_Q); bf16_t* Kb = (bf16_t*)(ws + WS_K); bf16_t* VT = (bf16_t*)(ws + WS_VT); bf16_t* VTC = (bf16_t*)(ws + WS_VTC);
    bf16_t* ACT = (bf16_t*)(ws + WS_ACT);
    bf16_t* U = (bf16_t*)(ws + WS_U); bf16_t* LA = (bf16_t*)(ws + WS_LA); bf16_t* BX = (bf16_t*)(ws + WS_BX); bf16_t* RPRE = (bf16_t*)(ws + WS_RPRE);
    float* SP = (float*)(ws + WS_SP); float* SH = (float*)(ws + WS_SH); float* CIN = (float*)(ws + WS_CIN);
    const float* g0 = p.norm_g; const float* g1 = p.norm_g + 4 * DM;
    using namespace pg8;

    if (PH(0)) { TIDS prologue(p, lds, tid, lane, wave); }
    grid.sync();
    if (PH(1)) { TIDS row_phase<false, true>(p.x, p.ctx, nullptr, nullptr, nullptr, H, nullptr, g0, nullptr, 0, MOD0, 0, 1, MT, gw, ngw, lane); }
    grid.sync();
    if (PH(2)) {
        Gemm g{H, (const bf16_t*)(ws + WS_WQKV), DM, DM, DM}; Sched S; S.init(MT / 256, NQKV / 256, G, bid);
        EpiQKV E{Qb, Kb, VT, VTC, (const float*)(ws + WS_ROPE)};
        gemm_phase<EpiQKV, true, true>(lds, g, S, E);
    }
    grid.sync();
    if (PH(3)) { TIDS attn_phase(lds, Qb, Kb, VT, VTC, p.sink, tid, lane, wave); }
    grid.sync();
    if (PH(4)) {
        Gemm g{Qb, (const bf16_t*)(ws + WS_WO), DM, DM, DM}; Sched S; S.init(MT / 256, DM / 256, G, bid);
        EpiPlain<0> E{H, DM};
        gemm_phase<EpiPlain<0>, true, true>(lds, g, S, E);
    }
    grid.sync();
    if (PH(5)) { TIDS row_phase<true, true>(p.x, p.ctx, p.out, CTXRES, H, H, g0 + DM, g0 + 2 * DM, MOD0, 2, MOD0, 3, 4, MT, gw, ngw, lane); }
    grid.sync();
    if (PH(6)) {
        Gemm g{H, (const bf16_t*)(ws + WS_W1), DM, DM, DM}; Sched S; S.init(MT / 256, DFF / 256, G, bid);
        EpiPlain<1> E{ACT, DFF};
        gemm_phase<EpiPlain<1>, true, true>(lds, g, S, E);
    }
    grid.sync();
    if (PH(7)) {
        Gemm g{ACT, (const bf16_t*)(ws + WS_W2), DFF, DFF, DFF}; Sched S; S.init(MT / 256, DM / 256, G, bid);
        EpiPlain<0> E{H, DM};
        gemm_phase<EpiPlain<0>, true, true>(lds, g, S, E);
    }
    grid.sync();
    if (PH(8)) { TIDS row_phase<true, true>(p.out, CTXRES, p.out, CTXRES, H, H, g0 + 3 * DM, g1, MOD0, 5, MOD1, 0, 1, MT, gw, ngw, lane); }
    grid.sync();
    if (PH(9)) {
        Gemm g{H, (const bf16_t*)(ws + WS_WIN) + (size_t)DRNN * DM, DM, DM, DM}; Sched S; S.init(MT / 256, DRNN / 256, G, bid);
        EpiPlain<0> E{RPRE, DRNN};
        gemm_phase<EpiPlain<0>, true, true>(lds, g, S, E);
    }
    grid.sync();
    if (PH(10)) { TIDS conv_phase(RPRE, U, p.conv_w, p.conv_b, gtid, nthreads); }
    grid.sync();
#pragma unroll 1
    for (int half = 0; half < 2; ++half) {
        if (PH(11)) {
            Gemm g{U, (const bf16_t*)(ws + WS_WG), DRNN, 256, 256}; Sched S; S.init(36, 20, G, bid, 1, half);
            EpiGates E{U, LA, BX, p.b_a, p.b_i, (const float*)(ws + WS_NLS)};
            gemm_phase<EpiGates, true, true>(lds, g, S, E);
        }
        grid.sync();
        if (PH(12)) { TIDS scanA_phase(LA, BX, SP, SH, gtid, nthreads); }
        grid.sync();
        if (PH(13)) { TIDS scanB_phase(SP, SH, CIN, gtid, nthreads); }
        grid.sync();
        if (PH(14)) { TIDS scanC_phase(LA, BX, CIN, U, half, gtid, nthreads); }
        grid.sync();
    }
    if (PH(15)) {
        Gemm g{H, (const bf16_t*)(ws + WS_WIN), DM, DM, DM}; Sched S; S.init(ML / 256, DRNN / 256, G, bid);
        EpiGateMul E{U};
        gemm_phase<EpiGateMul, true, true>(lds, g, S, E);
    }
    grid.sync();
    if (PH(16)) {
        Gemm g{U, (const bf16_t*)(ws + WS_WOUT), DRNN, DRNN, DRNN}; Sched S; S.init(ML / 256, DM / 256, G, bid);
        EpiPlain<0> E{H, DM};
        gemm_phase<EpiPlain<0>, true, true>(lds, g, S, E);
    }
    grid.sync();
    if (PH(17)) { TIDS row_phase<true, true>(p.out, CTXRES, p.out, CTXRES, H, H, g1 + DM, g1 + 2 * DM, MOD1, 2, MOD1, 3, 4, ML, gw, ngw, lane); }
    grid.sync();
    if (PH(18)) {
        Gemm g{H, (const bf16_t*)(ws + WS_W1 + 16 * MiB), DM, DM, DM}; Sched S; S.init(ML / 256, DFF / 256, G, bid);
        EpiPlain<1> E{ACT, DFF};
        gemm_phase<EpiPlain<1>, true, true>(lds, g, S, E);
    }
    grid.sync();
    if (PH(19)) {
        Gemm g{ACT, (const bf16_t*)(ws + WS_W2 + 16 * MiB), DFF, DFF, DFF}; Sched S; S.init(ML / 256, DM / 256, G, bid);
        EpiPlain<0> E{H, DM};
        gemm_phase<EpiPlain<0>, true, true>(lds, g, S, E);
    }
    grid.sync();
    if (PH(20)) { TIDS row_phase<true, false>(p.out, CTXRES, p.out, CTXRES, H, nullptr, g1 + 3 * DM, nullptr, MOD1, 5, nullptr, 0, 0, ML, gw, ngw, lane); }
}

extern "C" void kernel_launch(void* const* d_in, const int* in_sizes, int n_in, void* d_out, int out_size, void* d_ws, size_t ws_size, hipStream_t stream) {
    static int grid_blocks = 0;
    if (grid_blocks == 0) {
        if (n_in != 21 || ws_size < WS_END) { fprintf(stderr, "kernel_launch: unexpected n_in %d / ws_size %zu\n", n_in, ws_size); grid_blocks = -1; return; }
        int dev = 0, cus = 0, per_cu = 0;
        hipGetDevice(&dev);
        hipDeviceGetAttribute(&cus, hipDeviceAttributeMultiprocessorCount, dev);
        if (hipFuncSetAttribute((const void*)fwd_megakernel, hipFuncAttributeMaxDynamicSharedMemorySize, LDS_BYTES) != hipSuccess) { fprintf(stderr, "hipFuncSetAttribute failed\n"); grid_blocks = -1; return; }
        if (hipOccupancyMaxActiveBlocksPerMultiprocessor(&per_cu, (const void*)fwd_megakernel, 512, LDS_BYTES) != hipSuccess || per_cu < 1) { fprintf(stderr, "occupancy query failed (%d)\n", per_cu); (void)hipGetLastError(); per_cu = 1; }
        grid_blocks = cus * 1;
    }
    if (grid_blocks < 0) return;
    Params p{};
    p.x = (const float*)d_in[0]; p.c = (const float*)d_in[1]; p.ctx = (const float*)d_in[2]; p.c_ctx = (const float*)d_in[3];
    p.ada_w = (const float*)d_in[4]; p.ada_b = (const float*)d_in[5]; p.norm_g = (const float*)d_in[6]; p.mlp_w1 = (const float*)d_in[7]; p.mlp_w2 = (const float*)d_in[8];
    p.w_qkv = (const float*)d_in[9]; p.w_o = (const float*)d_in[10]; p.sink = (const float*)d_in[11];
    p.w_in = (const float*)d_in[12]; p.conv_w = (const float*)d_in[13]; p.conv_b = (const float*)d_in[14]; p.w_a = (const float*)d_in[15]; p.b_a = (const float*)d_in[16];
    p.w_i = (const float*)d_in[17]; p.b_i = (const float*)d_in[18]; p.lam = (const float*)d_in[19]; p.w_out = (const float*)d_in[20];
    p.out = (float*)d_out; p.ws = (unsigned char*)d_ws;
    void* args[] = {&p};
    hipError_t e = hipLaunchCooperativeKernel((const void*)fwd_megakernel, dim3(grid_blocks), dim3(512), args, LDS_BYTES, stream);
    if (e != hipSuccess) fprintf(stderr, "cooperative launch failed: %s (grid %d)\n", hipGetErrorString(e), grid_blocks);
}
```

```cpp
#include <hip/hip_runtime.h>
#include <hip/hip_cooperative_groups.h>
#include <cstdio>
#include <cstdint>
namespace cg = cooperative_groups;

#define LAS __attribute__((address_space(3)))
typedef unsigned short bf16_t;
typedef short bf16x8 __attribute__((ext_vector_type(8)));
typedef float f32x4 __attribute__((ext_vector_type(4)));
typedef float f32x2 __attribute__((ext_vector_type(2)));
typedef unsigned u32x4 __attribute__((ext_vector_type(4)));
typedef unsigned u32x2 __attribute__((ext_vector_type(2)));

constexpr int DM = 1024, NB = 8, SEQ = 2048, CTX = 256;
constexpr int ML = NB * SEQ;
constexpr int MC = NB * CTX;
constexpr int MT = ML + MC;
constexpr int NQKV = 1536, DFF = 4096, DRNN = 1280;
constexpr float EPS = 1e-6f;
constexpr float LOG2E = 1.4426950408889634f;

constexpr size_t MiB = 1u << 20;
constexpr size_t WS_MOD = 0;
constexpr size_t WS_ROPE = 448 * 1024;
constexpr size_t WS_NLS = 460 * 1024;
constexpr size_t WS_BAR = 480 * 1024;
constexpr size_t WS_WQKV = 1 * MiB, WS_WO = 4 * MiB, WS_W1 = 6 * MiB, WS_W2 = 14 * MiB;
constexpr size_t WS_WIN = 38 * MiB, WS_WG = 43 * MiB, WS_WOUT = 46 * MiB;
constexpr size_t WS_CTXRES = 49 * MiB;
constexpr size_t WS_H = 57 * MiB;
constexpr size_t WS_R3 = 93 * MiB;
constexpr size_t WS_Q = WS_R3, WS_K = 129 * MiB, WS_VT = 138 * MiB, WS_VTC = 146 * MiB;
constexpr size_t WS_ACT = WS_R3;
constexpr size_t WS_U = WS_R3;
constexpr size_t WS_LA = 138 * MiB;
constexpr size_t WS_BX = 183 * MiB;
constexpr size_t WS_RPRE = 138 * MiB;
constexpr size_t WS_SP = 228 * MiB, WS_SH = 231 * MiB, WS_CIN = 234 * MiB;
constexpr size_t WS_END = 256 * MiB;
constexpr int LDS_BYTES = 135168;

__device__ __forceinline__ unsigned f2bf(float f) { unsigned u = __builtin_bit_cast(unsigned, f); return (u + 0x7fffu + ((u >> 16) & 1u)) >> 16; }
__device__ __forceinline__ unsigned cvt_pk_bf16(float lo, float hi) { unsigned r; asm volatile("v_cvt_pk_bf16_f32 %0, %1, %2" : "=v"(r) : "v"(lo), "v"(hi)); return r; }
__device__ __forceinline__ float bf_lo(unsigned w) { return __builtin_bit_cast(float, w << 16); }
__device__ __forceinline__ float bf_hi(unsigned w) { return __builtin_bit_cast(float, w & 0xffff0000u); }
__device__ __forceinline__ f32x4 bf4_to_f32(u32x2 w) { return (f32x4){bf_lo(w.x), bf_hi(w.x), bf_lo(w.y), bf_hi(w.y)}; }
__device__ __forceinline__ u32x2 f32_to_bf4(f32x4 v) { u32x2 w; w.x = cvt_pk_bf16(v[0], v[1]); w.y = cvt_pk_bf16(v[2], v[3]); return w; }
__device__ __forceinline__ float wave_sum(float v) {
#pragma unroll
    for (int o = 1; o < 64; o <<= 1) v += __shfl_xor(v, o);
    return v;
}
__device__ __forceinline__ float fsigmoid(float x) { return __builtin_amdgcn_rcpf(1.0f + __expf(-x)); }

namespace pg8 {
constexpr int BM = 256, BK = 64, HALF = 128, HTB = HALF * BK * 2, STAGE_BYTES = 8 * HTB, NXCD = 8, WGM = 8;
__device__ __forceinline__ int lds_byte(int r, int c) { const int st = (r >> 4) * 2 + (c >> 5), rr = r & 15, cc = c & 31, ob = rr * 64 + cc * 2; return st * 1024 + (ob ^ (((ob >> 9) & 1) << 5)); }
__device__ __forceinline__ void stage_rc(int b, int& R, int& C) { const int st = b / 1024, sb = b % 1024, swz = sb ^ (((sb >> 9) & 1) << 5); R = (st >> 1) * 16 + swz / 64; C = (st & 1) * 32 + (swz % 64) / 2; }

struct Unit { int pm, pn, koff, po; };
struct Gemm { const bf16_t* A; const bf16_t* Bt; int lda, ldb, K; };

struct Sched {
    int nM, nN, nwg, G, c, mode, half;
    __device__ void init(int nM_, int nN_, int G_, int c_, int mode_ = 0, int half_ = 0) { nM = nM_; nN = nN_; nwg = nM * nN; G = G_; c = c_; mode = mode_; half = half_; }
    __device__ bool next(int i, Unit& u) const {
        const long L = (long)i * G + c; if (L >= nwg) return false;
        int wgid = (int)L; { const int q = nwg / NXCD, r = nwg % NXCD, xcd = wgid % NXCD, off = wgid / NXCD; wgid = (xcd < r ? xcd * (q + 1) : r * (q + 1) + (xcd - r) * q) + off; }
        const int nig = WGM * nN, gid = wgid / nig, fm = gid * WGM, gsz = (nM - fm) < WGM ? (nM - fm) : WGM;
        const int pmi = fm + ((wgid % nig) % gsz), pn = (wgid % nig) / gsz;
        u.pm = pmi; u.pn = pn; u.koff = 0; u.po = pmi;
        if (mode == 1) { u.pm = pmi < 32 ? 32 * half + pmi : 64 + 4 * half + (pmi - 32); u.koff = ((pn >> 1) % 5) * 256; }
        return true;
    }
};

template <class Epi, bool ALIGN_EPI, bool SP2>
__device__ __forceinline__ void gemm_phase(LAS unsigned char* lds, const Gemm g, const Sched& S, const Epi& E) {
    int tid = threadIdx.x; asm volatile("" : "+v"(tid));
    const int wid = __builtin_amdgcn_readfirstlane(tid >> 6), lane = tid & 63, wr = wid >> 2, wc = wid & 3, fr = lane & 15, fq = lane >> 4;
    const int K = g.K, nt = K / BK;
    unsigned voffA[2], voffB[2];
#pragma unroll
    for (int i = 0; i < 2; ++i) { int R, C; stage_rc(tid * 16 + i * 8192, R, C);
        voffA[i] = (unsigned)(R * g.lda + C) * 2u; voffB[i] = (unsigned)(R * g.ldb + C) * 2u; }
    const size_t kstep = (size_t)(BK * 2);
    const size_t hstepA = (size_t)HALF * g.lda * 2, hstepB = (size_t)HALF * g.ldb * 2;
    const unsigned ldsw = (unsigned)wid * 1024u;
    const int aoff = lds_byte(wr * 64 + fr, fq * 8), boff = lds_byte(wc * 32 + fr, fq * 8);
#define PG8_SA(b, h) (((b) * 2 + (h)) * HTB)
#define PG8_SB(b, h) ((4 + (b) * 2 + (h)) * HTB)
#define PG8_STAGE(bufoff, gbase, voff) do { _Pragma("unroll") for (int _i = 0; _i < 2; ++_i) \
        __builtin_amdgcn_global_load_lds((const unsigned*)((const char*)(gbase) + (voff)[_i]), (LAS unsigned*)(lds + (bufoff) + ldsw + _i * 8192), 16, 0, 0); } while (0)
#define PG8_LDA(dst, b, h) do { _Pragma("unroll") for (int m = 0; m < 4; ++m) _Pragma("unroll") for (int k = 0; k < 2; ++k) dst[m][k] = *(const LAS bf16x8*)(lds + PG8_SA(b, h) + aoff + m * 2048 + k * 1024); } while (0)
#define PG8_LDB(dst, b, h) do { _Pragma("unroll") for (int n = 0; n < 2; ++n) _Pragma("unroll") for (int k = 0; k < 2; ++k) dst[n][k] = *(const LAS bf16x8*)(lds + PG8_SB(b, h) + boff + n * 2048 + k * 1024); } while (0)
#define PG8_MMA(ai, bj, At, Bt) do { __builtin_amdgcn_s_setprio(1); _Pragma("unroll") for (int m = 0; m < 4; ++m) _Pragma("unroll") for (int n = 0; n < 2; ++n) _Pragma("unroll") for (int k = 0; k < 2; ++k) \
        acc[ai][bj][m][n] = __builtin_amdgcn_mfma_f32_16x16x32_bf16(Bt[n][k], At[m][k], acc[ai][bj][m][n], 0, 0, 0); __builtin_amdgcn_s_setprio(0); } while (0)
#define PG8_WAIT_V(n) asm volatile("s_waitcnt vmcnt(" #n ")" ::: "memory")
#define PG8_WAIT_L(n) asm volatile("s_waitcnt lgkmcnt(" #n ")" ::: "memory")
#define PG8_BAR __builtin_amdgcn_s_barrier()
#define PG8_SCHED __builtin_amdgcn_sched_barrier(0)
    Unit cur, nxt; int ui = 0;
    if (!S.next(0, cur)) return;
    f32x4 acc[2][2][4][2];
#pragma unroll
    for (int a = 0; a < 2; ++a)
#pragma unroll
        for (int b = 0; b < 2; ++b)
#pragma unroll
            for (int m = 0; m < 4; ++m)
#pragma unroll
                for (int n = 0; n < 2; ++n) acc[a][b][m][n] = (f32x4){0.f, 0.f, 0.f, 0.f};
    bf16x8 At[4][2], B0[2][2], B1[2][2];
    const char* cA = (const char*)g.A + ((size_t)cur.pm * BM * g.lda + cur.koff) * 2; const char* cB = (const char*)g.Bt + (size_t)cur.pn * BM * g.ldb * 2;
    if constexpr (SP2) {
        PG8_STAGE(PG8_SB(0, 0), cB, voffB); PG8_STAGE(PG8_SB(0, 1), cB + hstepB, voffB); PG8_STAGE(PG8_SA(0, 0), cA, voffA); PG8_STAGE(PG8_SA(0, 1), cA + hstepA, voffA);
        if (wr == 1) PG8_BAR;
        PG8_WAIT_V(2); PG8_BAR;
        PG8_STAGE(PG8_SB(1, 0), cB + kstep, voffB); PG8_STAGE(PG8_SA(1, 0), cA + kstep, voffA); PG8_STAGE(PG8_SB(1, 1), cB + hstepB + kstep, voffB);
        PG8_WAIT_V(6); PG8_BAR;
    } else {
        PG8_STAGE(PG8_SB(0, 0), cB, voffB); PG8_STAGE(PG8_SA(0, 0), cA, voffA); PG8_STAGE(PG8_SB(0, 1), cB + hstepB, voffB); PG8_STAGE(PG8_SA(0, 1), cA + hstepA, voffA);
        if (wr == 1) PG8_BAR;
        PG8_WAIT_V(4); PG8_BAR;
        PG8_STAGE(PG8_SB(1, 0), cB + kstep, voffB); PG8_STAGE(PG8_SA(1, 0), cA + kstep, voffA); PG8_STAGE(PG8_SB(1, 1), cB + hstepB + kstep, voffB);
        PG8_WAIT_V(6); PG8_BAR;
    }
    for (;;) {
        const bool has_next = S.next(ui + 1, nxt);
        const char* nA = has_next ? (const char*)g.A + ((size_t)nxt.pm * BM * g.lda + nxt.koff) * 2 : cA;
        const char* nB = has_next ? (const char*)g.Bt + (size_t)nxt.pn * BM * g.ldb * 2 : cB;
#pragma unroll 1
        for (int t = 0; t < nt; t += 2) {
            const bool last = (t == nt - 2);
            const char* a1 = cA + (size_t)(t + 1) * kstep;
            const char* a2 = last ? nA : cA + (size_t)(t + 2) * kstep; const char* b2 = last ? nB : cB + (size_t)(t + 2) * kstep;
            const char* a3 = a2 + kstep; const char* b3 = b2 + kstep;
            if constexpr (SP2) {
            PG8_LDB(B0, 0, 0); PG8_LDB(B1, 0, 1); PG8_SCHED; PG8_LDA(At, 0, 0); PG8_STAGE(PG8_SA(1, 1), a1 + hstepA, voffA);
            PG8_WAIT_V(8); PG8_WAIT_L(0); PG8_BAR; PG8_MMA(0, 0, At, B0); PG8_MMA(0, 1, At, B1); PG8_BAR; PG8_SCHED;
            PG8_LDA(At, 0, 1); PG8_STAGE(PG8_SB(0, 0), b2, voffB); PG8_STAGE(PG8_SB(0, 1), b2 + hstepB, voffB); PG8_STAGE(PG8_SA(0, 0), a2, voffA);
            PG8_WAIT_V(8); PG8_WAIT_L(0); PG8_BAR; PG8_MMA(1, 0, At, B0); PG8_MMA(1, 1, At, B1); PG8_BAR; PG8_SCHED;
            PG8_LDB(B0, 1, 0); PG8_LDB(B1, 1, 1); PG8_SCHED; PG8_LDA(At, 1, 0); PG8_STAGE(PG8_SA(0, 1), a2 + hstepA, voffA);
            PG8_WAIT_V(8); PG8_WAIT_L(0); PG8_BAR; PG8_MMA(0, 0, At, B0); PG8_MMA(0, 1, At, B1); PG8_BAR; PG8_SCHED;
            PG8_LDA(At, 1, 1); PG8_STAGE(PG8_SB(1, 0), b3, voffB); PG8_STAGE(PG8_SB(1, 1), b3 + hstepB, voffB); PG8_STAGE(PG8_SA(1, 0), a3, voffA);
            PG8_WAIT_V(8); PG8_WAIT_L(0); PG8_BAR; PG8_MMA(1, 0, At, B0); PG8_MMA(1, 1, At, B1); PG8_BAR; PG8_SCHED;
            } else {
            PG8_LDB(B0, 0, 0); PG8_SCHED; PG8_LDA(At, 0, 0); PG8_STAGE(PG8_SA(1, 1), a1 + hstepA, voffA);
            PG8_WAIT_L(8); PG8_BAR; PG8_WAIT_L(0); PG8_MMA(0, 0, At, B0); PG8_BAR; PG8_SCHED;
            PG8_LDB(B1, 0, 1); PG8_STAGE(PG8_SB(0, 0), b2, voffB);
            PG8_BAR; PG8_WAIT_L(0); PG8_MMA(0, 1, At, B1); PG8_BAR;
            PG8_LDA(At, 0, 1); PG8_STAGE(PG8_SA(0, 0), a2, voffA);
            PG8_BAR; PG8_WAIT_L(0); PG8_MMA(1, 0, At, B0); PG8_BAR; PG8_SCHED;
            PG8_STAGE(PG8_SB(0, 1), b2 + hstepB, voffB);
            PG8_WAIT_V(6); PG8_BAR; PG8_MMA(1, 1, At, B1); PG8_BAR;
            PG8_LDB(B0, 1, 0); PG8_SCHED; PG8_LDA(At, 1, 0); PG8_STAGE(PG8_SA(0, 1), a2 + hstepA, voffA);
            PG8_WAIT_L(8); PG8_BAR; PG8_WAIT_L(0); PG8_MMA(0, 0, At, B0); PG8_BAR; PG8_SCHED;
            PG8_LDB(B1, 1, 1); PG8_STAGE(PG8_SB(1, 0), b3, voffB);
            PG8_BAR; PG8_WAIT_L(0); PG8_MMA(0, 1, At, B1); PG8_BAR;
            PG8_LDA(At, 1, 1); PG8_STAGE(PG8_SA(1, 0), a3, voffA);
            PG8_BAR; PG8_WAIT_L(0); PG8_MMA(1, 0, At, B0); PG8_BAR; PG8_SCHED;
            PG8_STAGE(PG8_SB(1, 1), b3 + hstepB, voffB);
            PG8_WAIT_V(6); PG8_BAR; PG8_MMA(1, 1, At, B1); PG8_BAR;
            }
        }
        if constexpr (ALIGN_EPI) { if (wr == 0) PG8_BAR; }
        E(acc, cur, wr, wc, fr, fq);
        if (!has_next) break;
#pragma unroll
        for (int a = 0; a < 2; ++a)
#pragma unroll
            for (int b = 0; b < 2; ++b)
#pragma unroll
                for (int m = 0; m < 4; ++m)
#pragma unroll
                    for (int n = 0; n < 2; ++n) acc[a][b][m][n] = (f32x4){0.f, 0.f, 0.f, 0.f};
        cur = nxt; cA = nA; cB = nB; ++ui;
        if constexpr (ALIGN_EPI) { if (wr == 1) PG8_BAR; }
    }
    PG8_WAIT_V(0);
    if constexpr (!ALIGN_EPI) { if (wr == 0) PG8_BAR; }
    PG8_BAR;
#undef PG8_SA
#undef PG8_SB
#undef PG8_STAGE
#undef PG8_LDA
#undef PG8_LDB
#undef PG8_MMA
#undef PG8_WAIT_V
#undef PG8_WAIT_L
#undef PG8_BAR
#undef PG8_SCHED
}

template <int ACT> struct EpiPlain {
    bf16_t* O; int ldc;
    __device__ __forceinline__ void operator()(const f32x4 (&acc)[2][2][4][2], const Unit& u, int wr, int wc, int fr_, int fq_) const {
        int fr = fr_, fq = fq_; asm volatile("" : "+v"(fr), "+v"(fq));
        const int col0 = u.pn * BM + wc * 32 + fq * 4;
#pragma unroll
        for (int ai = 0; ai < 2; ++ai)
#pragma unroll
            for (int m = 0; m < 4; ++m) { bf16_t* rowp = O + (size_t)(u.pm * BM + ai * HALF + wr * 64 + m * 16 + fr) * ldc + col0;
#pragma unroll
                for (int bj = 0; bj < 2; ++bj)
#pragma unroll
                    for (int n = 0; n < 2; ++n) { f32x4 v = acc[ai][bj][m][n];
                        if (ACT == 1) { v = __builtin_elementwise_max(v, (f32x4){0.f, 0.f, 0.f, 0.f}); v = v * v; }
                        *(u32x2*)(rowp + bj * HALF + n * 16) = f32_to_bf4(v); } }
    }
};

struct EpiQKV {
    bf16_t* Q; bf16_t* Kb; bf16_t* VT; bf16_t* VTC; const float* rope;
    __device__ __forceinline__ void operator()(const f32x4 (&acc)[2][2][4][2], const Unit& u, int wr, int wc, int fr_, int fq_) const {
        int fr = fr_, fq = fq_; asm volatile("" : "+v"(fr), "+v"(fq));
        const bool lat = u.pm < 64;
        if (u.pn < 5) {
#pragma unroll
            for (int ai = 0; ai < 2; ++ai)
#pragma unroll
                for (int m = 0; m < 4; ++m) {
                    const int row = u.pm * BM + ai * HALF + wr * 64 + m * 16 + fr;
                    f32x4 cs0 = {1.f, 0.f, 1.f, 0.f}, cs1 = {1.f, 0.f, 1.f, 0.f};
                    if (lat) { const int t = row & 2047; const int pos = (wc & 1) ? (t & 63) : (t >> 6); const f32x4* pp = (const f32x4*)(rope + (pos * 16 + 4 * fq) * 2); cs0 = pp[0]; cs1 = pp[1]; }
                    const f32x4 cv = {cs0[0], cs0[2], cs1[0], cs1[2]}, sv = {cs0[1], cs0[3], cs1[1], cs1[3]};
#pragma unroll
                    for (int bj = 0; bj < 2; ++bj) {
                        const f32x4 a = acc[ai][bj][m][0], b = acc[ai][bj][m][1];
                        f32x4 na = a * cv - b * sv, nb = b * cv + a * sv;
                        if (u.pn < 4) { na = na * 0.125f; nb = nb * 0.125f;
                            bf16_t* d = Q + (size_t)row * 1024 + u.pn * 256 + bj * HALF + wc * 32 + fq * 4;
                            *(u32x2*)d = f32_to_bf4(na); *(u32x2*)(d + 16) = f32_to_bf4(nb);
                        } else {
                            bf16_t* d = Kb + (size_t)row * 256 + bj * HALF + wc * 32 + fq * 4;
                            *(u32x2*)d = f32_to_bf4(na); *(u32x2*)(d + 16) = f32_to_bf4(nb);
                        }
                    }
                }
        } else {
#pragma unroll
            for (int ai = 0; ai < 2; ++ai)
#pragma unroll
                for (int m = 0; m < 4; ++m) {
                    const int row = u.pm * BM + ai * HALF + wr * 64 + m * 16 + fr;
                    bf16_t* base; size_t stride;
                    if (lat) { const int b = row >> 11, t = row & 2047; base = VT + (size_t)b * 256 * 2048 + t; stride = 2048; }
                    else { const int rc = row - ML; const int b = rc >> 8, t = rc & 255; base = VTC + (size_t)b * 256 * 256 + t; stride = 256; }
#pragma unroll
                    for (int bj = 0; bj < 2; ++bj)
#pragma unroll
                        for (int n = 0; n < 2; ++n)
#pragma unroll
                            for (int j = 0; j < 4; ++j) { const int vc = bj * HALF + wc * 32 + n * 16 + fq * 4 + j; base[(size_t)vc * stride] = (bf16_t)f2bf(acc[ai][bj][m][n][j]); }
                }
        }
    }
};

struct EpiGates {
    const bf16_t* U; bf16_t* LA; bf16_t* BX; const float* ba; const float* bi; const float* nls;
    __device__ __forceinline__ void operator()(const f32x4 (&acc)[2][2][4][2], const Unit& u, int wr, int wc, int fr_, int fq_) const {
        int fr = fr_, fq = fq_; asm volatile("" : "+v"(fr), "+v"(fq));
        const int tile = u.pn >> 1, dir = tile / 5, blk = tile % 5, chalf = u.pn & 1;
        const int ch0 = blk * 256 + chalf * 128 + wc * 32 + fq * 4;
#pragma unroll
        for (int n = 0; n < 2; ++n) {
            const int ch = ch0 + n * 16;
            const f32x4 bav = *(const f32x4*)(ba + dir * DRNN + ch), biv = *(const f32x4*)(bi + dir * DRNN + ch), nl = *(const f32x4*)(nls + dir * DRNN + ch);
#pragma unroll
            for (int ai = 0; ai < 2; ++ai)
#pragma unroll
                for (int m = 0; m < 4; ++m) {
                    const int rin = ai * HALF + wr * 64 + m * 16 + fr;
                    const size_t rowg = (size_t)u.pm * BM + rin, rowl = (size_t)u.po * BM + rin;
                    const f32x4 uv = bf4_to_f32(*(const u32x2*)(U + rowg * DRNN + ch));
                    f32x4 lav, bxv;
#pragma unroll
                    for (int j = 0; j < 4; ++j) {
                        const float r = fsigmoid(acc[ai][0][m][n][j] + bav[j]);
                        const float ig = fsigmoid(acc[ai][1][m][n][j] + biv[j]);
                        const float la = nl[j] * r, x = 2.0f * la;
                        float om;
                        if (x > -0.5f) { float q = 1.0f / 720.0f; q = q * x + 1.0f / 120.0f; q = q * x + 1.0f / 24.0f; q = q * x + 1.0f / 6.0f; q = q * x + 0.5f; q = q * x + 1.0f; om = -x * q; }
                        else om = 1.0f - __expf(x);
                        lav[j] = la; bxv[j] = __builtin_amdgcn_sqrtf(om) * (ig * uv[j]);
                    }
                    const size_t o = ((size_t)dir * 9216 + rowl) * DRNN + ch;
                    *(u32x2*)(LA + o) = f32_to_bf4(lav); *(u32x2*)(BX + o) = f32_to_bf4(bxv);
                    asm volatile("" ::: "memory");
                }
        }
    }
};

struct EpiGateMul {
    bf16_t* Z;
    __device__ __forceinline__ void operator()(const f32x4 (&acc)[2][2][4][2], const Unit& u, int wr, int wc, int fr_, int fq_) const {
        int fr = fr_, fq = fq_; asm volatile("" : "+v"(fr), "+v"(fq));
        const int col0 = u.pn * BM + wc * 32 + fq * 4;
#pragma unroll
        for (int ai = 0; ai < 2; ++ai)
#pragma unroll
            for (int m = 0; m < 4; ++m) { bf16_t* rowp = Z + (size_t)(u.pm * BM + ai * HALF + wr * 64 + m * 16 + fr) * DRNN + col0;
#pragma unroll
                for (int bj = 0; bj < 2; ++bj)
#pragma unroll
                    for (int n = 0; n < 2; ++n) { const f32x4 v = acc[ai][bj][m][n]; const f32x4 rc = bf4_to_f32(*(const u32x2*)(rowp + bj * HALF + n * 16)); f32x4 o;
#pragma unroll
                        for (int j = 0; j < 4; ++j) { const float x = v[j]; const float z2 = 1.5957691216057308f * (x + 0.044715f * x * x * x); o[j] = x * fsigmoid(z2) * rc[j]; }
                        *(u32x2*)(rowp + bj * HALF + n * 16) = f32_to_bf4(o); }
                asm volatile("" ::: "memory"); }
    }
};
}


#define XB_TMO      128
#define XB_XCNT(j)  (256  + 64 * (j))
#define XB_XSUB(j)  (1280 + 64 * (j))
#define XB_XGEN(j)  (2304 + 64 * (j))
#define XB_TOP      3328
#define XB_TOPGEN   3392
#define XCD_BAR_WORDS 3456
#define XB_SPIN_CAP (1u << 18)
__device__ __forceinline__ unsigned xb_ld(unsigned* p)              { return __hip_atomic_load(p, __ATOMIC_RELAXED, __HIP_MEMORY_SCOPE_AGENT); }
__device__ __forceinline__ unsigned xb_add(unsigned* p, unsigned v) { return __hip_atomic_fetch_add(p, v, __ATOMIC_RELAXED, __HIP_MEMORY_SCOPE_AGENT); }
__device__ __forceinline__ unsigned xb_xcc_id() { return (unsigned)__builtin_amdgcn_s_getreg((3 << 11) | 20) & 0xFu; }
#define XB_SPIN(cond, bar) do { unsigned _sp = 0; while (cond) { __builtin_amdgcn_s_sleep(1); \
    if ((++_sp & 255u) == 0u) { if (xb_ld(&(bar)[XB_TMO])) break; if (_sp > XB_SPIN_CAP) { atomicAdd(&(bar)[XB_TMO], 1u); break; } } } } while (0)
struct XcdBarrier { unsigned* bar; unsigned x; volatile LAS unsigned* st; };
__device__ __forceinline__ XcdBarrier xcd_barrier_post(unsigned* bar, volatile LAS unsigned* st) {
    XcdBarrier b; b.bar = bar; b.x = xb_xcc_id(); b.st = st;
    if (threadIdx.x == 0) (void)xb_add(&bar[XB_XCNT(b.x)], 1u);
    return b;
}
__device__ __forceinline__ void xcd_barrier_complete(unsigned* bar, unsigned x, unsigned& nloc, unsigned& nx) {
    const unsigned G = gridDim.x * gridDim.y * gridDim.z;
    unsigned sum, cnt, mine, sp = 0u;
    for (;;) {
        sum = 0u; cnt = 0u; mine = 0u;
#pragma unroll
        for (unsigned j = 0; j < 16; ++j) { const unsigned c = xb_ld(&bar[XB_XCNT(j)]); sum += c; cnt += (c > 0u) ? 1u : 0u; mine = (j == x) ? c : mine; }
        if (sum == G) break;
        __builtin_amdgcn_s_sleep(1);
        if ((++sp & 255u) == 0u) { if (xb_ld(&bar[XB_TMO])) break; if (sp > XB_SPIN_CAP) { atomicAdd(&bar[XB_TMO], 1u); break; } }
    }
    nloc = mine > 0u ? mine : 1u; nx = cnt > 0u ? cnt : 1u;
}
__device__ __forceinline__ void xcd_barrier(const XcdBarrier& b) {
    asm volatile("s_waitcnt vmcnt(0)" ::: "memory");
    __syncthreads();
    if (threadIdx.x == 0) {
        unsigned* bar = b.bar;
        __builtin_amdgcn_s_waitcnt(0);
        unsigned nloc = b.st[0], nx = b.st[1];
        if (nloc == 0u) { xcd_barrier_complete(bar, b.x, nloc, nx); b.st[0] = nloc; b.st[1] = nx; }
        const unsigned old = xb_add(&bar[XB_XSUB(b.x)], 1u);
        const unsigned gen = old / nloc;
        if (old + 1u == (gen + 1u) * nloc) {
            __builtin_amdgcn_fence(__ATOMIC_RELEASE, "agent");
            asm volatile("s_waitcnt vmcnt(0)" ::: "memory");
            const unsigned og = xb_add(&bar[XB_TOP], 1u);
            const unsigned tg = og / nx;
            if (og + 1u == (tg + 1u) * nx) xb_add(&bar[XB_TOPGEN], 1u);
            else XB_SPIN(xb_ld(&bar[XB_TOPGEN]) == tg, bar);
            __builtin_amdgcn_fence(__ATOMIC_ACQUIRE, "agent");
            xb_add(&bar[XB_XGEN(b.x)], 1u);
            asm volatile("s_waitcnt vmcnt(0)" ::: "memory");
        } else {
            XB_SPIN(xb_ld(&bar[XB_XGEN(b.x)]) == gen, bar);
            __builtin_amdgcn_fence(__ATOMIC_ACQUIRE, "agent");
            asm volatile("s_waitcnt vmcnt(0)" ::: "memory");
        }
    }
    __syncthreads();
}

struct Params {
    const float *x, *c, *ctx, *c_ctx, *ada_w, *ada_b, *norm_g, *mlp_w1, *mlp_w2, *w_qkv, *w_o, *sink;
    const float *w_in, *conv_w, *conv_b, *w_a, *b_a, *w_i, *b_i, *lam, *w_out;
    float* out; unsigned char* ws;
};

__device__ __forceinline__ void transpose_item(const float* W, int ldw, bf16_t* WT, int ldwt, int k0, int n0, int dst_row0, LAS float* scr, int lane) {
#pragma unroll 8
    for (int i = 0; i < 32; ++i) { const int kk = 2 * i + (lane >> 5); scr[kk * 33 + (lane & 31)] = W[(size_t)(k0 + kk) * ldw + n0 + (lane & 31)]; }
    asm volatile("s_waitcnt lgkmcnt(0)" ::: "memory");
    const int c = lane & 7;
#pragma unroll
    for (int j = 0; j < 4; ++j) { const int n = (lane >> 3) + 8 * j; const LAS float* s = scr + (8 * c) * 33 + n;
        u32x4 o; o.x = cvt_pk_bf16(s[0 * 33], s[1 * 33]); o.y = cvt_pk_bf16(s[2 * 33], s[3 * 33]); o.z = cvt_pk_bf16(s[4 * 33], s[5 * 33]); o.w = cvt_pk_bf16(s[6 * 33], s[7 * 33]);
        *(u32x4*)(WT + (size_t)(dst_row0 + n) * ldwt + k0 + 8 * c) = o; }
    asm volatile("s_waitcnt lgkmcnt(0)" ::: "memory");
}
__device__ __forceinline__ void transpose_plain(const float* W, int K, int N, bf16_t* WT, int r, LAS float* scr, int lane) {
    const int nblk = N / 32, kb = r / nblk, nb = r % nblk;
    transpose_item(W, N, WT, K, 64 * kb, 32 * nb, 32 * nb, scr, lane);
}

__device__ __forceinline__ void prologue(const Params& p, LAS unsigned char* lds, int tid, int lane, int wave) {
    unsigned char* ws = p.ws;
    float* MOD = (float*)(ws + WS_MOD);
    if (blockIdx.x < 96) {
        LAS float* sl = (LAS float*)lds;
        LAS float* red = (LAS float*)(lds + 36864);
        for (int idx = tid; idx < 9216; idx += 512) { const int w = idx >> 10, k = idx & 1023; const float v = (w < 8) ? p.c[w * 1024 + k] : p.c_ctx[k]; sl[idx] = v / (1.0f + __expf(-v)); }
        __syncthreads();
        const int l = blockIdx.x / 48, n0 = (blockIdx.x % 48) * 128, kg = tid >> 5, cq = tid & 31;
        f32x4 acc[9];
#pragma unroll
        for (int w = 0; w < 9; ++w) acc[w] = (f32x4){0.f, 0.f, 0.f, 0.f};
        const float* wb = p.ada_w + (size_t)l * 1024 * 6144 + n0 + cq * 4;
#pragma unroll 4
        for (int it = 0; it < 64; ++it) { const int k = it * 16 + kg; const f32x4 w4 = *(const f32x4*)(wb + (size_t)k * 6144);
#pragma unroll
            for (int w = 0; w < 9; ++w) acc[w] += sl[w * 1024 + k] * w4; }
#pragma unroll
        for (int w = 0; w < 9; ++w) *(LAS f32x4*)(red + (kg * 9 + w) * 128 + cq * 4) = acc[w];
        __syncthreads();
        for (int idx = tid; idx < 9 * 128; idx += 512) { const int w = idx >> 7, n = idx & 127; float s = 0.f;
#pragma unroll
            for (int g = 0; g < 16; ++g) s += red[(g * 9 + w) * 128 + n];
            MOD[(size_t)(l * 9 + w) * 6144 + n0 + n] = s + p.ada_b[l * 6144 + n0 + n]; }
        __syncthreads();
    }
    if (blockIdx.x == gridDim.x - 1) {
        float* rope = (float*)(ws + WS_ROPE); float* nls = (float*)(ws + WS_NLS);
        for (int idx = tid; idx < 1024; idx += 512) { const int pos = idx >> 4, i = idx & 15;
            const float inv = __builtin_exp2f(-(float)i * (13.287712379549449f / 16.0f));
            const float angf = (float)pos * inv; const double ang = (double)angf;
            const double twopi = 6.283185307179586476925287; const double r = ang - twopi * __builtin_rint(ang / twopi);
            const double r2 = r * r; double cterm = 1.0, sterm = r, cs = 1.0, sn = r;
            for (int k = 1; k <= 14; ++k) { cterm *= -r2 / (double)((2 * k - 1) * (2 * k)); sterm *= -r2 / (double)((2 * k) * (2 * k + 1)); cs += cterm; sn += sterm; }
            rope[idx * 2] = (float)cs; rope[idx * 2 + 1] = (float)sn; }
        for (int idx = tid; idx < 2 * DRNN; idx += 512) { const float lm = p.lam[idx]; nls[idx] = -8.0f * log1pf(__expf(-lm)); }
    }
    LAS float* scr = (LAS float*)(lds + wave * 16384);
    const int gw = blockIdx.x * 8 + wave, NGW = gridDim.x * 8;
    constexpr int I_QKV = 16 * 48, I_O = 16 * 32, I_1 = 16 * 128, I_2 = 64 * 32, I_IN = 16 * 80, I_OUT = 20 * 32, I_G = 40 * 16;
    constexpr int NITEMS = I_QKV + I_O + 2 * I_1 + 2 * I_2 + I_IN + I_OUT + I_G;
    for (int it = gw; it < NITEMS; it += NGW) {
        int r = it;
        if (r < I_QKV) { transpose_plain(p.w_qkv, 1024, NQKV, (bf16_t*)(ws + WS_WQKV), r, scr, lane); continue; } r -= I_QKV;
        if (r < I_O) { transpose_plain(p.w_o, 1024, 1024, (bf16_t*)(ws + WS_WO), r, scr, lane); continue; } r -= I_O;
        if (r < 2 * I_1) { const int l = r / I_1; transpose_plain(p.mlp_w1 + (size_t)l * 1024 * DFF, 1024, DFF, (bf16_t*)(ws + WS_W1 + (size_t)l * 16 * MiB), r % I_1, scr, lane); continue; } r -= 2 * I_1;
        if (r < 2 * I_2) { const int l = r / I_2; transpose_plain(p.mlp_w2 + (size_t)l * 1024 * DFF, DFF, 1024, (bf16_t*)(ws + WS_W2 + (size_t)l * 16 * MiB), r % I_2, scr, lane); continue; } r -= 2 * I_2;
        if (r < I_IN) { transpose_plain(p.w_in, 1024, 2 * DRNN, (bf16_t*)(ws + WS_WIN), r, scr, lane); continue; } r -= I_IN;
        if (r < I_OUT) { transpose_plain(p.w_out, DRNN, 1024, (bf16_t*)(ws + WS_WOUT), r, scr, lane); continue; } r -= I_OUT;
        {
            const int sm = r >> 4, ii = r & 15, kb = ii >> 2, nb = ii & 3;
            const int chalf = sm & 1, blk = (sm >> 1) % 5, dg = (sm >> 1) / 5, gate = dg & 1, dir = dg >> 1;
            const float* W = (gate ? p.w_i : p.w_a) + (size_t)(dir * 5 + blk) * 256 * 256;
            const int dst_row0 = ((dir * 5 + blk) * 2 + chalf) * 256 + gate * 128 + nb * 32;
            transpose_item(W, 256, (bf16_t*)(ws + WS_WG), 256, 64 * kb, chalf * 128 + nb * 32, dst_row0, scr, lane);
        }
    }
}

template <bool HAS_Y, bool HAS_H>
__device__ __forceinline__ void row_phase(const float* xin_lat, const float* xin_ctx, float* xout_lat, float* xout_ctx, const bf16_t* Y, bf16_t* H,
                                          const float* gy, const float* gh, const float* mod_g, int gate_idx, const float* mod_h, int shift_idx, int scale_idx,
                                          int nrows, int gw, int ngw, int lane) {
    for (int row = gw; row < nrows; row += ngw) {
        const bool lat = row < ML; const int who = lat ? (row >> 11) : 8;
        const float* xi = lat ? xin_lat + (size_t)row * DM : xin_ctx + (size_t)(row - ML) * DM;
        f32x4 xv[4];
#pragma unroll
        for (int j = 0; j < 4; ++j) xv[j] = *(const f32x4*)(xi + lane * 4 + 256 * j);
        if (HAS_Y) {
            f32x4 yv[4]; float s = 0.f;
#pragma unroll
            for (int j = 0; j < 4; ++j) { yv[j] = bf4_to_f32(*(const u32x2*)(Y + (size_t)row * DM + lane * 4 + 256 * j)); s += (yv[j][0] * yv[j][0] + yv[j][1] * yv[j][1]) + (yv[j][2] * yv[j][2] + yv[j][3] * yv[j][3]); }
            const float rstd = 1.0f / sqrtf(wave_sum(s) * (1.0f / DM) + EPS);
            float* xo = lat ? xout_lat + (size_t)row * DM : xout_ctx + (size_t)(row - ML) * DM;
#pragma unroll
            for (int j = 0; j < 4; ++j) { const int col = lane * 4 + 256 * j;
                const f32x4 g = *(const f32x4*)(gy + col), gt = *(const f32x4*)(mod_g + (size_t)who * 6144 + gate_idx * 1024 + col);
                xv[j] = xv[j] + gt * (yv[j] * rstd * g);
                *(f32x4*)(xo + col) = xv[j]; }
        }
        if (HAS_H) {
            float s = 0.f;
#pragma unroll
            for (int j = 0; j < 4; ++j) s += (xv[j][0] * xv[j][0] + xv[j][1] * xv[j][1]) + (xv[j][2] * xv[j][2] + xv[j][3] * xv[j][3]);
            const float rstd = 1.0f / sqrtf(wave_sum(s) * (1.0f / DM) + EPS);
#pragma unroll
            for (int j = 0; j < 4; ++j) { const int col = lane * 4 + 256 * j;
                const f32x4 g = *(const f32x4*)(gh + col), sh = *(const f32x4*)(mod_h + (size_t)who * 6144 + shift_idx * 1024 + col), sc = *(const f32x4*)(mod_h + (size_t)who * 6144 + scale_idx * 1024 + col);
                const f32x4 hv = (xv[j] * rstd * g) * (1.0f + sc) + sh;
                *(u32x2*)(H + (size_t)row * DM + col) = f32_to_bf4(hv); }
        }
    }
}

__device__ __forceinline__ void attn_phase(LAS unsigned char* lds, bf16_t* Q, const bf16_t* Kb, const bf16_t* VT, const bf16_t* VTC, const float* sink, int tid, int lane, int wave) {
    constexpr int PITCH = 72;
    LAS bf16_t* Ks = (LAS bf16_t*)lds;
    LAS bf16_t* Vs = (LAS bf16_t*)(lds + 2 * 64 * PITCH * 2);
    const int lr = lane & 15, lg = lane >> 4;
    const int skey = tid >> 3, spiece = tid & 7;
    for (int unit = blockIdx.x; unit < 576; unit += gridDim.x) {
        int b, kvh, qrow0, qblk, nloc, lt0; bool latu = unit < 512;
        if (latu) { b = unit >> 6; const int rem = unit & 63; qblk = rem >> 2; kvh = rem & 3; qrow0 = b * SEQ + qblk * 128; lt0 = (qblk == 0) ? 2 : 0; nloc = ((qblk == 15) ? 4 : 6) - lt0; }
        else { const int cu = unit - 512; b = cu >> 3; kvh = (cu & 7) >> 1; qblk = 0; qrow0 = ML + b * CTX + (cu & 1) * 128; lt0 = 0; nloc = 0; }
        const int nT = nloc + 4;
        const int head = kvh * 4 + (wave >> 1);
        const int qr0 = qrow0 + (wave & 1) * 64;
        bf16_t* qbase = Q + (size_t)qr0 * 1024 + head * 64;
        LAS unsigned char* Qs = lds + 40960 + wave * 8192;
#pragma unroll
        for (int qt = 0; qt < 4; ++qt)
#pragma unroll
            for (int dh = 0; dh < 2; ++dh) *(LAS bf16x8*)(Qs + (qt * 2 + dh) * 1024 + lane * 16) = *(const bf16x8*)(qbase + (unsigned)((qt * 16 + lr) * 1024 + dh * 32 + lg * 8));
        f32x4 o[4][4];
#pragma unroll
        for (int qt = 0; qt < 4; ++qt)
#pragma unroll
            for (int dt = 0; dt < 4; ++dt) o[qt][dt] = (f32x4){0.f, 0.f, 0.f, 0.f};
        float m2[4], ls[4];
        { const float sk = sink[head] * LOG2E;
#pragma unroll
          for (int qt = 0; qt < 4; ++qt) { m2[qt] = sk; ls[qt] = (lg == 0) ? 1.0f : 0.0f; } }
        u32x4 kreg, vreg;
#define ATT_LOAD(j) do { const int _j = (j); if (_j < nloc) { const int tok0 = (qblk - 1) * 128 + (lt0 + _j) * 64; \
                const bf16_t* kb_ = Kb + (size_t)(b * SEQ + tok0) * 256 + kvh * 64; const bf16_t* vb_ = VT + (size_t)(b * 4 + kvh) * 64 * SEQ + tok0; \
                kreg = *(const u32x4*)(kb_ + (unsigned)(skey * 256 + spiece * 8)); vreg = *(const u32x4*)(vb_ + (unsigned)(skey * SEQ + spiece * 8)); } \
            else { const int tok0 = (_j - nloc) * 64; \
                const bf16_t* kb_ = Kb + (size_t)(ML + b * CTX + tok0) * 256 + kvh * 64; const bf16_t* vb_ = VTC + (size_t)(b * 4 + kvh) * 64 * CTX + tok0; \
                kreg = *(const u32x4*)(kb_ + (unsigned)(skey * 256 + spiece * 8)); vreg = *(const u32x4*)(vb_ + (unsigned)(skey * CTX + spiece * 8)); } } while (0)
#define ATT_STORE(buf) do { *(LAS u32x4*)(Ks + (buf) * 64 * PITCH + skey * PITCH + spiece * 8) = kreg; *(LAS u32x4*)(Vs + (buf) * 64 * PITCH + skey * PITCH + spiece * 8) = vreg; } while (0)
        __syncthreads();
        ATT_LOAD(0); ATT_STORE(0);
        __syncthreads();
        for (int j = 0; j < nT; ++j) {
            const int buf = j & 1;
            if (j + 1 < nT) ATT_LOAD(j + 1);
            const LAS bf16_t* Kt = Ks + buf * 64 * PITCH; const LAS bf16_t* Vt = Vs + buf * 64 * PITCH;
            int mmode = 0, ktok0 = 0;
            if (j < nloc) { const int lt = lt0 + j; ktok0 = (qblk - 1) * 128 + lt * 64; mmode = (lt < 2) ? 1 : ((lt >= 4) ? 2 : 0); }
            bf16x8 kf[4][2];
#pragma unroll
            for (int ks = 0; ks < 4; ++ks)
#pragma unroll
                for (int dh = 0; dh < 2; ++dh) kf[ks][dh] = *(const LAS bf16x8*)(Kt + (ks * 16 + lr) * PITCH + dh * 32 + lg * 8);
#pragma unroll
            for (int hq = 0; hq < 2; ++hq) {
            bf16x8 pb[2][2];
#pragma unroll
            for (int q2 = 0; q2 < 2; ++q2) {
                const int qt = hq * 2 + q2;
                f32x4 s[4];
                const bf16x8 qf0 = *(const LAS bf16x8*)(Qs + (qt * 2 + 0) * 1024 + lane * 16), qf1 = *(const LAS bf16x8*)(Qs + (qt * 2 + 1) * 1024 + lane * 16);
#pragma unroll
                for (int ks = 0; ks < 4; ++ks) { s[ks] = __builtin_amdgcn_mfma_f32_16x16x32_bf16(kf[ks][0], qf0, (f32x4){0.f, 0.f, 0.f, 0.f}, 0, 0, 0);
                    s[ks] = __builtin_amdgcn_mfma_f32_16x16x32_bf16(kf[ks][1], qf1, s[ks], 0, 0, 0); }
                if (mmode) { const int qp = qblk * 128 + (wave & 1) * 64 + qt * 16 + lr;
#pragma unroll
                    for (int ks = 0; ks < 4; ++ks)
#pragma unroll
                        for (int jj = 0; jj < 4; ++jj) { const int kp = ktok0 + ks * 16 + lg * 4 + jj; const bool ok = (mmode == 1) ? (kp >= qp - 128) : (kp <= qp + 128); s[ks][jj] = ok ? s[ks][jj] : -1e30f; } }
                float mx = -3e38f;
#pragma unroll
                for (int ks = 0; ks < 4; ++ks) mx = fmaxf(mx, fmaxf(fmaxf(s[ks][0], s[ks][1]), fmaxf(s[ks][2], s[ks][3])));
                mx = fmaxf(mx, __shfl_xor(mx, 16)); mx = fmaxf(mx, __shfl_xor(mx, 32));
                const float mnew = fmaxf(m2[qt], mx * LOG2E);
                const float alpha = __builtin_amdgcn_exp2f(m2[qt] - mnew);
                m2[qt] = mnew;
                float rs = 0.f;
#pragma unroll
                for (int ks = 0; ks < 4; ++ks)
#pragma unroll
                    for (int jj = 0; jj < 4; ++jj) { const float pv = __builtin_amdgcn_exp2f(s[ks][jj] * LOG2E - mnew); s[ks][jj] = pv; rs += pv; }
                ls[qt] = ls[qt] * alpha + rs;
#pragma unroll
                for (int dt = 0; dt < 4; ++dt) o[qt][dt] = o[qt][dt] * alpha;
#pragma unroll
                for (int c2 = 0; c2 < 2; ++c2) { u32x4 w; w.x = cvt_pk_bf16(s[2 * c2][0], s[2 * c2][1]); w.y = cvt_pk_bf16(s[2 * c2][2], s[2 * c2][3]); w.z = cvt_pk_bf16(s[2 * c2 + 1][0], s[2 * c2 + 1][1]); w.w = cvt_pk_bf16(s[2 * c2 + 1][2], s[2 * c2 + 1][3]);
                    pb[q2][c2] = __builtin_bit_cast(bf16x8, w); }
            }
#pragma unroll
            for (int c2 = 0; c2 < 2; ++c2)
#pragma unroll
                for (int dt = 0; dt < 4; ++dt) {
                    const LAS bf16_t* vp = Vt + (dt * 16 + lr) * PITCH + c2 * 32 + lg * 4;
                    const u32x2 v0 = *(const LAS u32x2*)vp, v1 = *(const LAS u32x2*)(vp + 16);
                    const u32x4 vv = {v0.x, v0.y, v1.x, v1.y};
                    const bf16x8 vf = __builtin_bit_cast(bf16x8, vv);
#pragma unroll
                    for (int q2 = 0; q2 < 2; ++q2) o[hq * 2 + q2][dt] = __builtin_amdgcn_mfma_f32_16x16x32_bf16(vf, pb[q2][c2], o[hq * 2 + q2][dt], 0, 0, 0);
                }
            }
            if (j + 1 < nT) ATT_STORE(buf ^ 1);
            __syncthreads();
        }
#pragma unroll
        for (int qt = 0; qt < 4; ++qt) {
            float l = ls[qt]; l += __shfl_xor(l, 16); l += __shfl_xor(l, 32);
            const float inv = 1.0f / l;
            int lro = lr * 1024 + lg * 4; asm volatile("" : "+v"(lro));
            bf16_t* op = qbase + (unsigned)(qt * 16 * 1024 + lro);
#pragma unroll
            for (int dt = 0; dt < 4; ++dt) *(u32x2*)(op + dt * 16) = f32_to_bf4(o[qt][dt] * inv);
        }
    }
#undef ATT_LOAD
#undef ATT_STORE
}

__device__ __forceinline__ void conv_phase(const bf16_t* R, bf16_t* U, const float* cw, const float* cb, int gtid, int nthreads) {
    for (int idx = gtid; idx < MT * 160; idx += nthreads) {
        const int row = idx / 160, ch = (idx % 160) * 8;
        int t, T; if (row < ML) { t = row & 2047; T = SEQ; } else { t = (row - ML) & 255; T = CTX; }
        float acc[8];
        { const f32x4 b0 = *(const f32x4*)(cb + ch), b1 = *(const f32x4*)(cb + ch + 4); acc[0] = b0[0]; acc[1] = b0[1]; acc[2] = b0[2]; acc[3] = b0[3]; acc[4] = b1[0]; acc[5] = b1[1]; acc[6] = b1[2]; acc[7] = b1[3]; }
#pragma unroll
        for (int tap = 0; tap < 4; ++tap) { const int tt = t + tap - 2;
            if (tt >= 0 && tt < T) { const u32x4 rv = *(const u32x4*)(R + (size_t)(row + tap - 2) * DRNN + ch);
                const f32x4 w0 = *(const f32x4*)(cw + tap * DRNN + ch), w1 = *(const f32x4*)(cw + tap * DRNN + ch + 4);
                acc[0] += w0[0] * bf_lo(rv.x); acc[1] += w0[1] * bf_hi(rv.x); acc[2] += w0[2] * bf_lo(rv.y); acc[3] += w0[3] * bf_hi(rv.y);
                acc[4] += w1[0] * bf_lo(rv.z); acc[5] += w1[1] * bf_hi(rv.z); acc[6] += w1[2] * bf_lo(rv.w); acc[7] += w1[3] * bf_hi(rv.w); } }
        u32x4 o; o.x = cvt_pk_bf16(acc[0], acc[1]); o.y = cvt_pk_bf16(acc[2], acc[3]); o.z = cvt_pk_bf16(acc[4], acc[5]); o.w = cvt_pk_bf16(acc[6], acc[7]);
        *(u32x4*)(U + (size_t)row * DRNN + ch) = o;
    }
}
__device__ __forceinline__ int scan_row0(int bl, int c) { return (c < 8) ? (8192 + bl * CTX + c * 32) : (bl * SEQ + (c - 8) * 32); }
__device__ __forceinline__ void scanA_phase(const bf16_t* LA, const bf16_t* BX, float* SP, float* SH, int gtid, int nthreads) {
    for (int idx = gtid; idx < 2 * 4 * 72 * 640; idx += nthreads) {
        const int cp = idx % 640, r1 = idx / 640, c = r1 % 72, r2 = r1 / 72, bl = r2 & 3, dir = r2 >> 2;
        const int row0 = scan_row0(bl, c);
        const size_t base = ((size_t)dir * 9216 + row0) * DRNN + cp * 2;
        float P0 = 1.f, P1 = 1.f, H0 = 0.f, H1 = 0.f;
#pragma unroll 8
        for (int i = 0; i < 32; ++i) { const int ii = dir ? (31 - i) : i;
            const unsigned lw = *(const unsigned*)(LA + base + (size_t)ii * DRNN), bw = *(const unsigned*)(BX + base + (size_t)ii * DRNN);
            const float a0 = __expf(bf_lo(lw)), a1 = __expf(bf_hi(lw));
            P0 *= a0; P1 *= a1; H0 = a0 * H0 + bf_lo(bw); H1 = a1 * H1 + bf_hi(bw); }
        const size_t so = ((size_t)(dir * 4 + bl) * 72 + c) * DRNN + cp * 2;
        *(f32x2*)(SP + so) = (f32x2){P0, P1}; *(f32x2*)(SH + so) = (f32x2){H0, H1};
    }
}
__device__ __forceinline__ void scanB_phase(const float* SP, const float* SH, float* CIN, int gtid, int nthreads) {
    for (int idx = gtid; idx < 2 * 4 * DRNN; idx += nthreads) {
        const int ch = idx % DRNN, r = idx / DRNN, bl = r & 3, dir = r >> 2;
        const size_t base = ((size_t)(dir * 4 + bl) * 72) * DRNN + ch;
        float carry = 0.f;
#pragma unroll 1
        for (int s0 = 0; s0 < 72; s0 += 24) {
            float pv[24], hv[24];
#pragma unroll
            for (int s = 0; s < 24; ++s) { const int sq = s0 + s; const int c = dir ? (sq < 8 ? 7 - sq : 79 - sq) : sq; pv[s] = SP[base + (size_t)c * DRNN]; hv[s] = SH[base + (size_t)c * DRNN]; }
#pragma unroll
            for (int s = 0; s < 24; ++s) { const int sq = s0 + s; const int c = dir ? (sq < 8 ? 7 - sq : 79 - sq) : sq; CIN[base + (size_t)c * DRNN] = carry; carry = pv[s] * carry + hv[s]; }
        }
    }
}
__device__ __forceinline__ void scanC_phase(const bf16_t* LA, const bf16_t* BX, const float* CIN, bf16_t* REC, int half, int gtid, int nthreads) {
    for (int idx = gtid; idx < 4 * 64 * 640; idx += nthreads) {
        const int cp = idx % 640, r1 = idx / 640, lc = r1 & 63, bl = r1 >> 6;
        const int row0 = bl * SEQ + lc * 32;
        const size_t b0 = ((size_t)row0) * DRNN + cp * 2, b1 = ((size_t)9216 + row0) * DRNN + cp * 2;
        const f32x2 cf = *(const f32x2*)(CIN + ((size_t)(0 * 4 + bl) * 72 + 8 + lc) * DRNN + cp * 2);
        const f32x2 cbk = *(const f32x2*)(CIN + ((size_t)(1 * 4 + bl) * 72 + 8 + lc) * DRNN + cp * 2);
        float hf0[32], hf1[32];
        float h0 = cf[0], h1 = cf[1];
#pragma unroll
        for (int i = 0; i < 32; ++i) { const unsigned lw = *(const unsigned*)(LA + b0 + (size_t)i * DRNN), bw = *(const unsigned*)(BX + b0 + (size_t)i * DRNN);
            h0 = __expf(bf_lo(lw)) * h0 + bf_lo(bw); h1 = __expf(bf_hi(lw)) * h1 + bf_hi(bw); hf0[i] = h0; hf1[i] = h1; }
        h0 = cbk[0]; h1 = cbk[1];
        bf16_t* out = REC + ((size_t)(half * 4 + bl) * SEQ + lc * 32) * DRNN + cp * 2;
#pragma unroll
        for (int i = 31; i >= 0; --i) { const unsigned lw = *(const unsigned*)(LA + b1 + (size_t)i * DRNN), bw = *(const unsigned*)(BX + b1 + (size_t)i * DRNN);
            h0 = __expf(bf_lo(lw)) * h0 + bf_lo(bw); h1 = __expf(bf_hi(lw)) * h1 + bf_hi(bw);
            *(unsigned*)(out + (size_t)i * DRNN) = cvt_pk_bf16(hf0[i] + h0, hf1[i] + h1); }
    }
}

#ifndef PH_MASK
#define PH_MASK 0xFFFFFFFFu
#endif
#define PH(k) ((PH_MASK >> (k)) & 1u)
__global__ void __launch_bounds__(512, 2) fwd_megakernel(Params p) {
    extern __shared__ __attribute__((aligned(16))) unsigned char lds_raw[];
    LAS unsigned char* lds = (LAS unsigned char*)lds_raw;
    cg::grid_group grid = cg::this_grid();
    const int G = gridDim.x, bid = blockIdx.x;
    const int ngw = G * 8, nthreads = G * 512;
#define TIDS int tid = threadIdx.x; asm volatile("" : "+v"(tid)); const int lane = tid & 63, wave = __builtin_amdgcn_readfirstlane(tid >> 6); const int gw = bid * 8 + wave, gtid = bid * 512 + tid; (void)lane; (void)gw; (void)gtid;
    unsigned char* ws = p.ws;
    float* MOD0 = (float*)(ws + WS_MOD); float* MOD1 = MOD0 + 9 * 6144;
    float* CTXRES = (float*)(ws + WS_CTXRES);
    bf16_t* H = (bf16_t*)(ws + WS_H);
    bf16_t* Qb = (bf16_t*)(ws + WS_Q); bf16_t* Kb = (bf16_t*)(ws + WS_K); bf16_t* VT = (bf16_t*)(ws + WS_VT); bf16_t* VTC = (bf16_t*)(ws + WS_VTC);
    bf16_t* ACT = (bf16_t*)(ws + WS_ACT);
    bf16_t* U = (bf16_t*)(ws + WS_U); bf16_t* LA = (bf16_t*)(ws + WS_LA); bf16_t* BX = (bf16_t*)(ws + WS_BX); bf16_t* RPRE = (bf16_t*)(ws + WS_RPRE);
    float* SP = (float*)(ws + WS_SP); float* SH = (float*)(ws + WS_SH); float* CIN = (float*)(ws + WS_CIN);
    const float* g0 = p.norm_g; const float* g1 = p.norm_g + 4 * DM;
    using namespace pg8;
    unsigned* barw = (unsigned*)(ws + WS_BAR);
    if (bid == 0) for (int i = threadIdx.x; i < XCD_BAR_WORDS; i += 512) __hip_atomic_store(barw + i, 0u, __ATOMIC_RELAXED, __HIP_MEMORY_SCOPE_AGENT);
    if (threadIdx.x < 4) ((volatile LAS unsigned*)(lds + 132096))[threadIdx.x] = 0u;

    if (PH(0)) { TIDS prologue(p, lds, tid, lane, wave); }
    __syncthreads();
    grid.sync();
    XcdBarrier xbar = xcd_barrier_post(barw, (volatile LAS unsigned*)(lds + 132096));
#ifdef EXTRA_SYNCS
#pragma unroll 1
    for (int es = 0; es < EXTRA_SYNCS; ++es) xcd_barrier(xbar);
#endif
    if (PH(1)) { TIDS row_phase<false, true>(p.x, p.ctx, nullptr, nullptr, nullptr, H, nullptr, g0, nullptr, 0, MOD0, 0, 1, MT, gw, ngw, lane); }
    xcd_barrier(xbar);
    if (PH(2)) {
        Gemm g{H, (const bf16_t*)(ws + WS_WQKV), DM, DM, DM}; Sched S; S.init(MT / 256, NQKV / 256, G, bid);
        EpiQKV E{Qb, Kb, VT, VTC, (const float*)(ws + WS_ROPE)};
        gemm_phase<EpiQKV, true, true>(lds, g, S, E);
    }
    xcd_barrier(xbar);
    if (PH(3)) { TIDS attn_phase(lds, Qb, Kb, VT, VTC, p.sink, tid, lane, wave); }
    xcd_barrier(xbar);
    if (PH(4)) {
        Gemm g{Qb, (const bf16_t*)(ws + WS_WO), DM, DM, DM}; Sched S; S.init(MT / 256, DM / 256, G, bid);
        EpiPlain<0> E{H, DM};
        gemm_phase<EpiPlain<0>, true, true>(lds, g, S, E);
    }
    xcd_barrier(xbar);
    if (PH(5)) { TIDS row_phase<true, true>(p.x, p.ctx, p.out, CTXRES, H, H, g0 + DM, g0 + 2 * DM, MOD0, 2, MOD0, 3, 4, MT, gw, ngw, lane); }
    xcd_barrier(xbar);
    if (PH(6)) {
        Gemm g{H, (const bf16_t*)(ws + WS_W1), DM, DM, DM}; Sched S; S.init(MT / 256, DFF / 256, G, bid);
        EpiPlain<1> E{ACT, DFF};
        gemm_phase<EpiPlain<1>, true, true>(lds, g, S, E);
    }
    xcd_barrier(xbar);
    if (PH(7)) {
        Gemm g{ACT, (const bf16_t*)(ws + WS_W2), DFF, DFF, DFF}; Sched S; S.init(MT / 256, DM / 256, G, bid);
        EpiPlain<0> E{H, DM};
        gemm_phase<EpiPlain<0>, true, true>(lds, g, S, E);
    }
    xcd_barrier(xbar);
    if (PH(8)) { TIDS row_phase<true, true>(p.out, CTXRES, p.out, CTXRES, H, H, g0 + 3 * DM, g1, MOD0, 5, MOD1, 0, 1, MT, gw, ngw, lane); }
    xcd_barrier(xbar);
    if (PH(9)) {
        Gemm g{H, (const bf16_t*)(ws + WS_WIN) + (size_t)DRNN * DM, DM, DM, DM}; Sched S; S.init(MT / 256, DRNN / 256, G, bid);
        EpiPlain<0> E{RPRE, DRNN};
        gemm_phase<EpiPlain<0>, true, true>(lds, g, S, E);
    }
    xcd_barrier(xbar);
    if (PH(10)) { TIDS conv_phase(RPRE, U, p.conv_w, p.conv_b, gtid, nthreads); }
    xcd_barrier(xbar);
#pragma unroll 1
    for (int half = 0; half < 2; ++half) {
        if (PH(11)) {
            Gemm g{U, (const bf16_t*)(ws + WS_WG), DRNN, 256, 256}; Sched S; S.init(36, 20, G, bid, 1, half);
            EpiGates E{U, LA, BX, p.b_a, p.b_i, (const float*)(ws + WS_NLS)};
            gemm_phase<EpiGates, true, true>(lds, g, S, E);
        }
        xcd_barrier(xbar);
        if (PH(12)) { TIDS scanA_phase(LA, BX, SP, SH, gtid, nthreads); }
        xcd_barrier(xbar);
        if (PH(13)) { TIDS scanB_phase(SP, SH, CIN, gtid, nthreads); }
        xcd_barrier(xbar);
        if (PH(14)) { TIDS scanC_phase(LA, BX, CIN, U, half, gtid, nthreads); }
        xcd_barrier(xbar);
    }
    if (PH(15)) {
        Gemm g{H, (const bf16_t*)(ws + WS_WIN), DM, DM, DM}; Sched S; S.init(ML / 256, DRNN / 256, G, bid);
        EpiGateMul E{U};
        gemm_phase<EpiGateMul, true, true>(lds, g, S, E);
    }
    xcd_barrier(xbar);
    if (PH(16)) {
        Gemm g{U, (const bf16_t*)(ws + WS_WOUT), DRNN, DRNN, DRNN}; Sched S; S.init(ML / 256, DM / 256, G, bid);
        EpiPlain<0> E{H, DM};
        gemm_phase<EpiPlain<0>, true, true>(lds, g, S, E);
    }
    xcd_barrier(xbar);
    if (PH(17)) { TIDS row_phase<true, true>(p.out, CTXRES, p.out, CTXRES, H, H, g1 + DM, g1 + 2 * DM, MOD1, 2, MOD1, 3, 4, ML, gw, ngw, lane); }
    xcd_barrier(xbar);
    if (PH(18)) {
        Gemm g{H, (const bf16_t*)(ws + WS_W1 + 16 * MiB), DM, DM, DM}; Sched S; S.init(ML / 256, DFF / 256, G, bid);
        EpiPlain<1> E{ACT, DFF};
        gemm_phase<EpiPlain<1>, true, true>(lds, g, S, E);
    }
    xcd_barrier(xbar);
    if (PH(19)) {
        Gemm g{ACT, (const bf16_t*)(ws + WS_W2 + 16 * MiB), DFF, DFF, DFF}; Sched S; S.init(ML / 256, DM / 256, G, bid);
        EpiPlain<0> E{H, DM};
        gemm_phase<EpiPlain<0>, true, true>(lds, g, S, E);
    }
    xcd_barrier(xbar);
    if (PH(20)) { TIDS row_phase<true, false>(p.out, CTXRES, p.out, CTXRES, H, nullptr, g1 + 3 * DM, nullptr, MOD1, 5, nullptr, 0, 0, ML, gw, ngw, lane); }
}

extern "C" void kernel_launch(void* const* d_in, const int* in_sizes, int n_in, void* d_out, int out_size, void* d_ws, size_t ws_size, hipStream_t stream) {
    static int grid_blocks = 0;
    if (grid_blocks == 0) {
        if (n_in != 21 || ws_size < WS_END) { fprintf(stderr, "kernel_launch: unexpected n_in %d / ws_size %zu\n", n_in, ws_size); grid_blocks = -1; return; }
        int dev = 0, cus = 0, per_cu = 0;
        hipGetDevice(&dev);
        hipDeviceGetAttribute(&cus, hipDeviceAttributeMultiprocessorCount, dev);
        if (hipFuncSetAttribute((const void*)fwd_megakernel, hipFuncAttributeMaxDynamicSharedMemorySize, LDS_BYTES) != hipSuccess) { fprintf(stderr, "hipFuncSetAttribute failed\n"); grid_blocks = -1; return; }
        if (hipOccupancyMaxActiveBlocksPerMultiprocessor(&per_cu, (const void*)fwd_megakernel, 512, LDS_BYTES) != hipSuccess || per_cu < 1) { fprintf(stderr, "occupancy query failed (%d)\n", per_cu); (void)hipGetLastError(); per_cu = 1; }
        grid_blocks = cus * 1;
    }
    if (grid_blocks < 0) return;
    Params p{};
    p.x = (const float*)d_in[0]; p.c = (const float*)d_in[1]; p.ctx = (const float*)d_in[2]; p.c_ctx = (const float*)d_in[3];
    p.ada_w = (const float*)d_in[4]; p.ada_b = (const float*)d_in[5]; p.norm_g = (const float*)d_in[6]; p.mlp_w1 = (const float*)d_in[7]; p.mlp_w2 = (const float*)d_in[8];
    p.w_qkv = (const float*)d_in[9]; p.w_o = (const float*)d_in[10]; p.sink = (const float*)d_in[11];
    p.w_in = (const float*)d_in[12]; p.conv_w = (const float*)d_in[13]; p.conv_b = (const float*)d_in[14]; p.w_a = (const float*)d_in[15]; p.b_a = (const float*)d_in[16];
    p.w_i = (const float*)d_in[17]; p.b_i = (const float*)d_in[18]; p.lam = (const float*)d_in[19]; p.w_out = (const float*)d_in[20];
    p.out = (float*)d_out; p.ws = (unsigned char*)d_ws;
    void* args[] = {&p};
    hipError_t e = hipLaunchCooperativeKernel((const void*)fwd_megakernel, dim3(grid_blocks), dim3(512), args, LDS_BYTES, stream);
    if (e != hipSuccess) fprintf(stderr, "cooperative launch failed: %s (grid %d)\n", hipGetErrorString(e), grid_blocks);
}
```

```cpp
#include <hip/hip_runtime.h>
#include <hip/hip_cooperative_groups.h>
#include <cstdio>
#include <cstdint>
namespace cg = cooperative_groups;

#define LAS __attribute__((address_space(3)))
typedef unsigned short bf16_t;
typedef short bf16x8 __attribute__((ext_vector_type(8)));
typedef float f32x4 __attribute__((ext_vector_type(4)));
typedef float f32x2 __attribute__((ext_vector_type(2)));
typedef unsigned u32x4 __attribute__((ext_vector_type(4)));
typedef unsigned u32x2 __attribute__((ext_vector_type(2)));

constexpr int DM = 1024, NB = 8, SEQ = 2048, CTX = 256;
constexpr int ML = NB * SEQ;
constexpr int MC = NB * CTX;
constexpr int MT = ML + MC;
constexpr int NQKV = 1536, DFF = 4096, DRNN = 1280;
constexpr float EPS = 1e-6f;
constexpr float LOG2E = 1.4426950408889634f;

constexpr size_t MiB = 1u << 20;
constexpr size_t WS_MOD = 0;
constexpr size_t WS_ROPE = 448 * 1024;
constexpr size_t WS_NLS = 460 * 1024;
constexpr size_t WS_BAR = 480 * 1024;
constexpr size_t WS_WQKV = 1 * MiB, WS_WO = 4 * MiB, WS_W1 = 6 * MiB, WS_W2 = 14 * MiB;
constexpr size_t WS_WIN = 38 * MiB, WS_WG = 43 * MiB, WS_WOUT = 46 * MiB;
constexpr size_t WS_CTXRES = 49 * MiB;
constexpr size_t WS_H = 57 * MiB;
constexpr size_t WS_R3 = 93 * MiB;
constexpr size_t WS_Q = WS_R3, WS_K = 129 * MiB, WS_VT = 138 * MiB, WS_VTC = 146 * MiB;
constexpr size_t WS_O = 150 * MiB;
constexpr size_t WS_ACT = WS_R3;
constexpr size_t WS_U = WS_R3;
constexpr size_t WS_LA = 138 * MiB;
constexpr size_t WS_BX = 183 * MiB;
constexpr size_t WS_RPRE = 138 * MiB;
constexpr size_t WS_SP = 228 * MiB, WS_SH = 231 * MiB, WS_CIN = 234 * MiB;
constexpr size_t WS_SLAB = 238 * MiB;
constexpr size_t WS_END = 256 * MiB;
constexpr int LDS_BYTES = 135168;

__device__ __forceinline__ unsigned f2bf(float f) { unsigned u = __builtin_bit_cast(unsigned, f); return (u + 0x7fffu + ((u >> 16) & 1u)) >> 16; }
__device__ __forceinline__ unsigned cvt_pk_bf16(float lo, float hi) { unsigned r; asm volatile("v_cvt_pk_bf16_f32 %0, %1, %2" : "=v"(r) : "v"(lo), "v"(hi)); return r; }
__device__ __forceinline__ float bf_lo(unsigned w) { return __builtin_bit_cast(float, w << 16); }
__device__ __forceinline__ float bf_hi(unsigned w) { return __builtin_bit_cast(float, w & 0xffff0000u); }
__device__ __forceinline__ f32x4 bf4_to_f32(u32x2 w) { return (f32x4){bf_lo(w.x), bf_hi(w.x), bf_lo(w.y), bf_hi(w.y)}; }
__device__ __forceinline__ u32x2 f32_to_bf4(f32x4 v) { u32x2 w; w.x = cvt_pk_bf16(v[0], v[1]); w.y = cvt_pk_bf16(v[2], v[3]); return w; }
__device__ __forceinline__ float wave_sum(float v) {
#pragma unroll
    for (int o = 1; o < 64; o <<= 1) v += __shfl_xor(v, o);
    return v;
}
__device__ __forceinline__ float fsigmoid(float x) { return __builtin_amdgcn_rcpf(1.0f + __expf(-x)); }

namespace pg8 {
constexpr int BM = 256, BK = 64, HALF = 128, HTB = HALF * BK * 2, STAGE_BYTES = 8 * HTB, NXCD = 8, WGM = 8;
__device__ __forceinline__ int lds_byte(int r, int c) { const int st = (r >> 4) * 2 + (c >> 5), rr = r & 15, cc = c & 31, ob = rr * 64 + cc * 2; return st * 1024 + (ob ^ (((ob >> 9) & 1) << 5)); }
__device__ __forceinline__ void stage_rc(int b, int& R, int& C) { const int st = b / 1024, sb = b % 1024, swz = sb ^ (((sb >> 9) & 1) << 5); R = (st >> 1) * 16 + swz / 64; C = (st & 1) * 32 + (swz % 64) / 2; }

struct Unit { int pm, pn, koff, po, kboff; };
struct Gemm { const bf16_t* A; const bf16_t* Bt; int lda, ldb, K; };

struct Sched {
    int nM, nN, nwg, G, c, mode, half;
    __device__ void init(int nM_, int nN_, int G_, int c_, int mode_ = 0, int half_ = 0) { nM = nM_; nN = nN_; nwg = nM * nN; G = G_; c = c_; mode = mode_; half = half_; }
    __device__ bool next(int i, Unit& u) const {
        const long L = (long)i * G + c; if (L >= nwg) return false;
        int wgid = (int)L; { const int q = nwg / NXCD, r = nwg % NXCD, xcd = wgid % NXCD, off = wgid / NXCD; wgid = (xcd < r ? xcd * (q + 1) : r * (q + 1) + (xcd - r) * q) + off; }
        const int nig = WGM * nN, gid = wgid / nig, fm = gid * WGM, gsz = (nM - fm) < WGM ? (nM - fm) : WGM;
        const int pmi = fm + ((wgid % nig) % gsz), pn = (wgid % nig) / gsz;
        u.pm = pmi; u.pn = pn; u.koff = 0; u.po = pmi; u.kboff = 0;
        if (mode == 2) { u.pm = 64 + pmi; u.pn = pn & 3; u.koff = (pn >> 2) * half; u.kboff = u.koff; }
        if (mode == 1) { u.pm = pmi < 32 ? 32 * half + pmi : 64 + 4 * half + (pmi - 32); u.koff = ((pn >> 1) % 5) * 256; }
        return true;
    }
};

template <class Epi, bool ALIGN_EPI, bool SP2>
__device__ __forceinline__ void gemm_phase(LAS unsigned char* lds, const Gemm g, const Sched& S, const Epi& E) {
    int tid = threadIdx.x; asm volatile("" : "+v"(tid));
    const int wid = __builtin_amdgcn_readfirstlane(tid >> 6), lane = tid & 63, wr = wid >> 2, wc = wid & 3, fr = lane & 15, fq = lane >> 4;
    const int K = g.K, nt = K / BK;
    unsigned voffA[2], voffB[2];
#pragma unroll
    for (int i = 0; i < 2; ++i) { int R, C; stage_rc(tid * 16 + i * 8192, R, C);
        voffA[i] = (unsigned)(R * g.lda + C) * 2u; voffB[i] = (unsigned)(R * g.ldb + C) * 2u; }
    const size_t kstep = (size_t)(BK * 2);
    const size_t hstepA = (size_t)HALF * g.lda * 2, hstepB = (size_t)HALF * g.ldb * 2;
    const unsigned ldsw = (unsigned)wid * 1024u;
    const int aoff = lds_byte(wr * 64 + fr, fq * 8), boff = lds_byte(wc * 32 + fr, fq * 8);
#define PG8_SA(b, h) (((b) * 2 + (h)) * HTB)
#define PG8_SB(b, h) ((4 + (b) * 2 + (h)) * HTB)
#define PG8_STAGE(bufoff, gbase, voff) do { _Pragma("unroll") for (int _i = 0; _i < 2; ++_i) \
        __builtin_amdgcn_global_load_lds((const unsigned*)((const char*)(gbase) + (voff)[_i]), (LAS unsigned*)(lds + (bufoff) + ldsw + _i * 8192), 16, 0, 0); } while (0)
#define PG8_LDA(dst, b, h) do { _Pragma("unroll") for (int m = 0; m < 4; ++m) _Pragma("unroll") for (int k = 0; k < 2; ++k) dst[m][k] = *(const LAS bf16x8*)(lds + PG8_SA(b, h) + aoff + m * 2048 + k * 1024); } while (0)
#define PG8_LDB(dst, b, h) do { _Pragma("unroll") for (int n = 0; n < 2; ++n) _Pragma("unroll") for (int k = 0; k < 2; ++k) dst[n][k] = *(const LAS bf16x8*)(lds + PG8_SB(b, h) + boff + n * 2048 + k * 1024); } while (0)
#define PG8_MMA(ai, bj, At, Bt) do { __builtin_amdgcn_s_setprio(1); _Pragma("unroll") for (int m = 0; m < 4; ++m) _Pragma("unroll") for (int n = 0; n < 2; ++n) _Pragma("unroll") for (int k = 0; k < 2; ++k) \
        acc[ai][bj][m][n] = __builtin_amdgcn_mfma_f32_16x16x32_bf16(Bt[n][k], At[m][k], acc[ai][bj][m][n], 0, 0, 0); __builtin_amdgcn_s_setprio(0); } while (0)
#define PG8_WAIT_V(n) asm volatile("s_waitcnt vmcnt(" #n ")" ::: "memory")
#define PG8_WAIT_L(n) asm volatile("s_waitcnt lgkmcnt(" #n ")" ::: "memory")
#define PG8_BAR __builtin_amdgcn_s_barrier()
#define PG8_SCHED __builtin_amdgcn_sched_barrier(0)
    Unit cur, nxt; int ui = 0;
    if (!S.next(0, cur)) return;
    f32x4 acc[2][2][4][2];
#pragma unroll
    for (int a = 0; a < 2; ++a)
#pragma unroll
        for (int b = 0; b < 2; ++b)
#pragma unroll
            for (int m = 0; m < 4; ++m)
#pragma unroll
                for (int n = 0; n < 2; ++n) acc[a][b][m][n] = (f32x4){0.f, 0.f, 0.f, 0.f};
    bf16x8 At[4][2], B0[2][2], B1[2][2];
    const char* cA = (const char*)g.A + ((size_t)cur.pm * BM * g.lda + cur.koff) * 2; const char* cB = (const char*)g.Bt + ((size_t)cur.pn * BM * g.ldb + cur.kboff) * 2;
    if constexpr (SP2) {
        PG8_STAGE(PG8_SB(0, 0), cB, voffB); PG8_STAGE(PG8_SB(0, 1), cB + hstepB, voffB); PG8_STAGE(PG8_SA(0, 0), cA, voffA); PG8_STAGE(PG8_SA(0, 1), cA + hstepA, voffA);
        if (wr == 1) PG8_BAR;
        PG8_WAIT_V(2); PG8_BAR;
        PG8_STAGE(PG8_SB(1, 0), cB + kstep, voffB); PG8_STAGE(PG8_SA(1, 0), cA + kstep, voffA); PG8_STAGE(PG8_SB(1, 1), cB + hstepB + kstep, voffB);
        PG8_WAIT_V(6); PG8_BAR;
    } else {
        PG8_STAGE(PG8_SB(0, 0), cB, voffB); PG8_STAGE(PG8_SA(0, 0), cA, voffA); PG8_STAGE(PG8_SB(0, 1), cB + hstepB, voffB); PG8_STAGE(PG8_SA(0, 1), cA + hstepA, voffA);
        if (wr == 1) PG8_BAR;
        PG8_WAIT_V(4); PG8_BAR;
        PG8_STAGE(PG8_SB(1, 0), cB + kstep, voffB); PG8_STAGE(PG8_SA(1, 0), cA + kstep, voffA); PG8_STAGE(PG8_SB(1, 1), cB + hstepB + kstep, voffB);
        PG8_WAIT_V(6); PG8_BAR;
    }
    for (;;) {
        const bool has_next = S.next(ui + 1, nxt);
        const char* nA = has_next ? (const char*)g.A + ((size_t)nxt.pm * BM * g.lda + nxt.koff) * 2 : cA;
        const char* nB = has_next ? (const char*)g.Bt + ((size_t)nxt.pn * BM * g.ldb + nxt.kboff) * 2 : cB;
#pragma unroll 1
        for (int t = 0; t < nt; t += 2) {
            const bool last = (t == nt - 2);
            const char* a1 = cA + (size_t)(t + 1) * kstep;
            const char* a2 = last ? nA : cA + (size_t)(t + 2) * kstep; const char* b2 = last ? nB : cB + (size_t)(t + 2) * kstep;
            const char* a3 = a2 + kstep; const char* b3 = b2 + kstep;
            if constexpr (SP2) {
            PG8_LDB(B0, 0, 0); PG8_LDB(B1, 0, 1); PG8_SCHED; PG8_LDA(At, 0, 0); PG8_STAGE(PG8_SA(1, 1), a1 + hstepA, voffA);
            PG8_WAIT_V(8); PG8_WAIT_L(0); PG8_BAR; PG8_MMA(0, 0, At, B0); PG8_MMA(0, 1, At, B1); PG8_BAR; PG8_SCHED;
            PG8_LDA(At, 0, 1); PG8_STAGE(PG8_SB(0, 0), b2, voffB); PG8_STAGE(PG8_SB(0, 1), b2 + hstepB, voffB); PG8_STAGE(PG8_SA(0, 0), a2, voffA);
            PG8_WAIT_V(8); PG8_WAIT_L(0); PG8_BAR; PG8_MMA(1, 0, At, B0); PG8_MMA(1, 1, At, B1); PG8_BAR; PG8_SCHED;
            PG8_LDB(B0, 1, 0); PG8_LDB(B1, 1, 1); PG8_SCHED; PG8_LDA(At, 1, 0); PG8_STAGE(PG8_SA(0, 1), a2 + hstepA, voffA);
            PG8_WAIT_V(8); PG8_WAIT_L(0); PG8_BAR; PG8_MMA(0, 0, At, B0); PG8_MMA(0, 1, At, B1); PG8_BAR; PG8_SCHED;
            PG8_LDA(At, 1, 1); PG8_STAGE(PG8_SB(1, 0), b3, voffB); PG8_STAGE(PG8_SB(1, 1), b3 + hstepB, voffB); PG8_STAGE(PG8_SA(1, 0), a3, voffA);
            PG8_WAIT_V(8); PG8_WAIT_L(0); PG8_BAR; PG8_MMA(1, 0, At, B0); PG8_MMA(1, 1, At, B1); PG8_BAR; PG8_SCHED;
            } else {
            PG8_LDB(B0, 0, 0); PG8_SCHED; PG8_LDA(At, 0, 0); PG8_STAGE(PG8_SA(1, 1), a1 + hstepA, voffA);
            PG8_WAIT_L(8); PG8_BAR; PG8_WAIT_L(0); PG8_MMA(0, 0, At, B0); PG8_BAR; PG8_SCHED;
            PG8_LDB(B1, 0, 1); PG8_STAGE(PG8_SB(0, 0), b2, voffB);
            PG8_BAR; PG8_WAIT_L(0); PG8_MMA(0, 1, At, B1); PG8_BAR;
            PG8_LDA(At, 0, 1); PG8_STAGE(PG8_SA(0, 0), a2, voffA);
            PG8_BAR; PG8_WAIT_L(0); PG8_MMA(1, 0, At, B0); PG8_BAR; PG8_SCHED;
            PG8_STAGE(PG8_SB(0, 1), b2 + hstepB, voffB);
            PG8_WAIT_V(6); PG8_BAR; PG8_MMA(1, 1, At, B1); PG8_BAR;
            PG8_LDB(B0, 1, 0); PG8_SCHED; PG8_LDA(At, 1, 0); PG8_STAGE(PG8_SA(0, 1), a2 + hstepA, voffA);
            PG8_WAIT_L(8); PG8_BAR; PG8_WAIT_L(0); PG8_MMA(0, 0, At, B0); PG8_BAR; PG8_SCHED;
            PG8_LDB(B1, 1, 1); PG8_STAGE(PG8_SB(1, 0), b3, voffB);
            PG8_BAR; PG8_WAIT_L(0); PG8_MMA(0, 1, At, B1); PG8_BAR;
            PG8_LDA(At, 1, 1); PG8_STAGE(PG8_SA(1, 0), a3, voffA);
            PG8_BAR; PG8_WAIT_L(0); PG8_MMA(1, 0, At, B0); PG8_BAR; PG8_SCHED;
            PG8_STAGE(PG8_SB(1, 1), b3 + hstepB, voffB);
            PG8_WAIT_V(6); PG8_BAR; PG8_MMA(1, 1, At, B1); PG8_BAR;
            }
        }
        if constexpr (ALIGN_EPI) { if (wr == 0) PG8_BAR; }
        E(acc, cur, wr, wc, fr, fq);
        if (!has_next) break;
#pragma unroll
        for (int a = 0; a < 2; ++a)
#pragma unroll
            for (int b = 0; b < 2; ++b)
#pragma unroll
                for (int m = 0; m < 4; ++m)
#pragma unroll
                    for (int n = 0; n < 2; ++n) acc[a][b][m][n] = (f32x4){0.f, 0.f, 0.f, 0.f};
        cur = nxt; cA = nA; cB = nB; ++ui;
        if constexpr (ALIGN_EPI) { if (wr == 1) PG8_BAR; }
    }
    PG8_WAIT_V(0);
    if constexpr (!ALIGN_EPI) { if (wr == 0) PG8_BAR; }
    PG8_BAR;
#undef PG8_SA
#undef PG8_SB
#undef PG8_STAGE
#undef PG8_LDA
#undef PG8_LDB
#undef PG8_MMA
#undef PG8_WAIT_V
#undef PG8_WAIT_L
#undef PG8_BAR
#undef PG8_SCHED
}

template <int ACT> struct EpiPlain {
    bf16_t* O; int ldc;
    __device__ __forceinline__ void operator()(const f32x4 (&acc)[2][2][4][2], const Unit& u, int wr, int wc, int fr_, int fq_) const {
        int fr = fr_, fq = fq_; asm volatile("" : "+v"(fr), "+v"(fq));
        const int col0 = u.pn * BM + wc * 32 + fq * 4;
#pragma unroll
        for (int ai = 0; ai < 2; ++ai)
#pragma unroll
            for (int m = 0; m < 4; ++m) { bf16_t* rowp = O + (size_t)(u.pm * BM + ai * HALF + wr * 64 + m * 16 + fr) * ldc + col0;
#pragma unroll
                for (int bj = 0; bj < 2; ++bj)
#pragma unroll
                    for (int n = 0; n < 2; ++n) { f32x4 v = acc[ai][bj][m][n];
                        if (ACT == 1) { v = __builtin_elementwise_max(v, (f32x4){0.f, 0.f, 0.f, 0.f}); v = v * v; }
                        *(u32x2*)(rowp + bj * HALF + n * 16) = f32_to_bf4(v); } }
    }
};

struct EpiSlabCtx {
    bf16_t* S; int ksz;
    __device__ __forceinline__ void operator()(const f32x4 (&acc)[2][2][4][2], const Unit& u, int wr, int wc, int fr_, int fq_) const {
        int fr = fr_, fq = fq_; asm volatile("" : "+v"(fr), "+v"(fq));
        const int col0 = u.pn * BM + wc * 32 + fq * 4;
        bf16_t* base = S + (size_t)(u.koff / ksz) * MC * DM;
#pragma unroll
        for (int ai = 0; ai < 2; ++ai)
#pragma unroll
            for (int m = 0; m < 4; ++m) { bf16_t* rowp = base + (size_t)(u.pm * BM - ML + ai * HALF + wr * 64 + m * 16 + fr) * DM + col0;
#pragma unroll
                for (int bj = 0; bj < 2; ++bj)
#pragma unroll
                    for (int n = 0; n < 2; ++n) *(u32x2*)(rowp + bj * HALF + n * 16) = f32_to_bf4(acc[ai][bj][m][n]); }
    }
};

struct EpiQKV {
    bf16_t* Q; bf16_t* Kb; bf16_t* VT; bf16_t* VTC; const float* rope;
    __device__ __forceinline__ void operator()(const f32x4 (&acc)[2][2][4][2], const Unit& u, int wr, int wc, int fr_, int fq_) const {
        int fr = fr_, fq = fq_; asm volatile("" : "+v"(fr), "+v"(fq));
        const bool lat = u.pm < 64;
        if (u.pn < 5) {
#pragma unroll
            for (int ai = 0; ai < 2; ++ai)
#pragma unroll
                for (int m = 0; m < 4; ++m) {
                    const int row = u.pm * BM + ai * HALF + wr * 64 + m * 16 + fr;
                    f32x4 cs0 = {1.f, 0.f, 1.f, 0.f}, cs1 = {1.f, 0.f, 1.f, 0.f};
                    if (lat) { const int t = row & 2047; const int pos = (wc & 1) ? (t & 63) : (t >> 6); const f32x4* pp = (const f32x4*)(rope + (pos * 16 + 4 * fq) * 2); cs0 = pp[0]; cs1 = pp[1]; }
                    const f32x4 cv = {cs0[0], cs0[2], cs1[0], cs1[2]}, sv = {cs0[1], cs0[3], cs1[1], cs1[3]};
#pragma unroll
                    for (int bj = 0; bj < 2; ++bj) {
                        const f32x4 a = acc[ai][bj][m][0], b = acc[ai][bj][m][1];
                        f32x4 na = a * cv - b * sv, nb = b * cv + a * sv;
                        if (u.pn < 4) { na = na * 0.125f; nb = nb * 0.125f;
                            bf16_t* d = Q + (size_t)row * 1024 + u.pn * 256 + bj * HALF + wc * 32 + fq * 4;
                            *(u32x2*)d = f32_to_bf4(na); *(u32x2*)(d + 16) = f32_to_bf4(nb);
                        } else {
                            bf16_t* d = Kb + (size_t)row * 256 + bj * HALF + wc * 32 + fq * 4;
                            *(u32x2*)d = f32_to_bf4(na); *(u32x2*)(d + 16) = f32_to_bf4(nb);
                        }
                    }
                }
        } else {
#pragma unroll
            for (int ai = 0; ai < 2; ++ai)
#pragma unroll
                for (int m = 0; m < 4; ++m) {
                    const int row = u.pm * BM + ai * HALF + wr * 64 + m * 16 + fr;
                    bf16_t* base; size_t stride;
                    if (lat) { const int b = row >> 11, t = row & 2047; base = VT + (size_t)b * 256 * 2048 + t; stride = 2048; }
                    else { const int rc = row - ML; const int b = rc >> 8, t = rc & 255; base = VTC + (size_t)b * 256 * 256 + t; stride = 256; }
#pragma unroll
                    for (int bj = 0; bj < 2; ++bj)
#pragma unroll
                        for (int n = 0; n < 2; ++n)
#pragma unroll
                            for (int j = 0; j < 4; ++j) { const int vc = bj * HALF + wc * 32 + n * 16 + fq * 4 + j; base[(size_t)vc * stride] = (bf16_t)f2bf(acc[ai][bj][m][n][j]); }
                }
        }
    }
};

struct EpiGates {
    const bf16_t* U; bf16_t* LA; bf16_t* BX; const float* ba; const float* bi; const float* nls;
    __device__ __forceinline__ void operator()(const f32x4 (&acc)[2][2][4][2], const Unit& u, int wr, int wc, int fr_, int fq_) const {
        int fr = fr_, fq = fq_; asm volatile("" : "+v"(fr), "+v"(fq));
        const int tile = u.pn >> 1, dir = tile / 5, blk = tile % 5, chalf = u.pn & 1;
        const int ch0 = blk * 256 + chalf * 128 + wc * 32 + fq * 4;
#pragma unroll
        for (int n = 0; n < 2; ++n) {
            const int ch = ch0 + n * 16;
            const f32x4 bav = *(const f32x4*)(ba + dir * DRNN + ch), biv = *(const f32x4*)(bi + dir * DRNN + ch), nl = *(const f32x4*)(nls + dir * DRNN + ch);
#pragma unroll
            for (int ai = 0; ai < 2; ++ai)
#pragma unroll
                for (int m = 0; m < 4; ++m) {
                    const int rin = ai * HALF + wr * 64 + m * 16 + fr;
                    const size_t rowg = (size_t)u.pm * BM + rin, rowl = (size_t)u.po * BM + rin;
                    const f32x4 uv = bf4_to_f32(*(const u32x2*)(U + rowg * DRNN + ch));
                    f32x4 lav, bxv;
#pragma unroll
                    for (int j = 0; j < 4; ++j) {
                        const float r = fsigmoid(acc[ai][0][m][n][j] + bav[j]);
                        const float ig = fsigmoid(acc[ai][1][m][n][j] + biv[j]);
                        const float la = nl[j] * r, x = 2.0f * la;
                        float om;
                        if (x > -0.5f) { float q = 1.0f / 720.0f; q = q * x + 1.0f / 120.0f; q = q * x + 1.0f / 24.0f; q = q * x + 1.0f / 6.0f; q = q * x + 0.5f; q = q * x + 1.0f; om = -x * q; }
                        else om = 1.0f - __expf(x);
                        lav[j] = la; bxv[j] = __builtin_amdgcn_sqrtf(om) * (ig * uv[j]);
                    }
                    const size_t o = ((size_t)dir * 9216 + rowl) * DRNN + ch;
                    *(u32x2*)(LA + o) = f32_to_bf4(lav); *(u32x2*)(BX + o) = f32_to_bf4(bxv);
                    asm volatile("" ::: "memory");
                }
        }
    }
};

struct EpiGateMul {
    bf16_t* Z;
    __device__ __forceinline__ void operator()(const f32x4 (&acc)[2][2][4][2], const Unit& u, int wr, int wc, int fr_, int fq_) const {
        int fr = fr_, fq = fq_; asm volatile("" : "+v"(fr), "+v"(fq));
        const int col0 = u.pn * BM + wc * 32 + fq * 4;
#pragma unroll
        for (int ai = 0; ai < 2; ++ai)
#pragma unroll
            for (int m = 0; m < 4; ++m) { bf16_t* rowp = Z + (size_t)(u.pm * BM + ai * HALF + wr * 64 + m * 16 + fr) * DRNN + col0;
#pragma unroll
                for (int bj = 0; bj < 2; ++bj)
#pragma unroll
                    for (int n = 0; n < 2; ++n) { const f32x4 v = acc[ai][bj][m][n]; const f32x4 rc = bf4_to_f32(*(const u32x2*)(rowp + bj * HALF + n * 16)); f32x4 o;
#pragma unroll
                        for (int j = 0; j < 4; ++j) { const float x = v[j]; const float z2 = 1.5957691216057308f * (x + 0.044715f * x * x * x); o[j] = x * fsigmoid(z2) * rc[j]; }
                        *(u32x2*)(rowp + bj * HALF + n * 16) = f32_to_bf4(o); }
                asm volatile("" ::: "memory"); }
    }
};
}


#define XB_TMO      128
#define XB_XCNT(j)  (256  + 64 * (j))
#define XB_XSUB(j)  (1280 + 64 * (j))
#define XB_XGEN(j)  (2304 + 64 * (j))
#define XB_TOP      3328
#define XB_TOPGEN   3392
#define XCD_BAR_WORDS 3456
#define XB_SPIN_CAP (1u << 18)
__device__ __forceinline__ unsigned xb_ld(unsigned* p)              { return __hip_atomic_load(p, __ATOMIC_RELAXED, __HIP_MEMORY_SCOPE_AGENT); }
__device__ __forceinline__ unsigned xb_add(unsigned* p, unsigned v) { return __hip_atomic_fetch_add(p, v, __ATOMIC_RELAXED, __HIP_MEMORY_SCOPE_AGENT); }
__device__ __forceinline__ unsigned xb_xcc_id() { return (unsigned)__builtin_amdgcn_s_getreg((3 << 11) | 20) & 0xFu; }
#define XB_SPIN(cond, bar) do { unsigned _sp = 0; while (cond) { __builtin_amdgcn_s_sleep(1); \
    if ((++_sp & 255u) == 0u) { if (xb_ld(&(bar)[XB_TMO])) break; if (_sp > XB_SPIN_CAP) { atomicAdd(&(bar)[XB_TMO], 1u); break; } } } } while (0)
struct XcdBarrier { unsigned* bar; unsigned x; volatile LAS unsigned* st; };
__device__ __forceinline__ XcdBarrier xcd_barrier_post(unsigned* bar, volatile LAS unsigned* st) {
    XcdBarrier b; b.bar = bar; b.x = xb_xcc_id(); b.st = st;
    if (threadIdx.x == 0) (void)xb_add(&bar[XB_XCNT(b.x)], 1u);
    return b;
}
__device__ __forceinline__ void xcd_barrier_complete(unsigned* bar, unsigned x, unsigned& nloc, unsigned& nx) {
    const unsigned G = gridDim.x * gridDim.y * gridDim.z;
    unsigned sum, cnt, mine, sp = 0u;
    for (;;) {
        sum = 0u; cnt = 0u; mine = 0u;
#pragma unroll
        for (unsigned j = 0; j < 16; ++j) { const unsigned c = xb_ld(&bar[XB_XCNT(j)]); sum += c; cnt += (c > 0u) ? 1u : 0u; mine = (j == x) ? c : mine; }
        if (sum == G) break;
        __builtin_amdgcn_s_sleep(1);
        if ((++sp & 255u) == 0u) { if (xb_ld(&bar[XB_TMO])) break; if (sp > XB_SPIN_CAP) { atomicAdd(&bar[XB_TMO], 1u); break; } }
    }
    nloc = mine > 0u ? mine : 1u; nx = cnt > 0u ? cnt : 1u;
}
__device__ __forceinline__ void xcd_barrier(const XcdBarrier& b) {
    asm volatile("s_waitcnt vmcnt(0)" ::: "memory");
    __syncthreads();
    if (threadIdx.x == 0) {
        unsigned* bar = b.bar;
        __builtin_amdgcn_s_waitcnt(0);
        unsigned nloc = b.st[0], nx = b.st[1];
        if (nloc == 0u) { xcd_barrier_complete(bar, b.x, nloc, nx); b.st[0] = nloc; b.st[1] = nx; }
        const unsigned old = xb_add(&bar[XB_XSUB(b.x)], 1u);
        const unsigned gen = old / nloc;
        if (old + 1u == (gen + 1u) * nloc) {
            __builtin_amdgcn_fence(__ATOMIC_RELEASE, "agent");
            asm volatile("s_waitcnt vmcnt(0)" ::: "memory");
            const unsigned og = xb_add(&bar[XB_TOP], 1u);
            const unsigned tg = og / nx;
            if (og + 1u == (tg + 1u) * nx) xb_add(&bar[XB_TOPGEN], 1u);
            else XB_SPIN(xb_ld(&bar[XB_TOPGEN]) == tg, bar);
            __builtin_amdgcn_fence(__ATOMIC_ACQUIRE, "agent");
            xb_add(&bar[XB_XGEN(b.x)], 1u);
            asm volatile("s_waitcnt vmcnt(0)" ::: "memory");
        } else {
            XB_SPIN(xb_ld(&bar[XB_XGEN(b.x)]) == gen, bar);
            __builtin_amdgcn_fence(__ATOMIC_ACQUIRE, "agent");
            asm volatile("s_waitcnt vmcnt(0)" ::: "memory");
        }
    }
    __syncthreads();
}

struct Params {
    const float *x, *c, *ctx, *c_ctx, *ada_w, *ada_b, *norm_g, *mlp_w1, *mlp_w2, *w_qkv, *w_o, *sink;
    const float *w_in, *conv_w, *conv_b, *w_a, *b_a, *w_i, *b_i, *lam, *w_out;
    float* out; unsigned char* ws;
};

typedef const __attribute__((address_space(4))) Params* ParamsK;
__device__ __forceinline__ void transpose_item(const float* W, int ldw, bf16_t* WT, int ldwt, int k0, int n0, int dst_row0, LAS float* scr, int lane) {
#pragma unroll 8
    for (int i = 0; i < 32; ++i) { const int kk = 2 * i + (lane >> 5); scr[kk * 33 + (lane & 31)] = W[(size_t)(k0 + kk) * ldw + n0 + (lane & 31)]; }
    asm volatile("s_waitcnt lgkmcnt(0)" ::: "memory");
    const int c = lane & 7;
#pragma unroll
    for (int j = 0; j < 4; ++j) { const int n = (lane >> 3) + 8 * j; const LAS float* s = scr + (8 * c) * 33 + n;
        u32x4 o; o.x = cvt_pk_bf16(s[0 * 33], s[1 * 33]); o.y = cvt_pk_bf16(s[2 * 33], s[3 * 33]); o.z = cvt_pk_bf16(s[4 * 33], s[5 * 33]); o.w = cvt_pk_bf16(s[6 * 33], s[7 * 33]);
        *(u32x4*)(WT + (size_t)(dst_row0 + n) * ldwt + k0 + 8 * c) = o; }
    asm volatile("s_waitcnt lgkmcnt(0)" ::: "memory");
}
__device__ __forceinline__ void transpose_plain(const float* W, int K, int N, bf16_t* WT, int r, LAS float* scr, int lane) {
    const int nblk = N / 32, kb = r / nblk, nb = r % nblk;
    transpose_item(W, N, WT, K, 64 * kb, 32 * nb, 32 * nb, scr, lane);
}

__device__ __forceinline__ void prologue(ParamsK p, LAS unsigned char* lds, int tid, int lane, int wave) {
    unsigned char* ws = p->ws;
    float* MOD = (float*)(ws + WS_MOD);
    if (blockIdx.x < 96) {
        LAS float* sl = (LAS float*)lds;
        LAS float* red = (LAS float*)(lds + 36864);
        for (int idx = tid; idx < 9216; idx += 512) { const int w = idx >> 10, k = idx & 1023; const float v = (w < 8) ? p->c[w * 1024 + k] : p->c_ctx[k]; sl[idx] = v / (1.0f + __expf(-v)); }
        __syncthreads();
        const int l = blockIdx.x / 48, n0 = (blockIdx.x % 48) * 128, kg = tid >> 5, cq = tid & 31;
        f32x4 acc[9];
#pragma unroll
        for (int w = 0; w < 9; ++w) acc[w] = (f32x4){0.f, 0.f, 0.f, 0.f};
        const float* wb = p->ada_w + (size_t)l * 1024 * 6144 + n0 + cq * 4;
#pragma unroll 4
        for (int it = 0; it < 64; ++it) { const int k = it * 16 + kg; const f32x4 w4 = *(const f32x4*)(wb + (size_t)k * 6144);
#pragma unroll
            for (int w = 0; w < 9; ++w) acc[w] += sl[w * 1024 + k] * w4; }
#pragma unroll
        for (int w = 0; w < 9; ++w) *(LAS f32x4*)(red + (kg * 9 + w) * 128 + cq * 4) = acc[w];
        __syncthreads();
        for (int idx = tid; idx < 9 * 128; idx += 512) { const int w = idx >> 7, n = idx & 127; float s = 0.f;
#pragma unroll
            for (int g = 0; g < 16; ++g) s += red[(g * 9 + w) * 128 + n];
            MOD[(size_t)(l * 9 + w) * 6144 + n0 + n] = s + p->ada_b[l * 6144 + n0 + n]; }
        __syncthreads();
    }
    if (blockIdx.x == gridDim.x - 1) {
        float* rope = (float*)(ws + WS_ROPE); float* nls = (float*)(ws + WS_NLS);
        for (int idx = tid; idx < 1024; idx += 512) { const int pos = idx >> 4, i = idx & 15;
            const float inv = __builtin_exp2f(-(float)i * (13.287712379549449f / 16.0f));
            const float angf = (float)pos * inv; const double ang = (double)angf;
            const double twopi = 6.283185307179586476925287; const double r = ang - twopi * __builtin_rint(ang / twopi);
            const double r2 = r * r; double cterm = 1.0, sterm = r, cs = 1.0, sn = r;
            for (int k = 1; k <= 14; ++k) { cterm *= -r2 / (double)((2 * k - 1) * (2 * k)); sterm *= -r2 / (double)((2 * k) * (2 * k + 1)); cs += cterm; sn += sterm; }
            rope[idx * 2] = (float)cs; rope[idx * 2 + 1] = (float)sn; }
        for (int idx = tid; idx < 2 * DRNN; idx += 512) { const float lm = p->lam[idx]; nls[idx] = -8.0f * log1pf(__expf(-lm)); }
    }
    LAS float* scr = (LAS float*)(lds + wave * 16384);
    const int gw = blockIdx.x * 8 + wave, NGW = gridDim.x * 8;
    constexpr int I_QKV = 16 * 48, I_O = 16 * 32, I_1 = 16 * 128, I_2 = 64 * 32, I_IN = 16 * 80, I_OUT = 20 * 32, I_G = 40 * 16;
    constexpr int NITEMS = I_QKV + I_O + 2 * I_1 + 2 * I_2 + I_IN + I_OUT + I_G;
    for (int it = gw; it < NITEMS; it += NGW) {
        int r = it;
        if (r < I_QKV) { transpose_plain(p->w_qkv, 1024, NQKV, (bf16_t*)(ws + WS_WQKV), r, scr, lane); continue; } r -= I_QKV;
        if (r < I_O) { transpose_plain(p->w_o, 1024, 1024, (bf16_t*)(ws + WS_WO), r, scr, lane); continue; } r -= I_O;
        if (r < 2 * I_1) { const int l = r / I_1; transpose_plain(p->mlp_w1 + (size_t)l * 1024 * DFF, 1024, DFF, (bf16_t*)(ws + WS_W1 + (size_t)l * 16 * MiB), r % I_1, scr, lane); continue; } r -= 2 * I_1;
        if (r < 2 * I_2) { const int l = r / I_2; transpose_plain(p->mlp_w2 + (size_t)l * 1024 * DFF, DFF, 1024, (bf16_t*)(ws + WS_W2 + (size_t)l * 16 * MiB), r % I_2, scr, lane); continue; } r -= 2 * I_2;
        if (r < I_IN) { transpose_plain(p->w_in, 1024, 2 * DRNN, (bf16_t*)(ws + WS_WIN), r, scr, lane); continue; } r -= I_IN;
        if (r < I_OUT) { transpose_plain(p->w_out, DRNN, 1024, (bf16_t*)(ws + WS_WOUT), r, scr, lane); continue; } r -= I_OUT;
        {
            const int sm = r >> 4, ii = r & 15, kb = ii >> 2, nb = ii & 3;
            const int chalf = sm & 1, blk = (sm >> 1) % 5, dg = (sm >> 1) / 5, gate = dg & 1, dir = dg >> 1;
            const float* W = (gate ? p->w_i : p->w_a) + (size_t)(dir * 5 + blk) * 256 * 256;
            const int dst_row0 = ((dir * 5 + blk) * 2 + chalf) * 256 + gate * 128 + nb * 32;
            transpose_item(W, 256, (bf16_t*)(ws + WS_WG), 256, 64 * kb, chalf * 128 + nb * 32, dst_row0, scr, lane);
        }
    }
}

template <bool HAS_Y, bool HAS_H>
__device__ __forceinline__ void row_phase(const float* xin_lat, const float* xin_ctx, float* xout_lat, float* xout_ctx, const bf16_t* Y, const bf16_t* SLAB, bf16_t* H,
                                          const float* gy, const float* gh, const float* mod_g, int gate_idx, const float* mod_h, int shift_idx, int scale_idx,
                                          int nrows, int gw, int ngw, int lane) {
    for (int row = gw; row < nrows; row += ngw) {
        const bool lat = row < ML; const int who = lat ? (row >> 11) : 8;
        const float* xi = lat ? xin_lat + (size_t)row * DM : xin_ctx + (size_t)(row - ML) * DM;
        f32x4 xv[4];
#pragma unroll
        for (int j = 0; j < 4; ++j) xv[j] = *(const f32x4*)(xi + lane * 4 + 256 * j);
        if (HAS_Y) {
            f32x4 yv[4]; float s = 0.f;
#pragma unroll
            for (int j = 0; j < 4; ++j) {
                if (SLAB != nullptr && !lat) { const bf16_t* yp = SLAB + (size_t)(row - ML) * DM + lane * 4 + 256 * j;
                    yv[j] = (bf4_to_f32(*(const u32x2*)yp) + bf4_to_f32(*(const u32x2*)(yp + (size_t)MC * DM))) + (bf4_to_f32(*(const u32x2*)(yp + (size_t)2 * MC * DM)) + bf4_to_f32(*(const u32x2*)(yp + (size_t)3 * MC * DM))); }
                else yv[j] = bf4_to_f32(*(const u32x2*)(Y + (size_t)row * DM + lane * 4 + 256 * j));
                s += (yv[j][0] * yv[j][0] + yv[j][1] * yv[j][1]) + (yv[j][2] * yv[j][2] + yv[j][3] * yv[j][3]); }
            const float rstd = 1.0f / sqrtf(wave_sum(s) * (1.0f / DM) + EPS);
            float* xo = lat ? xout_lat + (size_t)row * DM : xout_ctx + (size_t)(row - ML) * DM;
#pragma unroll
            for (int j = 0; j < 4; ++j) { const int col = lane * 4 + 256 * j;
                const f32x4 g = *(const f32x4*)(gy + col), gt = *(const f32x4*)(mod_g + (size_t)who * 6144 + gate_idx * 1024 + col);
                xv[j] = xv[j] + gt * (yv[j] * rstd * g);
                *(f32x4*)(xo + col) = xv[j]; }
        }
        if (HAS_H) {
            float s = 0.f;
#pragma unroll
            for (int j = 0; j < 4; ++j) s += (xv[j][0] * xv[j][0] + xv[j][1] * xv[j][1]) + (xv[j][2] * xv[j][2] + xv[j][3] * xv[j][3]);
            const float rstd = 1.0f / sqrtf(wave_sum(s) * (1.0f / DM) + EPS);
#pragma unroll
            for (int j = 0; j < 4; ++j) { const int col = lane * 4 + 256 * j;
                const f32x4 g = *(const f32x4*)(gh + col), sh = *(const f32x4*)(mod_h + (size_t)who * 6144 + shift_idx * 1024 + col), sc = *(const f32x4*)(mod_h + (size_t)who * 6144 + scale_idx * 1024 + col);
                const f32x4 hv = (xv[j] * rstd * g) * (1.0f + sc) + sh;
                *(u32x2*)(H + (size_t)row * DM + col) = f32_to_bf4(hv); }
        }
    }
}

__device__ __forceinline__ void attn_phase(LAS unsigned char* lds, const bf16_t* Q, bf16_t* O, const bf16_t* Kb, const bf16_t* VT, const bf16_t* VTC, const float* sink, int tid, int lane, int wave) {
    constexpr int PITCH = 72;
    LAS bf16_t* Ks = (LAS bf16_t*)lds;
    LAS bf16_t* Vs = (LAS bf16_t*)(lds + 2 * 64 * PITCH * 2);
    const int lr = lane & 15, lg = lane >> 4;
    const int skey = tid >> 3, spiece = tid & 7;
    for (int unit = blockIdx.x; unit < 576; unit += gridDim.x) {
        int b, kvh, qrow0, qblk, nloc, lt0; bool latu = unit < 512;
        if (latu) { b = unit >> 6; const int rem = unit & 63; qblk = rem >> 2; kvh = rem & 3; qrow0 = b * SEQ + qblk * 128; lt0 = (qblk == 0) ? 2 : 0; nloc = ((qblk == 15) ? 4 : 6) - lt0; }
        else { const int cu = unit - 512; b = cu >> 3; kvh = (cu & 7) >> 1; qblk = 0; qrow0 = ML + b * CTX + (cu & 1) * 128; lt0 = 0; nloc = 0; }
        const int nT = nloc + 4;
        const int head = kvh * 4 + (wave >> 1);
        const int qr0 = qrow0 + (wave & 1) * 64;
        const bf16_t* qbase = Q + (size_t)qr0 * 1024 + head * 64;
        bf16_t* obase = O + (size_t)qr0 * 1024 + head * 64;
        LAS unsigned char* Qs = lds + 40960 + wave * 8192;
#pragma unroll
        for (int qt = 0; qt < 4; ++qt)
#pragma unroll
            for (int dh = 0; dh < 2; ++dh) *(LAS bf16x8*)(Qs + (qt * 2 + dh) * 1024 + lane * 16) = *(const bf16x8*)(qbase + (unsigned)((qt * 16 + lr) * 1024 + dh * 32 + lg * 8));
        f32x4 o[4][4];
#pragma unroll
        for (int qt = 0; qt < 4; ++qt)
#pragma unroll
            for (int dt = 0; dt < 4; ++dt) o[qt][dt] = (f32x4){0.f, 0.f, 0.f, 0.f};
        float m2[4], ls[4];
        { const float sk = sink[head] * LOG2E;
#pragma unroll
          for (int qt = 0; qt < 4; ++qt) { m2[qt] = sk; ls[qt] = (lg == 0) ? 1.0f : 0.0f; } }
        u32x4 kreg, vreg;
#define ATT_LOAD(j) do { const int _j = (j); if (_j < nloc) { const int tok0 = (qblk - 1) * 128 + (lt0 + _j) * 64; \
                const bf16_t* kb_ = Kb + (size_t)(b * SEQ + tok0) * 256 + kvh * 64; const bf16_t* vb_ = VT + (size_t)(b * 4 + kvh) * 64 * SEQ + tok0; \
                kreg = *(const u32x4*)(kb_ + (unsigned)(skey * 256 + spiece * 8)); vreg = *(const u32x4*)(vb_ + (unsigned)(skey * SEQ + spiece * 8)); } \
            else { const int tok0 = (_j - nloc) * 64; \
                const bf16_t* kb_ = Kb + (size_t)(ML + b * CTX + tok0) * 256 + kvh * 64; const bf16_t* vb_ = VTC + (size_t)(b * 4 + kvh) * 64 * CTX + tok0; \
                kreg = *(const u32x4*)(kb_ + (unsigned)(skey * 256 + spiece * 8)); vreg = *(const u32x4*)(vb_ + (unsigned)(skey * CTX + spiece * 8)); } } while (0)
#define ATT_STORE(buf) do { *(LAS u32x4*)(Ks + (buf) * 64 * PITCH + skey * PITCH + spiece * 8) = kreg; *(LAS u32x4*)(Vs + (buf) * 64 * PITCH + skey * PITCH + spiece * 8) = vreg; } while (0)
        __syncthreads();
        ATT_LOAD(0); ATT_STORE(0);
        __syncthreads();
        for (int j = 0; j < nT; ++j) {
            const int buf = j & 1;
            if (j + 1 < nT) ATT_LOAD(j + 1);
            const LAS bf16_t* Kt = Ks + buf * 64 * PITCH; const LAS bf16_t* Vt = Vs + buf * 64 * PITCH;
            int mmode = 0, ktok0 = 0;
            if (j < nloc) { const int lt = lt0 + j; ktok0 = (qblk - 1) * 128 + lt * 64; mmode = (lt < 2) ? 1 : ((lt >= 4) ? 2 : 0); }
            bf16x8 kf[4][2];
#pragma unroll
            for (int ks = 0; ks < 4; ++ks)
#pragma unroll
                for (int dh = 0; dh < 2; ++dh) kf[ks][dh] = *(const LAS bf16x8*)(Kt + (ks * 16 + lr) * PITCH + dh * 32 + lg * 8);
#pragma unroll
            for (int hq = 0; hq < 2; ++hq) {
            bf16x8 pb[2][2];
#pragma unroll
            for (int q2 = 0; q2 < 2; ++q2) {
                const int qt = hq * 2 + q2;
                f32x4 s[4];
                const bf16x8 qf0 = *(const LAS bf16x8*)(Qs + (qt * 2 + 0) * 1024 + lane * 16), qf1 = *(const LAS bf16x8*)(Qs + (qt * 2 + 1) * 1024 + lane * 16);
#pragma unroll
                for (int ks = 0; ks < 4; ++ks) { s[ks] = __builtin_amdgcn_mfma_f32_16x16x32_bf16(kf[ks][0], qf0, (f32x4){0.f, 0.f, 0.f, 0.f}, 0, 0, 0);
                    s[ks] = __builtin_amdgcn_mfma_f32_16x16x32_bf16(kf[ks][1], qf1, s[ks], 0, 0, 0); }
                if (mmode) { const int qp = qblk * 128 + (wave & 1) * 64 + qt * 16 + lr;
#pragma unroll
                    for (int ks = 0; ks < 4; ++ks)
#pragma unroll
                        for (int jj = 0; jj < 4; ++jj) { const int kp = ktok0 + ks * 16 + lg * 4 + jj; const bool ok = (mmode == 1) ? (kp >= qp - 128) : (kp <= qp + 128); s[ks][jj] = ok ? s[ks][jj] : -1e30f; } }
                float mx = -3e38f;
#pragma unroll
                for (int ks = 0; ks < 4; ++ks) mx = fmaxf(mx, fmaxf(fmaxf(s[ks][0], s[ks][1]), fmaxf(s[ks][2], s[ks][3])));
                mx = fmaxf(mx, __shfl_xor(mx, 16)); mx = fmaxf(mx, __shfl_xor(mx, 32));
                const float mnew = fmaxf(m2[qt], mx * LOG2E);
                const float alpha = __builtin_amdgcn_exp2f(m2[qt] - mnew);
                m2[qt] = mnew;
                float rs = 0.f;
#pragma unroll
                for (int ks = 0; ks < 4; ++ks)
#pragma unroll
                    for (int jj = 0; jj < 4; ++jj) { const float pv = __builtin_amdgcn_exp2f(s[ks][jj] * LOG2E - mnew); s[ks][jj] = pv; rs += pv; }
                ls[qt] = ls[qt] * alpha + rs;
#pragma unroll
                for (int dt = 0; dt < 4; ++dt) o[qt][dt] = o[qt][dt] * alpha;
#pragma unroll
                for (int c2 = 0; c2 < 2; ++c2) { u32x4 w; w.x = cvt_pk_bf16(s[2 * c2][0], s[2 * c2][1]); w.y = cvt_pk_bf16(s[2 * c2][2], s[2 * c2][3]); w.z = cvt_pk_bf16(s[2 * c2 + 1][0], s[2 * c2 + 1][1]); w.w = cvt_pk_bf16(s[2 * c2 + 1][2], s[2 * c2 + 1][3]);
                    pb[q2][c2] = __builtin_bit_cast(bf16x8, w); }
            }
#pragma unroll
            for (int c2 = 0; c2 < 2; ++c2)
#pragma unroll
                for (int dt = 0; dt < 4; ++dt) {
                    const LAS bf16_t* vp = Vt + (dt * 16 + lr) * PITCH + c2 * 32 + lg * 4;
                    const u32x2 v0 = *(const LAS u32x2*)vp, v1 = *(const LAS u32x2*)(vp + 16);
                    const u32x4 vv = {v0.x, v0.y, v1.x, v1.y};
                    const bf16x8 vf = __builtin_bit_cast(bf16x8, vv);
#pragma unroll
                    for (int q2 = 0; q2 < 2; ++q2) o[hq * 2 + q2][dt] = __builtin_amdgcn_mfma_f32_16x16x32_bf16(vf, pb[q2][c2], o[hq * 2 + q2][dt], 0, 0, 0);
                }
            }
            if (j + 1 < nT) ATT_STORE(buf ^ 1);
            __syncthreads();
        }
#pragma unroll
        for (int qt = 0; qt < 4; ++qt) {
            float l = ls[qt]; l += __shfl_xor(l, 16); l += __shfl_xor(l, 32);
            const float inv = 1.0f / l;
            int lro = lr * 1024 + lg * 4; asm volatile("" : "+v"(lro));
            bf16_t* op = obase + (unsigned)(qt * 16 * 1024 + lro);
#pragma unroll
            for (int dt = 0; dt < 4; ++dt) *(u32x2*)(op + dt * 16) = f32_to_bf4(o[qt][dt] * inv);
        }
    }
#undef ATT_LOAD
#undef ATT_STORE
}

__device__ __forceinline__ void conv_phase(const bf16_t* R, bf16_t* U, const float* cw, const float* cb, int gtid, int nthreads) {
    for (int idx = gtid; idx < MT * 160; idx += nthreads) {
        const int row = idx / 160, ch = (idx % 160) * 8;
        int t, T; if (row < ML) { t = row & 2047; T = SEQ; } else { t = (row - ML) & 255; T = CTX; }
        float acc[8];
        { const f32x4 b0 = *(const f32x4*)(cb + ch), b1 = *(const f32x4*)(cb + ch + 4); acc[0] = b0[0]; acc[1] = b0[1]; acc[2] = b0[2]; acc[3] = b0[3]; acc[4] = b1[0]; acc[5] = b1[1]; acc[6] = b1[2]; acc[7] = b1[3]; }
#pragma unroll
        for (int tap = 0; tap < 4; ++tap) { const int tt = t + tap - 2;
            if (tt >= 0 && tt < T) { const u32x4 rv = *(const u32x4*)(R + (size_t)(row + tap - 2) * DRNN + ch);
                const f32x4 w0 = *(const f32x4*)(cw + tap * DRNN + ch), w1 = *(const f32x4*)(cw + tap * DRNN + ch + 4);
                acc[0] += w0[0] * bf_lo(rv.x); acc[1] += w0[1] * bf_hi(rv.x); acc[2] += w0[2] * bf_lo(rv.y); acc[3] += w0[3] * bf_hi(rv.y);
                acc[4] += w1[0] * bf_lo(rv.z); acc[5] += w1[1] * bf_hi(rv.z); acc[6] += w1[2] * bf_lo(rv.w); acc[7] += w1[3] * bf_hi(rv.w); } }
        u32x4 o; o.x = cvt_pk_bf16(acc[0], acc[1]); o.y = cvt_pk_bf16(acc[2], acc[3]); o.z = cvt_pk_bf16(acc[4], acc[5]); o.w = cvt_pk_bf16(acc[6], acc[7]);
        *(u32x4*)(U + (size_t)row * DRNN + ch) = o;
    }
}
__device__ __forceinline__ int scan_row0(int bl, int c) { return (c < 8) ? (8192 + bl * CTX + c * 32) : (bl * SEQ + (c - 8) * 32); }
__device__ __forceinline__ void scanA_phase(const bf16_t* LA, const bf16_t* BX, float* SP, float* SH, int gtid, int nthreads) {
    for (int idx = gtid; idx < 2 * 4 * 72 * 640; idx += nthreads) {
        const int cp = idx % 640, r1 = idx / 640, c = r1 % 72, r2 = r1 / 72, bl = r2 & 3, dir = r2 >> 2;
        const int row0 = scan_row0(bl, c);
        const size_t base = ((size_t)dir * 9216 + row0) * DRNN + cp * 2;
        float P0 = 1.f, P1 = 1.f, H0 = 0.f, H1 = 0.f;
#pragma unroll 8
        for (int i = 0; i < 32; ++i) { const int ii = dir ? (31 - i) : i;
            const unsigned lw = *(const unsigned*)(LA + base + (size_t)ii * DRNN), bw = *(const unsigned*)(BX + base + (size_t)ii * DRNN);
            const float a0 = __expf(bf_lo(lw)), a1 = __expf(bf_hi(lw));
            P0 *= a0; P1 *= a1; H0 = a0 * H0 + bf_lo(bw); H1 = a1 * H1 + bf_hi(bw); }
        const size_t so = ((size_t)(dir * 4 + bl) * 72 + c) * DRNN + cp * 2;
        *(f32x2*)(SP + so) = (f32x2){P0, P1}; *(f32x2*)(SH + so) = (f32x2){H0, H1};
    }
}
__device__ __forceinline__ void scanB_phase(const float* SP, const float* SH, float* CIN, int gtid, int nthreads) {
    for (int idx = gtid; idx < 2 * 4 * DRNN; idx += nthreads) {
        const int ch = idx % DRNN, r = idx / DRNN, bl = r & 3, dir = r >> 2;
        const size_t base = ((size_t)(dir * 4 + bl) * 72) * DRNN + ch;
        float carry = 0.f;
#pragma unroll 1
        for (int s0 = 0; s0 < 72; s0 += 24) {
            float pv[24], hv[24];
#pragma unroll
            for (int s = 0; s < 24; ++s) { const int sq = s0 + s; const int c = dir ? (sq < 8 ? 7 - sq : 79 - sq) : sq; pv[s] = SP[base + (size_t)c * DRNN]; hv[s] = SH[base + (size_t)c * DRNN]; }
#pragma unroll
            for (int s = 0; s < 24; ++s) { const int sq = s0 + s; const int c = dir ? (sq < 8 ? 7 - sq : 79 - sq) : sq; CIN[base + (size_t)c * DRNN] = carry; carry = pv[s] * carry + hv[s]; }
        }
    }
}
__device__ __forceinline__ void scanC_phase(const bf16_t* LA, const bf16_t* BX, const float* CIN, bf16_t* REC, int half, int gtid, int nthreads) {
    for (int idx = gtid; idx < 4 * 64 * 640; idx += nthreads) {
        const int cp = idx % 640, r1 = idx / 640, lc = r1 & 63, bl = r1 >> 6;
        const int row0 = bl * SEQ + lc * 32;
        const size_t b0 = ((size_t)row0) * DRNN + cp * 2, b1 = ((size_t)9216 + row0) * DRNN + cp * 2;
        const f32x2 cf = *(const f32x2*)(CIN + ((size_t)(0 * 4 + bl) * 72 + 8 + lc) * DRNN + cp * 2);
        const f32x2 cbk = *(const f32x2*)(CIN + ((size_t)(1 * 4 + bl) * 72 + 8 + lc) * DRNN + cp * 2);
        float hf0[32], hf1[32];
        float h0 = cf[0], h1 = cf[1];
#pragma unroll
        for (int i = 0; i < 32; ++i) { const unsigned lw = *(const unsigned*)(LA + b0 + (size_t)i * DRNN), bw = *(const unsigned*)(BX + b0 + (size_t)i * DRNN);
            h0 = __expf(bf_lo(lw)) * h0 + bf_lo(bw); h1 = __expf(bf_hi(lw)) * h1 + bf_hi(bw); hf0[i] = h0; hf1[i] = h1; }
        h0 = cbk[0]; h1 = cbk[1];
        bf16_t* out = REC + ((size_t)(half * 4 + bl) * SEQ + lc * 32) * DRNN + cp * 2;
#pragma unroll
        for (int i = 31; i >= 0; --i) { const unsigned lw = *(const unsigned*)(LA + b1 + (size_t)i * DRNN), bw = *(const unsigned*)(BX + b1 + (size_t)i * DRNN);
            h0 = __expf(bf_lo(lw)) * h0 + bf_lo(bw); h1 = __expf(bf_hi(lw)) * h1 + bf_hi(bw);
            *(unsigned*)(out + (size_t)i * DRNN) = cvt_pk_bf16(hf0[i] + h0, hf1[i] + h1); }
    }
}

#ifndef PH_MASK
#define PH_MASK 0xFFFFFFFFu
#endif
#define PH(k) ((PH_MASK >> (k)) & 1u)
#ifndef REP_MASK
#define REP_MASK 0u
#endif
#define REP_BEGIN(k) _Pragma("unroll 1") for (int rep_ = 0; rep_ < (((REP_MASK >> (k)) & 1u) ? 2 : 1); ++rep_) {
#define REP_END }
__device__ __forceinline__ ParamsK kparams() { ParamsK q = (ParamsK)__builtin_amdgcn_kernarg_segment_ptr(); asm volatile("" : "+s"(q)); return q; }
#define PHASE_BEGIN ParamsK kp = kparams(); unsigned char* ws = kp->ws; (void)ws; \
    int tid = threadIdx.x; asm volatile("" : "+v"(tid)); const int lane = tid & 63, wave = __builtin_amdgcn_readfirstlane(tid >> 6); \
    const int gw = bid * 8 + wave, gtid = bid * 512 + tid; (void)lane; (void)gw; (void)gtid;
#define P_MOD0 ((float*)(ws + WS_MOD))
#define P_MOD1 ((float*)(ws + WS_MOD) + 9 * 6144)
#define P_CTXRES ((float*)(ws + WS_CTXRES))
#define P_H ((bf16_t*)(ws + WS_H))
#define P_SLAB ((bf16_t*)(ws + WS_SLAB))
#define P_Q ((bf16_t*)(ws + WS_Q))
#define P_O ((bf16_t*)(ws + WS_O))
#define P_K ((bf16_t*)(ws + WS_K))
#define P_VT ((bf16_t*)(ws + WS_VT))
#define P_VTC ((bf16_t*)(ws + WS_VTC))
#define P_ACT ((bf16_t*)(ws + WS_ACT))
#define P_U ((bf16_t*)(ws + WS_U))
#define P_LA ((bf16_t*)(ws + WS_LA))
#define P_BX ((bf16_t*)(ws + WS_BX))
#define P_RPRE ((bf16_t*)(ws + WS_RPRE))
#define P_SP ((float*)(ws + WS_SP))
#define P_SH ((float*)(ws + WS_SH))
#define P_CIN ((float*)(ws + WS_CIN))
#define G0 (kp->norm_g)
#define G1 (kp->norm_g + 4 * DM)

__global__ void __launch_bounds__(512, 2) fwd_megakernel(Params p) {
    extern __shared__ __attribute__((aligned(16))) unsigned char lds_raw[];
    LAS unsigned char* lds = (LAS unsigned char*)lds_raw;
    cg::grid_group grid = cg::this_grid();
    const int G = gridDim.x, bid = blockIdx.x;
    const int ngw = G * 8, nthreads = G * 512;
    using namespace pg8;
    {
        unsigned* barw = (unsigned*)(p.ws + WS_BAR);
        if (bid == 0) for (int i = threadIdx.x; i < XCD_BAR_WORDS; i += 512) __hip_atomic_store(barw + i, 0u, __ATOMIC_RELAXED, __HIP_MEMORY_SCOPE_AGENT);
        if (threadIdx.x < 4) ((volatile LAS unsigned*)(lds + 132096))[threadIdx.x] = 0u;
    }
    if (PH(0)) { PHASE_BEGIN prologue(kp, lds, tid, lane, wave); }
    __syncthreads();
    grid.sync();
    XcdBarrier xbar = xcd_barrier_post((unsigned*)(p.ws + WS_BAR), (volatile LAS unsigned*)(lds + 132096));
#ifdef EXTRA_SYNCS
#pragma unroll 1
    for (int es = 0; es < EXTRA_SYNCS; ++es) xcd_barrier(xbar);
#endif
    REP_BEGIN(1)
    if (PH(1)) { PHASE_BEGIN row_phase<false, true>(kp->x, kp->ctx, nullptr, nullptr, nullptr, nullptr, P_H, nullptr, G0, nullptr, 0, P_MOD0, 0, 1, MT, gw, ngw, lane); }
    xcd_barrier(xbar);
    REP_END
    if (PH(2)) {
        PHASE_BEGIN
        Gemm g{P_H, (const bf16_t*)(ws + WS_WQKV), DM, DM, DM}; Sched S; S.init(MT / 256, NQKV / 256, G, bid);
        EpiQKV E{P_Q, P_K, P_VT, P_VTC, (const float*)(ws + WS_ROPE)};
        gemm_phase<EpiQKV, true, true>(lds, g, S, E);
    }
    xcd_barrier(xbar);
    REP_BEGIN(3)
    if (PH(3)) { PHASE_BEGIN attn_phase(lds, P_Q, P_O, P_K, P_VT, P_VTC, kp->sink, tid, lane, wave); }
    xcd_barrier(xbar);
    REP_END
    if (PH(4)) {
        PHASE_BEGIN
        Gemm g{P_O, (const bf16_t*)(ws + WS_WO), DM, DM, DM}; Sched S; S.init(MT / 256, DM / 256, G, bid);
        EpiPlain<0> E{P_H, DM};
        gemm_phase<EpiPlain<0>, true, true>(lds, g, S, E);
    }
    xcd_barrier(xbar);
    if (PH(5)) { PHASE_BEGIN row_phase<true, true>(kp->x, kp->ctx, kp->out, P_CTXRES, P_H, nullptr, P_H, G0 + DM, G0 + 2 * DM, P_MOD0, 2, P_MOD0, 3, 4, MT, gw, ngw, lane); }
    xcd_barrier(xbar);
    if (PH(6)) {
        PHASE_BEGIN
        Gemm g{P_H, (const bf16_t*)(ws + WS_W1), DM, DM, DM}; Sched S; S.init(MT / 256, DFF / 256, G, bid);
        EpiPlain<1> E{P_ACT, DFF};
        gemm_phase<EpiPlain<1>, true, true>(lds, g, S, E);
    }
    xcd_barrier(xbar);
    if (PH(7)) {
        PHASE_BEGIN
        { Gemm g{P_ACT, (const bf16_t*)(ws + WS_W2), DFF, DFF, DFF}; Sched S; S.init(ML / 256, DM / 256, G, bid);
          EpiPlain<0> E{P_H, DM};
          gemm_phase<EpiPlain<0>, true, true>(lds, g, S, E); }
        { Gemm g{P_ACT, (const bf16_t*)(ws + WS_W2), DFF, DFF, 1024}; Sched S; S.init(8, 4 * 4, G, bid, 2, 1024);
          EpiSlabCtx E{P_SLAB, 1024};
          gemm_phase<EpiSlabCtx, true, true>(lds, g, S, E); }
    }
    xcd_barrier(xbar);
    if (PH(8)) { PHASE_BEGIN row_phase<true, true>(kp->out, P_CTXRES, kp->out, P_CTXRES, P_H, P_SLAB, P_H, G0 + 3 * DM, G1, P_MOD0, 5, P_MOD1, 0, 1, MT, gw, ngw, lane); }
    xcd_barrier(xbar);
    if (PH(9)) {
        PHASE_BEGIN
        Gemm g{P_H, (const bf16_t*)(ws + WS_WIN) + (size_t)DRNN * DM, DM, DM, DM}; Sched S; S.init(MT / 256, DRNN / 256, G, bid);
        EpiPlain<0> E{P_RPRE, DRNN};
        gemm_phase<EpiPlain<0>, true, true>(lds, g, S, E);
    }
    xcd_barrier(xbar);
    REP_BEGIN(10)
    if (PH(10)) { PHASE_BEGIN conv_phase(P_RPRE, P_U, kp->conv_w, kp->conv_b, gtid, nthreads); }
    xcd_barrier(xbar);
    REP_END
#pragma unroll 1
    for (int half = 0; half < 2; ++half) {
        REP_BEGIN(11)
        if (PH(11)) {
            PHASE_BEGIN
            Gemm g{P_U, (const bf16_t*)(ws + WS_WG), DRNN, 256, 256}; Sched S; S.init(36, 20, G, bid, 1, half);
            EpiGates E{P_U, P_LA, P_BX, kp->b_a, kp->b_i, (const float*)(ws + WS_NLS)};
            gemm_phase<EpiGates, true, true>(lds, g, S, E);
        }
        xcd_barrier(xbar);
        if (PH(12)) { PHASE_BEGIN scanA_phase(P_LA, P_BX, P_SP, P_SH, gtid, nthreads); }
        xcd_barrier(xbar);
        if (PH(13)) { PHASE_BEGIN scanB_phase(P_SP, P_SH, P_CIN, gtid, nthreads); }
        xcd_barrier(xbar);
        REP_END
        if (PH(14)) { PHASE_BEGIN scanC_phase(P_LA, P_BX, P_CIN, P_U, half, gtid, nthreads); }
        xcd_barrier(xbar);
    }
    if (PH(15)) {
        PHASE_BEGIN
        Gemm g{P_H, (const bf16_t*)(ws + WS_WIN), DM, DM, DM}; Sched S; S.init(ML / 256, DRNN / 256, G, bid);
        EpiGateMul E{P_U};
        gemm_phase<EpiGateMul, true, true>(lds, g, S, E);
    }
    xcd_barrier(xbar);
    if (PH(16)) {
        PHASE_BEGIN
        Gemm g{P_U, (const bf16_t*)(ws + WS_WOUT), DRNN, DRNN, DRNN}; Sched S; S.init(ML / 256, DM / 256, G, bid);
        EpiPlain<0> E{P_H, DM};
        gemm_phase<EpiPlain<0>, true, true>(lds, g, S, E);
    }
    xcd_barrier(xbar);
    if (PH(17)) { PHASE_BEGIN row_phase<true, true>(kp->out, P_CTXRES, kp->out, P_CTXRES, P_H, nullptr, P_H, G1 + DM, G1 + 2 * DM, P_MOD1, 2, P_MOD1, 3, 4, ML, gw, ngw, lane); }
    xcd_barrier(xbar);
    if (PH(18)) {
        PHASE_BEGIN
        Gemm g{P_H, (const bf16_t*)(ws + WS_W1 + 16 * MiB), DM, DM, DM}; Sched S; S.init(ML / 256, DFF / 256, G, bid);
        EpiPlain<1> E{P_ACT, DFF};
        gemm_phase<EpiPlain<1>, true, true>(lds, g, S, E);
    }
    xcd_barrier(xbar);
    if (PH(19)) {
        PHASE_BEGIN
        Gemm g{P_ACT, (const bf16_t*)(ws + WS_W2 + 16 * MiB), DFF, DFF, DFF}; Sched S; S.init(ML / 256, DM / 256, G, bid);
        EpiPlain<0> E{P_H, DM};
        gemm_phase<EpiPlain<0>, true, true>(lds, g, S, E);
    }
    xcd_barrier(xbar);
    if (PH(20)) { PHASE_BEGIN row_phase<true, false>(kp->out, P_CTXRES, kp->out, P_CTXRES, P_H, nullptr, nullptr, G1 + 3 * DM, nullptr, P_MOD1, 5, nullptr, 0, 0, ML, gw, ngw, lane); }
}

extern "C" void kernel_launch(void* const* d_in, const int* in_sizes, int n_in, void* d_out, int out_size, void* d_ws, size_t ws_size, hipStream_t stream) {
    static int grid_blocks = 0;
    if (grid_blocks == 0) {
        if (n_in != 21 || ws_size < WS_END) { fprintf(stderr, "kernel_launch: unexpected n_in %d / ws_size %zu\n", n_in, ws_size); grid_blocks = -1; return; }
        int dev = 0, cus = 0, per_cu = 0;
        hipGetDevice(&dev);
        hipDeviceGetAttribute(&cus, hipDeviceAttributeMultiprocessorCount, dev);
        if (hipFuncSetAttribute((const void*)fwd_megakernel, hipFuncAttributeMaxDynamicSharedMemorySize, LDS_BYTES) != hipSuccess) { fprintf(stderr, "hipFuncSetAttribute failed\n"); grid_blocks = -1; return; }
        if (hipOccupancyMaxActiveBlocksPerMultiprocessor(&per_cu, (const void*)fwd_megakernel, 512, LDS_BYTES) != hipSuccess || per_cu < 1) { fprintf(stderr, "occupancy query failed (%d)\n", per_cu); (void)hipGetLastError(); per_cu = 1; }
        grid_blocks = cus * 1;
    }
    if (grid_blocks < 0) return;
    Params p{};
    p.x = (const float*)d_in[0]; p.c = (const float*)d_in[1]; p.ctx = (const float*)d_in[2]; p.c_ctx = (const float*)d_in[3];
    p.ada_w = (const float*)d_in[4]; p.ada_b = (const float*)d_in[5]; p.norm_g = (const float*)d_in[6]; p.mlp_w1 = (const float*)d_in[7]; p.mlp_w2 = (const float*)d_in[8];
    p.w_qkv = (const float*)d_in[9]; p.w_o = (const float*)d_in[10]; p.sink = (const float*)d_in[11];
    p.w_in = (const float*)d_in[12]; p.conv_w = (const float*)d_in[13]; p.conv_b = (const float*)d_in[14]; p.w_a = (const float*)d_in[15]; p.b_a = (const float*)d_in[16];
    p.w_i = (const float*)d_in[17]; p.b_i = (const float*)d_in[18]; p.lam = (const float*)d_in[19]; p.w_out = (const float*)d_in[20];
    p.out = (float*)d_out; p.ws = (unsigned char*)d_ws;
    void* args[] = {&p};
    hipError_t e = hipLaunchCooperativeKernel((const void*)fwd_megakernel, dim3(grid_blocks), dim3(512), args, LDS_BYTES, stream);
    if (e != hipSuccess) fprintf(stderr, "cooperative launch failed: %s (grid %d)\n", hipGetErrorString(e), grid_blocks);
}
```

```cpp
#include <hip/hip_runtime.h>
#include <hip/hip_cooperative_groups.h>
#include <cstdio>
#include <cstdint>
namespace cg = cooperative_groups;

#define LAS __attribute__((address_space(3)))
typedef unsigned short bf16_t;
typedef short bf16x8 __attribute__((ext_vector_type(8)));
typedef float f32x4 __attribute__((ext_vector_type(4)));
typedef float f32x2 __attribute__((ext_vector_type(2)));
typedef unsigned u32x4 __attribute__((ext_vector_type(4)));
typedef unsigned u32x2 __attribute__((ext_vector_type(2)));

constexpr int DM = 1024, NB = 8, SEQ = 2048, CTX = 256;
constexpr int ML = NB * SEQ;
constexpr int MC = NB * CTX;
constexpr int MT = ML + MC;
constexpr int NQKV = 1536, DFF = 4096, DRNN = 1280;
constexpr float EPS = 1e-6f;
constexpr float LOG2E = 1.4426950408889634f;

constexpr size_t MiB = 1u << 20;
constexpr size_t WS_MOD = 0;
constexpr size_t WS_ROPE = 448 * 1024;
constexpr size_t WS_NLS = 460 * 1024;
constexpr size_t WS_BAR = 480 * 1024;
constexpr size_t WS_WQKV = 1 * MiB, WS_WO = 4 * MiB, WS_W1 = 6 * MiB, WS_W2 = 14 * MiB;
constexpr size_t WS_WIN = 38 * MiB, WS_WG = 43 * MiB, WS_WOUT = 46 * MiB;
constexpr size_t WS_CTXRES = 49 * MiB;
constexpr size_t WS_H = 57 * MiB;
constexpr size_t WS_R3 = 93 * MiB;
constexpr size_t WS_Q = WS_R3, WS_K = 129 * MiB, WS_VT = 138 * MiB, WS_VTC = 146 * MiB;
constexpr size_t WS_O = 150 * MiB;
constexpr size_t WS_ACT = WS_R3;
constexpr size_t WS_U = WS_R3;
constexpr size_t WS_LA = 138 * MiB;
constexpr size_t WS_BX = 183 * MiB;
constexpr size_t WS_RPRE = 138 * MiB;
constexpr size_t WS_SP = 228 * MiB, WS_SH = 231 * MiB, WS_CIN = 234 * MiB;
constexpr size_t WS_SLAB = 238 * MiB;
constexpr size_t WS_END = 256 * MiB;
constexpr int LDS_BYTES = 135168;

__device__ __forceinline__ unsigned f2bf(float f) { unsigned u = __builtin_bit_cast(unsigned, f); return (u + 0x7fffu + ((u >> 16) & 1u)) >> 16; }
__device__ __forceinline__ unsigned cvt_pk_bf16(float lo, float hi) { unsigned r; asm volatile("v_cvt_pk_bf16_f32 %0, %1, %2" : "=v"(r) : "v"(lo), "v"(hi)); return r; }
__device__ __forceinline__ float bf_lo(unsigned w) { return __builtin_bit_cast(float, w << 16); }
__device__ __forceinline__ float bf_hi(unsigned w) { return __builtin_bit_cast(float, w & 0xffff0000u); }
__device__ __forceinline__ f32x4 bf4_to_f32(u32x2 w) { return (f32x4){bf_lo(w.x), bf_hi(w.x), bf_lo(w.y), bf_hi(w.y)}; }
__device__ __forceinline__ u32x2 f32_to_bf4(f32x4 v) { u32x2 w; w.x = cvt_pk_bf16(v[0], v[1]); w.y = cvt_pk_bf16(v[2], v[3]); return w; }
__device__ __forceinline__ float wave_sum(float v) {
#pragma unroll
    for (int o = 1; o < 64; o <<= 1) v += __shfl_xor(v, o);
    return v;
}
__device__ __forceinline__ float fsigmoid(float x) { return __builtin_amdgcn_rcpf(1.0f + __expf(-x)); }

namespace pg8 {
constexpr int BM = 256, BK = 64, HALF = 128, HTB = HALF * BK * 2, STAGE_BYTES = 8 * HTB, NXCD = 8, WGM = 8;
__device__ __forceinline__ int lds_byte(int r, int c) { const int st = (r >> 4) * 2 + (c >> 5), rr = r & 15, cc = c & 31, ob = rr * 64 + cc * 2; return st * 1024 + (ob ^ (((ob >> 9) & 1) << 5)); }
__device__ __forceinline__ void stage_rc(int b, int& R, int& C) { const int st = b / 1024, sb = b % 1024, swz = sb ^ (((sb >> 9) & 1) << 5); R = (st >> 1) * 16 + swz / 64; C = (st & 1) * 32 + (swz % 64) / 2; }

struct Unit { int pm, pn, koff, po, kboff; };
struct Gemm { const bf16_t* A; const bf16_t* Bt; int lda, ldb, K; };

struct Sched {
    int nM, nN, nwg, G, c, mode, half;
    __device__ void init(int nM_, int nN_, int G_, int c_, int mode_ = 0, int half_ = 0) { nM = nM_; nN = nN_; nwg = nM * nN; G = G_; c = c_; mode = mode_; half = half_; }
    __device__ bool next(int i, Unit& u) const {
        const long L = (long)i * G + c; if (L >= nwg) return false;
        int wgid = (int)L; { const int q = nwg / NXCD, r = nwg % NXCD, xcd = wgid % NXCD, off = wgid / NXCD; wgid = (xcd < r ? xcd * (q + 1) : r * (q + 1) + (xcd - r) * q) + off; }
        const int nig = WGM * nN, gid = wgid / nig, fm = gid * WGM, gsz = (nM - fm) < WGM ? (nM - fm) : WGM;
        const int pmi = fm + ((wgid % nig) % gsz), pn = (wgid % nig) / gsz;
        u.pm = pmi; u.pn = pn; u.koff = 0; u.po = pmi; u.kboff = 0;
        if (mode == 2) { u.pm = 64 + pmi; u.pn = pn & 3; u.koff = (pn >> 2) * half; u.kboff = u.koff; }
        if (mode == 1) { u.pm = pmi < 32 ? 32 * half + pmi : 64 + 4 * half + (pmi - 32); u.koff = ((pn >> 1) % 5) * 256; }
        return true;
    }
};

template <class Epi, bool ALIGN_EPI, bool SP2>
__device__ __forceinline__ void gemm_phase(LAS unsigned char* lds, const Gemm g, const Sched& S, const Epi& E) {
    int tid = threadIdx.x; asm volatile("" : "+v"(tid));
    const int wid = __builtin_amdgcn_readfirstlane(tid >> 6), lane = tid & 63, wr = wid >> 2, wc = wid & 3, fr = lane & 15, fq = lane >> 4;
    const int K = g.K, nt = K / BK;
    unsigned voffA[2], voffB[2];
#pragma unroll
    for (int i = 0; i < 2; ++i) { int R, C; stage_rc(tid * 16 + i * 8192, R, C);
        voffA[i] = (unsigned)(R * g.lda + C) * 2u; voffB[i] = (unsigned)(R * g.ldb + C) * 2u; }
    const size_t kstep = (size_t)(BK * 2);
    const size_t hstepA = (size_t)HALF * g.lda * 2, hstepB = (size_t)HALF * g.ldb * 2;
    const unsigned ldsw = (unsigned)wid * 1024u;
    const int aoff = lds_byte(wr * 64 + fr, fq * 8), boff = lds_byte(wc * 32 + fr, fq * 8);
#define PG8_SA(b, h) (((b) * 2 + (h)) * HTB)
#define PG8_SB(b, h) ((4 + (b) * 2 + (h)) * HTB)
#define PG8_STAGE(bufoff, gbase, voff) do { _Pragma("unroll") for (int _i = 0; _i < 2; ++_i) \
        __builtin_amdgcn_global_load_lds((const unsigned*)((const char*)(gbase) + (voff)[_i]), (LAS unsigned*)(lds + (bufoff) + ldsw + _i * 8192), 16, 0, 0); } while (0)
#define PG8_LDA(dst, b, h) do { _Pragma("unroll") for (int m = 0; m < 4; ++m) _Pragma("unroll") for (int k = 0; k < 2; ++k) dst[m][k] = *(const LAS bf16x8*)(lds + PG8_SA(b, h) + aoff + m * 2048 + k * 1024); } while (0)
#define PG8_LDB(dst, b, h) do { _Pragma("unroll") for (int n = 0; n < 2; ++n) _Pragma("unroll") for (int k = 0; k < 2; ++k) dst[n][k] = *(const LAS bf16x8*)(lds + PG8_SB(b, h) + boff + n * 2048 + k * 1024); } while (0)
#define PG8_MMA(ai, bj, At, Bt) do { __builtin_amdgcn_s_setprio(1); _Pragma("unroll") for (int m = 0; m < 4; ++m) _Pragma("unroll") for (int n = 0; n < 2; ++n) _Pragma("unroll") for (int k = 0; k < 2; ++k) \
        acc[ai][bj][m][n] = __builtin_amdgcn_mfma_f32_16x16x32_bf16(Bt[n][k], At[m][k], acc[ai][bj][m][n], 0, 0, 0); __builtin_amdgcn_s_setprio(0); } while (0)
#define PG8_WAIT_V(n) asm volatile("s_waitcnt vmcnt(" #n ")" ::: "memory")
#define PG8_WAIT_L(n) asm volatile("s_waitcnt lgkmcnt(" #n ")" ::: "memory")
#define PG8_BAR __builtin_amdgcn_s_barrier()
#define PG8_SCHED __builtin_amdgcn_sched_barrier(0)
    Unit cur, nxt; int ui = 0;
    if (!S.next(0, cur)) return;
    f32x4 acc[2][2][4][2];
#pragma unroll
    for (int a = 0; a < 2; ++a)
#pragma unroll
        for (int b = 0; b < 2; ++b)
#pragma unroll
            for (int m = 0; m < 4; ++m)
#pragma unroll
                for (int n = 0; n < 2; ++n) acc[a][b][m][n] = (f32x4){0.f, 0.f, 0.f, 0.f};
    bf16x8 At[4][2], B0[2][2], B1[2][2];
    const char* cA = (const char*)g.A + ((size_t)cur.pm * BM * g.lda + cur.koff) * 2; const char* cB = (const char*)g.Bt + ((size_t)cur.pn * BM * g.ldb + cur.kboff) * 2;
    if constexpr (SP2) {
        PG8_STAGE(PG8_SB(0, 0), cB, voffB); PG8_STAGE(PG8_SB(0, 1), cB + hstepB, voffB); PG8_STAGE(PG8_SA(0, 0), cA, voffA); PG8_STAGE(PG8_SA(0, 1), cA + hstepA, voffA);
        if (wr == 1) PG8_BAR;
        PG8_WAIT_V(2); PG8_BAR;
        PG8_STAGE(PG8_SB(1, 0), cB + kstep, voffB); PG8_STAGE(PG8_SA(1, 0), cA + kstep, voffA); PG8_STAGE(PG8_SB(1, 1), cB + hstepB + kstep, voffB);
        PG8_WAIT_V(6); PG8_BAR;
    } else {
        PG8_STAGE(PG8_SB(0, 0), cB, voffB); PG8_STAGE(PG8_SA(0, 0), cA, voffA); PG8_STAGE(PG8_SB(0, 1), cB + hstepB, voffB); PG8_STAGE(PG8_SA(0, 1), cA + hstepA, voffA);
        if (wr == 1) PG8_BAR;
        PG8_WAIT_V(4); PG8_BAR;
        PG8_STAGE(PG8_SB(1, 0), cB + kstep, voffB); PG8_STAGE(PG8_SA(1, 0), cA + kstep, voffA); PG8_STAGE(PG8_SB(1, 1), cB + hstepB + kstep, voffB);
        PG8_WAIT_V(6); PG8_BAR;
    }
    for (;;) {
        const bool has_next = S.next(ui + 1, nxt);
        const char* nA = has_next ? (const char*)g.A + ((size_t)nxt.pm * BM * g.lda + nxt.koff) * 2 : cA;
        const char* nB = has_next ? (const char*)g.Bt + ((size_t)nxt.pn * BM * g.ldb + nxt.kboff) * 2 : cB;
#pragma unroll 1
        for (int t = 0; t < nt; t += 2) {
            const bool last = (t == nt - 2);
            const char* a1 = cA + (size_t)(t + 1) * kstep;
            const char* a2 = last ? nA : cA + (size_t)(t + 2) * kstep; const char* b2 = last ? nB : cB + (size_t)(t + 2) * kstep;
            const char* a3 = a2 + kstep; const char* b3 = b2 + kstep;
            if constexpr (SP2) {
            PG8_LDB(B0, 0, 0); PG8_LDB(B1, 0, 1); PG8_SCHED; PG8_LDA(At, 0, 0); PG8_STAGE(PG8_SA(1, 1), a1 + hstepA, voffA);
            PG8_WAIT_V(8); PG8_WAIT_L(0); PG8_BAR; PG8_MMA(0, 0, At, B0); PG8_MMA(0, 1, At, B1); PG8_BAR; PG8_SCHED;
            PG8_LDA(At, 0, 1); PG8_STAGE(PG8_SB(0, 0), b2, voffB); PG8_STAGE(PG8_SB(0, 1), b2 + hstepB, voffB); PG8_STAGE(PG8_SA(0, 0), a2, voffA);
            PG8_WAIT_V(8); PG8_WAIT_L(0); PG8_BAR; PG8_MMA(1, 0, At, B0); PG8_MMA(1, 1, At, B1); PG8_BAR; PG8_SCHED;
            PG8_LDB(B0, 1, 0); PG8_LDB(B1, 1, 1); PG8_SCHED; PG8_LDA(At, 1, 0); PG8_STAGE(PG8_SA(0, 1), a2 + hstepA, voffA);
            PG8_WAIT_V(8); PG8_WAIT_L(0); PG8_BAR; PG8_MMA(0, 0, At, B0); PG8_MMA(0, 1, At, B1); PG8_BAR; PG8_SCHED;
            PG8_LDA(At, 1, 1); PG8_STAGE(PG8_SB(1, 0), b3, voffB); PG8_STAGE(PG8_SB(1, 1), b3 + hstepB, voffB); PG8_STAGE(PG8_SA(1, 0), a3, voffA);
            PG8_WAIT_V(8); PG8_WAIT_L(0); PG8_BAR; PG8_MMA(1, 0, At, B0); PG8_MMA(1, 1, At, B1); PG8_BAR; PG8_SCHED;
            } else {
            PG8_LDB(B0, 0, 0); PG8_SCHED; PG8_LDA(At, 0, 0); PG8_STAGE(PG8_SA(1, 1), a1 + hstepA, voffA);
            PG8_WAIT_L(8); PG8_BAR; PG8_WAIT_L(0); PG8_MMA(0, 0, At, B0); PG8_BAR; PG8_SCHED;
            PG8_LDB(B1, 0, 1); PG8_STAGE(PG8_SB(0, 0), b2, voffB);
            PG8_BAR; PG8_WAIT_L(0); PG8_MMA(0, 1, At, B1); PG8_BAR;
            PG8_LDA(At, 0, 1); PG8_STAGE(PG8_SA(0, 0), a2, voffA);
            PG8_BAR; PG8_WAIT_L(0); PG8_MMA(1, 0, At, B0); PG8_BAR; PG8_SCHED;
            PG8_STAGE(PG8_SB(0, 1), b2 + hstepB, voffB);
            PG8_WAIT_V(6); PG8_BAR; PG8_MMA(1, 1, At, B1); PG8_BAR;
            PG8_LDB(B0, 1, 0); PG8_SCHED; PG8_LDA(At, 1, 0); PG8_STAGE(PG8_SA(0, 1), a2 + hstepA, voffA);
            PG8_WAIT_L(8); PG8_BAR; PG8_WAIT_L(0); PG8_MMA(0, 0, At, B0); PG8_BAR; PG8_SCHED;
            PG8_LDB(B1, 1, 1); PG8_STAGE(PG8_SB(1, 0), b3, voffB);
            PG8_BAR; PG8_WAIT_L(0); PG8_MMA(0, 1, At, B1); PG8_BAR;
            PG8_LDA(At, 1, 1); PG8_STAGE(PG8_SA(1, 0), a3, voffA);
            PG8_BAR; PG8_WAIT_L(0); PG8_MMA(1, 0, At, B0); PG8_BAR; PG8_SCHED;
            PG8_STAGE(PG8_SB(1, 1), b3 + hstepB, voffB);
            PG8_WAIT_V(6); PG8_BAR; PG8_MMA(1, 1, At, B1); PG8_BAR;
            }
        }
        if constexpr (ALIGN_EPI) { if (wr == 0) PG8_BAR; }
        E(acc, cur, wr, wc, fr, fq);
        if (!has_next) break;
#pragma unroll
        for (int a = 0; a < 2; ++a)
#pragma unroll
            for (int b = 0; b < 2; ++b)
#pragma unroll
                for (int m = 0; m < 4; ++m)
#pragma unroll
                    for (int n = 0; n < 2; ++n) acc[a][b][m][n] = (f32x4){0.f, 0.f, 0.f, 0.f};
        cur = nxt; cA = nA; cB = nB; ++ui;
        if constexpr (ALIGN_EPI) { if (wr == 1) PG8_BAR; }
    }
    PG8_WAIT_V(0);
    if constexpr (!ALIGN_EPI) { if (wr == 0) PG8_BAR; }
    PG8_BAR;
#undef PG8_SA
#undef PG8_SB
#undef PG8_STAGE
#undef PG8_LDA
#undef PG8_LDB
#undef PG8_MMA
#undef PG8_WAIT_V
#undef PG8_WAIT_L
#undef PG8_BAR
#undef PG8_SCHED
}

template <int ACT> struct EpiPlain {
    bf16_t* O; int ldc;
    __device__ __forceinline__ void operator()(const f32x4 (&acc)[2][2][4][2], const Unit& u, int wr, int wc, int fr_, int fq_) const {
        int fr = fr_, fq = fq_; asm volatile("" : "+v"(fr), "+v"(fq));
        const int col0 = u.pn * BM + wc * 32 + fq * 4;
#pragma unroll
        for (int ai = 0; ai < 2; ++ai)
#pragma unroll
            for (int m = 0; m < 4; ++m) { bf16_t* rowp = O + (size_t)(u.pm * BM + ai * HALF + wr * 64 + m * 16 + fr) * ldc + col0;
#pragma unroll
                for (int bj = 0; bj < 2; ++bj)
#pragma unroll
                    for (int n = 0; n < 2; ++n) { f32x4 v = acc[ai][bj][m][n];
                        if (ACT == 1) { v = __builtin_elementwise_max(v, (f32x4){0.f, 0.f, 0.f, 0.f}); v = v * v; }
                        *(u32x2*)(rowp + bj * HALF + n * 16) = f32_to_bf4(v); } }
    }
};

struct EpiSlabCtx {
    bf16_t* S; int ksz;
    __device__ __forceinline__ void operator()(const f32x4 (&acc)[2][2][4][2], const Unit& u, int wr, int wc, int fr_, int fq_) const {
        int fr = fr_, fq = fq_; asm volatile("" : "+v"(fr), "+v"(fq));
        const int col0 = u.pn * BM + wc * 32 + fq * 4;
        bf16_t* base = S + (size_t)(u.koff / ksz) * MC * DM;
#pragma unroll
        for (int ai = 0; ai < 2; ++ai)
#pragma unroll
            for (int m = 0; m < 4; ++m) { bf16_t* rowp = base + (size_t)(u.pm * BM - ML + ai * HALF + wr * 64 + m * 16 + fr) * DM + col0;
#pragma unroll
                for (int bj = 0; bj < 2; ++bj)
#pragma unroll
                    for (int n = 0; n < 2; ++n) *(u32x2*)(rowp + bj * HALF + n * 16) = f32_to_bf4(acc[ai][bj][m][n]); }
    }
};

struct EpiQKV {
    bf16_t* Q; bf16_t* Kb; bf16_t* VT; bf16_t* VTC; const float* rope;
    __device__ __forceinline__ void operator()(const f32x4 (&acc)[2][2][4][2], const Unit& u, int wr, int wc, int fr_, int fq_) const {
        int fr = fr_, fq = fq_; asm volatile("" : "+v"(fr), "+v"(fq));
        const bool lat = u.pm < 64;
        if (u.pn < 5) {
#pragma unroll
            for (int ai = 0; ai < 2; ++ai)
#pragma unroll
                for (int m = 0; m < 4; ++m) {
                    const int row = u.pm * BM + ai * HALF + wr * 64 + m * 16 + fr;
                    f32x4 cs0 = {1.f, 0.f, 1.f, 0.f}, cs1 = {1.f, 0.f, 1.f, 0.f};
                    if (lat) { const int t = row & 2047; const int pos = (wc & 1) ? (t & 63) : (t >> 6); const f32x4* pp = (const f32x4*)(rope + (pos * 16 + 4 * fq) * 2); cs0 = pp[0]; cs1 = pp[1]; }
                    const f32x4 cv = {cs0[0], cs0[2], cs1[0], cs1[2]}, sv = {cs0[1], cs0[3], cs1[1], cs1[3]};
#pragma unroll
                    for (int bj = 0; bj < 2; ++bj) {
                        const f32x4 a = acc[ai][bj][m][0], b = acc[ai][bj][m][1];
                        f32x4 na = a * cv - b * sv, nb = b * cv + a * sv;
                        if (u.pn < 4) { na = na * 0.125f; nb = nb * 0.125f;
                            bf16_t* d = Q + (size_t)row * 1024 + u.pn * 256 + bj * HALF + wc * 32 + fq * 4;
                            *(u32x2*)d = f32_to_bf4(na); *(u32x2*)(d + 16) = f32_to_bf4(nb);
                        } else {
                            bf16_t* d = Kb + (size_t)row * 256 + bj * HALF + wc * 32 + fq * 4;
                            *(u32x2*)d = f32_to_bf4(na); *(u32x2*)(d + 16) = f32_to_bf4(nb);
                        }
                    }
                }
        } else {
#pragma unroll
            for (int ai = 0; ai < 2; ++ai)
#pragma unroll
                for (int m = 0; m < 4; ++m) {
                    const int row = u.pm * BM + ai * HALF + wr * 64 + m * 16 + fr;
                    bf16_t* base; size_t stride;
                    if (lat) { const int b = row >> 11, t = row & 2047; base = VT + (size_t)b * 256 * 2048 + t; stride = 2048; }
                    else { const int rc = row - ML; const int b = rc >> 8, t = rc & 255; base = VTC + (size_t)b * 256 * 256 + t; stride = 256; }
#pragma unroll
                    for (int bj = 0; bj < 2; ++bj)
#pragma unroll
                        for (int n = 0; n < 2; ++n)
#pragma unroll
                            for (int j = 0; j < 4; ++j) { const int vc = bj * HALF + wc * 32 + n * 16 + fq * 4 + j; base[(size_t)vc * stride] = (bf16_t)f2bf(acc[ai][bj][m][n][j]); }
                }
        }
    }
};

struct EpiGates {
    const bf16_t* U; bf16_t* LA; bf16_t* BX; const float* ba; const float* bi; const float* nls;
    __device__ __forceinline__ void operator()(const f32x4 (&acc)[2][2][4][2], const Unit& u, int wr, int wc, int fr_, int fq_) const {
        int fr = fr_, fq = fq_; asm volatile("" : "+v"(fr), "+v"(fq));
        const int tile = u.pn >> 1, dir = tile / 5, blk = tile % 5, chalf = u.pn & 1;
        const int ch0 = blk * 256 + chalf * 128 + wc * 32 + fq * 4;
#pragma unroll
        for (int n = 0; n < 2; ++n) {
            const int ch = ch0 + n * 16;
            const f32x4 bav = *(const f32x4*)(ba + dir * DRNN + ch), biv = *(const f32x4*)(bi + dir * DRNN + ch), nl = *(const f32x4*)(nls + dir * DRNN + ch);
#pragma unroll
            for (int ai = 0; ai < 2; ++ai)
#pragma unroll
                for (int m = 0; m < 4; ++m) {
                    const int rin = ai * HALF + wr * 64 + m * 16 + fr;
                    const size_t rowg = (size_t)u.pm * BM + rin, rowl = (size_t)u.po * BM + rin;
                    const f32x4 uv = bf4_to_f32(*(const u32x2*)(U + rowg * DRNN + ch));
                    f32x4 lav, bxv;
#pragma unroll
                    for (int j = 0; j < 4; ++j) {
                        const float r = fsigmoid(acc[ai][0][m][n][j] + bav[j]);
                        const float ig = fsigmoid(acc[ai][1][m][n][j] + biv[j]);
                        const float la = nl[j] * r, x = 2.0f * la;
                        float om;
                        if (x > -0.5f) { float q = 1.0f / 720.0f; q = q * x + 1.0f / 120.0f; q = q * x + 1.0f / 24.0f; q = q * x + 1.0f / 6.0f; q = q * x + 0.5f; q = q * x + 1.0f; om = -x * q; }
                        else om = 1.0f - __expf(x);
                        lav[j] = la; bxv[j] = __builtin_amdgcn_sqrtf(om) * (ig * uv[j]);
                    }
                    const size_t o = ((size_t)dir * 9216 + rowl) * DRNN + ch;
                    *(u32x2*)(LA + o) = f32_to_bf4(lav); *(u32x2*)(BX + o) = f32_to_bf4(bxv);
                    asm volatile("" ::: "memory");
                }
        }
    }
};

struct EpiGateMul {
    bf16_t* Z;
    __device__ __forceinline__ void operator()(const f32x4 (&acc)[2][2][4][2], const Unit& u, int wr, int wc, int fr_, int fq_) const {
        int fr = fr_, fq = fq_; asm volatile("" : "+v"(fr), "+v"(fq));
        const int col0 = u.pn * BM + wc * 32 + fq * 4;
#pragma unroll
        for (int ai = 0; ai < 2; ++ai)
#pragma unroll
            for (int m = 0; m < 4; ++m) { bf16_t* rowp = Z + (size_t)(u.pm * BM + ai * HALF + wr * 64 + m * 16 + fr) * DRNN + col0;
#pragma unroll
                for (int bj = 0; bj < 2; ++bj)
#pragma unroll
                    for (int n = 0; n < 2; ++n) { const f32x4 v = acc[ai][bj][m][n]; const f32x4 rc = bf4_to_f32(*(const u32x2*)(rowp + bj * HALF + n * 16)); f32x4 o;
#pragma unroll
                        for (int j = 0; j < 4; ++j) { const float x = v[j]; const float z2 = 1.5957691216057308f * (x + 0.044715f * x * x * x); o[j] = x * fsigmoid(z2) * rc[j]; }
                        *(u32x2*)(rowp + bj * HALF + n * 16) = f32_to_bf4(o); }
                asm volatile("" ::: "memory"); }
    }
};
}


#define XB_TMO      128
#define XB_XCNT(j)  (256  + 64 * (j))
#define XB_XSUB(j)  (1280 + 64 * (j))
#define XB_XGEN(j)  (2304 + 64 * (j))
#define XB_TOP      3328
#define XB_TOPGEN   3392
#define XCD_BAR_WORDS 3456
#define XB_SPIN_CAP (1u << 18)
__device__ __forceinline__ unsigned xb_ld(unsigned* p)              { return __hip_atomic_load(p, __ATOMIC_RELAXED, __HIP_MEMORY_SCOPE_AGENT); }
__device__ __forceinline__ unsigned xb_add(unsigned* p, unsigned v) { return __hip_atomic_fetch_add(p, v, __ATOMIC_RELAXED, __HIP_MEMORY_SCOPE_AGENT); }
__device__ __forceinline__ unsigned xb_xcc_id() { return (unsigned)__builtin_amdgcn_s_getreg((3 << 11) | 20) & 0xFu; }
#define XB_SPIN(cond, bar) do { unsigned _sp = 0; while (cond) { __builtin_amdgcn_s_sleep(1); \
    if ((++_sp & 255u) == 0u) { if (xb_ld(&(bar)[XB_TMO])) break; if (_sp > XB_SPIN_CAP) { atomicAdd(&(bar)[XB_TMO], 1u); break; } } } } while (0)
struct XcdBarrier { unsigned* bar; unsigned x; volatile LAS unsigned* st; };
__device__ __forceinline__ XcdBarrier xcd_barrier_post(unsigned* bar, volatile LAS unsigned* st) {
    XcdBarrier b; b.bar = bar; b.x = xb_xcc_id(); b.st = st;
    if (threadIdx.x == 0) (void)xb_add(&bar[XB_XCNT(b.x)], 1u);
    return b;
}
__device__ __forceinline__ void xcd_barrier_complete(unsigned* bar, unsigned x, unsigned& nloc, unsigned& nx) {
    const unsigned G = gridDim.x * gridDim.y * gridDim.z;
    unsigned sum, cnt, mine, sp = 0u;
    for (;;) {
        sum = 0u; cnt = 0u; mine = 0u;
#pragma unroll
        for (unsigned j = 0; j < 16; ++j) { const unsigned c = xb_ld(&bar[XB_XCNT(j)]); sum += c; cnt += (c > 0u) ? 1u : 0u; mine = (j == x) ? c : mine; }
        if (sum == G) break;
        __builtin_amdgcn_s_sleep(1);
        if ((++sp & 255u) == 0u) { if (xb_ld(&bar[XB_TMO])) break; if (sp > XB_SPIN_CAP) { atomicAdd(&bar[XB_TMO], 1u); break; } }
    }
    nloc = mine > 0u ? mine : 1u; nx = cnt > 0u ? cnt : 1u;
}
__device__ __forceinline__ void xcd_barrier(const XcdBarrier& b) {
    asm volatile("s_waitcnt vmcnt(0)" ::: "memory");
    __syncthreads();
    if (threadIdx.x == 0) {
        unsigned* bar = b.bar;
        __builtin_amdgcn_s_waitcnt(0);
        unsigned nloc = b.st[0], nx = b.st[1];
        if (nloc == 0u) { xcd_barrier_complete(bar, b.x, nloc, nx); b.st[0] = nloc; b.st[1] = nx; }
        const unsigned old = xb_add(&bar[XB_XSUB(b.x)], 1u);
        const unsigned gen = old / nloc;
        if (old + 1u == (gen + 1u) * nloc) {
            __builtin_amdgcn_fence(__ATOMIC_RELEASE, "agent");
            asm volatile("s_waitcnt vmcnt(0)" ::: "memory");
            const unsigned og = xb_add(&bar[XB_TOP], 1u);
            const unsigned tg = og / nx;
            if (og + 1u == (tg + 1u) * nx) xb_add(&bar[XB_TOPGEN], 1u);
            else XB_SPIN(xb_ld(&bar[XB_TOPGEN]) == tg, bar);
            __builtin_amdgcn_fence(__ATOMIC_ACQUIRE, "agent");
            xb_add(&bar[XB_XGEN(b.x)], 1u);
            asm volatile("s_waitcnt vmcnt(0)" ::: "memory");
        } else {
            XB_SPIN(xb_ld(&bar[XB_XGEN(b.x)]) == gen, bar);
            __builtin_amdgcn_fence(__ATOMIC_ACQUIRE, "agent");
            asm volatile("s_waitcnt vmcnt(0)" ::: "memory");
        }
    }
    __syncthreads();
}

struct Params {
    const float *x, *c, *ctx, *c_ctx, *ada_w, *ada_b, *norm_g, *mlp_w1, *mlp_w2, *w_qkv, *w_o, *sink;
    const float *w_in, *conv_w, *conv_b, *w_a, *b_a, *w_i, *b_i, *lam, *w_out;
    float* out; unsigned char* ws;
};

typedef const __attribute__((address_space(4))) Params* ParamsK;
__device__ __forceinline__ void transpose_item(const float* W, int ldw, bf16_t* WT, int ldwt, int k0, int n0, int dst_row0, LAS float* scr, int lane) {
#pragma unroll 8
    for (int i = 0; i < 32; ++i) { const int kk = 2 * i + (lane >> 5); scr[kk * 33 + (lane & 31)] = W[(size_t)(k0 + kk) * ldw + n0 + (lane & 31)]; }
    asm volatile("s_waitcnt lgkmcnt(0)" ::: "memory");
    const int c = lane & 7;
#pragma unroll
    for (int j = 0; j < 4; ++j) { const int n = (lane >> 3) + 8 * j; const LAS float* s = scr + (8 * c) * 33 + n;
        u32x4 o; o.x = cvt_pk_bf16(s[0 * 33], s[1 * 33]); o.y = cvt_pk_bf16(s[2 * 33], s[3 * 33]); o.z = cvt_pk_bf16(s[4 * 33], s[5 * 33]); o.w = cvt_pk_bf16(s[6 * 33], s[7 * 33]);
        *(u32x4*)(WT + (size_t)(dst_row0 + n) * ldwt + k0 + 8 * c) = o; }
    asm volatile("s_waitcnt lgkmcnt(0)" ::: "memory");
}
__device__ __forceinline__ void transpose_plain(const float* W, int K, int N, bf16_t* WT, int r, LAS float* scr, int lane) {
    const int nblk = N / 32, kb = r / nblk, nb = r % nblk;
    transpose_item(W, N, WT, K, 64 * kb, 32 * nb, 32 * nb, scr, lane);
}

__device__ __forceinline__ void prologue(ParamsK p, LAS unsigned char* lds, int tid, int lane, int wave) {
    unsigned char* ws = p->ws;
    float* MOD = (float*)(ws + WS_MOD);
    if (blockIdx.x < 96) {
        LAS float* sl = (LAS float*)lds;
        LAS float* red = (LAS float*)(lds + 36864);
        for (int idx = tid; idx < 9216; idx += 512) { const int w = idx >> 10, k = idx & 1023; const float v = (w < 8) ? p->c[w * 1024 + k] : p->c_ctx[k]; sl[idx] = v / (1.0f + __expf(-v)); }
        __syncthreads();
        const int l = blockIdx.x / 48, n0 = (blockIdx.x % 48) * 128, kg = tid >> 5, cq = tid & 31;
        f32x4 acc[9];
#pragma unroll
        for (int w = 0; w < 9; ++w) acc[w] = (f32x4){0.f, 0.f, 0.f, 0.f};
        const float* wb = p->ada_w + (size_t)l * 1024 * 6144 + n0 + cq * 4;
#pragma unroll 4
        for (int it = 0; it < 64; ++it) { const int k = it * 16 + kg; const f32x4 w4 = *(const f32x4*)(wb + (size_t)k * 6144);
#pragma unroll
            for (int w = 0; w < 9; ++w) acc[w] += sl[w * 1024 + k] * w4; }
#pragma unroll
        for (int w = 0; w < 9; ++w) *(LAS f32x4*)(red + (kg * 9 + w) * 128 + cq * 4) = acc[w];
        __syncthreads();
        for (int idx = tid; idx < 9 * 128; idx += 512) { const int w = idx >> 7, n = idx & 127; float s = 0.f;
#pragma unroll
            for (int g = 0; g < 16; ++g) s += red[(g * 9 + w) * 128 + n];
            MOD[(size_t)(l * 9 + w) * 6144 + n0 + n] = s + p->ada_b[l * 6144 + n0 + n]; }
        __syncthreads();
    }
    if (blockIdx.x == gridDim.x - 1) {
        float* rope = (float*)(ws + WS_ROPE); float* nls = (float*)(ws + WS_NLS);
        for (int idx = tid; idx < 1024; idx += 512) { const int pos = idx >> 4, i = idx & 15;
            const float inv = __builtin_exp2f(-(float)i * (13.287712379549449f / 16.0f));
            const float angf = (float)pos * inv; const double ang = (double)angf;
            const double twopi = 6.283185307179586476925287; const double r = ang - twopi * __builtin_rint(ang / twopi);
            const double r2 = r * r; double cterm = 1.0, sterm = r, cs = 1.0, sn = r;
            for (int k = 1; k <= 14; ++k) { cterm *= -r2 / (double)((2 * k - 1) * (2 * k)); sterm *= -r2 / (double)((2 * k) * (2 * k + 1)); cs += cterm; sn += sterm; }
            rope[idx * 2] = (float)cs; rope[idx * 2 + 1] = (float)sn; }
        for (int idx = tid; idx < 2 * DRNN; idx += 512) { const float lm = p->lam[idx]; nls[idx] = -8.0f * log1pf(__expf(-lm)); }
    }
    LAS float* scr = (LAS float*)(lds + wave * 16384);
    const int gw = blockIdx.x * 8 + wave, NGW = gridDim.x * 8;
    constexpr int I_QKV = 16 * 48, I_O = 16 * 32, I_1 = 16 * 128, I_2 = 64 * 32, I_IN = 16 * 80, I_OUT = 20 * 32, I_G = 40 * 16;
    constexpr int NITEMS = I_QKV + I_O + 2 * I_1 + 2 * I_2 + I_IN + I_OUT + I_G;
    for (int it = gw; it < NITEMS; it += NGW) {
        int r = it;
        if (r < I_QKV) { transpose_plain(p->w_qkv, 1024, NQKV, (bf16_t*)(ws + WS_WQKV), r, scr, lane); continue; } r -= I_QKV;
        if (r < I_O) { transpose_plain(p->w_o, 1024, 1024, (bf16_t*)(ws + WS_WO), r, scr, lane); continue; } r -= I_O;
        if (r < 2 * I_1) { const int l = r / I_1; transpose_plain(p->mlp_w1 + (size_t)l * 1024 * DFF, 1024, DFF, (bf16_t*)(ws + WS_W1 + (size_t)l * 16 * MiB), r % I_1, scr, lane); continue; } r -= 2 * I_1;
        if (r < 2 * I_2) { const int l = r / I_2; transpose_plain(p->mlp_w2 + (size_t)l * 1024 * DFF, DFF, 1024, (bf16_t*)(ws + WS_W2 + (size_t)l * 16 * MiB), r % I_2, scr, lane); continue; } r -= 2 * I_2;
        if (r < I_IN) { transpose_plain(p->w_in, 1024, 2 * DRNN, (bf16_t*)(ws + WS_WIN), r, scr, lane); continue; } r -= I_IN;
        if (r < I_OUT) { transpose_plain(p->w_out, DRNN, 1024, (bf16_t*)(ws + WS_WOUT), r, scr, lane); continue; } r -= I_OUT;
        {
            const int sm = r >> 4, ii = r & 15, kb = ii >> 2, nb = ii & 3;
            const int chalf = sm & 1, blk = (sm >> 1) % 5, dg = (sm >> 1) / 5, gate = dg & 1, dir = dg >> 1;
            const float* W = (gate ? p->w_i : p->w_a) + (size_t)(dir * 5 + blk) * 256 * 256;
            const int dst_row0 = ((dir * 5 + blk) * 2 + chalf) * 256 + gate * 128 + nb * 32;
            transpose_item(W, 256, (bf16_t*)(ws + WS_WG), 256, 64 * kb, chalf * 128 + nb * 32, dst_row0, scr, lane);
        }
    }
}

template <bool HAS_Y, bool HAS_H>
__device__ __forceinline__ void row_phase(const float* xin_lat, const float* xin_ctx, float* xout_lat, float* xout_ctx, const bf16_t* Y, const bf16_t* SLAB, bf16_t* H,
                                          const float* gy, const float* gh, const float* mod_g, int gate_idx, const float* mod_h, int shift_idx, int scale_idx,
                                          int nrows, int gw, int ngw, int lane) {
    for (int row = gw; row < nrows; row += ngw) {
        const bool lat = row < ML; const int who = lat ? (row >> 11) : 8;
        const float* xi = lat ? xin_lat + (size_t)row * DM : xin_ctx + (size_t)(row - ML) * DM;
        f32x4 xv[4];
#pragma unroll
        for (int j = 0; j < 4; ++j) xv[j] = *(const f32x4*)(xi + lane * 4 + 256 * j);
        if (HAS_Y) {
            f32x4 yv[4]; float s = 0.f;
#pragma unroll
            for (int j = 0; j < 4; ++j) {
                if (SLAB != nullptr && !lat) { const bf16_t* yp = SLAB + (size_t)(row - ML) * DM + lane * 4 + 256 * j;
                    yv[j] = (bf4_to_f32(*(const u32x2*)yp) + bf4_to_f32(*(const u32x2*)(yp + (size_t)MC * DM))) + (bf4_to_f32(*(const u32x2*)(yp + (size_t)2 * MC * DM)) + bf4_to_f32(*(const u32x2*)(yp + (size_t)3 * MC * DM))); }
                else yv[j] = bf4_to_f32(*(const u32x2*)(Y + (size_t)row * DM + lane * 4 + 256 * j));
                s += (yv[j][0] * yv[j][0] + yv[j][1] * yv[j][1]) + (yv[j][2] * yv[j][2] + yv[j][3] * yv[j][3]); }
            const float rstd = 1.0f / sqrtf(wave_sum(s) * (1.0f / DM) + EPS);
            float* xo = lat ? xout_lat + (size_t)row * DM : xout_ctx + (size_t)(row - ML) * DM;
#pragma unroll
            for (int j = 0; j < 4; ++j) { const int col = lane * 4 + 256 * j;
                const f32x4 g = *(const f32x4*)(gy + col), gt = *(const f32x4*)(mod_g + (size_t)who * 6144 + gate_idx * 1024 + col);
                xv[j] = xv[j] + gt * (yv[j] * rstd * g);
                *(f32x4*)(xo + col) = xv[j]; }
        }
        if (HAS_H) {
            float s = 0.f;
#pragma unroll
            for (int j = 0; j < 4; ++j) s += (xv[j][0] * xv[j][0] + xv[j][1] * xv[j][1]) + (xv[j][2] * xv[j][2] + xv[j][3] * xv[j][3]);
            const float rstd = 1.0f / sqrtf(wave_sum(s) * (1.0f / DM) + EPS);
#pragma unroll
            for (int j = 0; j < 4; ++j) { const int col = lane * 4 + 256 * j;
                const f32x4 g = *(const f32x4*)(gh + col), sh = *(const f32x4*)(mod_h + (size_t)who * 6144 + shift_idx * 1024 + col), sc = *(const f32x4*)(mod_h + (size_t)who * 6144 + scale_idx * 1024 + col);
                const f32x4 hv = (xv[j] * rstd * g) * (1.0f + sc) + sh;
                *(u32x2*)(H + (size_t)row * DM + col) = f32_to_bf4(hv); }
        }
    }
}

__device__ __forceinline__ void attn_phase(LAS unsigned char* lds, const bf16_t* Q, bf16_t* O, const bf16_t* Kb, const bf16_t* VT, const bf16_t* VTC, const float* sink, int tid, int lane, int wave) {
    constexpr int PITCH = 72;
    LAS bf16_t* Ks = (LAS bf16_t*)lds;
    LAS bf16_t* Vs = (LAS bf16_t*)(lds + 2 * 64 * PITCH * 2);
    const int lr = lane & 15, lg = lane >> 4;
    const int skey = tid >> 3, spiece = tid & 7;
    for (int unit = blockIdx.x; unit < 576; unit += gridDim.x) {
        int b, kvh, qrow0, qblk, nloc, lt0; bool latu = unit < 512;
        if (latu) { b = unit >> 6; const int rem = unit & 63; qblk = rem >> 2; kvh = rem & 3; qrow0 = b * SEQ + qblk * 128; lt0 = (qblk == 0) ? 2 : 0; nloc = ((qblk == 15) ? 4 : 6) - lt0; }
        else { const int cu = unit - 512; b = cu >> 3; kvh = (cu & 7) >> 1; qblk = 0; qrow0 = ML + b * CTX + (cu & 1) * 128; lt0 = 0; nloc = 0; }
        const int nT = nloc + 4;
        const int head = kvh * 4 + (wave >> 1);
        const int qr0 = qrow0 + (wave & 1) * 64;
        const bf16_t* qbase = Q + (size_t)qr0 * 1024 + head * 64;
        bf16_t* obase = O + (size_t)qr0 * 1024 + head * 64;
        LAS unsigned char* Qs = lds + 40960 + wave * 8192;
#pragma unroll
        for (int qt = 0; qt < 4; ++qt)
#pragma unroll
            for (int dh = 0; dh < 2; ++dh) *(LAS bf16x8*)(Qs + (qt * 2 + dh) * 1024 + lane * 16) = *(const bf16x8*)(qbase + (unsigned)((qt * 16 + lr) * 1024 + dh * 32 + lg * 8));
        f32x4 o[4][4];
#pragma unroll
        for (int qt = 0; qt < 4; ++qt)
#pragma unroll
            for (int dt = 0; dt < 4; ++dt) o[qt][dt] = (f32x4){0.f, 0.f, 0.f, 0.f};
        float m2[4], ls[4];
        { const float sk = sink[head] * LOG2E;
#pragma unroll
          for (int qt = 0; qt < 4; ++qt) { m2[qt] = sk; ls[qt] = (lg == 0) ? 1.0f : 0.0f; } }
        u32x4 kreg, vreg;
#define ATT_LOAD(j) do { const int _j = (j); if (_j < nloc) { const int tok0 = (qblk - 1) * 128 + (lt0 + _j) * 64; \
                const bf16_t* kb_ = Kb + (size_t)(b * SEQ + tok0) * 256 + kvh * 64; const bf16_t* vb_ = VT + (size_t)(b * 4 + kvh) * 64 * SEQ + tok0; \
                kreg = *(const u32x4*)(kb_ + (unsigned)(skey * 256 + spiece * 8)); vreg = *(const u32x4*)(vb_ + (unsigned)(skey * SEQ + spiece * 8)); } \
            else { const int tok0 = (_j - nloc) * 64; \
                const bf16_t* kb_ = Kb + (size_t)(ML + b * CTX + tok0) * 256 + kvh * 64; const bf16_t* vb_ = VTC + (size_t)(b * 4 + kvh) * 64 * CTX + tok0; \
                kreg = *(const u32x4*)(kb_ + (unsigned)(skey * 256 + spiece * 8)); vreg = *(const u32x4*)(vb_ + (unsigned)(skey * CTX + spiece * 8)); } } while (0)
#define ATT_STORE(buf) do { *(LAS u32x4*)(Ks + (buf) * 64 * PITCH + skey * PITCH + spiece * 8) = kreg; *(LAS u32x4*)(Vs + (buf) * 64 * PITCH + skey * PITCH + spiece * 8) = vreg; } while (0)
        __syncthreads();
        ATT_LOAD(0); ATT_STORE(0);
        __syncthreads();
        for (int j = 0; j < nT; ++j) {
            const int buf = j & 1;
            if (j + 1 < nT) ATT_LOAD(j + 1);
            const LAS bf16_t* Kt = Ks + buf * 64 * PITCH; const LAS bf16_t* Vt = Vs + buf * 64 * PITCH;
            int mmode = 0, ktok0 = 0;
            if (j < nloc) { const int lt = lt0 + j; ktok0 = (qblk - 1) * 128 + lt * 64; mmode = (lt < 2) ? 1 : ((lt >= 4) ? 2 : 0); }
            bf16x8 kf[4][2];
#pragma unroll
            for (int ks = 0; ks < 4; ++ks)
#pragma unroll
                for (int dh = 0; dh < 2; ++dh) kf[ks][dh] = *(const LAS bf16x8*)(Kt + (ks * 16 + lr) * PITCH + dh * 32 + lg * 8);
#pragma unroll
            for (int hq = 0; hq < 2; ++hq) {
            bf16x8 pb[2][2];
#pragma unroll
            for (int q2 = 0; q2 < 2; ++q2) {
                const int qt = hq * 2 + q2;
                f32x4 s[4];
                const bf16x8 qf0 = *(const LAS bf16x8*)(Qs + (qt * 2 + 0) * 1024 + lane * 16), qf1 = *(const LAS bf16x8*)(Qs + (qt * 2 + 1) * 1024 + lane * 16);
#pragma unroll
                for (int ks = 0; ks < 4; ++ks) { s[ks] = __builtin_amdgcn_mfma_f32_16x16x32_bf16(kf[ks][0], qf0, (f32x4){0.f, 0.f, 0.f, 0.f}, 0, 0, 0);
                    s[ks] = __builtin_amdgcn_mfma_f32_16x16x32_bf16(kf[ks][1], qf1, s[ks], 0, 0, 0); }
                if (mmode) { const int qp = qblk * 128 + (wave & 1) * 64 + qt * 16 + lr;
#pragma unroll
                    for (int ks = 0; ks < 4; ++ks)
#pragma unroll
                        for (int jj = 0; jj < 4; ++jj) { const int kp = ktok0 + ks * 16 + lg * 4 + jj; const bool ok = (mmode == 1) ? (kp >= qp - 128) : (kp <= qp + 128); s[ks][jj] = ok ? s[ks][jj] : -1e30f; } }
                float mx = -3e38f;
#pragma unroll
                for (int ks = 0; ks < 4; ++ks) mx = fmaxf(mx, fmaxf(fmaxf(s[ks][0], s[ks][1]), fmaxf(s[ks][2], s[ks][3])));
                mx = fmaxf(mx, __shfl_xor(mx, 16)); mx = fmaxf(mx, __shfl_xor(mx, 32));
                const float mnew = fmaxf(m2[qt], mx * LOG2E);
                const float alpha = __builtin_amdgcn_exp2f(m2[qt] - mnew);
                m2[qt] = mnew;
                float rs = 0.f;
#pragma unroll
                for (int ks = 0; ks < 4; ++ks)
#pragma unroll
                    for (int jj = 0; jj < 4; ++jj) { const float pv = __builtin_amdgcn_exp2f(s[ks][jj] * LOG2E - mnew); s[ks][jj] = pv; rs += pv; }
                ls[qt] = ls[qt] * alpha + rs;
#pragma unroll
                for (int dt = 0; dt < 4; ++dt) o[qt][dt] = o[qt][dt] * alpha;
#pragma unroll
                for (int c2 = 0; c2 < 2; ++c2) { u32x4 w; w.x = cvt_pk_bf16(s[2 * c2][0], s[2 * c2][1]); w.y = cvt_pk_bf16(s[2 * c2][2], s[2 * c2][3]); w.z = cvt_pk_bf16(s[2 * c2 + 1][0], s[2 * c2 + 1][1]); w.w = cvt_pk_bf16(s[2 * c2 + 1][2], s[2 * c2 + 1][3]);
                    pb[q2][c2] = __builtin_bit_cast(bf16x8, w); }
            }
#pragma unroll
            for (int c2 = 0; c2 < 2; ++c2)
#pragma unroll
                for (int dt = 0; dt < 4; ++dt) {
                    const LAS bf16_t* vp = Vt + (dt * 16 + lr) * PITCH + c2 * 32 + lg * 4;
                    const u32x2 v0 = *(const LAS u32x2*)vp, v1 = *(const LAS u32x2*)(vp + 16);
                    const u32x4 vv = {v0.x, v0.y, v1.x, v1.y};
                    const bf16x8 vf = __builtin_bit_cast(bf16x8, vv);
#pragma unroll
                    for (int q2 = 0; q2 < 2; ++q2) o[hq * 2 + q2][dt] = __builtin_amdgcn_mfma_f32_16x16x32_bf16(vf, pb[q2][c2], o[hq * 2 + q2][dt], 0, 0, 0);
                }
            }
            if (j + 1 < nT) ATT_STORE(buf ^ 1);
            __syncthreads();
        }
#pragma unroll
        for (int qt = 0; qt < 4; ++qt) {
            float l = ls[qt]; l += __shfl_xor(l, 16); l += __shfl_xor(l, 32);
            const float inv = 1.0f / l;
            int lro = lr * 1024 + lg * 4; asm volatile("" : "+v"(lro));
            bf16_t* op = obase + (unsigned)(qt * 16 * 1024 + lro);
#pragma unroll
            for (int dt = 0; dt < 4; ++dt) *(u32x2*)(op + dt * 16) = f32_to_bf4(o[qt][dt] * inv);
        }
    }
#undef ATT_LOAD
#undef ATT_STORE
}

__device__ __forceinline__ void conv_phase(const bf16_t* R, bf16_t* U, const float* cw, const float* cb, int gtid, int nthreads) {
    for (int idx = gtid; idx < MT * 160; idx += nthreads) {
        const int row = idx / 160, ch = (idx % 160) * 8;
        int t, T; if (row < ML) { t = row & 2047; T = SEQ; } else { t = (row - ML) & 255; T = CTX; }
        float acc[8];
        { const f32x4 b0 = *(const f32x4*)(cb + ch), b1 = *(const f32x4*)(cb + ch + 4); acc[0] = b0[0]; acc[1] = b0[1]; acc[2] = b0[2]; acc[3] = b0[3]; acc[4] = b1[0]; acc[5] = b1[1]; acc[6] = b1[2]; acc[7] = b1[3]; }
#pragma unroll
        for (int tap = 0; tap < 4; ++tap) { const int tt = t + tap - 2;
            if (tt >= 0 && tt < T) { const u32x4 rv = *(const u32x4*)(R + (size_t)(row + tap - 2) * DRNN + ch);
                const f32x4 w0 = *(const f32x4*)(cw + tap * DRNN + ch), w1 = *(const f32x4*)(cw + tap * DRNN + ch + 4);
                acc[0] += w0[0] * bf_lo(rv.x); acc[1] += w0[1] * bf_hi(rv.x); acc[2] += w0[2] * bf_lo(rv.y); acc[3] += w0[3] * bf_hi(rv.y);
                acc[4] += w1[0] * bf_lo(rv.z); acc[5] += w1[1] * bf_hi(rv.z); acc[6] += w1[2] * bf_lo(rv.w); acc[7] += w1[3] * bf_hi(rv.w); } }
        u32x4 o; o.x = cvt_pk_bf16(acc[0], acc[1]); o.y = cvt_pk_bf16(acc[2], acc[3]); o.z = cvt_pk_bf16(acc[4], acc[5]); o.w = cvt_pk_bf16(acc[6], acc[7]);
        *(u32x4*)(U + (size_t)row * DRNN + ch) = o;
    }
}
__device__ __forceinline__ int scan_row0(int bl, int c) { return (c < 8) ? (8192 + bl * CTX + c * 32) : (bl * SEQ + (c - 8) * 32); }
__device__ __forceinline__ void scanA_phase(const bf16_t* LA, const bf16_t* BX, float* SP, float* SH, int gtid, int nthreads) {
    for (int idx = gtid; idx < 2 * 4 * 72 * 640; idx += nthreads) {
        const int cp = idx % 640, r1 = idx / 640, c = r1 % 72, r2 = r1 / 72, bl = r2 & 3, dir = r2 >> 2;
        const int row0 = scan_row0(bl, c);
        const size_t base = ((size_t)dir * 9216 + row0) * DRNN + cp * 2;
        float P0 = 1.f, P1 = 1.f, H0 = 0.f, H1 = 0.f;
#pragma unroll 8
        for (int i = 0; i < 32; ++i) { const int ii = dir ? (31 - i) : i;
            const unsigned lw = *(const unsigned*)(LA + base + (size_t)ii * DRNN), bw = *(const unsigned*)(BX + base + (size_t)ii * DRNN);
            const float a0 = __expf(bf_lo(lw)), a1 = __expf(bf_hi(lw));
            P0 *= a0; P1 *= a1; H0 = a0 * H0 + bf_lo(bw); H1 = a1 * H1 + bf_hi(bw); }
        const size_t so = ((size_t)(dir * 4 + bl) * 72 + c) * DRNN + cp * 2;
        *(f32x2*)(SP + so) = (f32x2){P0, P1}; *(f32x2*)(SH + so) = (f32x2){H0, H1};
    }
}
__device__ __forceinline__ void scanB_phase(const float* SP, const float* SH, float* CIN, int gtid, int nthreads) {
    for (int idx = gtid; idx < 2 * 4 * DRNN; idx += nthreads) {
        const int ch = idx % DRNN, r = idx / DRNN, bl = r & 3, dir = r >> 2;
        const size_t base = ((size_t)(dir * 4 + bl) * 72) * DRNN + ch;
        float carry = 0.f;
#pragma unroll 1
        for (int s0 = 0; s0 < 72; s0 += 24) {
            float pv[24], hv[24];
#pragma unroll
            for (int s = 0; s < 24; ++s) { const int sq = s0 + s; const int c = dir ? (sq < 8 ? 7 - sq : 79 - sq) : sq; pv[s] = SP[base + (size_t)c * DRNN]; hv[s] = SH[base + (size_t)c * DRNN]; }
#pragma unroll
            for (int s = 0; s < 24; ++s) { const int sq = s0 + s; const int c = dir ? (sq < 8 ? 7 - sq : 79 - sq) : sq; CIN[base + (size_t)c * DRNN] = carry; carry = pv[s] * carry + hv[s]; }
        }
    }
}
__device__ __forceinline__ void scanC_phase(const bf16_t* LA, const bf16_t* BX, const float* CIN, bf16_t* REC, int half, int gtid, int nthreads) {
    for (int idx = gtid; idx < 4 * 64 * 640; idx += nthreads) {
        const int cp = idx % 640, r1 = idx / 640, lc = r1 & 63, bl = r1 >> 6;
        const int row0 = bl * SEQ + lc * 32;
        const size_t b0 = ((size_t)row0) * DRNN + cp * 2, b1 = ((size_t)9216 + row0) * DRNN + cp * 2;
        const f32x2 cf = *(const f32x2*)(CIN + ((size_t)(0 * 4 + bl) * 72 + 8 + lc) * DRNN + cp * 2);
        const f32x2 cbk = *(const f32x2*)(CIN + ((size_t)(1 * 4 + bl) * 72 + 8 + lc) * DRNN + cp * 2);
        float hf0[32], hf1[32];
        float h0 = cf[0], h1 = cf[1];
#pragma unroll
        for (int i = 0; i < 32; ++i) { const unsigned lw = *(const unsigned*)(LA + b0 + (size_t)i * DRNN), bw = *(const unsigned*)(BX + b0 + (size_t)i * DRNN);
            h0 = __expf(bf_lo(lw)) * h0 + bf_lo(bw); h1 = __expf(bf_hi(lw)) * h1 + bf_hi(bw); hf0[i] = h0; hf1[i] = h1; }
        h0 = cbk[0]; h1 = cbk[1];
        bf16_t* out = REC + ((size_t)(half * 4 + bl) * SEQ + lc * 32) * DRNN + cp * 2;
#pragma unroll
        for (int i = 31; i >= 0; --i) { const unsigned lw = *(const unsigned*)(LA + b1 + (size_t)i * DRNN), bw = *(const unsigned*)(BX + b1 + (size_t)i * DRNN);
            h0 = __expf(bf_lo(lw)) * h0 + bf_lo(bw); h1 = __expf(bf_hi(lw)) * h1 + bf_hi(bw);
            *(unsigned*)(out + (size_t)i * DRNN) = cvt_pk_bf16(hf0[i] + h0, hf1[i] + h1); }
    }
}

#ifndef PH_MASK
#define PH_MASK 0xFFFFFFFFu
#endif
#define PH(k) ((PH_MASK >> (k)) & 1u)
#ifndef REP_MASK
#define REP_MASK 0u
#endif
#define REP_BEGIN(k) _Pragma("unroll 1") for (int rep_ = 0; rep_ < (((REP_MASK >> (k)) & 1u) ? 2 : 1); ++rep_) {
#define REP_END }
__device__ __forceinline__ ParamsK kparams() { ParamsK q = (ParamsK)__builtin_amdgcn_kernarg_segment_ptr(); asm volatile("" : "+s"(q)); return q; }
#define PHASE_BEGIN ParamsK kp = kparams(); unsigned char* ws = kp->ws; (void)ws; \
    int tid = threadIdx.x; asm volatile("" : "+v"(tid)); const int lane = tid & 63, wave = __builtin_amdgcn_readfirstlane(tid >> 6); \
    const int gw = bid * 8 + wave, gtid = bid * 512 + tid; (void)lane; (void)gw; (void)gtid;
#define P_MOD0 ((float*)(ws + WS_MOD))
#define P_MOD1 ((float*)(ws + WS_MOD) + 9 * 6144)
#define P_CTXRES ((float*)(ws + WS_CTXRES))
#define P_H ((bf16_t*)(ws + WS_H))
#define P_SLAB ((bf16_t*)(ws + WS_SLAB))
#define P_Q ((bf16_t*)(ws + WS_Q))
#define P_O ((bf16_t*)(ws + WS_O))
#define P_K ((bf16_t*)(ws + WS_K))
#define P_VT ((bf16_t*)(ws + WS_VT))
#define P_VTC ((bf16_t*)(ws + WS_VTC))
#define P_ACT ((bf16_t*)(ws + WS_ACT))
#define P_U ((bf16_t*)(ws + WS_U))
#define P_LA ((bf16_t*)(ws + WS_LA))
#define P_BX ((bf16_t*)(ws + WS_BX))
#define P_RPRE ((bf16_t*)(ws + WS_RPRE))
#define P_SP ((float*)(ws + WS_SP))
#define P_SH ((float*)(ws + WS_SH))
#define P_CIN ((float*)(ws + WS_CIN))
#define G0 (kp->norm_g)
#define G1 (kp->norm_g + 4 * DM)

__global__ void __launch_bounds__(512, 2) fwd_megakernel(Params p) {
    extern __shared__ __attribute__((aligned(16))) unsigned char lds_raw[];
    LAS unsigned char* lds = (LAS unsigned char*)lds_raw;
    const int G = gridDim.x, bid = blockIdx.x;
    const int ngw = G * 8, nthreads = G * 512;
    using namespace pg8;
    if (threadIdx.x < 4) ((volatile LAS unsigned*)(lds + 132096))[threadIdx.x] = 0u;
    __syncthreads();
    XcdBarrier xbar = xcd_barrier_post((unsigned*)(p.ws + WS_BAR), (volatile LAS unsigned*)(lds + 132096));
    if (PH(0)) { PHASE_BEGIN prologue(kp, lds, tid, lane, wave); }
    xcd_barrier(xbar);
#ifdef EXTRA_SYNCS
#pragma unroll 1
    for (int es = 0; es < EXTRA_SYNCS; ++es) xcd_barrier(xbar);
#endif
    REP_BEGIN(1)
    if (PH(1)) { PHASE_BEGIN row_phase<false, true>(kp->x, kp->ctx, nullptr, nullptr, nullptr, nullptr, P_H, nullptr, G0, nullptr, 0, P_MOD0, 0, 1, MT, gw, ngw, lane); }
    xcd_barrier(xbar);
    REP_END
    if (PH(2)) {
        PHASE_BEGIN
        Gemm g{P_H, (const bf16_t*)(ws + WS_WQKV), DM, DM, DM}; Sched S; S.init(MT / 256, NQKV / 256, G, bid);
        EpiQKV E{P_Q, P_K, P_VT, P_VTC, (const float*)(ws + WS_ROPE)};
        gemm_phase<EpiQKV, true, true>(lds, g, S, E);
    }
    xcd_barrier(xbar);
    REP_BEGIN(3)
    if (PH(3)) { PHASE_BEGIN attn_phase(lds, P_Q, P_O, P_K, P_VT, P_VTC, kp->sink, tid, lane, wave); }
    xcd_barrier(xbar);
    REP_END
    if (PH(4)) {
        PHASE_BEGIN
        { Gemm g{P_O, (const bf16_t*)(ws + WS_WO), DM, DM, DM}; Sched S; S.init(ML / 256, DM / 256, G, bid);
          EpiPlain<0> E{P_H, DM};
          gemm_phase<EpiPlain<0>, true, true>(lds, g, S, E); }
        { Gemm g{P_O, (const bf16_t*)(ws + WS_WO), DM, DM, 256}; Sched S; S.init(8, 4 * 4, G, bid, 2, 256);
          EpiSlabCtx E{P_SLAB, 256};
          gemm_phase<EpiSlabCtx, true, true>(lds, g, S, E); }
    }
    xcd_barrier(xbar);
    if (PH(5)) { PHASE_BEGIN row_phase<true, true>(kp->x, kp->ctx, kp->out, P_CTXRES, P_H, P_SLAB, P_H, G0 + DM, G0 + 2 * DM, P_MOD0, 2, P_MOD0, 3, 4, MT, gw, ngw, lane); }
    xcd_barrier(xbar);
    if (PH(6)) {
        PHASE_BEGIN
        Gemm g{P_H, (const bf16_t*)(ws + WS_W1), DM, DM, DM}; Sched S; S.init(MT / 256, DFF / 256, G, bid);
        EpiPlain<1> E{P_ACT, DFF};
        gemm_phase<EpiPlain<1>, true, true>(lds, g, S, E);
    }
    xcd_barrier(xbar);
    if (PH(7)) {
        PHASE_BEGIN
        { Gemm g{P_ACT, (const bf16_t*)(ws + WS_W2), DFF, DFF, DFF}; Sched S; S.init(ML / 256, DM / 256, G, bid);
          EpiPlain<0> E{P_H, DM};
          gemm_phase<EpiPlain<0>, true, true>(lds, g, S, E); }
        { Gemm g{P_ACT, (const bf16_t*)(ws + WS_W2), DFF, DFF, 1024}; Sched S; S.init(8, 4 * 4, G, bid, 2, 1024);
          EpiSlabCtx E{P_SLAB, 1024};
          gemm_phase<EpiSlabCtx, true, true>(lds, g, S, E); }
    }
    xcd_barrier(xbar);
    if (PH(8)) { PHASE_BEGIN row_phase<true, true>(kp->out, P_CTXRES, kp->out, P_CTXRES, P_H, P_SLAB, P_H, G0 + 3 * DM, G1, P_MOD0, 5, P_MOD1, 0, 1, MT, gw, ngw, lane); }
    xcd_barrier(xbar);
    if (PH(9)) {
        PHASE_BEGIN
        Gemm g{P_H, (const bf16_t*)(ws + WS_WIN) + (size_t)DRNN * DM, DM, DM, DM}; Sched S; S.init(MT / 256, DRNN / 256, G, bid);
        EpiPlain<0> E{P_RPRE, DRNN};
        gemm_phase<EpiPlain<0>, true, true>(lds, g, S, E);
    }
    xcd_barrier(xbar);
    REP_BEGIN(10)
    if (PH(10)) { PHASE_BEGIN conv_phase(P_RPRE, P_U, kp->conv_w, kp->conv_b, gtid, nthreads); }
    xcd_barrier(xbar);
    REP_END
#pragma unroll 1
    for (int half = 0; half < 2; ++half) {
        REP_BEGIN(11)
        if (PH(11)) {
            PHASE_BEGIN
            Gemm g{P_U, (const bf16_t*)(ws + WS_WG), DRNN, 256, 256}; Sched S; S.init(36, 20, G, bid, 1, half);
            EpiGates E{P_U, P_LA, P_BX, kp->b_a, kp->b_i, (const float*)(ws + WS_NLS)};
            gemm_phase<EpiGates, true, true>(lds, g, S, E);
        }
        xcd_barrier(xbar);
        if (PH(12)) { PHASE_BEGIN scanA_phase(P_LA, P_BX, P_SP, P_SH, gtid, nthreads); }
        xcd_barrier(xbar);
        if (PH(13)) { PHASE_BEGIN scanB_phase(P_SP, P_SH, P_CIN, gtid, nthreads); }
        xcd_barrier(xbar);
        REP_END
        if (PH(14)) { PHASE_BEGIN scanC_phase(P_LA, P_BX, P_CIN, P_U, half, gtid, nthreads); }
        xcd_barrier(xbar);
    }
    if (PH(15)) {
        PHASE_BEGIN
        Gemm g{P_H, (const bf16_t*)(ws + WS_WIN), DM, DM, DM}; Sched S; S.init(ML / 256, DRNN / 256, G, bid);
        EpiGateMul E{P_U};
        gemm_phase<EpiGateMul, true, true>(lds, g, S, E);
    }
    xcd_barrier(xbar);
    if (PH(16)) {
        PHASE_BEGIN
        Gemm g{P_U, (const bf16_t*)(ws + WS_WOUT), DRNN, DRNN, DRNN}; Sched S; S.init(ML / 256, DM / 256, G, bid);
        EpiPlain<0> E{P_H, DM};
        gemm_phase<EpiPlain<0>, true, true>(lds, g, S, E);
    }
    xcd_barrier(xbar);
    if (PH(17)) { PHASE_BEGIN row_phase<true, true>(kp->out, P_CTXRES, kp->out, P_CTXRES, P_H, nullptr, P_H, G1 + DM, G1 + 2 * DM, P_MOD1, 2, P_MOD1, 3, 4, ML, gw, ngw, lane); }
    xcd_barrier(xbar);
    if (PH(18)) {
        PHASE_BEGIN
        Gemm g{P_H, (const bf16_t*)(ws + WS_W1 + 16 * MiB), DM, DM, DM}; Sched S; S.init(ML / 256, DFF / 256, G, bid);
        EpiPlain<1> E{P_ACT, DFF};
        gemm_phase<EpiPlain<1>, true, true>(lds, g, S, E);
    }
    xcd_barrier(xbar);
    if (PH(19)) {
        PHASE_BEGIN
        Gemm g{P_ACT, (const bf16_t*)(ws + WS_W2 + 16 * MiB), DFF, DFF, DFF}; Sched S; S.init(ML / 256, DM / 256, G, bid);
        EpiPlain<0> E{P_H, DM};
        gemm_phase<EpiPlain<0>, true, true>(lds, g, S, E);
    }
    xcd_barrier(xbar);
    if (PH(20)) { PHASE_BEGIN row_phase<true, false>(kp->out, P_CTXRES, kp->out, P_CTXRES, P_H, nullptr, nullptr, G1 + 3 * DM, nullptr, P_MOD1, 5, nullptr, 0, 0, ML, gw, ngw, lane); }
}

extern "C" void kernel_launch(void* const* d_in, const int* in_sizes, int n_in, void* d_out, int out_size, void* d_ws, size_t ws_size, hipStream_t stream) {
    static int grid_blocks = 0;
    if (grid_blocks == 0) {
        if (n_in != 21 || ws_size < WS_END) { fprintf(stderr, "kernel_launch: unexpected n_in %d / ws_size %zu\n", n_in, ws_size); grid_blocks = -1; return; }
        int dev = 0, cus = 0, per_cu = 0;
        hipGetDevice(&dev);
        hipDeviceGetAttribute(&cus, hipDeviceAttributeMultiprocessorCount, dev);
        if (hipFuncSetAttribute((const void*)fwd_megakernel, hipFuncAttributeMaxDynamicSharedMemorySize, LDS_BYTES) != hipSuccess) { fprintf(stderr, "hipFuncSetAttribute failed\n"); grid_blocks = -1; return; }
        if (hipOccupancyMaxActiveBlocksPerMultiprocessor(&per_cu, (const void*)fwd_megakernel, 512, LDS_BYTES) != hipSuccess || per_cu < 1) { fprintf(stderr, "occupancy query failed (%d)\n", per_cu); (void)hipGetLastError(); per_cu = 1; }
        grid_blocks = cus * 1;
    }
    if (grid_blocks < 0) return;
    Params p{};
    p.x = (const float*)d_in[0]; p.c = (const float*)d_in[1]; p.ctx = (const float*)d_in[2]; p.c_ctx = (const float*)d_in[3];
    p.ada_w = (const float*)d_in[4]; p.ada_b = (const float*)d_in[5]; p.norm_g = (const float*)d_in[6]; p.mlp_w1 = (const float*)d_in[7]; p.mlp_w2 = (const float*)d_in[8];
    p.w_qkv = (const float*)d_in[9]; p.w_o = (const float*)d_in[10]; p.sink = (const float*)d_in[11];
    p.w_in = (const float*)d_in[12]; p.conv_w = (const float*)d_in[13]; p.conv_b = (const float*)d_in[14]; p.w_a = (const float*)d_in[15]; p.b_a = (const float*)d_in[16];
    p.w_i = (const float*)d_in[17]; p.b_i = (const float*)d_in[18]; p.lam = (const float*)d_in[19]; p.w_out = (const float*)d_in[20];
    p.out = (float*)d_out; p.ws = (unsigned char*)d_ws;
    if (hipMemsetAsync((unsigned char*)d_ws + WS_BAR, 0, XCD_BAR_WORDS * 4, stream) != hipSuccess) { fprintf(stderr, "memset of barrier words failed\n"); return; }
    void* args[] = {&p};
    hipError_t e = hipLaunchCooperativeKernel((const void*)fwd_megakernel, dim3(grid_blocks), dim3(512), args, LDS_BYTES, stream);
    if (e != hipSuccess) fprintf(stderr, "cooperative launch failed: %s (grid %d)\n", hipGetErrorString(e), grid_blocks);
}
```

```cpp
#include <hip/hip_runtime.h>
#include <hip/hip_cooperative_groups.h>
#include <cstdio>
#include <cstdint>
namespace cg = cooperative_groups;

#define LAS __attribute__((address_space(3)))
typedef unsigned short bf16_t;
typedef short bf16x8 __attribute__((ext_vector_type(8)));
typedef float f32x4 __attribute__((ext_vector_type(4)));
typedef float f32x2 __attribute__((ext_vector_type(2)));
typedef unsigned u32x4 __attribute__((ext_vector_type(4)));
typedef unsigned u32x2 __attribute__((ext_vector_type(2)));

constexpr int DM = 1024, NB = 8, SEQ = 2048, CTX = 256;
constexpr int ML = NB * SEQ;
constexpr int MC = NB * CTX;
constexpr int MT = ML + MC;
constexpr int NQKV = 1536, DFF = 4096, DRNN = 1280;
constexpr float EPS = 1e-6f;
constexpr float LOG2E = 1.4426950408889634f;

constexpr size_t MiB = 1u << 20;
constexpr size_t WS_MOD = 0;
constexpr size_t WS_ROPE = 448 * 1024;
constexpr size_t WS_NLS = 460 * 1024;
constexpr size_t WS_BAR = 480 * 1024;
constexpr size_t WS_WQKV = 1 * MiB, WS_WO = 4 * MiB, WS_W1 = 6 * MiB, WS_W2 = 14 * MiB;
constexpr size_t WS_WIN = 38 * MiB, WS_WG = 43 * MiB, WS_WOUT = 46 * MiB;
constexpr size_t WS_CTXRES = 49 * MiB;
constexpr size_t WS_H = 57 * MiB;
constexpr size_t WS_R3 = 93 * MiB;
constexpr size_t WS_Q = WS_R3, WS_K = 129 * MiB, WS_VT = 138 * MiB, WS_VTC = 146 * MiB;
constexpr size_t WS_O = 150 * MiB;
constexpr size_t WS_ACT = WS_R3;
constexpr size_t WS_U = WS_R3;
constexpr size_t WS_RECF = 138 * MiB;
constexpr size_t WS_RECB = 178 * MiB;
constexpr size_t WS_LA = 138 * MiB;
constexpr size_t WS_BX = 183 * MiB;
constexpr size_t WS_RPRE = 138 * MiB;
constexpr size_t WS_SP = 228 * MiB, WS_SH = 231 * MiB, WS_CIN = 234 * MiB;
constexpr size_t WS_SLAB = 238 * MiB;
constexpr size_t WS_END = 256 * MiB;
constexpr int LDS_BYTES = 135168;

__device__ __forceinline__ unsigned f2bf(float f) { unsigned u = __builtin_bit_cast(unsigned, f); return (u + 0x7fffu + ((u >> 16) & 1u)) >> 16; }
__device__ __forceinline__ unsigned cvt_pk_bf16(float lo, float hi) { unsigned r; asm volatile("v_cvt_pk_bf16_f32 %0, %1, %2" : "=v"(r) : "v"(lo), "v"(hi)); return r; }
__device__ __forceinline__ float bf_lo(unsigned w) { return __builtin_bit_cast(float, w << 16); }
__device__ __forceinline__ float bf_hi(unsigned w) { return __builtin_bit_cast(float, w & 0xffff0000u); }
__device__ __forceinline__ f32x4 bf4_to_f32(u32x2 w) { return (f32x4){bf_lo(w.x), bf_hi(w.x), bf_lo(w.y), bf_hi(w.y)}; }
__device__ __forceinline__ u32x2 f32_to_bf4(f32x4 v) { u32x2 w; w.x = cvt_pk_bf16(v[0], v[1]); w.y = cvt_pk_bf16(v[2], v[3]); return w; }
__device__ __forceinline__ float wave_sum(float v) {
#pragma unroll
    for (int o = 1; o < 64; o <<= 1) v += __shfl_xor(v, o);
    return v;
}
__device__ __forceinline__ float fsigmoid(float x) { return __builtin_amdgcn_rcpf(1.0f + __expf(-x)); }

namespace pg8 {
constexpr int BM = 256, BK = 64, HALF = 128, HTB = HALF * BK * 2, STAGE_BYTES = 8 * HTB, NXCD = 8, WGM = 8;
__device__ __forceinline__ int lds_byte(int r, int c) { const int st = (r >> 4) * 2 + (c >> 5), rr = r & 15, cc = c & 31, ob = rr * 64 + cc * 2; return st * 1024 + (ob ^ (((ob >> 9) & 1) << 5)); }
__device__ __forceinline__ void stage_rc(int b, int& R, int& C) { const int st = b / 1024, sb = b % 1024, swz = sb ^ (((sb >> 9) & 1) << 5); R = (st >> 1) * 16 + swz / 64; C = (st & 1) * 32 + (swz % 64) / 2; }

struct Unit { int pm, pn, koff, po, kboff; };
struct Gemm { const bf16_t* A; const bf16_t* Bt; int lda, ldb, K; int rev = 0; };

struct Sched {
    int nM, nN, nwg, G, c, mode, half;
    __device__ void init(int nM_, int nN_, int G_, int c_, int mode_ = 0, int half_ = 0) { nM = nM_; nN = nN_; nwg = nM * nN; G = G_; c = c_; mode = mode_; half = half_; }
    __device__ bool next(int i, Unit& u) const {
        if (mode == 3) {
            if (c >= 160 || i >= 9) return false;
            const int chalf = c & 1, dir = (c >> 1) & 1, bb = c >> 2, blk = bb % 5, b = bb / 5;
            u.pm = (i == 0) ? 64 + b : (dir ? b * 8 + (8 - i) : b * 8 + (i - 1));
            u.pn = (dir * 5 + blk) * 2 + chalf; u.koff = blk * 256; u.kboff = 0; u.po = i;
            return true;
        }
        const long L = (long)i * G + c; if (L >= nwg) return false;
        int wgid = (int)L; { const int q = nwg / NXCD, r = nwg % NXCD, xcd = wgid % NXCD, off = wgid / NXCD; wgid = (xcd < r ? xcd * (q + 1) : r * (q + 1) + (xcd - r) * q) + off; }
        const int nig = WGM * nN, gid = wgid / nig, fm = gid * WGM, gsz = (nM - fm) < WGM ? (nM - fm) : WGM;
        const int pmi = fm + ((wgid % nig) % gsz), pn = (wgid % nig) / gsz;
        u.pm = pmi; u.pn = pn; u.koff = 0; u.po = pmi; u.kboff = 0;
        if (mode == 2) { u.pm = 64 + pmi; u.pn = pn & 3; u.koff = (pn >> 2) * half; u.kboff = u.koff; }
        if (mode == 1) { u.pm = pmi < 32 ? 32 * half + pmi : 64 + 4 * half + (pmi - 32); u.koff = ((pn >> 1) % 5) * 256; }
        return true;
    }
};

template <class Epi, bool ALIGN_EPI, bool SP2>
__device__ __forceinline__ void gemm_phase(LAS unsigned char* lds, const Gemm g, const Sched& S, const Epi& E) {
    int tid = threadIdx.x; asm volatile("" : "+v"(tid));
    const int wid = __builtin_amdgcn_readfirstlane(tid >> 6), lane = tid & 63, wr = wid >> 2, wc = wid & 3, fr = lane & 15, fq = lane >> 4;
    const int K = g.K, nt = K / BK;
    unsigned voffA[2], voffB[2];
#pragma unroll
    for (int i = 0; i < 2; ++i) { int R, C; stage_rc(tid * 16 + i * 8192, R, C);
        voffA[i] = (unsigned)((g.rev ? 127 - R : R) * g.lda + C) * 2u; voffB[i] = (unsigned)(R * g.ldb + C) * 2u; }
    const size_t kstep = (size_t)(BK * 2);
    const long hstepA = g.rev ? -(long)HALF * g.lda * 2 : (long)HALF * g.lda * 2; const size_t hstepB = (size_t)HALF * g.ldb * 2;
    const size_t revoff = g.rev ? (size_t)HALF * g.lda * 2 : 0;
    const unsigned ldsw = (unsigned)wid * 1024u;
    const int aoff = lds_byte(wr * 64 + fr, fq * 8), boff = lds_byte(wc * 32 + fr, fq * 8);
#define PG8_SA(b, h) (((b) * 2 + (h)) * HTB)
#define PG8_SB(b, h) ((4 + (b) * 2 + (h)) * HTB)
#define PG8_STAGE(bufoff, gbase, voff) do { _Pragma("unroll") for (int _i = 0; _i < 2; ++_i) \
        __builtin_amdgcn_global_load_lds((const unsigned*)((const char*)(gbase) + (voff)[_i]), (LAS unsigned*)(lds + (bufoff) + ldsw + _i * 8192), 16, 0, 0); } while (0)
#define PG8_LDA(dst, b, h) do { _Pragma("unroll") for (int m = 0; m < 4; ++m) _Pragma("unroll") for (int k = 0; k < 2; ++k) dst[m][k] = *(const LAS bf16x8*)(lds + PG8_SA(b, h) + aoff + m * 2048 + k * 1024); } while (0)
#define PG8_LDB(dst, b, h) do { _Pragma("unroll") for (int n = 0; n < 2; ++n) _Pragma("unroll") for (int k = 0; k < 2; ++k) dst[n][k] = *(const LAS bf16x8*)(lds + PG8_SB(b, h) + boff + n * 2048 + k * 1024); } while (0)
#define PG8_MMA(ai, bj, At, Bt) do { __builtin_amdgcn_s_setprio(1); _Pragma("unroll") for (int m = 0; m < 4; ++m) _Pragma("unroll") for (int n = 0; n < 2; ++n) _Pragma("unroll") for (int k = 0; k < 2; ++k) \
        acc[ai][bj][m][n] = __builtin_amdgcn_mfma_f32_16x16x32_bf16(Bt[n][k], At[m][k], acc[ai][bj][m][n], 0, 0, 0); __builtin_amdgcn_s_setprio(0); } while (0)
#define PG8_WAIT_V(n) asm volatile("s_waitcnt vmcnt(" #n ")" ::: "memory")
#define PG8_WAIT_L(n) asm volatile("s_waitcnt lgkmcnt(" #n ")" ::: "memory")
#define PG8_BAR __builtin_amdgcn_s_barrier()
#define PG8_SCHED __builtin_amdgcn_sched_barrier(0)
    Unit cur, nxt; int ui = 0;
    if (!S.next(0, cur)) return;
    f32x4 acc[2][2][4][2];
#pragma unroll
    for (int a = 0; a < 2; ++a)
#pragma unroll
        for (int b = 0; b < 2; ++b)
#pragma unroll
            for (int m = 0; m < 4; ++m)
#pragma unroll
                for (int n = 0; n < 2; ++n) acc[a][b][m][n] = (f32x4){0.f, 0.f, 0.f, 0.f};
    bf16x8 At[4][2], B0[2][2], B1[2][2];
    const char* cA = (const char*)g.A + ((size_t)cur.pm * BM * g.lda + cur.koff) * 2 + revoff; const char* cB = (const char*)g.Bt + ((size_t)cur.pn * BM * g.ldb + cur.kboff) * 2;
    if constexpr (SP2) {
        PG8_STAGE(PG8_SB(0, 0), cB, voffB); PG8_STAGE(PG8_SB(0, 1), cB + hstepB, voffB); PG8_STAGE(PG8_SA(0, 0), cA, voffA); PG8_STAGE(PG8_SA(0, 1), cA + hstepA, voffA);
        if (wr == 1) PG8_BAR;
        PG8_WAIT_V(2); PG8_BAR;
        PG8_STAGE(PG8_SB(1, 0), cB + kstep, voffB); PG8_STAGE(PG8_SA(1, 0), cA + kstep, voffA); PG8_STAGE(PG8_SB(1, 1), cB + hstepB + kstep, voffB);
        PG8_WAIT_V(6); PG8_BAR;
    } else {
        PG8_STAGE(PG8_SB(0, 0), cB, voffB); PG8_STAGE(PG8_SA(0, 0), cA, voffA); PG8_STAGE(PG8_SB(0, 1), cB + hstepB, voffB); PG8_STAGE(PG8_SA(0, 1), cA + hstepA, voffA);
        if (wr == 1) PG8_BAR;
        PG8_WAIT_V(4); PG8_BAR;
        PG8_STAGE(PG8_SB(1, 0), cB + kstep, voffB); PG8_STAGE(PG8_SA(1, 0), cA + kstep, voffA); PG8_STAGE(PG8_SB(1, 1), cB + hstepB + kstep, voffB);
        PG8_WAIT_V(6); PG8_BAR;
    }
    for (;;) {
        const bool has_next = S.next(ui + 1, nxt);
        const char* nA = has_next ? (const char*)g.A + ((size_t)nxt.pm * BM * g.lda + nxt.koff) * 2 + revoff : cA;
        const char* nB = has_next ? (const char*)g.Bt + ((size_t)nxt.pn * BM * g.ldb + nxt.kboff) * 2 : cB;
#pragma unroll 1
        for (int t = 0; t < nt; t += 2) {
            const bool last = (t == nt - 2);
            const char* a1 = cA + (size_t)(t + 1) * kstep;
            const char* a2 = last ? nA : cA + (size_t)(t + 2) * kstep; const char* b2 = last ? nB : cB + (size_t)(t + 2) * kstep;
            const char* a3 = a2 + kstep; const char* b3 = b2 + kstep;
            if constexpr (SP2) {
            PG8_LDB(B0, 0, 0); PG8_LDB(B1, 0, 1); PG8_SCHED; PG8_LDA(At, 0, 0); PG8_STAGE(PG8_SA(1, 1), a1 + hstepA, voffA);
            PG8_WAIT_V(8); PG8_WAIT_L(0); PG8_BAR; PG8_MMA(0, 0, At, B0); PG8_MMA(0, 1, At, B1); PG8_BAR; PG8_SCHED;
            PG8_LDA(At, 0, 1); PG8_STAGE(PG8_SB(0, 0), b2, voffB); PG8_STAGE(PG8_SB(0, 1), b2 + hstepB, voffB); PG8_STAGE(PG8_SA(0, 0), a2, voffA);
            PG8_WAIT_V(8); PG8_WAIT_L(0); PG8_BAR; PG8_MMA(1, 0, At, B0); PG8_MMA(1, 1, At, B1); PG8_BAR; PG8_SCHED;
            PG8_LDB(B0, 1, 0); PG8_LDB(B1, 1, 1); PG8_SCHED; PG8_LDA(At, 1, 0); PG8_STAGE(PG8_SA(0, 1), a2 + hstepA, voffA);
            PG8_WAIT_V(8); PG8_WAIT_L(0); PG8_BAR; PG8_MMA(0, 0, At, B0); PG8_MMA(0, 1, At, B1); PG8_BAR; PG8_SCHED;
            PG8_LDA(At, 1, 1); PG8_STAGE(PG8_SB(1, 0), b3, voffB); PG8_STAGE(PG8_SB(1, 1), b3 + hstepB, voffB); PG8_STAGE(PG8_SA(1, 0), a3, voffA);
            PG8_WAIT_V(8); PG8_WAIT_L(0); PG8_BAR; PG8_MMA(1, 0, At, B0); PG8_MMA(1, 1, At, B1); PG8_BAR; PG8_SCHED;
            } else {
            PG8_LDB(B0, 0, 0); PG8_SCHED; PG8_LDA(At, 0, 0); PG8_STAGE(PG8_SA(1, 1), a1 + hstepA, voffA);
            PG8_WAIT_L(8); PG8_BAR; PG8_WAIT_L(0); PG8_MMA(0, 0, At, B0); PG8_BAR; PG8_SCHED;
            PG8_LDB(B1, 0, 1); PG8_STAGE(PG8_SB(0, 0), b2, voffB);
            PG8_BAR; PG8_WAIT_L(0); PG8_MMA(0, 1, At, B1); PG8_BAR;
            PG8_LDA(At, 0, 1); PG8_STAGE(PG8_SA(0, 0), a2, voffA);
            PG8_BAR; PG8_WAIT_L(0); PG8_MMA(1, 0, At, B0); PG8_BAR; PG8_SCHED;
            PG8_STAGE(PG8_SB(0, 1), b2 + hstepB, voffB);
            PG8_WAIT_V(6); PG8_BAR; PG8_MMA(1, 1, At, B1); PG8_BAR;
            PG8_LDB(B0, 1, 0); PG8_SCHED; PG8_LDA(At, 1, 0); PG8_STAGE(PG8_SA(0, 1), a2 + hstepA, voffA);
            PG8_WAIT_L(8); PG8_BAR; PG8_WAIT_L(0); PG8_MMA(0, 0, At, B0); PG8_BAR; PG8_SCHED;
            PG8_LDB(B1, 1, 1); PG8_STAGE(PG8_SB(1, 0), b3, voffB);
            PG8_BAR; PG8_WAIT_L(0); PG8_MMA(0, 1, At, B1); PG8_BAR;
            PG8_LDA(At, 1, 1); PG8_STAGE(PG8_SA(1, 0), a3, voffA);
            PG8_BAR; PG8_WAIT_L(0); PG8_MMA(1, 0, At, B0); PG8_BAR; PG8_SCHED;
            PG8_STAGE(PG8_SB(1, 1), b3 + hstepB, voffB);
            PG8_WAIT_V(6); PG8_BAR; PG8_MMA(1, 1, At, B1); PG8_BAR;
            }
        }
        if constexpr (ALIGN_EPI) { if (wr == 0) PG8_BAR; }
        if constexpr (Epi::WITH_LDS) E.run(acc, cur, wr, wc, lane, lds); else E(acc, cur, wr, wc, fr, fq);
        if (!has_next) break;
#pragma unroll
        for (int a = 0; a < 2; ++a)
#pragma unroll
            for (int b = 0; b < 2; ++b)
#pragma unroll
                for (int m = 0; m < 4; ++m)
#pragma unroll
                    for (int n = 0; n < 2; ++n) acc[a][b][m][n] = (f32x4){0.f, 0.f, 0.f, 0.f};
        cur = nxt; cA = nA; cB = nB; ++ui;
        if constexpr (ALIGN_EPI) { if (wr == 1) PG8_BAR; }
    }
    PG8_WAIT_V(0);
    if constexpr (!ALIGN_EPI) { if (wr == 0) PG8_BAR; }
    PG8_BAR;
#undef PG8_SA
#undef PG8_SB
#undef PG8_STAGE
#undef PG8_LDA
#undef PG8_LDB
#undef PG8_MMA
#undef PG8_WAIT_V
#undef PG8_WAIT_L
#undef PG8_BAR
#undef PG8_SCHED
}

template <int ACT> struct EpiPlain {
    static constexpr bool WITH_LDS = false;
    bf16_t* O; int ldc;
    __device__ __forceinline__ void operator()(const f32x4 (&acc)[2][2][4][2], const Unit& u, int wr, int wc, int fr_, int fq_) const {
        int fr = fr_, fq = fq_; asm volatile("" : "+v"(fr), "+v"(fq));
        const int col0 = u.pn * BM + wc * 32 + fq * 4;
#pragma unroll
        for (int ai = 0; ai < 2; ++ai)
#pragma unroll
            for (int m = 0; m < 4; ++m) { bf16_t* rowp = O + (size_t)(u.pm * BM + ai * HALF + wr * 64 + m * 16 + fr) * ldc + col0;
#pragma unroll
                for (int bj = 0; bj < 2; ++bj)
#pragma unroll
                    for (int n = 0; n < 2; ++n) { f32x4 v = acc[ai][bj][m][n];
                        if (ACT == 1) { v = __builtin_elementwise_max(v, (f32x4){0.f, 0.f, 0.f, 0.f}); v = v * v; }
                        *(u32x2*)(rowp + bj * HALF + n * 16) = f32_to_bf4(v); } }
    }
};

struct EpiSlabCtx {
    static constexpr bool WITH_LDS = false;
    bf16_t* S; int ksz;
    __device__ __forceinline__ void operator()(const f32x4 (&acc)[2][2][4][2], const Unit& u, int wr, int wc, int fr_, int fq_) const {
        int fr = fr_, fq = fq_; asm volatile("" : "+v"(fr), "+v"(fq));
        const int col0 = u.pn * BM + wc * 32 + fq * 4;
        bf16_t* base = S + (size_t)(u.koff / ksz) * MC * DM;
#pragma unroll
        for (int ai = 0; ai < 2; ++ai)
#pragma unroll
            for (int m = 0; m < 4; ++m) { bf16_t* rowp = base + (size_t)(u.pm * BM - ML + ai * HALF + wr * 64 + m * 16 + fr) * DM + col0;
#pragma unroll
                for (int bj = 0; bj < 2; ++bj)
#pragma unroll
                    for (int n = 0; n < 2; ++n) *(u32x2*)(rowp + bj * HALF + n * 16) = f32_to_bf4(acc[ai][bj][m][n]); }
    }
};

struct EpiQKV {
    static constexpr bool WITH_LDS = false;
    bf16_t* Q; bf16_t* Kb; bf16_t* VT; bf16_t* VTC; const float* rope;
    __device__ __forceinline__ void operator()(const f32x4 (&acc)[2][2][4][2], const Unit& u, int wr, int wc, int fr_, int fq_) const {
        int fr = fr_, fq = fq_; asm volatile("" : "+v"(fr), "+v"(fq));
        const bool lat = u.pm < 64;
        if (u.pn < 5) {
#pragma unroll
            for (int ai = 0; ai < 2; ++ai)
#pragma unroll
                for (int m = 0; m < 4; ++m) {
                    const int row = u.pm * BM + ai * HALF + wr * 64 + m * 16 + fr;
                    f32x4 cs0 = {1.f, 0.f, 1.f, 0.f}, cs1 = {1.f, 0.f, 1.f, 0.f};
                    if (lat) { const int t = row & 2047; const int pos = (wc & 1) ? (t & 63) : (t >> 6); const f32x4* pp = (const f32x4*)(rope + (pos * 16 + 4 * fq) * 2); cs0 = pp[0]; cs1 = pp[1]; }
                    const f32x4 cv = {cs0[0], cs0[2], cs1[0], cs1[2]}, sv = {cs0[1], cs0[3], cs1[1], cs1[3]};
#pragma unroll
                    for (int bj = 0; bj < 2; ++bj) {
                        const f32x4 a = acc[ai][bj][m][0], b = acc[ai][bj][m][1];
                        f32x4 na = a * cv - b * sv, nb = b * cv + a * sv;
                        if (u.pn < 4) { na = na * 0.125f; nb = nb * 0.125f;
                            bf16_t* d = Q + (size_t)row * 1024 + u.pn * 256 + bj * HALF + wc * 32 + fq * 4;
                            *(u32x2*)d = f32_to_bf4(na); *(u32x2*)(d + 16) = f32_to_bf4(nb);
                        } else {
                            bf16_t* d = Kb + (size_t)row * 256 + bj * HALF + wc * 32 + fq * 4;
                            *(u32x2*)d = f32_to_bf4(na); *(u32x2*)(d + 16) = f32_to_bf4(nb);
                        }
                    }
                }
        } else {
#pragma unroll
            for (int ai = 0; ai < 2; ++ai)
#pragma unroll
                for (int m = 0; m < 4; ++m) {
                    const int row = u.pm * BM + ai * HALF + wr * 64 + m * 16 + fr;
                    bf16_t* base; size_t stride;
                    if (lat) { const int b = row >> 11, t = row & 2047; base = VT + (size_t)b * 256 * 2048 + t; stride = 2048; }
                    else { const int rc = row - ML; const int b = rc >> 8, t = rc & 255; base = VTC + (size_t)b * 256 * 256 + t; stride = 256; }
#pragma unroll
                    for (int bj = 0; bj < 2; ++bj)
#pragma unroll
                        for (int n = 0; n < 2; ++n)
#pragma unroll
                            for (int j = 0; j < 4; ++j) { const int vc = bj * HALF + wc * 32 + n * 16 + fq * 4 + j; base[(size_t)vc * stride] = (bf16_t)f2bf(acc[ai][bj][m][n][j]); }
                }
        }
    }
};

struct EpiGates {
    static constexpr bool WITH_LDS = false;
    const bf16_t* U; bf16_t* LA; bf16_t* BX; const float* ba; const float* bi; const float* nls;
    __device__ __forceinline__ void operator()(const f32x4 (&acc)[2][2][4][2], const Unit& u, int wr, int wc, int fr_, int fq_) const {
        int fr = fr_, fq = fq_; asm volatile("" : "+v"(fr), "+v"(fq));
        const int tile = u.pn >> 1, dir = tile / 5, blk = tile % 5, chalf = u.pn & 1;
        const int ch0 = blk * 256 + chalf * 128 + wc * 32 + fq * 4;
#pragma unroll
        for (int n = 0; n < 2; ++n) {
            const int ch = ch0 + n * 16;
            const f32x4 bav = *(const f32x4*)(ba + dir * DRNN + ch), biv = *(const f32x4*)(bi + dir * DRNN + ch), nl = *(const f32x4*)(nls + dir * DRNN + ch);
#pragma unroll
            for (int ai = 0; ai < 2; ++ai)
#pragma unroll
                for (int m = 0; m < 4; ++m) {
                    const int rin = ai * HALF + wr * 64 + m * 16 + fr;
                    const size_t rowg = (size_t)u.pm * BM + rin, rowl = (size_t)u.po * BM + rin;
                    const f32x4 uv = bf4_to_f32(*(const u32x2*)(U + rowg * DRNN + ch));
                    f32x4 lav, bxv;
#pragma unroll
                    for (int j = 0; j < 4; ++j) {
                        const float r = fsigmoid(acc[ai][0][m][n][j] + bav[j]);
                        const float ig = fsigmoid(acc[ai][1][m][n][j] + biv[j]);
                        const float la = nl[j] * r, x = 2.0f * la;
                        float om;
                        if (x > -0.5f) { float q = 1.0f / 720.0f; q = q * x + 1.0f / 120.0f; q = q * x + 1.0f / 24.0f; q = q * x + 1.0f / 6.0f; q = q * x + 0.5f; q = q * x + 1.0f; om = -x * q; }
                        else om = 1.0f - __expf(x);
                        lav[j] = la; bxv[j] = __builtin_amdgcn_sqrtf(om) * (ig * uv[j]);
                    }
                    const size_t o = ((size_t)dir * 9216 + rowl) * DRNN + ch;
                    *(u32x2*)(LA + o) = f32_to_bf4(lav); *(u32x2*)(BX + o) = f32_to_bf4(bxv);
                    asm volatile("" ::: "memory");
                }
        }
    }
};

template <int CTRL> __device__ __forceinline__ float dpp_mov(float oldv, float srcv) {
    return __builtin_bit_cast(float, __builtin_amdgcn_update_dpp(__builtin_bit_cast(int, oldv), __builtin_bit_cast(int, srcv), CTRL, 0xf, 0xf, false));
}
struct EpiGatesScan {
    static constexpr bool WITH_LDS = true;
    const bf16_t* U; bf16_t* RECF; bf16_t* RECB; const float* ba; const float* bi; const float* nls;
    __device__ __forceinline__ void run(f32x4 (&acc)[2][2][4][2], const Unit& u, int wr, int wc, int lane_, LAS unsigned char* lds) const {
        int lane = lane_; asm volatile("" : "+v"(lane));
        const int fr = lane & 15, fq = lane >> 4;
        LAS float* carry = (LAS float*)(lds + 131072);
        const int tile = u.pn >> 1, dir = tile / 5, blk = tile % 5, chalf = u.pn & 1;
        const int ch0 = blk * 256 + chalf * 128 + wc * 32 + fq * 4;
        const int rmask = dir ? 255 : 0;
        bf16_t* REC = dir ? RECB : RECF;
        if (u.po == 0 && wr == 0 && fr == 0) {
#pragma unroll
            for (int n = 0; n < 2; ++n) *(LAS f32x4*)(carry + wc * 32 + n * 16 + fq * 4) = (f32x4){0.f, 0.f, 0.f, 0.f};
        }
#pragma unroll
        for (int n = 0; n < 2; ++n) {
            const int ch = ch0 + n * 16;
            const f32x4 bav = *(const f32x4*)(ba + dir * DRNN + ch), biv = *(const f32x4*)(bi + dir * DRNN + ch), nl = *(const f32x4*)(nls + dir * DRNN + ch);
#pragma unroll
            for (int ai = 0; ai < 2; ++ai)
#pragma unroll
                for (int m = 0; m < 4; ++m) {
                    const size_t rowg = (size_t)u.pm * BM + ((ai * HALF + wr * 64 + m * 16 + fr) ^ rmask);
                    const f32x4 uv = bf4_to_f32(*(const u32x2*)(U + rowg * DRNN + ch));
#pragma unroll
                    for (int j = 0; j < 4; ++j) {
                        const float r = fsigmoid(acc[ai][0][m][n][j] + bav[j]);
                        const float ig = fsigmoid(acc[ai][1][m][n][j] + biv[j]);
                        const float la = nl[j] * r, x = 2.0f * la;
                        float a = __expf(la), ap, bp;
                        float q = 1.0f / 720.0f; q = q * x + 1.0f / 120.0f; q = q * x + 1.0f / 24.0f; q = q * x + 1.0f / 6.0f; q = q * x + 0.5f; q = q * x + 1.0f;
                        const float om = (x > -0.5f) ? -x * q : 1.0f - a * a;
                        float b = __builtin_amdgcn_sqrtf(om) * (ig * uv[j]);
                        ap = dpp_mov<0x111>(1.0f, a); bp = dpp_mov<0x111>(0.0f, b); b = a * bp + b; a = a * ap;
                        ap = dpp_mov<0x112>(1.0f, a); bp = dpp_mov<0x112>(0.0f, b); b = a * bp + b; a = a * ap;
                        ap = dpp_mov<0x114>(1.0f, a); bp = dpp_mov<0x114>(0.0f, b); b = a * bp + b; a = a * ap;
                        ap = dpp_mov<0x118>(1.0f, a); bp = dpp_mov<0x118>(0.0f, b); b = a * bp + b; a = a * ap;
                        asm volatile("" : "+v"(a), "+v"(b));
                        acc[ai][0][m][n][j] = a; acc[ai][1][m][n][j] = b;
                    }
                    __builtin_amdgcn_sched_barrier(0);
                }
        }
        asm volatile("s_waitcnt lgkmcnt(0)" ::: "memory"); __builtin_amdgcn_s_barrier(); asm volatile("" ::: "memory");
        const bool emit = u.pm < 64;
        const int lastl = (lane & 48) | 15;
#pragma unroll
        for (int seg = 0; seg < 4; ++seg) {
            const int ai = seg >> 1, wrs = seg & 1;
            if (wr == wrs) {
                f32x4 hg[2];
#pragma unroll
                for (int n = 0; n < 2; ++n) hg[n] = *(const LAS f32x4*)(carry + wc * 32 + n * 16 + fq * 4);
#pragma unroll
                for (int m = 0; m < 4; ++m) {
                    f32x4 h[2];
#pragma unroll
                    for (int n = 0; n < 2; ++n) h[n] = acc[ai][0][m][n] * hg[n] + acc[ai][1][m][n];
                    if (emit) { bf16_t* rp = REC + ((size_t)u.pm * BM + ((ai * HALF + wr * 64 + m * 16 + fr) ^ rmask)) * DRNN + ch0;
#pragma unroll
                        for (int n = 0; n < 2; ++n) *(u32x2*)(rp + n * 16) = f32_to_bf4(h[n]); }
#pragma unroll
                    for (int n = 0; n < 2; ++n)
#pragma unroll
                        for (int j = 0; j < 4; ++j) hg[n][j] = __shfl(h[n][j], lastl);
                }
                if (fr == 0) {
#pragma unroll
                    for (int n = 0; n < 2; ++n) *(LAS f32x4*)(carry + wc * 32 + n * 16 + fq * 4) = hg[n];
                }
            }
            asm volatile("s_waitcnt lgkmcnt(0)" ::: "memory"); __builtin_amdgcn_s_barrier(); asm volatile("" ::: "memory");
        }
    }
};

struct EpiGateMul {
    static constexpr bool WITH_LDS = false;
    bf16_t* Z; const bf16_t* RB;
    __device__ __forceinline__ void operator()(const f32x4 (&acc)[2][2][4][2], const Unit& u, int wr, int wc, int fr_, int fq_) const {
        int fr = fr_, fq = fq_; asm volatile("" : "+v"(fr), "+v"(fq));
        const int col0 = u.pn * BM + wc * 32 + fq * 4;
#pragma unroll
        for (int ai = 0; ai < 2; ++ai)
#pragma unroll
            for (int m = 0; m < 4; ++m) { bf16_t* rowp = Z + (size_t)(u.pm * BM + ai * HALF + wr * 64 + m * 16 + fr) * DRNN + col0;
#pragma unroll
                for (int bj = 0; bj < 2; ++bj)
#pragma unroll
                    for (int n = 0; n < 2; ++n) { const f32x4 v = acc[ai][bj][m][n]; const f32x4 rc = bf4_to_f32(*(const u32x2*)(rowp + bj * HALF + n * 16)) + bf4_to_f32(*(const u32x2*)(RB + (rowp - Z) + bj * HALF + n * 16)); f32x4 o;
#pragma unroll
                        for (int j = 0; j < 4; ++j) { const float x = v[j]; const float z2 = 1.5957691216057308f * (x + 0.044715f * x * x * x); o[j] = x * fsigmoid(z2) * rc[j]; }
                        *(u32x2*)(rowp + bj * HALF + n * 16) = f32_to_bf4(o); }
                asm volatile("" ::: "memory"); }
    }
};
}


#define XB_TMO      128
#define XB_XCNT(j)  (256  + 64 * (j))
#define XB_XSUB(j)  (1280 + 64 * (j))
#define XB_XGEN(j)  (2304 + 64 * (j))
#define XB_TOP      3328
#define XB_TOPGEN   3392
#define XCD_BAR_WORDS 3456
#define XB_SPIN_CAP (1u << 18)
__device__ __forceinline__ unsigned xb_ld(unsigned* p)              { return __hip_atomic_load(p, __ATOMIC_RELAXED, __HIP_MEMORY_SCOPE_AGENT); }
__device__ __forceinline__ unsigned xb_add(unsigned* p, unsigned v) { return __hip_atomic_fetch_add(p, v, __ATOMIC_RELAXED, __HIP_MEMORY_SCOPE_AGENT); }
__device__ __forceinline__ unsigned xb_xcc_id() { return (unsigned)__builtin_amdgcn_s_getreg((3 << 11) | 20) & 0xFu; }
#define XB_SPIN(cond, bar) do { unsigned _sp = 0; while (cond) { __builtin_amdgcn_s_sleep(1); \
    if ((++_sp & 255u) == 0u) { if (xb_ld(&(bar)[XB_TMO])) break; if (_sp > XB_SPIN_CAP) { atomicAdd(&(bar)[XB_TMO], 1u); break; } } } } while (0)
struct XcdBarrier { unsigned* bar; unsigned x; volatile LAS unsigned* st; };
__device__ __forceinline__ XcdBarrier xcd_barrier_post(unsigned* bar, volatile LAS unsigned* st) {
    XcdBarrier b; b.bar = bar; b.x = xb_xcc_id(); b.st = st;
    if (threadIdx.x == 0) (void)xb_add(&bar[XB_XCNT(b.x)], 1u);
    return b;
}
__device__ __forceinline__ void xcd_barrier_complete(unsigned* bar, unsigned x, unsigned& nloc, unsigned& nx) {
    const unsigned G = gridDim.x * gridDim.y * gridDim.z;
    unsigned sum, cnt, mine, sp = 0u;
    for (;;) {
        sum = 0u; cnt = 0u; mine = 0u;
#pragma unroll
        for (unsigned j = 0; j < 16; ++j) { const unsigned c = xb_ld(&bar[XB_XCNT(j)]); sum += c; cnt += (c > 0u) ? 1u : 0u; mine = (j == x) ? c : mine; }
        if (sum == G) break;
        __builtin_amdgcn_s_sleep(1);
        if ((++sp & 255u) == 0u) { if (xb_ld(&bar[XB_TMO])) break; if (sp > XB_SPIN_CAP) { atomicAdd(&bar[XB_TMO], 1u); break; } }
    }
    nloc = mine > 0u ? mine : 1u; nx = cnt > 0u ? cnt : 1u;
}
__device__ __forceinline__ void xcd_barrier(const XcdBarrier& b) {
    asm volatile("s_waitcnt vmcnt(0)" ::: "memory");
    __syncthreads();
    if (threadIdx.x == 0) {
        unsigned* bar = b.bar;
        __builtin_amdgcn_s_waitcnt(0);
        unsigned nloc = b.st[0], nx = b.st[1];
        if (nloc == 0u) { xcd_barrier_complete(bar, b.x, nloc, nx); b.st[0] = nloc; b.st[1] = nx; }
        const unsigned old = xb_add(&bar[XB_XSUB(b.x)], 1u);
        const unsigned gen = old / nloc;
        if (old + 1u == (gen + 1u) * nloc) {
            __builtin_amdgcn_fence(__ATOMIC_RELEASE, "agent");
            asm volatile("s_waitcnt vmcnt(0)" ::: "memory");
            const unsigned og = xb_add(&bar[XB_TOP], 1u);
            const unsigned tg = og / nx;
            if (og + 1u == (tg + 1u) * nx) xb_add(&bar[XB_TOPGEN], 1u);
            else XB_SPIN(xb_ld(&bar[XB_TOPGEN]) == tg, bar);
            __builtin_amdgcn_fence(__ATOMIC_ACQUIRE, "agent");
            xb_add(&bar[XB_XGEN(b.x)], 1u);
            asm volatile("s_waitcnt vmcnt(0)" ::: "memory");
        } else {
            XB_SPIN(xb_ld(&bar[XB_XGEN(b.x)]) == gen, bar);
            __builtin_amdgcn_fence(__ATOMIC_ACQUIRE, "agent");
            asm volatile("s_waitcnt vmcnt(0)" ::: "memory");
        }
    }
    __syncthreads();
}

struct Params {
    const float *x, *c, *ctx, *c_ctx, *ada_w, *ada_b, *norm_g, *mlp_w1, *mlp_w2, *w_qkv, *w_o, *sink;
    const float *w_in, *conv_w, *conv_b, *w_a, *b_a, *w_i, *b_i, *lam, *w_out;
    float* out; unsigned char* ws;
};

typedef const __attribute__((address_space(4))) Params* ParamsK;
__device__ __forceinline__ void transpose_item(const float* W, int ldw, bf16_t* WT, int ldwt, int k0, int n0, int dst_row0, LAS float* scr, int lane) {
#pragma unroll 8
    for (int i = 0; i < 32; ++i) { const int kk = 2 * i + (lane >> 5); scr[kk * 33 + (lane & 31)] = W[(size_t)(k0 + kk) * ldw + n0 + (lane & 31)]; }
    asm volatile("s_waitcnt lgkmcnt(0)" ::: "memory");
    const int c = lane & 7;
#pragma unroll
    for (int j = 0; j < 4; ++j) { const int n = (lane >> 3) + 8 * j; const LAS float* s = scr + (8 * c) * 33 + n;
        u32x4 o; o.x = cvt_pk_bf16(s[0 * 33], s[1 * 33]); o.y = cvt_pk_bf16(s[2 * 33], s[3 * 33]); o.z = cvt_pk_bf16(s[4 * 33], s[5 * 33]); o.w = cvt_pk_bf16(s[6 * 33], s[7 * 33]);
        *(u32x4*)(WT + (size_t)(dst_row0 + n) * ldwt + k0 + 8 * c) = o; }
    asm volatile("s_waitcnt lgkmcnt(0)" ::: "memory");
}
__device__ __forceinline__ void transpose_plain(const float* W, int K, int N, bf16_t* WT, int r, LAS float* scr, int lane) {
    const int nblk = N / 32, kb = r / nblk, nb = r % nblk;
    transpose_item(W, N, WT, K, 64 * kb, 32 * nb, 32 * nb, scr, lane);
}

__device__ __forceinline__ void prologue(ParamsK p, LAS unsigned char* lds, int tid, int lane, int wave) {
    unsigned char* ws = p->ws;
    float* MOD = (float*)(ws + WS_MOD);
    if (blockIdx.x < 96) {
        LAS float* sl = (LAS float*)lds;
        LAS float* red = (LAS float*)(lds + 36864);
        for (int idx = tid; idx < 9216; idx += 512) { const int w = idx >> 10, k = idx & 1023; const float v = (w < 8) ? p->c[w * 1024 + k] : p->c_ctx[k]; sl[idx] = v / (1.0f + __expf(-v)); }
        __syncthreads();
        const int l = blockIdx.x / 48, n0 = (blockIdx.x % 48) * 128, kg = tid >> 5, cq = tid & 31;
        f32x4 acc[9];
#pragma unroll
        for (int w = 0; w < 9; ++w) acc[w] = (f32x4){0.f, 0.f, 0.f, 0.f};
        const float* wb = p->ada_w + (size_t)l * 1024 * 6144 + n0 + cq * 4;
#pragma unroll 4
        for (int it = 0; it < 64; ++it) { const int k = it * 16 + kg; const f32x4 w4 = *(const f32x4*)(wb + (size_t)k * 6144);
#pragma unroll
            for (int w = 0; w < 9; ++w) acc[w] += sl[w * 1024 + k] * w4; }
#pragma unroll
        for (int w = 0; w < 9; ++w) *(LAS f32x4*)(red + (kg * 9 + w) * 128 + cq * 4) = acc[w];
        __syncthreads();
        for (int idx = tid; idx < 9 * 128; idx += 512) { const int w = idx >> 7, n = idx & 127; float s = 0.f;
#pragma unroll
            for (int g = 0; g < 16; ++g) s += red[(g * 9 + w) * 128 + n];
            MOD[(size_t)(l * 9 + w) * 6144 + n0 + n] = s + p->ada_b[l * 6144 + n0 + n]; }
        __syncthreads();
    }
    if (blockIdx.x == gridDim.x - 1) {
        float* rope = (float*)(ws + WS_ROPE); float* nls = (float*)(ws + WS_NLS);
        for (int idx = tid; idx < 1024; idx += 512) { const int pos = idx >> 4, i = idx & 15;
            const float inv = __builtin_exp2f(-(float)i * (13.287712379549449f / 16.0f));
            const float angf = (float)pos * inv; const double ang = (double)angf;
            const double twopi = 6.283185307179586476925287; const double r = ang - twopi * __builtin_rint(ang / twopi);
            const double r2 = r * r; double cterm = 1.0, sterm = r, cs = 1.0, sn = r;
            for (int k = 1; k <= 14; ++k) { cterm *= -r2 / (double)((2 * k - 1) * (2 * k)); sterm *= -r2 / (double)((2 * k) * (2 * k + 1)); cs += cterm; sn += sterm; }
            rope[idx * 2] = (float)cs; rope[idx * 2 + 1] = (float)sn; }
        for (int idx = tid; idx < 2 * DRNN; idx += 512) { const float lm = p->lam[idx]; nls[idx] = -8.0f * log1pf(__expf(-lm)); }
    }
    LAS float* scr = (LAS float*)(lds + wave * 16384);
    const int gw = blockIdx.x * 8 + wave, NGW = gridDim.x * 8;
    constexpr int I_QKV = 16 * 48, I_O = 16 * 32, I_1 = 16 * 128, I_2 = 64 * 32, I_IN = 16 * 80, I_OUT = 20 * 32, I_G = 40 * 16;
    constexpr int NITEMS = I_QKV + I_O + 2 * I_1 + 2 * I_2 + I_IN + I_OUT + I_G;
    for (int it = gw; it < NITEMS; it += NGW) {
        int r = it;
        if (r < I_QKV) { transpose_plain(p->w_qkv, 1024, NQKV, (bf16_t*)(ws + WS_WQKV), r, scr, lane); continue; } r -= I_QKV;
        if (r < I_O) { transpose_plain(p->w_o, 1024, 1024, (bf16_t*)(ws + WS_WO), r, scr, lane); continue; } r -= I_O;
        if (r < 2 * I_1) { const int l = r / I_1; transpose_plain(p->mlp_w1 + (size_t)l * 1024 * DFF, 1024, DFF, (bf16_t*)(ws + WS_W1 + (size_t)l * 16 * MiB), r % I_1, scr, lane); continue; } r -= 2 * I_1;
        if (r < 2 * I_2) { const int l = r / I_2; transpose_plain(p->mlp_w2 + (size_t)l * 1024 * DFF, DFF, 1024, (bf16_t*)(ws + WS_W2 + (size_t)l * 16 * MiB), r % I_2, scr, lane); continue; } r -= 2 * I_2;
        if (r < I_IN) { transpose_plain(p->w_in, 1024, 2 * DRNN, (bf16_t*)(ws + WS_WIN), r, scr, lane); continue; } r -= I_IN;
        if (r < I_OUT) { transpose_plain(p->w_out, DRNN, 1024, (bf16_t*)(ws + WS_WOUT), r, scr, lane); continue; } r -= I_OUT;
        {
            const int sm = r >> 4, ii = r & 15, kb = ii >> 2, nb = ii & 3;
            const int chalf = sm & 1, blk = (sm >> 1) % 5, dg = (sm >> 1) / 5, gate = dg & 1, dir = dg >> 1;
            const float* W = (gate ? p->w_i : p->w_a) + (size_t)(dir * 5 + blk) * 256 * 256;
            const int dst_row0 = ((dir * 5 + blk) * 2 + chalf) * 256 + gate * 128 + nb * 32;
            transpose_item(W, 256, (bf16_t*)(ws + WS_WG), 256, 64 * kb, chalf * 128 + nb * 32, dst_row0, scr, lane);
        }
    }
}

template <bool HAS_Y, bool HAS_H>
__device__ __forceinline__ void row_phase(const float* xin_lat, const float* xin_ctx, float* xout_lat, float* xout_ctx, const bf16_t* Y, const bf16_t* SLAB, bf16_t* H,
                                          const float* gy, const float* gh, const float* mod_g, int gate_idx, const float* mod_h, int shift_idx, int scale_idx,
                                          int nrows, int gw, int ngw, int lane) {
    for (int row = gw; row < nrows; row += ngw) {
        const bool lat = row < ML; const int who = lat ? (row >> 11) : 8;
        const float* xi = lat ? xin_lat + (size_t)row * DM : xin_ctx + (size_t)(row - ML) * DM;
        f32x4 xv[4];
#pragma unroll
        for (int j = 0; j < 4; ++j) xv[j] = *(const f32x4*)(xi + lane * 4 + 256 * j);
        if (HAS_Y) {
            f32x4 yv[4]; float s = 0.f;
#pragma unroll
            for (int j = 0; j < 4; ++j) {
                if (SLAB != nullptr && !lat) { const bf16_t* yp = SLAB + (size_t)(row - ML) * DM + lane * 4 + 256 * j;
                    yv[j] = (bf4_to_f32(*(const u32x2*)yp) + bf4_to_f32(*(const u32x2*)(yp + (size_t)MC * DM))) + (bf4_to_f32(*(const u32x2*)(yp + (size_t)2 * MC * DM)) + bf4_to_f32(*(const u32x2*)(yp + (size_t)3 * MC * DM))); }
                else yv[j] = bf4_to_f32(*(const u32x2*)(Y + (size_t)row * DM + lane * 4 + 256 * j));
                s += (yv[j][0] * yv[j][0] + yv[j][1] * yv[j][1]) + (yv[j][2] * yv[j][2] + yv[j][3] * yv[j][3]); }
            const float rstd = 1.0f / sqrtf(wave_sum(s) * (1.0f / DM) + EPS);
            float* xo = lat ? xout_lat + (size_t)row * DM : xout_ctx + (size_t)(row - ML) * DM;
#pragma unroll
            for (int j = 0; j < 4; ++j) { const int col = lane * 4 + 256 * j;
                const f32x4 g = *(const f32x4*)(gy + col), gt = *(const f32x4*)(mod_g + (size_t)who * 6144 + gate_idx * 1024 + col);
                xv[j] = xv[j] + gt * (yv[j] * rstd * g);
                *(f32x4*)(xo + col) = xv[j]; }
        }
        if (HAS_H) {
            float s = 0.f;
#pragma unroll
            for (int j = 0; j < 4; ++j) s += (xv[j][0] * xv[j][0] + xv[j][1] * xv[j][1]) + (xv[j][2] * xv[j][2] + xv[j][3] * xv[j][3]);
            const float rstd = 1.0f / sqrtf(wave_sum(s) * (1.0f / DM) + EPS);
#pragma unroll
            for (int j = 0; j < 4; ++j) { const int col = lane * 4 + 256 * j;
                const f32x4 g = *(const f32x4*)(gh + col), sh = *(const f32x4*)(mod_h + (size_t)who * 6144 + shift_idx * 1024 + col), sc = *(const f32x4*)(mod_h + (size_t)who * 6144 + scale_idx * 1024 + col);
                const f32x4 hv = (xv[j] * rstd * g) * (1.0f + sc) + sh;
                *(u32x2*)(H + (size_t)row * DM + col) = f32_to_bf4(hv); }
        }
    }
}

__device__ __forceinline__ void attn_phase(LAS unsigned char* lds, const bf16_t* Q, bf16_t* O, const bf16_t* Kb, const bf16_t* VT, const bf16_t* VTC, const float* sink, int tid, int lane, int wave) {
    constexpr int PITCH = 72;
    LAS bf16_t* Ks = (LAS bf16_t*)lds;
    LAS bf16_t* Vs = (LAS bf16_t*)(lds + 2 * 64 * PITCH * 2);
    const int lr = lane & 15, lg = lane >> 4;
    const int skey = tid >> 3, spiece = tid & 7;
    for (int unit = blockIdx.x; unit < 576; unit += gridDim.x) {
        int b, kvh, qrow0, qblk, nloc, lt0; bool latu = unit < 512;
        if (latu) { b = unit >> 6; const int rem = unit & 63; qblk = rem >> 2; kvh = rem & 3; qrow0 = b * SEQ + qblk * 128; lt0 = (qblk == 0) ? 2 : 0; nloc = ((qblk == 15) ? 4 : 6) - lt0; }
        else { const int cu = unit - 512; b = cu >> 3; kvh = (cu & 7) >> 1; qblk = 0; qrow0 = ML + b * CTX + (cu & 1) * 128; lt0 = 0; nloc = 0; }
        const int nT = nloc + 4;
        const int head = kvh * 4 + (wave >> 1);
        const int qr0 = qrow0 + (wave & 1) * 64;
        const bf16_t* qbase = Q + (size_t)qr0 * 1024 + head * 64;
        bf16_t* obase = O + (size_t)qr0 * 1024 + head * 64;
        LAS unsigned char* Qs = lds + 40960 + wave * 8192;
#pragma unroll
        for (int qt = 0; qt < 4; ++qt)
#pragma unroll
            for (int dh = 0; dh < 2; ++dh) *(LAS bf16x8*)(Qs + (qt * 2 + dh) * 1024 + lane * 16) = *(const bf16x8*)(qbase + (unsigned)((qt * 16 + lr) * 1024 + dh * 32 + lg * 8));
        f32x4 o[4][4];
#pragma unroll
        for (int qt = 0; qt < 4; ++qt)
#pragma unroll
            for (int dt = 0; dt < 4; ++dt) o[qt][dt] = (f32x4){0.f, 0.f, 0.f, 0.f};
        float m2[4], ls[4];
        { const float sk = sink[head] * LOG2E;
#pragma unroll
          for (int qt = 0; qt < 4; ++qt) { m2[qt] = sk; ls[qt] = (lg == 0) ? 1.0f : 0.0f; } }
        u32x4 kreg, vreg;
#define ATT_LOAD(j) do { const int _j = (j); if (_j < nloc) { const int tok0 = (qblk - 1) * 128 + (lt0 + _j) * 64; \
                const bf16_t* kb_ = Kb + (size_t)(b * SEQ + tok0) * 256 + kvh * 64; const bf16_t* vb_ = VT + (size_t)(b * 4 + kvh) * 64 * SEQ + tok0; \
                kreg = *(const u32x4*)(kb_ + (unsigned)(skey * 256 + spiece * 8)); vreg = *(const u32x4*)(vb_ + (unsigned)(skey * SEQ + spiece * 8)); } \
            else { const int tok0 = (_j - nloc) * 64; \
                const bf16_t* kb_ = Kb + (size_t)(ML + b * CTX + tok0) * 256 + kvh * 64; const bf16_t* vb_ = VTC + (size_t)(b * 4 + kvh) * 64 * CTX + tok0; \
                kreg = *(const u32x4*)(kb_ + (unsigned)(skey * 256 + spiece * 8)); vreg = *(const u32x4*)(vb_ + (unsigned)(skey * CTX + spiece * 8)); } } while (0)
#define ATT_STORE(buf) do { *(LAS u32x4*)(Ks + (buf) * 64 * PITCH + skey * PITCH + spiece * 8) = kreg; *(LAS u32x4*)(Vs + (buf) * 64 * PITCH + skey * PITCH + spiece * 8) = vreg; } while (0)
        __syncthreads();
        ATT_LOAD(0); ATT_STORE(0);
        __syncthreads();
        for (int j = 0; j < nT; ++j) {
            const int buf = j & 1;
            if (j + 1 < nT) ATT_LOAD(j + 1);
            const LAS bf16_t* Kt = Ks + buf * 64 * PITCH; const LAS bf16_t* Vt = Vs + buf * 64 * PITCH;
            int mmode = 0, ktok0 = 0;
            if (j < nloc) { const int lt = lt0 + j; ktok0 = (qblk - 1) * 128 + lt * 64; mmode = (lt < 2) ? 1 : ((lt >= 4) ? 2 : 0); }
            bf16x8 kf[4][2];
#pragma unroll
            for (int ks = 0; ks < 4; ++ks)
#pragma unroll
                for (int dh = 0; dh < 2; ++dh) kf[ks][dh] = *(const LAS bf16x8*)(Kt + (ks * 16 + lr) * PITCH + dh * 32 + lg * 8);
#pragma unroll
            for (int hq = 0; hq < 2; ++hq) {
            bf16x8 pb[2][2];
#pragma unroll
            for (int q2 = 0; q2 < 2; ++q2) {
                const int qt = hq * 2 + q2;
                f32x4 s[4];
                const bf16x8 qf0 = *(const LAS bf16x8*)(Qs + (qt * 2 + 0) * 1024 + lane * 16), qf1 = *(const LAS bf16x8*)(Qs + (qt * 2 + 1) * 1024 + lane * 16);
#pragma unroll
                for (int ks = 0; ks < 4; ++ks) { s[ks] = __builtin_amdgcn_mfma_f32_16x16x32_bf16(kf[ks][0], qf0, (f32x4){0.f, 0.f, 0.f, 0.f}, 0, 0, 0);
                    s[ks] = __builtin_amdgcn_mfma_f32_16x16x32_bf16(kf[ks][1], qf1, s[ks], 0, 0, 0); }
                if (mmode) { const int qp = qblk * 128 + (wave & 1) * 64 + qt * 16 + lr;
#pragma unroll
                    for (int ks = 0; ks < 4; ++ks)
#pragma unroll
                        for (int jj = 0; jj < 4; ++jj) { const int kp = ktok0 + ks * 16 + lg * 4 + jj; const bool ok = (mmode == 1) ? (kp >= qp - 128) : (kp <= qp + 128); s[ks][jj] = ok ? s[ks][jj] : -1e30f; } }
                float mx = -3e38f;
#pragma unroll
                for (int ks = 0; ks < 4; ++ks) mx = fmaxf(mx, fmaxf(fmaxf(s[ks][0], s[ks][1]), fmaxf(s[ks][2], s[ks][3])));
                mx = fmaxf(mx, __shfl_xor(mx, 16)); mx = fmaxf(mx, __shfl_xor(mx, 32));
                const float mnew = fmaxf(m2[qt], mx * LOG2E);
                const float alpha = __builtin_amdgcn_exp2f(m2[qt] - mnew);
                m2[qt] = mnew;
                float rs = 0.f;
#pragma unroll
                for (int ks = 0; ks < 4; ++ks)
#pragma unroll
                    for (int jj = 0; jj < 4; ++jj) { const float pv = __builtin_amdgcn_exp2f(s[ks][jj] * LOG2E - mnew); s[ks][jj] = pv; rs += pv; }
                ls[qt] = ls[qt] * alpha + rs;
#pragma unroll
                for (int dt = 0; dt < 4; ++dt) o[qt][dt] = o[qt][dt] * alpha;
#pragma unroll
                for (int c2 = 0; c2 < 2; ++c2) { u32x4 w; w.x = cvt_pk_bf16(s[2 * c2][0], s[2 * c2][1]); w.y = cvt_pk_bf16(s[2 * c2][2], s[2 * c2][3]); w.z = cvt_pk_bf16(s[2 * c2 + 1][0], s[2 * c2 + 1][1]); w.w = cvt_pk_bf16(s[2 * c2 + 1][2], s[2 * c2 + 1][3]);
                    pb[q2][c2] = __builtin_bit_cast(bf16x8, w); }
            }
#pragma unroll
            for (int c2 = 0; c2 < 2; ++c2)
#pragma unroll
                for (int dt = 0; dt < 4; ++dt) {
                    const LAS bf16_t* vp = Vt + (dt * 16 + lr) * PITCH + c2 * 32 + lg * 4;
                    const u32x2 v0 = *(const LAS u32x2*)vp, v1 = *(const LAS u32x2*)(vp + 16);
                    const u32x4 vv = {v0.x, v0.y, v1.x, v1.y};
                    const bf16x8 vf = __builtin_bit_cast(bf16x8, vv);
#pragma unroll
                    for (int q2 = 0; q2 < 2; ++q2) o[hq * 2 + q2][dt] = __builtin_amdgcn_mfma_f32_16x16x32_bf16(vf, pb[q2][c2], o[hq * 2 + q2][dt], 0, 0, 0);
                }
            }
            if (j + 1 < nT) ATT_STORE(buf ^ 1);
            __syncthreads();
        }
#pragma unroll
        for (int qt = 0; qt < 4; ++qt) {
            float l = ls[qt]; l += __shfl_xor(l, 16); l += __shfl_xor(l, 32);
            const float inv = 1.0f / l;
            int lro = lr * 1024 + lg * 4; asm volatile("" : "+v"(lro));
            bf16_t* op = obase + (unsigned)(qt * 16 * 1024 + lro);
#pragma unroll
            for (int dt = 0; dt < 4; ++dt) *(u32x2*)(op + dt * 16) = f32_to_bf4(o[qt][dt] * inv);
        }
    }
#undef ATT_LOAD
#undef ATT_STORE
}

__device__ __forceinline__ void conv_phase(const bf16_t* R, bf16_t* U, const float* cw, const float* cb, int gtid, int nthreads) {
    for (int idx = gtid; idx < MT * 160; idx += nthreads) {
        const int row = idx / 160, ch = (idx % 160) * 8;
        int t, T; if (row < ML) { t = row & 2047; T = SEQ; } else { t = (row - ML) & 255; T = CTX; }
        float acc[8];
        { const f32x4 b0 = *(const f32x4*)(cb + ch), b1 = *(const f32x4*)(cb + ch + 4); acc[0] = b0[0]; acc[1] = b0[1]; acc[2] = b0[2]; acc[3] = b0[3]; acc[4] = b1[0]; acc[5] = b1[1]; acc[6] = b1[2]; acc[7] = b1[3]; }
#pragma unroll
        for (int tap = 0; tap < 4; ++tap) { const int tt = t + tap - 2;
            if (tt >= 0 && tt < T) { const u32x4 rv = *(const u32x4*)(R + (size_t)(row + tap - 2) * DRNN + ch);
                const f32x4 w0 = *(const f32x4*)(cw + tap * DRNN + ch), w1 = *(const f32x4*)(cw + tap * DRNN + ch + 4);
                acc[0] += w0[0] * bf_lo(rv.x); acc[1] += w0[1] * bf_hi(rv.x); acc[2] += w0[2] * bf_lo(rv.y); acc[3] += w0[3] * bf_hi(rv.y);
                acc[4] += w1[0] * bf_lo(rv.z); acc[5] += w1[1] * bf_hi(rv.z); acc[6] += w1[2] * bf_lo(rv.w); acc[7] += w1[3] * bf_hi(rv.w); } }
        u32x4 o; o.x = cvt_pk_bf16(acc[0], acc[1]); o.y = cvt_pk_bf16(acc[2], acc[3]); o.z = cvt_pk_bf16(acc[4], acc[5]); o.w = cvt_pk_bf16(acc[6], acc[7]);
        *(u32x4*)(U + (size_t)row * DRNN + ch) = o;
    }
}
__device__ __forceinline__ int scan_row0(int bl, int c) { return (c < 8) ? (8192 + bl * CTX + c * 32) : (bl * SEQ + (c - 8) * 32); }
__device__ __forceinline__ void scanA_phase(const bf16_t* LA, const bf16_t* BX, float* SP, float* SH, int gtid, int nthreads) {
    for (int idx = gtid; idx < 2 * 4 * 72 * 640; idx += nthreads) {
        const int cp = idx % 640, r1 = idx / 640, c = r1 % 72, r2 = r1 / 72, bl = r2 & 3, dir = r2 >> 2;
        const int row0 = scan_row0(bl, c);
        const size_t base = ((size_t)dir * 9216 + row0) * DRNN + cp * 2;
        float P0 = 1.f, P1 = 1.f, H0 = 0.f, H1 = 0.f;
#pragma unroll 8
        for (int i = 0; i < 32; ++i) { const int ii = dir ? (31 - i) : i;
            const unsigned lw = *(const unsigned*)(LA + base + (size_t)ii * DRNN), bw = *(const unsigned*)(BX + base + (size_t)ii * DRNN);
            const float a0 = __expf(bf_lo(lw)), a1 = __expf(bf_hi(lw));
            P0 *= a0; P1 *= a1; H0 = a0 * H0 + bf_lo(bw); H1 = a1 * H1 + bf_hi(bw); }
        const size_t so = ((size_t)(dir * 4 + bl) * 72 + c) * DRNN + cp * 2;
        *(f32x2*)(SP + so) = (f32x2){P0, P1}; *(f32x2*)(SH + so) = (f32x2){H0, H1};
    }
}
__device__ __forceinline__ void scanB_phase(const float* SP, const float* SH, float* CIN, int gtid, int nthreads) {
    for (int idx = gtid; idx < 2 * 4 * DRNN; idx += nthreads) {
        const int ch = idx % DRNN, r = idx / DRNN, bl = r & 3, dir = r >> 2;
        const size_t base = ((size_t)(dir * 4 + bl) * 72) * DRNN + ch;
        float carry = 0.f;
#pragma unroll 1
        for (int s0 = 0; s0 < 72; s0 += 24) {
            float pv[24], hv[24];
#pragma unroll
            for (int s = 0; s < 24; ++s) { const int sq = s0 + s; const int c = dir ? (sq < 8 ? 7 - sq : 79 - sq) : sq; pv[s] = SP[base + (size_t)c * DRNN]; hv[s] = SH[base + (size_t)c * DRNN]; }
#pragma unroll
            for (int s = 0; s < 24; ++s) { const int sq = s0 + s; const int c = dir ? (sq < 8 ? 7 - sq : 79 - sq) : sq; CIN[base + (size_t)c * DRNN] = carry; carry = pv[s] * carry + hv[s]; }
        }
    }
}
__device__ __forceinline__ void scanC_phase(const bf16_t* LA, const bf16_t* BX, const float* CIN, bf16_t* REC, int half, int gtid, int nthreads) {
    for (int idx = gtid; idx < 4 * 64 * 640; idx += nthreads) {
        const int cp = idx % 640, r1 = idx / 640, lc = r1 & 63, bl = r1 >> 6;
        const int row0 = bl * SEQ + lc * 32;
        const size_t b0 = ((size_t)row0) * DRNN + cp * 2, b1 = ((size_t)9216 + row0) * DRNN + cp * 2;
        const f32x2 cf = *(const f32x2*)(CIN + ((size_t)(0 * 4 + bl) * 72 + 8 + lc) * DRNN + cp * 2);
        const f32x2 cbk = *(const f32x2*)(CIN + ((size_t)(1 * 4 + bl) * 72 + 8 + lc) * DRNN + cp * 2);
        float hf0[32], hf1[32];
        float h0 = cf[0], h1 = cf[1];
#pragma unroll
        for (int i = 0; i < 32; ++i) { const unsigned lw = *(const unsigned*)(LA + b0 + (size_t)i * DRNN), bw = *(const unsigned*)(BX + b0 + (size_t)i * DRNN);
            h0 = __expf(bf_lo(lw)) * h0 + bf_lo(bw); h1 = __expf(bf_hi(lw)) * h1 + bf_hi(bw); hf0[i] = h0; hf1[i] = h1; }
        h0 = cbk[0]; h1 = cbk[1];
        bf16_t* out = REC + ((size_t)(half * 4 + bl) * SEQ + lc * 32) * DRNN + cp * 2;
#pragma unroll
        for (int i = 31; i >= 0; --i) { const unsigned lw = *(const unsigned*)(LA + b1 + (size_t)i * DRNN), bw = *(const unsigned*)(BX + b1 + (size_t)i * DRNN);
            h0 = __expf(bf_lo(lw)) * h0 + bf_lo(bw); h1 = __expf(bf_hi(lw)) * h1 + bf_hi(bw);
            *(unsigned*)(out + (size_t)i * DRNN) = cvt_pk_bf16(hf0[i] + h0, hf1[i] + h1); }
    }
}

#ifndef PH_MASK
#define PH_MASK 0xFFFFFFFFu
#endif
#define PH(k) ((PH_MASK >> (k)) & 1u)
#ifndef REP_MASK
#define REP_MASK 0u
#endif
#define REP_BEGIN(k) _Pragma("unroll 1") for (int rep_ = 0; rep_ < (((REP_MASK >> (k)) & 1u) ? 2 : 1); ++rep_) {
#define REP_END }
__device__ __forceinline__ ParamsK kparams() { ParamsK q = (ParamsK)__builtin_amdgcn_kernarg_segment_ptr(); asm volatile("" : "+s"(q)); return q; }
#define PHASE_BEGIN ParamsK kp = kparams(); unsigned char* ws = kp->ws; (void)ws; \
    int tid = threadIdx.x; asm volatile("" : "+v"(tid)); const int lane = tid & 63, wave = __builtin_amdgcn_readfirstlane(tid >> 6); \
    const int gw = bid * 8 + wave, gtid = bid * 512 + tid; (void)lane; (void)gw; (void)gtid;
#define P_MOD0 ((float*)(ws + WS_MOD))
#define P_MOD1 ((float*)(ws + WS_MOD) + 9 * 6144)
#define P_CTXRES ((float*)(ws + WS_CTXRES))
#define P_H ((bf16_t*)(ws + WS_H))
#define P_SLAB ((bf16_t*)(ws + WS_SLAB))
#define P_Q ((bf16_t*)(ws + WS_Q))
#define P_O ((bf16_t*)(ws + WS_O))
#define P_K ((bf16_t*)(ws + WS_K))
#define P_VT ((bf16_t*)(ws + WS_VT))
#define P_VTC ((bf16_t*)(ws + WS_VTC))
#define P_ACT ((bf16_t*)(ws + WS_ACT))
#define P_U ((bf16_t*)(ws + WS_U))
#define P_RECF ((bf16_t*)(ws + WS_RECF))
#define P_RECB ((bf16_t*)(ws + WS_RECB))
#define P_LA ((bf16_t*)(ws + WS_LA))
#define P_BX ((bf16_t*)(ws + WS_BX))
#define P_RPRE ((bf16_t*)(ws + WS_RPRE))
#define P_SP ((float*)(ws + WS_SP))
#define P_SH ((float*)(ws + WS_SH))
#define P_CIN ((float*)(ws + WS_CIN))
#define G0 (kp->norm_g)
#define G1 (kp->norm_g + 4 * DM)

__global__ void __launch_bounds__(512, 2) fwd_megakernel(Params p) {
    extern __shared__ __attribute__((aligned(16))) unsigned char lds_raw[];
    LAS unsigned char* lds = (LAS unsigned char*)lds_raw;
    const int G = gridDim.x, bid = blockIdx.x;
    const int ngw = G * 8, nthreads = G * 512;
    using namespace pg8;
    if (threadIdx.x < 4) ((volatile LAS unsigned*)(lds + 132096))[threadIdx.x] = 0u;
    __syncthreads();
    XcdBarrier xbar = xcd_barrier_post((unsigned*)(p.ws + WS_BAR), (volatile LAS unsigned*)(lds + 132096));
    if (PH(0)) { PHASE_BEGIN prologue(kp, lds, tid, lane, wave); }
    xcd_barrier(xbar);
#ifdef EXTRA_SYNCS
#pragma unroll 1
    for (int es = 0; es < EXTRA_SYNCS; ++es) xcd_barrier(xbar);
#endif
    REP_BEGIN(1)
    if (PH(1)) { PHASE_BEGIN row_phase<false, true>(kp->x, kp->ctx, nullptr, nullptr, nullptr, nullptr, P_H, nullptr, G0, nullptr, 0, P_MOD0, 0, 1, MT, gw, ngw, lane); }
    xcd_barrier(xbar);
    REP_END
    if (PH(2)) {
        PHASE_BEGIN
        Gemm g{P_H, (const bf16_t*)(ws + WS_WQKV), DM, DM, DM}; Sched S; S.init(MT / 256, NQKV / 256, G, bid);
        EpiQKV E{P_Q, P_K, P_VT, P_VTC, (const float*)(ws + WS_ROPE)};
        gemm_phase<EpiQKV, true, true>(lds, g, S, E);
    }
    xcd_barrier(xbar);
    REP_BEGIN(3)
    if (PH(3)) { PHASE_BEGIN attn_phase(lds, P_Q, P_O, P_K, P_VT, P_VTC, kp->sink, tid, lane, wave); }
    xcd_barrier(xbar);
    REP_END
    if (PH(4)) {
        PHASE_BEGIN
        { Gemm g{P_O, (const bf16_t*)(ws + WS_WO), DM, DM, DM}; Sched S; S.init(ML / 256, DM / 256, G, bid);
          EpiPlain<0> E{P_H, DM};
          gemm_phase<EpiPlain<0>, true, true>(lds, g, S, E); }
        { Gemm g{P_O, (const bf16_t*)(ws + WS_WO), DM, DM, 256}; Sched S; S.init(8, 4 * 4, G, bid, 2, 256);
          EpiSlabCtx E{P_SLAB, 256};
          gemm_phase<EpiSlabCtx, true, true>(lds, g, S, E); }
    }
    xcd_barrier(xbar);
    if (PH(5)) { PHASE_BEGIN row_phase<true, true>(kp->x, kp->ctx, kp->out, P_CTXRES, P_H, P_SLAB, P_H, G0 + DM, G0 + 2 * DM, P_MOD0, 2, P_MOD0, 3, 4, MT, gw, ngw, lane); }
    xcd_barrier(xbar);
    if (PH(6)) {
        PHASE_BEGIN
        Gemm g{P_H, (const bf16_t*)(ws + WS_W1), DM, DM, DM}; Sched S; S.init(MT / 256, DFF / 256, G, bid);
        EpiPlain<1> E{P_ACT, DFF};
        gemm_phase<EpiPlain<1>, true, true>(lds, g, S, E);
    }
    xcd_barrier(xbar);
    if (PH(7)) {
        PHASE_BEGIN
        { Gemm g{P_ACT, (const bf16_t*)(ws + WS_W2), DFF, DFF, DFF}; Sched S; S.init(ML / 256, DM / 256, G, bid);
          EpiPlain<0> E{P_H, DM};
          gemm_phase<EpiPlain<0>, true, true>(lds, g, S, E); }
        { Gemm g{P_ACT, (const bf16_t*)(ws + WS_W2), DFF, DFF, 1024}; Sched S; S.init(8, 4 * 4, G, bid, 2, 1024);
          EpiSlabCtx E{P_SLAB, 1024};
          gemm_phase<EpiSlabCtx, true, true>(lds, g, S, E); }
    }
    xcd_barrier(xbar);
    if (PH(8)) { PHASE_BEGIN row_phase<true, true>(kp->out, P_CTXRES, kp->out, P_CTXRES, P_H, P_SLAB, P_H, G0 + 3 * DM, G1, P_MOD0, 5, P_MOD1, 0, 1, MT, gw, ngw, lane); }
    xcd_barrier(xbar);
    if (PH(9)) {
        PHASE_BEGIN
        Gemm g{P_H, (const bf16_t*)(ws + WS_WIN) + (size_t)DRNN * DM, DM, DM, DM}; Sched S; S.init(MT / 256, DRNN / 256, G, bid);
        EpiPlain<0> E{P_RPRE, DRNN};
        gemm_phase<EpiPlain<0>, true, true>(lds, g, S, E);
    }
    xcd_barrier(xbar);
    REP_BEGIN(10)
    if (PH(10)) { PHASE_BEGIN conv_phase(P_RPRE, P_U, kp->conv_w, kp->conv_b, gtid, nthreads); }
    xcd_barrier(xbar);
    REP_END
    if (PH(11)) {
        PHASE_BEGIN
        Gemm g{P_U, (const bf16_t*)(ws + WS_WG), DRNN, 256, 256, (bid >> 1) & 1}; Sched S; S.init(1, 1, G, bid, 3, 0);
        EpiGatesScan E{P_U, P_RECF, P_RECB, kp->b_a, kp->b_i, (const float*)(ws + WS_NLS)};
        gemm_phase<EpiGatesScan, true, true>(lds, g, S, E);
    }
    xcd_barrier(xbar);
    if (PH(15)) {
        PHASE_BEGIN
        Gemm g{P_H, (const bf16_t*)(ws + WS_WIN), DM, DM, DM}; Sched S; S.init(ML / 256, DRNN / 256, G, bid);
        EpiGateMul E{P_RECF, P_RECB};
        gemm_phase<EpiGateMul, true, true>(lds, g, S, E);
    }
    xcd_barrier(xbar);
    if (PH(16)) {
        PHASE_BEGIN
        Gemm g{P_RECF, (const bf16_t*)(ws + WS_WOUT), DRNN, DRNN, DRNN}; Sched S; S.init(ML / 256, DM / 256, G, bid);
        EpiPlain<0> E{P_H, DM};
        gemm_phase<EpiPlain<0>, true, true>(lds, g, S, E);
    }
    xcd_barrier(xbar);
    if (PH(17)) { PHASE_BEGIN row_phase<true, true>(kp->out, P_CTXRES, kp->out, P_CTXRES, P_H, nullptr, P_H, G1 + DM, G1 + 2 * DM, P_MOD1, 2, P_MOD1, 3, 4, ML, gw, ngw, lane); }
    xcd_barrier(xbar);
    if (PH(18)) {
        PHASE_BEGIN
        Gemm g{P_H, (const bf16_t*)(ws + WS_W1 + 16 * MiB), DM, DM, DM}; Sched S; S.init(ML / 256, DFF / 256, G, bid);
        EpiPlain<1> E{P_ACT, DFF};
        gemm_phase<EpiPlain<1>, true, true>(lds, g, S, E);
    }
    xcd_barrier(xbar);
    if (PH(19)) {
        PHASE_BEGIN
        Gemm g{P_ACT, (const bf16_t*)(ws + WS_W2 + 16 * MiB), DFF, DFF, DFF}; Sched S; S.init(ML / 256, DM / 256, G, bid);
        EpiPlain<0> E{P_H, DM};
        gemm_phase<EpiPlain<0>, true, true>(lds, g, S, E);
    }
    xcd_barrier(xbar);
    if (PH(20)) { PHASE_BEGIN row_phase<true, false>(kp->out, P_CTXRES, kp->out, P_CTXRES, P_H, nullptr, nullptr, G1 + 3 * DM, nullptr, P_MOD1, 5, nullptr, 0, 0, ML, gw, ngw, lane); }
}

extern "C" void kernel_launch(void* const* d_in, const int* in_sizes, int n_in, void* d_out, int out_size, void* d_ws, size_t ws_size, hipStream_t stream) {
    static int grid_blocks = 0;
    if (grid_blocks == 0) {
        if (n_in != 21 || ws_size < WS_END) { fprintf(stderr, "kernel_launch: unexpected n_in %d / ws_size %zu\n", n_in, ws_size); grid_blocks = -1; return; }
        int dev = 0, cus = 0, per_cu = 0;
        hipGetDevice(&dev);
        hipDeviceGetAttribute(&cus, hipDeviceAttributeMultiprocessorCount, dev);
        if (hipFuncSetAttribute((const void*)fwd_megakernel, hipFuncAttributeMaxDynamicSharedMemorySize, LDS_BYTES) != hipSuccess) { fprintf(stderr, "hipFuncSetAttribute failed\n"); grid_blocks = -1; return; }
        if (hipOccupancyMaxActiveBlocksPerMultiprocessor(&per_cu, (const void*)fwd_megakernel, 512, LDS_BYTES) != hipSuccess || per_cu < 1) { fprintf(stderr, "occupancy query failed (%d)\n", per_cu); (void)hipGetLastError(); per_cu = 1; }
        grid_blocks = cus * 1;
    }
    if (grid_blocks < 0) return;
    Params p{};
    p.x = (const float*)d_in[0]; p.c = (const float*)d_in[1]; p.ctx = (const float*)d_in[2]; p.c_ctx = (const float*)d_in[3];
    p.ada_w = (const float*)d_in[4]; p.ada_b = (const float*)d_in[5]; p.norm_g = (const float*)d_in[6]; p.mlp_w1 = (const float*)d_in[7]; p.mlp_w2 = (const float*)d_in[8];
    p.w_qkv = (const float*)d_in[9]; p.w_o = (const float*)d_in[10]; p.sink = (const float*)d_in[11];
    p.w_in = (const float*)d_in[12]; p.conv_w = (const float*)d_in[13]; p.conv_b = (const float*)d_in[14]; p.w_a = (const float*)d_in[15]; p.b_a = (const float*)d_in[16];
    p.w_i = (const float*)d_in[17]; p.b_i = (const float*)d_in[18]; p.lam = (const float*)d_in[19]; p.w_out = (const float*)d_in[20];
    p.out = (float*)d_out; p.ws = (unsigned char*)d_ws;
    if (hipMemsetAsync((unsigned char*)d_ws + WS_BAR, 0, XCD_BAR_WORDS * 4, stream) != hipSuccess) { fprintf(stderr, "memset of barrier words failed\n"); return; }
    void* args[] = {&p};
    hipError_t e = hipLaunchCooperativeKernel((const void*)fwd_megakernel, dim3(grid_blocks), dim3(512), args, LDS_BYTES, stream);
    if (e != hipSuccess) fprintf(stderr, "cooperative launch failed: %s (grid %d)\n", hipGetErrorString(e), grid_blocks);
}
```

```cpp
#include <hip/hip_runtime.h>
#include <hip/hip_cooperative_groups.h>
#include <cstdio>
#include <cstdint>
namespace cg = cooperative_groups;

#define LAS __attribute__((address_space(3)))
typedef unsigned short bf16_t;
typedef short bf16x8 __attribute__((ext_vector_type(8)));
typedef float f32x4 __attribute__((ext_vector_type(4)));
typedef float f32x2 __attribute__((ext_vector_type(2)));
typedef unsigned u32x4 __attribute__((ext_vector_type(4)));
typedef unsigned u32x2 __attribute__((ext_vector_type(2)));

constexpr int DM = 1024, NB = 8, SEQ = 2048, CTX = 256;
constexpr int ML = NB * SEQ;
constexpr int MC = NB * CTX;
constexpr int MT = ML + MC;
constexpr int NQKV = 1536, DFF = 4096, DRNN = 1280;
constexpr float EPS = 1e-6f;
constexpr float LOG2E = 1.4426950408889634f;

constexpr size_t MiB = 1u << 20;
constexpr size_t WS_MOD = 0;
constexpr size_t WS_ROPE = 448 * 1024;
constexpr size_t WS_NLS = 460 * 1024;
constexpr size_t WS_BAR = 480 * 1024;
constexpr size_t WS_WQKV = 1 * MiB, WS_WO = 4 * MiB, WS_W1 = 6 * MiB, WS_W2 = 14 * MiB;
constexpr size_t WS_WIN = 38 * MiB, WS_WG = 43 * MiB, WS_WOUT = 46 * MiB;
constexpr size_t WS_CTXRES = 49 * MiB;
constexpr size_t WS_H = 57 * MiB;
constexpr size_t WS_R3 = 93 * MiB;
constexpr size_t WS_Q = WS_R3, WS_K = 129 * MiB, WS_VT = 138 * MiB, WS_VTC = 146 * MiB;
constexpr size_t WS_O = 150 * MiB;
constexpr size_t WS_ACT = WS_R3;
constexpr size_t WS_U = WS_R3;
constexpr size_t WS_RECF = 138 * MiB;
constexpr size_t WS_RECB = 178 * MiB;
constexpr size_t WS_LA = 138 * MiB;
constexpr size_t WS_BX = 183 * MiB;
constexpr size_t WS_RPRE = 138 * MiB;
constexpr size_t WS_SP = 228 * MiB, WS_SH = 231 * MiB, WS_CIN = 234 * MiB;
constexpr size_t WS_SLAB = 238 * MiB;
constexpr size_t WS_END = 256 * MiB;
constexpr int LDS_BYTES = 135168;

__device__ __forceinline__ unsigned f2bf(float f) { unsigned u = __builtin_bit_cast(unsigned, f); return (u + 0x7fffu + ((u >> 16) & 1u)) >> 16; }
__device__ __forceinline__ unsigned cvt_pk_bf16(float lo, float hi) { unsigned r; asm volatile("v_cvt_pk_bf16_f32 %0, %1, %2" : "=v"(r) : "v"(lo), "v"(hi)); return r; }
__device__ __forceinline__ float bf_lo(unsigned w) { return __builtin_bit_cast(float, w << 16); }
__device__ __forceinline__ float bf_hi(unsigned w) { return __builtin_bit_cast(float, w & 0xffff0000u); }
__device__ __forceinline__ f32x4 bf4_to_f32(u32x2 w) { return (f32x4){bf_lo(w.x), bf_hi(w.x), bf_lo(w.y), bf_hi(w.y)}; }
__device__ __forceinline__ u32x2 f32_to_bf4(f32x4 v) { u32x2 w; w.x = cvt_pk_bf16(v[0], v[1]); w.y = cvt_pk_bf16(v[2], v[3]); return w; }
__device__ __forceinline__ float wave_sum(float v) {
#pragma unroll
    for (int o = 1; o < 64; o <<= 1) v += __shfl_xor(v, o);
    return v;
}
__device__ __forceinline__ float fsigmoid(float x) { return __builtin_amdgcn_rcpf(1.0f + __expf(-x)); }

namespace pg8 {
constexpr int BM = 256, BK = 64, HALF = 128, HTB = HALF * BK * 2, STAGE_BYTES = 8 * HTB, NXCD = 8, WGM = 8;
__device__ __forceinline__ int lds_byte(int r, int c) { const int st = (r >> 4) * 2 + (c >> 5), rr = r & 15, cc = c & 31, ob = rr * 64 + cc * 2; return st * 1024 + (ob ^ (((ob >> 9) & 1) << 5)); }
__device__ __forceinline__ void stage_rc(int b, int& R, int& C) { const int st = b / 1024, sb = b % 1024, swz = sb ^ (((sb >> 9) & 1) << 5); R = (st >> 1) * 16 + swz / 64; C = (st & 1) * 32 + (swz % 64) / 2; }

struct Unit { int pm, pn, koff, po, kboff; };
struct Gemm { const bf16_t* A; const bf16_t* Bt; int lda, ldb, K; int rev = 0; };

struct Sched {
    int nM, nN, nwg, G, c, mode, half;
    __device__ void init(int nM_, int nN_, int G_, int c_, int mode_ = 0, int half_ = 0) { nM = nM_; nN = nN_; nwg = nM * nN; G = G_; c = c_; mode = mode_; half = half_; }
    __device__ bool next(int i, Unit& u) const {
        if (mode == 3) {
            if (c >= 160 || i >= 9) return false;
            const int chalf = c & 1, dir = (c >> 1) & 1, bb = c >> 2, blk = bb % 5, b = bb / 5;
            u.pm = (i == 0) ? 64 + b : (dir ? b * 8 + (8 - i) : b * 8 + (i - 1));
            u.pn = (dir * 5 + blk) * 2 + chalf; u.koff = blk * 256; u.kboff = 0; u.po = i;
            return true;
        }
        const long L = (long)i * G + c; if (L >= nwg) return false;
        int wgid = (int)L; { const int q = nwg / NXCD, r = nwg % NXCD, xcd = wgid % NXCD, off = wgid / NXCD; wgid = (xcd < r ? xcd * (q + 1) : r * (q + 1) + (xcd - r) * q) + off; }
        const int nig = WGM * nN, gid = wgid / nig, fm = gid * WGM, gsz = (nM - fm) < WGM ? (nM - fm) : WGM;
        const int pmi = fm + ((wgid % nig) % gsz), pn = (wgid % nig) / gsz;
        u.pm = pmi; u.pn = pn; u.koff = 0; u.po = pmi; u.kboff = 0;
        if (mode == 2) { u.pm = 64 + pmi; u.pn = pn & 3; u.koff = (pn >> 2) * half; u.kboff = u.koff; }
        if (mode == 1) { u.pm = pmi < 32 ? 32 * half + pmi : 64 + 4 * half + (pmi - 32); u.koff = ((pn >> 1) % 5) * 256; }
        return true;
    }
};

template <class Epi, bool ALIGN_EPI, bool SP2>
__device__ __forceinline__ void gemm_phase(LAS unsigned char* lds, const Gemm g, const Sched& S, const Epi& E) {
    int tid = threadIdx.x; asm volatile("" : "+v"(tid));
    const int wid = __builtin_amdgcn_readfirstlane(tid >> 6), lane = tid & 63, wr = wid >> 2, wc = wid & 3, fr = lane & 15, fq = lane >> 4;
    const int K = g.K, nt = K / BK;
    unsigned voffA[2], voffB[2];
#pragma unroll
    for (int i = 0; i < 2; ++i) { int R, C; stage_rc(tid * 16 + i * 8192, R, C);
        voffA[i] = (unsigned)((g.rev ? 127 - R : R) * g.lda + C) * 2u; voffB[i] = (unsigned)(R * g.ldb + C) * 2u; }
    const size_t kstep = (size_t)(BK * 2);
    const long hstepA = g.rev ? -(long)HALF * g.lda * 2 : (long)HALF * g.lda * 2; const size_t hstepB = (size_t)HALF * g.ldb * 2;
    const size_t revoff = g.rev ? (size_t)HALF * g.lda * 2 : 0;
    const unsigned ldsw = (unsigned)wid * 1024u;
    const int aoff = lds_byte(wr * 64 + fr, fq * 8), boff = lds_byte(wc * 32 + fr, fq * 8);
#define PG8_SA(b, h) (((b) * 2 + (h)) * HTB)
#define PG8_SB(b, h) ((4 + (b) * 2 + (h)) * HTB)
#define PG8_STAGE(bufoff, gbase, voff) do { _Pragma("unroll") for (int _i = 0; _i < 2; ++_i) \
        __builtin_amdgcn_global_load_lds((const unsigned*)((const char*)(gbase) + (voff)[_i]), (LAS unsigned*)(lds + (bufoff) + ldsw + _i * 8192), 16, 0, 0); } while (0)
#define PG8_LDA(dst, b, h) do { _Pragma("unroll") for (int m = 0; m < 4; ++m) _Pragma("unroll") for (int k = 0; k < 2; ++k) dst[m][k] = *(const LAS bf16x8*)(lds + PG8_SA(b, h) + aoff + m * 2048 + k * 1024); } while (0)
#define PG8_LDB(dst, b, h) do { _Pragma("unroll") for (int n = 0; n < 2; ++n) _Pragma("unroll") for (int k = 0; k < 2; ++k) dst[n][k] = *(const LAS bf16x8*)(lds + PG8_SB(b, h) + boff + n * 2048 + k * 1024); } while (0)
#define PG8_MMA(ai, bj, At, Bt) do { __builtin_amdgcn_s_setprio(1); _Pragma("unroll") for (int m = 0; m < 4; ++m) _Pragma("unroll") for (int n = 0; n < 2; ++n) _Pragma("unroll") for (int k = 0; k < 2; ++k) \
        acc[ai][bj][m][n] = __builtin_amdgcn_mfma_f32_16x16x32_bf16(Bt[n][k], At[m][k], acc[ai][bj][m][n], 0, 0, 0); __builtin_amdgcn_s_setprio(0); } while (0)
#define PG8_WAIT_V(n) asm volatile("s_waitcnt vmcnt(" #n ")" ::: "memory")
#define PG8_WAIT_L(n) asm volatile("s_waitcnt lgkmcnt(" #n ")" ::: "memory")
#define PG8_BAR __builtin_amdgcn_s_barrier()
#define PG8_SCHED __builtin_amdgcn_sched_barrier(0)
    Unit cur, nxt; int ui = 0;
    if (!S.next(0, cur)) return;
    f32x4 acc[2][2][4][2];
#pragma unroll
    for (int a = 0; a < 2; ++a)
#pragma unroll
        for (int b = 0; b < 2; ++b)
#pragma unroll
            for (int m = 0; m < 4; ++m)
#pragma unroll
                for (int n = 0; n < 2; ++n) acc[a][b][m][n] = (f32x4){0.f, 0.f, 0.f, 0.f};
    bf16x8 At[4][2], B0[2][2], B1[2][2];
    const char* cA = (const char*)g.A + ((size_t)cur.pm * BM * g.lda + cur.koff) * 2 + revoff; const char* cB = (const char*)g.Bt + ((size_t)cur.pn * BM * g.ldb + cur.kboff) * 2;
    if constexpr (SP2) {
        PG8_STAGE(PG8_SB(0, 0), cB, voffB); PG8_STAGE(PG8_SB(0, 1), cB + hstepB, voffB); PG8_STAGE(PG8_SA(0, 0), cA, voffA); PG8_STAGE(PG8_SA(0, 1), cA + hstepA, voffA);
        if (wr == 1) PG8_BAR;
        PG8_WAIT_V(2); PG8_BAR;
        PG8_STAGE(PG8_SB(1, 0), cB + kstep, voffB); PG8_STAGE(PG8_SA(1, 0), cA + kstep, voffA); PG8_STAGE(PG8_SB(1, 1), cB + hstepB + kstep, voffB);
        PG8_WAIT_V(6); PG8_BAR;
    } else {
        PG8_STAGE(PG8_SB(0, 0), cB, voffB); PG8_STAGE(PG8_SA(0, 0), cA, voffA); PG8_STAGE(PG8_SB(0, 1), cB + hstepB, voffB); PG8_STAGE(PG8_SA(0, 1), cA + hstepA, voffA);
        if (wr == 1) PG8_BAR;
        PG8_WAIT_V(4); PG8_BAR;
        PG8_STAGE(PG8_SB(1, 0), cB + kstep, voffB); PG8_STAGE(PG8_SA(1, 0), cA + kstep, voffA); PG8_STAGE(PG8_SB(1, 1), cB + hstepB + kstep, voffB);
        PG8_WAIT_V(6); PG8_BAR;
    }
    for (;;) {
        const bool has_next = S.next(ui + 1, nxt);
        const char* nA = has_next ? (const char*)g.A + ((size_t)nxt.pm * BM * g.lda + nxt.koff) * 2 + revoff : cA;
        const char* nB = has_next ? (const char*)g.Bt + ((size_t)nxt.pn * BM * g.ldb + nxt.kboff) * 2 : cB;
#pragma unroll 1
        for (int t = 0; t < nt; t += 2) {
            const bool last = (t == nt - 2);
            const char* a1 = cA + (size_t)(t + 1) * kstep;
            const char* a2 = last ? nA : cA + (size_t)(t + 2) * kstep; const char* b2 = last ? nB : cB + (size_t)(t + 2) * kstep;
            const char* a3 = a2 + kstep; const char* b3 = b2 + kstep;
            if constexpr (SP2) {
            PG8_LDB(B0, 0, 0); PG8_LDB(B1, 0, 1); PG8_SCHED; PG8_LDA(At, 0, 0); PG8_STAGE(PG8_SA(1, 1), a1 + hstepA, voffA);
            PG8_WAIT_V(8); PG8_WAIT_L(0); PG8_BAR; PG8_MMA(0, 0, At, B0); PG8_MMA(0, 1, At, B1); PG8_BAR; PG8_SCHED;
            PG8_LDA(At, 0, 1); PG8_STAGE(PG8_SB(0, 0), b2, voffB); PG8_STAGE(PG8_SB(0, 1), b2 + hstepB, voffB); PG8_STAGE(PG8_SA(0, 0), a2, voffA);
            PG8_WAIT_V(8); PG8_WAIT_L(0); PG8_BAR; PG8_MMA(1, 0, At, B0); PG8_MMA(1, 1, At, B1); PG8_BAR; PG8_SCHED;
            PG8_LDB(B0, 1, 0); PG8_LDB(B1, 1, 1); PG8_SCHED; PG8_LDA(At, 1, 0); PG8_STAGE(PG8_SA(0, 1), a2 + hstepA, voffA);
            PG8_WAIT_V(8); PG8_WAIT_L(0); PG8_BAR; PG8_MMA(0, 0, At, B0); PG8_MMA(0, 1, At, B1); PG8_BAR; PG8_SCHED;
            PG8_LDA(At, 1, 1); PG8_STAGE(PG8_SB(1, 0), b3, voffB); PG8_STAGE(PG8_SB(1, 1), b3 + hstepB, voffB); PG8_STAGE(PG8_SA(1, 0), a3, voffA);
            PG8_WAIT_V(8); PG8_WAIT_L(0); PG8_BAR; PG8_MMA(1, 0, At, B0); PG8_MMA(1, 1, At, B1); PG8_BAR; PG8_SCHED;
            } else {
            PG8_LDB(B0, 0, 0); PG8_SCHED; PG8_LDA(At, 0, 0); PG8_STAGE(PG8_SA(1, 1), a1 + hstepA, voffA);
            PG8_WAIT_L(8); PG8_BAR; PG8_WAIT_L(0); PG8_MMA(0, 0, At, B0); PG8_BAR; PG8_SCHED;
            PG8_LDB(B1, 0, 1); PG8_STAGE(PG8_SB(0, 0), b2, voffB);
            PG8_BAR; PG8_WAIT_L(0); PG8_MMA(0, 1, At, B1); PG8_BAR;
            PG8_LDA(At, 0, 1); PG8_STAGE(PG8_SA(0, 0), a2, voffA);
            PG8_BAR; PG8_WAIT_L(0); PG8_MMA(1, 0, At, B0); PG8_BAR; PG8_SCHED;
            PG8_STAGE(PG8_SB(0, 1), b2 + hstepB, voffB);
            PG8_WAIT_V(6); PG8_BAR; PG8_MMA(1, 1, At, B1); PG8_BAR;
            PG8_LDB(B0, 1, 0); PG8_SCHED; PG8_LDA(At, 1, 0); PG8_STAGE(PG8_SA(0, 1), a2 + hstepA, voffA);
            PG8_WAIT_L(8); PG8_BAR; PG8_WAIT_L(0); PG8_MMA(0, 0, At, B0); PG8_BAR; PG8_SCHED;
            PG8_LDB(B1, 1, 1); PG8_STAGE(PG8_SB(1, 0), b3, voffB);
            PG8_BAR; PG8_WAIT_L(0); PG8_MMA(0, 1, At, B1); PG8_BAR;
            PG8_LDA(At, 1, 1); PG8_STAGE(PG8_SA(1, 0), a3, voffA);
            PG8_BAR; PG8_WAIT_L(0); PG8_MMA(1, 0, At, B0); PG8_BAR; PG8_SCHED;
            PG8_STAGE(PG8_SB(1, 1), b3 + hstepB, voffB);
            PG8_WAIT_V(6); PG8_BAR; PG8_MMA(1, 1, At, B1); PG8_BAR;
            }
        }
        if constexpr (ALIGN_EPI) { if (wr == 0) PG8_BAR; }
        if constexpr (Epi::WITH_LDS) E.run(acc, cur, wr, wc, lane, lds); else E(acc, cur, wr, wc, fr, fq);
        if (!has_next) break;
#pragma unroll
        for (int a = 0; a < 2; ++a)
#pragma unroll
            for (int b = 0; b < 2; ++b)
#pragma unroll
                for (int m = 0; m < 4; ++m)
#pragma unroll
                    for (int n = 0; n < 2; ++n) acc[a][b][m][n] = (f32x4){0.f, 0.f, 0.f, 0.f};
        cur = nxt; cA = nA; cB = nB; ++ui;
        if constexpr (ALIGN_EPI) { if (wr == 1) PG8_BAR; }
    }
    PG8_WAIT_V(0);
    if constexpr (!ALIGN_EPI) { if (wr == 0) PG8_BAR; }
    PG8_BAR;
#undef PG8_SA
#undef PG8_SB
#undef PG8_STAGE
#undef PG8_LDA
#undef PG8_LDB
#undef PG8_MMA
#undef PG8_WAIT_V
#undef PG8_WAIT_L
#undef PG8_BAR
#undef PG8_SCHED
}

template <int ACT> struct EpiPlain {
    static constexpr bool WITH_LDS = false;
    bf16_t* O; int ldc;
    __device__ __forceinline__ void operator()(const f32x4 (&acc)[2][2][4][2], const Unit& u, int wr, int wc, int fr_, int fq_) const {
        int fr = fr_, fq = fq_; asm volatile("" : "+v"(fr), "+v"(fq));
        const int col0 = u.pn * BM + wc * 32 + fq * 4;
#pragma unroll
        for (int ai = 0; ai < 2; ++ai)
#pragma unroll
            for (int m = 0; m < 4; ++m) { bf16_t* rowp = O + (size_t)(u.pm * BM + ai * HALF + wr * 64 + m * 16 + fr) * ldc + col0;
#pragma unroll
                for (int bj = 0; bj < 2; ++bj)
#pragma unroll
                    for (int n = 0; n < 2; ++n) { f32x4 v = acc[ai][bj][m][n];
                        if (ACT == 1) { v = __builtin_elementwise_max(v, (f32x4){0.f, 0.f, 0.f, 0.f}); v = v * v; }
                        *(u32x2*)(rowp + bj * HALF + n * 16) = f32_to_bf4(v); } }
    }
};

struct EpiSlabCtx {
    static constexpr bool WITH_LDS = false;
    bf16_t* S; int ksz;
    __device__ __forceinline__ void operator()(const f32x4 (&acc)[2][2][4][2], const Unit& u, int wr, int wc, int fr_, int fq_) const {
        int fr = fr_, fq = fq_; asm volatile("" : "+v"(fr), "+v"(fq));
        const int col0 = u.pn * BM + wc * 32 + fq * 4;
        bf16_t* base = S + (size_t)(u.koff / ksz) * MC * DM;
#pragma unroll
        for (int ai = 0; ai < 2; ++ai)
#pragma unroll
            for (int m = 0; m < 4; ++m) { bf16_t* rowp = base + (size_t)(u.pm * BM - ML + ai * HALF + wr * 64 + m * 16 + fr) * DM + col0;
#pragma unroll
                for (int bj = 0; bj < 2; ++bj)
#pragma unroll
                    for (int n = 0; n < 2; ++n) *(u32x2*)(rowp + bj * HALF + n * 16) = f32_to_bf4(acc[ai][bj][m][n]); }
    }
};

struct EpiQKV {
    static constexpr bool WITH_LDS = false;
    bf16_t* Q; bf16_t* Kb; bf16_t* VT; bf16_t* VTC; const float* rope;
    __device__ __forceinline__ void operator()(const f32x4 (&acc)[2][2][4][2], const Unit& u, int wr, int wc, int fr_, int fq_) const {
        int fr = fr_, fq = fq_; asm volatile("" : "+v"(fr), "+v"(fq));
        const bool lat = u.pm < 64;
        if (u.pn < 5) {
#pragma unroll
            for (int ai = 0; ai < 2; ++ai)
#pragma unroll
                for (int m = 0; m < 4; ++m) {
                    const int row = u.pm * BM + ai * HALF + wr * 64 + m * 16 + fr;
                    f32x4 cs0 = {1.f, 0.f, 1.f, 0.f}, cs1 = {1.f, 0.f, 1.f, 0.f};
                    if (lat) { const int t = row & 2047; const int pos = (wc & 1) ? (t & 63) : (t >> 6); const f32x4* pp = (const f32x4*)(rope + (pos * 16 + 4 * fq) * 2); cs0 = pp[0]; cs1 = pp[1]; }
                    const f32x4 cv = {cs0[0], cs0[2], cs1[0], cs1[2]}, sv = {cs0[1], cs0[3], cs1[1], cs1[3]};
#pragma unroll
                    for (int bj = 0; bj < 2; ++bj) {
                        const f32x4 a = acc[ai][bj][m][0], b = acc[ai][bj][m][1];
                        f32x4 na = a * cv - b * sv, nb = b * cv + a * sv;
                        if (u.pn < 4) { na = na * 0.125f; nb = nb * 0.125f;
                            bf16_t* d = Q + (size_t)row * 1024 + u.pn * 256 + bj * HALF + wc * 32 + fq * 4;
                            *(u32x2*)d = f32_to_bf4(na); *(u32x2*)(d + 16) = f32_to_bf4(nb);
                        } else {
                            bf16_t* d = Kb + (size_t)row * 256 + bj * HALF + wc * 32 + fq * 4;
                            *(u32x2*)d = f32_to_bf4(na); *(u32x2*)(d + 16) = f32_to_bf4(nb);
                        }
                    }
                }
        } else {
#pragma unroll
            for (int ai = 0; ai < 2; ++ai)
#pragma unroll
                for (int m = 0; m < 4; ++m) {
                    const int row = u.pm * BM + ai * HALF + wr * 64 + m * 16 + fr;
                    bf16_t* base; size_t stride;
                    if (lat) { const int b = row >> 11, t = row & 2047; base = VT + (size_t)b * 256 * 2048 + t; stride = 2048; }
                    else { const int rc = row - ML; const int b = rc >> 8, t = rc & 255; base = VTC + (size_t)b * 256 * 256 + t; stride = 256; }
#pragma unroll
                    for (int bj = 0; bj < 2; ++bj)
#pragma unroll
                        for (int n = 0; n < 2; ++n)
#pragma unroll
                            for (int j = 0; j < 4; ++j) { const int vc = bj * HALF + wc * 32 + n * 16 + fq * 4 + j; base[(size_t)vc * stride] = (bf16_t)f2bf(acc[ai][bj][m][n][j]); }
                }
        }
    }
};

struct EpiGates {
    static constexpr bool WITH_LDS = false;
    const bf16_t* U; bf16_t* LA; bf16_t* BX; const float* ba; const float* bi; const float* nls;
    __device__ __forceinline__ void operator()(const f32x4 (&acc)[2][2][4][2], const Unit& u, int wr, int wc, int fr_, int fq_) const {
        int fr = fr_, fq = fq_; asm volatile("" : "+v"(fr), "+v"(fq));
        const int tile = u.pn >> 1, dir = tile / 5, blk = tile % 5, chalf = u.pn & 1;
        const int ch0 = blk * 256 + chalf * 128 + wc * 32 + fq * 4;
#pragma unroll
        for (int n = 0; n < 2; ++n) {
            const int ch = ch0 + n * 16;
            const f32x4 bav = *(const f32x4*)(ba + dir * DRNN + ch), biv = *(const f32x4*)(bi + dir * DRNN + ch), nl = *(const f32x4*)(nls + dir * DRNN + ch);
#pragma unroll
            for (int ai = 0; ai < 2; ++ai)
#pragma unroll
                for (int m = 0; m < 4; ++m) {
                    const int rin = ai * HALF + wr * 64 + m * 16 + fr;
                    const size_t rowg = (size_t)u.pm * BM + rin, rowl = (size_t)u.po * BM + rin;
                    const f32x4 uv = bf4_to_f32(*(const u32x2*)(U + rowg * DRNN + ch));
                    f32x4 lav, bxv;
#pragma unroll
                    for (int j = 0; j < 4; ++j) {
                        const float r = fsigmoid(acc[ai][0][m][n][j] + bav[j]);
                        const float ig = fsigmoid(acc[ai][1][m][n][j] + biv[j]);
                        const float la = nl[j] * r, x = 2.0f * la;
                        float om;
                        if (x > -0.5f) { float q = 1.0f / 720.0f; q = q * x + 1.0f / 120.0f; q = q * x + 1.0f / 24.0f; q = q * x + 1.0f / 6.0f; q = q * x + 0.5f; q = q * x + 1.0f; om = -x * q; }
                        else om = 1.0f - __expf(x);
                        lav[j] = la; bxv[j] = __builtin_amdgcn_sqrtf(om) * (ig * uv[j]);
                    }
                    const size_t o = ((size_t)dir * 9216 + rowl) * DRNN + ch;
                    *(u32x2*)(LA + o) = f32_to_bf4(lav); *(u32x2*)(BX + o) = f32_to_bf4(bxv);
                    asm volatile("" ::: "memory");
                }
        }
    }
};

#define SC_STEP(d) \
    "v_fmac_f32_dpp %1, %1, %0 row_shr:" #d " row_mask:0xf bank_mask:0xf\n\t" "v_mul_f32_dpp %0, %0, %0 row_shr:" #d " row_mask:0xf bank_mask:0xf\n\t" \
    "v_fmac_f32_dpp %3, %3, %2 row_shr:" #d " row_mask:0xf bank_mask:0xf\n\t" "v_mul_f32_dpp %2, %2, %2 row_shr:" #d " row_mask:0xf bank_mask:0xf\n\t" \
    "v_fmac_f32_dpp %5, %5, %4 row_shr:" #d " row_mask:0xf bank_mask:0xf\n\t" "v_mul_f32_dpp %4, %4, %4 row_shr:" #d " row_mask:0xf bank_mask:0xf\n\t" \
    "v_fmac_f32_dpp %7, %7, %6 row_shr:" #d " row_mask:0xf bank_mask:0xf\n\t" "v_mul_f32_dpp %6, %6, %6 row_shr:" #d " row_mask:0xf bank_mask:0xf\n\t"
__device__ __forceinline__ void scan16x4(float& a0, float& b0, float& a1, float& b1, float& a2, float& b2, float& a3, float& b3) {
    asm volatile("s_nop 1\n\t" SC_STEP(1) SC_STEP(2) SC_STEP(4) SC_STEP(8)
                 : "+v"(a0), "+v"(b0), "+v"(a1), "+v"(b1), "+v"(a2), "+v"(b2), "+v"(a3), "+v"(b3));
}
struct EpiGatesScan {
    static constexpr bool WITH_LDS = true;
    const bf16_t* U; bf16_t* RECF; bf16_t* RECB; const float* ba; const float* bi; const float* nls;
    __device__ __forceinline__ void run(f32x4 (&acc)[2][2][4][2], const Unit& u, int wr, int wc, int lane_, LAS unsigned char* lds) const {
        int lane = lane_; asm volatile("" : "+v"(lane));
        const int fr = lane & 15, fq = lane >> 4;
        LAS float* carry = (LAS float*)(lds + 131072);
        const int tile = u.pn >> 1, dir = tile / 5, blk = tile % 5, chalf = u.pn & 1;
        const int ch0 = blk * 256 + chalf * 128 + wc * 32 + fq * 4;
        const int rmask = dir ? 255 : 0;
        bf16_t* REC = dir ? RECB : RECF;
        if (u.po == 0 && wr == 0 && fr == 0) {
#pragma unroll
            for (int n = 0; n < 2; ++n) *(LAS f32x4*)(carry + wc * 32 + n * 16 + fq * 4) = (f32x4){0.f, 0.f, 0.f, 0.f};
        }
#pragma unroll
        for (int n = 0; n < 2; ++n) {
            const int ch = ch0 + n * 16;
            const f32x4 bav2 = *(const f32x4*)(ba + dir * DRNN + ch) * (-LOG2E), biv2 = *(const f32x4*)(bi + dir * DRNN + ch) * (-LOG2E), nl = *(const f32x4*)(nls + dir * DRNN + ch);
            const f32x4 nl2 = nl * LOG2E, nlx = nl * 2.0f;
#pragma unroll
            for (int ai = 0; ai < 2; ++ai)
#pragma unroll
                for (int m = 0; m < 4; ++m) {
                    const size_t rowg = (size_t)u.pm * BM + ((ai * HALF + wr * 64 + m * 16 + fr) ^ rmask);
                    const f32x4 uv = bf4_to_f32(*(const u32x2*)(U + rowg * DRNN + ch));
                    float av[4], bv[4];
#pragma unroll
                    for (int j = 0; j < 4; ++j) {
                        const float r = __builtin_amdgcn_rcpf(1.0f + __builtin_amdgcn_exp2f(acc[ai][0][m][n][j] * (-LOG2E) + bav2[j]));
                        const float ig = __builtin_amdgcn_rcpf(1.0f + __builtin_amdgcn_exp2f(acc[ai][1][m][n][j] * (-LOG2E) + biv2[j]));
                        const float a = __builtin_amdgcn_exp2f(nl2[j] * r), x = nlx[j] * r;
                        float q = 1.0f / 720.0f; q = q * x + 1.0f / 120.0f; q = q * x + 1.0f / 24.0f; q = q * x + 1.0f / 6.0f; q = q * x + 0.5f; q = q * x + 1.0f;
                        const float om = (x > -0.5f) ? -x * q : 1.0f - a * a;
                        av[j] = a; bv[j] = __builtin_amdgcn_sqrtf(om) * (ig * uv[j]);
                    }
                    scan16x4(av[0], bv[0], av[1], bv[1], av[2], bv[2], av[3], bv[3]);
#pragma unroll
                    for (int j = 0; j < 4; ++j) { acc[ai][0][m][n][j] = av[j]; acc[ai][1][m][n][j] = bv[j]; }
                    __builtin_amdgcn_sched_barrier(0);
                }
        }
        asm volatile("s_waitcnt lgkmcnt(0)" ::: "memory"); __builtin_amdgcn_s_barrier(); asm volatile("" ::: "memory");
        const bool emit = u.pm < 64;
        const int lastl = (lane & 48) | 15;
#pragma unroll
        for (int seg = 0; seg < 4; ++seg) {
            const int ai = seg >> 1, wrs = seg & 1;
            if (wr == wrs) {
                f32x4 hg[2];
#pragma unroll
                for (int n = 0; n < 2; ++n) hg[n] = *(const LAS f32x4*)(carry + wc * 32 + n * 16 + fq * 4);
#pragma unroll
                for (int m = 0; m < 4; ++m) {
                    f32x4 h[2];
#pragma unroll
                    for (int n = 0; n < 2; ++n) h[n] = acc[ai][0][m][n] * hg[n] + acc[ai][1][m][n];
                    if (emit) { bf16_t* rp = REC + ((size_t)u.pm * BM + ((ai * HALF + wr * 64 + m * 16 + fr) ^ rmask)) * DRNN + ch0;
#pragma unroll
                        for (int n = 0; n < 2; ++n) *(u32x2*)(rp + n * 16) = f32_to_bf4(h[n]); }
#pragma unroll
                    for (int n = 0; n < 2; ++n)
#pragma unroll
                        for (int j = 0; j < 4; ++j) hg[n][j] = __shfl(h[n][j], lastl);
                }
                if (fr == 0) {
#pragma unroll
                    for (int n = 0; n < 2; ++n) *(LAS f32x4*)(carry + wc * 32 + n * 16 + fq * 4) = hg[n];
                }
            }
            asm volatile("s_waitcnt lgkmcnt(0)" ::: "memory"); __builtin_amdgcn_s_barrier(); asm volatile("" ::: "memory");
        }
    }
};

struct EpiGateMul {
    static constexpr bool WITH_LDS = false;
    bf16_t* Z; const bf16_t* RB;
    __device__ __forceinline__ void operator()(const f32x4 (&acc)[2][2][4][2], const Unit& u, int wr, int wc, int fr_, int fq_) const {
        int fr = fr_, fq = fq_; asm volatile("" : "+v"(fr), "+v"(fq));
        const int col0 = u.pn * BM + wc * 32 + fq * 4;
#pragma unroll
        for (int ai = 0; ai < 2; ++ai)
#pragma unroll
            for (int m = 0; m < 4; ++m) { bf16_t* rowp = Z + (size_t)(u.pm * BM + ai * HALF + wr * 64 + m * 16 + fr) * DRNN + col0;
#pragma unroll
                for (int bj = 0; bj < 2; ++bj)
#pragma unroll
                    for (int n = 0; n < 2; ++n) { const f32x4 v = acc[ai][bj][m][n]; const f32x4 rc = bf4_to_f32(*(const u32x2*)(rowp + bj * HALF + n * 16)) + bf4_to_f32(*(const u32x2*)(RB + (rowp - Z) + bj * HALF + n * 16)); f32x4 o;
#pragma unroll
                        for (int j = 0; j < 4; ++j) { const float x = v[j]; const float z2 = 1.5957691216057308f * (x + 0.044715f * x * x * x); o[j] = x * fsigmoid(z2) * rc[j]; }
                        *(u32x2*)(rowp + bj * HALF + n * 16) = f32_to_bf4(o); }
                asm volatile("" ::: "memory"); }
    }
};
}


#define XB_TMO      128
#define XB_XCNT(j)  (256  + 64 * (j))
#define XB_XSUB(j)  (1280 + 64 * (j))
#define XB_XGEN(j)  (2304 + 64 * (j))
#define XB_TOP      3328
#define XB_TOPGEN   3392
#define XCD_BAR_WORDS 3456
#define XB_SPIN_CAP (1u << 18)
__device__ __forceinline__ unsigned xb_ld(unsigned* p)              { return __hip_atomic_load(p, __ATOMIC_RELAXED, __HIP_MEMORY_SCOPE_AGENT); }
__device__ __forceinline__ unsigned xb_add(unsigned* p, unsigned v) { return __hip_atomic_fetch_add(p, v, __ATOMIC_RELAXED, __HIP_MEMORY_SCOPE_AGENT); }
__device__ __forceinline__ unsigned xb_xcc_id() { return (unsigned)__builtin_amdgcn_s_getreg((3 << 11) | 20) & 0xFu; }
#define XB_SPIN(cond, bar) do { unsigned _sp = 0; while (cond) { __builtin_amdgcn_s_sleep(1); \
    if ((++_sp & 255u) == 0u) { if (xb_ld(&(bar)[XB_TMO])) break; if (_sp > XB_SPIN_CAP) { atomicAdd(&(bar)[XB_TMO], 1u); break; } } } } while (0)
struct XcdBarrier { unsigned* bar; unsigned x; volatile LAS unsigned* st; };
__device__ __forceinline__ XcdBarrier xcd_barrier_post(unsigned* bar, volatile LAS unsigned* st) {
    XcdBarrier b; b.bar = bar; b.x = xb_xcc_id(); b.st = st;
    if (threadIdx.x == 0) (void)xb_add(&bar[XB_XCNT(b.x)], 1u);
    return b;
}
__device__ __forceinline__ void xcd_barrier_complete(unsigned* bar, unsigned x, unsigned& nloc, unsigned& nx) {
    const unsigned G = gridDim.x * gridDim.y * gridDim.z;
    unsigned sum, cnt, mine, sp = 0u;
    for (;;) {
        sum = 0u; cnt = 0u; mine = 0u;
#pragma unroll
        for (unsigned j = 0; j < 16; ++j) { const unsigned c = xb_ld(&bar[XB_XCNT(j)]); sum += c; cnt += (c > 0u) ? 1u : 0u; mine = (j == x) ? c : mine; }
        if (sum == G) break;
        __builtin_amdgcn_s_sleep(1);
        if ((++sp & 255u) == 0u) { if (xb_ld(&bar[XB_TMO])) break; if (sp > XB_SPIN_CAP) { atomicAdd(&bar[XB_TMO], 1u); break; } }
    }
    nloc = mine > 0u ? mine : 1u; nx = cnt > 0u ? cnt : 1u;
}
__device__ __forceinline__ void xcd_barrier(const XcdBarrier& b) {
    asm volatile("s_waitcnt vmcnt(0)" ::: "memory");
    __syncthreads();
    if (threadIdx.x == 0) {
        unsigned* bar = b.bar;
        __builtin_amdgcn_s_waitcnt(0);
        unsigned nloc = b.st[0], nx = b.st[1];
        if (nloc == 0u) { xcd_barrier_complete(bar, b.x, nloc, nx); b.st[0] = nloc; b.st[1] = nx; }
        const unsigned old = xb_add(&bar[XB_XSUB(b.x)], 1u);
        const unsigned gen = old / nloc;
        if (old + 1u == (gen + 1u) * nloc) {
            __builtin_amdgcn_fence(__ATOMIC_RELEASE, "agent");
            asm volatile("s_waitcnt vmcnt(0)" ::: "memory");
            const unsigned og = xb_add(&bar[XB_TOP], 1u);
            const unsigned tg = og / nx;
            if (og + 1u == (tg + 1u) * nx) xb_add(&bar[XB_TOPGEN], 1u);
            else XB_SPIN(xb_ld(&bar[XB_TOPGEN]) == tg, bar);
            __builtin_amdgcn_fence(__ATOMIC_ACQUIRE, "agent");
            xb_add(&bar[XB_XGEN(b.x)], 1u);
            asm volatile("s_waitcnt vmcnt(0)" ::: "memory");
        } else {
            XB_SPIN(xb_ld(&bar[XB_XGEN(b.x)]) == gen, bar);
            __builtin_amdgcn_fence(__ATOMIC_ACQUIRE, "agent");
            asm volatile("s_waitcnt vmcnt(0)" ::: "memory");
        }
    }
    __syncthreads();
}

struct Params {
    const float *x, *c, *ctx, *c_ctx, *ada_w, *ada_b, *norm_g, *mlp_w1, *mlp_w2, *w_qkv, *w_o, *sink;
    const float *w_in, *conv_w, *conv_b, *w_a, *b_a, *w_i, *b_i, *lam, *w_out;
    float* out; unsigned char* ws;
};

typedef const __attribute__((address_space(4))) Params* ParamsK;
__device__ __forceinline__ void transpose_item(const float* W, int ldw, bf16_t* WT, int ldwt, int k0, int n0, int dst_row0, LAS float* scr, int lane) {
#pragma unroll 8
    for (int i = 0; i < 32; ++i) { const int kk = 2 * i + (lane >> 5); scr[kk * 33 + (lane & 31)] = W[(size_t)(k0 + kk) * ldw + n0 + (lane & 31)]; }
    asm volatile("s_waitcnt lgkmcnt(0)" ::: "memory");
    const int c = lane & 7;
#pragma unroll
    for (int j = 0; j < 4; ++j) { const int n = (lane >> 3) + 8 * j; const LAS float* s = scr + (8 * c) * 33 + n;
        u32x4 o; o.x = cvt_pk_bf16(s[0 * 33], s[1 * 33]); o.y = cvt_pk_bf16(s[2 * 33], s[3 * 33]); o.z = cvt_pk_bf16(s[4 * 33], s[5 * 33]); o.w = cvt_pk_bf16(s[6 * 33], s[7 * 33]);
        *(u32x4*)(WT + (size_t)(dst_row0 + n) * ldwt + k0 + 8 * c) = o; }
    asm volatile("s_waitcnt lgkmcnt(0)" ::: "memory");
}
__device__ __forceinline__ void transpose_plain(const float* W, int K, int N, bf16_t* WT, int r, LAS float* scr, int lane) {
    const int nblk = N / 32, kb = r / nblk, nb = r % nblk;
    transpose_item(W, N, WT, K, 64 * kb, 32 * nb, 32 * nb, scr, lane);
}

__device__ __forceinline__ void prologue(ParamsK p, LAS unsigned char* lds, int tid, int lane, int wave) {
    unsigned char* ws = p->ws;
    float* MOD = (float*)(ws + WS_MOD);
    if (blockIdx.x < 96) {
        LAS float* sl = (LAS float*)lds;
        LAS float* red = (LAS float*)(lds + 36864);
        for (int idx = tid; idx < 9216; idx += 512) { const int w = idx >> 10, k = idx & 1023; const float v = (w < 8) ? p->c[w * 1024 + k] : p->c_ctx[k]; sl[idx] = v / (1.0f + __expf(-v)); }
        __syncthreads();
        const int l = blockIdx.x / 48, n0 = (blockIdx.x % 48) * 128, kg = tid >> 5, cq = tid & 31;
        f32x4 acc[9];
#pragma unroll
        for (int w = 0; w < 9; ++w) acc[w] = (f32x4){0.f, 0.f, 0.f, 0.f};
        const float* wb = p->ada_w + (size_t)l * 1024 * 6144 + n0 + cq * 4;
#pragma unroll 4
        for (int it = 0; it < 64; ++it) { const int k = it * 16 + kg; const f32x4 w4 = *(const f32x4*)(wb + (size_t)k * 6144);
#pragma unroll
            for (int w = 0; w < 9; ++w) acc[w] += sl[w * 1024 + k] * w4; }
#pragma unroll
        for (int w = 0; w < 9; ++w) *(LAS f32x4*)(red + (kg * 9 + w) * 128 + cq * 4) = acc[w];
        __syncthreads();
        for (int idx = tid; idx < 9 * 128; idx += 512) { const int w = idx >> 7, n = idx & 127; float s = 0.f;
#pragma unroll
            for (int g = 0; g < 16; ++g) s += red[(g * 9 + w) * 128 + n];
            MOD[(size_t)(l * 9 + w) * 6144 + n0 + n] = s + p->ada_b[l * 6144 + n0 + n]; }
        __syncthreads();
    }
    if (blockIdx.x == gridDim.x - 1) {
        float* rope = (float*)(ws + WS_ROPE); float* nls = (float*)(ws + WS_NLS);
        for (int idx = tid; idx < 1024; idx += 512) { const int pos = idx >> 4, i = idx & 15;
            const float inv = __builtin_exp2f(-(float)i * (13.287712379549449f / 16.0f));
            const float angf = (float)pos * inv; const double ang = (double)angf;
            const double twopi = 6.283185307179586476925287; const double r = ang - twopi * __builtin_rint(ang / twopi);
            const double r2 = r * r; double cterm = 1.0, sterm = r, cs = 1.0, sn = r;
            for (int k = 1; k <= 14; ++k) { cterm *= -r2 / (double)((2 * k - 1) * (2 * k)); sterm *= -r2 / (double)((2 * k) * (2 * k + 1)); cs += cterm; sn += sterm; }
            rope[idx * 2] = (float)cs; rope[idx * 2 + 1] = (float)sn; }
        for (int idx = tid; idx < 2 * DRNN; idx += 512) { const float lm = p->lam[idx]; nls[idx] = -8.0f * log1pf(__expf(-lm)); }
    }
    LAS float* scr = (LAS float*)(lds + wave * 16384);
    const int gw = blockIdx.x * 8 + wave, NGW = gridDim.x * 8;
    constexpr int I_QKV = 16 * 48, I_O = 16 * 32, I_1 = 16 * 128, I_2 = 64 * 32, I_IN = 16 * 80, I_OUT = 20 * 32, I_G = 40 * 16;
    constexpr int NITEMS = I_QKV + I_O + 2 * I_1 + 2 * I_2 + I_IN + I_OUT + I_G;
    for (int it = gw; it < NITEMS; it += NGW) {
        int r = it;
        if (r < I_QKV) { transpose_plain(p->w_qkv, 1024, NQKV, (bf16_t*)(ws + WS_WQKV), r, scr, lane); continue; } r -= I_QKV;
        if (r < I_O) { transpose_plain(p->w_o, 1024, 1024, (bf16_t*)(ws + WS_WO), r, scr, lane); continue; } r -= I_O;
        if (r < 2 * I_1) { const int l = r / I_1; transpose_plain(p->mlp_w1 + (size_t)l * 1024 * DFF, 1024, DFF, (bf16_t*)(ws + WS_W1 + (size_t)l * 16 * MiB), r % I_1, scr, lane); continue; } r -= 2 * I_1;
        if (r < 2 * I_2) { const int l = r / I_2; transpose_plain(p->mlp_w2 + (size_t)l * 1024 * DFF, DFF, 1024, (bf16_t*)(ws + WS_W2 + (size_t)l * 16 * MiB), r % I_2, scr, lane); continue; } r -= 2 * I_2;
        if (r < I_IN) { transpose_plain(p->w_in, 1024, 2 * DRNN, (bf16_t*)(ws + WS_WIN), r, scr, lane); continue; } r -= I_IN;
        if (r < I_OUT) { transpose_plain(p->w_out, DRNN, 1024, (bf16_t*)(ws + WS_WOUT), r, scr, lane); continue; } r -= I_OUT;
        {
            const int sm = r >> 4, ii = r & 15, kb = ii >> 2, nb = ii & 3;
            const int chalf = sm & 1, blk = (sm >> 1) % 5, dg = (sm >> 1) / 5, gate = dg & 1, dir = dg >> 1;
            const float* W = (gate ? p->w_i : p->w_a) + (size_t)(dir * 5 + blk) * 256 * 256;
            const int dst_row0 = ((dir * 5 + blk) * 2 + chalf) * 256 + gate * 128 + nb * 32;
            transpose_item(W, 256, (bf16_t*)(ws + WS_WG), 256, 64 * kb, chalf * 128 + nb * 32, dst_row0, scr, lane);
        }
    }
}

template <bool HAS_Y, bool HAS_H>
__device__ __forceinline__ void row_phase(const float* xin_lat, const float* xin_ctx, float* xout_lat, float* xout_ctx, const bf16_t* Y, const bf16_t* SLAB, bf16_t* H,
                                          const float* gy, const float* gh, const float* mod_g, int gate_idx, const float* mod_h, int shift_idx, int scale_idx,
                                          int nrows, int gw, int ngw, int lane) {
    for (int row = gw; row < nrows; row += ngw) {
        const bool lat = row < ML; const int who = lat ? (row >> 11) : 8;
        const float* xi = lat ? xin_lat + (size_t)row * DM : xin_ctx + (size_t)(row - ML) * DM;
        f32x4 xv[4];
#pragma unroll
        for (int j = 0; j < 4; ++j) xv[j] = *(const f32x4*)(xi + lane * 4 + 256 * j);
        if (HAS_Y) {
            f32x4 yv[4]; float s = 0.f;
#pragma unroll
            for (int j = 0; j < 4; ++j) {
                if (SLAB != nullptr && !lat) { const bf16_t* yp = SLAB + (size_t)(row - ML) * DM + lane * 4 + 256 * j;
                    yv[j] = (bf4_to_f32(*(const u32x2*)yp) + bf4_to_f32(*(const u32x2*)(yp + (size_t)MC * DM))) + (bf4_to_f32(*(const u32x2*)(yp + (size_t)2 * MC * DM)) + bf4_to_f32(*(const u32x2*)(yp + (size_t)3 * MC * DM))); }
                else yv[j] = bf4_to_f32(*(const u32x2*)(Y + (size_t)row * DM + lane * 4 + 256 * j));
                s += (yv[j][0] * yv[j][0] + yv[j][1] * yv[j][1]) + (yv[j][2] * yv[j][2] + yv[j][3] * yv[j][3]); }
            const float rstd = 1.0f / sqrtf(wave_sum(s) * (1.0f / DM) + EPS);
            float* xo = lat ? xout_lat + (size_t)row * DM : xout_ctx + (size_t)(row - ML) * DM;
#pragma unroll
            for (int j = 0; j < 4; ++j) { const int col = lane * 4 + 256 * j;
                const f32x4 g = *(const f32x4*)(gy + col), gt = *(const f32x4*)(mod_g + (size_t)who * 6144 + gate_idx * 1024 + col);
                xv[j] = xv[j] + gt * (yv[j] * rstd * g);
                *(f32x4*)(xo + col) = xv[j]; }
        }
        if (HAS_H) {
            float s = 0.f;
#pragma unroll
            for (int j = 0; j < 4; ++j) s += (xv[j][0] * xv[j][0] + xv[j][1] * xv[j][1]) + (xv[j][2] * xv[j][2] + xv[j][3] * xv[j][3]);
            const float rstd = 1.0f / sqrtf(wave_sum(s) * (1.0f / DM) + EPS);
#pragma unroll
            for (int j = 0; j < 4; ++j) { const int col = lane * 4 + 256 * j;
                const f32x4 g = *(const f32x4*)(gh + col), sh = *(const f32x4*)(mod_h + (size_t)who * 6144 + shift_idx * 1024 + col), sc = *(const f32x4*)(mod_h + (size_t)who * 6144 + scale_idx * 1024 + col);
                const f32x4 hv = (xv[j] * rstd * g) * (1.0f + sc) + sh;
                *(u32x2*)(H + (size_t)row * DM + col) = f32_to_bf4(hv); }
        }
    }
}

__device__ __forceinline__ void attn_phase(LAS unsigned char* lds, const bf16_t* Q, bf16_t* O, const bf16_t* Kb, const bf16_t* VT, const bf16_t* VTC, const float* sink, int tid, int lane, int wave) {
    constexpr int PITCH = 72;
    LAS bf16_t* Ks = (LAS bf16_t*)lds;
    LAS bf16_t* Vs = (LAS bf16_t*)(lds + 2 * 64 * PITCH * 2);
    const int lr = lane & 15, lg = lane >> 4;
    const int skey = tid >> 3, spiece = tid & 7;
    for (int unit = blockIdx.x; unit < 576; unit += gridDim.x) {
        int b, kvh, qrow0, qblk, nloc, lt0; bool latu = unit < 512;
        if (latu) { b = unit >> 6; const int rem = unit & 63; qblk = rem >> 2; kvh = rem & 3; qrow0 = b * SEQ + qblk * 128; lt0 = (qblk == 0) ? 2 : 0; nloc = ((qblk == 15) ? 4 : 6) - lt0; }
        else { const int cu = unit - 512; b = cu >> 3; kvh = (cu & 7) >> 1; qblk = 0; qrow0 = ML + b * CTX + (cu & 1) * 128; lt0 = 0; nloc = 0; }
        const int nT = nloc + 4;
        const int head = kvh * 4 + (wave >> 1);
        const int qr0 = qrow0 + (wave & 1) * 64;
        const bf16_t* qbase = Q + (size_t)qr0 * 1024 + head * 64;
        bf16_t* obase = O + (size_t)qr0 * 1024 + head * 64;
        LAS unsigned char* Qs = lds + 40960 + wave * 8192;
#pragma unroll
        for (int qt = 0; qt < 4; ++qt)
#pragma unroll
            for (int dh = 0; dh < 2; ++dh) *(LAS bf16x8*)(Qs + (qt * 2 + dh) * 1024 + lane * 16) = *(const bf16x8*)(qbase + (unsigned)((qt * 16 + lr) * 1024 + dh * 32 + lg * 8));
        f32x4 o[4][4];
#pragma unroll
        for (int qt = 0; qt < 4; ++qt)
#pragma unroll
            for (int dt = 0; dt < 4; ++dt) o[qt][dt] = (f32x4){0.f, 0.f, 0.f, 0.f};
        float m2[4], ls[4];
        { const float sk = sink[head] * LOG2E;
#pragma unroll
          for (int qt = 0; qt < 4; ++qt) { m2[qt] = sk; ls[qt] = (lg == 0) ? 1.0f : 0.0f; } }
        u32x4 kreg, vreg;
#define ATT_LOAD(j) do { const int _j = (j); if (_j < nloc) { const int tok0 = (qblk - 1) * 128 + (lt0 + _j) * 64; \
                const bf16_t* kb_ = Kb + (size_t)(b * SEQ + tok0) * 256 + kvh * 64; const bf16_t* vb_ = VT + (size_t)(b * 4 + kvh) * 64 * SEQ + tok0; \
                kreg = *(const u32x4*)(kb_ + (unsigned)(skey * 256 + spiece * 8)); vreg = *(const u32x4*)(vb_ + (unsigned)(skey * SEQ + spiece * 8)); } \
            else { const int tok0 = (_j - nloc) * 64; \
                const bf16_t* kb_ = Kb + (size_t)(ML + b * CTX + tok0) * 256 + kvh * 64; const bf16_t* vb_ = VTC + (size_t)(b * 4 + kvh) * 64 * CTX + tok0; \
                kreg = *(const u32x4*)(kb_ + (unsigned)(skey * 256 + spiece * 8)); vreg = *(const u32x4*)(vb_ + (unsigned)(skey * CTX + spiece * 8)); } } while (0)
#define ATT_STORE(buf) do { *(LAS u32x4*)(Ks + (buf) * 64 * PITCH + skey * PITCH + spiece * 8) = kreg; *(LAS u32x4*)(Vs + (buf) * 64 * PITCH + skey * PITCH + spiece * 8) = vreg; } while (0)
        __syncthreads();
        ATT_LOAD(0); ATT_STORE(0);
        __syncthreads();
        for (int j = 0; j < nT; ++j) {
            const int buf = j & 1;
            if (j + 1 < nT) ATT_LOAD(j + 1);
            const LAS bf16_t* Kt = Ks + buf * 64 * PITCH; const LAS bf16_t* Vt = Vs + buf * 64 * PITCH;
            int mmode = 0, ktok0 = 0;
            if (j < nloc) { const int lt = lt0 + j; ktok0 = (qblk - 1) * 128 + lt * 64; mmode = (lt < 2) ? 1 : ((lt >= 4) ? 2 : 0); }
            bf16x8 kf[4][2];
#pragma unroll
            for (int ks = 0; ks < 4; ++ks)
#pragma unroll
                for (int dh = 0; dh < 2; ++dh) kf[ks][dh] = *(const LAS bf16x8*)(Kt + (ks * 16 + lr) * PITCH + dh * 32 + lg * 8);
#pragma unroll
            for (int hq = 0; hq < 2; ++hq) {
            bf16x8 pb[2][2];
#pragma unroll
            for (int q2 = 0; q2 < 2; ++q2) {
                const int qt = hq * 2 + q2;
                f32x4 s[4];
                const bf16x8 qf0 = *(const LAS bf16x8*)(Qs + (qt * 2 + 0) * 1024 + lane * 16), qf1 = *(const LAS bf16x8*)(Qs + (qt * 2 + 1) * 1024 + lane * 16);
#pragma unroll
                for (int ks = 0; ks < 4; ++ks) { s[ks] = __builtin_amdgcn_mfma_f32_16x16x32_bf16(kf[ks][0], qf0, (f32x4){0.f, 0.f, 0.f, 0.f}, 0, 0, 0);
                    s[ks] = __builtin_amdgcn_mfma_f32_16x16x32_bf16(kf[ks][1], qf1, s[ks], 0, 0, 0); }
                if (mmode) { const int qp = qblk * 128 + (wave & 1) * 64 + qt * 16 + lr;
#pragma unroll
                    for (int ks = 0; ks < 4; ++ks)
#pragma unroll
                        for (int jj = 0; jj < 4; ++jj) { const int kp = ktok0 + ks * 16 + lg * 4 + jj; const bool ok = (mmode == 1) ? (kp >= qp - 128) : (kp <= qp + 128); s[ks][jj] = ok ? s[ks][jj] : -1e30f; } }
                float mx = -3e38f;
#pragma unroll
                for (int ks = 0; ks < 4; ++ks) mx = fmaxf(mx, fmaxf(fmaxf(s[ks][0], s[ks][1]), fmaxf(s[ks][2], s[ks][3])));
                mx = fmaxf(mx, __shfl_xor(mx, 16)); mx = fmaxf(mx, __shfl_xor(mx, 32));
                const float mnew = fmaxf(m2[qt], mx * LOG2E);
                const float alpha = __builtin_amdgcn_exp2f(m2[qt] - mnew);
                m2[qt] = mnew;
                float rs = 0.f;
#pragma unroll
                for (int ks = 0; ks < 4; ++ks)
#pragma unroll
                    for (int jj = 0; jj < 4; ++jj) { const float pv = __builtin_amdgcn_exp2f(s[ks][jj] * LOG2E - mnew); s[ks][jj] = pv; rs += pv; }
                ls[qt] = ls[qt] * alpha + rs;
#pragma unroll
                for (int dt = 0; dt < 4; ++dt) o[qt][dt] = o[qt][dt] * alpha;
#pragma unroll
                for (int c2 = 0; c2 < 2; ++c2) { u32x4 w; w.x = cvt_pk_bf16(s[2 * c2][0], s[2 * c2][1]); w.y = cvt_pk_bf16(s[2 * c2][2], s[2 * c2][3]); w.z = cvt_pk_bf16(s[2 * c2 + 1][0], s[2 * c2 + 1][1]); w.w = cvt_pk_bf16(s[2 * c2 + 1][2], s[2 * c2 + 1][3]);
                    pb[q2][c2] = __builtin_bit_cast(bf16x8, w); }
            }
#pragma unroll
            for (int c2 = 0; c2 < 2; ++c2)
#pragma unroll
                for (int dt = 0; dt < 4; ++dt) {
                    const LAS bf16_t* vp = Vt + (dt * 16 + lr) * PITCH + c2 * 32 + lg * 4;
                    const u32x2 v0 = *(const LAS u32x2*)vp, v1 = *(const LAS u32x2*)(vp + 16);
                    const u32x4 vv = {v0.x, v0.y, v1.x, v1.y};
                    const bf16x8 vf = __builtin_bit_cast(bf16x8, vv);
#pragma unroll
                    for (int q2 = 0; q2 < 2; ++q2) o[hq * 2 + q2][dt] = __builtin_amdgcn_mfma_f32_16x16x32_bf16(vf, pb[q2][c2], o[hq * 2 + q2][dt], 0, 0, 0);
                }
            }
            if (j + 1 < nT) ATT_STORE(buf ^ 1);
            __syncthreads();
        }
#pragma unroll
        for (int qt = 0; qt < 4; ++qt) {
            float l = ls[qt]; l += __shfl_xor(l, 16); l += __shfl_xor(l, 32);
            const float inv = 1.0f / l;
            int lro = lr * 1024 + lg * 4; asm volatile("" : "+v"(lro));
            bf16_t* op = obase + (unsigned)(qt * 16 * 1024 + lro);
#pragma unroll
            for (int dt = 0; dt < 4; ++dt) *(u32x2*)(op + dt * 16) = f32_to_bf4(o[qt][dt] * inv);
        }
    }
#undef ATT_LOAD
#undef ATT_STORE
}

__device__ __forceinline__ void conv_phase(const bf16_t* R, bf16_t* U, const float* cw, const float* cb, int gtid, int nthreads) {
    for (int idx = gtid; idx < MT * 160; idx += nthreads) {
        const int row = idx / 160, ch = (idx % 160) * 8;
        int t, T; if (row < ML) { t = row & 2047; T = SEQ; } else { t = (row - ML) & 255; T = CTX; }
        float acc[8];
        { const f32x4 b0 = *(const f32x4*)(cb + ch), b1 = *(const f32x4*)(cb + ch + 4); acc[0] = b0[0]; acc[1] = b0[1]; acc[2] = b0[2]; acc[3] = b0[3]; acc[4] = b1[0]; acc[5] = b1[1]; acc[6] = b1[2]; acc[7] = b1[3]; }
#pragma unroll
        for (int tap = 0; tap < 4; ++tap) { const int tt = t + tap - 2;
            if (tt >= 0 && tt < T) { const u32x4 rv = *(const u32x4*)(R + (size_t)(row + tap - 2) * DRNN + ch);
                const f32x4 w0 = *(const f32x4*)(cw + tap * DRNN + ch), w1 = *(const f32x4*)(cw + tap * DRNN + ch + 4);
                acc[0] += w0[0] * bf_lo(rv.x); acc[1] += w0[1] * bf_hi(rv.x); acc[2] += w0[2] * bf_lo(rv.y); acc[3] += w0[3] * bf_hi(rv.y);
                acc[4] += w1[0] * bf_lo(rv.z); acc[5] += w1[1] * bf_hi(rv.z); acc[6] += w1[2] * bf_lo(rv.w); acc[7] += w1[3] * bf_hi(rv.w); } }
        u32x4 o; o.x = cvt_pk_bf16(acc[0], acc[1]); o.y = cvt_pk_bf16(acc[2], acc[3]); o.z = cvt_pk_bf16(acc[4], acc[5]); o.w = cvt_pk_bf16(acc[6], acc[7]);
        *(u32x4*)(U + (size_t)row * DRNN + ch) = o;
    }
}
__device__ __forceinline__ int scan_row0(int bl, int c) { return (c < 8) ? (8192 + bl * CTX + c * 32) : (bl * SEQ + (c - 8) * 32); }
__device__ __forceinline__ void scanA_phase(const bf16_t* LA, const bf16_t* BX, float* SP, float* SH, int gtid, int nthreads) {
    for (int idx = gtid; idx < 2 * 4 * 72 * 640; idx += nthreads) {
        const int cp = idx % 640, r1 = idx / 640, c = r1 % 72, r2 = r1 / 72, bl = r2 & 3, dir = r2 >> 2;
        const int row0 = scan_row0(bl, c);
        const size_t base = ((size_t)dir * 9216 + row0) * DRNN + cp * 2;
        float P0 = 1.f, P1 = 1.f, H0 = 0.f, H1 = 0.f;
#pragma unroll 8
        for (int i = 0; i < 32; ++i) { const int ii = dir ? (31 - i) : i;
            const unsigned lw = *(const unsigned*)(LA + base + (size_t)ii * DRNN), bw = *(const unsigned*)(BX + base + (size_t)ii * DRNN);
            const float a0 = __expf(bf_lo(lw)), a1 = __expf(bf_hi(lw));
            P0 *= a0; P1 *= a1; H0 = a0 * H0 + bf_lo(bw); H1 = a1 * H1 + bf_hi(bw); }
        const size_t so = ((size_t)(dir * 4 + bl) * 72 + c) * DRNN + cp * 2;
        *(f32x2*)(SP + so) = (f32x2){P0, P1}; *(f32x2*)(SH + so) = (f32x2){H0, H1};
    }
}
__device__ __forceinline__ void scanB_phase(const float* SP, const float* SH, float* CIN, int gtid, int nthreads) {
    for (int idx = gtid; idx < 2 * 4 * DRNN; idx += nthreads) {
        const int ch = idx % DRNN, r = idx / DRNN, bl = r & 3, dir = r >> 2;
        const size_t base = ((size_t)(dir * 4 + bl) * 72) * DRNN + ch;
        float carry = 0.f;
#pragma unroll 1
        for (int s0 = 0; s0 < 72; s0 += 24) {
            float pv[24], hv[24];
#pragma unroll
            for (int s = 0; s < 24; ++s) { const int sq = s0 + s; const int c = dir ? (sq < 8 ? 7 - sq : 79 - sq) : sq; pv[s] = SP[base + (size_t)c * DRNN]; hv[s] = SH[base + (size_t)c * DRNN]; }
#pragma unroll
            for (int s = 0; s < 24; ++s) { const int sq = s0 + s; const int c = dir ? (sq < 8 ? 7 - sq : 79 - sq) : sq; CIN[base + (size_t)c * DRNN] = carry; carry = pv[s] * carry + hv[s]; }
        }
    }
}
__device__ __forceinline__ void scanC_phase(const bf16_t* LA, const bf16_t* BX, const float* CIN, bf16_t* REC, int half, int gtid, int nthreads) {
    for (int idx = gtid; idx < 4 * 64 * 640; idx += nthreads) {
        const int cp = idx % 640, r1 = idx / 640, lc = r1 & 63, bl = r1 >> 6;
        const int row0 = bl * SEQ + lc * 32;
        const size_t b0 = ((size_t)row0) * DRNN + cp * 2, b1 = ((size_t)9216 + row0) * DRNN + cp * 2;
        const f32x2 cf = *(const f32x2*)(CIN + ((size_t)(0 * 4 + bl) * 72 + 8 + lc) * DRNN + cp * 2);
        const f32x2 cbk = *(const f32x2*)(CIN + ((size_t)(1 * 4 + bl) * 72 + 8 + lc) * DRNN + cp * 2);
        float hf0[32], hf1[32];
        float h0 = cf[0], h1 = cf[1];
#pragma unroll
        for (int i = 0; i < 32; ++i) { const unsigned lw = *(const unsigned*)(LA + b0 + (size_t)i * DRNN), bw = *(const unsigned*)(BX + b0 + (size_t)i * DRNN);
            h0 = __expf(bf_lo(lw)) * h0 + bf_lo(bw); h1 = __expf(bf_hi(lw)) * h1 + bf_hi(bw); hf0[i] = h0; hf1[i] = h1; }
        h0 = cbk[0]; h1 = cbk[1];
        bf16_t* out = REC + ((size_t)(half * 4 + bl) * SEQ + lc * 32) * DRNN + cp * 2;
#pragma unroll
        for (int i = 31; i >= 0; --i) { const unsigned lw = *(const unsigned*)(LA + b1 + (size_t)i * DRNN), bw = *(const unsigned*)(BX + b1 + (size_t)i * DRNN);
            h0 = __expf(bf_lo(lw)) * h0 + bf_lo(bw); h1 = __expf(bf_hi(lw)) * h1 + bf_hi(bw);
            *(unsigned*)(out + (size_t)i * DRNN) = cvt_pk_bf16(hf0[i] + h0, hf1[i] + h1); }
    }
}

#ifndef PH_MASK
#define PH_MASK 0xFFFFFFFFu
#endif
#define PH(k) ((PH_MASK >> (k)) & 1u)
#ifndef REP_MASK
#define REP_MASK 0u
#endif
#define REP_BEGIN(k) _Pragma("unroll 1") for (int rep_ = 0; rep_ < (((REP_MASK >> (k)) & 1u) ? 2 : 1); ++rep_) {
#define REP_END }
__device__ __forceinline__ ParamsK kparams() { ParamsK q = (ParamsK)__builtin_amdgcn_kernarg_segment_ptr(); asm volatile("" : "+s"(q)); return q; }
#define PHASE_BEGIN ParamsK kp = kparams(); unsigned char* ws = kp->ws; (void)ws; \
    int tid = threadIdx.x; asm volatile("" : "+v"(tid)); const int lane = tid & 63, wave = __builtin_amdgcn_readfirstlane(tid >> 6); \
    const int gw = bid * 8 + wave, gtid = bid * 512 + tid; (void)lane; (void)gw; (void)gtid;
#define P_MOD0 ((float*)(ws + WS_MOD))
#define P_MOD1 ((float*)(ws + WS_MOD) + 9 * 6144)
#define P_CTXRES ((float*)(ws + WS_CTXRES))
#define P_H ((bf16_t*)(ws + WS_H))
#define P_SLAB ((bf16_t*)(ws + WS_SLAB))
#define P_Q ((bf16_t*)(ws + WS_Q))
#define P_O ((bf16_t*)(ws + WS_O))
#define P_K ((bf16_t*)(ws + WS_K))
#define P_VT ((bf16_t*)(ws + WS_VT))
#define P_VTC ((bf16_t*)(ws + WS_VTC))
#define P_ACT ((bf16_t*)(ws + WS_ACT))
#define P_U ((bf16_t*)(ws + WS_U))
#define P_RECF ((bf16_t*)(ws + WS_RECF))
#define P_RECB ((bf16_t*)(ws + WS_RECB))
#define P_LA ((bf16_t*)(ws + WS_LA))
#define P_BX ((bf16_t*)(ws + WS_BX))
#define P_RPRE ((bf16_t*)(ws + WS_RPRE))
#define P_SP ((float*)(ws + WS_SP))
#define P_SH ((float*)(ws + WS_SH))
#define P_CIN ((float*)(ws + WS_CIN))
#define G0 (kp->norm_g)
#define G1 (kp->norm_g + 4 * DM)

__global__ void __launch_bounds__(512, 2) fwd_megakernel(Params p) {
    extern __shared__ __attribute__((aligned(16))) unsigned char lds_raw[];
    LAS unsigned char* lds = (LAS unsigned char*)lds_raw;
    const int G = gridDim.x, bid = blockIdx.x;
    const int ngw = G * 8, nthreads = G * 512;
    using namespace pg8;
    if (threadIdx.x < 4) ((volatile LAS unsigned*)(lds + 132096))[threadIdx.x] = 0u;
    __syncthreads();
    XcdBarrier xbar = xcd_barrier_post((unsigned*)(p.ws + WS_BAR), (volatile LAS unsigned*)(lds + 132096));
    if (PH(0)) { PHASE_BEGIN prologue(kp, lds, tid, lane, wave); }
    xcd_barrier(xbar);
#ifdef EXTRA_SYNCS
#pragma unroll 1
    for (int es = 0; es < EXTRA_SYNCS; ++es) xcd_barrier(xbar);
#endif
    REP_BEGIN(1)
    if (PH(1)) { PHASE_BEGIN row_phase<false, true>(kp->x, kp->ctx, nullptr, nullptr, nullptr, nullptr, P_H, nullptr, G0, nullptr, 0, P_MOD0, 0, 1, MT, gw, ngw, lane); }
    xcd_barrier(xbar);
    REP_END
    if (PH(2)) {
        PHASE_BEGIN
        Gemm g{P_H, (const bf16_t*)(ws + WS_WQKV), DM, DM, DM}; Sched S; S.init(MT / 256, NQKV / 256, G, bid);
        EpiQKV E{P_Q, P_K, P_VT, P_VTC, (const float*)(ws + WS_ROPE)};
        gemm_phase<EpiQKV, true, true>(lds, g, S, E);
    }
    xcd_barrier(xbar);
    REP_BEGIN(3)
    if (PH(3)) { PHASE_BEGIN attn_phase(lds, P_Q, P_O, P_K, P_VT, P_VTC, kp->sink, tid, lane, wave); }
    xcd_barrier(xbar);
    REP_END
    if (PH(4)) {
        PHASE_BEGIN
        { Gemm g{P_O, (const bf16_t*)(ws + WS_WO), DM, DM, DM}; Sched S; S.init(ML / 256, DM / 256, G, bid);
          EpiPlain<0> E{P_H, DM};
          gemm_phase<EpiPlain<0>, true, true>(lds, g, S, E); }
        { Gemm g{P_O, (const bf16_t*)(ws + WS_WO), DM, DM, 256}; Sched S; S.init(8, 4 * 4, G, bid, 2, 256);
          EpiSlabCtx E{P_SLAB, 256};
          gemm_phase<EpiSlabCtx, true, true>(lds, g, S, E); }
    }
    xcd_barrier(xbar);
    if (PH(5)) { PHASE_BEGIN row_phase<true, true>(kp->x, kp->ctx, kp->out, P_CTXRES, P_H, P_SLAB, P_H, G0 + DM, G0 + 2 * DM, P_MOD0, 2, P_MOD0, 3, 4, MT, gw, ngw, lane); }
    xcd_barrier(xbar);
    if (PH(6)) {
        PHASE_BEGIN
        Gemm g{P_H, (const bf16_t*)(ws + WS_W1), DM, DM, DM}; Sched S; S.init(MT / 256, DFF / 256, G, bid);
        EpiPlain<1> E{P_ACT, DFF};
        gemm_phase<EpiPlain<1>, true, true>(lds, g, S, E);
    }
    xcd_barrier(xbar);
    if (PH(7)) {
        PHASE_BEGIN
        { Gemm g{P_ACT, (const bf16_t*)(ws + WS_W2), DFF, DFF, DFF}; Sched S; S.init(ML / 256, DM / 256, G, bid);
          EpiPlain<0> E{P_H, DM};
          gemm_phase<EpiPlain<0>, true, true>(lds, g, S, E); }
        { Gemm g{P_ACT, (const bf16_t*)(ws + WS_W2), DFF, DFF, 1024}; Sched S; S.init(8, 4 * 4, G, bid, 2, 1024);
          EpiSlabCtx E{P_SLAB, 1024};
          gemm_phase<EpiSlabCtx, true, true>(lds, g, S, E); }
    }
    xcd_barrier(xbar);
    if (PH(8)) { PHASE_BEGIN row_phase<true, true>(kp->out, P_CTXRES, kp->out, P_CTXRES, P_H, P_SLAB, P_H, G0 + 3 * DM, G1, P_MOD0, 5, P_MOD1, 0, 1, MT, gw, ngw, lane); }
    xcd_barrier(xbar);
    if (PH(9)) {
        PHASE_BEGIN
        Gemm g{P_H, (const bf16_t*)(ws + WS_WIN) + (size_t)DRNN * DM, DM, DM, DM}; Sched S; S.init(MT / 256, DRNN / 256, G, bid);
        EpiPlain<0> E{P_RPRE, DRNN};
        gemm_phase<EpiPlain<0>, true, true>(lds, g, S, E);
    }
    xcd_barrier(xbar);
    REP_BEGIN(10)
    if (PH(10)) { PHASE_BEGIN conv_phase(P_RPRE, P_U, kp->conv_w, kp->conv_b, gtid, nthreads); }
    xcd_barrier(xbar);
    REP_END
    if (PH(11)) {
        PHASE_BEGIN
        Gemm g{P_U, (const bf16_t*)(ws + WS_WG), DRNN, 256, 256, (bid >> 1) & 1}; Sched S; S.init(1, 1, G, bid, 3, 0);
        EpiGatesScan E{P_U, P_RECF, P_RECB, kp->b_a, kp->b_i, (const float*)(ws + WS_NLS)};
        gemm_phase<EpiGatesScan, true, true>(lds, g, S, E);
    }
    xcd_barrier(xbar);
    if (PH(15)) {
        PHASE_BEGIN
        Gemm g{P_H, (const bf16_t*)(ws + WS_WIN), DM, DM, DM}; Sched S; S.init(ML / 256, DRNN / 256, G, bid);
        EpiGateMul E{P_RECF, P_RECB};
        gemm_phase<EpiGateMul, true, true>(lds, g, S, E);
    }
    xcd_barrier(xbar);
    if (PH(16)) {
        PHASE_BEGIN
        Gemm g{P_RECF, (const bf16_t*)(ws + WS_WOUT), DRNN, DRNN, DRNN}; Sched S; S.init(ML / 256, DM / 256, G, bid);
        EpiPlain<0> E{P_H, DM};
        gemm_phase<EpiPlain<0>, true, true>(lds, g, S, E);
    }
    xcd_barrier(xbar);
    if (PH(17)) { PHASE_BEGIN row_phase<true, true>(kp->out, P_CTXRES, kp->out, P_CTXRES, P_H, nullptr, P_H, G1 + DM, G1 + 2 * DM, P_MOD1, 2, P_MOD1, 3, 4, ML, gw, ngw, lane); }
    xcd_barrier(xbar);
    if (PH(18)) {
        PHASE_BEGIN
        Gemm g{P_H, (const bf16_t*)(ws + WS_W1 + 16 * MiB), DM, DM, DM}; Sched S; S.init(ML / 256, DFF / 256, G, bid);
        EpiPlain<1> E{P_ACT, DFF};
        gemm_phase<EpiPlain<1>, true, true>(lds, g, S, E);
    }
    xcd_barrier(xbar);
    if (PH(19)) {
        PHASE_BEGIN
        Gemm g{P_ACT, (const bf16_t*)(ws + WS_W2 + 16 * MiB), DFF, DFF, DFF}; Sched S; S.init(ML / 256, DM / 256, G, bid);
        EpiPlain<0> E{P_H, DM};
        gemm_phase<EpiPlain<0>, true, true>(lds, g, S, E);
    }
    xcd_barrier(xbar);
    if (PH(20)) { PHASE_BEGIN row_phase<true, false>(kp->out, P_CTXRES, kp->out, P_CTXRES, P_H, nullptr, nullptr, G1 + 3 * DM, nullptr, P_MOD1, 5, nullptr, 0, 0, ML, gw, ngw, lane); }
}

extern "C" void kernel_launch(void* const* d_in, const int* in_sizes, int n_in, void* d_out, int out_size, void* d_ws, size_t ws_size, hipStream_t stream) {
    static int grid_blocks = 0;
    if (grid_blocks == 0) {
        if (n_in != 21 || ws_size < WS_END) { fprintf(stderr, "kernel_launch: unexpected n_in %d / ws_size %zu\n", n_in, ws_size); grid_blocks = -1; return; }
        int dev = 0, cus = 0, per_cu = 0;
        hipGetDevice(&dev);
        hipDeviceGetAttribute(&cus, hipDeviceAttributeMultiprocessorCount, dev);
        if (hipFuncSetAttribute((const void*)fwd_megakernel, hipFuncAttributeMaxDynamicSharedMemorySize, LDS_BYTES) != hipSuccess) { fprintf(stderr, "hipFuncSetAttribute failed\n"); grid_blocks = -1; return; }
        if (hipOccupancyMaxActiveBlocksPerMultiprocessor(&per_cu, (const void*)fwd_megakernel, 512, LDS_BYTES) != hipSuccess || per_cu < 1) { fprintf(stderr, "occupancy query failed (%d)\n", per_cu); (void)hipGetLastError(); per_cu = 1; }
        grid_blocks = cus * 1;
    }
    if (grid_blocks < 0) return;
    Params p{};
    p.x = (const float*)d_in[0]; p.c = (const float*)d_in[1]; p.ctx = (const float*)d_in[2]; p.c_ctx = (const float*)d_in[3];
    p.ada_w = (const float*)d_in[4]; p.ada_b = (const float*)d_in[5]; p.norm_g = (const float*)d_in[6]; p.mlp_w1 = (const float*)d_in[7]; p.mlp_w2 = (const float*)d_in[8];
    p.w_qkv = (const float*)d_in[9]; p.w_o = (const float*)d_in[10]; p.sink = (const float*)d_in[11];
    p.w_in = (const float*)d_in[12]; p.conv_w = (const float*)d_in[13]; p.conv_b = (const float*)d_in[14]; p.w_a = (const float*)d_in[15]; p.b_a = (const float*)d_in[16];
    p.w_i = (const float*)d_in[17]; p.b_i = (const float*)d_in[18]; p.lam = (const float*)d_in[19]; p.w_out = (const float*)d_in[20];
    p.out = (float*)d_out; p.ws = (unsigned char*)d_ws;
    if (hipMemsetAsync((unsigned char*)d_ws + WS_BAR, 0, XCD_BAR_WORDS * 4, stream) != hipSuccess) { fprintf(stderr, "memset of barrier words failed\n"); return; }
    void* args[] = {&p};
    hipError_t e = hipLaunchCooperativeKernel((const void*)fwd_megakernel, dim3(grid_blocks), dim3(512), args, LDS_BYTES, stream);
    if (e != hipSuccess) fprintf(stderr, "cooperative launch failed: %s (grid %d)\n", hipGetErrorString(e), grid_blocks);
}
```

```cpp
#include <hip/hip_runtime.h>
#include <hip/hip_cooperative_groups.h>
#include <cstdio>
#include <cstdint>
namespace cg = cooperative_groups;

#define LAS __attribute__((address_space(3)))
typedef unsigned short bf16_t;
typedef short bf16x8 __attribute__((ext_vector_type(8)));
typedef float f32x4 __attribute__((ext_vector_type(4)));
typedef float f32x2 __attribute__((ext_vector_type(2)));
typedef unsigned u32x4 __attribute__((ext_vector_type(4)));
typedef unsigned u32x2 __attribute__((ext_vector_type(2)));

constexpr int DM = 1024, NB = 8, SEQ = 2048, CTX = 256;
constexpr int ML = NB * SEQ;
constexpr int MC = NB * CTX;
constexpr int MT = ML + MC;
constexpr int NQKV = 1536, DFF = 4096, DRNN = 1280;
constexpr float EPS = 1e-6f;
constexpr float LOG2E = 1.4426950408889634f;

constexpr size_t MiB = 1u << 20;
constexpr size_t WS_MOD = 0;
constexpr size_t WS_ROPE = 448 * 1024;
constexpr size_t WS_NLS = 460 * 1024;
constexpr size_t WS_BAR = 480 * 1024;
constexpr size_t WS_WQKV = 1 * MiB, WS_WO = 4 * MiB, WS_W1 = 6 * MiB, WS_W2 = 14 * MiB;
constexpr size_t WS_WIN = 38 * MiB, WS_WG = 43 * MiB, WS_WOUT = 46 * MiB;
constexpr size_t WS_CTXRES = 49 * MiB;
constexpr size_t WS_H = 57 * MiB;
constexpr size_t WS_R3 = 93 * MiB;
constexpr size_t WS_Q = WS_R3, WS_K = 129 * MiB, WS_VT = 138 * MiB, WS_VTC = 146 * MiB;
constexpr size_t WS_O = 150 * MiB;
constexpr size_t WS_ACT = WS_R3;
constexpr size_t WS_U = WS_R3;
constexpr size_t WS_RECF = 138 * MiB;
constexpr size_t WS_RECB = 178 * MiB;
constexpr size_t WS_LA = 138 * MiB;
constexpr size_t WS_BX = 183 * MiB;
constexpr size_t WS_RPRE = 138 * MiB;
constexpr size_t WS_SP = 228 * MiB, WS_SH = 231 * MiB, WS_CIN = 234 * MiB;
constexpr size_t WS_SLAB = 238 * MiB;
constexpr size_t WS_END = 256 * MiB;
constexpr int LDS_BYTES = 135168;

__device__ __forceinline__ unsigned f2bf(float f) { unsigned u = __builtin_bit_cast(unsigned, f); return (u + 0x7fffu + ((u >> 16) & 1u)) >> 16; }
__device__ __forceinline__ unsigned cvt_pk_bf16(float lo, float hi) { unsigned r; asm volatile("v_cvt_pk_bf16_f32 %0, %1, %2" : "=v"(r) : "v"(lo), "v"(hi)); return r; }
__device__ __forceinline__ float bf_lo(unsigned w) { return __builtin_bit_cast(float, w << 16); }
__device__ __forceinline__ float bf_hi(unsigned w) { return __builtin_bit_cast(float, w & 0xffff0000u); }
__device__ __forceinline__ f32x4 bf4_to_f32(u32x2 w) { return (f32x4){bf_lo(w.x), bf_hi(w.x), bf_lo(w.y), bf_hi(w.y)}; }
__device__ __forceinline__ u32x2 f32_to_bf4(f32x4 v) { u32x2 w; w.x = cvt_pk_bf16(v[0], v[1]); w.y = cvt_pk_bf16(v[2], v[3]); return w; }
__device__ __forceinline__ float wave_sum(float v) {
#pragma unroll
    for (int o = 1; o < 64; o <<= 1) v += __shfl_xor(v, o);
    return v;
}
__device__ __forceinline__ float fsigmoid(float x) { return __builtin_amdgcn_rcpf(1.0f + __expf(-x)); }

namespace pg8 {
constexpr int BM = 256, BK = 64, HALF = 128, HTB = HALF * BK * 2, STAGE_BYTES = 8 * HTB, NXCD = 8, WGM = 8;
__device__ __forceinline__ int lds_byte(int r, int c) { const int st = (r >> 4) * 2 + (c >> 5), rr = r & 15, cc = c & 31, ob = rr * 64 + cc * 2; return st * 1024 + (ob ^ (((ob >> 9) & 1) << 5)); }
__device__ __forceinline__ void stage_rc(int b, int& R, int& C) { const int st = b / 1024, sb = b % 1024, swz = sb ^ (((sb >> 9) & 1) << 5); R = (st >> 1) * 16 + swz / 64; C = (st & 1) * 32 + (swz % 64) / 2; }

struct Unit { int pm, pn, koff, po, kboff; };
struct Gemm { const bf16_t* A; const bf16_t* Bt; int lda, ldb, K; int rev = 0; };

struct Sched {
    int nM, nN, nwg, G, c, mode, half;
    __device__ void init(int nM_, int nN_, int G_, int c_, int mode_ = 0, int half_ = 0) { nM = nM_; nN = nN_; nwg = nM * nN; G = G_; c = c_; mode = mode_; half = half_; }
    __device__ bool next(int i, Unit& u) const {
        if (mode == 3) {
            if (c >= 160 || i >= 9) return false;
            const int chalf = c & 1, dir = (c >> 1) & 1, bb = c >> 2, blk = bb % 5, b = bb / 5;
            u.pm = (i == 0) ? 64 + b : (dir ? b * 8 + (8 - i) : b * 8 + (i - 1));
            u.pn = (dir * 5 + blk) * 2 + chalf; u.koff = blk * 256; u.kboff = 0; u.po = i;
            return true;
        }
        const long L = (long)i * G + c; if (L >= nwg) return false;
        int wgid = (int)L; { const int q = nwg / NXCD, r = nwg % NXCD, xcd = wgid % NXCD, off = wgid / NXCD; wgid = (xcd < r ? xcd * (q + 1) : r * (q + 1) + (xcd - r) * q) + off; }
        const int nig = WGM * nN, gid = wgid / nig, fm = gid * WGM, gsz = (nM - fm) < WGM ? (nM - fm) : WGM;
        const int pmi = fm + ((wgid % nig) % gsz), pn = (wgid % nig) / gsz;
        u.pm = pmi; u.pn = pn; u.koff = 0; u.po = pmi; u.kboff = 0;
        if (mode == 2) { u.pm = 64 + pmi; u.pn = pn & 3; u.koff = (pn >> 2) * half; u.kboff = u.koff; }
        if (mode == 1) { u.pm = pmi < 32 ? 32 * half + pmi : 64 + 4 * half + (pmi - 32); u.koff = ((pn >> 1) % 5) * 256; }
        return true;
    }
};

template <class Epi, bool ALIGN_EPI, bool SP2>
__device__ __forceinline__ void gemm_phase(LAS unsigned char* lds, const Gemm g, const Sched& S, const Epi& E) {
    int tid = threadIdx.x; asm volatile("" : "+v"(tid));
    const int wid = __builtin_amdgcn_readfirstlane(tid >> 6), lane = tid & 63, wr = wid >> 2, wc = wid & 3, fr = lane & 15, fq = lane >> 4;
    const int K = g.K, nt = K / BK;
    unsigned voffA[2], voffB[2];
#pragma unroll
    for (int i = 0; i < 2; ++i) { int R, C; stage_rc(tid * 16 + i * 8192, R, C);
        voffA[i] = (unsigned)((g.rev ? 127 - R : R) * g.lda + C) * 2u; voffB[i] = (unsigned)(R * g.ldb + C) * 2u; }
    const size_t kstep = (size_t)(BK * 2);
    const long hstepA = g.rev ? -(long)HALF * g.lda * 2 : (long)HALF * g.lda * 2; const size_t hstepB = (size_t)HALF * g.ldb * 2;
    const size_t revoff = g.rev ? (size_t)HALF * g.lda * 2 : 0;
    const unsigned ldsw = (unsigned)wid * 1024u;
    const int aoff = lds_byte(wr * 64 + fr, fq * 8), boff = lds_byte(wc * 32 + fr, fq * 8);
#define PG8_SA(b, h) (((b) * 2 + (h)) * HTB)
#define PG8_SB(b, h) ((4 + (b) * 2 + (h)) * HTB)
#define PG8_STAGE(bufoff, gbase, voff) do { _Pragma("unroll") for (int _i = 0; _i < 2; ++_i) \
        __builtin_amdgcn_global_load_lds((const unsigned*)((const char*)(gbase) + (voff)[_i]), (LAS unsigned*)(lds + (bufoff) + ldsw + _i * 8192), 16, 0, 0); } while (0)
#define PG8_LDA(dst, b, h) do { _Pragma("unroll") for (int m = 0; m < 4; ++m) _Pragma("unroll") for (int k = 0; k < 2; ++k) dst[m][k] = *(const LAS bf16x8*)(lds + PG8_SA(b, h) + aoff + m * 2048 + k * 1024); } while (0)
#define PG8_LDB(dst, b, h) do { _Pragma("unroll") for (int n = 0; n < 2; ++n) _Pragma("unroll") for (int k = 0; k < 2; ++k) dst[n][k] = *(const LAS bf16x8*)(lds + PG8_SB(b, h) + boff + n * 2048 + k * 1024); } while (0)
#define PG8_MMA(ai, bj, At, Bt) do { __builtin_amdgcn_s_setprio(1); _Pragma("unroll") for (int m = 0; m < 4; ++m) _Pragma("unroll") for (int n = 0; n < 2; ++n) _Pragma("unroll") for (int k = 0; k < 2; ++k) \
        acc[ai][bj][m][n] = __builtin_amdgcn_mfma_f32_16x16x32_bf16(Bt[n][k], At[m][k], acc[ai][bj][m][n], 0, 0, 0); __builtin_amdgcn_s_setprio(0); } while (0)
#define PG8_WAIT_V(n) asm volatile("s_waitcnt vmcnt(" #n ")" ::: "memory")
#define PG8_WAIT_L(n) asm volatile("s_waitcnt lgkmcnt(" #n ")" ::: "memory")
#define PG8_BAR __builtin_amdgcn_s_barrier()
#define PG8_SCHED __builtin_amdgcn_sched_barrier(0)
    Unit cur, nxt; int ui = 0;
    if (!S.next(0, cur)) return;
    f32x4 acc[2][2][4][2];
#pragma unroll
    for (int a = 0; a < 2; ++a)
#pragma unroll
        for (int b = 0; b < 2; ++b)
#pragma unroll
            for (int m = 0; m < 4; ++m)
#pragma unroll
                for (int n = 0; n < 2; ++n) acc[a][b][m][n] = (f32x4){0.f, 0.f, 0.f, 0.f};
    bf16x8 At[4][2], B0[2][2], B1[2][2];
    const char* cA = (const char*)g.A + ((size_t)cur.pm * BM * g.lda + cur.koff) * 2 + revoff; const char* cB = (const char*)g.Bt + ((size_t)cur.pn * BM * g.ldb + cur.kboff) * 2;
    if constexpr (SP2) {
        PG8_STAGE(PG8_SB(0, 0), cB, voffB); PG8_STAGE(PG8_SB(0, 1), cB + hstepB, voffB); PG8_STAGE(PG8_SA(0, 0), cA, voffA); PG8_STAGE(PG8_SA(0, 1), cA + hstepA, voffA);
        if (wr == 1) PG8_BAR;
        PG8_WAIT_V(2); PG8_BAR;
        PG8_STAGE(PG8_SB(1, 0), cB + kstep, voffB); PG8_STAGE(PG8_SA(1, 0), cA + kstep, voffA); PG8_STAGE(PG8_SB(1, 1), cB + hstepB + kstep, voffB);
        PG8_WAIT_V(6); PG8_BAR;
    } else {
        PG8_STAGE(PG8_SB(0, 0), cB, voffB); PG8_STAGE(PG8_SA(0, 0), cA, voffA); PG8_STAGE(PG8_SB(0, 1), cB + hstepB, voffB); PG8_STAGE(PG8_SA(0, 1), cA + hstepA, voffA);
        if (wr == 1) PG8_BAR;
        PG8_WAIT_V(4); PG8_BAR;
        PG8_STAGE(PG8_SB(1, 0), cB + kstep, voffB); PG8_STAGE(PG8_SA(1, 0), cA + kstep, voffA); PG8_STAGE(PG8_SB(1, 1), cB + hstepB + kstep, voffB);
        PG8_WAIT_V(6); PG8_BAR;
    }
    for (;;) {
        const bool has_next = S.next(ui + 1, nxt);
        const char* nA = has_next ? (const char*)g.A + ((size_t)nxt.pm * BM * g.lda + nxt.koff) * 2 + revoff : cA;
        const char* nB = has_next ? (const char*)g.Bt + ((size_t)nxt.pn * BM * g.ldb + nxt.kboff) * 2 : cB;
#pragma unroll 1
        for (int t = 0; t < nt; t += 2) {
            const bool last = (t == nt - 2);
            const char* a1 = cA + (size_t)(t + 1) * kstep;
            const char* a2 = last ? nA : cA + (size_t)(t + 2) * kstep; const char* b2 = last ? nB : cB + (size_t)(t + 2) * kstep;
            const char* a3 = a2 + kstep; const char* b3 = b2 + kstep;
            if constexpr (SP2) {
            PG8_LDB(B0, 0, 0); PG8_LDB(B1, 0, 1); PG8_SCHED; PG8_LDA(At, 0, 0); PG8_STAGE(PG8_SA(1, 1), a1 + hstepA, voffA);
            PG8_WAIT_V(8); PG8_WAIT_L(0); PG8_BAR; PG8_MMA(0, 0, At, B0); PG8_MMA(0, 1, At, B1); PG8_BAR; PG8_SCHED;
            PG8_LDA(At, 0, 1); PG8_STAGE(PG8_SB(0, 0), b2, voffB); PG8_STAGE(PG8_SB(0, 1), b2 + hstepB, voffB); PG8_STAGE(PG8_SA(0, 0), a2, voffA);
            PG8_WAIT_V(8); PG8_WAIT_L(0); PG8_BAR; PG8_MMA(1, 0, At, B0); PG8_MMA(1, 1, At, B1); PG8_BAR; PG8_SCHED;
            PG8_LDB(B0, 1, 0); PG8_LDB(B1, 1, 1); PG8_SCHED; PG8_LDA(At, 1, 0); PG8_STAGE(PG8_SA(0, 1), a2 + hstepA, voffA);
            PG8_WAIT_V(8); PG8_WAIT_L(0); PG8_BAR; PG8_MMA(0, 0, At, B0); PG8_MMA(0, 1, At, B1); PG8_BAR; PG8_SCHED;
            PG8_LDA(At, 1, 1); PG8_STAGE(PG8_SB(1, 0), b3, voffB); PG8_STAGE(PG8_SB(1, 1), b3 + hstepB, voffB); PG8_STAGE(PG8_SA(1, 0), a3, voffA);
            PG8_WAIT_V(8); PG8_WAIT_L(0); PG8_BAR; PG8_MMA(1, 0, At, B0); PG8_MMA(1, 1, At, B1); PG8_BAR; PG8_SCHED;
            } else {
            PG8_LDB(B0, 0, 0); PG8_SCHED; PG8_LDA(At, 0, 0); PG8_STAGE(PG8_SA(1, 1), a1 + hstepA, voffA);
            PG8_WAIT_L(8); PG8_BAR; PG8_WAIT_L(0); PG8_MMA(0, 0, At, B0); PG8_BAR; PG8_SCHED;
            PG8_LDB(B1, 0, 1); PG8_STAGE(PG8_SB(0, 0), b2, voffB);
            PG8_BAR; PG8_WAIT_L(0); PG8_MMA(0, 1, At, B1); PG8_BAR;
            PG8_LDA(At, 0, 1); PG8_STAGE(PG8_SA(0, 0), a2, voffA);
            PG8_BAR; PG8_WAIT_L(0); PG8_MMA(1, 0, At, B0); PG8_BAR; PG8_SCHED;
            PG8_STAGE(PG8_SB(0, 1), b2 + hstepB, voffB);
            PG8_WAIT_V(6); PG8_BAR; PG8_MMA(1, 1, At, B1); PG8_BAR;
            PG8_LDB(B0, 1, 0); PG8_SCHED; PG8_LDA(At, 1, 0); PG8_STAGE(PG8_SA(0, 1), a2 + hstepA, voffA);
            PG8_WAIT_L(8); PG8_BAR; PG8_WAIT_L(0); PG8_MMA(0, 0, At, B0); PG8_BAR; PG8_SCHED;
            PG8_LDB(B1, 1, 1); PG8_STAGE(PG8_SB(1, 0), b3, voffB);
            PG8_BAR; PG8_WAIT_L(0); PG8_MMA(0, 1, At, B1); PG8_BAR;
            PG8_LDA(At, 1, 1); PG8_STAGE(PG8_SA(1, 0), a3, voffA);
            PG8_BAR; PG8_WAIT_L(0); PG8_MMA(1, 0, At, B0); PG8_BAR; PG8_SCHED;
            PG8_STAGE(PG8_SB(1, 1), b3 + hstepB, voffB);
            PG8_WAIT_V(6); PG8_BAR; PG8_MMA(1, 1, At, B1); PG8_BAR;
            }
        }
        if constexpr (ALIGN_EPI) { if (wr == 0) PG8_BAR; }
        if constexpr (Epi::WITH_LDS) E.run(acc, cur, wr, wc, lane, lds); else E(acc, cur, wr, wc, fr, fq);
        if (!has_next) break;
#pragma unroll
        for (int a = 0; a < 2; ++a)
#pragma unroll
            for (int b = 0; b < 2; ++b)
#pragma unroll
                for (int m = 0; m < 4; ++m)
#pragma unroll
                    for (int n = 0; n < 2; ++n) acc[a][b][m][n] = (f32x4){0.f, 0.f, 0.f, 0.f};
        cur = nxt; cA = nA; cB = nB; ++ui;
        if constexpr (ALIGN_EPI) { if (wr == 1) PG8_BAR; }
    }
    PG8_WAIT_V(0);
    if constexpr (!ALIGN_EPI) { if (wr == 0) PG8_BAR; }
    PG8_BAR;
#undef PG8_SA
#undef PG8_SB
#undef PG8_STAGE
#undef PG8_LDA
#undef PG8_LDB
#undef PG8_MMA
#undef PG8_WAIT_V
#undef PG8_WAIT_L
#undef PG8_BAR
#undef PG8_SCHED
}

template <int ACT> struct EpiPlain {
    static constexpr bool WITH_LDS = false;
    bf16_t* O; int ldc;
    __device__ __forceinline__ void operator()(const f32x4 (&acc)[2][2][4][2], const Unit& u, int wr, int wc, int fr_, int fq_) const {
        int fr = fr_, fq = fq_; asm volatile("" : "+v"(fr), "+v"(fq));
        const int col0 = u.pn * BM + wc * 32 + fq * 4;
#pragma unroll
        for (int ai = 0; ai < 2; ++ai)
#pragma unroll
            for (int m = 0; m < 4; ++m) { bf16_t* rowp = O + (size_t)(u.pm * BM + ai * HALF + wr * 64 + m * 16 + fr) * ldc + col0;
#pragma unroll
                for (int bj = 0; bj < 2; ++bj)
#pragma unroll
                    for (int n = 0; n < 2; ++n) { f32x4 v = acc[ai][bj][m][n];
                        if (ACT == 1) { v = __builtin_elementwise_max(v, (f32x4){0.f, 0.f, 0.f, 0.f}); v = v * v; }
                        *(u32x2*)(rowp + bj * HALF + n * 16) = f32_to_bf4(v); } }
    }
};

struct EpiSlabCtx {
    static constexpr bool WITH_LDS = false;
    bf16_t* S; int ksz;
    __device__ __forceinline__ void operator()(const f32x4 (&acc)[2][2][4][2], const Unit& u, int wr, int wc, int fr_, int fq_) const {
        int fr = fr_, fq = fq_; asm volatile("" : "+v"(fr), "+v"(fq));
        const int col0 = u.pn * BM + wc * 32 + fq * 4;
        bf16_t* base = S + (size_t)(u.koff / ksz) * MC * DM;
#pragma unroll
        for (int ai = 0; ai < 2; ++ai)
#pragma unroll
            for (int m = 0; m < 4; ++m) { bf16_t* rowp = base + (size_t)(u.pm * BM - ML + ai * HALF + wr * 64 + m * 16 + fr) * DM + col0;
#pragma unroll
                for (int bj = 0; bj < 2; ++bj)
#pragma unroll
                    for (int n = 0; n < 2; ++n) *(u32x2*)(rowp + bj * HALF + n * 16) = f32_to_bf4(acc[ai][bj][m][n]); }
    }
};

struct EpiQKV {
    static constexpr bool WITH_LDS = false;
    bf16_t* Q; bf16_t* Kb; bf16_t* VT; bf16_t* VTC; const float* rope;
    __device__ __forceinline__ void operator()(const f32x4 (&acc)[2][2][4][2], const Unit& u, int wr, int wc, int fr_, int fq_) const {
        int fr = fr_, fq = fq_; asm volatile("" : "+v"(fr), "+v"(fq));
        const bool lat = u.pm < 64;
        if (u.pn < 5) {
#pragma unroll
            for (int ai = 0; ai < 2; ++ai)
#pragma unroll
                for (int m = 0; m < 4; ++m) {
                    const int row = u.pm * BM + ai * HALF + wr * 64 + m * 16 + fr;
                    f32x4 cs0 = {1.f, 0.f, 1.f, 0.f}, cs1 = {1.f, 0.f, 1.f, 0.f};
                    if (lat) { const int t = row & 2047; const int pos = (wc & 1) ? (t & 63) : (t >> 6); const f32x4* pp = (const f32x4*)(rope + (pos * 16 + 4 * fq) * 2); cs0 = pp[0]; cs1 = pp[1]; }
                    const f32x4 cv = {cs0[0], cs0[2], cs1[0], cs1[2]}, sv = {cs0[1], cs0[3], cs1[1], cs1[3]};
#pragma unroll
                    for (int bj = 0; bj < 2; ++bj) {
                        const f32x4 a = acc[ai][bj][m][0], b = acc[ai][bj][m][1];
                        f32x4 na = a * cv - b * sv, nb = b * cv + a * sv;
                        if (u.pn < 4) { na = na * 0.125f; nb = nb * 0.125f;
                            bf16_t* d = Q + (size_t)row * 1024 + u.pn * 256 + bj * HALF + wc * 32 + fq * 4;
                            *(u32x2*)d = f32_to_bf4(na); *(u32x2*)(d + 16) = f32_to_bf4(nb);
                        } else {
                            bf16_t* d = Kb + (size_t)row * 256 + bj * HALF + wc * 32 + fq * 4;
                            *(u32x2*)d = f32_to_bf4(na); *(u32x2*)(d + 16) = f32_to_bf4(nb);
                        }
                    }
                }
        } else {
#pragma unroll
            for (int ai = 0; ai < 2; ++ai)
#pragma unroll
                for (int m = 0; m < 4; ++m) {
                    const int row = u.pm * BM + ai * HALF + wr * 64 + m * 16 + fr;
                    bf16_t* base; size_t stride;
                    if (lat) { const int b = row >> 11, t = row & 2047; base = VT + (size_t)b * 256 * 2048 + t; stride = 2048; }
                    else { const int rc = row - ML; const int b = rc >> 8, t = rc & 255; base = VTC + (size_t)b * 256 * 256 + t; stride = 256; }
#pragma unroll
                    for (int bj = 0; bj < 2; ++bj)
#pragma unroll
                        for (int n = 0; n < 2; ++n)
#pragma unroll
                            for (int j = 0; j < 4; ++j) { const int vc = bj * HALF + wc * 32 + n * 16 + fq * 4 + j; base[(size_t)vc * stride] = (bf16_t)f2bf(acc[ai][bj][m][n][j]); }
                }
        }
    }
};

struct EpiGates {
    static constexpr bool WITH_LDS = false;
    const bf16_t* U; bf16_t* LA; bf16_t* BX; const float* ba; const float* bi; const float* nls;
    __device__ __forceinline__ void operator()(const f32x4 (&acc)[2][2][4][2], const Unit& u, int wr, int wc, int fr_, int fq_) const {
        int fr = fr_, fq = fq_; asm volatile("" : "+v"(fr), "+v"(fq));
        const int tile = u.pn >> 1, dir = tile / 5, blk = tile % 5, chalf = u.pn & 1;
        const int ch0 = blk * 256 + chalf * 128 + wc * 32 + fq * 4;
#pragma unroll
        for (int n = 0; n < 2; ++n) {
            const int ch = ch0 + n * 16;
            const f32x4 bav = *(const f32x4*)(ba + dir * DRNN + ch), biv = *(const f32x4*)(bi + dir * DRNN + ch), nl = *(const f32x4*)(nls + dir * DRNN + ch);
#pragma unroll
            for (int ai = 0; ai < 2; ++ai)
#pragma unroll
                for (int m = 0; m < 4; ++m) {
                    const int rin = ai * HALF + wr * 64 + m * 16 + fr;
                    const size_t rowg = (size_t)u.pm * BM + rin, rowl = (size_t)u.po * BM + rin;
                    const f32x4 uv = bf4_to_f32(*(const u32x2*)(U + rowg * DRNN + ch));
                    f32x4 lav, bxv;
#pragma unroll
                    for (int j = 0; j < 4; ++j) {
                        const float r = fsigmoid(acc[ai][0][m][n][j] + bav[j]);
                        const float ig = fsigmoid(acc[ai][1][m][n][j] + biv[j]);
                        const float la = nl[j] * r, x = 2.0f * la;
                        float om;
                        if (x > -0.5f) { float q = 1.0f / 720.0f; q = q * x + 1.0f / 120.0f; q = q * x + 1.0f / 24.0f; q = q * x + 1.0f / 6.0f; q = q * x + 0.5f; q = q * x + 1.0f; om = -x * q; }
                        else om = 1.0f - __expf(x);
                        lav[j] = la; bxv[j] = __builtin_amdgcn_sqrtf(om) * (ig * uv[j]);
                    }
                    const size_t o = ((size_t)dir * 9216 + rowl) * DRNN + ch;
                    *(u32x2*)(LA + o) = f32_to_bf4(lav); *(u32x2*)(BX + o) = f32_to_bf4(bxv);
                    asm volatile("" ::: "memory");
                }
        }
    }
};

#define SC_STEP(d) \
    "v_fmac_f32_dpp %1, %1, %0 row_shr:" #d " row_mask:0xf bank_mask:0xf\n\t" "v_mul_f32_dpp %0, %0, %0 row_shr:" #d " row_mask:0xf bank_mask:0xf\n\t" \
    "v_fmac_f32_dpp %3, %3, %2 row_shr:" #d " row_mask:0xf bank_mask:0xf\n\t" "v_mul_f32_dpp %2, %2, %2 row_shr:" #d " row_mask:0xf bank_mask:0xf\n\t" \
    "v_fmac_f32_dpp %5, %5, %4 row_shr:" #d " row_mask:0xf bank_mask:0xf\n\t" "v_mul_f32_dpp %4, %4, %4 row_shr:" #d " row_mask:0xf bank_mask:0xf\n\t" \
    "v_fmac_f32_dpp %7, %7, %6 row_shr:" #d " row_mask:0xf bank_mask:0xf\n\t" "v_mul_f32_dpp %6, %6, %6 row_shr:" #d " row_mask:0xf bank_mask:0xf\n\t"
__device__ __forceinline__ void scan16x4(float& a0, float& b0, float& a1, float& b1, float& a2, float& b2, float& a3, float& b3) {
    asm volatile("s_nop 1\n\t" SC_STEP(1) SC_STEP(2) SC_STEP(4) SC_STEP(8)
                 : "+v"(a0), "+v"(b0), "+v"(a1), "+v"(b1), "+v"(a2), "+v"(b2), "+v"(a3), "+v"(b3));
}
struct EpiGatesScan {
    static constexpr bool WITH_LDS = true;
    const bf16_t* U; bf16_t* RECF; bf16_t* RECB; const float* ba; const float* bi; const float* nls;
    __device__ __forceinline__ void run(f32x4 (&acc)[2][2][4][2], const Unit& u, int wr, int wc, int lane_, LAS unsigned char* lds) const {
        int lane = lane_; asm volatile("" : "+v"(lane));
        const int fr = lane & 15, fq = lane >> 4;
        LAS float* carry = (LAS float*)(lds + 131072);
        const int tile = u.pn >> 1, dir = tile / 5, blk = tile % 5, chalf = u.pn & 1;
        const int ch0 = blk * 256 + chalf * 128 + wc * 32 + fq * 4;
        const int rmask = dir ? 255 : 0;
        bf16_t* REC = dir ? RECB : RECF;
        if (u.po == 0 && wr == 0 && fr == 0) {
#pragma unroll
            for (int n = 0; n < 2; ++n) *(LAS f32x4*)(carry + wc * 32 + n * 16 + fq * 4) = (f32x4){0.f, 0.f, 0.f, 0.f};
        }
#pragma unroll
        for (int n = 0; n < 2; ++n) {
            const int ch = ch0 + n * 16;
            const f32x4 bav2 = *(const f32x4*)(ba + dir * DRNN + ch) * (-LOG2E), biv2 = *(const f32x4*)(bi + dir * DRNN + ch) * (-LOG2E), nl = *(const f32x4*)(nls + dir * DRNN + ch);
            const f32x4 nl2 = nl * LOG2E, nlx = nl * 2.0f;
#pragma unroll
            for (int ai = 0; ai < 2; ++ai)
#pragma unroll
                for (int m = 0; m < 4; ++m) {
                    const size_t rowg = (size_t)u.pm * BM + ((ai * HALF + wr * 64 + m * 16 + fr) ^ rmask);
                    const f32x4 uv = bf4_to_f32(*(const u32x2*)(U + rowg * DRNN + ch));
                    float av[4], bv[4];
#pragma unroll
                    for (int j = 0; j < 4; ++j) {
                        const float r = __builtin_amdgcn_rcpf(1.0f + __builtin_amdgcn_exp2f(acc[ai][0][m][n][j] * (-LOG2E) + bav2[j]));
                        const float ig = __builtin_amdgcn_rcpf(1.0f + __builtin_amdgcn_exp2f(acc[ai][1][m][n][j] * (-LOG2E) + biv2[j]));
                        const float a = __builtin_amdgcn_exp2f(nl2[j] * r), x = nlx[j] * r;
                        float q = 1.0f / 720.0f; q = q * x + 1.0f / 120.0f; q = q * x + 1.0f / 24.0f; q = q * x + 1.0f / 6.0f; q = q * x + 0.5f; q = q * x + 1.0f;
                        const float om = (x > -0.5f) ? -x * q : 1.0f - a * a;
                        av[j] = a; bv[j] = __builtin_amdgcn_sqrtf(om) * (ig * uv[j]);
                    }
                    scan16x4(av[0], bv[0], av[1], bv[1], av[2], bv[2], av[3], bv[3]);
#pragma unroll
                    for (int j = 0; j < 4; ++j) { acc[ai][0][m][n][j] = av[j]; acc[ai][1][m][n][j] = bv[j]; }
                    __builtin_amdgcn_sched_barrier(0);
                }
        }
        asm volatile("s_waitcnt lgkmcnt(0)" ::: "memory"); __builtin_amdgcn_s_barrier(); asm volatile("" ::: "memory");
        const bool emit = u.pm < 64;
        const int lastl = (lane & 48) | 15;
#pragma unroll
        for (int seg = 0; seg < 4; ++seg) {
            const int ai = seg >> 1, wrs = seg & 1;
            if (wr == wrs) {
                f32x4 hg[2];
#pragma unroll
                for (int n = 0; n < 2; ++n) hg[n] = *(const LAS f32x4*)(carry + wc * 32 + n * 16 + fq * 4);
#pragma unroll
                for (int m = 0; m < 4; ++m) {
                    f32x4 h[2];
#pragma unroll
                    for (int n = 0; n < 2; ++n) h[n] = acc[ai][0][m][n] * hg[n] + acc[ai][1][m][n];
                    if (emit) { bf16_t* rp = REC + ((size_t)u.pm * BM + ((ai * HALF + wr * 64 + m * 16 + fr) ^ rmask)) * DRNN + ch0;
#pragma unroll
                        for (int n = 0; n < 2; ++n) *(u32x2*)(rp + n * 16) = f32_to_bf4(h[n]); }
#pragma unroll
                    for (int n = 0; n < 2; ++n)
#pragma unroll
                        for (int j = 0; j < 4; ++j) hg[n][j] = __shfl(h[n][j], lastl);
                }
                if (fr == 0) {
#pragma unroll
                    for (int n = 0; n < 2; ++n) *(LAS f32x4*)(carry + wc * 32 + n * 16 + fq * 4) = hg[n];
                }
            }
            asm volatile("s_waitcnt lgkmcnt(0)" ::: "memory"); __builtin_amdgcn_s_barrier(); asm volatile("" ::: "memory");
        }
    }
};

struct EpiGateMul {
    static constexpr bool WITH_LDS = false;
    bf16_t* Z; const bf16_t* RB;
    __device__ __forceinline__ void operator()(const f32x4 (&acc)[2][2][4][2], const Unit& u, int wr, int wc, int fr_, int fq_) const {
        int fr = fr_, fq = fq_; asm volatile("" : "+v"(fr), "+v"(fq));
        const int col0 = u.pn * BM + wc * 32 + fq * 4;
#pragma unroll
        for (int ai = 0; ai < 2; ++ai)
#pragma unroll
            for (int m = 0; m < 4; ++m) { bf16_t* rowp = Z + (size_t)(u.pm * BM + ai * HALF + wr * 64 + m * 16 + fr) * DRNN + col0;
#pragma unroll
                for (int bj = 0; bj < 2; ++bj)
#pragma unroll
                    for (int n = 0; n < 2; ++n) { const f32x4 v = acc[ai][bj][m][n]; const f32x4 rc = bf4_to_f32(*(const u32x2*)(rowp + bj * HALF + n * 16)) + bf4_to_f32(*(const u32x2*)(RB + (rowp - Z) + bj * HALF + n * 16)); f32x4 o;
#pragma unroll
                        for (int j = 0; j < 4; ++j) { const float x = v[j]; const float z2 = 1.5957691216057308f * (x + 0.044715f * x * x * x); o[j] = x * fsigmoid(z2) * rc[j]; }
                        *(u32x2*)(rowp + bj * HALF + n * 16) = f32_to_bf4(o); }
                asm volatile("" ::: "memory"); }
    }
};
}


#define XB_TMO      128
#define XB_XCNT(j)  (256  + 64 * (j))
#define XB_XSUB(j)  (1280 + 64 * (j))
#define XB_XGEN(j)  (2304 + 64 * (j))
#define XB_TOP      3328
#define XB_TOPGEN   3392
#define XCD_BAR_WORDS 3456
#define XB_SPIN_CAP (1u << 18)
__device__ __forceinline__ unsigned xb_ld(unsigned* p)              { return __hip_atomic_load(p, __ATOMIC_RELAXED, __HIP_MEMORY_SCOPE_AGENT); }
__device__ __forceinline__ unsigned xb_add(unsigned* p, unsigned v) { return __hip_atomic_fetch_add(p, v, __ATOMIC_RELAXED, __HIP_MEMORY_SCOPE_AGENT); }
__device__ __forceinline__ unsigned xb_xcc_id() { return (unsigned)__builtin_amdgcn_s_getreg((3 << 11) | 20) & 0xFu; }
#define XB_SPIN(cond, bar) do { unsigned _sp = 0; while (cond) { __builtin_amdgcn_s_sleep(1); \
    if ((++_sp & 255u) == 0u) { if (xb_ld(&(bar)[XB_TMO])) break; if (_sp > XB_SPIN_CAP) { atomicAdd(&(bar)[XB_TMO], 1u); break; } } } } while (0)
struct XcdBarrier { unsigned* bar; unsigned x; volatile LAS unsigned* st; };
__device__ __forceinline__ XcdBarrier xcd_barrier_post(unsigned* bar, volatile LAS unsigned* st) {
    XcdBarrier b; b.bar = bar; b.x = xb_xcc_id(); b.st = st;
    if (threadIdx.x == 0) (void)xb_add(&bar[XB_XCNT(b.x)], 1u);
    return b;
}
__device__ __forceinline__ void xcd_barrier_complete(unsigned* bar, unsigned x, unsigned& nloc, unsigned& nx) {
    const unsigned G = gridDim.x * gridDim.y * gridDim.z;
    unsigned sum, cnt, mine, sp = 0u;
    for (;;) {
        sum = 0u; cnt = 0u; mine = 0u;
#pragma unroll
        for (unsigned j = 0; j < 16; ++j) { const unsigned c = xb_ld(&bar[XB_XCNT(j)]); sum += c; cnt += (c > 0u) ? 1u : 0u; mine = (j == x) ? c : mine; }
        if (sum == G) break;
        __builtin_amdgcn_s_sleep(1);
        if ((++sp & 255u) == 0u) { if (xb_ld(&bar[XB_TMO])) break; if (sp > XB_SPIN_CAP) { atomicAdd(&bar[XB_TMO], 1u); break; } }
    }
    nloc = mine > 0u ? mine : 1u; nx = cnt > 0u ? cnt : 1u;
}
__device__ __forceinline__ void xcd_barrier(const XcdBarrier& b) {
    asm volatile("s_waitcnt vmcnt(0)" ::: "memory");
    __syncthreads();
    if (threadIdx.x == 0) {
        unsigned* bar = b.bar;
        __builtin_amdgcn_s_waitcnt(0);
        unsigned nloc = b.st[0], nx = b.st[1];
        if (nloc == 0u) { xcd_barrier_complete(bar, b.x, nloc, nx); b.st[0] = nloc; b.st[1] = nx; }
        const unsigned old = xb_add(&bar[XB_XSUB(b.x)], 1u);
        const unsigned gen = old / nloc;
        if (old + 1u == (gen + 1u) * nloc) {
            __builtin_amdgcn_fence(__ATOMIC_RELEASE, "agent");
            asm volatile("s_waitcnt vmcnt(0)" ::: "memory");
            const unsigned og = xb_add(&bar[XB_TOP], 1u);
            const unsigned tg = og / nx;
            if (og + 1u == (tg + 1u) * nx) xb_add(&bar[XB_TOPGEN], 1u);
            else XB_SPIN(xb_ld(&bar[XB_TOPGEN]) == tg, bar);
            __builtin_amdgcn_fence(__ATOMIC_ACQUIRE, "agent");
            xb_add(&bar[XB_XGEN(b.x)], 1u);
            asm volatile("s_waitcnt vmcnt(0)" ::: "memory");
        } else {
            XB_SPIN(xb_ld(&bar[XB_XGEN(b.x)]) == gen, bar);
            __builtin_amdgcn_fence(__ATOMIC_ACQUIRE, "agent");
            asm volatile("s_waitcnt vmcnt(0)" ::: "memory");
        }
    }
    __syncthreads();
}

struct Params {
    const float *x, *c, *ctx, *c_ctx, *ada_w, *ada_b, *norm_g, *mlp_w1, *mlp_w2, *w_qkv, *w_o, *sink;
    const float *w_in, *conv_w, *conv_b, *w_a, *b_a, *w_i, *b_i, *lam, *w_out;
    float* out; unsigned char* ws;
};

typedef const __attribute__((address_space(4))) Params* ParamsK;
__device__ __forceinline__ void transpose_item(const float* W, int ldw, bf16_t* WT, int ldwt, int k0, int n0, int dst_row0, LAS float* scr, int lane) {
#pragma unroll 8
    for (int i = 0; i < 32; ++i) { const int kk = 2 * i + (lane >> 5); scr[kk * 33 + (lane & 31)] = W[(size_t)(k0 + kk) * ldw + n0 + (lane & 31)]; }
    asm volatile("s_waitcnt lgkmcnt(0)" ::: "memory");
    const int c = lane & 7;
#pragma unroll
    for (int j = 0; j < 4; ++j) { const int n = (lane >> 3) + 8 * j; const LAS float* s = scr + (8 * c) * 33 + n;
        u32x4 o; o.x = cvt_pk_bf16(s[0 * 33], s[1 * 33]); o.y = cvt_pk_bf16(s[2 * 33], s[3 * 33]); o.z = cvt_pk_bf16(s[4 * 33], s[5 * 33]); o.w = cvt_pk_bf16(s[6 * 33], s[7 * 33]);
        *(u32x4*)(WT + (size_t)(dst_row0 + n) * ldwt + k0 + 8 * c) = o; }
    asm volatile("s_waitcnt lgkmcnt(0)" ::: "memory");
}
__device__ __forceinline__ void transpose_plain(const float* W, int K, int N, bf16_t* WT, int r, LAS float* scr, int lane) {
    const int nblk = N / 32, kb = r / nblk, nb = r % nblk;
    transpose_item(W, N, WT, K, 64 * kb, 32 * nb, 32 * nb, scr, lane);
}

__device__ __forceinline__ void prologue(ParamsK p, LAS unsigned char* lds, int tid, int lane, int wave) {
    unsigned char* ws = p->ws;
    float* MOD = (float*)(ws + WS_MOD);
    if (blockIdx.x < 96) {
        LAS float* sl = (LAS float*)lds;
        LAS float* red = (LAS float*)(lds + 36864);
        for (int idx = tid; idx < 9216; idx += 512) { const int w = idx >> 10, k = idx & 1023; const float v = (w < 8) ? p->c[w * 1024 + k] : p->c_ctx[k]; sl[idx] = v / (1.0f + __expf(-v)); }
        __syncthreads();
        const int l = blockIdx.x / 48, n0 = (blockIdx.x % 48) * 128, kg = tid >> 5, cq = tid & 31;
        f32x4 acc[9];
#pragma unroll
        for (int w = 0; w < 9; ++w) acc[w] = (f32x4){0.f, 0.f, 0.f, 0.f};
        const float* wb = p->ada_w + (size_t)l * 1024 * 6144 + n0 + cq * 4;
#pragma unroll 4
        for (int it = 0; it < 64; ++it) { const int k = it * 16 + kg; const f32x4 w4 = *(const f32x4*)(wb + (size_t)k * 6144);
#pragma unroll
            for (int w = 0; w < 9; ++w) acc[w] += sl[w * 1024 + k] * w4; }
#pragma unroll
        for (int w = 0; w < 9; ++w) *(LAS f32x4*)(red + (kg * 9 + w) * 128 + cq * 4) = acc[w];
        __syncthreads();
        for (int idx = tid; idx < 9 * 128; idx += 512) { const int w = idx >> 7, n = idx & 127; float s = 0.f;
#pragma unroll
            for (int g = 0; g < 16; ++g) s += red[(g * 9 + w) * 128 + n];
            MOD[(size_t)(l * 9 + w) * 6144 + n0 + n] = s + p->ada_b[l * 6144 + n0 + n]; }
        __syncthreads();
    }
    if (blockIdx.x == gridDim.x - 1) {
        float* rope = (float*)(ws + WS_ROPE); float* nls = (float*)(ws + WS_NLS);
        for (int idx = tid; idx < 1024; idx += 512) { const int pos = idx >> 4, i = idx & 15;
            const float inv = __builtin_exp2f(-(float)i * (13.287712379549449f / 16.0f));
            const float angf = (float)pos * inv; const double ang = (double)angf;
            const double twopi = 6.283185307179586476925287; const double r = ang - twopi * __builtin_rint(ang / twopi);
            const double r2 = r * r; double cterm = 1.0, sterm = r, cs = 1.0, sn = r;
            for (int k = 1; k <= 14; ++k) { cterm *= -r2 / (double)((2 * k - 1) * (2 * k)); sterm *= -r2 / (double)((2 * k) * (2 * k + 1)); cs += cterm; sn += sterm; }
            rope[idx * 2] = (float)cs; rope[idx * 2 + 1] = (float)sn; }
        for (int idx = tid; idx < 2 * DRNN; idx += 512) { const float lm = p->lam[idx]; nls[idx] = -8.0f * log1pf(__expf(-lm)); }
    }
    LAS float* scr = (LAS float*)(lds + wave * 16384);
    const int gw = blockIdx.x * 8 + wave, NGW = gridDim.x * 8;
    constexpr int I_QKV = 16 * 48, I_O = 16 * 32, I_1 = 16 * 128, I_2 = 64 * 32, I_IN = 16 * 80, I_OUT = 20 * 32, I_G = 40 * 16;
    constexpr int NITEMS = I_QKV + I_O + 2 * I_1 + 2 * I_2 + I_IN + I_OUT + I_G;
    for (int it = gw; it < NITEMS; it += NGW) {
        int r = it;
        if (r < I_QKV) { transpose_plain(p->w_qkv, 1024, NQKV, (bf16_t*)(ws + WS_WQKV), r, scr, lane); continue; } r -= I_QKV;
        if (r < I_O) { transpose_plain(p->w_o, 1024, 1024, (bf16_t*)(ws + WS_WO), r, scr, lane); continue; } r -= I_O;
        if (r < 2 * I_1) { const int l = r / I_1; transpose_plain(p->mlp_w1 + (size_t)l * 1024 * DFF, 1024, DFF, (bf16_t*)(ws + WS_W1 + (size_t)l * 16 * MiB), r % I_1, scr, lane); continue; } r -= 2 * I_1;
        if (r < 2 * I_2) { const int l = r / I_2; transpose_plain(p->mlp_w2 + (size_t)l * 1024 * DFF, DFF, 1024, (bf16_t*)(ws + WS_W2 + (size_t)l * 16 * MiB), r % I_2, scr, lane); continue; } r -= 2 * I_2;
        if (r < I_IN) { transpose_plain(p->w_in, 1024, 2 * DRNN, (bf16_t*)(ws + WS_WIN), r, scr, lane); continue; } r -= I_IN;
        if (r < I_OUT) { transpose_plain(p->w_out, DRNN, 1024, (bf16_t*)(ws + WS_WOUT), r, scr, lane); continue; } r -= I_OUT;
        {
            const int sm = r >> 4, ii = r & 15, kb = ii >> 2, nb = ii & 3;
            const int chalf = sm & 1, blk = (sm >> 1) % 5, dg = (sm >> 1) / 5, gate = dg & 1, dir = dg >> 1;
            const float* W = (gate ? p->w_i : p->w_a) + (size_t)(dir * 5 + blk) * 256 * 256;
            const int dst_row0 = ((dir * 5 + blk) * 2 + chalf) * 256 + gate * 128 + nb * 32;
            transpose_item(W, 256, (bf16_t*)(ws + WS_WG), 256, 64 * kb, chalf * 128 + nb * 32, dst_row0, scr, lane);
        }
    }
}

template <bool HAS_Y, bool HAS_H>
__device__ __forceinline__ void row_phase(const float* xin_lat, const float* xin_ctx, float* xout_lat, float* xout_ctx, const bf16_t* Y, const bf16_t* SLAB, bf16_t* H,
                                          const float* gy, const float* gh, const float* mod_g, int gate_idx, const float* mod_h, int shift_idx, int scale_idx,
                                          int nrows, int gw, int ngw, int lane) {
    const int rpw = (nrows + ngw - 1) / ngw, r_begin = gw * rpw, r_end = (r_begin + rpw < nrows) ? r_begin + rpw : nrows;
    f32x4 xn[4]; u32x2 yn[4], ys[3][4];
    f32x4 vgy[4], vgh[4], vgt[4], vsh[4], vsc[4];
#pragma unroll
    for (int j = 0; j < 4; ++j) { if (HAS_Y) vgy[j] = *(const f32x4*)(gy + lane * 4 + 256 * j); if (HAS_H) vgh[j] = *(const f32x4*)(gh + lane * 4 + 256 * j); }
    int cur_who = -1;
#define ROW_LOAD(r) do { const int r_ = (r); const bool lat_ = r_ < ML; \
        const float* xi_ = lat_ ? xin_lat + (size_t)r_ * DM : xin_ctx + (size_t)(r_ - ML) * DM; \
        _Pragma("unroll") for (int j = 0; j < 4; ++j) xn[j] = *(const f32x4*)(xi_ + lane * 4 + 256 * j); \
        if (HAS_Y) { if (SLAB != nullptr && !lat_) { const bf16_t* yp_ = SLAB + (size_t)(r_ - ML) * DM + lane * 4; \
                _Pragma("unroll") for (int j = 0; j < 4; ++j) { yn[j] = *(const u32x2*)(yp_ + 256 * j); ys[0][j] = *(const u32x2*)(yp_ + 256 * j + (size_t)MC * DM); ys[1][j] = *(const u32x2*)(yp_ + 256 * j + (size_t)2 * MC * DM); ys[2][j] = *(const u32x2*)(yp_ + 256 * j + (size_t)3 * MC * DM); } } \
            else { _Pragma("unroll") for (int j = 0; j < 4; ++j) yn[j] = *(const u32x2*)(Y + (size_t)r_ * DM + lane * 4 + 256 * j); } } } while (0)
    if (r_begin < r_end) ROW_LOAD(r_begin);
    for (int row = r_begin; row < r_end; ++row) {
        const bool lat = row < ML; const int who = lat ? (row >> 11) : 8;
        if (who != cur_who) { cur_who = who;
#pragma unroll
            for (int j = 0; j < 4; ++j) { const int col = lane * 4 + 256 * j;
                if (HAS_Y) vgt[j] = *(const f32x4*)(mod_g + (size_t)who * 6144 + gate_idx * 1024 + col);
                if (HAS_H) { vsh[j] = *(const f32x4*)(mod_h + (size_t)who * 6144 + shift_idx * 1024 + col); vsc[j] = *(const f32x4*)(mod_h + (size_t)who * 6144 + scale_idx * 1024 + col) + 1.0f; } } }
        f32x4 xv[4], yv[4];
#pragma unroll
        for (int j = 0; j < 4; ++j) xv[j] = xn[j];
        if (HAS_Y) {
#pragma unroll
            for (int j = 0; j < 4; ++j) { yv[j] = bf4_to_f32(yn[j]);
                if (SLAB != nullptr && !lat) yv[j] = (yv[j] + bf4_to_f32(ys[0][j])) + (bf4_to_f32(ys[1][j]) + bf4_to_f32(ys[2][j])); }
        }
        asm volatile("" ::: "memory");
        if (row + 1 < r_end) ROW_LOAD(row + 1);
        if (HAS_Y) {
            float s = 0.f;
#pragma unroll
            for (int j = 0; j < 4; ++j) s += (yv[j][0] * yv[j][0] + yv[j][1] * yv[j][1]) + (yv[j][2] * yv[j][2] + yv[j][3] * yv[j][3]);
            const float rstd = 1.0f / sqrtf(wave_sum(s) * (1.0f / DM) + EPS);
            float* xo = lat ? xout_lat + (size_t)row * DM : xout_ctx + (size_t)(row - ML) * DM;
#pragma unroll
            for (int j = 0; j < 4; ++j) { xv[j] = xv[j] + vgt[j] * (yv[j] * rstd * vgy[j]); *(f32x4*)(xo + lane * 4 + 256 * j) = xv[j]; }
        }
        if (HAS_H) {
            float s = 0.f;
#pragma unroll
            for (int j = 0; j < 4; ++j) s += (xv[j][0] * xv[j][0] + xv[j][1] * xv[j][1]) + (xv[j][2] * xv[j][2] + xv[j][3] * xv[j][3]);
            const float rstd = 1.0f / sqrtf(wave_sum(s) * (1.0f / DM) + EPS);
#pragma unroll
            for (int j = 0; j < 4; ++j) { const f32x4 hv = (xv[j] * rstd * vgh[j]) * vsc[j] + vsh[j]; *(u32x2*)(H + (size_t)row * DM + lane * 4 + 256 * j) = f32_to_bf4(hv); }
        }
    }
#undef ROW_LOAD
}

__device__ __forceinline__ void attn_phase(LAS unsigned char* lds, const bf16_t* Q, bf16_t* O, const bf16_t* Kb, const bf16_t* VT, const bf16_t* VTC, const float* sink, int tid, int lane, int wave) {
    constexpr int PITCH = 72;
    LAS bf16_t* Ks = (LAS bf16_t*)lds;
    LAS bf16_t* Vs = (LAS bf16_t*)(lds + 2 * 64 * PITCH * 2);
    const int lr = lane & 15, lg = lane >> 4;
    const int skey = tid >> 3, spiece = tid & 7;
    for (int unit = blockIdx.x; unit < 576; unit += gridDim.x) {
        int b, kvh, qrow0, qblk, nloc, lt0; bool latu = unit < 512;
        if (latu) { b = unit >> 6; const int rem = unit & 63; qblk = rem >> 2; kvh = rem & 3; qrow0 = b * SEQ + qblk * 128; lt0 = (qblk == 0) ? 2 : 0; nloc = ((qblk == 15) ? 4 : 6) - lt0; }
        else { const int cu = unit - 512; b = cu >> 3; kvh = (cu & 7) >> 1; qblk = 0; qrow0 = ML + b * CTX + (cu & 1) * 128; lt0 = 0; nloc = 0; }
        const int nT = nloc + 4;
        const int head = kvh * 4 + (wave >> 1);
        const int qr0 = qrow0 + (wave & 1) * 64;
        const bf16_t* qbase = Q + (size_t)qr0 * 1024 + head * 64;
        bf16_t* obase = O + (size_t)qr0 * 1024 + head * 64;
        LAS unsigned char* Qs = lds + 40960 + wave * 8192;
#pragma unroll
        for (int qt = 0; qt < 4; ++qt)
#pragma unroll
            for (int dh = 0; dh < 2; ++dh) *(LAS bf16x8*)(Qs + (qt * 2 + dh) * 1024 + lane * 16) = *(const bf16x8*)(qbase + (unsigned)((qt * 16 + lr) * 1024 + dh * 32 + lg * 8));
        f32x4 o[4][4];
#pragma unroll
        for (int qt = 0; qt < 4; ++qt)
#pragma unroll
            for (int dt = 0; dt < 4; ++dt) o[qt][dt] = (f32x4){0.f, 0.f, 0.f, 0.f};
        float m2[4], ls[4];
        { const float sk = sink[head] * LOG2E;
#pragma unroll
          for (int qt = 0; qt < 4; ++qt) { m2[qt] = sk; ls[qt] = (lg == 0) ? 1.0f : 0.0f; } }
        u32x4 kreg, vreg;
#define ATT_LOAD(j) do { const int _j = (j); if (_j < nloc) { const int tok0 = (qblk - 1) * 128 + (lt0 + _j) * 64; \
                const bf16_t* kb_ = Kb + (size_t)(b * SEQ + tok0) * 256 + kvh * 64; const bf16_t* vb_ = VT + (size_t)(b * 4 + kvh) * 64 * SEQ + tok0; \
                kreg = *(const u32x4*)(kb_ + (unsigned)(skey * 256 + spiece * 8)); vreg = *(const u32x4*)(vb_ + (unsigned)(skey * SEQ + spiece * 8)); } \
            else { const int tok0 = (_j - nloc) * 64; \
                const bf16_t* kb_ = Kb + (size_t)(ML + b * CTX + tok0) * 256 + kvh * 64; const bf16_t* vb_ = VTC + (size_t)(b * 4 + kvh) * 64 * CTX + tok0; \
                kreg = *(const u32x4*)(kb_ + (unsigned)(skey * 256 + spiece * 8)); vreg = *(const u32x4*)(vb_ + (unsigned)(skey * CTX + spiece * 8)); } } while (0)
#define ATT_STORE(buf) do { *(LAS u32x4*)(Ks + (buf) * 64 * PITCH + skey * PITCH + spiece * 8) = kreg; *(LAS u32x4*)(Vs + (buf) * 64 * PITCH + skey * PITCH + spiece * 8) = vreg; } while (0)
        __syncthreads();
        ATT_LOAD(0); ATT_STORE(0);
        __syncthreads();
        for (int j = 0; j < nT; ++j) {
            const int buf = j & 1;
            if (j + 1 < nT) ATT_LOAD(j + 1);
            const LAS bf16_t* Kt = Ks + buf * 64 * PITCH; const LAS bf16_t* Vt = Vs + buf * 64 * PITCH;
            int mmode = 0, ktok0 = 0;
            if (j < nloc) { const int lt = lt0 + j; ktok0 = (qblk - 1) * 128 + lt * 64; mmode = (lt < 2) ? 1 : ((lt >= 4) ? 2 : 0); }
            bf16x8 kf[4][2];
#pragma unroll
            for (int ks = 0; ks < 4; ++ks)
#pragma unroll
                for (int dh = 0; dh < 2; ++dh) kf[ks][dh] = *(const LAS bf16x8*)(Kt + (ks * 16 + lr) * PITCH + dh * 32 + lg * 8);
#pragma unroll
            for (int hq = 0; hq < 2; ++hq) {
            bf16x8 pb[2][2];
#pragma unroll
            for (int q2 = 0; q2 < 2; ++q2) {
                const int qt = hq * 2 + q2;
                f32x4 s[4];
                const bf16x8 qf0 = *(const LAS bf16x8*)(Qs + (qt * 2 + 0) * 1024 + lane * 16), qf1 = *(const LAS bf16x8*)(Qs + (qt * 2 + 1) * 1024 + lane * 16);
#pragma unroll
                for (int ks = 0; ks < 4; ++ks) { s[ks] = __builtin_amdgcn_mfma_f32_16x16x32_bf16(kf[ks][0], qf0, (f32x4){0.f, 0.f, 0.f, 0.f}, 0, 0, 0);
                    s[ks] = __builtin_amdgcn_mfma_f32_16x16x32_bf16(kf[ks][1], qf1, s[ks], 0, 0, 0); }
                if (mmode) { const int qp = qblk * 128 + (wave & 1) * 64 + qt * 16 + lr;
#pragma unroll
                    for (int ks = 0; ks < 4; ++ks)
#pragma unroll
                        for (int jj = 0; jj < 4; ++jj) { const int kp = ktok0 + ks * 16 + lg * 4 + jj; const bool ok = (mmode == 1) ? (kp >= qp - 128) : (kp <= qp + 128); s[ks][jj] = ok ? s[ks][jj] : -1e30f; } }
                float mx = -3e38f;
#pragma unroll
                for (int ks = 0; ks < 4; ++ks) mx = fmaxf(mx, fmaxf(fmaxf(s[ks][0], s[ks][1]), fmaxf(s[ks][2], s[ks][3])));
                mx = fmaxf(mx, __shfl_xor(mx, 16)); mx = fmaxf(mx, __shfl_xor(mx, 32));
                const float mnew = fmaxf(m2[qt], mx * LOG2E);
                const float alpha = __builtin_amdgcn_exp2f(m2[qt] - mnew);
                m2[qt] = mnew;
                float rs = 0.f;
#pragma unroll
                for (int ks = 0; ks < 4; ++ks)
#pragma unroll
                    for (int jj = 0; jj < 4; ++jj) { const float pv = __builtin_amdgcn_exp2f(s[ks][jj] * LOG2E - mnew); s[ks][jj] = pv; rs += pv; }
                ls[qt] = ls[qt] * alpha + rs;
#pragma unroll
                for (int dt = 0; dt < 4; ++dt) o[qt][dt] = o[qt][dt] * alpha;
#pragma unroll
                for (int c2 = 0; c2 < 2; ++c2) { u32x4 w; w.x = cvt_pk_bf16(s[2 * c2][0], s[2 * c2][1]); w.y = cvt_pk_bf16(s[2 * c2][2], s[2 * c2][3]); w.z = cvt_pk_bf16(s[2 * c2 + 1][0], s[2 * c2 + 1][1]); w.w = cvt_pk_bf16(s[2 * c2 + 1][2], s[2 * c2 + 1][3]);
                    pb[q2][c2] = __builtin_bit_cast(bf16x8, w); }
            }
#pragma unroll
            for (int c2 = 0; c2 < 2; ++c2)
#pragma unroll
                for (int dt = 0; dt < 4; ++dt) {
                    const LAS bf16_t* vp = Vt + (dt * 16 + lr) * PITCH + c2 * 32 + lg * 4;
                    const u32x2 v0 = *(const LAS u32x2*)vp, v1 = *(const LAS u32x2*)(vp + 16);
                    const u32x4 vv = {v0.x, v0.y, v1.x, v1.y};
                    const bf16x8 vf = __builtin_bit_cast(bf16x8, vv);
#pragma unroll
                    for (int q2 = 0; q2 < 2; ++q2) o[hq * 2 + q2][dt] = __builtin_amdgcn_mfma_f32_16x16x32_bf16(vf, pb[q2][c2], o[hq * 2 + q2][dt], 0, 0, 0);
                }
            }
            if (j + 1 < nT) ATT_STORE(buf ^ 1);
            __syncthreads();
        }
#pragma unroll
        for (int qt = 0; qt < 4; ++qt) {
            float l = ls[qt]; l += __shfl_xor(l, 16); l += __shfl_xor(l, 32);
            const float inv = 1.0f / l;
            int lro = lr * 1024 + lg * 4; asm volatile("" : "+v"(lro));
            bf16_t* op = obase + (unsigned)(qt * 16 * 1024 + lro);
#pragma unroll
            for (int dt = 0; dt < 4; ++dt) *(u32x2*)(op + dt * 16) = f32_to_bf4(o[qt][dt] * inv);
        }
    }
#undef ATT_LOAD
#undef ATT_STORE
}

__device__ __forceinline__ void conv_phase(const bf16_t* R, bf16_t* U, const float* cw, const float* cb, int gtid, int nthreads) {
    for (int idx = gtid; idx < MT * 160; idx += nthreads) {
        const int row = idx / 160, ch = (idx % 160) * 8;
        int t, T; if (row < ML) { t = row & 2047; T = SEQ; } else { t = (row - ML) & 255; T = CTX; }
        float acc[8];
        { const f32x4 b0 = *(const f32x4*)(cb + ch), b1 = *(const f32x4*)(cb + ch + 4); acc[0] = b0[0]; acc[1] = b0[1]; acc[2] = b0[2]; acc[3] = b0[3]; acc[4] = b1[0]; acc[5] = b1[1]; acc[6] = b1[2]; acc[7] = b1[3]; }
#pragma unroll
        for (int tap = 0; tap < 4; ++tap) { const int tt = t + tap - 2;
            if (tt >= 0 && tt < T) { const u32x4 rv = *(const u32x4*)(R + (size_t)(row + tap - 2) * DRNN + ch);
                const f32x4 w0 = *(const f32x4*)(cw + tap * DRNN + ch), w1 = *(const f32x4*)(cw + tap * DRNN + ch + 4);
                acc[0] += w0[0] * bf_lo(rv.x); acc[1] += w0[1] * bf_hi(rv.x); acc[2] += w0[2] * bf_lo(rv.y); acc[3] += w0[3] * bf_hi(rv.y);
                acc[4] += w1[0] * bf_lo(rv.z); acc[5] += w1[1] * bf_hi(rv.z); acc[6] += w1[2] * bf_lo(rv.w); acc[7] += w1[3] * bf_hi(rv.w); } }
        u32x4 o; o.x = cvt_pk_bf16(acc[0], acc[1]); o.y = cvt_pk_bf16(acc[2], acc[3]); o.z = cvt_pk_bf16(acc[4], acc[5]); o.w = cvt_pk_bf16(acc[6], acc[7]);
        *(u32x4*)(U + (size_t)row * DRNN + ch) = o;
    }
}
__device__ __forceinline__ int scan_row0(int bl, int c) { return (c < 8) ? (8192 + bl * CTX + c * 32) : (bl * SEQ + (c - 8) * 32); }
__device__ __forceinline__ void scanA_phase(const bf16_t* LA, const bf16_t* BX, float* SP, float* SH, int gtid, int nthreads) {
    for (int idx = gtid; idx < 2 * 4 * 72 * 640; idx += nthreads) {
        const int cp = idx % 640, r1 = idx / 640, c = r1 % 72, r2 = r1 / 72, bl = r2 & 3, dir = r2 >> 2;
        const int row0 = scan_row0(bl, c);
        const size_t base = ((size_t)dir * 9216 + row0) * DRNN + cp * 2;
        float P0 = 1.f, P1 = 1.f, H0 = 0.f, H1 = 0.f;
#pragma unroll 8
        for (int i = 0; i < 32; ++i) { const int ii = dir ? (31 - i) : i;
            const unsigned lw = *(const unsigned*)(LA + base + (size_t)ii * DRNN), bw = *(const unsigned*)(BX + base + (size_t)ii * DRNN);
            const float a0 = __expf(bf_lo(lw)), a1 = __expf(bf_hi(lw));
            P0 *= a0; P1 *= a1; H0 = a0 * H0 + bf_lo(bw); H1 = a1 * H1 + bf_hi(bw); }
        const size_t so = ((size_t)(dir * 4 + bl) * 72 + c) * DRNN + cp * 2;
        *(f32x2*)(SP + so) = (f32x2){P0, P1}; *(f32x2*)(SH + so) = (f32x2){H0, H1};
    }
}
__device__ __forceinline__ void scanB_phase(const float* SP, const float* SH, float* CIN, int gtid, int nthreads) {
    for (int idx = gtid; idx < 2 * 4 * DRNN; idx += nthreads) {
        const int ch = idx % DRNN, r = idx / DRNN, bl = r & 3, dir = r >> 2;
        const size_t base = ((size_t)(dir * 4 + bl) * 72) * DRNN + ch;
        float carry = 0.f;
#pragma unroll 1
        for (int s0 = 0; s0 < 72; s0 += 24) {
            float pv[24], hv[24];
#pragma unroll
            for (int s = 0; s < 24; ++s) { const int sq = s0 + s; const int c = dir ? (sq < 8 ? 7 - sq : 79 - sq) : sq; pv[s] = SP[base + (size_t)c * DRNN]; hv[s] = SH[base + (size_t)c * DRNN]; }
#pragma unroll
            for (int s = 0; s < 24; ++s) { const int sq = s0 + s; const int c = dir ? (sq < 8 ? 7 - sq : 79 - sq) : sq; CIN[base + (size_t)c * DRNN] = carry; carry = pv[s] * carry + hv[s]; }
        }
    }
}
__device__ __forceinline__ void scanC_phase(const bf16_t* LA, const bf16_t* BX, const float* CIN, bf16_t* REC, int half, int gtid, int nthreads) {
    for (int idx = gtid; idx < 4 * 64 * 640; idx += nthreads) {
        const int cp = idx % 640, r1 = idx / 640, lc = r1 & 63, bl = r1 >> 6;
        const int row0 = bl * SEQ + lc * 32;
        const size_t b0 = ((size_t)row0) * DRNN + cp * 2, b1 = ((size_t)9216 + row0) * DRNN + cp * 2;
        const f32x2 cf = *(const f32x2*)(CIN + ((size_t)(0 * 4 + bl) * 72 + 8 + lc) * DRNN + cp * 2);
        const f32x2 cbk = *(const f32x2*)(CIN + ((size_t)(1 * 4 + bl) * 72 + 8 + lc) * DRNN + cp * 2);
        float hf0[32], hf1[32];
        float h0 = cf[0], h1 = cf[1];
#pragma unroll
        for (int i = 0; i < 32; ++i) { const unsigned lw = *(const unsigned*)(LA + b0 + (size_t)i * DRNN), bw = *(const unsigned*)(BX + b0 + (size_t)i * DRNN);
            h0 = __expf(bf_lo(lw)) * h0 + bf_lo(bw); h1 = __expf(bf_hi(lw)) * h1 + bf_hi(bw); hf0[i] = h0; hf1[i] = h1; }
        h0 = cbk[0]; h1 = cbk[1];
        bf16_t* out = REC + ((size_t)(half * 4 + bl) * SEQ + lc * 32) * DRNN + cp * 2;
#pragma unroll
        for (int i = 31; i >= 0; --i) { const unsigned lw = *(const unsigned*)(LA + b1 + (size_t)i * DRNN), bw = *(const unsigned*)(BX + b1 + (size_t)i * DRNN);
            h0 = __expf(bf_lo(lw)) * h0 + bf_lo(bw); h1 = __expf(bf_hi(lw)) * h1 + bf_hi(bw);
            *(unsigned*)(out + (size_t)i * DRNN) = cvt_pk_bf16(hf0[i] + h0, hf1[i] + h1); }
    }
}

#ifndef PH_MASK
#define PH_MASK 0xFFFFFFFFu
#endif
#define PH(k) ((PH_MASK >> (k)) & 1u)
#ifndef REP_MASK
#define REP_MASK 0u
#endif
#define REP_BEGIN(k) _Pragma("unroll 1") for (int rep_ = 0; rep_ < (((REP_MASK >> (k)) & 1u) ? 2 : 1); ++rep_) {
#define REP_END }
__device__ __forceinline__ ParamsK kparams() { ParamsK q = (ParamsK)__builtin_amdgcn_kernarg_segment_ptr(); asm volatile("" : "+s"(q)); return q; }
#define PHASE_BEGIN ParamsK kp = kparams(); unsigned char* ws = kp->ws; (void)ws; \
    int tid = threadIdx.x; asm volatile("" : "+v"(tid)); const int lane = tid & 63, wave = __builtin_amdgcn_readfirstlane(tid >> 6); \
    const int gw = bid * 8 + wave, gtid = bid * 512 + tid; (void)lane; (void)gw; (void)gtid;
#define P_MOD0 ((float*)(ws + WS_MOD))
#define P_MOD1 ((float*)(ws + WS_MOD) + 9 * 6144)
#define P_CTXRES ((float*)(ws + WS_CTXRES))
#define P_H ((bf16_t*)(ws + WS_H))
#define P_SLAB ((bf16_t*)(ws + WS_SLAB))
#define P_Q ((bf16_t*)(ws + WS_Q))
#define P_O ((bf16_t*)(ws + WS_O))
#define P_K ((bf16_t*)(ws + WS_K))
#define P_VT ((bf16_t*)(ws + WS_VT))
#define P_VTC ((bf16_t*)(ws + WS_VTC))
#define P_ACT ((bf16_t*)(ws + WS_ACT))
#define P_U ((bf16_t*)(ws + WS_U))
#define P_RECF ((bf16_t*)(ws + WS_RECF))
#define P_RECB ((bf16_t*)(ws + WS_RECB))
#define P_LA ((bf16_t*)(ws + WS_LA))
#define P_BX ((bf16_t*)(ws + WS_BX))
#define P_RPRE ((bf16_t*)(ws + WS_RPRE))
#define P_SP ((float*)(ws + WS_SP))
#define P_SH ((float*)(ws + WS_SH))
#define P_CIN ((float*)(ws + WS_CIN))
#define G0 (kp->norm_g)
#define G1 (kp->norm_g + 4 * DM)

__global__ void __launch_bounds__(512, 2) fwd_megakernel(Params p) {
    extern __shared__ __attribute__((aligned(16))) unsigned char lds_raw[];
    LAS unsigned char* lds = (LAS unsigned char*)lds_raw;
    const int G = gridDim.x, bid = blockIdx.x;
    const int ngw = G * 8, nthreads = G * 512;
    using namespace pg8;
    if (threadIdx.x < 4) ((volatile LAS unsigned*)(lds + 132096))[threadIdx.x] = 0u;
    __syncthreads();
    XcdBarrier xbar = xcd_barrier_post((unsigned*)(p.ws + WS_BAR), (volatile LAS unsigned*)(lds + 132096));
    if (PH(0)) { PHASE_BEGIN prologue(kp, lds, tid, lane, wave); }
    xcd_barrier(xbar);
#ifdef EXTRA_SYNCS
#pragma unroll 1
    for (int es = 0; es < EXTRA_SYNCS; ++es) xcd_barrier(xbar);
#endif
    REP_BEGIN(1)
    if (PH(1)) { PHASE_BEGIN row_phase<false, true>(kp->x, kp->ctx, nullptr, nullptr, nullptr, nullptr, P_H, nullptr, G0, nullptr, 0, P_MOD0, 0, 1, MT, gw, ngw, lane); }
    xcd_barrier(xbar);
    REP_END
    if (PH(2)) {
        PHASE_BEGIN
        Gemm g{P_H, (const bf16_t*)(ws + WS_WQKV), DM, DM, DM}; Sched S; S.init(MT / 256, NQKV / 256, G, bid);
        EpiQKV E{P_Q, P_K, P_VT, P_VTC, (const float*)(ws + WS_ROPE)};
        gemm_phase<EpiQKV, true, true>(lds, g, S, E);
    }
    xcd_barrier(xbar);
    REP_BEGIN(3)
    if (PH(3)) { PHASE_BEGIN attn_phase(lds, P_Q, P_O, P_K, P_VT, P_VTC, kp->sink, tid, lane, wave); }
    xcd_barrier(xbar);
    REP_END
    if (PH(4)) {
        PHASE_BEGIN
        { Gemm g{P_O, (const bf16_t*)(ws + WS_WO), DM, DM, DM}; Sched S; S.init(ML / 256, DM / 256, G, bid);
          EpiPlain<0> E{P_H, DM};
          gemm_phase<EpiPlain<0>, true, true>(lds, g, S, E); }
        { Gemm g{P_O, (const bf16_t*)(ws + WS_WO), DM, DM, 256}; Sched S; S.init(8, 4 * 4, G, bid, 2, 256);
          EpiSlabCtx E{P_SLAB, 256};
          gemm_phase<EpiSlabCtx, true, true>(lds, g, S, E); }
    }
    xcd_barrier(xbar);
    if (PH(5)) { PHASE_BEGIN row_phase<true, true>(kp->x, kp->ctx, kp->out, P_CTXRES, P_H, P_SLAB, P_H, G0 + DM, G0 + 2 * DM, P_MOD0, 2, P_MOD0, 3, 4, MT, gw, ngw, lane); }
    xcd_barrier(xbar);
    if (PH(6)) {
        PHASE_BEGIN
        Gemm g{P_H, (const bf16_t*)(ws + WS_W1), DM, DM, DM}; Sched S; S.init(MT / 256, DFF / 256, G, bid);
        EpiPlain<1> E{P_ACT, DFF};
        gemm_phase<EpiPlain<1>, true, true>(lds, g, S, E);
    }
    xcd_barrier(xbar);
    if (PH(7)) {
        PHASE_BEGIN
        { Gemm g{P_ACT, (const bf16_t*)(ws + WS_W2), DFF, DFF, DFF}; Sched S; S.init(ML / 256, DM / 256, G, bid);
          EpiPlain<0> E{P_H, DM};
          gemm_phase<EpiPlain<0>, true, true>(lds, g, S, E); }
        { Gemm g{P_ACT, (const bf16_t*)(ws + WS_W2), DFF, DFF, 1024}; Sched S; S.init(8, 4 * 4, G, bid, 2, 1024);
          EpiSlabCtx E{P_SLAB, 1024};
          gemm_phase<EpiSlabCtx, true, true>(lds, g, S, E); }
    }
    xcd_barrier(xbar);
    if (PH(8)) { PHASE_BEGIN row_phase<true, true>(kp->out, P_CTXRES, kp->out, P_CTXRES, P_H, P_SLAB, P_H, G0 + 3 * DM, G1, P_MOD0, 5, P_MOD1, 0, 1, MT, gw, ngw, lane); }
    xcd_barrier(xbar);
    if (PH(9)) {
        PHASE_BEGIN
        Gemm g{P_H, (const bf16_t*)(ws + WS_WIN) + (size_t)DRNN * DM, DM, DM, DM}; Sched S; S.init(MT / 256, DRNN / 256, G, bid);
        EpiPlain<0> E{P_RPRE, DRNN};
        gemm_phase<EpiPlain<0>, true, true>(lds, g, S, E);
    }
    xcd_barrier(xbar);
    REP_BEGIN(10)
    if (PH(10)) { PHASE_BEGIN conv_phase(P_RPRE, P_U, kp->conv_w, kp->conv_b, gtid, nthreads); }
    xcd_barrier(xbar);
    REP_END
    if (PH(11)) {
        PHASE_BEGIN
        Gemm g{P_U, (const bf16_t*)(ws + WS_WG), DRNN, 256, 256, (bid >> 1) & 1}; Sched S; S.init(1, 1, G, bid, 3, 0);
        EpiGatesScan E{P_U, P_RECF, P_RECB, kp->b_a, kp->b_i, (const float*)(ws + WS_NLS)};
        gemm_phase<EpiGatesScan, true, true>(lds, g, S, E);
    }
    xcd_barrier(xbar);
    if (PH(15)) {
        PHASE_BEGIN
        Gemm g{P_H, (const bf16_t*)(ws + WS_WIN), DM, DM, DM}; Sched S; S.init(ML / 256, DRNN / 256, G, bid);
        EpiGateMul E{P_RECF, P_RECB};
        gemm_phase<EpiGateMul, true, true>(lds, g, S, E);
    }
    xcd_barrier(xbar);
    if (PH(16)) {
        PHASE_BEGIN
        Gemm g{P_RECF, (const bf16_t*)(ws + WS_WOUT), DRNN, DRNN, DRNN}; Sched S; S.init(ML / 256, DM / 256, G, bid);
        EpiPlain<0> E{P_H, DM};
        gemm_phase<EpiPlain<0>, true, true>(lds, g, S, E);
    }
    xcd_barrier(xbar);
    if (PH(17)) { PHASE_BEGIN row_phase<true, true>(kp->out, P_CTXRES, kp->out, P_CTXRES, P_H, nullptr, P_H, G1 + DM, G1 + 2 * DM, P_MOD1, 2, P_MOD1, 3, 4, ML, gw, ngw, lane); }
    xcd_barrier(xbar);
    if (PH(18)) {
        PHASE_BEGIN
        Gemm g{P_H, (const bf16_t*)(ws + WS_W1 + 16 * MiB), DM, DM, DM}; Sched S; S.init(ML / 256, DFF / 256, G, bid);
        EpiPlain<1> E{P_ACT, DFF};
        gemm_phase<EpiPlain<1>, true, true>(lds, g, S, E);
    }
    xcd_barrier(xbar);
    if (PH(19)) {
        PHASE_BEGIN
        Gemm g{P_ACT, (const bf16_t*)(ws + WS_W2 + 16 * MiB), DFF, DFF, DFF}; Sched S; S.init(ML / 256, DM / 256, G, bid);
        EpiPlain<0> E{P_H, DM};
        gemm_phase<EpiPlain<0>, true, true>(lds, g, S, E);
    }
    xcd_barrier(xbar);
    if (PH(20)) { PHASE_BEGIN row_phase<true, false>(kp->out, P_CTXRES, kp->out, P_CTXRES, P_H, nullptr, nullptr, G1 + 3 * DM, nullptr, P_MOD1, 5, nullptr, 0, 0, ML, gw, ngw, lane); }
}

extern "C" void kernel_launch(void* const* d_in, const int* in_sizes, int n_in, void* d_out, int out_size, void* d_ws, size_t ws_size, hipStream_t stream) {
    static int grid_blocks = 0;
    if (grid_blocks == 0) {
        if (n_in != 21 || ws_size < WS_END) { fprintf(stderr, "kernel_launch: unexpected n_in %d / ws_size %zu\n", n_in, ws_size); grid_blocks = -1; return; }
        int dev = 0, cus = 0, per_cu = 0;
        hipGetDevice(&dev);
        hipDeviceGetAttribute(&cus, hipDeviceAttributeMultiprocessorCount, dev);
        if (hipFuncSetAttribute((const void*)fwd_megakernel, hipFuncAttributeMaxDynamicSharedMemorySize, LDS_BYTES) != hipSuccess) { fprintf(stderr, "hipFuncSetAttribute failed\n"); grid_blocks = -1; return; }
        if (hipOccupancyMaxActiveBlocksPerMultiprocessor(&per_cu, (const void*)fwd_megakernel, 512, LDS_BYTES) != hipSuccess || per_cu < 1) { fprintf(stderr, "occupancy query failed (%d)\n", per_cu); (void)hipGetLastError(); per_cu = 1; }
        grid_blocks = cus * 1;
    }
    if (grid_blocks < 0) return;
    Params p{};
    p.x = (const float*)d_in[0]; p.c = (const float*)d_in[1]; p.ctx = (const float*)d_in[2]; p.c_ctx = (const float*)d_in[3];
    p.ada_w = (const float*)d_in[4]; p.ada_b = (const float*)d_in[5]; p.norm_g = (const float*)d_in[6]; p.mlp_w1 = (const float*)d_in[7]; p.mlp_w2 = (const float*)d_in[8];
    p.w_qkv = (const float*)d_in[9]; p.w_o = (const float*)d_in[10]; p.sink = (const float*)d_in[11];
    p.w_in = (const float*)d_in[12]; p.conv_w = (const float*)d_in[13]; p.conv_b = (const float*)d_in[14]; p.w_a = (const float*)d_in[15]; p.b_a = (const float*)d_in[16];
    p.w_i = (const float*)d_in[17]; p.b_i = (const float*)d_in[18]; p.lam = (const float*)d_in[19]; p.w_out = (const float*)d_in[20];
    p.out = (float*)d_out; p.ws = (unsigned char*)d_ws;
    if (hipMemsetAsync((unsigned char*)d_ws + WS_BAR, 0, XCD_BAR_WORDS * 4, stream) != hipSuccess) { fprintf(stderr, "memset of barrier words failed\n"); return; }
    void* args[] = {&p};
    hipError_t e = hipLaunchCooperativeKernel((const void*)fwd_megakernel, dim3(grid_blocks), dim3(512), args, LDS_BYTES, stream);
    if (e != hipSuccess) fprintf(stderr, "cooperative launch failed: %s (grid %d)\n", hipGetErrorString(e), grid_blocks);
}
```

```cpp
#include <hip/hip_runtime.h>
#include <hip/hip_cooperative_groups.h>
#include <cstdio>
#include <cstdint>
namespace cg = cooperative_groups;

#define LAS __attribute__((address_space(3)))
typedef unsigned short bf16_t;
typedef short bf16x8 __attribute__((ext_vector_type(8)));
typedef float f32x4 __attribute__((ext_vector_type(4)));
typedef float f32x2 __attribute__((ext_vector_type(2)));
typedef unsigned u32x4 __attribute__((ext_vector_type(4)));
typedef unsigned u32x2 __attribute__((ext_vector_type(2)));

constexpr int DM = 1024, NB = 8, SEQ = 2048, CTX = 256;
constexpr int ML = NB * SEQ;
constexpr int MC = NB * CTX;
constexpr int MT = ML + MC;
constexpr int NQKV = 1536, DFF = 4096, DRNN = 1280;
constexpr float EPS = 1e-6f;
constexpr float LOG2E = 1.4426950408889634f;

constexpr size_t MiB = 1u << 20;
constexpr size_t WS_MOD = 0;
constexpr size_t WS_ROPE = 448 * 1024;
constexpr size_t WS_NLS = 460 * 1024;
constexpr size_t WS_BAR = 480 * 1024;
constexpr size_t WS_WQKV = 1 * MiB, WS_WO = 4 * MiB, WS_W1 = 6 * MiB, WS_W2 = 14 * MiB;
constexpr size_t WS_WIN = 38 * MiB, WS_WG = 43 * MiB, WS_WOUT = 46 * MiB;
constexpr size_t WS_CTXRES = 49 * MiB;
constexpr size_t WS_H = 57 * MiB;
constexpr size_t WS_R3 = 93 * MiB;
constexpr size_t WS_Q = WS_R3, WS_K = 129 * MiB, WS_VT = 138 * MiB, WS_VTC = 146 * MiB;
constexpr size_t WS_O = 150 * MiB;
constexpr size_t WS_ACT = WS_R3;
constexpr size_t WS_U = WS_R3;
constexpr size_t WS_RECF = 138 * MiB;
constexpr size_t WS_RECB = 178 * MiB;
constexpr size_t WS_LA = 138 * MiB;
constexpr size_t WS_BX = 183 * MiB;
constexpr size_t WS_RPRE = 138 * MiB;
constexpr size_t WS_SP = 228 * MiB, WS_SH = 231 * MiB, WS_CIN = 234 * MiB;
constexpr size_t WS_SLAB = 238 * MiB;
constexpr size_t WS_CARRY = 219 * MiB;
constexpr size_t WS_FLAG = 512 * 1024;
constexpr size_t WS_END = 256 * MiB;
constexpr int LDS_BYTES = 135168;

__device__ __forceinline__ unsigned f2bf(float f) { unsigned u = __builtin_bit_cast(unsigned, f); return (u + 0x7fffu + ((u >> 16) & 1u)) >> 16; }
__device__ __forceinline__ unsigned cvt_pk_bf16(float lo, float hi) { unsigned r; asm volatile("v_cvt_pk_bf16_f32 %0, %1, %2" : "=v"(r) : "v"(lo), "v"(hi)); return r; }
__device__ __forceinline__ float bf_lo(unsigned w) { return __builtin_bit_cast(float, w << 16); }
__device__ __forceinline__ float bf_hi(unsigned w) { return __builtin_bit_cast(float, w & 0xffff0000u); }
__device__ __forceinline__ f32x4 bf4_to_f32(u32x2 w) { return (f32x4){bf_lo(w.x), bf_hi(w.x), bf_lo(w.y), bf_hi(w.y)}; }
__device__ __forceinline__ u32x2 f32_to_bf4(f32x4 v) { u32x2 w; w.x = cvt_pk_bf16(v[0], v[1]); w.y = cvt_pk_bf16(v[2], v[3]); return w; }
__device__ __forceinline__ float wave_sum(float v) {
#pragma unroll
    for (int o = 1; o < 64; o <<= 1) v += __shfl_xor(v, o);
    return v;
}
__device__ __forceinline__ float fsigmoid(float x) { return __builtin_amdgcn_rcpf(1.0f + __expf(-x)); }

namespace pg8 {
constexpr int BM = 256, BK = 64, HALF = 128, HTB = HALF * BK * 2, STAGE_BYTES = 8 * HTB, NXCD = 8, WGM = 8;
__device__ __forceinline__ int lds_byte(int r, int c) { const int st = (r >> 4) * 2 + (c >> 5), rr = r & 15, cc = c & 31, ob = rr * 64 + cc * 2; return st * 1024 + (ob ^ (((ob >> 9) & 1) << 5)); }
__device__ __forceinline__ void stage_rc(int b, int& R, int& C) { const int st = b / 1024, sb = b % 1024, swz = sb ^ (((sb >> 9) & 1) << 5); R = (st >> 1) * 16 + swz / 64; C = (st & 1) * 32 + (swz % 64) / 2; }

struct Unit { int pm, pn, koff, po, kboff, rev, lin; };
struct Gemm { const bf16_t* A; const bf16_t* Bt; int lda, ldb, K; };

struct Sched {
    int nM, nN, nwg, G, c, mode, half;
    __device__ void init(int nM_, int nN_, int G_, int c_, int mode_ = 0, int half_ = 0) { nM = nM_; nN = nN_; nwg = nM * nN; G = G_; c = c_; mode = mode_; half = half_; }
    __device__ bool next(int i, Unit& u) const {
        if (mode == 3) {
            const int L = i * G + c; if (L >= 1440) return false;
            const int ti = L / 160, s = L % 160;
            const int chalf = s & 1, dir = (s >> 1) & 1, bb = s >> 2, blk = bb % 5, b = bb / 5;
            u.pm = (ti == 0) ? 64 + b : (dir ? b * 8 + (8 - ti) : b * 8 + (ti - 1));
            u.pn = (dir * 5 + blk) * 2 + chalf; u.koff = blk * 256; u.kboff = 0; u.po = ti; u.rev = dir; u.lin = L;
            return true;
        }
        const long L = (long)i * G + c; if (L >= nwg) return false;
        int wgid = (int)L; { const int q = nwg / NXCD, r = nwg % NXCD, xcd = wgid % NXCD, off = wgid / NXCD; wgid = (xcd < r ? xcd * (q + 1) : r * (q + 1) + (xcd - r) * q) + off; }
        const int nig = WGM * nN, gid = wgid / nig, fm = gid * WGM, gsz = (nM - fm) < WGM ? (nM - fm) : WGM;
        const int pmi = fm + ((wgid % nig) % gsz), pn = (wgid % nig) / gsz;
        u.pm = pmi; u.pn = pn; u.koff = 0; u.po = pmi; u.kboff = 0; u.rev = 0; u.lin = 0;
        if (mode == 2) { u.pm = 64 + pmi; u.pn = pn & 3; u.koff = (pn >> 2) * half; u.kboff = u.koff; }
        if (mode == 1) { u.pm = pmi < 32 ? 32 * half + pmi : 64 + 4 * half + (pmi - 32); u.koff = ((pn >> 1) % 5) * 256; }
        return true;
    }
};

template <class Epi, bool ALIGN_EPI, bool SP2>
__device__ __forceinline__ void gemm_phase(LAS unsigned char* lds, const Gemm g, const Sched& S, const Epi& E) {
    int tid = threadIdx.x; asm volatile("" : "+v"(tid));
    const int wid = __builtin_amdgcn_readfirstlane(tid >> 6), lane = tid & 63, wr = wid >> 2, wc = wid & 3, fr = lane & 15, fq = lane >> 4;
    const int K = g.K, nt = K / BK;
    unsigned voffAf[2], voffAr[2], voffB[2];
#pragma unroll
    for (int i = 0; i < 2; ++i) { int R, C; stage_rc(tid * 16 + i * 8192, R, C);
        voffAf[i] = (unsigned)(R * g.lda + C) * 2u; voffAr[i] = (unsigned)((127 - R) * g.lda + C) * 2u; voffB[i] = (unsigned)(R * g.ldb + C) * 2u; }
    const size_t kstep = (size_t)(BK * 2);
    const long hstepAf = (long)HALF * g.lda * 2; const size_t hstepB = (size_t)HALF * g.ldb * 2;
    const unsigned ldsw = (unsigned)wid * 1024u;
    const int aoff = lds_byte(wr * 64 + fr, fq * 8), boff = lds_byte(wc * 32 + fr, fq * 8);
#define PG8_SA(b, h) (((b) * 2 + (h)) * HTB)
#define PG8_SB(b, h) ((4 + (b) * 2 + (h)) * HTB)
#define PG8_STAGE(bufoff, gbase, voff) do { _Pragma("unroll") for (int _i = 0; _i < 2; ++_i) \
        __builtin_amdgcn_global_load_lds((const unsigned*)((const char*)(gbase) + (voff)[_i]), (LAS unsigned*)(lds + (bufoff) + ldsw + _i * 8192), 16, 0, 0); } while (0)
#define PG8_LDA(dst, b, h) do { _Pragma("unroll") for (int m = 0; m < 4; ++m) _Pragma("unroll") for (int k = 0; k < 2; ++k) dst[m][k] = *(const LAS bf16x8*)(lds + PG8_SA(b, h) + aoff + m * 2048 + k * 1024); } while (0)
#define PG8_LDB(dst, b, h) do { _Pragma("unroll") for (int n = 0; n < 2; ++n) _Pragma("unroll") for (int k = 0; k < 2; ++k) dst[n][k] = *(const LAS bf16x8*)(lds + PG8_SB(b, h) + boff + n * 2048 + k * 1024); } while (0)
#define PG8_MMA(ai, bj, At, Bt) do { __builtin_amdgcn_s_setprio(1); _Pragma("unroll") for (int m = 0; m < 4; ++m) _Pragma("unroll") for (int n = 0; n < 2; ++n) _Pragma("unroll") for (int k = 0; k < 2; ++k) \
        acc[ai][bj][m][n] = __builtin_amdgcn_mfma_f32_16x16x32_bf16(Bt[n][k], At[m][k], acc[ai][bj][m][n], 0, 0, 0); __builtin_amdgcn_s_setprio(0); } while (0)
#define PG8_WAIT_V(n) asm volatile("s_waitcnt vmcnt(" #n ")" ::: "memory")
#define PG8_WAIT_L(n) asm volatile("s_waitcnt lgkmcnt(" #n ")" ::: "memory")
#define PG8_BAR __builtin_amdgcn_s_barrier()
#define PG8_SCHED __builtin_amdgcn_sched_barrier(0)
    Unit cur, nxt; int ui = 0;
    if (!S.next(0, cur)) return;
    f32x4 acc[2][2][4][2];
#pragma unroll
    for (int a = 0; a < 2; ++a)
#pragma unroll
        for (int b = 0; b < 2; ++b)
#pragma unroll
            for (int m = 0; m < 4; ++m)
#pragma unroll
                for (int n = 0; n < 2; ++n) acc[a][b][m][n] = (f32x4){0.f, 0.f, 0.f, 0.f};
    bf16x8 At[4][2], B0[2][2], B1[2][2];
#define PG8_UNIT_A(u_) ((const char*)g.A + ((size_t)(u_).pm * BM * g.lda + (u_).koff) * 2 + (Epi::WITH_LDS && (u_).rev ? hstepAf : 0))
    const char* cA = PG8_UNIT_A(cur);
    unsigned voffA[2] = {voffAf[0], voffAf[1]}; long hstepA = hstepAf;
    if (Epi::WITH_LDS && cur.rev) { voffA[0] = voffAr[0]; voffA[1] = voffAr[1]; hstepA = -hstepAf; } const char* cB = (const char*)g.Bt + ((size_t)cur.pn * BM * g.ldb + cur.kboff) * 2;
    if constexpr (SP2) {
        PG8_STAGE(PG8_SB(0, 0), cB, voffB); PG8_STAGE(PG8_SB(0, 1), cB + hstepB, voffB); PG8_STAGE(PG8_SA(0, 0), cA, voffA); PG8_STAGE(PG8_SA(0, 1), cA + hstepA, voffA);
        if (wr == 1) PG8_BAR;
        PG8_WAIT_V(2); PG8_BAR;
        PG8_STAGE(PG8_SB(1, 0), cB + kstep, voffB); PG8_STAGE(PG8_SA(1, 0), cA + kstep, voffA); PG8_STAGE(PG8_SB(1, 1), cB + hstepB + kstep, voffB);
        PG8_WAIT_V(6); PG8_BAR;
    } else {
        PG8_STAGE(PG8_SB(0, 0), cB, voffB); PG8_STAGE(PG8_SA(0, 0), cA, voffA); PG8_STAGE(PG8_SB(0, 1), cB + hstepB, voffB); PG8_STAGE(PG8_SA(0, 1), cA + hstepA, voffA);
        if (wr == 1) PG8_BAR;
        PG8_WAIT_V(4); PG8_BAR;
        PG8_STAGE(PG8_SB(1, 0), cB + kstep, voffB); PG8_STAGE(PG8_SA(1, 0), cA + kstep, voffA); PG8_STAGE(PG8_SB(1, 1), cB + hstepB + kstep, voffB);
        PG8_WAIT_V(6); PG8_BAR;
    }
    for (;;) {
        const bool has_next = S.next(ui + 1, nxt);
        const char* nA = has_next ? PG8_UNIT_A(nxt) : cA;
        unsigned voffN[2] = {voffA[0], voffA[1]}; long hstepN = hstepA;
        if (Epi::WITH_LDS && has_next) { const bool nr = nxt.rev != 0; voffN[0] = nr ? voffAr[0] : voffAf[0]; voffN[1] = nr ? voffAr[1] : voffAf[1]; hstepN = nr ? -hstepAf : hstepAf; }
        const char* nB = has_next ? (const char*)g.Bt + ((size_t)nxt.pn * BM * g.ldb + nxt.kboff) * 2 : cB;
#pragma unroll 1
        for (int t = 0; t < nt; t += 2) {
            const bool last = (t == nt - 2);
            const char* a1 = cA + (size_t)(t + 1) * kstep;
            const char* a2 = last ? nA : cA + (size_t)(t + 2) * kstep; const char* b2 = last ? nB : cB + (size_t)(t + 2) * kstep;
            const char* a3 = a2 + kstep; const char* b3 = b2 + kstep;
            unsigned voff2[2] = {voffA[0], voffA[1]}; long hstep2 = hstepA;
            if (Epi::WITH_LDS && last) { voff2[0] = voffN[0]; voff2[1] = voffN[1]; hstep2 = hstepN; }
            if constexpr (SP2) {
            PG8_LDB(B0, 0, 0); PG8_LDB(B1, 0, 1); PG8_SCHED; PG8_LDA(At, 0, 0); PG8_STAGE(PG8_SA(1, 1), a1 + hstepA, voffA);
            PG8_WAIT_V(8); PG8_WAIT_L(0); PG8_BAR; PG8_MMA(0, 0, At, B0); PG8_MMA(0, 1, At, B1); PG8_BAR; PG8_SCHED;
            PG8_LDA(At, 0, 1); PG8_STAGE(PG8_SB(0, 0), b2, voffB); PG8_STAGE(PG8_SB(0, 1), b2 + hstepB, voffB); PG8_STAGE(PG8_SA(0, 0), a2, voff2);
            PG8_WAIT_V(8); PG8_WAIT_L(0); PG8_BAR; PG8_MMA(1, 0, At, B0); PG8_MMA(1, 1, At, B1); PG8_BAR; PG8_SCHED;
            PG8_LDB(B0, 1, 0); PG8_LDB(B1, 1, 1); PG8_SCHED; PG8_LDA(At, 1, 0); PG8_STAGE(PG8_SA(0, 1), a2 + hstep2, voff2);
            PG8_WAIT_V(8); PG8_WAIT_L(0); PG8_BAR; PG8_MMA(0, 0, At, B0); PG8_MMA(0, 1, At, B1); PG8_BAR; PG8_SCHED;
            PG8_LDA(At, 1, 1); PG8_STAGE(PG8_SB(1, 0), b3, voffB); PG8_STAGE(PG8_SB(1, 1), b3 + hstepB, voffB); PG8_STAGE(PG8_SA(1, 0), a3, voff2);
            PG8_WAIT_V(8); PG8_WAIT_L(0); PG8_BAR; PG8_MMA(1, 0, At, B0); PG8_MMA(1, 1, At, B1); PG8_BAR; PG8_SCHED;
            } else {
            PG8_LDB(B0, 0, 0); PG8_SCHED; PG8_LDA(At, 0, 0); PG8_STAGE(PG8_SA(1, 1), a1 + hstepA, voffA);
            PG8_WAIT_L(8); PG8_BAR; PG8_WAIT_L(0); PG8_MMA(0, 0, At, B0); PG8_BAR; PG8_SCHED;
            PG8_LDB(B1, 0, 1); PG8_STAGE(PG8_SB(0, 0), b2, voffB);
            PG8_BAR; PG8_WAIT_L(0); PG8_MMA(0, 1, At, B1); PG8_BAR;
            PG8_LDA(At, 0, 1); PG8_STAGE(PG8_SA(0, 0), a2, voff2);
            PG8_BAR; PG8_WAIT_L(0); PG8_MMA(1, 0, At, B0); PG8_BAR; PG8_SCHED;
            PG8_STAGE(PG8_SB(0, 1), b2 + hstepB, voffB);
            PG8_WAIT_V(6); PG8_BAR; PG8_MMA(1, 1, At, B1); PG8_BAR;
            PG8_LDB(B0, 1, 0); PG8_SCHED; PG8_LDA(At, 1, 0); PG8_STAGE(PG8_SA(0, 1), a2 + hstep2, voff2);
            PG8_WAIT_L(8); PG8_BAR; PG8_WAIT_L(0); PG8_MMA(0, 0, At, B0); PG8_BAR; PG8_SCHED;
            PG8_LDB(B1, 1, 1); PG8_STAGE(PG8_SB(1, 0), b3, voffB);
            PG8_BAR; PG8_WAIT_L(0); PG8_MMA(0, 1, At, B1); PG8_BAR;
            PG8_LDA(At, 1, 1); PG8_STAGE(PG8_SA(1, 0), a3, voff2);
            PG8_BAR; PG8_WAIT_L(0); PG8_MMA(1, 0, At, B0); PG8_BAR; PG8_SCHED;
            PG8_STAGE(PG8_SB(1, 1), b3 + hstepB, voffB);
            PG8_WAIT_V(6); PG8_BAR; PG8_MMA(1, 1, At, B1); PG8_BAR;
            }
        }
        if constexpr (ALIGN_EPI) { if (wr == 0) PG8_BAR; }
        if constexpr (Epi::WITH_LDS) E.run(acc, cur, wr, wc, lane, lds); else E(acc, cur, wr, wc, fr, fq);
        if (!has_next) break;
#pragma unroll
        for (int a = 0; a < 2; ++a)
#pragma unroll
            for (int b = 0; b < 2; ++b)
#pragma unroll
                for (int m = 0; m < 4; ++m)
#pragma unroll
                    for (int n = 0; n < 2; ++n) acc[a][b][m][n] = (f32x4){0.f, 0.f, 0.f, 0.f};
        cur = nxt; cA = nA; cB = nB; ++ui; voffA[0] = voffN[0]; voffA[1] = voffN[1]; hstepA = hstepN;
        if constexpr (ALIGN_EPI) { if (wr == 1) PG8_BAR; }
    }
    PG8_WAIT_V(0);
    if constexpr (!ALIGN_EPI) { if (wr == 0) PG8_BAR; }
    PG8_BAR;
#undef PG8_UNIT_A
#undef PG8_SA
#undef PG8_SB
#undef PG8_STAGE
#undef PG8_LDA
#undef PG8_LDB
#undef PG8_MMA
#undef PG8_WAIT_V
#undef PG8_WAIT_L
#undef PG8_BAR
#undef PG8_SCHED
}

template <int ACT> struct EpiPlain {
    static constexpr bool WITH_LDS = false;
    bf16_t* O; int ldc;
    __device__ __forceinline__ void operator()(const f32x4 (&acc)[2][2][4][2], const Unit& u, int wr, int wc, int fr_, int fq_) const {
        int fr = fr_, fq = fq_; asm volatile("" : "+v"(fr), "+v"(fq));
        const int col0 = u.pn * BM + wc * 32 + fq * 4;
#pragma unroll
        for (int ai = 0; ai < 2; ++ai)
#pragma unroll
            for (int m = 0; m < 4; ++m) { bf16_t* rowp = O + (size_t)(u.pm * BM + ai * HALF + wr * 64 + m * 16 + fr) * ldc + col0;
#pragma unroll
                for (int bj = 0; bj < 2; ++bj)
#pragma unroll
                    for (int n = 0; n < 2; ++n) { f32x4 v = acc[ai][bj][m][n];
                        if (ACT == 1) { v = __builtin_elementwise_max(v, (f32x4){0.f, 0.f, 0.f, 0.f}); v = v * v; }
                        *(u32x2*)(rowp + bj * HALF + n * 16) = f32_to_bf4(v); } }
    }
};

struct EpiSlabCtx {
    static constexpr bool WITH_LDS = false;
    bf16_t* S; int ksz;
    __device__ __forceinline__ void operator()(const f32x4 (&acc)[2][2][4][2], const Unit& u, int wr, int wc, int fr_, int fq_) const {
        int fr = fr_, fq = fq_; asm volatile("" : "+v"(fr), "+v"(fq));
        const int col0 = u.pn * BM + wc * 32 + fq * 4;
        bf16_t* base = S + (size_t)(u.koff / ksz) * MC * DM;
#pragma unroll
        for (int ai = 0; ai < 2; ++ai)
#pragma unroll
            for (int m = 0; m < 4; ++m) { bf16_t* rowp = base + (size_t)(u.pm * BM - ML + ai * HALF + wr * 64 + m * 16 + fr) * DM + col0;
#pragma unroll
                for (int bj = 0; bj < 2; ++bj)
#pragma unroll
                    for (int n = 0; n < 2; ++n) *(u32x2*)(rowp + bj * HALF + n * 16) = f32_to_bf4(acc[ai][bj][m][n]); }
    }
};

struct EpiQKV {
    static constexpr bool WITH_LDS = false;
    bf16_t* Q; bf16_t* Kb; bf16_t* VT; bf16_t* VTC; const float* rope;
    __device__ __forceinline__ void operator()(const f32x4 (&acc)[2][2][4][2], const Unit& u, int wr, int wc, int fr_, int fq_) const {
        int fr = fr_, fq = fq_; asm volatile("" : "+v"(fr), "+v"(fq));
        const bool lat = u.pm < 64;
        if (u.pn < 5) {
#pragma unroll
            for (int ai = 0; ai < 2; ++ai)
#pragma unroll
                for (int m = 0; m < 4; ++m) {
                    const int row = u.pm * BM + ai * HALF + wr * 64 + m * 16 + fr;
                    f32x4 cs0 = {1.f, 0.f, 1.f, 0.f}, cs1 = {1.f, 0.f, 1.f, 0.f};
                    if (lat) { const int t = row & 2047; const int pos = (wc & 1) ? (t & 63) : (t >> 6); const f32x4* pp = (const f32x4*)(rope + (pos * 16 + 4 * fq) * 2); cs0 = pp[0]; cs1 = pp[1]; }
                    const f32x4 cv = {cs0[0], cs0[2], cs1[0], cs1[2]}, sv = {cs0[1], cs0[3], cs1[1], cs1[3]};
#pragma unroll
                    for (int bj = 0; bj < 2; ++bj) {
                        const f32x4 a = acc[ai][bj][m][0], b = acc[ai][bj][m][1];
                        f32x4 na = a * cv - b * sv, nb = b * cv + a * sv;
                        if (u.pn < 4) { na = na * 0.125f; nb = nb * 0.125f;
                            bf16_t* d = Q + (size_t)row * 1024 + u.pn * 256 + bj * HALF + wc * 32 + fq * 4;
                            *(u32x2*)d = f32_to_bf4(na); *(u32x2*)(d + 16) = f32_to_bf4(nb);
                        } else {
                            bf16_t* d = Kb + (size_t)row * 256 + bj * HALF + wc * 32 + fq * 4;
                            *(u32x2*)d = f32_to_bf4(na); *(u32x2*)(d + 16) = f32_to_bf4(nb);
                        }
                    }
                }
        } else {
#pragma unroll
            for (int ai = 0; ai < 2; ++ai)
#pragma unroll
                for (int m = 0; m < 4; ++m) {
                    const int row = u.pm * BM + ai * HALF + wr * 64 + m * 16 + fr;
                    bf16_t* base; size_t stride;
                    if (lat) { const int b = row >> 11, t = row & 2047; base = VT + (size_t)b * 256 * 2048 + t; stride = 2048; }
                    else { const int rc = row - ML; const int b = rc >> 8, t = rc & 255; base = VTC + (size_t)b * 256 * 256 + t; stride = 256; }
#pragma unroll
                    for (int bj = 0; bj < 2; ++bj)
#pragma unroll
                        for (int n = 0; n < 2; ++n)
#pragma unroll
                            for (int j = 0; j < 4; ++j) { const int vc = bj * HALF + wc * 32 + n * 16 + fq * 4 + j; base[(size_t)vc * stride] = (bf16_t)f2bf(acc[ai][bj][m][n][j]); }
                }
        }
    }
};

struct EpiGates {
    static constexpr bool WITH_LDS = false;
    const bf16_t* U; bf16_t* LA; bf16_t* BX; const float* ba; const float* bi; const float* nls;
    __device__ __forceinline__ void operator()(const f32x4 (&acc)[2][2][4][2], const Unit& u, int wr, int wc, int fr_, int fq_) const {
        int fr = fr_, fq = fq_; asm volatile("" : "+v"(fr), "+v"(fq));
        const int tile = u.pn >> 1, dir = tile / 5, blk = tile % 5, chalf = u.pn & 1;
        const int ch0 = blk * 256 + chalf * 128 + wc * 32 + fq * 4;
#pragma unroll
        for (int n = 0; n < 2; ++n) {
            const int ch = ch0 + n * 16;
            const f32x4 bav = *(const f32x4*)(ba + dir * DRNN + ch), biv = *(const f32x4*)(bi + dir * DRNN + ch), nl = *(const f32x4*)(nls + dir * DRNN + ch);
#pragma unroll
            for (int ai = 0; ai < 2; ++ai)
#pragma unroll
                for (int m = 0; m < 4; ++m) {
                    const int rin = ai * HALF + wr * 64 + m * 16 + fr;
                    const size_t rowg = (size_t)u.pm * BM + rin, rowl = (size_t)u.po * BM + rin;
                    const f32x4 uv = bf4_to_f32(*(const u32x2*)(U + rowg * DRNN + ch));
                    f32x4 lav, bxv;
#pragma unroll
                    for (int j = 0; j < 4; ++j) {
                        const float r = fsigmoid(acc[ai][0][m][n][j] + bav[j]);
                        const float ig = fsigmoid(acc[ai][1][m][n][j] + biv[j]);
                        const float la = nl[j] * r, x = 2.0f * la;
                        float om;
                        if (x > -0.5f) { float q = 1.0f / 720.0f; q = q * x + 1.0f / 120.0f; q = q * x + 1.0f / 24.0f; q = q * x + 1.0f / 6.0f; q = q * x + 0.5f; q = q * x + 1.0f; om = -x * q; }
                        else om = 1.0f - __expf(x);
                        lav[j] = la; bxv[j] = __builtin_amdgcn_sqrtf(om) * (ig * uv[j]);
                    }
                    const size_t o = ((size_t)dir * 9216 + rowl) * DRNN + ch;
                    *(u32x2*)(LA + o) = f32_to_bf4(lav); *(u32x2*)(BX + o) = f32_to_bf4(bxv);
                    asm volatile("" ::: "memory");
                }
        }
    }
};

#define SC_STEP(d) \
    "v_fmac_f32_dpp %1, %1, %0 row_shr:" #d " row_mask:0xf bank_mask:0xf\n\t" "v_mul_f32_dpp %0, %0, %0 row_shr:" #d " row_mask:0xf bank_mask:0xf\n\t" \
    "v_fmac_f32_dpp %3, %3, %2 row_shr:" #d " row_mask:0xf bank_mask:0xf\n\t" "v_mul_f32_dpp %2, %2, %2 row_shr:" #d " row_mask:0xf bank_mask:0xf\n\t" \
    "v_fmac_f32_dpp %5, %5, %4 row_shr:" #d " row_mask:0xf bank_mask:0xf\n\t" "v_mul_f32_dpp %4, %4, %4 row_shr:" #d " row_mask:0xf bank_mask:0xf\n\t" \
    "v_fmac_f32_dpp %7, %7, %6 row_shr:" #d " row_mask:0xf bank_mask:0xf\n\t" "v_mul_f32_dpp %6, %6, %6 row_shr:" #d " row_mask:0xf bank_mask:0xf\n\t"
__device__ __forceinline__ void scan16x4(float& a0, float& b0, float& a1, float& b1, float& a2, float& b2, float& a3, float& b3) {
    asm volatile("s_nop 1\n\t" SC_STEP(1) SC_STEP(2) SC_STEP(4) SC_STEP(8)
                 : "+v"(a0), "+v"(b0), "+v"(a1), "+v"(b1), "+v"(a2), "+v"(b2), "+v"(a3), "+v"(b3));
}
struct EpiGatesScan {
    static constexpr bool WITH_LDS = true;
    const bf16_t* U; bf16_t* RECF; bf16_t* RECB; const float* ba; const float* bi; const float* nls; float* CARRY; unsigned* FLAG;
    __device__ __forceinline__ void run(f32x4 (&acc)[2][2][4][2], const Unit& u, int wr, int wc, int lane_, LAS unsigned char* lds) const {
        int lane = lane_; asm volatile("" : "+v"(lane));
        const int fr = lane & 15, fq = lane >> 4;
        LAS float* carry = (LAS float*)(lds + 131072);
        const int tile = u.pn >> 1, dir = tile / 5, blk = tile % 5, chalf = u.pn & 1;
        const int ch0 = blk * 256 + chalf * 128 + wc * 32 + fq * 4;
        const int rmask = dir ? 255 : 0;
        bf16_t* REC = dir ? RECB : RECF;
#pragma unroll
        for (int n = 0; n < 2; ++n) {
            const int ch = ch0 + n * 16;
            const f32x4 bav2 = *(const f32x4*)(ba + dir * DRNN + ch) * (-LOG2E), biv2 = *(const f32x4*)(bi + dir * DRNN + ch) * (-LOG2E), nl = *(const f32x4*)(nls + dir * DRNN + ch);
            const f32x4 nl2 = nl * LOG2E, nlx = nl * 2.0f;
#pragma unroll
            for (int ai = 0; ai < 2; ++ai)
#pragma unroll
                for (int m = 0; m < 4; ++m) {
                    const size_t rowg = (size_t)u.pm * BM + ((ai * HALF + wr * 64 + m * 16 + fr) ^ rmask);
                    const f32x4 uv = bf4_to_f32(*(const u32x2*)(U + rowg * DRNN + ch));
                    float av[4], bv[4];
#pragma unroll
                    for (int j = 0; j < 4; ++j) {
                        const float r = __builtin_amdgcn_rcpf(1.0f + __builtin_amdgcn_exp2f(acc[ai][0][m][n][j] * (-LOG2E) + bav2[j]));
                        const float ig = __builtin_amdgcn_rcpf(1.0f + __builtin_amdgcn_exp2f(acc[ai][1][m][n][j] * (-LOG2E) + biv2[j]));
                        const float a = __builtin_amdgcn_exp2f(nl2[j] * r), x = nlx[j] * r;
                        float q = 1.0f / 720.0f; q = q * x + 1.0f / 120.0f; q = q * x + 1.0f / 24.0f; q = q * x + 1.0f / 6.0f; q = q * x + 0.5f; q = q * x + 1.0f;
                        const float om = (x > -0.5f) ? -x * q : 1.0f - a * a;
                        av[j] = a; bv[j] = __builtin_amdgcn_sqrtf(om) * (ig * uv[j]);
                    }
                    scan16x4(av[0], bv[0], av[1], bv[1], av[2], bv[2], av[3], bv[3]);
#pragma unroll
                    for (int j = 0; j < 4; ++j) { acc[ai][0][m][n][j] = av[j]; acc[ai][1][m][n][j] = bv[j]; }
                    __builtin_amdgcn_sched_barrier(0);
                }
        }
        const int tid_ = threadIdx.x;
        if (u.po > 0 && tid_ < 64) {
            unsigned* fl = FLAG + (size_t)(u.lin - 160) * 16; unsigned sp = 0;
            while (__hip_atomic_load(fl, __ATOMIC_RELAXED, __HIP_MEMORY_SCOPE_AGENT) == 0u) { __builtin_amdgcn_s_sleep(2); if (++sp > (1u << 22)) break; }
        }
        asm volatile("s_waitcnt vmcnt(0) lgkmcnt(0)" ::: "memory"); __builtin_amdgcn_s_barrier(); asm volatile("" ::: "memory");
        if (tid_ < 128) carry[tid_] = (u.po > 0) ? __hip_atomic_load(CARRY + (size_t)(u.lin - 160) * 128 + tid_, __ATOMIC_RELAXED, __HIP_MEMORY_SCOPE_AGENT) : 0.0f;
        asm volatile("s_waitcnt vmcnt(0) lgkmcnt(0)" ::: "memory"); __builtin_amdgcn_s_barrier(); asm volatile("" ::: "memory");
        const bool emit = u.pm < 64;
        const int lastl = (lane & 48) | 15;
#pragma unroll
        for (int seg = 0; seg < 4; ++seg) {
            const int ai = seg >> 1, wrs = seg & 1;
            if (wr == wrs) {
                f32x4 hg[2];
#pragma unroll
                for (int n = 0; n < 2; ++n) hg[n] = *(const LAS f32x4*)(carry + wc * 32 + n * 16 + fq * 4);
#pragma unroll
                for (int m = 0; m < 4; ++m) {
                    f32x4 h[2];
#pragma unroll
                    for (int n = 0; n < 2; ++n) h[n] = acc[ai][0][m][n] * hg[n] + acc[ai][1][m][n];
                    if (emit) { bf16_t* rp = REC + ((size_t)u.pm * BM + ((ai * HALF + wr * 64 + m * 16 + fr) ^ rmask)) * DRNN + ch0;
#pragma unroll
                        for (int n = 0; n < 2; ++n) *(u32x2*)(rp + n * 16) = f32_to_bf4(h[n]); }
#pragma unroll
                    for (int n = 0; n < 2; ++n)
#pragma unroll
                        for (int j = 0; j < 4; ++j) hg[n][j] = __shfl(h[n][j], lastl);
                }
                if (fr == 0) {
#pragma unroll
                    for (int n = 0; n < 2; ++n) *(LAS f32x4*)(carry + wc * 32 + n * 16 + fq * 4) = hg[n];
                }
            }
            asm volatile("s_waitcnt lgkmcnt(0)" ::: "memory"); __builtin_amdgcn_s_barrier(); asm volatile("" ::: "memory");
        }
        if (u.po < 8) {
            if (tid_ < 128) __hip_atomic_store(CARRY + (size_t)u.lin * 128 + tid_, carry[tid_], __ATOMIC_RELAXED, __HIP_MEMORY_SCOPE_AGENT);
            asm volatile("s_waitcnt vmcnt(0) lgkmcnt(0)" ::: "memory"); __builtin_amdgcn_s_barrier(); asm volatile("" ::: "memory");
            if (tid_ == 0) __hip_atomic_store(FLAG + (size_t)u.lin * 16, 1u, __ATOMIC_RELAXED, __HIP_MEMORY_SCOPE_AGENT);
        }
    }
};

struct EpiGateMul {
    static constexpr bool WITH_LDS = false;
    bf16_t* Z; const bf16_t* RB;
    __device__ __forceinline__ void operator()(const f32x4 (&acc)[2][2][4][2], const Unit& u, int wr, int wc, int fr_, int fq_) const {
        int fr = fr_, fq = fq_; asm volatile("" : "+v"(fr), "+v"(fq));
        const int col0 = u.pn * BM + wc * 32 + fq * 4;
#pragma unroll
        for (int ai = 0; ai < 2; ++ai)
#pragma unroll
            for (int m = 0; m < 4; ++m) { bf16_t* rowp = Z + (size_t)(u.pm * BM + ai * HALF + wr * 64 + m * 16 + fr) * DRNN + col0;
#pragma unroll
                for (int bj = 0; bj < 2; ++bj)
#pragma unroll
                    for (int n = 0; n < 2; ++n) { const f32x4 v = acc[ai][bj][m][n]; const f32x4 rc = bf4_to_f32(*(const u32x2*)(rowp + bj * HALF + n * 16)) + bf4_to_f32(*(const u32x2*)(RB + (rowp - Z) + bj * HALF + n * 16)); f32x4 o;
#pragma unroll
                        for (int j = 0; j < 4; ++j) { const float x = v[j]; const float z2 = 1.5957691216057308f * (x + 0.044715f * x * x * x); o[j] = x * fsigmoid(z2) * rc[j]; }
                        *(u32x2*)(rowp + bj * HALF + n * 16) = f32_to_bf4(o); }
                asm volatile("" ::: "memory"); }
    }
};
}


#define XB_TMO      128
#define XB_XCNT(j)  (256  + 64 * (j))
#define XB_XSUB(j)  (1280 + 64 * (j))
#define XB_XGEN(j)  (2304 + 64 * (j))
#define XB_TOP      3328
#define XB_TOPGEN   3392
#define XCD_BAR_WORDS 3456
#define XB_SPIN_CAP (1u << 18)
__device__ __forceinline__ unsigned xb_ld(unsigned* p)              { return __hip_atomic_load(p, __ATOMIC_RELAXED, __HIP_MEMORY_SCOPE_AGENT); }
__device__ __forceinline__ unsigned xb_add(unsigned* p, unsigned v) { return __hip_atomic_fetch_add(p, v, __ATOMIC_RELAXED, __HIP_MEMORY_SCOPE_AGENT); }
__device__ __forceinline__ unsigned xb_xcc_id() { return (unsigned)__builtin_amdgcn_s_getreg((3 << 11) | 20) & 0xFu; }
#define XB_SPIN(cond, bar) do { unsigned _sp = 0; while (cond) { __builtin_amdgcn_s_sleep(1); \
    if ((++_sp & 255u) == 0u) { if (xb_ld(&(bar)[XB_TMO])) break; if (_sp > XB_SPIN_CAP) { atomicAdd(&(bar)[XB_TMO], 1u); break; } } } } while (0)
struct XcdBarrier { unsigned* bar; unsigned x; volatile LAS unsigned* st; };
__device__ __forceinline__ XcdBarrier xcd_barrier_post(unsigned* bar, volatile LAS unsigned* st) {
    XcdBarrier b; b.bar = bar; b.x = xb_xcc_id(); b.st = st;
    if (threadIdx.x == 0) (void)xb_add(&bar[XB_XCNT(b.x)], 1u);
    return b;
}
__device__ __forceinline__ void xcd_barrier_complete(unsigned* bar, unsigned x, unsigned& nloc, unsigned& nx) {
    const unsigned G = gridDim.x * gridDim.y * gridDim.z;
    unsigned sum, cnt, mine, sp = 0u;
    for (;;) {
        sum = 0u; cnt = 0u; mine = 0u;
#pragma unroll
        for (unsigned j = 0; j < 16; ++j) { const unsigned c = xb_ld(&bar[XB_XCNT(j)]); sum += c; cnt += (c > 0u) ? 1u : 0u; mine = (j == x) ? c : mine; }
        if (sum == G) break;
        __builtin_amdgcn_s_sleep(1);
        if ((++sp & 255u) == 0u) { if (xb_ld(&bar[XB_TMO])) break; if (sp > XB_SPIN_CAP) { atomicAdd(&bar[XB_TMO], 1u); break; } }
    }
    nloc = mine > 0u ? mine : 1u; nx = cnt > 0u ? cnt : 1u;
}
__device__ __forceinline__ void xcd_barrier(const XcdBarrier& b) {
    asm volatile("s_waitcnt vmcnt(0)" ::: "memory");
    __syncthreads();
    if (threadIdx.x == 0) {
        unsigned* bar = b.bar;
        __builtin_amdgcn_s_waitcnt(0);
        unsigned nloc = b.st[0], nx = b.st[1];
        if (nloc == 0u) { xcd_barrier_complete(bar, b.x, nloc, nx); b.st[0] = nloc; b.st[1] = nx; }
        const unsigned old = xb_add(&bar[XB_XSUB(b.x)], 1u);
        const unsigned gen = old / nloc;
        if (old + 1u == (gen + 1u) * nloc) {
            __builtin_amdgcn_fence(__ATOMIC_RELEASE, "agent");
            asm volatile("s_waitcnt vmcnt(0)" ::: "memory");
            const unsigned og = xb_add(&bar[XB_TOP], 1u);
            const unsigned tg = og / nx;
            if (og + 1u == (tg + 1u) * nx) xb_add(&bar[XB_TOPGEN], 1u);
            else XB_SPIN(xb_ld(&bar[XB_TOPGEN]) == tg, bar);
            __builtin_amdgcn_fence(__ATOMIC_ACQUIRE, "agent");
            xb_add(&bar[XB_XGEN(b.x)], 1u);
            asm volatile("s_waitcnt vmcnt(0)" ::: "memory");
        } else {
            XB_SPIN(xb_ld(&bar[XB_XGEN(b.x)]) == gen, bar);
            __builtin_amdgcn_fence(__ATOMIC_ACQUIRE, "agent");
            asm volatile("s_waitcnt vmcnt(0)" ::: "memory");
        }
    }
    __syncthreads();
}

struct Params {
    const float *x, *c, *ctx, *c_ctx, *ada_w, *ada_b, *norm_g, *mlp_w1, *mlp_w2, *w_qkv, *w_o, *sink;
    const float *w_in, *conv_w, *conv_b, *w_a, *b_a, *w_i, *b_i, *lam, *w_out;
    float* out; unsigned char* ws;
};

typedef const __attribute__((address_space(4))) Params* ParamsK;
__device__ __forceinline__ void transpose_item(const float* W, int ldw, bf16_t* WT, int ldwt, int k0, int n0, int dst_row0, LAS float* scr, int lane) {
#pragma unroll 8
    for (int i = 0; i < 32; ++i) { const int kk = 2 * i + (lane >> 5); scr[kk * 33 + (lane & 31)] = W[(size_t)(k0 + kk) * ldw + n0 + (lane & 31)]; }
    asm volatile("s_waitcnt lgkmcnt(0)" ::: "memory");
    const int c = lane & 7;
#pragma unroll
    for (int j = 0; j < 4; ++j) { const int n = (lane >> 3) + 8 * j; const LAS float* s = scr + (8 * c) * 33 + n;
        u32x4 o; o.x = cvt_pk_bf16(s[0 * 33], s[1 * 33]); o.y = cvt_pk_bf16(s[2 * 33], s[3 * 33]); o.z = cvt_pk_bf16(s[4 * 33], s[5 * 33]); o.w = cvt_pk_bf16(s[6 * 33], s[7 * 33]);
        *(u32x4*)(WT + (size_t)(dst_row0 + n) * ldwt + k0 + 8 * c) = o; }
    asm volatile("s_waitcnt lgkmcnt(0)" ::: "memory");
}
__device__ __forceinline__ void transpose_plain(const float* W, int K, int N, bf16_t* WT, int r, LAS float* scr, int lane) {
    const int nblk = N / 32, kb = r / nblk, nb = r % nblk;
    transpose_item(W, N, WT, K, 64 * kb, 32 * nb, 32 * nb, scr, lane);
}

__device__ __forceinline__ void prologue(ParamsK p, LAS unsigned char* lds, int tid, int lane, int wave) {
    unsigned char* ws = p->ws;
    float* MOD = (float*)(ws + WS_MOD);
    if (blockIdx.x < 96) {
        LAS float* sl = (LAS float*)lds;
        LAS float* red = (LAS float*)(lds + 36864);
        for (int idx = tid; idx < 9216; idx += 512) { const int w = idx >> 10, k = idx & 1023; const float v = (w < 8) ? p->c[w * 1024 + k] : p->c_ctx[k]; sl[idx] = v / (1.0f + __expf(-v)); }
        __syncthreads();
        const int l = blockIdx.x / 48, n0 = (blockIdx.x % 48) * 128, kg = tid >> 5, cq = tid & 31;
        f32x4 acc[9];
#pragma unroll
        for (int w = 0; w < 9; ++w) acc[w] = (f32x4){0.f, 0.f, 0.f, 0.f};
        const float* wb = p->ada_w + (size_t)l * 1024 * 6144 + n0 + cq * 4;
#pragma unroll 4
        for (int it = 0; it < 64; ++it) { const int k = it * 16 + kg; const f32x4 w4 = *(const f32x4*)(wb + (size_t)k * 6144);
#pragma unroll
            for (int w = 0; w < 9; ++w) acc[w] += sl[w * 1024 + k] * w4; }
#pragma unroll
        for (int w = 0; w < 9; ++w) *(LAS f32x4*)(red + (kg * 9 + w) * 128 + cq * 4) = acc[w];
        __syncthreads();
        for (int idx = tid; idx < 9 * 128; idx += 512) { const int w = idx >> 7, n = idx & 127; float s = 0.f;
#pragma unroll
            for (int g = 0; g < 16; ++g) s += red[(g * 9 + w) * 128 + n];
            MOD[(size_t)(l * 9 + w) * 6144 + n0 + n] = s + p->ada_b[l * 6144 + n0 + n]; }
        __syncthreads();
    }
    if (blockIdx.x == gridDim.x - 1) {
        float* rope = (float*)(ws + WS_ROPE); float* nls = (float*)(ws + WS_NLS);
        for (int idx = tid; idx < 1024; idx += 512) { const int pos = idx >> 4, i = idx & 15;
            const float inv = __builtin_exp2f(-(float)i * (13.287712379549449f / 16.0f));
            const float angf = (float)pos * inv; const double ang = (double)angf;
            const double twopi = 6.283185307179586476925287; const double r = ang - twopi * __builtin_rint(ang / twopi);
            const double r2 = r * r; double cterm = 1.0, sterm = r, cs = 1.0, sn = r;
            for (int k = 1; k <= 14; ++k) { cterm *= -r2 / (double)((2 * k - 1) * (2 * k)); sterm *= -r2 / (double)((2 * k) * (2 * k + 1)); cs += cterm; sn += sterm; }
            rope[idx * 2] = (float)cs; rope[idx * 2 + 1] = (float)sn; }
        for (int idx = tid; idx < 2 * DRNN; idx += 512) { const float lm = p->lam[idx]; nls[idx] = -8.0f * log1pf(__expf(-lm)); }
        { unsigned* fl = (unsigned*)(ws + WS_FLAG); for (int idx = tid; idx < 1440 * 16; idx += 512) fl[idx] = 0u; }
    }
    LAS float* scr = (LAS float*)(lds + wave * 16384);
    const int gw = blockIdx.x * 8 + wave, NGW = gridDim.x * 8;
    constexpr int I_QKV = 16 * 48, I_O = 16 * 32, I_1 = 16 * 128, I_2 = 64 * 32, I_IN = 16 * 80, I_OUT = 20 * 32, I_G = 40 * 16;
    constexpr int NITEMS = I_QKV + I_O + 2 * I_1 + 2 * I_2 + I_IN + I_OUT + I_G;
    for (int it = gw; it < NITEMS; it += NGW) {
        int r = it;
        if (r < I_QKV) { transpose_plain(p->w_qkv, 1024, NQKV, (bf16_t*)(ws + WS_WQKV), r, scr, lane); continue; } r -= I_QKV;
        if (r < I_O) { transpose_plain(p->w_o, 1024, 1024, (bf16_t*)(ws + WS_WO), r, scr, lane); continue; } r -= I_O;
        if (r < 2 * I_1) { const int l = r / I_1; transpose_plain(p->mlp_w1 + (size_t)l * 1024 * DFF, 1024, DFF, (bf16_t*)(ws + WS_W1 + (size_t)l * 16 * MiB), r % I_1, scr, lane); continue; } r -= 2 * I_1;
        if (r < 2 * I_2) { const int l = r / I_2; transpose_plain(p->mlp_w2 + (size_t)l * 1024 * DFF, DFF, 1024, (bf16_t*)(ws + WS_W2 + (size_t)l * 16 * MiB), r % I_2, scr, lane); continue; } r -= 2 * I_2;
        if (r < I_IN) { transpose_plain(p->w_in, 1024, 2 * DRNN, (bf16_t*)(ws + WS_WIN), r, scr, lane); continue; } r -= I_IN;
        if (r < I_OUT) { transpose_plain(p->w_out, DRNN, 1024, (bf16_t*)(ws + WS_WOUT), r, scr, lane); continue; } r -= I_OUT;
        {
            const int sm = r >> 4, ii = r & 15, kb = ii >> 2, nb = ii & 3;
            const int chalf = sm & 1, blk = (sm >> 1) % 5, dg = (sm >> 1) / 5, gate = dg & 1, dir = dg >> 1;
            const float* W = (gate ? p->w_i : p->w_a) + (size_t)(dir * 5 + blk) * 256 * 256;
            const int dst_row0 = ((dir * 5 + blk) * 2 + chalf) * 256 + gate * 128 + nb * 32;
            transpose_item(W, 256, (bf16_t*)(ws + WS_WG), 256, 64 * kb, chalf * 128 + nb * 32, dst_row0, scr, lane);
        }
    }
}

template <bool HAS_Y, bool HAS_H>
__device__ __forceinline__ void row_phase(const float* xin_lat, const float* xin_ctx, float* xout_lat, float* xout_ctx, const bf16_t* Y, const bf16_t* SLAB, bf16_t* H,
                                          const float* gy, const float* gh, const float* mod_g, int gate_idx, const float* mod_h, int shift_idx, int scale_idx,
                                          int nrows, int gw, int ngw, int lane) {
    const int rpw = (nrows + ngw - 1) / ngw, r_begin = gw * rpw, r_end = (r_begin + rpw < nrows) ? r_begin + rpw : nrows;
    f32x4 xn[4]; u32x2 yn[4], ys[3][4];
    f32x4 vgy[4], vgh[4], vgt[4], vsh[4], vsc[4];
#pragma unroll
    for (int j = 0; j < 4; ++j) { if (HAS_Y) vgy[j] = *(const f32x4*)(gy + lane * 4 + 256 * j); if (HAS_H) vgh[j] = *(const f32x4*)(gh + lane * 4 + 256 * j); }
    int cur_who = -1;
#define ROW_LOAD(r) do { const int r_ = (r); const bool lat_ = r_ < ML; \
        const float* xi_ = lat_ ? xin_lat + (size_t)r_ * DM : xin_ctx + (size_t)(r_ - ML) * DM; \
        _Pragma("unroll") for (int j = 0; j < 4; ++j) xn[j] = *(const f32x4*)(xi_ + lane * 4 + 256 * j); \
        if (HAS_Y) { if (SLAB != nullptr && !lat_) { const bf16_t* yp_ = SLAB + (size_t)(r_ - ML) * DM + lane * 4; \
                _Pragma("unroll") for (int j = 0; j < 4; ++j) { yn[j] = *(const u32x2*)(yp_ + 256 * j); ys[0][j] = *(const u32x2*)(yp_ + 256 * j + (size_t)MC * DM); ys[1][j] = *(const u32x2*)(yp_ + 256 * j + (size_t)2 * MC * DM); ys[2][j] = *(const u32x2*)(yp_ + 256 * j + (size_t)3 * MC * DM); } } \
            else { _Pragma("unroll") for (int j = 0; j < 4; ++j) yn[j] = *(const u32x2*)(Y + (size_t)r_ * DM + lane * 4 + 256 * j); } } } while (0)
    if (r_begin < r_end) ROW_LOAD(r_begin);
    for (int row = r_begin; row < r_end; ++row) {
        const bool lat = row < ML; const int who = lat ? (row >> 11) : 8;
        if (who != cur_who) { cur_who = who;
#pragma unroll
            for (int j = 0; j < 4; ++j) { const int col = lane * 4 + 256 * j;
                if (HAS_Y) vgt[j] = *(const f32x4*)(mod_g + (size_t)who * 6144 + gate_idx * 1024 + col);
                if (HAS_H) { vsh[j] = *(const f32x4*)(mod_h + (size_t)who * 6144 + shift_idx * 1024 + col); vsc[j] = *(const f32x4*)(mod_h + (size_t)who * 6144 + scale_idx * 1024 + col) + 1.0f; } } }
        f32x4 xv[4], yv[4];
#pragma unroll
        for (int j = 0; j < 4; ++j) xv[j] = xn[j];
        if (HAS_Y) {
#pragma unroll
            for (int j = 0; j < 4; ++j) { yv[j] = bf4_to_f32(yn[j]);
                if (SLAB != nullptr && !lat) yv[j] = (yv[j] + bf4_to_f32(ys[0][j])) + (bf4_to_f32(ys[1][j]) + bf4_to_f32(ys[2][j])); }
        }
        asm volatile("" ::: "memory");
        if (row + 1 < r_end) ROW_LOAD(row + 1);
        if (HAS_Y) {
            float s = 0.f;
#pragma unroll
            for (int j = 0; j < 4; ++j) s += (yv[j][0] * yv[j][0] + yv[j][1] * yv[j][1]) + (yv[j][2] * yv[j][2] + yv[j][3] * yv[j][3]);
            const float rstd = 1.0f / sqrtf(wave_sum(s) * (1.0f / DM) + EPS);
            float* xo = lat ? xout_lat + (size_t)row * DM : xout_ctx + (size_t)(row - ML) * DM;
#pragma unroll
            for (int j = 0; j < 4; ++j) { xv[j] = xv[j] + vgt[j] * (yv[j] * rstd * vgy[j]); *(f32x4*)(xo + lane * 4 + 256 * j) = xv[j]; }
        }
        if (HAS_H) {
            float s = 0.f;
#pragma unroll
            for (int j = 0; j < 4; ++j) s += (xv[j][0] * xv[j][0] + xv[j][1] * xv[j][1]) + (xv[j][2] * xv[j][2] + xv[j][3] * xv[j][3]);
            const float rstd = 1.0f / sqrtf(wave_sum(s) * (1.0f / DM) + EPS);
#pragma unroll
            for (int j = 0; j < 4; ++j) { const f32x4 hv = (xv[j] * rstd * vgh[j]) * vsc[j] + vsh[j]; *(u32x2*)(H + (size_t)row * DM + lane * 4 + 256 * j) = f32_to_bf4(hv); }
        }
    }
#undef ROW_LOAD
}

__device__ __forceinline__ void attn_phase(LAS unsigned char* lds, const bf16_t* Q, bf16_t* O, const bf16_t* Kb, const bf16_t* VT, const bf16_t* VTC, const float* sink, int tid, int lane, int wave) {
    constexpr int PITCH = 72;
    LAS bf16_t* Ks = (LAS bf16_t*)lds;
    LAS bf16_t* Vs = (LAS bf16_t*)(lds + 2 * 64 * PITCH * 2);
    const int lr = lane & 15, lg = lane >> 4;
    const int skey = tid >> 3, spiece = tid & 7;
    for (int unit = blockIdx.x; unit < 576; unit += gridDim.x) {
        int b, kvh, qrow0, qblk, nloc, lt0; bool latu = unit < 512;
        if (latu) { b = unit >> 6; const int rem = unit & 63; qblk = rem >> 2; kvh = rem & 3; qrow0 = b * SEQ + qblk * 128; lt0 = (qblk == 0) ? 2 : 0; nloc = ((qblk == 15) ? 4 : 6) - lt0; }
        else { const int cu = unit - 512; b = cu >> 3; kvh = (cu & 7) >> 1; qblk = 0; qrow0 = ML + b * CTX + (cu & 1) * 128; lt0 = 0; nloc = 0; }
        const int nT = nloc + 4;
        const int head = kvh * 4 + (wave >> 1);
        const int qr0 = qrow0 + (wave & 1) * 64;
        const bf16_t* qbase = Q + (size_t)qr0 * 1024 + head * 64;
        bf16_t* obase = O + (size_t)qr0 * 1024 + head * 64;
        LAS unsigned char* Qs = lds + 40960 + wave * 8192;
#pragma unroll
        for (int qt = 0; qt < 4; ++qt)
#pragma unroll
            for (int dh = 0; dh < 2; ++dh) *(LAS bf16x8*)(Qs + (qt * 2 + dh) * 1024 + lane * 16) = *(const bf16x8*)(qbase + (unsigned)((qt * 16 + lr) * 1024 + dh * 32 + lg * 8));
        f32x4 o[4][4];
#pragma unroll
        for (int qt = 0; qt < 4; ++qt)
#pragma unroll
            for (int dt = 0; dt < 4; ++dt) o[qt][dt] = (f32x4){0.f, 0.f, 0.f, 0.f};
        float m2[4], ls[4];
        { const float sk = sink[head] * LOG2E;
#pragma unroll
          for (int qt = 0; qt < 4; ++qt) { m2[qt] = sk; ls[qt] = (lg == 0) ? 1.0f : 0.0f; } }
        u32x4 kreg, vreg;
#define ATT_LOAD(j) do { const int _j = (j); if (_j < nloc) { const int tok0 = (qblk - 1) * 128 + (lt0 + _j) * 64; \
                const bf16_t* kb_ = Kb + (size_t)(b * SEQ + tok0) * 256 + kvh * 64; const bf16_t* vb_ = VT + (size_t)(b * 4 + kvh) * 64 * SEQ + tok0; \
                kreg = *(const u32x4*)(kb_ + (unsigned)(skey * 256 + spiece * 8)); vreg = *(const u32x4*)(vb_ + (unsigned)(skey * SEQ + spiece * 8)); } \
            else { const int tok0 = (_j - nloc) * 64; \
                const bf16_t* kb_ = Kb + (size_t)(ML + b * CTX + tok0) * 256 + kvh * 64; const bf16_t* vb_ = VTC + (size_t)(b * 4 + kvh) * 64 * CTX + tok0; \
                kreg = *(const u32x4*)(kb_ + (unsigned)(skey * 256 + spiece * 8)); vreg = *(const u32x4*)(vb_ + (unsigned)(skey * CTX + spiece * 8)); } } while (0)
#define ATT_STORE(buf) do { *(LAS u32x4*)(Ks + (buf) * 64 * PITCH + skey * PITCH + spiece * 8) = kreg; *(LAS u32x4*)(Vs + (buf) * 64 * PITCH + skey * PITCH + spiece * 8) = vreg; } while (0)
        __syncthreads();
        ATT_LOAD(0); ATT_STORE(0);
        __syncthreads();
        for (int j = 0; j < nT; ++j) {
            const int buf = j & 1;
            if (j + 1 < nT) ATT_LOAD(j + 1);
            const LAS bf16_t* Kt = Ks + buf * 64 * PITCH; const LAS bf16_t* Vt = Vs + buf * 64 * PITCH;
            int mmode = 0, ktok0 = 0;
            if (j < nloc) { const int lt = lt0 + j; ktok0 = (qblk - 1) * 128 + lt * 64; mmode = (lt < 2) ? 1 : ((lt >= 4) ? 2 : 0); }
            bf16x8 kf[4][2];
#pragma unroll
            for (int ks = 0; ks < 4; ++ks)
#pragma unroll
                for (int dh = 0; dh < 2; ++dh) kf[ks][dh] = *(const LAS bf16x8*)(Kt + (ks * 16 + lr) * PITCH + dh * 32 + lg * 8);
#pragma unroll
            for (int hq = 0; hq < 2; ++hq) {
            bf16x8 pb[2][2];
#pragma unroll
            for (int q2 = 0; q2 < 2; ++q2) {
                const int qt = hq * 2 + q2;
                f32x4 s[4];
                const bf16x8 qf0 = *(const LAS bf16x8*)(Qs + (qt * 2 + 0) * 1024 + lane * 16), qf1 = *(const LAS bf16x8*)(Qs + (qt * 2 + 1) * 1024 + lane * 16);
#pragma unroll
                for (int ks = 0; ks < 4; ++ks) { s[ks] = __builtin_amdgcn_mfma_f32_16x16x32_bf16(kf[ks][0], qf0, (f32x4){0.f, 0.f, 0.f, 0.f}, 0, 0, 0);
                    s[ks] = __builtin_amdgcn_mfma_f32_16x16x32_bf16(kf[ks][1], qf1, s[ks], 0, 0, 0); }
                if (mmode) { const int qp = qblk * 128 + (wave & 1) * 64 + qt * 16 + lr;
#pragma unroll
                    for (int ks = 0; ks < 4; ++ks)
#pragma unroll
                        for (int jj = 0; jj < 4; ++jj) { const int kp = ktok0 + ks * 16 + lg * 4 + jj; const bool ok = (mmode == 1) ? (kp >= qp - 128) : (kp <= qp + 128); s[ks][jj] = ok ? s[ks][jj] : -1e30f; } }
                float mx = -3e38f;
#pragma unroll
                for (int ks = 0; ks < 4; ++ks) mx = fmaxf(mx, fmaxf(fmaxf(s[ks][0], s[ks][1]), fmaxf(s[ks][2], s[ks][3])));
                mx = fmaxf(mx, __shfl_xor(mx, 16)); mx = fmaxf(mx, __shfl_xor(mx, 32));
                const float mnew = fmaxf(m2[qt], mx * LOG2E);
                const float alpha = __builtin_amdgcn_exp2f(m2[qt] - mnew);
                m2[qt] = mnew;
                float rs = 0.f;
#pragma unroll
                for (int ks = 0; ks < 4; ++ks)
#pragma unroll
                    for (int jj = 0; jj < 4; ++jj) { const float pv = __builtin_amdgcn_exp2f(s[ks][jj] * LOG2E - mnew); s[ks][jj] = pv; rs += pv; }
                ls[qt] = ls[qt] * alpha + rs;
#pragma unroll
                for (int dt = 0; dt < 4; ++dt) o[qt][dt] = o[qt][dt] * alpha;
#pragma unroll
                for (int c2 = 0; c2 < 2; ++c2) { u32x4 w; w.x = cvt_pk_bf16(s[2 * c2][0], s[2 * c2][1]); w.y = cvt_pk_bf16(s[2 * c2][2], s[2 * c2][3]); w.z = cvt_pk_bf16(s[2 * c2 + 1][0], s[2 * c2 + 1][1]); w.w = cvt_pk_bf16(s[2 * c2 + 1][2], s[2 * c2 + 1][3]);
                    pb[q2][c2] = __builtin_bit_cast(bf16x8, w); }
            }
#pragma unroll
            for (int c2 = 0; c2 < 2; ++c2)
#pragma unroll
                for (int dt = 0; dt < 4; ++dt) {
                    const LAS bf16_t* vp = Vt + (dt * 16 + lr) * PITCH + c2 * 32 + lg * 4;
                    const u32x2 v0 = *(const LAS u32x2*)vp, v1 = *(const LAS u32x2*)(vp + 16);
                    const u32x4 vv = {v0.x, v0.y, v1.x, v1.y};
                    const bf16x8 vf = __builtin_bit_cast(bf16x8, vv);
#pragma unroll
                    for (int q2 = 0; q2 < 2; ++q2) o[hq * 2 + q2][dt] = __builtin_amdgcn_mfma_f32_16x16x32_bf16(vf, pb[q2][c2], o[hq * 2 + q2][dt], 0, 0, 0);
                }
            }
            if (j + 1 < nT) ATT_STORE(buf ^ 1);
            __syncthreads();
        }
#pragma unroll
        for (int qt = 0; qt < 4; ++qt) {
            float l = ls[qt]; l += __shfl_xor(l, 16); l += __shfl_xor(l, 32);
            const float inv = 1.0f / l;
            int lro = lr * 1024 + lg * 4; asm volatile("" : "+v"(lro));
            bf16_t* op = obase + (unsigned)(qt * 16 * 1024 + lro);
#pragma unroll
            for (int dt = 0; dt < 4; ++dt) *(u32x2*)(op + dt * 16) = f32_to_bf4(o[qt][dt] * inv);
        }
    }
#undef ATT_LOAD
#undef ATT_STORE
}

__device__ __forceinline__ void conv_phase(const bf16_t* R, bf16_t* U, const float* cw, const float* cb, int gtid, int nthreads) {
    for (int idx = gtid; idx < MT * 160; idx += nthreads) {
        const int row = idx / 160, ch = (idx % 160) * 8;
        int t, T; if (row < ML) { t = row & 2047; T = SEQ; } else { t = (row - ML) & 255; T = CTX; }
        float acc[8];
        { const f32x4 b0 = *(const f32x4*)(cb + ch), b1 = *(const f32x4*)(cb + ch + 4); acc[0] = b0[0]; acc[1] = b0[1]; acc[2] = b0[2]; acc[3] = b0[3]; acc[4] = b1[0]; acc[5] = b1[1]; acc[6] = b1[2]; acc[7] = b1[3]; }
#pragma unroll
        for (int tap = 0; tap < 4; ++tap) { const int tt = t + tap - 2;
            if (tt >= 0 && tt < T) { const u32x4 rv = *(const u32x4*)(R + (size_t)(row + tap - 2) * DRNN + ch);
                const f32x4 w0 = *(const f32x4*)(cw + tap * DRNN + ch), w1 = *(const f32x4*)(cw + tap * DRNN + ch + 4);
                acc[0] += w0[0] * bf_lo(rv.x); acc[1] += w0[1] * bf_hi(rv.x); acc[2] += w0[2] * bf_lo(rv.y); acc[3] += w0[3] * bf_hi(rv.y);
                acc[4] += w1[0] * bf_lo(rv.z); acc[5] += w1[1] * bf_hi(rv.z); acc[6] += w1[2] * bf_lo(rv.w); acc[7] += w1[3] * bf_hi(rv.w); } }
        u32x4 o; o.x = cvt_pk_bf16(acc[0], acc[1]); o.y = cvt_pk_bf16(acc[2], acc[3]); o.z = cvt_pk_bf16(acc[4], acc[5]); o.w = cvt_pk_bf16(acc[6], acc[7]);
        *(u32x4*)(U + (size_t)row * DRNN + ch) = o;
    }
}
__device__ __forceinline__ int scan_row0(int bl, int c) { return (c < 8) ? (8192 + bl * CTX + c * 32) : (bl * SEQ + (c - 8) * 32); }
__device__ __forceinline__ void scanA_phase(const bf16_t* LA, const bf16_t* BX, float* SP, float* SH, int gtid, int nthreads) {
    for (int idx = gtid; idx < 2 * 4 * 72 * 640; idx += nthreads) {
        const int cp = idx % 640, r1 = idx / 640, c = r1 % 72, r2 = r1 / 72, bl = r2 & 3, dir = r2 >> 2;
        const int row0 = scan_row0(bl, c);
        const size_t base = ((size_t)dir * 9216 + row0) * DRNN + cp * 2;
        float P0 = 1.f, P1 = 1.f, H0 = 0.f, H1 = 0.f;
#pragma unroll 8
        for (int i = 0; i < 32; ++i) { const int ii = dir ? (31 - i) : i;
            const unsigned lw = *(const unsigned*)(LA + base + (size_t)ii * DRNN), bw = *(const unsigned*)(BX + base + (size_t)ii * DRNN);
            const float a0 = __expf(bf_lo(lw)), a1 = __expf(bf_hi(lw));
            P0 *= a0; P1 *= a1; H0 = a0 * H0 + bf_lo(bw); H1 = a1 * H1 + bf_hi(bw); }
        const size_t so = ((size_t)(dir * 4 + bl) * 72 + c) * DRNN + cp * 2;
        *(f32x2*)(SP + so) = (f32x2){P0, P1}; *(f32x2*)(SH + so) = (f32x2){H0, H1};
    }
}
__device__ __forceinline__ void scanB_phase(const float* SP, const float* SH, float* CIN, int gtid, int nthreads) {
    for (int idx = gtid; idx < 2 * 4 * DRNN; idx += nthreads) {
        const int ch = idx % DRNN, r = idx / DRNN, bl = r & 3, dir = r >> 2;
        const size_t base = ((size_t)(dir * 4 + bl) * 72) * DRNN + ch;
        float carry = 0.f;
#pragma unroll 1
        for (int s0 = 0; s0 < 72; s0 += 24) {
            float pv[24], hv[24];
#pragma unroll
            for (int s = 0; s < 24; ++s) { const int sq = s0 + s; const int c = dir ? (sq < 8 ? 7 - sq : 79 - sq) : sq; pv[s] = SP[base + (size_t)c * DRNN]; hv[s] = SH[base + (size_t)c * DRNN]; }
#pragma unroll
            for (int s = 0; s < 24; ++s) { const int sq = s0 + s; const int c = dir ? (sq < 8 ? 7 - sq : 79 - sq) : sq; CIN[base + (size_t)c * DRNN] = carry; carry = pv[s] * carry + hv[s]; }
        }
    }
}
__device__ __forceinline__ void scanC_phase(const bf16_t* LA, const bf16_t* BX, const float* CIN, bf16_t* REC, int half, int gtid, int nthreads) {
    for (int idx = gtid; idx < 4 * 64 * 640; idx += nthreads) {
        const int cp = idx % 640, r1 = idx / 640, lc = r1 & 63, bl = r1 >> 6;
        const int row0 = bl * SEQ + lc * 32;
        const size_t b0 = ((size_t)row0) * DRNN + cp * 2, b1 = ((size_t)9216 + row0) * DRNN + cp * 2;
        const f32x2 cf = *(const f32x2*)(CIN + ((size_t)(0 * 4 + bl) * 72 + 8 + lc) * DRNN + cp * 2);
        const f32x2 cbk = *(const f32x2*)(CIN + ((size_t)(1 * 4 + bl) * 72 + 8 + lc) * DRNN + cp * 2);
        float hf0[32], hf1[32];
        float h0 = cf[0], h1 = cf[1];
#pragma unroll
        for (int i = 0; i < 32; ++i) { const unsigned lw = *(const unsigned*)(LA + b0 + (size_t)i * DRNN), bw = *(const unsigned*)(BX + b0 + (size_t)i * DRNN);
            h0 = __expf(bf_lo(lw)) * h0 + bf_lo(bw); h1 = __expf(bf_hi(lw)) * h1 + bf_hi(bw); hf0[i] = h0; hf1[i] = h1; }
        h0 = cbk[0]; h1 = cbk[1];
        bf16_t* out = REC + ((size_t)(half * 4 + bl) * SEQ + lc * 32) * DRNN + cp * 2;
#pragma unroll
        for (int i = 31; i >= 0; --i) { const unsigned lw = *(const unsigned*)(LA + b1 + (size_t)i * DRNN), bw = *(const unsigned*)(BX + b1 + (size_t)i * DRNN);
            h0 = __expf(bf_lo(lw)) * h0 + bf_lo(bw); h1 = __expf(bf_hi(lw)) * h1 + bf_hi(bw);
            *(unsigned*)(out + (size_t)i * DRNN) = cvt_pk_bf16(hf0[i] + h0, hf1[i] + h1); }
    }
}

#ifndef PH_MASK
#define PH_MASK 0xFFFFFFFFu
#endif
#define PH(k) ((PH_MASK >> (k)) & 1u)
#ifndef REP_MASK
#define REP_MASK 0u
#endif
#define REP_BEGIN(k) _Pragma("unroll 1") for (int rep_ = 0; rep_ < (((REP_MASK >> (k)) & 1u) ? 2 : 1); ++rep_) {
#define REP_END }
__device__ __forceinline__ ParamsK kparams() { ParamsK q = (ParamsK)__builtin_amdgcn_kernarg_segment_ptr(); asm volatile("" : "+s"(q)); return q; }
#define PHASE_BEGIN ParamsK kp = kparams(); unsigned char* ws = kp->ws; (void)ws; \
    int tid = threadIdx.x; asm volatile("" : "+v"(tid)); const int lane = tid & 63, wave = __builtin_amdgcn_readfirstlane(tid >> 6); \
    const int gw = bid * 8 + wave, gtid = bid * 512 + tid; (void)lane; (void)gw; (void)gtid;
#define P_MOD0 ((float*)(ws + WS_MOD))
#define P_MOD1 ((float*)(ws + WS_MOD) + 9 * 6144)
#define P_CTXRES ((float*)(ws + WS_CTXRES))
#define P_H ((bf16_t*)(ws + WS_H))
#define P_SLAB ((bf16_t*)(ws + WS_SLAB))
#define P_Q ((bf16_t*)(ws + WS_Q))
#define P_O ((bf16_t*)(ws + WS_O))
#define P_K ((bf16_t*)(ws + WS_K))
#define P_VT ((bf16_t*)(ws + WS_VT))
#define P_VTC ((bf16_t*)(ws + WS_VTC))
#define P_ACT ((bf16_t*)(ws + WS_ACT))
#define P_U ((bf16_t*)(ws + WS_U))
#define P_RECF ((bf16_t*)(ws + WS_RECF))
#define P_RECB ((bf16_t*)(ws + WS_RECB))
#define P_LA ((bf16_t*)(ws + WS_LA))
#define P_BX ((bf16_t*)(ws + WS_BX))
#define P_RPRE ((bf16_t*)(ws + WS_RPRE))
#define P_SP ((float*)(ws + WS_SP))
#define P_SH ((float*)(ws + WS_SH))
#define P_CIN ((float*)(ws + WS_CIN))
#define G0 (kp->norm_g)
#define G1 (kp->norm_g + 4 * DM)

__global__ void __launch_bounds__(512, 2) fwd_megakernel(Params p) {
    extern __shared__ __attribute__((aligned(16))) unsigned char lds_raw[];
    LAS unsigned char* lds = (LAS unsigned char*)lds_raw;
    const int G = gridDim.x, bid = blockIdx.x;
    const int ngw = G * 8, nthreads = G * 512;
    using namespace pg8;
    if (threadIdx.x < 4) ((volatile LAS unsigned*)(lds + 132096))[threadIdx.x] = 0u;
    __syncthreads();
    XcdBarrier xbar = xcd_barrier_post((unsigned*)(p.ws + WS_BAR), (volatile LAS unsigned*)(lds + 132096));
    if (PH(0)) { PHASE_BEGIN prologue(kp, lds, tid, lane, wave); }
    xcd_barrier(xbar);
#ifdef EXTRA_SYNCS
#pragma unroll 1
    for (int es = 0; es < EXTRA_SYNCS; ++es) xcd_barrier(xbar);
#endif
    REP_BEGIN(1)
    if (PH(1)) { PHASE_BEGIN row_phase<false, true>(kp->x, kp->ctx, nullptr, nullptr, nullptr, nullptr, P_H, nullptr, G0, nullptr, 0, P_MOD0, 0, 1, MT, gw, ngw, lane); }
    xcd_barrier(xbar);
    REP_END
    if (PH(2)) {
        PHASE_BEGIN
        Gemm g{P_H, (const bf16_t*)(ws + WS_WQKV), DM, DM, DM}; Sched S; S.init(MT / 256, NQKV / 256, G, bid);
        EpiQKV E{P_Q, P_K, P_VT, P_VTC, (const float*)(ws + WS_ROPE)};
        gemm_phase<EpiQKV, true, true>(lds, g, S, E);
    }
    xcd_barrier(xbar);
    REP_BEGIN(3)
    if (PH(3)) { PHASE_BEGIN attn_phase(lds, P_Q, P_O, P_K, P_VT, P_VTC, kp->sink, tid, lane, wave); }
    xcd_barrier(xbar);
    REP_END
    if (PH(4)) {
        PHASE_BEGIN
        { Gemm g{P_O, (const bf16_t*)(ws + WS_WO), DM, DM, DM}; Sched S; S.init(ML / 256, DM / 256, G, bid);
          EpiPlain<0> E{P_H, DM};
          gemm_phase<EpiPlain<0>, true, true>(lds, g, S, E); }
        { Gemm g{P_O, (const bf16_t*)(ws + WS_WO), DM, DM, 256}; Sched S; S.init(8, 4 * 4, G, bid, 2, 256);
          EpiSlabCtx E{P_SLAB, 256};
          gemm_phase<EpiSlabCtx, true, true>(lds, g, S, E); }
    }
    xcd_barrier(xbar);
    if (PH(5)) { PHASE_BEGIN row_phase<true, true>(kp->x, kp->ctx, kp->out, P_CTXRES, P_H, P_SLAB, P_H, G0 + DM, G0 + 2 * DM, P_MOD0, 2, P_MOD0, 3, 4, MT, gw, ngw, lane); }
    xcd_barrier(xbar);
    if (PH(6)) {
        PHASE_BEGIN
        Gemm g{P_H, (const bf16_t*)(ws + WS_W1), DM, DM, DM}; Sched S; S.init(MT / 256, DFF / 256, G, bid);
        EpiPlain<1> E{P_ACT, DFF};
        gemm_phase<EpiPlain<1>, true, true>(lds, g, S, E);
    }
    xcd_barrier(xbar);
    if (PH(7)) {
        PHASE_BEGIN
        { Gemm g{P_ACT, (const bf16_t*)(ws + WS_W2), DFF, DFF, DFF}; Sched S; S.init(ML / 256, DM / 256, G, bid);
          EpiPlain<0> E{P_H, DM};
          gemm_phase<EpiPlain<0>, true, true>(lds, g, S, E); }
        { Gemm g{P_ACT, (const bf16_t*)(ws + WS_W2), DFF, DFF, 1024}; Sched S; S.init(8, 4 * 4, G, bid, 2, 1024);
          EpiSlabCtx E{P_SLAB, 1024};
          gemm_phase<EpiSlabCtx, true, true>(lds, g, S, E); }
    }
    xcd_barrier(xbar);
    if (PH(8)) { PHASE_BEGIN row_phase<true, true>(kp->out, P_CTXRES, kp->out, P_CTXRES, P_H, P_SLAB, P_H, G0 + 3 * DM, G1, P_MOD0, 5, P_MOD1, 0, 1, MT, gw, ngw, lane); }
    xcd_barrier(xbar);
    if (PH(9)) {
        PHASE_BEGIN
        Gemm g{P_H, (const bf16_t*)(ws + WS_WIN) + (size_t)DRNN * DM, DM, DM, DM}; Sched S; S.init(MT / 256, DRNN / 256, G, bid);
        EpiPlain<0> E{P_RPRE, DRNN};
        gemm_phase<EpiPlain<0>, true, true>(lds, g, S, E);
    }
    xcd_barrier(xbar);
    REP_BEGIN(10)
    if (PH(10)) { PHASE_BEGIN conv_phase(P_RPRE, P_U, kp->conv_w, kp->conv_b, gtid, nthreads); }
    xcd_barrier(xbar);
    REP_END
    if (PH(11)) {
        PHASE_BEGIN
        Gemm g{P_U, (const bf16_t*)(ws + WS_WG), DRNN, 256, 256}; Sched S; S.init(1, 1, G, bid, 3, 0);
        EpiGatesScan E{P_U, P_RECF, P_RECB, kp->b_a, kp->b_i, (const float*)(ws + WS_NLS), (float*)(ws + WS_CARRY), (unsigned*)(ws + WS_FLAG)};
        gemm_phase<EpiGatesScan, true, true>(lds, g, S, E);
    }
    xcd_barrier(xbar);
    if (PH(15)) {
        PHASE_BEGIN
        Gemm g{P_H, (const bf16_t*)(ws + WS_WIN), DM, DM, DM}; Sched S; S.init(ML / 256, DRNN / 256, G, bid);
        EpiGateMul E{P_RECF, P_RECB};
        gemm_phase<EpiGateMul, true, true>(lds, g, S, E);
    }
    xcd_barrier(xbar);
    if (PH(16)) {
        PHASE_BEGIN
        Gemm g{P_RECF, (const bf16_t*)(ws + WS_WOUT), DRNN, DRNN, DRNN}; Sched S; S.init(ML / 256, DM / 256, G, bid);
        EpiPlain<0> E{P_H, DM};
        gemm_phase<EpiPlain<0>, true, true>(lds, g, S, E);
    }
    xcd_barrier(xbar);
    if (PH(17)) { PHASE_BEGIN row_phase<true, true>(kp->out, P_CTXRES, kp->out, P_CTXRES, P_H, nullptr, P_H, G1 + DM, G1 + 2 * DM, P_MOD1, 2, P_MOD1, 3, 4, ML, gw, ngw, lane); }
    xcd_barrier(xbar);
    if (PH(18)) {
        PHASE_BEGIN
        Gemm g{P_H, (const bf16_t*)(ws + WS_W1 + 16 * MiB), DM, DM, DM}; Sched S; S.init(ML / 256, DFF / 256, G, bid);
        EpiPlain<1> E{P_ACT, DFF};
        gemm_phase<EpiPlain<1>, true, true>(lds, g, S, E);
    }
    xcd_barrier(xbar);
    if (PH(19)) {
        PHASE_BEGIN
        Gemm g{P_ACT, (const bf16_t*)(ws + WS_W2 + 16 * MiB), DFF, DFF, DFF}; Sched S; S.init(ML / 256, DM / 256, G, bid);
        EpiPlain<0> E{P_H, DM};
        gemm_phase<EpiPlain<0>, true, true>(lds, g, S, E);
    }
    xcd_barrier(xbar);
    if (PH(20)) { PHASE_BEGIN row_phase<true, false>(kp->out, P_CTXRES, kp->out, P_CTXRES, P_H, nullptr, nullptr, G1 + 3 * DM, nullptr, P_MOD1, 5, nullptr, 0, 0, ML, gw, ngw, lane); }
}

extern "C" void kernel_launch(void* const* d_in, const int* in_sizes, int n_in, void* d_out, int out_size, void* d_ws, size_t ws_size, hipStream_t stream) {
    static int grid_blocks = 0;
    if (grid_blocks == 0) {
        if (n_in != 21 || ws_size < WS_END) { fprintf(stderr, "kernel_launch: unexpected n_in %d / ws_size %zu\n", n_in, ws_size); grid_blocks = -1; return; }
        int dev = 0, cus = 0, per_cu = 0;
        hipGetDevice(&dev);
        hipDeviceGetAttribute(&cus, hipDeviceAttributeMultiprocessorCount, dev);
        if (hipFuncSetAttribute((const void*)fwd_megakernel, hipFuncAttributeMaxDynamicSharedMemorySize, LDS_BYTES) != hipSuccess) { fprintf(stderr, "hipFuncSetAttribute failed\n"); grid_blocks = -1; return; }
        if (hipOccupancyMaxActiveBlocksPerMultiprocessor(&per_cu, (const void*)fwd_megakernel, 512, LDS_BYTES) != hipSuccess || per_cu < 1) { fprintf(stderr, "occupancy query failed (%d)\n", per_cu); (void)hipGetLastError(); per_cu = 1; }
        grid_blocks = cus * 1;
    }
    if (grid_blocks < 0) return;
    Params p{};
    p.x = (const float*)d_in[0]; p.c = (const float*)d_in[1]; p.ctx = (const float*)d_in[2]; p.c_ctx = (const float*)d_in[3];
    p.ada_w = (const float*)d_in[4]; p.ada_b = (const float*)d_in[5]; p.norm_g = (const float*)d_in[6]; p.mlp_w1 = (const float*)d_in[7]; p.mlp_w2 = (const float*)d_in[8];
    p.w_qkv = (const float*)d_in[9]; p.w_o = (const float*)d_in[10]; p.sink = (const float*)d_in[11];
    p.w_in = (const float*)d_in[12]; p.conv_w = (const float*)d_in[13]; p.conv_b = (const float*)d_in[14]; p.w_a = (const float*)d_in[15]; p.b_a = (const float*)d_in[16];
    p.w_i = (const float*)d_in[17]; p.b_i = (const float*)d_in[18]; p.lam = (const float*)d_in[19]; p.w_out = (const float*)d_in[20];
    p.out = (float*)d_out; p.ws = (unsigned char*)d_ws;
    if (hipMemsetAsync((unsigned char*)d_ws + WS_BAR, 0, XCD_BAR_WORDS * 4, stream) != hipSuccess) { fprintf(stderr, "memset of barrier words failed\n"); return; }
    void* args[] = {&p};
    hipError_t e = hipLaunchCooperativeKernel((const void*)fwd_megakernel, dim3(grid_blocks), dim3(512), args, LDS_BYTES, stream);
    if (e != hipSuccess) fprintf(stderr, "cooperative launch failed: %s (grid %d)\n", hipGetErrorString(e), grid_blocks);
}
```

```cpp
#include <hip/hip_runtime.h>
#include <hip/hip_cooperative_groups.h>
#include <cstdio>
#include <cstdint>
namespace cg = cooperative_groups;

#define LAS __attribute__((address_space(3)))
typedef unsigned short bf16_t;
typedef short bf16x8 __attribute__((ext_vector_type(8)));
typedef float f32x4 __attribute__((ext_vector_type(4)));
typedef float f32x2 __attribute__((ext_vector_type(2)));
typedef unsigned u32x4 __attribute__((ext_vector_type(4)));
typedef unsigned u32x2 __attribute__((ext_vector_type(2)));

constexpr int DM = 1024, NB = 8, SEQ = 2048, CTX = 256;
constexpr int ML = NB * SEQ;
constexpr int MC = NB * CTX;
constexpr int MT = ML + MC;
constexpr int NQKV = 1536, DFF = 4096, DRNN = 1280;
constexpr float EPS = 1e-6f;
constexpr float LOG2E = 1.4426950408889634f;

constexpr size_t MiB = 1u << 20;
constexpr size_t WS_MOD = 0;
constexpr size_t WS_ROPE = 448 * 1024;
constexpr size_t WS_NLS = 460 * 1024;
constexpr size_t WS_BAR = 480 * 1024;
constexpr size_t WS_WQKV = 1 * MiB, WS_WO = 4 * MiB, WS_W1 = 6 * MiB, WS_W2 = 14 * MiB;
constexpr size_t WS_WIN = 38 * MiB, WS_WG = 43 * MiB, WS_WOUT = 46 * MiB;
constexpr size_t WS_CTXRES = 49 * MiB;
constexpr size_t WS_H = 57 * MiB;
constexpr size_t WS_R3 = 93 * MiB;
constexpr size_t WS_Q = WS_R3, WS_K = 129 * MiB, WS_VT = 138 * MiB, WS_VTC = 146 * MiB;
constexpr size_t WS_O = 150 * MiB;
constexpr size_t WS_ACT = WS_R3;
constexpr size_t WS_U = WS_R3;
constexpr size_t WS_RECF = 138 * MiB;
constexpr size_t WS_RECB = 178 * MiB;
constexpr size_t WS_LA = 138 * MiB;
constexpr size_t WS_BX = 183 * MiB;
constexpr size_t WS_RPRE = 138 * MiB;
constexpr size_t WS_SP = 228 * MiB, WS_SH = 231 * MiB, WS_CIN = 234 * MiB;
constexpr size_t WS_SLAB = 238 * MiB;
constexpr size_t WS_CARRY = 219 * MiB;
constexpr size_t WS_FLAG = 512 * 1024;
constexpr size_t WS_END = 256 * MiB;
constexpr int LDS_BYTES = 135168;

__device__ __forceinline__ unsigned f2bf(float f) { unsigned u = __builtin_bit_cast(unsigned, f); return (u + 0x7fffu + ((u >> 16) & 1u)) >> 16; }
__device__ __forceinline__ unsigned cvt_pk_bf16(float lo, float hi) { unsigned r; asm volatile("v_cvt_pk_bf16_f32 %0, %1, %2" : "=v"(r) : "v"(lo), "v"(hi)); return r; }
__device__ __forceinline__ float bf_lo(unsigned w) { return __builtin_bit_cast(float, w << 16); }
__device__ __forceinline__ float bf_hi(unsigned w) { return __builtin_bit_cast(float, w & 0xffff0000u); }
__device__ __forceinline__ f32x4 bf4_to_f32(u32x2 w) { return (f32x4){bf_lo(w.x), bf_hi(w.x), bf_lo(w.y), bf_hi(w.y)}; }
__device__ __forceinline__ u32x2 f32_to_bf4(f32x4 v) { u32x2 w; w.x = cvt_pk_bf16(v[0], v[1]); w.y = cvt_pk_bf16(v[2], v[3]); return w; }
__device__ __forceinline__ float wave_sum(float v) {
#pragma unroll
    for (int o = 1; o < 64; o <<= 1) v += __shfl_xor(v, o);
    return v;
}
__device__ __forceinline__ float fsigmoid(float x) { return __builtin_amdgcn_rcpf(1.0f + __expf(-x)); }

namespace pg8 {
constexpr int BM = 256, BK = 64, HALF = 128, HTB = HALF * BK * 2, STAGE_BYTES = 8 * HTB, NXCD = 8, WGM = 8;
__device__ __forceinline__ int lds_byte(int r, int c) { const int st = (r >> 4) * 2 + (c >> 5), rr = r & 15, cc = c & 31, ob = rr * 64 + cc * 2; return st * 1024 + (ob ^ (((ob >> 9) & 1) << 5)); }
__device__ __forceinline__ void stage_rc(int b, int& R, int& C) { const int st = b / 1024, sb = b % 1024, swz = sb ^ (((sb >> 9) & 1) << 5); R = (st >> 1) * 16 + swz / 64; C = (st & 1) * 32 + (swz % 64) / 2; }

struct Unit { int pm, pn, koff, po, kboff, rev, lin; };
struct Gemm { const bf16_t* A; const bf16_t* Bt; int lda, ldb, K; };

struct Sched {
    int nM, nN, nwg, G, c, mode, half;
    __device__ void init(int nM_, int nN_, int G_, int c_, int mode_ = 0, int half_ = 0) { nM = nM_; nN = nN_; nwg = nM * nN; G = G_; c = c_; mode = mode_; half = half_; }
    __device__ bool next(int i, Unit& u) const {
        if (mode == 3) {
            const int L = i * G + c; if (L >= 1440) return false;
            const int ti = L / 160, s = L % 160;
            const int chalf = s & 1, dir = (s >> 1) & 1, bb = s >> 2, blk = bb % 5, b = bb / 5;
            u.pm = (ti == 0) ? 64 + b : (dir ? b * 8 + (8 - ti) : b * 8 + (ti - 1));
            u.pn = (dir * 5 + blk) * 2 + chalf; u.koff = blk * 256; u.kboff = 0; u.po = ti; u.rev = dir; u.lin = L;
            return true;
        }
        const long L = (long)i * G + c; if (L >= nwg) return false;
        int wgid = (int)L; { const int q = nwg / NXCD, r = nwg % NXCD, xcd = wgid % NXCD, off = wgid / NXCD; wgid = (xcd < r ? xcd * (q + 1) : r * (q + 1) + (xcd - r) * q) + off; }
        const int nig = WGM * nN, gid = wgid / nig, fm = gid * WGM, gsz = (nM - fm) < WGM ? (nM - fm) : WGM;
        const int pmi = fm + ((wgid % nig) % gsz), pn = (wgid % nig) / gsz;
        u.pm = pmi; u.pn = pn; u.koff = 0; u.po = pmi; u.kboff = 0; u.rev = 0; u.lin = 0;
        if (mode == 2) { u.pm = 64 + pmi; u.pn = pn & 3; u.koff = (pn >> 2) * half; u.kboff = u.koff; }
        if (mode == 1) { u.pm = pmi < 32 ? 32 * half + pmi : 64 + 4 * half + (pmi - 32); u.koff = ((pn >> 1) % 5) * 256; }
        return true;
    }
};

template <class Epi, bool ALIGN_EPI, bool SP2>
__device__ __forceinline__ void gemm_phase(LAS unsigned char* lds, const Gemm g, const Sched& S, const Epi& E) {
    int tid = threadIdx.x; asm volatile("" : "+v"(tid));
    const int wid = __builtin_amdgcn_readfirstlane(tid >> 6), lane = tid & 63, wr = wid >> 2, wc = wid & 3, fr = lane & 15, fq = lane >> 4;
    const int K = g.K, nt = K / BK;
    unsigned voffAf[2], voffAr[2], voffB[2];
#pragma unroll
    for (int i = 0; i < 2; ++i) { int R, C; stage_rc(tid * 16 + i * 8192, R, C);
        voffAf[i] = (unsigned)(R * g.lda + C) * 2u; voffAr[i] = (unsigned)((127 - R) * g.lda + C) * 2u; voffB[i] = (unsigned)(R * g.ldb + C) * 2u; }
    const size_t kstep = (size_t)(BK * 2);
    const long hstepAf = (long)HALF * g.lda * 2; const size_t hstepB = (size_t)HALF * g.ldb * 2;
    const unsigned ldsw = (unsigned)wid * 1024u;
    const int aoff = lds_byte(wr * 64 + fr, fq * 8), boff = lds_byte(wc * 32 + fr, fq * 8);
#define PG8_SA(b, h) (((b) * 2 + (h)) * HTB)
#define PG8_SB(b, h) ((4 + (b) * 2 + (h)) * HTB)
#define PG8_STAGE(bufoff, gbase, voff) do { _Pragma("unroll") for (int _i = 0; _i < 2; ++_i) \
        __builtin_amdgcn_global_load_lds((const unsigned*)((const char*)(gbase) + (voff)[_i]), (LAS unsigned*)(lds + (bufoff) + ldsw + _i * 8192), 16, 0, 0); } while (0)
#define PG8_LDA(dst, b, h) do { _Pragma("unroll") for (int m = 0; m < 4; ++m) _Pragma("unroll") for (int k = 0; k < 2; ++k) dst[m][k] = *(const LAS bf16x8*)(lds + PG8_SA(b, h) + aoff + m * 2048 + k * 1024); } while (0)
#define PG8_LDB(dst, b, h) do { _Pragma("unroll") for (int n = 0; n < 2; ++n) _Pragma("unroll") for (int k = 0; k < 2; ++k) dst[n][k] = *(const LAS bf16x8*)(lds + PG8_SB(b, h) + boff + n * 2048 + k * 1024); } while (0)
#define PG8_MMA(ai, bj, At, Bt) do { __builtin_amdgcn_s_setprio(1); _Pragma("unroll") for (int m = 0; m < 4; ++m) _Pragma("unroll") for (int n = 0; n < 2; ++n) _Pragma("unroll") for (int k = 0; k < 2; ++k) \
        acc[ai][bj][m][n] = __builtin_amdgcn_mfma_f32_16x16x32_bf16(Bt[n][k], At[m][k], acc[ai][bj][m][n], 0, 0, 0); __builtin_amdgcn_s_setprio(0); } while (0)
#define PG8_WAIT_V(n) asm volatile("s_waitcnt vmcnt(" #n ")" ::: "memory")
#define PG8_WAIT_L(n) asm volatile("s_waitcnt lgkmcnt(" #n ")" ::: "memory")
#define PG8_BAR __builtin_amdgcn_s_barrier()
#define PG8_SCHED __builtin_amdgcn_sched_barrier(0)
    Unit cur, nxt; int ui = 0;
    if (!S.next(0, cur)) return;
    f32x4 acc[2][2][4][2];
#pragma unroll
    for (int a = 0; a < 2; ++a)
#pragma unroll
        for (int b = 0; b < 2; ++b)
#pragma unroll
            for (int m = 0; m < 4; ++m)
#pragma unroll
                for (int n = 0; n < 2; ++n) acc[a][b][m][n] = (f32x4){0.f, 0.f, 0.f, 0.f};
    bf16x8 At[4][2], B0[2][2], B1[2][2];
#define PG8_UNIT_A(u_) ((const char*)g.A + ((size_t)(u_).pm * BM * g.lda + (u_).koff) * 2 + (Epi::WITH_LDS && (u_).rev ? hstepAf : 0))
    const char* cA = PG8_UNIT_A(cur);
    unsigned voffA[2] = {voffAf[0], voffAf[1]}; long hstepA = hstepAf;
    if (Epi::WITH_LDS && cur.rev) { voffA[0] = voffAr[0]; voffA[1] = voffAr[1]; hstepA = -hstepAf; } const char* cB = (const char*)g.Bt + ((size_t)cur.pn * BM * g.ldb + cur.kboff) * 2;
    if constexpr (SP2) {
        PG8_STAGE(PG8_SB(0, 0), cB, voffB); PG8_STAGE(PG8_SB(0, 1), cB + hstepB, voffB); PG8_STAGE(PG8_SA(0, 0), cA, voffA); PG8_STAGE(PG8_SA(0, 1), cA + hstepA, voffA);
        if (wr == 1) PG8_BAR;
        PG8_WAIT_V(2); PG8_BAR;
        PG8_STAGE(PG8_SB(1, 0), cB + kstep, voffB); PG8_STAGE(PG8_SA(1, 0), cA + kstep, voffA); PG8_STAGE(PG8_SB(1, 1), cB + hstepB + kstep, voffB);
        PG8_WAIT_V(6); PG8_BAR;
    } else {
        PG8_STAGE(PG8_SB(0, 0), cB, voffB); PG8_STAGE(PG8_SA(0, 0), cA, voffA); PG8_STAGE(PG8_SB(0, 1), cB + hstepB, voffB); PG8_STAGE(PG8_SA(0, 1), cA + hstepA, voffA);
        if (wr == 1) PG8_BAR;
        PG8_WAIT_V(4); PG8_BAR;
        PG8_STAGE(PG8_SB(1, 0), cB + kstep, voffB); PG8_STAGE(PG8_SA(1, 0), cA + kstep, voffA); PG8_STAGE(PG8_SB(1, 1), cB + hstepB + kstep, voffB);
        PG8_WAIT_V(6); PG8_BAR;
    }
    for (;;) {
        const bool has_next = S.next(ui + 1, nxt);
        const char* nA = has_next ? PG8_UNIT_A(nxt) : cA;
        unsigned voffN[2] = {voffA[0], voffA[1]}; long hstepN = hstepA;
        if (Epi::WITH_LDS && has_next) { const bool nr = nxt.rev != 0; voffN[0] = nr ? voffAr[0] : voffAf[0]; voffN[1] = nr ? voffAr[1] : voffAf[1]; hstepN = nr ? -hstepAf : hstepAf; }
        const char* nB = has_next ? (const char*)g.Bt + ((size_t)nxt.pn * BM * g.ldb + nxt.kboff) * 2 : cB;
#pragma unroll 1
        for (int t = 0; t < nt; t += 2) {
            const bool last = (t == nt - 2);
            const char* a1 = cA + (size_t)(t + 1) * kstep;
            const char* a2 = last ? nA : cA + (size_t)(t + 2) * kstep; const char* b2 = last ? nB : cB + (size_t)(t + 2) * kstep;
            const char* a3 = a2 + kstep; const char* b3 = b2 + kstep;
            unsigned voff2[2] = {voffA[0], voffA[1]}; long hstep2 = hstepA;
            if (Epi::WITH_LDS && last) { voff2[0] = voffN[0]; voff2[1] = voffN[1]; hstep2 = hstepN; }
            if constexpr (SP2) {
            PG8_LDB(B0, 0, 0); PG8_LDB(B1, 0, 1); PG8_SCHED; PG8_LDA(At, 0, 0); PG8_STAGE(PG8_SA(1, 1), a1 + hstepA, voffA);
            PG8_WAIT_V(8); PG8_WAIT_L(0); PG8_BAR; PG8_MMA(0, 0, At, B0); PG8_MMA(0, 1, At, B1); PG8_BAR; PG8_SCHED;
            PG8_LDA(At, 0, 1); PG8_STAGE(PG8_SB(0, 0), b2, voffB); PG8_STAGE(PG8_SB(0, 1), b2 + hstepB, voffB); PG8_STAGE(PG8_SA(0, 0), a2, voff2);
            PG8_WAIT_V(8); PG8_WAIT_L(0); PG8_BAR; PG8_MMA(1, 0, At, B0); PG8_MMA(1, 1, At, B1); PG8_BAR; PG8_SCHED;
            PG8_LDB(B0, 1, 0); PG8_LDB(B1, 1, 1); PG8_SCHED; PG8_LDA(At, 1, 0); PG8_STAGE(PG8_SA(0, 1), a2 + hstep2, voff2);
            PG8_WAIT_V(8); PG8_WAIT_L(0); PG8_BAR; PG8_MMA(0, 0, At, B0); PG8_MMA(0, 1, At, B1); PG8_BAR; PG8_SCHED;
            PG8_LDA(At, 1, 1); PG8_STAGE(PG8_SB(1, 0), b3, voffB); PG8_STAGE(PG8_SB(1, 1), b3 + hstepB, voffB); PG8_STAGE(PG8_SA(1, 0), a3, voff2);
            PG8_WAIT_V(8); PG8_WAIT_L(0); PG8_BAR; PG8_MMA(1, 0, At, B0); PG8_MMA(1, 1, At, B1); PG8_BAR; PG8_SCHED;
            } else {
            PG8_LDB(B0, 0, 0); PG8_SCHED; PG8_LDA(At, 0, 0); PG8_STAGE(PG8_SA(1, 1), a1 + hstepA, voffA);
            PG8_WAIT_L(8); PG8_BAR; PG8_WAIT_L(0); PG8_MMA(0, 0, At, B0); PG8_BAR; PG8_SCHED;
            PG8_LDB(B1, 0, 1); PG8_STAGE(PG8_SB(0, 0), b2, voffB);
            PG8_BAR; PG8_WAIT_L(0); PG8_MMA(0, 1, At, B1); PG8_BAR;
            PG8_LDA(At, 0, 1); PG8_STAGE(PG8_SA(0, 0), a2, voff2);
            PG8_BAR; PG8_WAIT_L(0); PG8_MMA(1, 0, At, B0); PG8_BAR; PG8_SCHED;
            PG8_STAGE(PG8_SB(0, 1), b2 + hstepB, voffB);
            PG8_WAIT_V(6); PG8_BAR; PG8_MMA(1, 1, At, B1); PG8_BAR;
            PG8_LDB(B0, 1, 0); PG8_SCHED; PG8_LDA(At, 1, 0); PG8_STAGE(PG8_SA(0, 1), a2 + hstep2, voff2);
            PG8_WAIT_L(8); PG8_BAR; PG8_WAIT_L(0); PG8_MMA(0, 0, At, B0); PG8_BAR; PG8_SCHED;
            PG8_LDB(B1, 1, 1); PG8_STAGE(PG8_SB(1, 0), b3, voffB);
            PG8_BAR; PG8_WAIT_L(0); PG8_MMA(0, 1, At, B1); PG8_BAR;
            PG8_LDA(At, 1, 1); PG8_STAGE(PG8_SA(1, 0), a3, voff2);
            PG8_BAR; PG8_WAIT_L(0); PG8_MMA(1, 0, At, B0); PG8_BAR; PG8_SCHED;
            PG8_STAGE(PG8_SB(1, 1), b3 + hstepB, voffB);
            PG8_WAIT_V(6); PG8_BAR; PG8_MMA(1, 1, At, B1); PG8_BAR;
            }
        }
        if constexpr (ALIGN_EPI) { if (wr == 0) PG8_BAR; }
        if constexpr (Epi::WITH_LDS) E.run(acc, cur, wr, wc, lane, lds); else E(acc, cur, wr, wc, fr, fq);
        if (!has_next) break;
#pragma unroll
        for (int a = 0; a < 2; ++a)
#pragma unroll
            for (int b = 0; b < 2; ++b)
#pragma unroll
                for (int m = 0; m < 4; ++m)
#pragma unroll
                    for (int n = 0; n < 2; ++n) acc[a][b][m][n] = (f32x4){0.f, 0.f, 0.f, 0.f};
        cur = nxt; cA = nA; cB = nB; ++ui; voffA[0] = voffN[0]; voffA[1] = voffN[1]; hstepA = hstepN;
        if constexpr (ALIGN_EPI) { if (wr == 1) PG8_BAR; }
    }
    PG8_WAIT_V(0);
    if constexpr (!ALIGN_EPI) { if (wr == 0) PG8_BAR; }
    PG8_BAR;
#undef PG8_UNIT_A
#undef PG8_SA
#undef PG8_SB
#undef PG8_STAGE
#undef PG8_LDA
#undef PG8_LDB
#undef PG8_MMA
#undef PG8_WAIT_V
#undef PG8_WAIT_L
#undef PG8_BAR
#undef PG8_SCHED
}

template <int ACT> struct EpiPlain {
    static constexpr bool WITH_LDS = false;
    bf16_t* O; int ldc;
    __device__ __forceinline__ void operator()(const f32x4 (&acc)[2][2][4][2], const Unit& u, int wr, int wc, int fr_, int fq_) const {
        int fr = fr_, fq = fq_; asm volatile("" : "+v"(fr), "+v"(fq));
        const int col0 = u.pn * BM + wc * 32 + fq * 4;
#pragma unroll
        for (int ai = 0; ai < 2; ++ai)
#pragma unroll
            for (int m = 0; m < 4; ++m) { bf16_t* rowp = O + (size_t)(u.pm * BM + ai * HALF + wr * 64 + m * 16 + fr) * ldc + col0;
#pragma unroll
                for (int bj = 0; bj < 2; ++bj)
#pragma unroll
                    for (int n = 0; n < 2; ++n) { f32x4 v = acc[ai][bj][m][n];
                        if (ACT == 1) { v = __builtin_elementwise_max(v, (f32x4){0.f, 0.f, 0.f, 0.f}); v = v * v; }
                        *(u32x2*)(rowp + bj * HALF + n * 16) = f32_to_bf4(v); } }
    }
};

struct EpiSlabCtx {
    static constexpr bool WITH_LDS = false;
    bf16_t* S; int ksz;
    __device__ __forceinline__ void operator()(const f32x4 (&acc)[2][2][4][2], const Unit& u, int wr, int wc, int fr_, int fq_) const {
        int fr = fr_, fq = fq_; asm volatile("" : "+v"(fr), "+v"(fq));
        const int col0 = u.pn * BM + wc * 32 + fq * 4;
        bf16_t* base = S + (size_t)(u.koff / ksz) * MC * DM;
#pragma unroll
        for (int ai = 0; ai < 2; ++ai)
#pragma unroll
            for (int m = 0; m < 4; ++m) { bf16_t* rowp = base + (size_t)(u.pm * BM - ML + ai * HALF + wr * 64 + m * 16 + fr) * DM + col0;
#pragma unroll
                for (int bj = 0; bj < 2; ++bj)
#pragma unroll
                    for (int n = 0; n < 2; ++n) *(u32x2*)(rowp + bj * HALF + n * 16) = f32_to_bf4(acc[ai][bj][m][n]); }
    }
};

struct EpiQKV {
    static constexpr bool WITH_LDS = false;
    bf16_t* Q; bf16_t* Kb; bf16_t* VT; bf16_t* VTC; const float* rope;
    __device__ __forceinline__ void operator()(const f32x4 (&acc)[2][2][4][2], const Unit& u, int wr, int wc, int fr_, int fq_) const {
        int fr = fr_, fq = fq_; asm volatile("" : "+v"(fr), "+v"(fq));
        const bool lat = u.pm < 64;
        if (u.pn < 5) {
#pragma unroll
            for (int ai = 0; ai < 2; ++ai)
#pragma unroll
                for (int m = 0; m < 4; ++m) {
                    const int row = u.pm * BM + ai * HALF + wr * 64 + m * 16 + fr;
                    f32x4 cs0 = {1.f, 0.f, 1.f, 0.f}, cs1 = {1.f, 0.f, 1.f, 0.f};
                    if (lat) { const int t = row & 2047; const int pos = (wc & 1) ? (t & 63) : (t >> 6); const f32x4* pp = (const f32x4*)(rope + (pos * 16 + 4 * fq) * 2); cs0 = pp[0]; cs1 = pp[1]; }
                    const f32x4 cv = {cs0[0], cs0[2], cs1[0], cs1[2]}, sv = {cs0[1], cs0[3], cs1[1], cs1[3]};
#pragma unroll
                    for (int bj = 0; bj < 2; ++bj) {
                        const f32x4 a = acc[ai][bj][m][0], b = acc[ai][bj][m][1];
                        f32x4 na = a * cv - b * sv, nb = b * cv + a * sv;
                        if (u.pn < 4) { na = na * 0.125f; nb = nb * 0.125f;
                            bf16_t* d = Q + (size_t)row * 1024 + u.pn * 256 + bj * HALF + wc * 32 + fq * 4;
                            *(u32x2*)d = f32_to_bf4(na); *(u32x2*)(d + 16) = f32_to_bf4(nb);
                        } else {
                            bf16_t* d = Kb + (size_t)row * 256 + bj * HALF + wc * 32 + fq * 4;
                            *(u32x2*)d = f32_to_bf4(na); *(u32x2*)(d + 16) = f32_to_bf4(nb);
                        }
                    }
                }
        } else {
#pragma unroll
            for (int ai = 0; ai < 2; ++ai)
#pragma unroll
                for (int m = 0; m < 4; ++m) {
                    const int row = u.pm * BM + ai * HALF + wr * 64 + m * 16 + fr;
                    bf16_t* base; size_t stride;
                    if (lat) { const int b = row >> 11, t = row & 2047; base = VT + (size_t)b * 256 * 2048 + t; stride = 2048; }
                    else { const int rc = row - ML; const int b = rc >> 8, t = rc & 255; base = VTC + (size_t)b * 256 * 256 + t; stride = 256; }
#pragma unroll
                    for (int bj = 0; bj < 2; ++bj)
#pragma unroll
                        for (int n = 0; n < 2; ++n)
#pragma unroll
                            for (int j = 0; j < 4; ++j) { const int vc = bj * HALF + wc * 32 + n * 16 + fq * 4 + j; base[(size_t)vc * stride] = (bf16_t)f2bf(acc[ai][bj][m][n][j]); }
                }
        }
    }
};

struct EpiGates {
    static constexpr bool WITH_LDS = false;
    const bf16_t* U; bf16_t* LA; bf16_t* BX; const float* ba; const float* bi; const float* nls;
    __device__ __forceinline__ void operator()(const f32x4 (&acc)[2][2][4][2], const Unit& u, int wr, int wc, int fr_, int fq_) const {
        int fr = fr_, fq = fq_; asm volatile("" : "+v"(fr), "+v"(fq));
        const int tile = u.pn >> 1, dir = tile / 5, blk = tile % 5, chalf = u.pn & 1;
        const int ch0 = blk * 256 + chalf * 128 + wc * 32 + fq * 4;
#pragma unroll
        for (int n = 0; n < 2; ++n) {
            const int ch = ch0 + n * 16;
            const f32x4 bav = *(const f32x4*)(ba + dir * DRNN + ch), biv = *(const f32x4*)(bi + dir * DRNN + ch), nl = *(const f32x4*)(nls + dir * DRNN + ch);
#pragma unroll
            for (int ai = 0; ai < 2; ++ai)
#pragma unroll
                for (int m = 0; m < 4; ++m) {
                    const int rin = ai * HALF + wr * 64 + m * 16 + fr;
                    const size_t rowg = (size_t)u.pm * BM + rin, rowl = (size_t)u.po * BM + rin;
                    const f32x4 uv = bf4_to_f32(*(const u32x2*)(U + rowg * DRNN + ch));
                    f32x4 lav, bxv;
#pragma unroll
                    for (int j = 0; j < 4; ++j) {
                        const float r = fsigmoid(acc[ai][0][m][n][j] + bav[j]);
                        const float ig = fsigmoid(acc[ai][1][m][n][j] + biv[j]);
                        const float la = nl[j] * r, x = 2.0f * la;
                        float om;
                        if (x > -0.5f) { float q = 1.0f / 720.0f; q = q * x + 1.0f / 120.0f; q = q * x + 1.0f / 24.0f; q = q * x + 1.0f / 6.0f; q = q * x + 0.5f; q = q * x + 1.0f; om = -x * q; }
                        else om = 1.0f - __expf(x);
                        lav[j] = la; bxv[j] = __builtin_amdgcn_sqrtf(om) * (ig * uv[j]);
                    }
                    const size_t o = ((size_t)dir * 9216 + rowl) * DRNN + ch;
                    *(u32x2*)(LA + o) = f32_to_bf4(lav); *(u32x2*)(BX + o) = f32_to_bf4(bxv);
                    asm volatile("" ::: "memory");
                }
        }
    }
};

#define SC_STEP(d) \
    "v_fmac_f32_dpp %1, %1, %0 row_shr:" #d " row_mask:0xf bank_mask:0xf\n\t" "v_mul_f32_dpp %0, %0, %0 row_shr:" #d " row_mask:0xf bank_mask:0xf\n\t" \
    "v_fmac_f32_dpp %3, %3, %2 row_shr:" #d " row_mask:0xf bank_mask:0xf\n\t" "v_mul_f32_dpp %2, %2, %2 row_shr:" #d " row_mask:0xf bank_mask:0xf\n\t" \
    "v_fmac_f32_dpp %5, %5, %4 row_shr:" #d " row_mask:0xf bank_mask:0xf\n\t" "v_mul_f32_dpp %4, %4, %4 row_shr:" #d " row_mask:0xf bank_mask:0xf\n\t" \
    "v_fmac_f32_dpp %7, %7, %6 row_shr:" #d " row_mask:0xf bank_mask:0xf\n\t" "v_mul_f32_dpp %6, %6, %6 row_shr:" #d " row_mask:0xf bank_mask:0xf\n\t"
__device__ __forceinline__ void scan16x4(float& a0, float& b0, float& a1, float& b1, float& a2, float& b2, float& a3, float& b3) {
    asm volatile("s_nop 1\n\t" SC_STEP(1) SC_STEP(2) SC_STEP(4) SC_STEP(8)
                 : "+v"(a0), "+v"(b0), "+v"(a1), "+v"(b1), "+v"(a2), "+v"(b2), "+v"(a3), "+v"(b3));
}
struct EpiGatesScan {
    static constexpr bool WITH_LDS = true;
    const bf16_t* U; bf16_t* RECF; bf16_t* RECB; const float* ba; const float* bi; const float* nls; float* CARRY; unsigned* FLAG;
    __device__ __forceinline__ void run(f32x4 (&acc)[2][2][4][2], const Unit& u, int wr, int wc, int lane_, LAS unsigned char* lds) const {
        int lane = lane_; asm volatile("" : "+v"(lane));
        const int fr = lane & 15, fq = lane >> 4;
        LAS float* carry = (LAS float*)(lds + 131072);
        const int tile = u.pn >> 1, dir = tile / 5, blk = tile % 5, chalf = u.pn & 1;
        const int ch0 = blk * 256 + chalf * 128 + wc * 32 + fq * 4;
        const int rmask = dir ? 255 : 0;
        bf16_t* REC = dir ? RECB : RECF;
#pragma unroll
        for (int n = 0; n < 2; ++n) {
            const int ch = ch0 + n * 16;
            const f32x4 bav2 = *(const f32x4*)(ba + dir * DRNN + ch) * (-LOG2E), biv2 = *(const f32x4*)(bi + dir * DRNN + ch) * (-LOG2E), nl = *(const f32x4*)(nls + dir * DRNN + ch);
            const f32x4 nl2 = nl * LOG2E, nlx = nl * 2.0f;
#pragma unroll
            for (int ai = 0; ai < 2; ++ai)
#pragma unroll
                for (int m = 0; m < 4; ++m) {
                    const size_t rowg = (size_t)u.pm * BM + ((ai * HALF + wr * 64 + m * 16 + fr) ^ rmask);
                    const f32x4 uv = bf4_to_f32(*(const u32x2*)(U + rowg * DRNN + ch));
                    float av[4], bv[4];
#pragma unroll
                    for (int j = 0; j < 4; ++j) {
                        const float r = __builtin_amdgcn_rcpf(1.0f + __builtin_amdgcn_exp2f(acc[ai][0][m][n][j] * (-LOG2E) + bav2[j]));
                        const float ig = __builtin_amdgcn_rcpf(1.0f + __builtin_amdgcn_exp2f(acc[ai][1][m][n][j] * (-LOG2E) + biv2[j]));
                        const float x = nlx[j] * r, a = __builtin_amdgcn_exp2f(nl2[j] * r);
                        const float om = (x > -0.0625f) ? -x * (1.0f + x * (0.5f + x * (1.0f / 6.0f + x * (1.0f / 24.0f)))) : 1.0f - a * a;
                        av[j] = a; bv[j] = __builtin_amdgcn_sqrtf(om) * (ig * uv[j]);
                    }
                    scan16x4(av[0], bv[0], av[1], bv[1], av[2], bv[2], av[3], bv[3]);
#pragma unroll
                    for (int j = 0; j < 4; ++j) { acc[ai][0][m][n][j] = av[j]; acc[ai][1][m][n][j] = bv[j]; }
                    __builtin_amdgcn_sched_barrier(0);
                }
        }
        const int tid_ = threadIdx.x;
        if (u.po > 0 && tid_ < 64) {
            unsigned* fl = FLAG + (size_t)(u.lin - 160) * 16; unsigned sp = 0;
            while (__hip_atomic_load(fl, __ATOMIC_RELAXED, __HIP_MEMORY_SCOPE_AGENT) == 0u) { __builtin_amdgcn_s_sleep(2); if (++sp > (1u << 22)) break; }
        }
        asm volatile("s_waitcnt vmcnt(0) lgkmcnt(0)" ::: "memory"); __builtin_amdgcn_s_barrier(); asm volatile("" ::: "memory");
        if (tid_ < 128) carry[tid_] = (u.po > 0) ? __hip_atomic_load(CARRY + (size_t)(u.lin - 160) * 128 + tid_, __ATOMIC_RELAXED, __HIP_MEMORY_SCOPE_AGENT) : 0.0f;
        asm volatile("s_waitcnt vmcnt(0) lgkmcnt(0)" ::: "memory"); __builtin_amdgcn_s_barrier(); asm volatile("" ::: "memory");
        const bool emit = u.pm < 64;
        const int lastl = (lane & 48) | 15;
#pragma unroll
        for (int seg = 0; seg < 4; ++seg) {
            const int ai = seg >> 1, wrs = seg & 1;
            if (wr == wrs) {
                f32x4 hg[2];
#pragma unroll
                for (int n = 0; n < 2; ++n) hg[n] = *(const LAS f32x4*)(carry + wc * 32 + n * 16 + fq * 4);
#pragma unroll
                for (int m = 0; m < 4; ++m) {
                    f32x4 h[2];
#pragma unroll
                    for (int n = 0; n < 2; ++n) h[n] = acc[ai][0][m][n] * hg[n] + acc[ai][1][m][n];
                    if (emit) { bf16_t* rp = REC + ((size_t)u.pm * BM + ((ai * HALF + wr * 64 + m * 16 + fr) ^ rmask)) * DRNN + ch0;
#pragma unroll
                        for (int n = 0; n < 2; ++n) *(u32x2*)(rp + n * 16) = f32_to_bf4(h[n]); }
#pragma unroll
                    for (int n = 0; n < 2; ++n)
#pragma unroll
                        for (int j = 0; j < 4; ++j) hg[n][j] = __shfl(h[n][j], lastl);
                }
                if (fr == 0) {
#pragma unroll
                    for (int n = 0; n < 2; ++n) *(LAS f32x4*)(carry + wc * 32 + n * 16 + fq * 4) = hg[n];
                }
            }
            asm volatile("s_waitcnt lgkmcnt(0)" ::: "memory"); __builtin_amdgcn_s_barrier(); asm volatile("" ::: "memory");
        }
        if (u.po < 8) {
            if (tid_ < 128) __hip_atomic_store(CARRY + (size_t)u.lin * 128 + tid_, carry[tid_], __ATOMIC_RELAXED, __HIP_MEMORY_SCOPE_AGENT);
            asm volatile("s_waitcnt vmcnt(0) lgkmcnt(0)" ::: "memory"); __builtin_amdgcn_s_barrier(); asm volatile("" ::: "memory");
            if (tid_ == 0) __hip_atomic_store(FLAG + (size_t)u.lin * 16, 1u, __ATOMIC_RELAXED, __HIP_MEMORY_SCOPE_AGENT);
        }
    }
};

struct EpiGateMul {
    static constexpr bool WITH_LDS = false;
    bf16_t* Z; const bf16_t* RB;
    __device__ __forceinline__ void operator()(const f32x4 (&acc)[2][2][4][2], const Unit& u, int wr, int wc, int fr_, int fq_) const {
        int fr = fr_, fq = fq_; asm volatile("" : "+v"(fr), "+v"(fq));
        const int col0 = u.pn * BM + wc * 32 + fq * 4;
#pragma unroll
        for (int ai = 0; ai < 2; ++ai)
#pragma unroll
            for (int m = 0; m < 4; ++m) { bf16_t* rowp = Z + (size_t)(u.pm * BM + ai * HALF + wr * 64 + m * 16 + fr) * DRNN + col0;
#pragma unroll
                for (int bj = 0; bj < 2; ++bj)
#pragma unroll
                    for (int n = 0; n < 2; ++n) { const f32x4 v = acc[ai][bj][m][n]; const f32x4 rc = bf4_to_f32(*(const u32x2*)(rowp + bj * HALF + n * 16)) + bf4_to_f32(*(const u32x2*)(RB + (rowp - Z) + bj * HALF + n * 16)); f32x4 o;
#pragma unroll
                        for (int j = 0; j < 4; ++j) { const float x = v[j]; const float z2 = 1.5957691216057308f * (x + 0.044715f * x * x * x); o[j] = x * fsigmoid(z2) * rc[j]; }
                        *(u32x2*)(rowp + bj * HALF + n * 16) = f32_to_bf4(o); }
                asm volatile("" ::: "memory"); }
    }
};
}


#define XB_TMO      128
#define XB_XCNT(j)  (256  + 64 * (j))
#define XB_XSUB(j)  (1280 + 64 * (j))
#define XB_XGEN(j)  (2304 + 64 * (j))
#define XB_TOP      3328
#define XB_TOPGEN   3392
#define XCD_BAR_WORDS 3456
#define XB_SPIN_CAP (1u << 18)
__device__ __forceinline__ unsigned xb_ld(unsigned* p)              { return __hip_atomic_load(p, __ATOMIC_RELAXED, __HIP_MEMORY_SCOPE_AGENT); }
__device__ __forceinline__ unsigned xb_add(unsigned* p, unsigned v) { return __hip_atomic_fetch_add(p, v, __ATOMIC_RELAXED, __HIP_MEMORY_SCOPE_AGENT); }
__device__ __forceinline__ unsigned xb_xcc_id() { return (unsigned)__builtin_amdgcn_s_getreg((3 << 11) | 20) & 0xFu; }
#define XB_SPIN(cond, bar) do { unsigned _sp = 0; while (cond) { __builtin_amdgcn_s_sleep(1); \
    if ((++_sp & 255u) == 0u) { if (xb_ld(&(bar)[XB_TMO])) break; if (_sp > XB_SPIN_CAP) { atomicAdd(&(bar)[XB_TMO], 1u); break; } } } } while (0)
struct XcdBarrier { unsigned* bar; unsigned x; volatile LAS unsigned* st; };
__device__ __forceinline__ XcdBarrier xcd_barrier_post(unsigned* bar, volatile LAS unsigned* st) {
    XcdBarrier b; b.bar = bar; b.x = xb_xcc_id(); b.st = st;
    if (threadIdx.x == 0) (void)xb_add(&bar[XB_XCNT(b.x)], 1u);
    return b;
}
__device__ __forceinline__ void xcd_barrier_complete(unsigned* bar, unsigned x, unsigned& nloc, unsigned& nx) {
    const unsigned G = gridDim.x * gridDim.y * gridDim.z;
    unsigned sum, cnt, mine, sp = 0u;
    for (;;) {
        sum = 0u; cnt = 0u; mine = 0u;
#pragma unroll
        for (unsigned j = 0; j < 16; ++j) { const unsigned c = xb_ld(&bar[XB_XCNT(j)]); sum += c; cnt += (c > 0u) ? 1u : 0u; mine = (j == x) ? c : mine; }
        if (sum == G) break;
        __builtin_amdgcn_s_sleep(1);
        if ((++sp & 255u) == 0u) { if (xb_ld(&bar[XB_TMO])) break; if (sp > XB_SPIN_CAP) { atomicAdd(&bar[XB_TMO], 1u); break; } }
    }
    nloc = mine > 0u ? mine : 1u; nx = cnt > 0u ? cnt : 1u;
}
__device__ __forceinline__ void xcd_barrier(const XcdBarrier& b) {
    asm volatile("s_waitcnt vmcnt(0)" ::: "memory");
    __syncthreads();
    if (threadIdx.x == 0) {
        unsigned* bar = b.bar;
        __builtin_amdgcn_s_waitcnt(0);
        unsigned nloc = b.st[0], nx = b.st[1];
        if (nloc == 0u) { xcd_barrier_complete(bar, b.x, nloc, nx); b.st[0] = nloc; b.st[1] = nx; }
        const unsigned old = xb_add(&bar[XB_XSUB(b.x)], 1u);
        const unsigned gen = old / nloc;
        if (old + 1u == (gen + 1u) * nloc) {
            __builtin_amdgcn_fence(__ATOMIC_RELEASE, "agent");
            asm volatile("s_waitcnt vmcnt(0)" ::: "memory");
            const unsigned og = xb_add(&bar[XB_TOP], 1u);
            const unsigned tg = og / nx;
            if (og + 1u == (tg + 1u) * nx) xb_add(&bar[XB_TOPGEN], 1u);
            else XB_SPIN(xb_ld(&bar[XB_TOPGEN]) == tg, bar);
            __builtin_amdgcn_fence(__ATOMIC_ACQUIRE, "agent");
            xb_add(&bar[XB_XGEN(b.x)], 1u);
            asm volatile("s_waitcnt vmcnt(0)" ::: "memory");
        } else {
            XB_SPIN(xb_ld(&bar[XB_XGEN(b.x)]) == gen, bar);
            __builtin_amdgcn_fence(__ATOMIC_ACQUIRE, "agent");
            asm volatile("s_waitcnt vmcnt(0)" ::: "memory");
        }
    }
    __syncthreads();
}

struct Params {
    const float *x, *c, *ctx, *c_ctx, *ada_w, *ada_b, *norm_g, *mlp_w1, *mlp_w2, *w_qkv, *w_o, *sink;
    const float *w_in, *conv_w, *conv_b, *w_a, *b_a, *w_i, *b_i, *lam, *w_out;
    float* out; unsigned char* ws;
};

typedef const __attribute__((address_space(4))) Params* ParamsK;
__device__ __forceinline__ void transpose_item(const float* W, int ldw, bf16_t* WT, int ldwt, int k0, int n0, int dst_row0, LAS float* scr, int lane) {
#pragma unroll 8
    for (int i = 0; i < 32; ++i) { const int kk = 2 * i + (lane >> 5); scr[kk * 33 + (lane & 31)] = W[(size_t)(k0 + kk) * ldw + n0 + (lane & 31)]; }
    asm volatile("s_waitcnt lgkmcnt(0)" ::: "memory");
    const int c = lane & 7;
#pragma unroll
    for (int j = 0; j < 4; ++j) { const int n = (lane >> 3) + 8 * j; const LAS float* s = scr + (8 * c) * 33 + n;
        u32x4 o; o.x = cvt_pk_bf16(s[0 * 33], s[1 * 33]); o.y = cvt_pk_bf16(s[2 * 33], s[3 * 33]); o.z = cvt_pk_bf16(s[4 * 33], s[5 * 33]); o.w = cvt_pk_bf16(s[6 * 33], s[7 * 33]);
        *(u32x4*)(WT + (size_t)(dst_row0 + n) * ldwt + k0 + 8 * c) = o; }
    asm volatile("s_waitcnt lgkmcnt(0)" ::: "memory");
}
__device__ __forceinline__ void transpose_plain(const float* W, int K, int N, bf16_t* WT, int r, LAS float* scr, int lane) {
    const int nblk = N / 32, kb = r / nblk, nb = r % nblk;
    transpose_item(W, N, WT, K, 64 * kb, 32 * nb, 32 * nb, scr, lane);
}

__device__ __forceinline__ void prologue(ParamsK p, LAS unsigned char* lds, int tid, int lane, int wave) {
    unsigned char* ws = p->ws;
    float* MOD = (float*)(ws + WS_MOD);
    if (blockIdx.x < 96) {
        LAS float* sl = (LAS float*)lds;
        LAS float* red = (LAS float*)(lds + 36864);
        for (int idx = tid; idx < 9216; idx += 512) { const int w = idx >> 10, k = idx & 1023; const float v = (w < 8) ? p->c[w * 1024 + k] : p->c_ctx[k]; sl[idx] = v / (1.0f + __expf(-v)); }
        __syncthreads();
        const int l = blockIdx.x / 48, n0 = (blockIdx.x % 48) * 128, kg = tid >> 5, cq = tid & 31;
        f32x4 acc[9];
#pragma unroll
        for (int w = 0; w < 9; ++w) acc[w] = (f32x4){0.f, 0.f, 0.f, 0.f};
        const float* wb = p->ada_w + (size_t)l * 1024 * 6144 + n0 + cq * 4;
#pragma unroll 4
        for (int it = 0; it < 64; ++it) { const int k = it * 16 + kg; const f32x4 w4 = *(const f32x4*)(wb + (size_t)k * 6144);
#pragma unroll
            for (int w = 0; w < 9; ++w) acc[w] += sl[w * 1024 + k] * w4; }
#pragma unroll
        for (int w = 0; w < 9; ++w) *(LAS f32x4*)(red + (kg * 9 + w) * 128 + cq * 4) = acc[w];
        __syncthreads();
        for (int idx = tid; idx < 9 * 128; idx += 512) { const int w = idx >> 7, n = idx & 127; float s = 0.f;
#pragma unroll
            for (int g = 0; g < 16; ++g) s += red[(g * 9 + w) * 128 + n];
            MOD[(size_t)(l * 9 + w) * 6144 + n0 + n] = s + p->ada_b[l * 6144 + n0 + n]; }
        __syncthreads();
    }
    if (blockIdx.x == gridDim.x - 1) {
        float* rope = (float*)(ws + WS_ROPE); float* nls = (float*)(ws + WS_NLS);
        for (int idx = tid; idx < 1024; idx += 512) { const int pos = idx >> 4, i = idx & 15;
            const float inv = __builtin_exp2f(-(float)i * (13.287712379549449f / 16.0f));
            const float angf = (float)pos * inv; const double ang = (double)angf;
            const double twopi = 6.283185307179586476925287; const double r = ang - twopi * __builtin_rint(ang / twopi);
            const double r2 = r * r; double cterm = 1.0, sterm = r, cs = 1.0, sn = r;
            for (int k = 1; k <= 14; ++k) { cterm *= -r2 / (double)((2 * k - 1) * (2 * k)); sterm *= -r2 / (double)((2 * k) * (2 * k + 1)); cs += cterm; sn += sterm; }
            rope[idx * 2] = (float)cs; rope[idx * 2 + 1] = (float)sn; }
        for (int idx = tid; idx < 2 * DRNN; idx += 512) { const float lm = p->lam[idx]; nls[idx] = -8.0f * log1pf(__expf(-lm)); }
        { unsigned* fl = (unsigned*)(ws + WS_FLAG); for (int idx = tid; idx < 1440 * 16; idx += 512) fl[idx] = 0u; }
    }
    LAS float* scr = (LAS float*)(lds + wave * 16384);
    const int gw = blockIdx.x * 8 + wave, NGW = gridDim.x * 8;
    constexpr int I_QKV = 16 * 48, I_O = 16 * 32, I_1 = 16 * 128, I_2 = 64 * 32, I_IN = 16 * 80, I_OUT = 20 * 32, I_G = 40 * 16;
    constexpr int NITEMS = I_QKV + I_O + 2 * I_1 + 2 * I_2 + I_IN + I_OUT + I_G;
    for (int it = gw; it < NITEMS; it += NGW) {
        int r = it;
        if (r < I_QKV) { transpose_plain(p->w_qkv, 1024, NQKV, (bf16_t*)(ws + WS_WQKV), r, scr, lane); continue; } r -= I_QKV;
        if (r < I_O) { transpose_plain(p->w_o, 1024, 1024, (bf16_t*)(ws + WS_WO), r, scr, lane); continue; } r -= I_O;
        if (r < 2 * I_1) { const int l = r / I_1; transpose_plain(p->mlp_w1 + (size_t)l * 1024 * DFF, 1024, DFF, (bf16_t*)(ws + WS_W1 + (size_t)l * 16 * MiB), r % I_1, scr, lane); continue; } r -= 2 * I_1;
        if (r < 2 * I_2) { const int l = r / I_2; transpose_plain(p->mlp_w2 + (size_t)l * 1024 * DFF, DFF, 1024, (bf16_t*)(ws + WS_W2 + (size_t)l * 16 * MiB), r % I_2, scr, lane); continue; } r -= 2 * I_2;
        if (r < I_IN) { transpose_plain(p->w_in, 1024, 2 * DRNN, (bf16_t*)(ws + WS_WIN), r, scr, lane); continue; } r -= I_IN;
        if (r < I_OUT) { transpose_plain(p->w_out, DRNN, 1024, (bf16_t*)(ws + WS_WOUT), r, scr, lane); continue; } r -= I_OUT;
        {
            const int sm = r >> 4, ii = r & 15, kb = ii >> 2, nb = ii & 3;
            const int chalf = sm & 1, blk = (sm >> 1) % 5, dg = (sm >> 1) / 5, gate = dg & 1, dir = dg >> 1;
            const float* W = (gate ? p->w_i : p->w_a) + (size_t)(dir * 5 + blk) * 256 * 256;
            const int dst_row0 = ((dir * 5 + blk) * 2 + chalf) * 256 + gate * 128 + nb * 32;
            transpose_item(W, 256, (bf16_t*)(ws + WS_WG), 256, 64 * kb, chalf * 128 + nb * 32, dst_row0, scr, lane);
        }
    }
}

template <bool HAS_Y, bool HAS_H>
__device__ __forceinline__ void row_phase(const float* xin_lat, const float* xin_ctx, float* xout_lat, float* xout_ctx, const bf16_t* Y, const bf16_t* SLAB, bf16_t* H,
                                          const float* gy, const float* gh, const float* mod_g, int gate_idx, const float* mod_h, int shift_idx, int scale_idx,
                                          int nrows, int gw, int ngw, int lane) {
    const int rpw = (nrows + ngw - 1) / ngw, r_begin = gw * rpw, r_end = (r_begin + rpw < nrows) ? r_begin + rpw : nrows;
    f32x4 xn[4]; u32x2 yn[4], ys[3][4];
    f32x4 vgy[4], vgh[4], vgt[4], vsh[4], vsc[4];
#pragma unroll
    for (int j = 0; j < 4; ++j) { if (HAS_Y) vgy[j] = *(const f32x4*)(gy + lane * 4 + 256 * j); if (HAS_H) vgh[j] = *(const f32x4*)(gh + lane * 4 + 256 * j); }
    int cur_who = -1;
#define ROW_LOAD(r) do { const int r_ = (r); const bool lat_ = r_ < ML; \
        const float* xi_ = lat_ ? xin_lat + (size_t)r_ * DM : xin_ctx + (size_t)(r_ - ML) * DM; \
        _Pragma("unroll") for (int j = 0; j < 4; ++j) xn[j] = *(const f32x4*)(xi_ + lane * 4 + 256 * j); \
        if (HAS_Y) { if (SLAB != nullptr && !lat_) { const bf16_t* yp_ = SLAB + (size_t)(r_ - ML) * DM + lane * 4; \
                _Pragma("unroll") for (int j = 0; j < 4; ++j) { yn[j] = *(const u32x2*)(yp_ + 256 * j); ys[0][j] = *(const u32x2*)(yp_ + 256 * j + (size_t)MC * DM); ys[1][j] = *(const u32x2*)(yp_ + 256 * j + (size_t)2 * MC * DM); ys[2][j] = *(const u32x2*)(yp_ + 256 * j + (size_t)3 * MC * DM); } } \
            else { _Pragma("unroll") for (int j = 0; j < 4; ++j) yn[j] = *(const u32x2*)(Y + (size_t)r_ * DM + lane * 4 + 256 * j); } } } while (0)
    if (r_begin < r_end) ROW_LOAD(r_begin);
    for (int row = r_begin; row < r_end; ++row) {
        const bool lat = row < ML; const int who = lat ? (row >> 11) : 8;
        if (who != cur_who) { cur_who = who;
#pragma unroll
            for (int j = 0; j < 4; ++j) { const int col = lane * 4 + 256 * j;
                if (HAS_Y) vgt[j] = *(const f32x4*)(mod_g + (size_t)who * 6144 + gate_idx * 1024 + col);
                if (HAS_H) { vsh[j] = *(const f32x4*)(mod_h + (size_t)who * 6144 + shift_idx * 1024 + col); vsc[j] = *(const f32x4*)(mod_h + (size_t)who * 6144 + scale_idx * 1024 + col) + 1.0f; } } }
        f32x4 xv[4], yv[4];
#pragma unroll
        for (int j = 0; j < 4; ++j) xv[j] = xn[j];
        if (HAS_Y) {
#pragma unroll
            for (int j = 0; j < 4; ++j) { yv[j] = bf4_to_f32(yn[j]);
                if (SLAB != nullptr && !lat) yv[j] = (yv[j] + bf4_to_f32(ys[0][j])) + (bf4_to_f32(ys[1][j]) + bf4_to_f32(ys[2][j])); }
        }
        asm volatile("" ::: "memory");
        if (row + 1 < r_end) ROW_LOAD(row + 1);
        if (HAS_Y) {
            float s = 0.f;
#pragma unroll
            for (int j = 0; j < 4; ++j) s += (yv[j][0] * yv[j][0] + yv[j][1] * yv[j][1]) + (yv[j][2] * yv[j][2] + yv[j][3] * yv[j][3]);
            const float rstd = 1.0f / sqrtf(wave_sum(s) * (1.0f / DM) + EPS);
            float* xo = lat ? xout_lat + (size_t)row * DM : xout_ctx + (size_t)(row - ML) * DM;
#pragma unroll
            for (int j = 0; j < 4; ++j) { xv[j] = xv[j] + vgt[j] * (yv[j] * rstd * vgy[j]); *(f32x4*)(xo + lane * 4 + 256 * j) = xv[j]; }
        }
        if (HAS_H) {
            float s = 0.f;
#pragma unroll
            for (int j = 0; j < 4; ++j) s += (xv[j][0] * xv[j][0] + xv[j][1] * xv[j][1]) + (xv[j][2] * xv[j][2] + xv[j][3] * xv[j][3]);
            const float rstd = 1.0f / sqrtf(wave_sum(s) * (1.0f / DM) + EPS);
#pragma unroll
            for (int j = 0; j < 4; ++j) { const f32x4 hv = (xv[j] * rstd * vgh[j]) * vsc[j] + vsh[j]; *(u32x2*)(H + (size_t)row * DM + lane * 4 + 256 * j) = f32_to_bf4(hv); }
        }
    }
#undef ROW_LOAD
}

__device__ __forceinline__ void attn_phase(LAS unsigned char* lds, const bf16_t* Q, bf16_t* O, const bf16_t* Kb, const bf16_t* VT, const bf16_t* VTC, const float* sink, int tid, int lane, int wave) {
    constexpr int PITCH = 72;
    LAS bf16_t* Ks = (LAS bf16_t*)lds;
    LAS bf16_t* Vs = (LAS bf16_t*)(lds + 2 * 64 * PITCH * 2);
    const int lr = lane & 15, lg = lane >> 4;
    const int skey = tid >> 3, spiece = tid & 7;
    for (int unit = blockIdx.x; unit < 576; unit += gridDim.x) {
        int b, kvh, qrow0, qblk, nloc, lt0; bool latu = unit < 512;
        if (latu) { b = unit >> 6; const int rem = unit & 63; qblk = rem >> 2; kvh = rem & 3; qrow0 = b * SEQ + qblk * 128; lt0 = (qblk == 0) ? 2 : 0; nloc = ((qblk == 15) ? 4 : 6) - lt0; }
        else { const int cu = unit - 512; b = cu >> 3; kvh = (cu & 7) >> 1; qblk = 0; qrow0 = ML + b * CTX + (cu & 1) * 128; lt0 = 0; nloc = 0; }
        const int nlo = (latu && qblk > 0) ? 2 : 0, nmid = latu ? 2 : 0, nup = (latu && qblk < 15) ? 2 : 0;
        const int n1 = nlo, n2 = nlo + nmid, n3 = n2 + 4, nT = n3 + nup; (void)nloc; (void)lt0;
        const int head = kvh * 4 + (wave >> 1);
        const int qr0 = qrow0 + (wave & 1) * 64;
        const bf16_t* qbase = Q + (size_t)qr0 * 1024 + head * 64;
        bf16_t* obase = O + (size_t)qr0 * 1024 + head * 64;
        LAS unsigned char* Qs = lds + 40960 + wave * 8192;
#pragma unroll
        for (int qt = 0; qt < 4; ++qt)
#pragma unroll
            for (int dh = 0; dh < 2; ++dh) *(LAS bf16x8*)(Qs + (qt * 2 + dh) * 1024 + lane * 16) = *(const bf16x8*)(qbase + (unsigned)((qt * 16 + lr) * 1024 + dh * 32 + lg * 8));
        f32x4 o[4][4];
#pragma unroll
        for (int qt = 0; qt < 4; ++qt)
#pragma unroll
            for (int dt = 0; dt < 4; ++dt) o[qt][dt] = (f32x4){0.f, 0.f, 0.f, 0.f};
        float m2[4], ls[4];
        { const float sk = sink[head] * LOG2E;
#pragma unroll
          for (int qt = 0; qt < 4; ++qt) { m2[qt] = sk; ls[qt] = (lg == 0) ? 1.0f : 0.0f; } }
        u32x4 kreg, vreg;
#define ATT_TOK0(j_) ((qblk - 1) * 128 + (((j_) < n1) ? (j_) : (((j_) < n2) ? 2 + (j_) - n1 : 4 + (j_) - n3)) * 64)
#define ATT_LOAD(j) do { const int _j = (j); if (_j < n2 || _j >= n3) { const int tok0 = ATT_TOK0(_j); \
                const bf16_t* kb_ = Kb + (size_t)(b * SEQ + tok0) * 256 + kvh * 64; const bf16_t* vb_ = VT + (size_t)(b * 4 + kvh) * 64 * SEQ + tok0; \
                kreg = *(const u32x4*)(kb_ + (unsigned)(skey * 256 + spiece * 8)); vreg = *(const u32x4*)(vb_ + (unsigned)(skey * SEQ + spiece * 8)); } \
            else { const int tok0 = (_j - n2) * 64; \
                const bf16_t* kb_ = Kb + (size_t)(ML + b * CTX + tok0) * 256 + kvh * 64; const bf16_t* vb_ = VTC + (size_t)(b * 4 + kvh) * 64 * CTX + tok0; \
                kreg = *(const u32x4*)(kb_ + (unsigned)(skey * 256 + spiece * 8)); vreg = *(const u32x4*)(vb_ + (unsigned)(skey * CTX + spiece * 8)); } } while (0)
#define ATT_STORE(buf) do { *(LAS u32x4*)(Ks + (buf) * 64 * PITCH + skey * PITCH + spiece * 8) = kreg; *(LAS u32x4*)(Vs + (buf) * 64 * PITCH + skey * PITCH + spiece * 8) = vreg; } while (0)
        __syncthreads();
        ATT_LOAD(0); ATT_STORE(0);
        __syncthreads();
#define ATT_BODY(MM) { \
            const int buf = j & 1; \
            if (j + 1 < nT) ATT_LOAD(j + 1); \
            const LAS bf16_t* Kt = Ks + buf * 64 * PITCH; const LAS bf16_t* Vt = Vs + buf * 64 * PITCH; \
            const int ktok0 = ATT_TOK0(j); \
            bf16x8 kf[4][2]; \
            _Pragma("unroll") \
            for (int ks = 0; ks < 4; ++ks) \
            _Pragma("unroll") \
                for (int dh = 0; dh < 2; ++dh) kf[ks][dh] = *(const LAS bf16x8*)(Kt + (ks * 16 + lr) * PITCH + dh * 32 + lg * 8); \
            _Pragma("unroll") \
            for (int hq = 0; hq < 2; ++hq) { \
            bf16x8 pb[2][2]; \
            _Pragma("unroll") \
            for (int q2 = 0; q2 < 2; ++q2) { \
                const int qt = hq * 2 + q2; \
                f32x4 s[4]; \
                const bf16x8 qf0 = *(const LAS bf16x8*)(Qs + (qt * 2 + 0) * 1024 + lane * 16), qf1 = *(const LAS bf16x8*)(Qs + (qt * 2 + 1) * 1024 + lane * 16); \
            _Pragma("unroll") \
                for (int ks = 0; ks < 4; ++ks) { s[ks] = __builtin_amdgcn_mfma_f32_16x16x32_bf16(kf[ks][0], qf0, (f32x4){0.f, 0.f, 0.f, 0.f}, 0, 0, 0); \
                    s[ks] = __builtin_amdgcn_mfma_f32_16x16x32_bf16(kf[ks][1], qf1, s[ks], 0, 0, 0); } \
                if (MM == 1) {    \
                    const int lim = qblk * 128 + (wave & 1) * 64 + qt * 16 + lr - 128 - ktok0 - lg * 4; \
            _Pragma("unroll") \
                    for (int ks = 0; ks < 4; ++ks) \
            _Pragma("unroll") \
                        for (int jj = 0; jj < 4; ++jj) s[ks][jj] = (ks * 16 + jj >= lim) ? s[ks][jj] : -1e30f; \
                } else if (MM == 2) {    \
                    const int lim = qblk * 128 + (wave & 1) * 64 + qt * 16 + lr + 128 - ktok0 - lg * 4; \
            _Pragma("unroll") \
                    for (int ks = 0; ks < 4; ++ks) \
            _Pragma("unroll") \
                        for (int jj = 0; jj < 4; ++jj) s[ks][jj] = (ks * 16 + jj <= lim) ? s[ks][jj] : -1e30f; \
                } \
                float mx = -3e38f; \
            _Pragma("unroll") \
                for (int ks = 0; ks < 4; ++ks) mx = fmaxf(mx, fmaxf(fmaxf(s[ks][0], s[ks][1]), fmaxf(s[ks][2], s[ks][3]))); \
                mx = fmaxf(mx, __shfl_xor(mx, 16)); mx = fmaxf(mx, __shfl_xor(mx, 32)); \
                const float mnew = fmaxf(m2[qt], mx * LOG2E); \
                const float alpha = __builtin_amdgcn_exp2f(m2[qt] - mnew); \
                m2[qt] = mnew; \
                float rs = 0.f; \
            _Pragma("unroll") \
                for (int ks = 0; ks < 4; ++ks) \
            _Pragma("unroll") \
                    for (int jj = 0; jj < 4; ++jj) { const float pv = __builtin_amdgcn_exp2f(s[ks][jj] * LOG2E - mnew); s[ks][jj] = pv; rs += pv; } \
                ls[qt] = ls[qt] * alpha + rs; \
            _Pragma("unroll") \
                for (int dt = 0; dt < 4; ++dt) o[qt][dt] = o[qt][dt] * alpha; \
            _Pragma("unroll") \
                for (int c2 = 0; c2 < 2; ++c2) { u32x4 w; w.x = cvt_pk_bf16(s[2 * c2][0], s[2 * c2][1]); w.y = cvt_pk_bf16(s[2 * c2][2], s[2 * c2][3]); w.z = cvt_pk_bf16(s[2 * c2 + 1][0], s[2 * c2 + 1][1]); w.w = cvt_pk_bf16(s[2 * c2 + 1][2], s[2 * c2 + 1][3]); \
                    pb[q2][c2] = __builtin_bit_cast(bf16x8, w); } \
            } \
            _Pragma("unroll") \
            for (int c2 = 0; c2 < 2; ++c2) \
            _Pragma("unroll") \
                for (int dt = 0; dt < 4; ++dt) { \
                    const LAS bf16_t* vp = Vt + (dt * 16 + lr) * PITCH + c2 * 32 + lg * 4; \
                    const u32x2 v0 = *(const LAS u32x2*)vp, v1 = *(const LAS u32x2*)(vp + 16); \
                    const u32x4 vv = {v0.x, v0.y, v1.x, v1.y}; \
                    const bf16x8 vf = __builtin_bit_cast(bf16x8, vv); \
            _Pragma("unroll") \
                    for (int q2 = 0; q2 < 2; ++q2) o[hq * 2 + q2][dt] = __builtin_amdgcn_mfma_f32_16x16x32_bf16(vf, pb[q2][c2], o[hq * 2 + q2][dt], 0, 0, 0); \
                } \
            } \
            if (j + 1 < nT) ATT_STORE(buf ^ 1); \
            __syncthreads(); \
        }
        int j = 0;
#pragma unroll 1
        for (; j < n1; ++j) ATT_BODY(1)
#pragma unroll 1
        for (; j < n3; ++j) ATT_BODY(0)
#pragma unroll 1
        for (; j < nT; ++j) ATT_BODY(2)
#undef ATT_BODY
#pragma unroll
        for (int qt = 0; qt < 4; ++qt) {
            float l = ls[qt]; l += __shfl_xor(l, 16); l += __shfl_xor(l, 32);
            const float inv = 1.0f / l;
            int lro = lr * 1024 + lg * 4; asm volatile("" : "+v"(lro));
            bf16_t* op = obase + (unsigned)(qt * 16 * 1024 + lro);
#pragma unroll
            for (int dt = 0; dt < 4; ++dt) *(u32x2*)(op + dt * 16) = f32_to_bf4(o[qt][dt] * inv);
        }
    }
#undef ATT_LOAD
#undef ATT_TOK0
#undef ATT_STORE
}

__device__ __forceinline__ void conv_phase(const bf16_t* R, bf16_t* U, const float* cw, const float* cb, int gtid, int nthreads) {
    for (int idx = gtid; idx < MT * 160; idx += nthreads) {
        const int row = idx / 160, ch = (idx % 160) * 8;
        int t, T; if (row < ML) { t = row & 2047; T = SEQ; } else { t = (row - ML) & 255; T = CTX; }
        float acc[8];
        { const f32x4 b0 = *(const f32x4*)(cb + ch), b1 = *(const f32x4*)(cb + ch + 4); acc[0] = b0[0]; acc[1] = b0[1]; acc[2] = b0[2]; acc[3] = b0[3]; acc[4] = b1[0]; acc[5] = b1[1]; acc[6] = b1[2]; acc[7] = b1[3]; }
#pragma unroll
        for (int tap = 0; tap < 4; ++tap) { const int tt = t + tap - 2;
            if (tt >= 0 && tt < T) { const u32x4 rv = *(const u32x4*)(R + (size_t)(row + tap - 2) * DRNN + ch);
                const f32x4 w0 = *(const f32x4*)(cw + tap * DRNN + ch), w1 = *(const f32x4*)(cw + tap * DRNN + ch + 4);
                acc[0] += w0[0] * bf_lo(rv.x); acc[1] += w0[1] * bf_hi(rv.x); acc[2] += w0[2] * bf_lo(rv.y); acc[3] += w0[3] * bf_hi(rv.y);
                acc[4] += w1[0] * bf_lo(rv.z); acc[5] += w1[1] * bf_hi(rv.z); acc[6] += w1[2] * bf_lo(rv.w); acc[7] += w1[3] * bf_hi(rv.w); } }
        u32x4 o; o.x = cvt_pk_bf16(acc[0], acc[1]); o.y = cvt_pk_bf16(acc[2], acc[3]); o.z = cvt_pk_bf16(acc[4], acc[5]); o.w = cvt_pk_bf16(acc[6], acc[7]);
        *(u32x4*)(U + (size_t)row * DRNN + ch) = o;
    }
}
__device__ __forceinline__ int scan_row0(int bl, int c) { return (c < 8) ? (8192 + bl * CTX + c * 32) : (bl * SEQ + (c - 8) * 32); }
__device__ __forceinline__ void scanA_phase(const bf16_t* LA, const bf16_t* BX, float* SP, float* SH, int gtid, int nthreads) {
    for (int idx = gtid; idx < 2 * 4 * 72 * 640; idx += nthreads) {
        const int cp = idx % 640, r1 = idx / 640, c = r1 % 72, r2 = r1 / 72, bl = r2 & 3, dir = r2 >> 2;
        const int row0 = scan_row0(bl, c);
        const size_t base = ((size_t)dir * 9216 + row0) * DRNN + cp * 2;
        float P0 = 1.f, P1 = 1.f, H0 = 0.f, H1 = 0.f;
#pragma unroll 8
        for (int i = 0; i < 32; ++i) { const int ii = dir ? (31 - i) : i;
            const unsigned lw = *(const unsigned*)(LA + base + (size_t)ii * DRNN), bw = *(const unsigned*)(BX + base + (size_t)ii * DRNN);
            const float a0 = __expf(bf_lo(lw)), a1 = __expf(bf_hi(lw));
            P0 *= a0; P1 *= a1; H0 = a0 * H0 + bf_lo(bw); H1 = a1 * H1 + bf_hi(bw); }
        const size_t so = ((size_t)(dir * 4 + bl) * 72 + c) * DRNN + cp * 2;
        *(f32x2*)(SP + so) = (f32x2){P0, P1}; *(f32x2*)(SH + so) = (f32x2){H0, H1};
    }
}
__device__ __forceinline__ void scanB_phase(const float* SP, const float* SH, float* CIN, int gtid, int nthreads) {
    for (int idx = gtid; idx < 2 * 4 * DRNN; idx += nthreads) {
        const int ch = idx % DRNN, r = idx / DRNN, bl = r & 3, dir = r >> 2;
        const size_t base = ((size_t)(dir * 4 + bl) * 72) * DRNN + ch;
        float carry = 0.f;
#pragma unroll 1
        for (int s0 = 0; s0 < 72; s0 += 24) {
            float pv[24], hv[24];
#pragma unroll
            for (int s = 0; s < 24; ++s) { const int sq = s0 + s; const int c = dir ? (sq < 8 ? 7 - sq : 79 - sq) : sq; pv[s] = SP[base + (size_t)c * DRNN]; hv[s] = SH[base + (size_t)c * DRNN]; }
#pragma unroll
            for (int s = 0; s < 24; ++s) { const int sq = s0 + s; const int c = dir ? (sq < 8 ? 7 - sq : 79 - sq) : sq; CIN[base + (size_t)c * DRNN] = carry; carry = pv[s] * carry + hv[s]; }
        }
    }
}
__device__ __forceinline__ void scanC_phase(const bf16_t* LA, const bf16_t* BX, const float* CIN, bf16_t* REC, int half, int gtid, int nthreads) {
    for (int idx = gtid; idx < 4 * 64 * 640; idx += nthreads) {
        const int cp = idx % 640, r1 = idx / 640, lc = r1 & 63, bl = r1 >> 6;
        const int row0 = bl * SEQ + lc * 32;
        const size_t b0 = ((size_t)row0) * DRNN + cp * 2, b1 = ((size_t)9216 + row0) * DRNN + cp * 2;
        const f32x2 cf = *(const f32x2*)(CIN + ((size_t)(0 * 4 + bl) * 72 + 8 + lc) * DRNN + cp * 2);
        const f32x2 cbk = *(const f32x2*)(CIN + ((size_t)(1 * 4 + bl) * 72 + 8 + lc) * DRNN + cp * 2);
        float hf0[32], hf1[32];
        float h0 = cf[0], h1 = cf[1];
#pragma unroll
        for (int i = 0; i < 32; ++i) { const unsigned lw = *(const unsigned*)(LA + b0 + (size_t)i * DRNN), bw = *(const unsigned*)(BX + b0 + (size_t)i * DRNN);
            h0 = __expf(bf_lo(lw)) * h0 + bf_lo(bw); h1 = __expf(bf_hi(lw)) * h1 + bf_hi(bw); hf0[i] = h0; hf1[i] = h1; }
        h0 = cbk[0]; h1 = cbk[1];
        bf16_t* out = REC + ((size_t)(half * 4 + bl) * SEQ + lc * 32) * DRNN + cp * 2;
#pragma unroll
        for (int i = 31; i >= 0; --i) { const unsigned lw = *(const unsigned*)(LA + b1 + (size_t)i * DRNN), bw = *(const unsigned*)(BX + b1 + (size_t)i * DRNN);
            h0 = __expf(bf_lo(lw)) * h0 + bf_lo(bw); h1 = __expf(bf_hi(lw)) * h1 + bf_hi(bw);
            *(unsigned*)(out + (size_t)i * DRNN) = cvt_pk_bf16(hf0[i] + h0, hf1[i] + h1); }
    }
}

#ifndef PH_MASK
#define PH_MASK 0xFFFFFFFFu
#endif
#define PH(k) ((PH_MASK >> (k)) & 1u)
#ifndef REP_MASK
#define REP_MASK 0u
#endif
#define REP_BEGIN(k) _Pragma("unroll 1") for (int rep_ = 0; rep_ < (((REP_MASK >> (k)) & 1u) ? 2 : 1); ++rep_) {
#define REP_END }
__device__ __forceinline__ ParamsK kparams() { ParamsK q = (ParamsK)__builtin_amdgcn_kernarg_segment_ptr(); asm volatile("" : "+s"(q)); return q; }
#define PHASE_BEGIN ParamsK kp = kparams(); unsigned char* ws = kp->ws; (void)ws; \
    int tid = threadIdx.x; asm volatile("" : "+v"(tid)); const int lane = tid & 63, wave = __builtin_amdgcn_readfirstlane(tid >> 6); \
    const int gw = bid * 8 + wave, gtid = bid * 512 + tid; (void)lane; (void)gw; (void)gtid;
#define P_MOD0 ((float*)(ws + WS_MOD))
#define P_MOD1 ((float*)(ws + WS_MOD) + 9 * 6144)
#define P_CTXRES ((float*)(ws + WS_CTXRES))
#define P_H ((bf16_t*)(ws + WS_H))
#define P_SLAB ((bf16_t*)(ws + WS_SLAB))
#define P_Q ((bf16_t*)(ws + WS_Q))
#define P_O ((bf16_t*)(ws + WS_O))
#define P_K ((bf16_t*)(ws + WS_K))
#define P_VT ((bf16_t*)(ws + WS_VT))
#define P_VTC ((bf16_t*)(ws + WS_VTC))
#define P_ACT ((bf16_t*)(ws + WS_ACT))
#define P_U ((bf16_t*)(ws + WS_U))
#define P_RECF ((bf16_t*)(ws + WS_RECF))
#define P_RECB ((bf16_t*)(ws + WS_RECB))
#define P_LA ((bf16_t*)(ws + WS_LA))
#define P_BX ((bf16_t*)(ws + WS_BX))
#define P_RPRE ((bf16_t*)(ws + WS_RPRE))
#define P_SP ((float*)(ws + WS_SP))
#define P_SH ((float*)(ws + WS_SH))
#define P_CIN ((float*)(ws + WS_CIN))
#define G0 (kp->norm_g)
#define G1 (kp->norm_g + 4 * DM)

__global__ void __launch_bounds__(512, 2) fwd_megakernel(Params p) {
    extern __shared__ __attribute__((aligned(16))) unsigned char lds_raw[];
    LAS unsigned char* lds = (LAS unsigned char*)lds_raw;
    const int G = gridDim.x, bid = blockIdx.x;
    const int ngw = G * 8, nthreads = G * 512;
    using namespace pg8;
    if (threadIdx.x < 4) ((volatile LAS unsigned*)(lds + 132096))[threadIdx.x] = 0u;
    __syncthreads();
    XcdBarrier xbar = xcd_barrier_post((unsigned*)(p.ws + WS_BAR), (volatile LAS unsigned*)(lds + 132096));
    if (PH(0)) { PHASE_BEGIN prologue(kp, lds, tid, lane, wave); }
    xcd_barrier(xbar);
#ifdef EXTRA_SYNCS
#pragma unroll 1
    for (int es = 0; es < EXTRA_SYNCS; ++es) xcd_barrier(xbar);
#endif
    REP_BEGIN(1)
    if (PH(1)) { PHASE_BEGIN row_phase<false, true>(kp->x, kp->ctx, nullptr, nullptr, nullptr, nullptr, P_H, nullptr, G0, nullptr, 0, P_MOD0, 0, 1, MT, gw, ngw, lane); }
    xcd_barrier(xbar);
    REP_END
    if (PH(2)) {
        PHASE_BEGIN
        Gemm g{P_H, (const bf16_t*)(ws + WS_WQKV), DM, DM, DM}; Sched S; S.init(MT / 256, NQKV / 256, G, bid);
        EpiQKV E{P_Q, P_K, P_VT, P_VTC, (const float*)(ws + WS_ROPE)};
        gemm_phase<EpiQKV, true, true>(lds, g, S, E);
    }
    xcd_barrier(xbar);
    REP_BEGIN(3)
    if (PH(3)) { PHASE_BEGIN attn_phase(lds, P_Q, P_O, P_K, P_VT, P_VTC, kp->sink, tid, lane, wave); }
    xcd_barrier(xbar);
    REP_END
    if (PH(4)) {
        PHASE_BEGIN
        { Gemm g{P_O, (const bf16_t*)(ws + WS_WO), DM, DM, DM}; Sched S; S.init(ML / 256, DM / 256, G, bid);
          EpiPlain<0> E{P_H, DM};
          gemm_phase<EpiPlain<0>, true, true>(lds, g, S, E); }
        { Gemm g{P_O, (const bf16_t*)(ws + WS_WO), DM, DM, 256}; Sched S; S.init(8, 4 * 4, G, bid, 2, 256);
          EpiSlabCtx E{P_SLAB, 256};
          gemm_phase<EpiSlabCtx, true, true>(lds, g, S, E); }
    }
    xcd_barrier(xbar);
    if (PH(5)) { PHASE_BEGIN row_phase<true, true>(kp->x, kp->ctx, kp->out, P_CTXRES, P_H, P_SLAB, P_H, G0 + DM, G0 + 2 * DM, P_MOD0, 2, P_MOD0, 3, 4, MT, gw, ngw, lane); }
    xcd_barrier(xbar);
    if (PH(6)) {
        PHASE_BEGIN
        Gemm g{P_H, (const bf16_t*)(ws + WS_W1), DM, DM, DM}; Sched S; S.init(MT / 256, DFF / 256, G, bid);
        EpiPlain<1> E{P_ACT, DFF};
        gemm_phase<EpiPlain<1>, true, true>(lds, g, S, E);
    }
    xcd_barrier(xbar);
    if (PH(7)) {
        PHASE_BEGIN
        { Gemm g{P_ACT, (const bf16_t*)(ws + WS_W2), DFF, DFF, DFF}; Sched S; S.init(ML / 256, DM / 256, G, bid);
          EpiPlain<0> E{P_H, DM};
          gemm_phase<EpiPlain<0>, true, true>(lds, g, S, E); }
        { Gemm g{P_ACT, (const bf16_t*)(ws + WS_W2), DFF, DFF, 1024}; Sched S; S.init(8, 4 * 4, G, bid, 2, 1024);
          EpiSlabCtx E{P_SLAB, 1024};
          gemm_phase<EpiSlabCtx, true, true>(lds, g, S, E); }
    }
    xcd_barrier(xbar);
    if (PH(8)) { PHASE_BEGIN row_phase<true, true>(kp->out, P_CTXRES, kp->out, P_CTXRES, P_H, P_SLAB, P_H, G0 + 3 * DM, G1, P_MOD0, 5, P_MOD1, 0, 1, MT, gw, ngw, lane); }
    xcd_barrier(xbar);
    if (PH(9)) {
        PHASE_BEGIN
        Gemm g{P_H, (const bf16_t*)(ws + WS_WIN) + (size_t)DRNN * DM, DM, DM, DM}; Sched S; S.init(MT / 256, DRNN / 256, G, bid);
        EpiPlain<0> E{P_RPRE, DRNN};
        gemm_phase<EpiPlain<0>, true, true>(lds, g, S, E);
    }
    xcd_barrier(xbar);
    REP_BEGIN(10)
    if (PH(10)) { PHASE_BEGIN conv_phase(P_RPRE, P_U, kp->conv_w, kp->conv_b, gtid, nthreads); }
    xcd_barrier(xbar);
    REP_END
    if (PH(11)) {
        PHASE_BEGIN
        Gemm g{P_U, (const bf16_t*)(ws + WS_WG), DRNN, 256, 256}; Sched S; S.init(1, 1, G, bid, 3, 0);
        EpiGatesScan E{P_U, P_RECF, P_RECB, kp->b_a, kp->b_i, (const float*)(ws + WS_NLS), (float*)(ws + WS_CARRY), (unsigned*)(ws + WS_FLAG)};
        gemm_phase<EpiGatesScan, true, true>(lds, g, S, E);
    }
    xcd_barrier(xbar);
    if (PH(15)) {
        PHASE_BEGIN
        Gemm g{P_H, (const bf16_t*)(ws + WS_WIN), DM, DM, DM}; Sched S; S.init(ML / 256, DRNN / 256, G, bid);
        EpiGateMul E{P_RECF, P_RECB};
        gemm_phase<EpiGateMul, true, true>(lds, g, S, E);
    }
    xcd_barrier(xbar);
    if (PH(16)) {
        PHASE_BEGIN
        Gemm g{P_RECF, (const bf16_t*)(ws + WS_WOUT), DRNN, DRNN, DRNN}; Sched S; S.init(ML / 256, DM / 256, G, bid);
        EpiPlain<0> E{P_H, DM};
        gemm_phase<EpiPlain<0>, true, true>(lds, g, S, E);
    }
    xcd_barrier(xbar);
    if (PH(17)) { PHASE_BEGIN row_phase<true, true>(kp->out, P_CTXRES, kp->out, P_CTXRES, P_H, nullptr, P_H, G1 + DM, G1 + 2 * DM, P_MOD1, 2, P_MOD1, 3, 4, ML, gw, ngw, lane); }
    xcd_barrier(xbar);
    if (PH(18)) {
        PHASE_BEGIN
        Gemm g{P_H, (const bf16_t*)(ws + WS_W1 + 16 * MiB), DM, DM, DM}; Sched S; S.init(ML / 256, DFF / 256, G, bid);
        EpiPlain<1> E{P_ACT, DFF};
        gemm_phase<EpiPlain<1>, true, true>(lds, g, S, E);
    }
    xcd_barrier(xbar);
    if (PH(19)) {
        PHASE_BEGIN
        Gemm g{P_ACT, (const bf16_t*)(ws + WS_W2 + 16 * MiB), DFF, DFF, DFF}; Sched S; S.init(ML / 256, DM / 256, G, bid);
        EpiPlain<0> E{P_H, DM};
        gemm_phase<EpiPlain<0>, true, true>(lds, g, S, E);
    }
    xcd_barrier(xbar);
    if (PH(20)) { PHASE_BEGIN row_phase<true, false>(kp->out, P_CTXRES, kp->out, P_CTXRES, P_H, nullptr, nullptr, G1 + 3 * DM, nullptr, P_MOD1, 5, nullptr, 0, 0, ML, gw, ngw, lane); }
}

extern "C" void kernel_launch(void* const* d_in, const int* in_sizes, int n_in, void* d_out, int out_size, void* d_ws, size_t ws_size, hipStream_t stream) {
    static int grid_blocks = 0;
    if (grid_blocks == 0) {
        if (n_in != 21 || ws_size < WS_END) { fprintf(stderr, "kernel_launch: unexpected n_in %d / ws_size %zu\n", n_in, ws_size); grid_blocks = -1; return; }
        int dev = 0, cus = 0, per_cu = 0;
        hipGetDevice(&dev);
        hipDeviceGetAttribute(&cus, hipDeviceAttributeMultiprocessorCount, dev);
        if (hipFuncSetAttribute((const void*)fwd_megakernel, hipFuncAttributeMaxDynamicSharedMemorySize, LDS_BYTES) != hipSuccess) { fprintf(stderr, "hipFuncSetAttribute failed\n"); grid_blocks = -1; return; }
        if (hipOccupancyMaxActiveBlocksPerMultiprocessor(&per_cu, (const void*)fwd_megakernel, 512, LDS_BYTES) != hipSuccess || per_cu < 1) { fprintf(stderr, "occupancy query failed (%d)\n", per_cu); (void)hipGetLastError(); per_cu = 1; }
        grid_blocks = cus * 1;
    }
    if (grid_blocks < 0) return;
    Params p{};
    p.x = (const float*)d_in[0]; p.c = (const float*)d_in[1]; p.ctx = (const float*)d_in[2]; p.c_ctx = (const float*)d_in[3];
    p.ada_w = (const float*)d_in[4]; p.ada_b = (const float*)d_in[5]; p.norm_g = (const float*)d_in[6]; p.mlp_w1 = (const float*)d_in[7]; p.mlp_w2 = (const float*)d_in[8];
    p.w_qkv = (const float*)d_in[9]; p.w_o = (const float*)d_in[10]; p.sink = (const float*)d_in[11];
    p.w_in = (const float*)d_in[12]; p.conv_w = (const float*)d_in[13]; p.conv_b = (const float*)d_in[14]; p.w_a = (const float*)d_in[15]; p.b_a = (const float*)d_in[16];
    p.w_i = (const float*)d_in[17]; p.b_i = (const float*)d_in[18]; p.lam = (const float*)d_in[19]; p.w_out = (const float*)d_in[20];
    p.out = (float*)d_out; p.ws = (unsigned char*)d_ws;
    if (hipMemsetAsync((unsigned char*)d_ws + WS_BAR, 0, XCD_BAR_WORDS * 4, stream) != hipSuccess) { fprintf(stderr, "memset of barrier words failed\n"); return; }
    void* args[] = {&p};
    hipError_t e = hipLaunchCooperativeKernel((const void*)fwd_megakernel, dim3(grid_blocks), dim3(512), args, LDS_BYTES, stream);
    if (e != hipSuccess) fprintf(stderr, "cooperative launch failed: %s (grid %d)\n", hipGetErrorString(e), grid_blocks);
}
```

```cpp
#include <hip/hip_runtime.h>
#include <hip/hip_cooperative_groups.h>
#include <cstdio>
#include <cstdint>
namespace cg = cooperative_groups;

#define LAS __attribute__((address_space(3)))
typedef unsigned short bf16_t;
typedef short bf16x8 __attribute__((ext_vector_type(8)));
typedef float f32x4 __attribute__((ext_vector_type(4)));
typedef float f32x2 __attribute__((ext_vector_type(2)));
typedef unsigned u32x4 __attribute__((ext_vector_type(4)));
typedef unsigned u32x2 __attribute__((ext_vector_type(2)));

constexpr int DM = 1024, NB = 8, SEQ = 2048, CTX = 256;
constexpr int ML = NB * SEQ;
constexpr int MC = NB * CTX;
constexpr int MT = ML + MC;
constexpr int NQKV = 1536, DFF = 4096, DRNN = 1280;
constexpr float EPS = 1e-6f;
constexpr float LOG2E = 1.4426950408889634f;

constexpr size_t MiB = 1u << 20;
constexpr size_t WS_MOD = 0;
constexpr size_t WS_ROPE = 448 * 1024;
constexpr size_t WS_NLS = 460 * 1024;
constexpr size_t WS_BAR = 480 * 1024;
constexpr size_t WS_WQKV = 1 * MiB, WS_WO = 4 * MiB, WS_W1 = 6 * MiB, WS_W2 = 14 * MiB;
constexpr size_t WS_WIN = 38 * MiB, WS_WG = 43 * MiB, WS_WOUT = 46 * MiB;
constexpr size_t WS_CTXRES = 49 * MiB;
constexpr size_t WS_H = 57 * MiB;
constexpr size_t WS_R3 = 93 * MiB;
constexpr size_t WS_Q = WS_R3, WS_K = 129 * MiB, WS_VT = 138 * MiB, WS_VTC = 146 * MiB;
constexpr size_t WS_O = 150 * MiB;
constexpr size_t WS_ACT = WS_R3;
constexpr size_t WS_U = WS_R3;
constexpr size_t WS_RECF = 138 * MiB;
constexpr size_t WS_RECB = 178 * MiB;
constexpr size_t WS_LA = 138 * MiB;
constexpr size_t WS_BX = 183 * MiB;
constexpr size_t WS_RPRE = 138 * MiB;
constexpr size_t WS_SP = 228 * MiB, WS_SH = 231 * MiB, WS_CIN = 234 * MiB;
constexpr size_t WS_SLAB = 238 * MiB;
constexpr size_t WS_CARRY = 219 * MiB;
constexpr size_t WS_FLAG = 512 * 1024;
constexpr size_t WS_END = 256 * MiB;
constexpr int LDS_BYTES = 135168;

__device__ __forceinline__ unsigned f2bf(float f) { unsigned u = __builtin_bit_cast(unsigned, f); return (u + 0x7fffu + ((u >> 16) & 1u)) >> 16; }
__device__ __forceinline__ unsigned cvt_pk_bf16(float lo, float hi) { unsigned r; asm volatile("v_cvt_pk_bf16_f32 %0, %1, %2" : "=v"(r) : "v"(lo), "v"(hi)); return r; }
__device__ __forceinline__ float bf_lo(unsigned w) { return __builtin_bit_cast(float, w << 16); }
__device__ __forceinline__ float bf_hi(unsigned w) { return __builtin_bit_cast(float, w & 0xffff0000u); }
__device__ __forceinline__ f32x4 bf4_to_f32(u32x2 w) { return (f32x4){bf_lo(w.x), bf_hi(w.x), bf_lo(w.y), bf_hi(w.y)}; }
__device__ __forceinline__ u32x2 f32_to_bf4(f32x4 v) { u32x2 w; w.x = cvt_pk_bf16(v[0], v[1]); w.y = cvt_pk_bf16(v[2], v[3]); return w; }
__device__ __forceinline__ float wave_sum(float v) {
#pragma unroll
    for (int o = 1; o < 64; o <<= 1) v += __shfl_xor(v, o);
    return v;
}
__device__ __forceinline__ float fsigmoid(float x) { return __builtin_amdgcn_rcpf(1.0f + __expf(-x)); }

namespace pg8 {
constexpr int BM = 256, BK = 64, HALF = 128, HTB = HALF * BK * 2, STAGE_BYTES = 8 * HTB, NXCD = 8, WGM = 8;
__device__ __forceinline__ int lds_byte(int r, int c) { const int st = (r >> 4) * 2 + (c >> 5), rr = r & 15, cc = c & 31, ob = rr * 64 + cc * 2; return st * 1024 + (ob ^ (((ob >> 9) & 1) << 5)); }
__device__ __forceinline__ void stage_rc(int b, int& R, int& C) { const int st = b / 1024, sb = b % 1024, swz = sb ^ (((sb >> 9) & 1) << 5); R = (st >> 1) * 16 + swz / 64; C = (st & 1) * 32 + (swz % 64) / 2; }

struct Unit { int pm, pn, koff, po, kboff, rev, lin; };
struct Gemm { const bf16_t* A; const bf16_t* Bt; int lda, ldb, K; };

struct Sched {
    int nM, nN, nwg, G, c, mode, half;
    __device__ void init(int nM_, int nN_, int G_, int c_, int mode_ = 0, int half_ = 0) { nM = nM_; nN = nN_; nwg = nM * nN; G = G_; c = c_; mode = mode_; half = half_; }
    __device__ bool next(int i, Unit& u) const {
        if (mode == 3) {
            const int L = i * G + c; if (L >= 1440) return false;
            const int ti = L / 160, s = L % 160;
            const int chalf = s & 1, dir = (s >> 1) & 1, bb = s >> 2, blk = bb % 5, b = bb / 5;
            u.pm = (ti == 0) ? 64 + b : (dir ? b * 8 + (8 - ti) : b * 8 + (ti - 1));
            u.pn = (dir * 5 + blk) * 2 + chalf; u.koff = blk * 256; u.kboff = 0; u.po = ti; u.rev = dir; u.lin = L;
            return true;
        }
        if (mode == 4) {
            const int L4 = i * G + c; if (L4 >= 424) return false;
            if (L4 >= 360) { u.pm = L4 - 360; u.pn = 4; u.koff = 0; u.po = u.pm; u.kboff = 0; u.rev = 0; u.lin = 0; return true; }
        }
        const long L = (long)i * G + c; if (L >= nwg) return false;
        int wgid = (int)L; { const int q = nwg / NXCD, r = nwg % NXCD, xcd = wgid % NXCD, off = wgid / NXCD; wgid = (xcd < r ? xcd * (q + 1) : r * (q + 1) + (xcd - r) * q) + off; }
        const int nig = WGM * nN, gid = wgid / nig, fm = gid * WGM, gsz = (nM - fm) < WGM ? (nM - fm) : WGM;
        const int pmi = fm + ((wgid % nig) % gsz), pn = (wgid % nig) / gsz;
        u.pm = pmi; u.pn = pn; u.koff = 0; u.po = pmi; u.kboff = 0; u.rev = 0; u.lin = 0;
        if (mode == 2) { u.pm = 64 + pmi; u.pn = pn & 3; u.koff = (pn >> 2) * half; u.kboff = u.koff; }
        if (mode == 4) u.pn += 5;
        if (mode == 1) { u.pm = pmi < 32 ? 32 * half + pmi : 64 + 4 * half + (pmi - 32); u.koff = ((pn >> 1) % 5) * 256; }
        return true;
    }
};

template <class Epi, bool ALIGN_EPI, bool SP2>
__device__ __forceinline__ void gemm_phase(LAS unsigned char* lds, const Gemm g, const Sched& S, const Epi& E) {
    int tid = threadIdx.x; asm volatile("" : "+v"(tid));
    const int wid = __builtin_amdgcn_readfirstlane(tid >> 6), lane = tid & 63, wr = wid >> 2, wc = wid & 3, fr = lane & 15, fq = lane >> 4;
    const int K = g.K, nt = K / BK;
    unsigned voffAf[2], voffAr[2], voffB[2];
#pragma unroll
    for (int i = 0; i < 2; ++i) { int R, C; stage_rc(tid * 16 + i * 8192, R, C);
        voffAf[i] = (unsigned)(R * g.lda + C) * 2u; voffAr[i] = (unsigned)((127 - R) * g.lda + C) * 2u; voffB[i] = (unsigned)(R * g.ldb + C) * 2u; }
    const size_t kstep = (size_t)(BK * 2);
    const long hstepAf = (long)HALF * g.lda * 2; const size_t hstepB = (size_t)HALF * g.ldb * 2;
    const unsigned ldsw = (unsigned)wid * 1024u;
    const int aoff = lds_byte(wr * 64 + fr, fq * 8), boff = lds_byte(wc * 32 + fr, fq * 8);
#define PG8_SA(b, h) (((b) * 2 + (h)) * HTB)
#define PG8_SB(b, h) ((4 + (b) * 2 + (h)) * HTB)
#define PG8_STAGE(bufoff, gbase, voff) do { _Pragma("unroll") for (int _i = 0; _i < 2; ++_i) \
        __builtin_amdgcn_global_load_lds((const unsigned*)((const char*)(gbase) + (voff)[_i]), (LAS unsigned*)(lds + (bufoff) + ldsw + _i * 8192), 16, 0, 0); } while (0)
#define PG8_LDA(dst, b, h) do { _Pragma("unroll") for (int m = 0; m < 4; ++m) _Pragma("unroll") for (int k = 0; k < 2; ++k) dst[m][k] = *(const LAS bf16x8*)(lds + PG8_SA(b, h) + aoff + m * 2048 + k * 1024); } while (0)
#define PG8_LDB(dst, b, h) do { _Pragma("unroll") for (int n = 0; n < 2; ++n) _Pragma("unroll") for (int k = 0; k < 2; ++k) dst[n][k] = *(const LAS bf16x8*)(lds + PG8_SB(b, h) + boff + n * 2048 + k * 1024); } while (0)
#define PG8_MMA(ai, bj, At, Bt) do { __builtin_amdgcn_s_setprio(1); _Pragma("unroll") for (int m = 0; m < 4; ++m) _Pragma("unroll") for (int n = 0; n < 2; ++n) _Pragma("unroll") for (int k = 0; k < 2; ++k) \
        acc[ai][bj][m][n] = __builtin_amdgcn_mfma_f32_16x16x32_bf16(Bt[n][k], At[m][k], acc[ai][bj][m][n], 0, 0, 0); __builtin_amdgcn_s_setprio(0); } while (0)
#define PG8_WAIT_V(n) asm volatile("s_waitcnt vmcnt(" #n ")" ::: "memory")
#define PG8_WAIT_L(n) asm volatile("s_waitcnt lgkmcnt(" #n ")" ::: "memory")
#define PG8_BAR __builtin_amdgcn_s_barrier()
#define PG8_SCHED __builtin_amdgcn_sched_barrier(0)
    Unit cur, nxt; int ui = 0;
    if (!S.next(0, cur)) return;
    f32x4 acc[2][2][4][2];
#pragma unroll
    for (int a = 0; a < 2; ++a)
#pragma unroll
        for (int b = 0; b < 2; ++b)
#pragma unroll
            for (int m = 0; m < 4; ++m)
#pragma unroll
                for (int n = 0; n < 2; ++n) acc[a][b][m][n] = (f32x4){0.f, 0.f, 0.f, 0.f};
    bf16x8 At[4][2], B0[2][2], B1[2][2];
#define PG8_UNIT_A(u_) ((const char*)g.A + ((size_t)(u_).pm * BM * g.lda + (u_).koff) * 2 + (Epi::WITH_LDS && (u_).rev ? hstepAf : 0))
    const char* cA = PG8_UNIT_A(cur);
    unsigned voffA[2] = {voffAf[0], voffAf[1]}; long hstepA = hstepAf;
    if (Epi::WITH_LDS && cur.rev) { voffA[0] = voffAr[0]; voffA[1] = voffAr[1]; hstepA = -hstepAf; } const char* cB = (const char*)g.Bt + ((size_t)cur.pn * BM * g.ldb + cur.kboff) * 2;
    if constexpr (SP2) {
        PG8_STAGE(PG8_SB(0, 0), cB, voffB); PG8_STAGE(PG8_SB(0, 1), cB + hstepB, voffB); PG8_STAGE(PG8_SA(0, 0), cA, voffA); PG8_STAGE(PG8_SA(0, 1), cA + hstepA, voffA);
        if (wr == 1) PG8_BAR;
        PG8_WAIT_V(2); PG8_BAR;
        PG8_STAGE(PG8_SB(1, 0), cB + kstep, voffB); PG8_STAGE(PG8_SA(1, 0), cA + kstep, voffA); PG8_STAGE(PG8_SB(1, 1), cB + hstepB + kstep, voffB);
        PG8_WAIT_V(6); PG8_BAR;
    } else {
        PG8_STAGE(PG8_SB(0, 0), cB, voffB); PG8_STAGE(PG8_SA(0, 0), cA, voffA); PG8_STAGE(PG8_SB(0, 1), cB + hstepB, voffB); PG8_STAGE(PG8_SA(0, 1), cA + hstepA, voffA);
        if (wr == 1) PG8_BAR;
        PG8_WAIT_V(4); PG8_BAR;
        PG8_STAGE(PG8_SB(1, 0), cB + kstep, voffB); PG8_STAGE(PG8_SA(1, 0), cA + kstep, voffA); PG8_STAGE(PG8_SB(1, 1), cB + hstepB + kstep, voffB);
        PG8_WAIT_V(6); PG8_BAR;
    }
    for (;;) {
        const bool has_next = S.next(ui + 1, nxt);
        const char* nA = has_next ? PG8_UNIT_A(nxt) : cA;
        unsigned voffN[2] = {voffA[0], voffA[1]}; long hstepN = hstepA;
        if (Epi::WITH_LDS && has_next) { const bool nr = nxt.rev != 0; voffN[0] = nr ? voffAr[0] : voffAf[0]; voffN[1] = nr ? voffAr[1] : voffAf[1]; hstepN = nr ? -hstepAf : hstepAf; }
        const char* nB = has_next ? (const char*)g.Bt + ((size_t)nxt.pn * BM * g.ldb + nxt.kboff) * 2 : cB;
#pragma unroll 1
        for (int t = 0; t < nt; t += 2) {
            const bool last = (t == nt - 2);
            const char* a1 = cA + (size_t)(t + 1) * kstep;
            const char* a2 = last ? nA : cA + (size_t)(t + 2) * kstep; const char* b2 = last ? nB : cB + (size_t)(t + 2) * kstep;
            const char* a3 = a2 + kstep; const char* b3 = b2 + kstep;
            unsigned voff2[2] = {voffA[0], voffA[1]}; long hstep2 = hstepA;
            if (Epi::WITH_LDS && last) { voff2[0] = voffN[0]; voff2[1] = voffN[1]; hstep2 = hstepN; }
            if constexpr (SP2) {
            PG8_LDB(B0, 0, 0); PG8_LDB(B1, 0, 1); PG8_SCHED; PG8_LDA(At, 0, 0); PG8_STAGE(PG8_SA(1, 1), a1 + hstepA, voffA);
            PG8_WAIT_V(8); PG8_WAIT_L(0); PG8_BAR; PG8_MMA(0, 0, At, B0); PG8_MMA(0, 1, At, B1); PG8_BAR; PG8_SCHED;
            PG8_LDA(At, 0, 1); PG8_STAGE(PG8_SB(0, 0), b2, voffB); PG8_STAGE(PG8_SB(0, 1), b2 + hstepB, voffB); PG8_STAGE(PG8_SA(0, 0), a2, voff2);
            PG8_WAIT_V(8); PG8_WAIT_L(0); PG8_BAR; PG8_MMA(1, 0, At, B0); PG8_MMA(1, 1, At, B1); PG8_BAR; PG8_SCHED;
            PG8_LDB(B0, 1, 0); PG8_LDB(B1, 1, 1); PG8_SCHED; PG8_LDA(At, 1, 0); PG8_STAGE(PG8_SA(0, 1), a2 + hstep2, voff2);
            PG8_WAIT_V(8); PG8_WAIT_L(0); PG8_BAR; PG8_MMA(0, 0, At, B0); PG8_MMA(0, 1, At, B1); PG8_BAR; PG8_SCHED;
            PG8_LDA(At, 1, 1); PG8_STAGE(PG8_SB(1, 0), b3, voffB); PG8_STAGE(PG8_SB(1, 1), b3 + hstepB, voffB); PG8_STAGE(PG8_SA(1, 0), a3, voff2);
            PG8_WAIT_V(8); PG8_WAIT_L(0); PG8_BAR; PG8_MMA(1, 0, At, B0); PG8_MMA(1, 1, At, B1); PG8_BAR; PG8_SCHED;
            } else {
            PG8_LDB(B0, 0, 0); PG8_SCHED; PG8_LDA(At, 0, 0); PG8_STAGE(PG8_SA(1, 1), a1 + hstepA, voffA);
            PG8_WAIT_L(8); PG8_BAR; PG8_WAIT_L(0); PG8_MMA(0, 0, At, B0); PG8_BAR; PG8_SCHED;
            PG8_LDB(B1, 0, 1); PG8_STAGE(PG8_SB(0, 0), b2, voffB);
            PG8_BAR; PG8_WAIT_L(0); PG8_MMA(0, 1, At, B1); PG8_BAR;
            PG8_LDA(At, 0, 1); PG8_STAGE(PG8_SA(0, 0), a2, voff2);
            PG8_BAR; PG8_WAIT_L(0); PG8_MMA(1, 0, At, B0); PG8_BAR; PG8_SCHED;
            PG8_STAGE(PG8_SB(0, 1), b2 + hstepB, voffB);
            PG8_WAIT_V(6); PG8_BAR; PG8_MMA(1, 1, At, B1); PG8_BAR;
            PG8_LDB(B0, 1, 0); PG8_SCHED; PG8_LDA(At, 1, 0); PG8_STAGE(PG8_SA(0, 1), a2 + hstep2, voff2);
            PG8_WAIT_L(8); PG8_BAR; PG8_WAIT_L(0); PG8_MMA(0, 0, At, B0); PG8_BAR; PG8_SCHED;
            PG8_LDB(B1, 1, 1); PG8_STAGE(PG8_SB(1, 0), b3, voffB);
            PG8_BAR; PG8_WAIT_L(0); PG8_MMA(0, 1, At, B1); PG8_BAR;
            PG8_LDA(At, 1, 1); PG8_STAGE(PG8_SA(1, 0), a3, voff2);
            PG8_BAR; PG8_WAIT_L(0); PG8_MMA(1, 0, At, B0); PG8_BAR; PG8_SCHED;
            PG8_STAGE(PG8_SB(1, 1), b3 + hstepB, voffB);
            PG8_WAIT_V(6); PG8_BAR; PG8_MMA(1, 1, At, B1); PG8_BAR;
            }
        }
        if constexpr (ALIGN_EPI) { if (wr == 0) PG8_BAR; }
        if constexpr (Epi::WITH_LDS) E.run(acc, cur, wr, wc, lane, lds); else E(acc, cur, wr, wc, fr, fq);
        if (!has_next) break;
#pragma unroll
        for (int a = 0; a < 2; ++a)
#pragma unroll
            for (int b = 0; b < 2; ++b)
#pragma unroll
                for (int m = 0; m < 4; ++m)
#pragma unroll
                    for (int n = 0; n < 2; ++n) acc[a][b][m][n] = (f32x4){0.f, 0.f, 0.f, 0.f};
        cur = nxt; cA = nA; cB = nB; ++ui; voffA[0] = voffN[0]; voffA[1] = voffN[1]; hstepA = hstepN;
        if constexpr (ALIGN_EPI) { if (wr == 1) PG8_BAR; }
    }
    PG8_WAIT_V(0);
    if constexpr (!ALIGN_EPI) { if (wr == 0) PG8_BAR; }
    PG8_BAR;
#undef PG8_UNIT_A
#undef PG8_SA
#undef PG8_SB
#undef PG8_STAGE
#undef PG8_LDA
#undef PG8_LDB
#undef PG8_MMA
#undef PG8_WAIT_V
#undef PG8_WAIT_L
#undef PG8_BAR
#undef PG8_SCHED
}

template <int ACT> struct EpiPlain {
    static constexpr bool WITH_LDS = false;
    bf16_t* O; int ldc;
    __device__ __forceinline__ void operator()(const f32x4 (&acc)[2][2][4][2], const Unit& u, int wr, int wc, int fr_, int fq_) const {
        int fr = fr_, fq = fq_; asm volatile("" : "+v"(fr), "+v"(fq));
        const int col0 = u.pn * BM + wc * 32 + fq * 4;
#pragma unroll
        for (int ai = 0; ai < 2; ++ai)
#pragma unroll
            for (int m = 0; m < 4; ++m) { bf16_t* rowp = O + (size_t)(u.pm * BM + ai * HALF + wr * 64 + m * 16 + fr) * ldc + col0;
#pragma unroll
                for (int bj = 0; bj < 2; ++bj)
#pragma unroll
                    for (int n = 0; n < 2; ++n) { f32x4 v = acc[ai][bj][m][n];
                        if (ACT == 1) { v = __builtin_elementwise_max(v, (f32x4){0.f, 0.f, 0.f, 0.f}); v = v * v; }
                        *(u32x2*)(rowp + bj * HALF + n * 16) = f32_to_bf4(v); } }
    }
};

struct EpiSlabCtx {
    static constexpr bool WITH_LDS = false;
    bf16_t* S; int ksz;
    __device__ __forceinline__ void operator()(const f32x4 (&acc)[2][2][4][2], const Unit& u, int wr, int wc, int fr_, int fq_) const {
        int fr = fr_, fq = fq_; asm volatile("" : "+v"(fr), "+v"(fq));
        const int col0 = u.pn * BM + wc * 32 + fq * 4;
        bf16_t* base = S + (size_t)(u.koff / ksz) * MC * DM;
#pragma unroll
        for (int ai = 0; ai < 2; ++ai)
#pragma unroll
            for (int m = 0; m < 4; ++m) { bf16_t* rowp = base + (size_t)(u.pm * BM - ML + ai * HALF + wr * 64 + m * 16 + fr) * DM + col0;
#pragma unroll
                for (int bj = 0; bj < 2; ++bj)
#pragma unroll
                    for (int n = 0; n < 2; ++n) *(u32x2*)(rowp + bj * HALF + n * 16) = f32_to_bf4(acc[ai][bj][m][n]); }
    }
};

struct EpiQKV {
    static constexpr bool WITH_LDS = false;
    bf16_t* Q; bf16_t* Kb; bf16_t* VT; bf16_t* VTC; const float* rope;
    __device__ __forceinline__ void operator()(const f32x4 (&acc)[2][2][4][2], const Unit& u, int wr, int wc, int fr_, int fq_) const {
        int fr = fr_, fq = fq_; asm volatile("" : "+v"(fr), "+v"(fq));
        const bool lat = u.pm < 64;
        if (u.pn < 5) {
#pragma unroll
            for (int ai = 0; ai < 2; ++ai)
#pragma unroll
                for (int m = 0; m < 4; ++m) {
                    const int row = u.pm * BM + ai * HALF + wr * 64 + m * 16 + fr;
                    f32x4 cs0 = {1.f, 0.f, 1.f, 0.f}, cs1 = {1.f, 0.f, 1.f, 0.f};
                    if (lat) { const int t = row & 2047; const int pos = (wc & 1) ? (t & 63) : (t >> 6); const f32x4* pp = (const f32x4*)(rope + (pos * 16 + 4 * fq) * 2); cs0 = pp[0]; cs1 = pp[1]; }
                    const f32x4 cv = {cs0[0], cs0[2], cs1[0], cs1[2]}, sv = {cs0[1], cs0[3], cs1[1], cs1[3]};
#pragma unroll
                    for (int bj = 0; bj < 2; ++bj) {
                        const f32x4 a = acc[ai][bj][m][0], b = acc[ai][bj][m][1];
                        f32x4 na = a * cv - b * sv, nb = b * cv + a * sv;
                        if (u.pn < 4) { na = na * 0.125f; nb = nb * 0.125f;
                            bf16_t* d = Q + (size_t)row * 1024 + u.pn * 256 + bj * HALF + wc * 32 + fq * 4;
                            *(u32x2*)d = f32_to_bf4(na); *(u32x2*)(d + 16) = f32_to_bf4(nb);
                        } else {
                            bf16_t* d = Kb + (size_t)row * 256 + bj * HALF + wc * 32 + fq * 4;
                            *(u32x2*)d = f32_to_bf4(na); *(u32x2*)(d + 16) = f32_to_bf4(nb);
                        }
                    }
                }
        } else {
#pragma unroll
            for (int ai = 0; ai < 2; ++ai)
#pragma unroll
                for (int m = 0; m < 4; ++m) {
                    const int row = u.pm * BM + ai * HALF + wr * 64 + m * 16 + fr;
                    bf16_t* base; size_t stride;
                    if (lat) { const int b = row >> 11, t = row & 2047; base = VT + (size_t)b * 256 * 2048 + t; stride = 2048; }
                    else { const int rc = row - ML; const int b = rc >> 8, t = rc & 255; base = VTC + (size_t)b * 256 * 256 + t; stride = 256; }
#pragma unroll
                    for (int bj = 0; bj < 2; ++bj)
#pragma unroll
                        for (int n = 0; n < 2; ++n)
#pragma unroll
                            for (int j = 0; j < 4; ++j) { const int vc = bj * HALF + wc * 32 + n * 16 + fq * 4 + j; base[(size_t)vc * stride] = (bf16_t)f2bf(acc[ai][bj][m][n][j]); }
                }
        }
    }
};

struct EpiInProj {
    static constexpr bool WITH_LDS = false;
    bf16_t* R; bf16_t* GB;
    __device__ __forceinline__ void operator()(const f32x4 (&acc)[2][2][4][2], const Unit& u, int wr, int wc, int fr_, int fq_) const {
        int fr = fr_, fq = fq_; asm volatile("" : "+v"(fr), "+v"(fq));
        const bool rec = u.pn >= 5;
        const int col0 = (rec ? (u.pn - 5) * BM : 0) + wc * 32 + fq * 4; const int ldc = rec ? DRNN : 256; bf16_t* O = rec ? R : GB;
#pragma unroll
        for (int ai = 0; ai < 2; ++ai)
#pragma unroll
            for (int m = 0; m < 4; ++m) { bf16_t* rowp = O + (size_t)(u.pm * BM + ai * HALF + wr * 64 + m * 16 + fr) * ldc + col0;
#pragma unroll
                for (int bj = 0; bj < 2; ++bj)
#pragma unroll
                    for (int n = 0; n < 2; ++n) { f32x4 v = acc[ai][bj][m][n];
                        if (!rec) {
#pragma unroll
                            for (int j = 0; j < 4; ++j) { const float x = v[j]; v[j] = x * fsigmoid(1.5957691216057308f * (x + 0.044715f * x * x * x)); } }
                        *(u32x2*)(rowp + bj * HALF + n * 16) = f32_to_bf4(v); } }
    }
};

struct EpiGates {
    static constexpr bool WITH_LDS = false;
    const bf16_t* U; bf16_t* LA; bf16_t* BX; const float* ba; const float* bi; const float* nls;
    __device__ __forceinline__ void operator()(const f32x4 (&acc)[2][2][4][2], const Unit& u, int wr, int wc, int fr_, int fq_) const {
        int fr = fr_, fq = fq_; asm volatile("" : "+v"(fr), "+v"(fq));
        const int tile = u.pn >> 1, dir = tile / 5, blk = tile % 5, chalf = u.pn & 1;
        const int ch0 = blk * 256 + chalf * 128 + wc * 32 + fq * 4;
#pragma unroll
        for (int n = 0; n < 2; ++n) {
            const int ch = ch0 + n * 16;
            const f32x4 bav = *(const f32x4*)(ba + dir * DRNN + ch), biv = *(const f32x4*)(bi + dir * DRNN + ch), nl = *(const f32x4*)(nls + dir * DRNN + ch);
#pragma unroll
            for (int ai = 0; ai < 2; ++ai)
#pragma unroll
                for (int m = 0; m < 4; ++m) {
                    const int rin = ai * HALF + wr * 64 + m * 16 + fr;
                    const size_t rowg = (size_t)u.pm * BM + rin, rowl = (size_t)u.po * BM + rin;
                    const f32x4 uv = bf4_to_f32(*(const u32x2*)(U + rowg * DRNN + ch));
                    f32x4 lav, bxv;
#pragma unroll
                    for (int j = 0; j < 4; ++j) {
                        const float r = fsigmoid(acc[ai][0][m][n][j] + bav[j]);
                        const float ig = fsigmoid(acc[ai][1][m][n][j] + biv[j]);
                        const float la = nl[j] * r, x = 2.0f * la;
                        float om;
                        if (x > -0.5f) { float q = 1.0f / 720.0f; q = q * x + 1.0f / 120.0f; q = q * x + 1.0f / 24.0f; q = q * x + 1.0f / 6.0f; q = q * x + 0.5f; q = q * x + 1.0f; om = -x * q; }
                        else om = 1.0f - __expf(x);
                        lav[j] = la; bxv[j] = __builtin_amdgcn_sqrtf(om) * (ig * uv[j]);
                    }
                    const size_t o = ((size_t)dir * 9216 + rowl) * DRNN + ch;
                    *(u32x2*)(LA + o) = f32_to_bf4(lav); *(u32x2*)(BX + o) = f32_to_bf4(bxv);
                    asm volatile("" ::: "memory");
                }
        }
    }
};

#define SC_STEP(d) \
    "v_fmac_f32_dpp %1, %1, %0 row_shr:" #d " row_mask:0xf bank_mask:0xf\n\t" "v_mul_f32_dpp %0, %0, %0 row_shr:" #d " row_mask:0xf bank_mask:0xf\n\t" \
    "v_fmac_f32_dpp %3, %3, %2 row_shr:" #d " row_mask:0xf bank_mask:0xf\n\t" "v_mul_f32_dpp %2, %2, %2 row_shr:" #d " row_mask:0xf bank_mask:0xf\n\t" \
    "v_fmac_f32_dpp %5, %5, %4 row_shr:" #d " row_mask:0xf bank_mask:0xf\n\t" "v_mul_f32_dpp %4, %4, %4 row_shr:" #d " row_mask:0xf bank_mask:0xf\n\t" \
    "v_fmac_f32_dpp %7, %7, %6 row_shr:" #d " row_mask:0xf bank_mask:0xf\n\t" "v_mul_f32_dpp %6, %6, %6 row_shr:" #d " row_mask:0xf bank_mask:0xf\n\t"
__device__ __forceinline__ void scan16x4(float& a0, float& b0, float& a1, float& b1, float& a2, float& b2, float& a3, float& b3) {
    asm volatile("s_nop 1\n\t" SC_STEP(1) SC_STEP(2) SC_STEP(4) SC_STEP(8)
                 : "+v"(a0), "+v"(b0), "+v"(a1), "+v"(b1), "+v"(a2), "+v"(b2), "+v"(a3), "+v"(b3));
}
struct EpiGatesScan {
    static constexpr bool WITH_LDS = true;
    const bf16_t* U; bf16_t* RECF; bf16_t* RECB; const float* ba; const float* bi; const float* nls; float* CARRY; unsigned* FLAG;
    __device__ __forceinline__ void run(f32x4 (&acc)[2][2][4][2], const Unit& u, int wr, int wc, int lane_, LAS unsigned char* lds) const {
        int lane = lane_; asm volatile("" : "+v"(lane));
        const int fr = lane & 15, fq = lane >> 4;
        LAS float* carry = (LAS float*)(lds + 131072);
        const int tile = u.pn >> 1, dir = tile / 5, blk = tile % 5, chalf = u.pn & 1;
        const int ch0 = blk * 256 + chalf * 128 + wc * 32 + fq * 4;
        const int rmask = dir ? 255 : 0;
        bf16_t* REC = dir ? RECB : RECF;
#pragma unroll
        for (int n = 0; n < 2; ++n) {
            const int ch = ch0 + n * 16;
            const f32x4 bav2 = *(const f32x4*)(ba + dir * DRNN + ch) * (-LOG2E), biv2 = *(const f32x4*)(bi + dir * DRNN + ch) * (-LOG2E), nl = *(const f32x4*)(nls + dir * DRNN + ch);
            const f32x4 nl2 = nl * LOG2E, nlx = nl * 2.0f;
#pragma unroll
            for (int ai = 0; ai < 2; ++ai)
#pragma unroll
                for (int m = 0; m < 4; ++m) {
                    const size_t rowg = (size_t)u.pm * BM + ((ai * HALF + wr * 64 + m * 16 + fr) ^ rmask);
                    const f32x4 uv = bf4_to_f32(*(const u32x2*)(U + rowg * DRNN + ch));
                    float av[4], bv[4];
#pragma unroll
                    for (int j = 0; j < 4; ++j) {
                        const float r = __builtin_amdgcn_rcpf(1.0f + __builtin_amdgcn_exp2f(acc[ai][0][m][n][j] * (-LOG2E) + bav2[j]));
                        const float ig = __builtin_amdgcn_rcpf(1.0f + __builtin_amdgcn_exp2f(acc[ai][1][m][n][j] * (-LOG2E) + biv2[j]));
                        const float x = nlx[j] * r, a = __builtin_amdgcn_exp2f(nl2[j] * r);
                        const float om = (x > -0.0625f) ? -x * (1.0f + x * (0.5f + x * (1.0f / 6.0f + x * (1.0f / 24.0f)))) : 1.0f - a * a;
                        av[j] = a; bv[j] = __builtin_amdgcn_sqrtf(om) * (ig * uv[j]);
                    }
                    scan16x4(av[0], bv[0], av[1], bv[1], av[2], bv[2], av[3], bv[3]);
#pragma unroll
                    for (int j = 0; j < 4; ++j) { acc[ai][0][m][n][j] = av[j]; acc[ai][1][m][n][j] = bv[j]; }
                    __builtin_amdgcn_sched_barrier(0);
                }
        }
        const int tid_ = threadIdx.x;
        if (u.po > 0 && tid_ < 64) {
            unsigned* fl = FLAG + (size_t)(u.lin - 160) * 16; unsigned sp = 0;
            while (__hip_atomic_load(fl, __ATOMIC_RELAXED, __HIP_MEMORY_SCOPE_AGENT) == 0u) { __builtin_amdgcn_s_sleep(2); if (++sp > (1u << 22)) break; }
        }
        asm volatile("s_waitcnt vmcnt(0) lgkmcnt(0)" ::: "memory"); __builtin_amdgcn_s_barrier(); asm volatile("" ::: "memory");
        if (tid_ < 128) carry[tid_] = (u.po > 0) ? __hip_atomic_load(CARRY + (size_t)(u.lin - 160) * 128 + tid_, __ATOMIC_RELAXED, __HIP_MEMORY_SCOPE_AGENT) : 0.0f;
        asm volatile("s_waitcnt vmcnt(0) lgkmcnt(0)" ::: "memory"); __builtin_amdgcn_s_barrier(); asm volatile("" ::: "memory");
        const bool emit = u.pm < 64;
        const int lastl = (lane & 48) | 15;
#pragma unroll
        for (int seg = 0; seg < 4; ++seg) {
            const int ai = seg >> 1, wrs = seg & 1;
            if (wr == wrs) {
                f32x4 hg[2];
#pragma unroll
                for (int n = 0; n < 2; ++n) hg[n] = *(const LAS f32x4*)(carry + wc * 32 + n * 16 + fq * 4);
#pragma unroll
                for (int m = 0; m < 4; ++m) {
                    f32x4 h[2];
#pragma unroll
                    for (int n = 0; n < 2; ++n) h[n] = acc[ai][0][m][n] * hg[n] + acc[ai][1][m][n];
                    if (emit) { bf16_t* rp = REC + ((size_t)u.pm * BM + ((ai * HALF + wr * 64 + m * 16 + fr) ^ rmask)) * DRNN + ch0;
#pragma unroll
                        for (int n = 0; n < 2; ++n) *(u32x2*)(rp + n * 16) = f32_to_bf4(h[n]); }
#pragma unroll
                    for (int n = 0; n < 2; ++n)
#pragma unroll
                        for (int j = 0; j < 4; ++j) hg[n][j] = __shfl(h[n][j], lastl);
                }
                if (fr == 0) {
#pragma unroll
                    for (int n = 0; n < 2; ++n) *(LAS f32x4*)(carry + wc * 32 + n * 16 + fq * 4) = hg[n];
                }
            }
            asm volatile("s_waitcnt lgkmcnt(0)" ::: "memory"); __builtin_amdgcn_s_barrier(); asm volatile("" ::: "memory");
        }
        if (u.po < 8) {
            if (tid_ < 128) __hip_atomic_store(CARRY + (size_t)u.lin * 128 + tid_, carry[tid_], __ATOMIC_RELAXED, __HIP_MEMORY_SCOPE_AGENT);
            asm volatile("s_waitcnt vmcnt(0) lgkmcnt(0)" ::: "memory"); __builtin_amdgcn_s_barrier(); asm volatile("" ::: "memory");
            if (tid_ == 0) __hip_atomic_store(FLAG + (size_t)u.lin * 16, 1u, __ATOMIC_RELAXED, __HIP_MEMORY_SCOPE_AGENT);
        }
    }
};

struct EpiGateMul {
    static constexpr bool WITH_LDS = false;
    bf16_t* Z; const bf16_t* RB;
    __device__ __forceinline__ void operator()(const f32x4 (&acc)[2][2][4][2], const Unit& u, int wr, int wc, int fr_, int fq_) const {
        int fr = fr_, fq = fq_; asm volatile("" : "+v"(fr), "+v"(fq));
        const int col0 = u.pn * BM + wc * 32 + fq * 4;
#pragma unroll
        for (int ai = 0; ai < 2; ++ai)
#pragma unroll
            for (int m = 0; m < 4; ++m) { bf16_t* rowp = Z + (size_t)(u.pm * BM + ai * HALF + wr * 64 + m * 16 + fr) * DRNN + col0;
#pragma unroll
                for (int bj = 0; bj < 2; ++bj)
#pragma unroll
                    for (int n = 0; n < 2; ++n) { const f32x4 v = acc[ai][bj][m][n]; const f32x4 rc = bf4_to_f32(*(const u32x2*)(rowp + bj * HALF + n * 16)) + bf4_to_f32(*(const u32x2*)(RB + (rowp - Z) + bj * HALF + n * 16)); f32x4 o;
#pragma unroll
                        for (int j = 0; j < 4; ++j) { const float x = v[j]; const float z2 = 1.5957691216057308f * (x + 0.044715f * x * x * x); o[j] = x * fsigmoid(z2) * rc[j]; }
                        *(u32x2*)(rowp + bj * HALF + n * 16) = f32_to_bf4(o); }
                asm volatile("" ::: "memory"); }
    }
};
}


#define XB_TMO      128
#define XB_XCNT(j)  (256  + 64 * (j))
#define XB_XSUB(j)  (1280 + 64 * (j))
#define XB_XGEN(j)  (2304 + 64 * (j))
#define XB_TOP      3328
#define XB_TOPGEN   3392
#define XCD_BAR_WORDS 3456
#define XB_SPIN_CAP (1u << 18)
__device__ __forceinline__ unsigned xb_ld(unsigned* p)              { return __hip_atomic_load(p, __ATOMIC_RELAXED, __HIP_MEMORY_SCOPE_AGENT); }
__device__ __forceinline__ unsigned xb_add(unsigned* p, unsigned v) { return __hip_atomic_fetch_add(p, v, __ATOMIC_RELAXED, __HIP_MEMORY_SCOPE_AGENT); }
__device__ __forceinline__ unsigned xb_xcc_id() { return (unsigned)__builtin_amdgcn_s_getreg((3 << 11) | 20) & 0xFu; }
#define XB_SPIN(cond, bar) do { unsigned _sp = 0; while (cond) { __builtin_amdgcn_s_sleep(1); \
    if ((++_sp & 255u) == 0u) { if (xb_ld(&(bar)[XB_TMO])) break; if (_sp > XB_SPIN_CAP) { atomicAdd(&(bar)[XB_TMO], 1u); break; } } } } while (0)
struct XcdBarrier { unsigned* bar; unsigned x; volatile LAS unsigned* st; };
__device__ __forceinline__ XcdBarrier xcd_barrier_post(unsigned* bar, volatile LAS unsigned* st) {
    XcdBarrier b; b.bar = bar; b.x = xb_xcc_id(); b.st = st;
    if (threadIdx.x == 0) (void)xb_add(&bar[XB_XCNT(b.x)], 1u);
    return b;
}
__device__ __forceinline__ void xcd_barrier_complete(unsigned* bar, unsigned x, unsigned& nloc, unsigned& nx) {
    const unsigned G = gridDim.x * gridDim.y * gridDim.z;
    unsigned sum, cnt, mine, sp = 0u;
    for (;;) {
        sum = 0u; cnt = 0u; mine = 0u;
#pragma unroll
        for (unsigned j = 0; j < 16; ++j) { const unsigned c = xb_ld(&bar[XB_XCNT(j)]); sum += c; cnt += (c > 0u) ? 1u : 0u; mine = (j == x) ? c : mine; }
        if (sum == G) break;
        __builtin_amdgcn_s_sleep(1);
        if ((++sp & 255u) == 0u) { if (xb_ld(&bar[XB_TMO])) break; if (sp > XB_SPIN_CAP) { atomicAdd(&bar[XB_TMO], 1u); break; } }
    }
    nloc = mine > 0u ? mine : 1u; nx = cnt > 0u ? cnt : 1u;
}
__device__ __forceinline__ void xcd_barrier(const XcdBarrier& b) {
    asm volatile("s_waitcnt vmcnt(0)" ::: "memory");
    __syncthreads();
    if (threadIdx.x == 0) {
        unsigned* bar = b.bar;
        __builtin_amdgcn_s_waitcnt(0);
        unsigned nloc = b.st[0], nx = b.st[1];
        if (nloc == 0u) { xcd_barrier_complete(bar, b.x, nloc, nx); b.st[0] = nloc; b.st[1] = nx; }
        const unsigned old = xb_add(&bar[XB_XSUB(b.x)], 1u);
        const unsigned gen = old / nloc;
        if (old + 1u == (gen + 1u) * nloc) {
            __builtin_amdgcn_fence(__ATOMIC_RELEASE, "agent");
            asm volatile("s_waitcnt vmcnt(0)" ::: "memory");
            const unsigned og = xb_add(&bar[XB_TOP], 1u);
            const unsigned tg = og / nx;
            if (og + 1u == (tg + 1u) * nx) xb_add(&bar[XB_TOPGEN], 1u);
            else XB_SPIN(xb_ld(&bar[XB_TOPGEN]) == tg, bar);
            __builtin_amdgcn_fence(__ATOMIC_ACQUIRE, "agent");
            xb_add(&bar[XB_XGEN(b.x)], 1u);
            asm volatile("s_waitcnt vmcnt(0)" ::: "memory");
        } else {
            XB_SPIN(xb_ld(&bar[XB_XGEN(b.x)]) == gen, bar);
            __builtin_amdgcn_fence(__ATOMIC_ACQUIRE, "agent");
            asm volatile("s_waitcnt vmcnt(0)" ::: "memory");
        }
    }
    __syncthreads();
}

struct Params {
    const float *x, *c, *ctx, *c_ctx, *ada_w, *ada_b, *norm_g, *mlp_w1, *mlp_w2, *w_qkv, *w_o, *sink;
    const float *w_in, *conv_w, *conv_b, *w_a, *b_a, *w_i, *b_i, *lam, *w_out;
    float* out; unsigned char* ws;
};

typedef const __attribute__((address_space(4))) Params* ParamsK;
__device__ __forceinline__ void transpose_item(const float* W, int ldw, bf16_t* WT, int ldwt, int k0, int n0, int dst_row0, LAS float* scr, int lane) {
#pragma unroll 8
    for (int i = 0; i < 32; ++i) { const int kk = 2 * i + (lane >> 5); scr[kk * 33 + (lane & 31)] = W[(size_t)(k0 + kk) * ldw + n0 + (lane & 31)]; }
    asm volatile("s_waitcnt lgkmcnt(0)" ::: "memory");
    const int c = lane & 7;
#pragma unroll
    for (int j = 0; j < 4; ++j) { const int n = (lane >> 3) + 8 * j; const LAS float* s = scr + (8 * c) * 33 + n;
        u32x4 o; o.x = cvt_pk_bf16(s[0 * 33], s[1 * 33]); o.y = cvt_pk_bf16(s[2 * 33], s[3 * 33]); o.z = cvt_pk_bf16(s[4 * 33], s[5 * 33]); o.w = cvt_pk_bf16(s[6 * 33], s[7 * 33]);
        *(u32x4*)(WT + (size_t)(dst_row0 + n) * ldwt + k0 + 8 * c) = o; }
    asm volatile("s_waitcnt lgkmcnt(0)" ::: "memory");
}
__device__ __forceinline__ void transpose_plain(const float* W, int K, int N, bf16_t* WT, int r, LAS float* scr, int lane) {
    const int nblk = N / 32, kb = r / nblk, nb = r % nblk;
    transpose_item(W, N, WT, K, 64 * kb, 32 * nb, 32 * nb, scr, lane);
}

__device__ __forceinline__ void prologue(ParamsK p, LAS unsigned char* lds, int tid, int lane, int wave) {
    unsigned char* ws = p->ws;
    float* MOD = (float*)(ws + WS_MOD);
    if (blockIdx.x < 96) {
        LAS float* sl = (LAS float*)lds;
        LAS float* red = (LAS float*)(lds + 36864);
        for (int idx = tid; idx < 9216; idx += 512) { const int w = idx >> 10, k = idx & 1023; const float v = (w < 8) ? p->c[w * 1024 + k] : p->c_ctx[k]; sl[idx] = v / (1.0f + __expf(-v)); }
        __syncthreads();
        const int l = blockIdx.x / 48, n0 = (blockIdx.x % 48) * 128, kg = tid >> 5, cq = tid & 31;
        f32x4 acc[9];
#pragma unroll
        for (int w = 0; w < 9; ++w) acc[w] = (f32x4){0.f, 0.f, 0.f, 0.f};
        const float* wb = p->ada_w + (size_t)l * 1024 * 6144 + n0 + cq * 4;
#pragma unroll 4
        for (int it = 0; it < 64; ++it) { const int k = it * 16 + kg; const f32x4 w4 = *(const f32x4*)(wb + (size_t)k * 6144);
#pragma unroll
            for (int w = 0; w < 9; ++w) acc[w] += sl[w * 1024 + k] * w4; }
#pragma unroll
        for (int w = 0; w < 9; ++w) *(LAS f32x4*)(red + (kg * 9 + w) * 128 + cq * 4) = acc[w];
        __syncthreads();
        for (int idx = tid; idx < 9 * 128; idx += 512) { const int w = idx >> 7, n = idx & 127; float s = 0.f;
#pragma unroll
            for (int g = 0; g < 16; ++g) s += red[(g * 9 + w) * 128 + n];
            MOD[(size_t)(l * 9 + w) * 6144 + n0 + n] = s + p->ada_b[l * 6144 + n0 + n]; }
        __syncthreads();
    }
    if (blockIdx.x == gridDim.x - 1) {
        float* rope = (float*)(ws + WS_ROPE); float* nls = (float*)(ws + WS_NLS);
        for (int idx = tid; idx < 1024; idx += 512) { const int pos = idx >> 4, i = idx & 15;
            const float inv = __builtin_exp2f(-(float)i * (13.287712379549449f / 16.0f));
            const float angf = (float)pos * inv; const double ang = (double)angf;
            const double twopi = 6.283185307179586476925287; const double r = ang - twopi * __builtin_rint(ang / twopi);
            const double r2 = r * r; double cterm = 1.0, sterm = r, cs = 1.0, sn = r;
            for (int k = 1; k <= 14; ++k) { cterm *= -r2 / (double)((2 * k - 1) * (2 * k)); sterm *= -r2 / (double)((2 * k) * (2 * k + 1)); cs += cterm; sn += sterm; }
            rope[idx * 2] = (float)cs; rope[idx * 2 + 1] = (float)sn; }
        for (int idx = tid; idx < 2 * DRNN; idx += 512) { const float lm = p->lam[idx]; nls[idx] = -8.0f * log1pf(__expf(-lm)); }
        { unsigned* fl = (unsigned*)(ws + WS_FLAG); for (int idx = tid; idx < 1440 * 16; idx += 512) fl[idx] = 0u; }
    }
    LAS float* scr = (LAS float*)(lds + wave * 16384);
    const int gw = blockIdx.x * 8 + wave, NGW = gridDim.x * 8;
    constexpr int I_QKV = 16 * 48, I_O = 16 * 32, I_1 = 16 * 128, I_2 = 64 * 32, I_IN = 16 * 80, I_OUT = 20 * 32, I_G = 40 * 16;
    constexpr int NITEMS = I_QKV + I_O + 2 * I_1 + 2 * I_2 + I_IN + I_OUT + I_G;
    for (int it = gw; it < NITEMS; it += NGW) {
        int r = it;
        if (r < I_QKV) { transpose_plain(p->w_qkv, 1024, NQKV, (bf16_t*)(ws + WS_WQKV), r, scr, lane); continue; } r -= I_QKV;
        if (r < I_O) { transpose_plain(p->w_o, 1024, 1024, (bf16_t*)(ws + WS_WO), r, scr, lane); continue; } r -= I_O;
        if (r < 2 * I_1) { const int l = r / I_1; transpose_plain(p->mlp_w1 + (size_t)l * 1024 * DFF, 1024, DFF, (bf16_t*)(ws + WS_W1 + (size_t)l * 16 * MiB), r % I_1, scr, lane); continue; } r -= 2 * I_1;
        if (r < 2 * I_2) { const int l = r / I_2; transpose_plain(p->mlp_w2 + (size_t)l * 1024 * DFF, DFF, 1024, (bf16_t*)(ws + WS_W2 + (size_t)l * 16 * MiB), r % I_2, scr, lane); continue; } r -= 2 * I_2;
        if (r < I_IN) { transpose_plain(p->w_in, 1024, 2 * DRNN, (bf16_t*)(ws + WS_WIN), r, scr, lane); continue; } r -= I_IN;
        if (r < I_OUT) { transpose_plain(p->w_out, DRNN, 1024, (bf16_t*)(ws + WS_WOUT), r, scr, lane); continue; } r -= I_OUT;
        {
            const int sm = r >> 4, ii = r & 15, kb = ii >> 2, nb = ii & 3;
            const int chalf = sm & 1, blk = (sm >> 1) % 5, dg = (sm >> 1) / 5, gate = dg & 1, dir = dg >> 1;
            const float* W = (gate ? p->w_i : p->w_a) + (size_t)(dir * 5 + blk) * 256 * 256;
            const int dst_row0 = ((dir * 5 + blk) * 2 + chalf) * 256 + gate * 128 + nb * 32;
            transpose_item(W, 256, (bf16_t*)(ws + WS_WG), 256, 64 * kb, chalf * 128 + nb * 32, dst_row0, scr, lane);
        }
    }
}

template <bool HAS_Y, bool HAS_H>
__device__ __forceinline__ void row_phase(const float* xin_lat, const float* xin_ctx, float* xout_lat, float* xout_ctx, const bf16_t* Y, const bf16_t* SLAB, bf16_t* H,
                                          const float* gy, const float* gh, const float* mod_g, int gate_idx, const float* mod_h, int shift_idx, int scale_idx,
                                          int nrows, int gw, int ngw, int lane) {
    const int rpw = (nrows + ngw - 1) / ngw, r_begin = gw * rpw, r_end = (r_begin + rpw < nrows) ? r_begin + rpw : nrows;
    f32x4 xn[4]; u32x2 yn[4], ys[3][4];
    f32x4 vgy[4], vgh[4], vgt[4], vsh[4], vsc[4];
#pragma unroll
    for (int j = 0; j < 4; ++j) { if (HAS_Y) vgy[j] = *(const f32x4*)(gy + lane * 4 + 256 * j); if (HAS_H) vgh[j] = *(const f32x4*)(gh + lane * 4 + 256 * j); }
    int cur_who = -1;
#define ROW_LOAD(r) do { const int r_ = (r); const bool lat_ = r_ < ML; \
        const float* xi_ = lat_ ? xin_lat + (size_t)r_ * DM : xin_ctx + (size_t)(r_ - ML) * DM; \
        _Pragma("unroll") for (int j = 0; j < 4; ++j) xn[j] = *(const f32x4*)(xi_ + lane * 4 + 256 * j); \
        if (HAS_Y) { if (SLAB != nullptr && !lat_) { const bf16_t* yp_ = SLAB + (size_t)(r_ - ML) * DM + lane * 4; \
                _Pragma("unroll") for (int j = 0; j < 4; ++j) { yn[j] = *(const u32x2*)(yp_ + 256 * j); ys[0][j] = *(const u32x2*)(yp_ + 256 * j + (size_t)MC * DM); ys[1][j] = *(const u32x2*)(yp_ + 256 * j + (size_t)2 * MC * DM); ys[2][j] = *(const u32x2*)(yp_ + 256 * j + (size_t)3 * MC * DM); } } \
            else { _Pragma("unroll") for (int j = 0; j < 4; ++j) yn[j] = *(const u32x2*)(Y + (size_t)r_ * DM + lane * 4 + 256 * j); } } } while (0)
    if (r_begin < r_end) ROW_LOAD(r_begin);
    for (int row = r_begin; row < r_end; ++row) {
        const bool lat = row < ML; const int who = lat ? (row >> 11) : 8;
        if (who != cur_who) { cur_who = who;
#pragma unroll
            for (int j = 0; j < 4; ++j) { const int col = lane * 4 + 256 * j;
                if (HAS_Y) vgt[j] = *(const f32x4*)(mod_g + (size_t)who * 6144 + gate_idx * 1024 + col);
                if (HAS_H) { vsh[j] = *(const f32x4*)(mod_h + (size_t)who * 6144 + shift_idx * 1024 + col); vsc[j] = *(const f32x4*)(mod_h + (size_t)who * 6144 + scale_idx * 1024 + col) + 1.0f; } } }
        f32x4 xv[4], yv[4];
#pragma unroll
        for (int j = 0; j < 4; ++j) xv[j] = xn[j];
        if (HAS_Y) {
#pragma unroll
            for (int j = 0; j < 4; ++j) { yv[j] = bf4_to_f32(yn[j]);
                if (SLAB != nullptr && !lat) yv[j] = (yv[j] + bf4_to_f32(ys[0][j])) + (bf4_to_f32(ys[1][j]) + bf4_to_f32(ys[2][j])); }
        }
        asm volatile("" ::: "memory");
        if (row + 1 < r_end) ROW_LOAD(row + 1);
        if (HAS_Y) {
            float s = 0.f;
#pragma unroll
            for (int j = 0; j < 4; ++j) s += (yv[j][0] * yv[j][0] + yv[j][1] * yv[j][1]) + (yv[j][2] * yv[j][2] + yv[j][3] * yv[j][3]);
            const float rstd = 1.0f / sqrtf(wave_sum(s) * (1.0f / DM) + EPS);
            float* xo = lat ? xout_lat + (size_t)row * DM : xout_ctx + (size_t)(row - ML) * DM;
#pragma unroll
            for (int j = 0; j < 4; ++j) { xv[j] = xv[j] + vgt[j] * (yv[j] * rstd * vgy[j]); *(f32x4*)(xo + lane * 4 + 256 * j) = xv[j]; }
        }
        if (HAS_H) {
            float s = 0.f;
#pragma unroll
            for (int j = 0; j < 4; ++j) s += (xv[j][0] * xv[j][0] + xv[j][1] * xv[j][1]) + (xv[j][2] * xv[j][2] + xv[j][3] * xv[j][3]);
            const float rstd = 1.0f / sqrtf(wave_sum(s) * (1.0f / DM) + EPS);
#pragma unroll
            for (int j = 0; j < 4; ++j) { const f32x4 hv = (xv[j] * rstd * vgh[j]) * vsc[j] + vsh[j]; *(u32x2*)(H + (size_t)row * DM + lane * 4 + 256 * j) = f32_to_bf4(hv); }
        }
    }
#undef ROW_LOAD
}

__device__ __forceinline__ void attn_phase(LAS unsigned char* lds, const bf16_t* Q, bf16_t* O, const bf16_t* Kb, const bf16_t* VT, const bf16_t* VTC, const float* sink, int tid, int lane, int wave) {
    constexpr int PITCH = 72;
    LAS bf16_t* Ks = (LAS bf16_t*)lds;
    LAS bf16_t* Vs = (LAS bf16_t*)(lds + 2 * 64 * PITCH * 2);
    const int lr = lane & 15, lg = lane >> 4;
    const int skey = tid >> 3, spiece = tid & 7;
    for (int unit = blockIdx.x; unit < 576; unit += gridDim.x) {
        int b, kvh, qrow0, qblk, nloc, lt0; bool latu = unit < 512;
        if (latu) { b = unit >> 6; const int rem = unit & 63; qblk = rem >> 2; kvh = rem & 3; qrow0 = b * SEQ + qblk * 128; lt0 = (qblk == 0) ? 2 : 0; nloc = ((qblk == 15) ? 4 : 6) - lt0; }
        else { const int cu = unit - 512; b = cu >> 3; kvh = (cu & 7) >> 1; qblk = 0; qrow0 = ML + b * CTX + (cu & 1) * 128; lt0 = 0; nloc = 0; }
        const int nlo = (latu && qblk > 0) ? 2 : 0, nmid = latu ? 2 : 0, nup = (latu && qblk < 15) ? 2 : 0;
        const int n1 = nlo, n2 = nlo + nmid, n3 = n2 + 4, nT = n3 + nup; (void)nloc; (void)lt0;
        const int head = kvh * 4 + (wave >> 1);
        const int qr0 = qrow0 + (wave & 1) * 64;
        const bf16_t* qbase = Q + (size_t)qr0 * 1024 + head * 64;
        bf16_t* obase = O + (size_t)qr0 * 1024 + head * 64;
        LAS unsigned char* Qs = lds + 40960 + wave * 8192;
#pragma unroll
        for (int qt = 0; qt < 4; ++qt)
#pragma unroll
            for (int dh = 0; dh < 2; ++dh) *(LAS bf16x8*)(Qs + (qt * 2 + dh) * 1024 + lane * 16) = *(const bf16x8*)(qbase + (unsigned)((qt * 16 + lr) * 1024 + dh * 32 + lg * 8));
        f32x4 o[4][4];
#pragma unroll
        for (int qt = 0; qt < 4; ++qt)
#pragma unroll
            for (int dt = 0; dt < 4; ++dt) o[qt][dt] = (f32x4){0.f, 0.f, 0.f, 0.f};
        float m2[4], ls[4];
        { const float sk = sink[head] * LOG2E;
#pragma unroll
          for (int qt = 0; qt < 4; ++qt) { m2[qt] = sk; ls[qt] = (lg == 0) ? 1.0f : 0.0f; } }
        u32x4 kreg, vreg;
#define ATT_TOK0(j_) ((qblk - 1) * 128 + (((j_) < n1) ? (j_) : (((j_) < n2) ? 2 + (j_) - n1 : 4 + (j_) - n3)) * 64)
#define ATT_LOAD(j) do { const int _j = (j); if (_j < n2 || _j >= n3) { const int tok0 = ATT_TOK0(_j); \
                const bf16_t* kb_ = Kb + (size_t)(b * SEQ + tok0) * 256 + kvh * 64; const bf16_t* vb_ = VT + (size_t)(b * 4 + kvh) * 64 * SEQ + tok0; \
                kreg = *(const u32x4*)(kb_ + (unsigned)(skey * 256 + spiece * 8)); vreg = *(const u32x4*)(vb_ + (unsigned)(skey * SEQ + spiece * 8)); } \
            else { const int tok0 = (_j - n2) * 64; \
                const bf16_t* kb_ = Kb + (size_t)(ML + b * CTX + tok0) * 256 + kvh * 64; const bf16_t* vb_ = VTC + (size_t)(b * 4 + kvh) * 64 * CTX + tok0; \
                kreg = *(const u32x4*)(kb_ + (unsigned)(skey * 256 + spiece * 8)); vreg = *(const u32x4*)(vb_ + (unsigned)(skey * CTX + spiece * 8)); } } while (0)
#define ATT_STORE(buf) do { *(LAS u32x4*)(Ks + (buf) * 64 * PITCH + skey * PITCH + spiece * 8) = kreg; *(LAS u32x4*)(Vs + (buf) * 64 * PITCH + skey * PITCH + spiece * 8) = vreg; } while (0)
        __syncthreads();
        ATT_LOAD(0); ATT_STORE(0);
        __syncthreads();
#define ATT_BODY(MM) { \
            const int buf = j & 1; \
            if (j + 1 < nT) ATT_LOAD(j + 1); \
            const LAS bf16_t* Kt = Ks + buf * 64 * PITCH; const LAS bf16_t* Vt = Vs + buf * 64 * PITCH; \
            const int ktok0 = ATT_TOK0(j); \
            bf16x8 kf[4][2]; \
            _Pragma("unroll") \
            for (int ks = 0; ks < 4; ++ks) \
            _Pragma("unroll") \
                for (int dh = 0; dh < 2; ++dh) kf[ks][dh] = *(const LAS bf16x8*)(Kt + (ks * 16 + lr) * PITCH + dh * 32 + lg * 8); \
            _Pragma("unroll") \
            for (int hq = 0; hq < 2; ++hq) { \
            bf16x8 pb[2][2]; \
            _Pragma("unroll") \
            for (int q2 = 0; q2 < 2; ++q2) { \
                const int qt = hq * 2 + q2; \
                f32x4 s[4]; \
                const bf16x8 qf0 = *(const LAS bf16x8*)(Qs + (qt * 2 + 0) * 1024 + lane * 16), qf1 = *(const LAS bf16x8*)(Qs + (qt * 2 + 1) * 1024 + lane * 16); \
            _Pragma("unroll") \
                for (int ks = 0; ks < 4; ++ks) { s[ks] = __builtin_amdgcn_mfma_f32_16x16x32_bf16(kf[ks][0], qf0, (f32x4){0.f, 0.f, 0.f, 0.f}, 0, 0, 0); \
                    s[ks] = __builtin_amdgcn_mfma_f32_16x16x32_bf16(kf[ks][1], qf1, s[ks], 0, 0, 0); } \
                if (MM == 1) {    \
                    const int lim = qblk * 128 + (wave & 1) * 64 + qt * 16 + lr - 128 - ktok0 - lg * 4; \
            _Pragma("unroll") \
                    for (int ks = 0; ks < 4; ++ks) \
            _Pragma("unroll") \
                        for (int jj = 0; jj < 4; ++jj) s[ks][jj] = (ks * 16 + jj >= lim) ? s[ks][jj] : -1e30f; \
                } else if (MM == 2) {    \
                    const int lim = qblk * 128 + (wave & 1) * 64 + qt * 16 + lr + 128 - ktok0 - lg * 4; \
            _Pragma("unroll") \
                    for (int ks = 0; ks < 4; ++ks) \
            _Pragma("unroll") \
                        for (int jj = 0; jj < 4; ++jj) s[ks][jj] = (ks * 16 + jj <= lim) ? s[ks][jj] : -1e30f; \
                } \
                float mx = -3e38f; \
            _Pragma("unroll") \
                for (int ks = 0; ks < 4; ++ks) mx = fmaxf(mx, fmaxf(fmaxf(s[ks][0], s[ks][1]), fmaxf(s[ks][2], s[ks][3]))); \
                mx = fmaxf(mx, __shfl_xor(mx, 16)); mx = fmaxf(mx, __shfl_xor(mx, 32)); \
                const float mnew = fmaxf(m2[qt], mx * LOG2E); \
                const float alpha = __builtin_amdgcn_exp2f(m2[qt] - mnew); \
                m2[qt] = mnew; \
                float rs = 0.f; \
            _Pragma("unroll") \
                for (int ks = 0; ks < 4; ++ks) \
            _Pragma("unroll") \
                    for (int jj = 0; jj < 4; ++jj) { const float pv = __builtin_amdgcn_exp2f(s[ks][jj] * LOG2E - mnew); s[ks][jj] = pv; rs += pv; } \
                ls[qt] = ls[qt] * alpha + rs; \
            _Pragma("unroll") \
                for (int dt = 0; dt < 4; ++dt) o[qt][dt] = o[qt][dt] * alpha; \
            _Pragma("unroll") \
                for (int c2 = 0; c2 < 2; ++c2) { u32x4 w; w.x = cvt_pk_bf16(s[2 * c2][0], s[2 * c2][1]); w.y = cvt_pk_bf16(s[2 * c2][2], s[2 * c2][3]); w.z = cvt_pk_bf16(s[2 * c2 + 1][0], s[2 * c2 + 1][1]); w.w = cvt_pk_bf16(s[2 * c2 + 1][2], s[2 * c2 + 1][3]); \
                    pb[q2][c2] = __builtin_bit_cast(bf16x8, w); } \
            } \
            _Pragma("unroll") \
            for (int c2 = 0; c2 < 2; ++c2) \
            _Pragma("unroll") \
                for (int dt = 0; dt < 4; ++dt) { \
                    const LAS bf16_t* vp = Vt + (dt * 16 + lr) * PITCH + c2 * 32 + lg * 4; \
                    const u32x2 v0 = *(const LAS u32x2*)vp, v1 = *(const LAS u32x2*)(vp + 16); \
                    const u32x4 vv = {v0.x, v0.y, v1.x, v1.y}; \
                    const bf16x8 vf = __builtin_bit_cast(bf16x8, vv); \
            _Pragma("unroll") \
                    for (int q2 = 0; q2 < 2; ++q2) o[hq * 2 + q2][dt] = __builtin_amdgcn_mfma_f32_16x16x32_bf16(vf, pb[q2][c2], o[hq * 2 + q2][dt], 0, 0, 0); \
                } \
            } \
            if (j + 1 < nT) ATT_STORE(buf ^ 1); \
            __syncthreads(); \
        }
        int j = 0;
#pragma unroll 1
        for (; j < n1; ++j) ATT_BODY(1)
#pragma unroll 1
        for (; j < n3; ++j) ATT_BODY(0)
#pragma unroll 1
        for (; j < nT; ++j) ATT_BODY(2)
#undef ATT_BODY
#pragma unroll
        for (int qt = 0; qt < 4; ++qt) {
            float l = ls[qt]; l += __shfl_xor(l, 16); l += __shfl_xor(l, 32);
            const float inv = 1.0f / l;
            int lro = lr * 1024 + lg * 4; asm volatile("" : "+v"(lro));
            bf16_t* op = obase + (unsigned)(qt * 16 * 1024 + lro);
#pragma unroll
            for (int dt = 0; dt < 4; ++dt) *(u32x2*)(op + dt * 16) = f32_to_bf4(o[qt][dt] * inv);
        }
    }
#undef ATT_LOAD
#undef ATT_TOK0
#undef ATT_STORE
}

__device__ __forceinline__ void conv_phase(const bf16_t* R, bf16_t* U, const float* cw, const float* cb, int gtid, int nthreads) {
    for (int idx = gtid; idx < MT * 160; idx += nthreads) {
        const int row = idx / 160, ch = (idx % 160) * 8;
        int t, T; if (row < ML) { t = row & 2047; T = SEQ; } else { t = (row - ML) & 255; T = CTX; }
        float acc[8];
        { const f32x4 b0 = *(const f32x4*)(cb + ch), b1 = *(const f32x4*)(cb + ch + 4); acc[0] = b0[0]; acc[1] = b0[1]; acc[2] = b0[2]; acc[3] = b0[3]; acc[4] = b1[0]; acc[5] = b1[1]; acc[6] = b1[2]; acc[7] = b1[3]; }
#pragma unroll
        for (int tap = 0; tap < 4; ++tap) { const int tt = t + tap - 2;
            if (tt >= 0 && tt < T) { const u32x4 rv = *(const u32x4*)(R + (size_t)(row + tap - 2) * DRNN + ch);
                const f32x4 w0 = *(const f32x4*)(cw + tap * DRNN + ch), w1 = *(const f32x4*)(cw + tap * DRNN + ch + 4);
                acc[0] += w0[0] * bf_lo(rv.x); acc[1] += w0[1] * bf_hi(rv.x); acc[2] += w0[2] * bf_lo(rv.y); acc[3] += w0[3] * bf_hi(rv.y);
                acc[4] += w1[0] * bf_lo(rv.z); acc[5] += w1[1] * bf_hi(rv.z); acc[6] += w1[2] * bf_lo(rv.w); acc[7] += w1[3] * bf_hi(rv.w); } }
        u32x4 o; o.x = cvt_pk_bf16(acc[0], acc[1]); o.y = cvt_pk_bf16(acc[2], acc[3]); o.z = cvt_pk_bf16(acc[4], acc[5]); o.w = cvt_pk_bf16(acc[6], acc[7]);
        *(u32x4*)(U + (size_t)row * DRNN + ch) = o;
    }
}
__device__ __forceinline__ int scan_row0(int bl, int c) { return (c < 8) ? (8192 + bl * CTX + c * 32) : (bl * SEQ + (c - 8) * 32); }
__device__ __forceinline__ void scanA_phase(const bf16_t* LA, const bf16_t* BX, float* SP, float* SH, int gtid, int nthreads) {
    for (int idx = gtid; idx < 2 * 4 * 72 * 640; idx += nthreads) {
        const int cp = idx % 640, r1 = idx / 640, c = r1 % 72, r2 = r1 / 72, bl = r2 & 3, dir = r2 >> 2;
        const int row0 = scan_row0(bl, c);
        const size_t base = ((size_t)dir * 9216 + row0) * DRNN + cp * 2;
        float P0 = 1.f, P1 = 1.f, H0 = 0.f, H1 = 0.f;
#pragma unroll 8
        for (int i = 0; i < 32; ++i) { const int ii = dir ? (31 - i) : i;
            const unsigned lw = *(const unsigned*)(LA + base + (size_t)ii * DRNN), bw = *(const unsigned*)(BX + base + (size_t)ii * DRNN);
            const float a0 = __expf(bf_lo(lw)), a1 = __expf(bf_hi(lw));
            P0 *= a0; P1 *= a1; H0 = a0 * H0 + bf_lo(bw); H1 = a1 * H1 + bf_hi(bw); }
        const size_t so = ((size_t)(dir * 4 + bl) * 72 + c) * DRNN + cp * 2;
        *(f32x2*)(SP + so) = (f32x2){P0, P1}; *(f32x2*)(SH + so) = (f32x2){H0, H1};
    }
}
__device__ __forceinline__ void scanB_phase(const float* SP, const float* SH, float* CIN, int gtid, int nthreads) {
    for (int idx = gtid; idx < 2 * 4 * DRNN; idx += nthreads) {
        const int ch = idx % DRNN, r = idx / DRNN, bl = r & 3, dir = r >> 2;
        const size_t base = ((size_t)(dir * 4 + bl) * 72) * DRNN + ch;
        float carry = 0.f;
#pragma unroll 1
        for (int s0 = 0; s0 < 72; s0 += 24) {
            float pv[24], hv[24];
#pragma unroll
            for (int s = 0; s < 24; ++s) { const int sq = s0 + s; const int c = dir ? (sq < 8 ? 7 - sq : 79 - sq) : sq; pv[s] = SP[base + (size_t)c * DRNN]; hv[s] = SH[base + (size_t)c * DRNN]; }
#pragma unroll
            for (int s = 0; s < 24; ++s) { const int sq = s0 + s; const int c = dir ? (sq < 8 ? 7 - sq : 79 - sq) : sq; CIN[base + (size_t)c * DRNN] = carry; carry = pv[s] * carry + hv[s]; }
        }
    }
}
__device__ __forceinline__ void scanC_phase(const bf16_t* LA, const bf16_t* BX, const float* CIN, bf16_t* REC, int half, int gtid, int nthreads) {
    for (int idx = gtid; idx < 4 * 64 * 640; idx += nthreads) {
        const int cp = idx % 640, r1 = idx / 640, lc = r1 & 63, bl = r1 >> 6;
        const int row0 = bl * SEQ + lc * 32;
        const size_t b0 = ((size_t)row0) * DRNN + cp * 2, b1 = ((size_t)9216 + row0) * DRNN + cp * 2;
        const f32x2 cf = *(const f32x2*)(CIN + ((size_t)(0 * 4 + bl) * 72 + 8 + lc) * DRNN + cp * 2);
        const f32x2 cbk = *(const f32x2*)(CIN + ((size_t)(1 * 4 + bl) * 72 + 8 + lc) * DRNN + cp * 2);
        float hf0[32], hf1[32];
        float h0 = cf[0], h1 = cf[1];
#pragma unroll
        for (int i = 0; i < 32; ++i) { const unsigned lw = *(const unsigned*)(LA + b0 + (size_t)i * DRNN), bw = *(const unsigned*)(BX + b0 + (size_t)i * DRNN);
            h0 = __expf(bf_lo(lw)) * h0 + bf_lo(bw); h1 = __expf(bf_hi(lw)) * h1 + bf_hi(bw); hf0[i] = h0; hf1[i] = h1; }
        h0 = cbk[0]; h1 = cbk[1];
        bf16_t* out = REC + ((size_t)(half * 4 + bl) * SEQ + lc * 32) * DRNN + cp * 2;
#pragma unroll
        for (int i = 31; i >= 0; --i) { const unsigned lw = *(const unsigned*)(LA + b1 + (size_t)i * DRNN), bw = *(const unsigned*)(BX + b1 + (size_t)i * DRNN);
            h0 = __expf(bf_lo(lw)) * h0 + bf_lo(bw); h1 = __expf(bf_hi(lw)) * h1 + bf_hi(bw);
            *(unsigned*)(out + (size_t)i * DRNN) = cvt_pk_bf16(hf0[i] + h0, hf1[i] + h1); }
    }
}

#ifndef PH_MASK
#define PH_MASK 0xFFFFFFFFu
#endif
#define PH(k) ((PH_MASK >> (k)) & 1u)
#ifndef REP_MASK
#define REP_MASK 0u
#endif
#define REP_BEGIN(k) _Pragma("unroll 1") for (int rep_ = 0; rep_ < (((REP_MASK >> (k)) & 1u) ? 2 : 1); ++rep_) {
#define REP_END }
__device__ __forceinline__ ParamsK kparams() { ParamsK q = (ParamsK)__builtin_amdgcn_kernarg_segment_ptr(); asm volatile("" : "+s"(q)); return q; }
#define PHASE_BEGIN ParamsK kp = kparams(); unsigned char* ws = kp->ws; (void)ws; \
    int tid = threadIdx.x; asm volatile("" : "+v"(tid)); const int lane = tid & 63, wave = __builtin_amdgcn_readfirstlane(tid >> 6); \
    const int gw = bid * 8 + wave, gtid = bid * 512 + tid; (void)lane; (void)gw; (void)gtid;
#define P_MOD0 ((float*)(ws + WS_MOD))
#define P_MOD1 ((float*)(ws + WS_MOD) + 9 * 6144)
#define P_CTXRES ((float*)(ws + WS_CTXRES))
#define P_H ((bf16_t*)(ws + WS_H))
#define P_SLAB ((bf16_t*)(ws + WS_SLAB))
#define P_Q ((bf16_t*)(ws + WS_Q))
#define P_O ((bf16_t*)(ws + WS_O))
#define P_K ((bf16_t*)(ws + WS_K))
#define P_VT ((bf16_t*)(ws + WS_VT))
#define P_VTC ((bf16_t*)(ws + WS_VTC))
#define P_ACT ((bf16_t*)(ws + WS_ACT))
#define P_U ((bf16_t*)(ws + WS_U))
#define P_RECF ((bf16_t*)(ws + WS_RECF))
#define P_RECB ((bf16_t*)(ws + WS_RECB))
#define P_LA ((bf16_t*)(ws + WS_LA))
#define P_BX ((bf16_t*)(ws + WS_BX))
#define P_RPRE ((bf16_t*)(ws + WS_RPRE))
#define P_SP ((float*)(ws + WS_SP))
#define P_SH ((float*)(ws + WS_SH))
#define P_CIN ((float*)(ws + WS_CIN))
#define G0 (kp->norm_g)
#define G1 (kp->norm_g + 4 * DM)

__global__ void __launch_bounds__(512, 2) fwd_megakernel(Params p) {
    extern __shared__ __attribute__((aligned(16))) unsigned char lds_raw[];
    LAS unsigned char* lds = (LAS unsigned char*)lds_raw;
    const int G = gridDim.x, bid = blockIdx.x;
    const int ngw = G * 8, nthreads = G * 512;
    using namespace pg8;
    if (threadIdx.x < 4) ((volatile LAS unsigned*)(lds + 132096))[threadIdx.x] = 0u;
    __syncthreads();
    XcdBarrier xbar = xcd_barrier_post((unsigned*)(p.ws + WS_BAR), (volatile LAS unsigned*)(lds + 132096));
    if (PH(0)) { PHASE_BEGIN prologue(kp, lds, tid, lane, wave); }
    xcd_barrier(xbar);
#ifdef EXTRA_SYNCS
#pragma unroll 1
    for (int es = 0; es < EXTRA_SYNCS; ++es) xcd_barrier(xbar);
#endif
    REP_BEGIN(1)
    if (PH(1)) { PHASE_BEGIN row_phase<false, true>(kp->x, kp->ctx, nullptr, nullptr, nullptr, nullptr, P_H, nullptr, G0, nullptr, 0, P_MOD0, 0, 1, MT, gw, ngw, lane); }
    xcd_barrier(xbar);
    REP_END
    if (PH(2)) {
        PHASE_BEGIN
        Gemm g{P_H, (const bf16_t*)(ws + WS_WQKV), DM, DM, DM}; Sched S; S.init(MT / 256, NQKV / 256, G, bid);
        EpiQKV E{P_Q, P_K, P_VT, P_VTC, (const float*)(ws + WS_ROPE)};
        gemm_phase<EpiQKV, true, true>(lds, g, S, E);
    }
    xcd_barrier(xbar);
    REP_BEGIN(3)
    if (PH(3)) { PHASE_BEGIN attn_phase(lds, P_Q, P_O, P_K, P_VT, P_VTC, kp->sink, tid, lane, wave); }
    xcd_barrier(xbar);
    REP_END
    if (PH(4)) {
        PHASE_BEGIN
        { Gemm g{P_O, (const bf16_t*)(ws + WS_WO), DM, DM, DM}; Sched S; S.init(ML / 256, DM / 256, G, bid);
          EpiPlain<0> E{P_H, DM};
          gemm_phase<EpiPlain<0>, true, true>(lds, g, S, E); }
        { Gemm g{P_O, (const bf16_t*)(ws + WS_WO), DM, DM, 256}; Sched S; S.init(8, 4 * 4, G, bid, 2, 256);
          EpiSlabCtx E{P_SLAB, 256};
          gemm_phase<EpiSlabCtx, true, true>(lds, g, S, E); }
    }
    xcd_barrier(xbar);
    if (PH(5)) { PHASE_BEGIN row_phase<true, true>(kp->x, kp->ctx, kp->out, P_CTXRES, P_H, P_SLAB, P_H, G0 + DM, G0 + 2 * DM, P_MOD0, 2, P_MOD0, 3, 4, MT, gw, ngw, lane); }
    xcd_barrier(xbar);
    if (PH(6)) {
        PHASE_BEGIN
        Gemm g{P_H, (const bf16_t*)(ws + WS_W1), DM, DM, DM}; Sched S; S.init(MT / 256, DFF / 256, G, bid);
        EpiPlain<1> E{P_ACT, DFF};
        gemm_phase<EpiPlain<1>, true, true>(lds, g, S, E);
    }
    xcd_barrier(xbar);
    if (PH(7)) {
        PHASE_BEGIN
        { Gemm g{P_ACT, (const bf16_t*)(ws + WS_W2), DFF, DFF, DFF}; Sched S; S.init(ML / 256, DM / 256, G, bid);
          EpiPlain<0> E{P_H, DM};
          gemm_phase<EpiPlain<0>, true, true>(lds, g, S, E); }
        { Gemm g{P_ACT, (const bf16_t*)(ws + WS_W2), DFF, DFF, 1024}; Sched S; S.init(8, 4 * 4, G, bid, 2, 1024);
          EpiSlabCtx E{P_SLAB, 1024};
          gemm_phase<EpiSlabCtx, true, true>(lds, g, S, E); }
    }
    xcd_barrier(xbar);
    if (PH(8)) { PHASE_BEGIN row_phase<true, true>(kp->out, P_CTXRES, kp->out, P_CTXRES, P_H, P_SLAB, P_H, G0 + 3 * DM, G1, P_MOD0, 5, P_MOD1, 0, 1, MT, gw, ngw, lane); }
    xcd_barrier(xbar);
    if (PH(9)) {
        PHASE_BEGIN
        Gemm g{P_H, (const bf16_t*)(ws + WS_WIN), DM, DM, DM}; Sched S; S.init(MT / 256, DRNN / 256, G, bid, 4, 0);
        EpiInProj E{P_RPRE, (bf16_t*)(ws + WS_CTXRES)};
        gemm_phase<EpiInProj, true, true>(lds, g, S, E);
    }
    xcd_barrier(xbar);
    REP_BEGIN(10)
    if (PH(10)) { PHASE_BEGIN conv_phase(P_RPRE, P_U, kp->conv_w, kp->conv_b, gtid, nthreads); }
    xcd_barrier(xbar);
    REP_END
    if (PH(11)) {
        PHASE_BEGIN
        Gemm g{P_U, (const bf16_t*)(ws + WS_WG), DRNN, 256, 256}; Sched S; S.init(1, 1, G, bid, 3, 0);
        EpiGatesScan E{P_U, P_RECF, P_RECB, kp->b_a, kp->b_i, (const float*)(ws + WS_NLS), (float*)(ws + WS_CARRY), (unsigned*)(ws + WS_FLAG)};
        gemm_phase<EpiGatesScan, true, true>(lds, g, S, E);
    }
    xcd_barrier(xbar);
    if (PH(15)) {
        PHASE_BEGIN
        Gemm g{P_H, (const bf16_t*)(ws + WS_WIN), DM, DM, DM}; Sched S; S.init(ML / 256, 4, G, bid);
        EpiGateMul E{P_RECF, P_RECB};
        gemm_phase<EpiGateMul, true, true>(lds, g, S, E);
        {
            const bf16_t* GB = (const bf16_t*)(ws + WS_CTXRES); bf16_t* Z = P_RECF; const bf16_t* RB = P_RECB;
            for (int idx = gtid; idx < ML * 32; idx += nthreads) { const int row = idx >> 5, c8 = (idx & 31) * 8;
                const u32x4 gv = *(const u32x4*)(GB + (size_t)row * 256 + c8); const size_t o = (size_t)row * DRNN + 1024 + c8;
                const u32x4 fv = *(const u32x4*)(Z + o), bv = *(const u32x4*)(RB + o); u32x4 w;
                w.x = cvt_pk_bf16(bf_lo(gv.x) * (bf_lo(fv.x) + bf_lo(bv.x)), bf_hi(gv.x) * (bf_hi(fv.x) + bf_hi(bv.x)));
                w.y = cvt_pk_bf16(bf_lo(gv.y) * (bf_lo(fv.y) + bf_lo(bv.y)), bf_hi(gv.y) * (bf_hi(fv.y) + bf_hi(bv.y)));
                w.z = cvt_pk_bf16(bf_lo(gv.z) * (bf_lo(fv.z) + bf_lo(bv.z)), bf_hi(gv.z) * (bf_hi(fv.z) + bf_hi(bv.z)));
                w.w = cvt_pk_bf16(bf_lo(gv.w) * (bf_lo(fv.w) + bf_lo(bv.w)), bf_hi(gv.w) * (bf_hi(fv.w) + bf_hi(bv.w)));
                *(u32x4*)(Z + o) = w; }
        }
    }
    xcd_barrier(xbar);
    if (PH(16)) {
        PHASE_BEGIN
        Gemm g{P_RECF, (const bf16_t*)(ws + WS_WOUT), DRNN, DRNN, DRNN}; Sched S; S.init(ML / 256, DM / 256, G, bid);
        EpiPlain<0> E{P_H, DM};
        gemm_phase<EpiPlain<0>, true, true>(lds, g, S, E);
    }
    xcd_barrier(xbar);
    if (PH(17)) { PHASE_BEGIN row_phase<true, true>(kp->out, P_CTXRES, kp->out, P_CTXRES, P_H, nullptr, P_H, G1 + DM, G1 + 2 * DM, P_MOD1, 2, P_MOD1, 3, 4, ML, gw, ngw, lane); }
    xcd_barrier(xbar);
    if (PH(18)) {
        PHASE_BEGIN
        Gemm g{P_H, (const bf16_t*)(ws + WS_W1 + 16 * MiB), DM, DM, DM}; Sched S; S.init(ML / 256, DFF / 256, G, bid);
        EpiPlain<1> E{P_ACT, DFF};
        gemm_phase<EpiPlain<1>, true, true>(lds, g, S, E);
    }
    xcd_barrier(xbar);
    if (PH(19)) {
        PHASE_BEGIN
        Gemm g{P_ACT, (const bf16_t*)(ws + WS_W2 + 16 * MiB), DFF, DFF, DFF}; Sched S; S.init(ML / 256, DM / 256, G, bid);
        EpiPlain<0> E{P_H, DM};
        gemm_phase<EpiPlain<0>, true, true>(lds, g, S, E);
    }
    xcd_barrier(xbar);
    if (PH(20)) { PHASE_BEGIN row_phase<true, false>(kp->out, P_CTXRES, kp->out, P_CTXRES, P_H, nullptr, nullptr, G1 + 3 * DM, nullptr, P_MOD1, 5, nullptr, 0, 0, ML, gw, ngw, lane); }
}

extern "C" void kernel_launch(void* const* d_in, const int* in_sizes, int n_in, void* d_out, int out_size, void* d_ws, size_t ws_size, hipStream_t stream) {
    static int grid_blocks = 0;
    if (grid_blocks == 0) {
        if (n_in != 21 || ws_size < WS_END) { fprintf(stderr, "kernel_launch: unexpected n_in %d / ws_size %zu\n", n_in, ws_size); grid_blocks = -1; return; }
        int dev = 0, cus = 0, per_cu = 0;
        hipGetDevice(&dev);
        hipDeviceGetAttribute(&cus, hipDeviceAttributeMultiprocessorCount, dev);
        if (hipFuncSetAttribute((const void*)fwd_megakernel, hipFuncAttributeMaxDynamicSharedMemorySize, LDS_BYTES) != hipSuccess) { fprintf(stderr, "hipFuncSetAttribute failed\n"); grid_blocks = -1; return; }
        if (hipOccupancyMaxActiveBlocksPerMultiprocessor(&per_cu, (const void*)fwd_megakernel, 512, LDS_BYTES) != hipSuccess || per_cu < 1) { fprintf(stderr, "occupancy query failed (%d)\n", per_cu); (void)hipGetLastError(); per_cu = 1; }
        grid_blocks = cus * 1;
    }
    if (grid_blocks < 0) return;
    Params p{};
    p.x = (const float*)d_in[0]; p.c = (const float*)d_in[1]; p.ctx = (const float*)d_in[2]; p.c_ctx = (const float*)d_in[3];
    p.ada_w = (const float*)d_in[4]; p.ada_b = (const float*)d_in[5]; p.norm_g = (const float*)d_in[6]; p.mlp_w1 = (const float*)d_in[7]; p.mlp_w2 = (const float*)d_in[8];
    p.w_qkv = (const float*)d_in[9]; p.w_o = (const float*)d_in[10]; p.sink = (const float*)d_in[11];
    p.w_in = (const float*)d_in[12]; p.conv_w = (const float*)d_in[13]; p.conv_b = (const float*)d_in[14]; p.w_a = (const float*)d_in[15]; p.b_a = (const float*)d_in[16];
    p.w_i = (const float*)d_in[17]; p.b_i = (const float*)d_in[18]; p.lam = (const float*)d_in[19]; p.w_out = (const float*)d_in[20];
    p.out = (float*)d_out; p.ws = (unsigned char*)d_ws;
    if (hipMemsetAsync((unsigned char*)d_ws + WS_BAR, 0, XCD_BAR_WORDS * 4, stream) != hipSuccess) { fprintf(stderr, "memset of barrier words failed\n"); return; }
    void* args[] = {&p};
    hipError_t e = hipLaunchCooperativeKernel((const void*)fwd_megakernel, dim3(grid_blocks), dim3(512), args, LDS_BYTES, stream);
    if (e != hipSuccess) fprintf(stderr, "cooperative launch failed: %s (grid %d)\n", hipGetErrorString(e), grid_blocks);
}
```

```cpp
#include <hip/hip_runtime.h>
#include <hip/hip_cooperative_groups.h>
#include <cstdio>
#include <cstdint>
namespace cg = cooperative_groups;

#define LAS __attribute__((address_space(3)))
typedef unsigned short bf16_t;
typedef short bf16x8 __attribute__((ext_vector_type(8)));
typedef float f32x4 __attribute__((ext_vector_type(4)));
typedef float f32x2 __attribute__((ext_vector_type(2)));
typedef unsigned u32x4 __attribute__((ext_vector_type(4)));
typedef unsigned u32x2 __attribute__((ext_vector_type(2)));

constexpr int DM = 1024, NB = 8, SEQ = 2048, CTX = 256;
constexpr int ML = NB * SEQ;
constexpr int MC = NB * CTX;
constexpr int MT = ML + MC;
constexpr int NQKV = 1536, DFF = 4096, DRNN = 1280;
constexpr float EPS = 1e-6f;
constexpr float LOG2E = 1.4426950408889634f;

constexpr size_t MiB = 1u << 20;
constexpr size_t WS_MOD = 0;
constexpr size_t WS_ROPE = 448 * 1024;
constexpr size_t WS_NLS = 460 * 1024;
constexpr size_t WS_BAR = 480 * 1024;
constexpr size_t WS_WQKV = 1 * MiB, WS_WO = 4 * MiB, WS_W1 = 6 * MiB, WS_W2 = 14 * MiB;
constexpr size_t WS_WIN = 38 * MiB, WS_WG = 43 * MiB, WS_WOUT = 46 * MiB;
constexpr size_t WS_CTXRES = 49 * MiB;
constexpr size_t WS_H = 57 * MiB;
constexpr size_t WS_R3 = 93 * MiB;
constexpr size_t WS_Q = WS_R3, WS_K = 129 * MiB, WS_VT = 138 * MiB, WS_VTC = 146 * MiB;
constexpr size_t WS_O = 150 * MiB;
constexpr size_t WS_ACT = WS_R3;
constexpr size_t WS_U = WS_R3;
constexpr size_t WS_RECF = 138 * MiB;
constexpr size_t WS_RECB = 178 * MiB;
constexpr size_t WS_LA = 138 * MiB;
constexpr size_t WS_BX = 183 * MiB;
constexpr size_t WS_RPRE = 138 * MiB;
constexpr size_t WS_SP = 228 * MiB, WS_SH = 231 * MiB, WS_CIN = 234 * MiB;
constexpr size_t WS_SLAB = 238 * MiB;
constexpr size_t WS_CARRY = 219 * MiB;
constexpr size_t WS_FLAG = 512 * 1024;
constexpr size_t WS_END = 256 * MiB;
constexpr int LDS_BYTES = 135168;

__device__ __forceinline__ unsigned f2bf(float f) { unsigned u = __builtin_bit_cast(unsigned, f); return (u + 0x7fffu + ((u >> 16) & 1u)) >> 16; }
__device__ __forceinline__ unsigned cvt_pk_bf16(float lo, float hi) { unsigned r; asm volatile("v_cvt_pk_bf16_f32 %0, %1, %2" : "=v"(r) : "v"(lo), "v"(hi)); return r; }
__device__ __forceinline__ float bf_lo(unsigned w) { return __builtin_bit_cast(float, w << 16); }
__device__ __forceinline__ float bf_hi(unsigned w) { return __builtin_bit_cast(float, w & 0xffff0000u); }
__device__ __forceinline__ f32x4 bf4_to_f32(u32x2 w) { return (f32x4){bf_lo(w.x), bf_hi(w.x), bf_lo(w.y), bf_hi(w.y)}; }
__device__ __forceinline__ u32x2 f32_to_bf4(f32x4 v) { u32x2 w; w.x = cvt_pk_bf16(v[0], v[1]); w.y = cvt_pk_bf16(v[2], v[3]); return w; }
__device__ __forceinline__ float wave_sum(float v) {
#pragma unroll
    for (int o = 1; o < 64; o <<= 1) v += __shfl_xor(v, o);
    return v;
}
__device__ __forceinline__ float fsigmoid(float x) { return __builtin_amdgcn_rcpf(1.0f + __expf(-x)); }

namespace pg8 {
constexpr int BM = 256, BK = 64, HALF = 128, HTB = HALF * BK * 2, STAGE_BYTES = 8 * HTB, NXCD = 8, WGM = 8;
__device__ __forceinline__ int lds_byte(int r, int c) { const int st = (r >> 4) * 2 + (c >> 5), rr = r & 15, cc = c & 31, ob = rr * 64 + cc * 2; return st * 1024 + (ob ^ (((ob >> 9) & 1) << 5)); }
__device__ __forceinline__ void stage_rc(int b, int& R, int& C) { const int st = b / 1024, sb = b % 1024, swz = sb ^ (((sb >> 9) & 1) << 5); R = (st >> 1) * 16 + swz / 64; C = (st & 1) * 32 + (swz % 64) / 2; }

struct Unit { int pm, pn, koff, po, kboff, rev, lin; };
struct Gemm { const bf16_t* A; const bf16_t* Bt; int lda, ldb, K; };

struct Sched {
    int nM, nN, nwg, G, c, mode, half;
    __device__ void init(int nM_, int nN_, int G_, int c_, int mode_ = 0, int half_ = 0) { nM = nM_; nN = nN_; nwg = nM * nN; G = G_; c = c_; mode = mode_; half = half_; }
    __device__ bool next(int i, Unit& u) const {
        if (mode == 3) {
            const int L = i * G + c; if (L >= 1440) return false;
            const int ti = L / 160, s = L % 160;
            const int chalf = s & 1, dir = (s >> 1) & 1, bb = s >> 2, blk = bb % 5, b = bb / 5;
            u.pm = (ti == 0) ? 64 + b : (dir ? b * 8 + (8 - ti) : b * 8 + (ti - 1));
            u.pn = (dir * 5 + blk) * 2 + chalf; u.koff = blk * 256; u.kboff = 0; u.po = ti; u.rev = dir; u.lin = L;
            return true;
        }
        if (mode == 4) {
            const int L4 = i * G + c; if (L4 >= 424) return false;
            if (L4 >= 360) { u.pm = L4 - 360; u.pn = 4; u.koff = 0; u.po = u.pm; u.kboff = 0; u.rev = 0; u.lin = 0; return true; }
        }
        const long L = (long)i * G + c; if (L >= nwg) return false;
        int wgid = (int)L; { const int q = nwg / NXCD, r = nwg % NXCD, xcd = wgid % NXCD, off = wgid / NXCD; wgid = (xcd < r ? xcd * (q + 1) : r * (q + 1) + (xcd - r) * q) + off; }
        const int nig = WGM * nN, gid = wgid / nig, fm = gid * WGM, gsz = (nM - fm) < WGM ? (nM - fm) : WGM;
        const int pmi = fm + ((wgid % nig) % gsz), pn = (wgid % nig) / gsz;
        u.pm = pmi; u.pn = pn; u.koff = 0; u.po = pmi; u.kboff = 0; u.rev = 0; u.lin = 0;
        if (mode == 2) { u.pm = 64 + pmi; u.pn = pn & 3; u.koff = (pn >> 2) * half; u.kboff = u.koff; }
        if (mode == 4) u.pn += 5;
        if (mode == 1) { u.pm = pmi < 32 ? 32 * half + pmi : 64 + 4 * half + (pmi - 32); u.koff = ((pn >> 1) % 5) * 256; }
        return true;
    }
};

template <class Epi, bool ALIGN_EPI, bool SP2>
__device__ __forceinline__ void gemm_phase(LAS unsigned char* lds, const Gemm g, const Sched& S, const Epi& E) {
    int tid = threadIdx.x; asm volatile("" : "+v"(tid));
    const int wid = __builtin_amdgcn_readfirstlane(tid >> 6), lane = tid & 63, wr = wid >> 2, wc = wid & 3, fr = lane & 15, fq = lane >> 4;
    const int K = g.K, nt = K / BK;
    unsigned voffAf[2], voffAr[2], voffB[2];
#pragma unroll
    for (int i = 0; i < 2; ++i) { int R, C; stage_rc(tid * 16 + i * 8192, R, C);
        voffAf[i] = (unsigned)(R * g.lda + C) * 2u; voffAr[i] = (unsigned)((127 - R) * g.lda + C) * 2u; voffB[i] = (unsigned)(R * g.ldb + C) * 2u; }
    const size_t kstep = (size_t)(BK * 2);
    const long hstepAf = (long)HALF * g.lda * 2; const size_t hstepB = (size_t)HALF * g.ldb * 2;
    const unsigned ldsw = (unsigned)wid * 1024u;
    const int aoff = lds_byte(wr * 64 + fr, fq * 8), boff = lds_byte(wc * 32 + fr, fq * 8);
#define PG8_SA(b, h) (((b) * 2 + (h)) * HTB)
#define PG8_SB(b, h) ((4 + (b) * 2 + (h)) * HTB)
#define PG8_STAGE(bufoff, gbase, voff) do { _Pragma("unroll") for (int _i = 0; _i < 2; ++_i) \
        __builtin_amdgcn_global_load_lds((const unsigned*)((const char*)(gbase) + (voff)[_i]), (LAS unsigned*)(lds + (bufoff) + ldsw + _i * 8192), 16, 0, 0); } while (0)
#define PG8_LDA(dst, b, h) do { _Pragma("unroll") for (int m = 0; m < 4; ++m) _Pragma("unroll") for (int k = 0; k < 2; ++k) dst[m][k] = *(const LAS bf16x8*)(lds + PG8_SA(b, h) + aoff + m * 2048 + k * 1024); } while (0)
#define PG8_LDB(dst, b, h) do { _Pragma("unroll") for (int n = 0; n < 2; ++n) _Pragma("unroll") for (int k = 0; k < 2; ++k) dst[n][k] = *(const LAS bf16x8*)(lds + PG8_SB(b, h) + boff + n * 2048 + k * 1024); } while (0)
#define PG8_MMA(ai, bj, At, Bt) do { __builtin_amdgcn_s_setprio(1); _Pragma("unroll") for (int m = 0; m < 4; ++m) _Pragma("unroll") for (int n = 0; n < 2; ++n) _Pragma("unroll") for (int k = 0; k < 2; ++k) \
        acc[ai][bj][m][n] = __builtin_amdgcn_mfma_f32_16x16x32_bf16(Bt[n][k], At[m][k], acc[ai][bj][m][n], 0, 0, 0); __builtin_amdgcn_s_setprio(0); } while (0)
#define PG8_WAIT_V(n) asm volatile("s_waitcnt vmcnt(" #n ")" ::: "memory")
#define PG8_WAIT_L(n) asm volatile("s_waitcnt lgkmcnt(" #n ")" ::: "memory")
#define PG8_BAR __builtin_amdgcn_s_barrier()
#define PG8_SCHED __builtin_amdgcn_sched_barrier(0)
    Unit cur, nxt; int ui = 0;
    if (!S.next(0, cur)) return;
    f32x4 acc[2][2][4][2];
#pragma unroll
    for (int a = 0; a < 2; ++a)
#pragma unroll
        for (int b = 0; b < 2; ++b)
#pragma unroll
            for (int m = 0; m < 4; ++m)
#pragma unroll
                for (int n = 0; n < 2; ++n) acc[a][b][m][n] = (f32x4){0.f, 0.f, 0.f, 0.f};
    bf16x8 At[4][2], B0[2][2], B1[2][2];
#define PG8_UNIT_A(u_) ((const char*)g.A + ((size_t)(u_).pm * BM * g.lda + (u_).koff) * 2 + (Epi::WITH_LDS && (u_).rev ? hstepAf : 0))
    const char* cA = PG8_UNIT_A(cur);
    unsigned voffA[2] = {voffAf[0], voffAf[1]}; long hstepA = hstepAf;
    if (Epi::WITH_LDS && cur.rev) { voffA[0] = voffAr[0]; voffA[1] = voffAr[1]; hstepA = -hstepAf; } const char* cB = (const char*)g.Bt + ((size_t)cur.pn * BM * g.ldb + cur.kboff) * 2;
    if constexpr (SP2) {
        PG8_STAGE(PG8_SB(0, 0), cB, voffB); PG8_STAGE(PG8_SB(0, 1), cB + hstepB, voffB); PG8_STAGE(PG8_SA(0, 0), cA, voffA); PG8_STAGE(PG8_SA(0, 1), cA + hstepA, voffA);
        if (wr == 1) PG8_BAR;
        PG8_WAIT_V(2); PG8_BAR;
        PG8_STAGE(PG8_SB(1, 0), cB + kstep, voffB); PG8_STAGE(PG8_SA(1, 0), cA + kstep, voffA); PG8_STAGE(PG8_SB(1, 1), cB + hstepB + kstep, voffB);
        PG8_WAIT_V(6); PG8_BAR;
    } else {
        PG8_STAGE(PG8_SB(0, 0), cB, voffB); PG8_STAGE(PG8_SA(0, 0), cA, voffA); PG8_STAGE(PG8_SB(0, 1), cB + hstepB, voffB); PG8_STAGE(PG8_SA(0, 1), cA + hstepA, voffA);
        if (wr == 1) PG8_BAR;
        PG8_WAIT_V(4); PG8_BAR;
        PG8_STAGE(PG8_SB(1, 0), cB + kstep, voffB); PG8_STAGE(PG8_SA(1, 0), cA + kstep, voffA); PG8_STAGE(PG8_SB(1, 1), cB + hstepB + kstep, voffB);
        PG8_WAIT_V(6); PG8_BAR;
    }
    for (;;) {
        const bool has_next = S.next(ui + 1, nxt);
        const char* nA = has_next ? PG8_UNIT_A(nxt) : cA;
        unsigned voffN[2] = {voffA[0], voffA[1]}; long hstepN = hstepA;
        if (Epi::WITH_LDS && has_next) { const bool nr = nxt.rev != 0; voffN[0] = nr ? voffAr[0] : voffAf[0]; voffN[1] = nr ? voffAr[1] : voffAf[1]; hstepN = nr ? -hstepAf : hstepAf; }
        const char* nB = has_next ? (const char*)g.Bt + ((size_t)nxt.pn * BM * g.ldb + nxt.kboff) * 2 : cB;
#pragma unroll 1
        for (int t = 0; t < nt; t += 2) {
            const bool last = (t == nt - 2);
            const char* a1 = cA + (size_t)(t + 1) * kstep;
            const char* a2 = last ? nA : cA + (size_t)(t + 2) * kstep; const char* b2 = last ? nB : cB + (size_t)(t + 2) * kstep;
            const char* a3 = a2 + kstep; const char* b3 = b2 + kstep;
            unsigned voff2[2] = {voffA[0], voffA[1]}; long hstep2 = hstepA;
            if (Epi::WITH_LDS && last) { voff2[0] = voffN[0]; voff2[1] = voffN[1]; hstep2 = hstepN; }
            if constexpr (SP2) {
            PG8_LDB(B0, 0, 0); PG8_LDB(B1, 0, 1); PG8_SCHED; PG8_LDA(At, 0, 0); PG8_STAGE(PG8_SA(1, 1), a1 + hstepA, voffA);
            PG8_WAIT_V(8); PG8_WAIT_L(0); PG8_BAR; PG8_MMA(0, 0, At, B0); PG8_MMA(0, 1, At, B1); PG8_BAR; PG8_SCHED;
            PG8_LDA(At, 0, 1); PG8_STAGE(PG8_SB(0, 0), b2, voffB); PG8_STAGE(PG8_SB(0, 1), b2 + hstepB, voffB); PG8_STAGE(PG8_SA(0, 0), a2, voff2);
            PG8_WAIT_V(8); PG8_WAIT_L(0); PG8_BAR; PG8_MMA(1, 0, At, B0); PG8_MMA(1, 1, At, B1); PG8_BAR; PG8_SCHED;
            PG8_LDB(B0, 1, 0); PG8_LDB(B1, 1, 1); PG8_SCHED; PG8_LDA(At, 1, 0); PG8_STAGE(PG8_SA(0, 1), a2 + hstep2, voff2);
            PG8_WAIT_V(8); PG8_WAIT_L(0); PG8_BAR; PG8_MMA(0, 0, At, B0); PG8_MMA(0, 1, At, B1); PG8_BAR; PG8_SCHED;
            PG8_LDA(At, 1, 1); PG8_STAGE(PG8_SB(1, 0), b3, voffB); PG8_STAGE(PG8_SB(1, 1), b3 + hstepB, voffB); PG8_STAGE(PG8_SA(1, 0), a3, voff2);
            PG8_WAIT_V(8); PG8_WAIT_L(0); PG8_BAR; PG8_MMA(1, 0, At, B0); PG8_MMA(1, 1, At, B1); PG8_BAR; PG8_SCHED;
            } else {
            PG8_LDB(B0, 0, 0); PG8_SCHED; PG8_LDA(At, 0, 0); PG8_STAGE(PG8_SA(1, 1), a1 + hstepA, voffA);
            PG8_WAIT_L(8); PG8_BAR; PG8_WAIT_L(0); PG8_MMA(0, 0, At, B0); PG8_BAR; PG8_SCHED;
            PG8_LDB(B1, 0, 1); PG8_STAGE(PG8_SB(0, 0), b2, voffB);
            PG8_BAR; PG8_WAIT_L(0); PG8_MMA(0, 1, At, B1); PG8_BAR;
            PG8_LDA(At, 0, 1); PG8_STAGE(PG8_SA(0, 0), a2, voff2);
            PG8_BAR; PG8_WAIT_L(0); PG8_MMA(1, 0, At, B0); PG8_BAR; PG8_SCHED;
            PG8_STAGE(PG8_SB(0, 1), b2 + hstepB, voffB);
            PG8_WAIT_V(6); PG8_BAR; PG8_MMA(1, 1, At, B1); PG8_BAR;
            PG8_LDB(B0, 1, 0); PG8_SCHED; PG8_LDA(At, 1, 0); PG8_STAGE(PG8_SA(0, 1), a2 + hstep2, voff2);
            PG8_WAIT_L(8); PG8_BAR; PG8_WAIT_L(0); PG8_MMA(0, 0, At, B0); PG8_BAR; PG8_SCHED;
            PG8_LDB(B1, 1, 1); PG8_STAGE(PG8_SB(1, 0), b3, voffB);
            PG8_BAR; PG8_WAIT_L(0); PG8_MMA(0, 1, At, B1); PG8_BAR;
            PG8_LDA(At, 1, 1); PG8_STAGE(PG8_SA(1, 0), a3, voff2);
            PG8_BAR; PG8_WAIT_L(0); PG8_MMA(1, 0, At, B0); PG8_BAR; PG8_SCHED;
            PG8_STAGE(PG8_SB(1, 1), b3 + hstepB, voffB);
            PG8_WAIT_V(6); PG8_BAR; PG8_MMA(1, 1, At, B1); PG8_BAR;
            }
        }
        if constexpr (ALIGN_EPI) { if (wr == 0) PG8_BAR; }
        if constexpr (Epi::WITH_LDS) E.run(acc, cur, wr, wc, lane, lds); else E(acc, cur, wr, wc, fr, fq);
        if (!has_next) break;
#pragma unroll
        for (int a = 0; a < 2; ++a)
#pragma unroll
            for (int b = 0; b < 2; ++b)
#pragma unroll
                for (int m = 0; m < 4; ++m)
#pragma unroll
                    for (int n = 0; n < 2; ++n) acc[a][b][m][n] = (f32x4){0.f, 0.f, 0.f, 0.f};
        cur = nxt; cA = nA; cB = nB; ++ui; voffA[0] = voffN[0]; voffA[1] = voffN[1]; hstepA = hstepN;
        if constexpr (ALIGN_EPI) { if (wr == 1) PG8_BAR; }
    }
    PG8_WAIT_V(0);
    if constexpr (!ALIGN_EPI) { if (wr == 0) PG8_BAR; }
    PG8_BAR;
#undef PG8_UNIT_A
#undef PG8_SA
#undef PG8_SB
#undef PG8_STAGE
#undef PG8_LDA
#undef PG8_LDB
#undef PG8_MMA
#undef PG8_WAIT_V
#undef PG8_WAIT_L
#undef PG8_BAR
#undef PG8_SCHED
}

template <int ACT> struct EpiPlain {
    static constexpr bool WITH_LDS = false;
    bf16_t* O; int ldc;
    __device__ __forceinline__ void operator()(const f32x4 (&acc)[2][2][4][2], const Unit& u, int wr, int wc, int fr_, int fq_) const {
        int fr = fr_, fq = fq_; asm volatile("" : "+v"(fr), "+v"(fq));
        const int col0 = u.pn * BM + wc * 32 + fq * 4;
#pragma unroll
        for (int ai = 0; ai < 2; ++ai)
#pragma unroll
            for (int m = 0; m < 4; ++m) { bf16_t* rowp = O + (size_t)(u.pm * BM + ai * HALF + wr * 64 + m * 16 + fr) * ldc + col0;
#pragma unroll
                for (int bj = 0; bj < 2; ++bj)
#pragma unroll
                    for (int n = 0; n < 2; ++n) { f32x4 v = acc[ai][bj][m][n];
                        if (ACT == 1) { v = __builtin_elementwise_max(v, (f32x4){0.f, 0.f, 0.f, 0.f}); v = v * v; }
                        *(u32x2*)(rowp + bj * HALF + n * 16) = f32_to_bf4(v); } }
    }
};

struct EpiSlabCtx {
    static constexpr bool WITH_LDS = false;
    bf16_t* S; int ksz;
    __device__ __forceinline__ void operator()(const f32x4 (&acc)[2][2][4][2], const Unit& u, int wr, int wc, int fr_, int fq_) const {
        int fr = fr_, fq = fq_; asm volatile("" : "+v"(fr), "+v"(fq));
        const int col0 = u.pn * BM + wc * 32 + fq * 4;
        bf16_t* base = S + (size_t)(u.koff / ksz) * MC * DM;
#pragma unroll
        for (int ai = 0; ai < 2; ++ai)
#pragma unroll
            for (int m = 0; m < 4; ++m) { bf16_t* rowp = base + (size_t)(u.pm * BM - ML + ai * HALF + wr * 64 + m * 16 + fr) * DM + col0;
#pragma unroll
                for (int bj = 0; bj < 2; ++bj)
#pragma unroll
                    for (int n = 0; n < 2; ++n) *(u32x2*)(rowp + bj * HALF + n * 16) = f32_to_bf4(acc[ai][bj][m][n]); }
    }
};

struct EpiQKV {
    static constexpr bool WITH_LDS = false;
    bf16_t* Q; bf16_t* Kb; bf16_t* VT; bf16_t* VTC; const float* rope;
    __device__ __forceinline__ void operator()(const f32x4 (&acc)[2][2][4][2], const Unit& u, int wr, int wc, int fr_, int fq_) const {
        int fr = fr_, fq = fq_; asm volatile("" : "+v"(fr), "+v"(fq));
        const bool lat = u.pm < 64;
        if (u.pn < 5) {
#pragma unroll
            for (int ai = 0; ai < 2; ++ai)
#pragma unroll
                for (int m = 0; m < 4; ++m) {
                    const int row = u.pm * BM + ai * HALF + wr * 64 + m * 16 + fr;
                    f32x4 cs0 = {1.f, 0.f, 1.f, 0.f}, cs1 = {1.f, 0.f, 1.f, 0.f};
                    if (lat) { const int t = row & 2047; const int pos = (wc & 1) ? (t & 63) : (t >> 6); const f32x4* pp = (const f32x4*)(rope + (pos * 16 + 4 * fq) * 2); cs0 = pp[0]; cs1 = pp[1]; }
                    const f32x4 cv = {cs0[0], cs0[2], cs1[0], cs1[2]}, sv = {cs0[1], cs0[3], cs1[1], cs1[3]};
#pragma unroll
                    for (int bj = 0; bj < 2; ++bj) {
                        const f32x4 a = acc[ai][bj][m][0], b = acc[ai][bj][m][1];
                        f32x4 na = a * cv - b * sv, nb = b * cv + a * sv;
                        if (u.pn < 4) { na = na * 0.125f; nb = nb * 0.125f;
                            bf16_t* d = Q + (size_t)row * 1024 + u.pn * 256 + bj * HALF + wc * 32 + fq * 4;
                            *(u32x2*)d = f32_to_bf4(na); *(u32x2*)(d + 16) = f32_to_bf4(nb);
                        } else {
                            bf16_t* d = Kb + (size_t)row * 256 + bj * HALF + wc * 32 + fq * 4;
                            *(u32x2*)d = f32_to_bf4(na); *(u32x2*)(d + 16) = f32_to_bf4(nb);
                        }
                    }
                }
        } else {
#pragma unroll
            for (int ai = 0; ai < 2; ++ai)
#pragma unroll
                for (int m = 0; m < 4; ++m) {
                    const int row = u.pm * BM + ai * HALF + wr * 64 + m * 16 + fr;
                    bf16_t* base; size_t stride;
                    if (lat) { const int b = row >> 11, t = row & 2047; base = VT + (size_t)b * 256 * 2048 + t; stride = 2048; }
                    else { const int rc = row - ML; const int b = rc >> 8, t = rc & 255; base = VTC + (size_t)b * 256 * 256 + t; stride = 256; }
#pragma unroll
                    for (int bj = 0; bj < 2; ++bj)
#pragma unroll
                        for (int n = 0; n < 2; ++n)
#pragma unroll
                            for (int j = 0; j < 4; ++j) { const int vc = bj * HALF + wc * 32 + n * 16 + fq * 4 + j; base[(size_t)vc * stride] = (bf16_t)f2bf(acc[ai][bj][m][n][j]); }
                }
        }
    }
};

struct EpiInProj {
    static constexpr bool WITH_LDS = false;
    bf16_t* R; bf16_t* GB;
    __device__ __forceinline__ void operator()(const f32x4 (&acc)[2][2][4][2], const Unit& u, int wr, int wc, int fr_, int fq_) const {
        int fr = fr_, fq = fq_; asm volatile("" : "+v"(fr), "+v"(fq));
        const bool rec = u.pn >= 5;
        const int col0 = (rec ? (u.pn - 5) * BM : 0) + wc * 32 + fq * 4; const int ldc = rec ? DRNN : 256; bf16_t* O = rec ? R : GB;
#pragma unroll
        for (int ai = 0; ai < 2; ++ai)
#pragma unroll
            for (int m = 0; m < 4; ++m) { bf16_t* rowp = O + (size_t)(u.pm * BM + ai * HALF + wr * 64 + m * 16 + fr) * ldc + col0;
#pragma unroll
                for (int bj = 0; bj < 2; ++bj)
#pragma unroll
                    for (int n = 0; n < 2; ++n) { f32x4 v = acc[ai][bj][m][n];
                        if (!rec) {
#pragma unroll
                            for (int j = 0; j < 4; ++j) { const float x = v[j]; v[j] = x * fsigmoid(1.5957691216057308f * (x + 0.044715f * x * x * x)); } }
                        *(u32x2*)(rowp + bj * HALF + n * 16) = f32_to_bf4(v); } }
    }
};

struct EpiGates {
    static constexpr bool WITH_LDS = false;
    const bf16_t* U; bf16_t* LA; bf16_t* BX; const float* ba; const float* bi; const float* nls;
    __device__ __forceinline__ void operator()(const f32x4 (&acc)[2][2][4][2], const Unit& u, int wr, int wc, int fr_, int fq_) const {
        int fr = fr_, fq = fq_; asm volatile("" : "+v"(fr), "+v"(fq));
        const int tile = u.pn >> 1, dir = tile / 5, blk = tile % 5, chalf = u.pn & 1;
        const int ch0 = blk * 256 + chalf * 128 + wc * 32 + fq * 4;
#pragma unroll
        for (int n = 0; n < 2; ++n) {
            const int ch = ch0 + n * 16;
            const f32x4 bav = *(const f32x4*)(ba + dir * DRNN + ch), biv = *(const f32x4*)(bi + dir * DRNN + ch), nl = *(const f32x4*)(nls + dir * DRNN + ch);
#pragma unroll
            for (int ai = 0; ai < 2; ++ai)
#pragma unroll
                for (int m = 0; m < 4; ++m) {
                    const int rin = ai * HALF + wr * 64 + m * 16 + fr;
                    const size_t rowg = (size_t)u.pm * BM + rin, rowl = (size_t)u.po * BM + rin;
                    const f32x4 uv = bf4_to_f32(*(const u32x2*)(U + rowg * DRNN + ch));
                    f32x4 lav, bxv;
#pragma unroll
                    for (int j = 0; j < 4; ++j) {
                        const float r = fsigmoid(acc[ai][0][m][n][j] + bav[j]);
                        const float ig = fsigmoid(acc[ai][1][m][n][j] + biv[j]);
                        const float la = nl[j] * r, x = 2.0f * la;
                        float om;
                        if (x > -0.5f) { float q = 1.0f / 720.0f; q = q * x + 1.0f / 120.0f; q = q * x + 1.0f / 24.0f; q = q * x + 1.0f / 6.0f; q = q * x + 0.5f; q = q * x + 1.0f; om = -x * q; }
                        else om = 1.0f - __expf(x);
                        lav[j] = la; bxv[j] = __builtin_amdgcn_sqrtf(om) * (ig * uv[j]);
                    }
                    const size_t o = ((size_t)dir * 9216 + rowl) * DRNN + ch;
                    *(u32x2*)(LA + o) = f32_to_bf4(lav); *(u32x2*)(BX + o) = f32_to_bf4(bxv);
                    asm volatile("" ::: "memory");
                }
        }
    }
};

#define SC_STEP(d) \
    "v_fmac_f32_dpp %1, %1, %0 row_shr:" #d " row_mask:0xf bank_mask:0xf\n\t" "v_mul_f32_dpp %0, %0, %0 row_shr:" #d " row_mask:0xf bank_mask:0xf\n\t" \
    "v_fmac_f32_dpp %3, %3, %2 row_shr:" #d " row_mask:0xf bank_mask:0xf\n\t" "v_mul_f32_dpp %2, %2, %2 row_shr:" #d " row_mask:0xf bank_mask:0xf\n\t" \
    "v_fmac_f32_dpp %5, %5, %4 row_shr:" #d " row_mask:0xf bank_mask:0xf\n\t" "v_mul_f32_dpp %4, %4, %4 row_shr:" #d " row_mask:0xf bank_mask:0xf\n\t" \
    "v_fmac_f32_dpp %7, %7, %6 row_shr:" #d " row_mask:0xf bank_mask:0xf\n\t" "v_mul_f32_dpp %6, %6, %6 row_shr:" #d " row_mask:0xf bank_mask:0xf\n\t"
__device__ __forceinline__ void scan16x4(float& a0, float& b0, float& a1, float& b1, float& a2, float& b2, float& a3, float& b3) {
    asm volatile("s_nop 1\n\t" SC_STEP(1) SC_STEP(2) SC_STEP(4) SC_STEP(8)
                 : "+v"(a0), "+v"(b0), "+v"(a1), "+v"(b1), "+v"(a2), "+v"(b2), "+v"(a3), "+v"(b3));
}
struct EpiGatesScan {
    static constexpr bool WITH_LDS = true;
    const bf16_t* U; bf16_t* RECF; bf16_t* RECB; const float* ba; const float* bi; const float* nls; float* CARRY; unsigned* FLAG;
    __device__ __forceinline__ void run(f32x4 (&acc)[2][2][4][2], const Unit& u, int wr, int wc, int lane_, LAS unsigned char* lds) const {
        int lane = lane_; asm volatile("" : "+v"(lane));
        const int fr = lane & 15, fq = lane >> 4;
        LAS float* carry = (LAS float*)(lds + 131072);
        const int tile = u.pn >> 1, dir = tile / 5, blk = tile % 5, chalf = u.pn & 1;
        const int ch0 = blk * 256 + chalf * 128 + wc * 32 + fq * 4;
        const int rmask = dir ? 255 : 0;
        bf16_t* REC = dir ? RECB : RECF;
#pragma unroll
        for (int n = 0; n < 2; ++n) {
            const int ch = ch0 + n * 16;
            const f32x4 bav2 = *(const f32x4*)(ba + dir * DRNN + ch) * (-LOG2E), biv2 = *(const f32x4*)(bi + dir * DRNN + ch) * (-LOG2E), nl = *(const f32x4*)(nls + dir * DRNN + ch);
            const f32x4 nl2 = nl * LOG2E, nlx = nl * 2.0f;
#pragma unroll
            for (int ai = 0; ai < 2; ++ai)
#pragma unroll
                for (int m = 0; m < 4; ++m) {
                    const size_t rowg = (size_t)u.pm * BM + ((ai * HALF + wr * 64 + m * 16 + fr) ^ rmask);
                    const f32x4 uv = bf4_to_f32(*(const u32x2*)(U + rowg * DRNN + ch));
                    float av[4], bv[4];
#pragma unroll
                    for (int j = 0; j < 4; ++j) {
                        const float r = __builtin_amdgcn_rcpf(1.0f + __builtin_amdgcn_exp2f(acc[ai][0][m][n][j] * (-LOG2E) + bav2[j]));
                        const float ig = __builtin_amdgcn_rcpf(1.0f + __builtin_amdgcn_exp2f(acc[ai][1][m][n][j] * (-LOG2E) + biv2[j]));
                        const float x = nlx[j] * r, a = __builtin_amdgcn_exp2f(nl2[j] * r);
                        const float om = (x > -0.0625f) ? -x * (1.0f + x * (0.5f + x * (1.0f / 6.0f + x * (1.0f / 24.0f)))) : 1.0f - a * a;
                        av[j] = a; bv[j] = __builtin_amdgcn_sqrtf(om) * (ig * uv[j]);
                    }
                    scan16x4(av[0], bv[0], av[1], bv[1], av[2], bv[2], av[3], bv[3]);
#pragma unroll
                    for (int j = 0; j < 4; ++j) { acc[ai][0][m][n][j] = av[j]; acc[ai][1][m][n][j] = bv[j]; }
                    __builtin_amdgcn_sched_barrier(0);
                }
        }
        const int tid_ = threadIdx.x;
        if (u.po > 0 && tid_ < 64) {
            unsigned* fl = FLAG + (size_t)(u.lin - 160) * 16; unsigned sp = 0;
            while (__hip_atomic_load(fl, __ATOMIC_RELAXED, __HIP_MEMORY_SCOPE_AGENT) == 0u) { __builtin_amdgcn_s_sleep(2); if (++sp > (1u << 22)) break; }
        }
        asm volatile("s_waitcnt vmcnt(0) lgkmcnt(0)" ::: "memory"); __builtin_amdgcn_s_barrier(); asm volatile("" ::: "memory");
        if (tid_ < 128) carry[tid_] = (u.po > 0) ? __hip_atomic_load(CARRY + (size_t)(u.lin - 160) * 128 + tid_, __ATOMIC_RELAXED, __HIP_MEMORY_SCOPE_AGENT) : 0.0f;
        asm volatile("s_waitcnt vmcnt(0) lgkmcnt(0)" ::: "memory"); __builtin_amdgcn_s_barrier(); asm volatile("" ::: "memory");
        const bool emit = u.pm < 64;
        const int lastl = (lane & 48) | 15;
#pragma unroll
        for (int seg = 0; seg < 4; ++seg) {
            const int ai = seg >> 1, wrs = seg & 1;
            if (wr == wrs) {
                f32x4 hg[2];
#pragma unroll
                for (int n = 0; n < 2; ++n) hg[n] = *(const LAS f32x4*)(carry + wc * 32 + n * 16 + fq * 4);
#pragma unroll
                for (int m = 0; m < 4; ++m) {
                    f32x4 h[2];
#pragma unroll
                    for (int n = 0; n < 2; ++n) h[n] = acc[ai][0][m][n] * hg[n] + acc[ai][1][m][n];
                    if (emit) { bf16_t* rp = REC + ((size_t)u.pm * BM + ((ai * HALF + wr * 64 + m * 16 + fr) ^ rmask)) * DRNN + ch0;
#pragma unroll
                        for (int n = 0; n < 2; ++n) *(u32x2*)(rp + n * 16) = f32_to_bf4(h[n]); }
#pragma unroll
                    for (int n = 0; n < 2; ++n)
#pragma unroll
                        for (int j = 0; j < 4; ++j) hg[n][j] = __shfl(h[n][j], lastl);
                }
                if (fr == 0) {
#pragma unroll
                    for (int n = 0; n < 2; ++n) *(LAS f32x4*)(carry + wc * 32 + n * 16 + fq * 4) = hg[n];
                }
            }
            asm volatile("s_waitcnt lgkmcnt(0)" ::: "memory"); __builtin_amdgcn_s_barrier(); asm volatile("" ::: "memory");
        }
        if (u.po < 8) {
            if (tid_ < 128) __hip_atomic_store(CARRY + (size_t)u.lin * 128 + tid_, carry[tid_], __ATOMIC_RELAXED, __HIP_MEMORY_SCOPE_AGENT);
            asm volatile("s_waitcnt vmcnt(0) lgkmcnt(0)" ::: "memory"); __builtin_amdgcn_s_barrier(); asm volatile("" ::: "memory");
            if (tid_ == 0) __hip_atomic_store(FLAG + (size_t)u.lin * 16, 1u, __ATOMIC_RELAXED, __HIP_MEMORY_SCOPE_AGENT);
        }
    }
};

struct EpiGateMul {
    static constexpr bool WITH_LDS = false;
    bf16_t* Z; const bf16_t* RB;
    __device__ __forceinline__ void operator()(const f32x4 (&acc)[2][2][4][2], const Unit& u, int wr, int wc, int fr_, int fq_) const {
        int fr = fr_, fq = fq_; asm volatile("" : "+v"(fr), "+v"(fq));
        const int col0 = u.pn * BM + wc * 32 + fq * 4;
#pragma unroll
        for (int ai = 0; ai < 2; ++ai)
#pragma unroll
            for (int m = 0; m < 4; ++m) { bf16_t* rowp = Z + (size_t)(u.pm * BM + ai * HALF + wr * 64 + m * 16 + fr) * DRNN + col0;
#pragma unroll
                for (int bj = 0; bj < 2; ++bj)
#pragma unroll
                    for (int n = 0; n < 2; ++n) { const f32x4 v = acc[ai][bj][m][n]; const f32x4 rc = bf4_to_f32(*(const u32x2*)(rowp + bj * HALF + n * 16)) + bf4_to_f32(*(const u32x2*)(RB + (rowp - Z) + bj * HALF + n * 16)); f32x4 o;
#pragma unroll
                        for (int j = 0; j < 4; ++j) { const float x = v[j]; const float z2 = 1.5957691216057308f * (x + 0.044715f * x * x * x); o[j] = x * fsigmoid(z2) * rc[j]; }
                        *(u32x2*)(rowp + bj * HALF + n * 16) = f32_to_bf4(o); }
                asm volatile("" ::: "memory"); }
    }
};
}


#define XB_TMO      128
#define XB_XCNT(j)  (256  + 64 * (j))
#define XB_XSUB(j)  (1280 + 64 * (j))
#define XB_XGEN(j)  (2304 + 64 * (j))
#define XB_TOP      3328
#define XB_TOPGEN   3392
#define XCD_BAR_WORDS 3456
#define XB_SPIN_CAP (1u << 18)
__device__ __forceinline__ unsigned xb_ld(unsigned* p)              { return __hip_atomic_load(p, __ATOMIC_RELAXED, __HIP_MEMORY_SCOPE_AGENT); }
__device__ __forceinline__ unsigned xb_add(unsigned* p, unsigned v) { return __hip_atomic_fetch_add(p, v, __ATOMIC_RELAXED, __HIP_MEMORY_SCOPE_AGENT); }
__device__ __forceinline__ unsigned xb_xcc_id() { return (unsigned)__builtin_amdgcn_s_getreg((3 << 11) | 20) & 0xFu; }
#define XB_SPIN(cond, bar) do { unsigned _sp = 0; while (cond) { __builtin_amdgcn_s_sleep(1); \
    if ((++_sp & 255u) == 0u) { if (xb_ld(&(bar)[XB_TMO])) break; if (_sp > XB_SPIN_CAP) { atomicAdd(&(bar)[XB_TMO], 1u); break; } } } } while (0)
struct XcdBarrier { unsigned* bar; unsigned x; volatile LAS unsigned* st; };
__device__ __forceinline__ XcdBarrier xcd_barrier_post(unsigned* bar, volatile LAS unsigned* st) {
    XcdBarrier b; b.bar = bar; b.x = xb_xcc_id(); b.st = st;
    if (threadIdx.x == 0) (void)xb_add(&bar[XB_XCNT(b.x)], 1u);
    return b;
}
__device__ __forceinline__ void xcd_barrier_complete(unsigned* bar, unsigned x, unsigned& nloc, unsigned& nx) {
    const unsigned G = gridDim.x * gridDim.y * gridDim.z;
    unsigned sum, cnt, mine, sp = 0u;
    for (;;) {
        sum = 0u; cnt = 0u; mine = 0u;
#pragma unroll
        for (unsigned j = 0; j < 16; ++j) { const unsigned c = xb_ld(&bar[XB_XCNT(j)]); sum += c; cnt += (c > 0u) ? 1u : 0u; mine = (j == x) ? c : mine; }
        if (sum == G) break;
        __builtin_amdgcn_s_sleep(1);
        if ((++sp & 255u) == 0u) { if (xb_ld(&bar[XB_TMO])) break; if (sp > XB_SPIN_CAP) { atomicAdd(&bar[XB_TMO], 1u); break; } }
    }
    nloc = mine > 0u ? mine : 1u; nx = cnt > 0u ? cnt : 1u;
}
__device__ __forceinline__ void xcd_barrier(const XcdBarrier& b) {
    asm volatile("s_waitcnt vmcnt(0)" ::: "memory");
    __syncthreads();
    if (threadIdx.x == 0) {
        unsigned* bar = b.bar;
        __builtin_amdgcn_s_waitcnt(0);
        unsigned nloc = b.st[0], nx = b.st[1];
        if (nloc == 0u) { xcd_barrier_complete(bar, b.x, nloc, nx); b.st[0] = nloc; b.st[1] = nx; }
        const unsigned old = xb_add(&bar[XB_XSUB(b.x)], 1u);
        const unsigned gen = old / nloc;
        if (old + 1u == (gen + 1u) * nloc) {
            __builtin_amdgcn_fence(__ATOMIC_RELEASE, "agent");
            asm volatile("s_waitcnt vmcnt(0)" ::: "memory");
            const unsigned og = xb_add(&bar[XB_TOP], 1u);
            const unsigned tg = og / nx;
            if (og + 1u == (tg + 1u) * nx) xb_add(&bar[XB_TOPGEN], 1u);
            else XB_SPIN(xb_ld(&bar[XB_TOPGEN]) == tg, bar);
            __builtin_amdgcn_fence(__ATOMIC_ACQUIRE, "agent");
            xb_add(&bar[XB_XGEN(b.x)], 1u);
            asm volatile("s_waitcnt vmcnt(0)" ::: "memory");
        } else {
            XB_SPIN(xb_ld(&bar[XB_XGEN(b.x)]) == gen, bar);
            __builtin_amdgcn_fence(__ATOMIC_ACQUIRE, "agent");
            asm volatile("s_waitcnt vmcnt(0)" ::: "memory");
        }
    }
    __syncthreads();
}

struct Params {
    const float *x, *c, *ctx, *c_ctx, *ada_w, *ada_b, *norm_g, *mlp_w1, *mlp_w2, *w_qkv, *w_o, *sink;
    const float *w_in, *conv_w, *conv_b, *w_a, *b_a, *w_i, *b_i, *lam, *w_out;
    float* out; unsigned char* ws;
};

typedef const __attribute__((address_space(4))) Params* ParamsK;
__device__ __forceinline__ void transpose_item(const float* W, int ldw, bf16_t* WT, int ldwt, int k0, int n0, int dst_row0, LAS float* scr, int lane) {
#pragma unroll 8
    for (int i = 0; i < 32; ++i) { const int kk = 2 * i + (lane >> 5); scr[kk * 33 + (lane & 31)] = W[(size_t)(k0 + kk) * ldw + n0 + (lane & 31)]; }
    asm volatile("s_waitcnt lgkmcnt(0)" ::: "memory");
    const int c = lane & 7;
#pragma unroll
    for (int j = 0; j < 4; ++j) { const int n = (lane >> 3) + 8 * j; const LAS float* s = scr + (8 * c) * 33 + n;
        u32x4 o; o.x = cvt_pk_bf16(s[0 * 33], s[1 * 33]); o.y = cvt_pk_bf16(s[2 * 33], s[3 * 33]); o.z = cvt_pk_bf16(s[4 * 33], s[5 * 33]); o.w = cvt_pk_bf16(s[6 * 33], s[7 * 33]);
        *(u32x4*)(WT + (size_t)(dst_row0 + n) * ldwt + k0 + 8 * c) = o; }
    asm volatile("s_waitcnt lgkmcnt(0)" ::: "memory");
}
__device__ __forceinline__ void transpose_plain(const float* W, int K, int N, bf16_t* WT, int r, LAS float* scr, int lane) {
    const int nblk = N / 32, kb = r / nblk, nb = r % nblk;
    transpose_item(W, N, WT, K, 64 * kb, 32 * nb, 32 * nb, scr, lane);
}

constexpr int I_QKV = 16 * 48, I_O = 16 * 32, I_1 = 16 * 128, I_2 = 64 * 32, I_IN = 16 * 80, I_OUT = 20 * 32, I_G = 40 * 16;
constexpr int TR_L0 = I_QKV + I_O + I_1 + I_2, TR_LRU = I_IN + I_OUT + I_G, TR_MLP1 = I_1 + I_2;
struct TrItem { const float* W; bf16_t* WT; int ldw, ldwt, k0, n0, drow; };
__device__ __forceinline__ TrItem tr_decode(ParamsK p, unsigned char* ws, int it) {
    TrItem d; int r = it;
#define TR_PLAIN(Wp, K_, N_, WTp) do { const int nblk_ = (N_) / 32, kb_ = r / nblk_, nb_ = r % nblk_; d.W = (Wp); d.WT = (WTp); d.ldw = (N_); d.ldwt = (K_); d.k0 = 64 * kb_; d.n0 = 32 * nb_; d.drow = 32 * nb_; return d; } while (0)
    if (r < I_QKV) TR_PLAIN(p->w_qkv, 1024, NQKV, (bf16_t*)(ws + WS_WQKV)); r -= I_QKV;
    if (r < I_O) TR_PLAIN(p->w_o, 1024, 1024, (bf16_t*)(ws + WS_WO)); r -= I_O;
    if (r < I_1) TR_PLAIN(p->mlp_w1, 1024, DFF, (bf16_t*)(ws + WS_W1)); r -= I_1;
    if (r < I_2) TR_PLAIN(p->mlp_w2, DFF, 1024, (bf16_t*)(ws + WS_W2)); r -= I_2;
    if (r < I_IN) TR_PLAIN(p->w_in, 1024, 2 * DRNN, (bf16_t*)(ws + WS_WIN)); r -= I_IN;
    if (r < I_OUT) TR_PLAIN(p->w_out, DRNN, 1024, (bf16_t*)(ws + WS_WOUT)); r -= I_OUT;
    if (r < I_G) {
        const int sm = r >> 4, ii = r & 15, kb = ii >> 2, nb = ii & 3;
        const int chalf = sm & 1, blk = (sm >> 1) % 5, dg = (sm >> 1) / 5, gate = dg & 1, dir = dg >> 1;
        d.W = (gate ? p->w_i : p->w_a) + (size_t)(dir * 5 + blk) * 256 * 256; d.WT = (bf16_t*)(ws + WS_WG); d.ldw = 256; d.ldwt = 256;
        d.k0 = 64 * kb; d.n0 = chalf * 128 + nb * 32; d.drow = ((dir * 5 + blk) * 2 + chalf) * 256 + gate * 128 + nb * 32; return d; }
    r -= I_G;
    if (r < I_1) TR_PLAIN(p->mlp_w1 + (size_t)1024 * DFF, 1024, DFF, (bf16_t*)(ws + WS_W1 + 16 * MiB)); r -= I_1;
    TR_PLAIN(p->mlp_w2 + (size_t)1024 * DFF, DFF, 1024, (bf16_t*)(ws + WS_W2 + 16 * MiB));
#undef TR_PLAIN
}
__device__ __forceinline__ void transpose_range(ParamsK p, unsigned char* ws, LAS unsigned char* lds, int first, int count, int w, int nw, int wave, int lane) {
    LAS float* scr = (LAS float*)(lds + wave * 16384);
    int it = first + w; if (it >= first + count) return;
    float cur[32], nxt[32];
    TrItem d = tr_decode(p, ws, it);
#pragma unroll
    for (int i = 0; i < 32; ++i) cur[i] = d.W[(size_t)(d.k0 + 2 * i + (lane >> 5)) * d.ldw + d.n0 + (lane & 31)];
    for (;;) {
        const int itn = it + nw; const bool more = itn < first + count;
        TrItem dn = d;
        if (more) { dn = tr_decode(p, ws, itn);
#pragma unroll
            for (int i = 0; i < 32; ++i) nxt[i] = dn.W[(size_t)(dn.k0 + 2 * i + (lane >> 5)) * dn.ldw + dn.n0 + (lane & 31)]; }
#pragma unroll
        for (int i = 0; i < 32; ++i) scr[(2 * i + (lane >> 5)) * 33 + (lane & 31)] = cur[i];
        asm volatile("s_waitcnt lgkmcnt(0)" ::: "memory");
        const int c = lane & 7;
#pragma unroll
        for (int j = 0; j < 4; ++j) { const int n = (lane >> 3) + 8 * j; const LAS float* s = scr + (8 * c) * 33 + n;
            u32x4 o; o.x = cvt_pk_bf16(s[0 * 33], s[1 * 33]); o.y = cvt_pk_bf16(s[2 * 33], s[3 * 33]); o.z = cvt_pk_bf16(s[4 * 33], s[5 * 33]); o.w = cvt_pk_bf16(s[6 * 33], s[7 * 33]);
            *(u32x4*)(d.WT + (size_t)(d.drow + n) * d.ldwt + d.k0 + 8 * c) = o; }
        asm volatile("s_waitcnt lgkmcnt(0)" ::: "memory");
        if (!more) break;
#pragma unroll
        for (int i = 0; i < 32; ++i) cur[i] = nxt[i];
        d = dn; it = itn;
    }
}
__device__ __forceinline__ void idle_transposes(ParamsK p, unsigned char* ws, LAS unsigned char* lds, int first, int count, int nwg, int G, int bid, int wave, int lane) {
    const int rem = nwg % G;
    if (rem == 0) transpose_range(p, ws, lds, first, count, bid * 8 + wave, G * 8, wave, lane);
    else if (bid >= rem) transpose_range(p, ws, lds, first, count, (bid - rem) * 8 + wave, (G - rem) * 8, wave, lane);
    __syncthreads();
}

__device__ __forceinline__ void prologue(ParamsK p, LAS unsigned char* lds, int tid, int lane, int wave) {
    unsigned char* ws = p->ws;
    float* MOD = (float*)(ws + WS_MOD);
    if (blockIdx.x < 192) {
        LAS float* sl = (LAS float*)lds;
        LAS float* red = (LAS float*)(lds + 36864);
        for (int idx = tid; idx < 9216; idx += 512) { const int w = idx >> 10, k = idx & 1023; const float v = (w < 8) ? p->c[w * 1024 + k] : p->c_ctx[k]; sl[idx] = v / (1.0f + __expf(-v)); }
        __syncthreads();
        const int l = blockIdx.x / 96, n0 = (blockIdx.x % 96) * 64, kg = tid >> 4, cq = tid & 15;
        f32x4 acc[9];
#pragma unroll
        for (int w = 0; w < 9; ++w) acc[w] = (f32x4){0.f, 0.f, 0.f, 0.f};
        const float* wb = p->ada_w + (size_t)l * 1024 * 6144 + n0 + cq * 4;
#pragma unroll 1
        for (int it0 = 0; it0 < 32; it0 += 8) {
            f32x4 w4[8];
#pragma unroll
            for (int u = 0; u < 8; ++u) w4[u] = *(const f32x4*)(wb + (size_t)((it0 + u) * 32 + kg) * 6144);
#pragma unroll
            for (int u = 0; u < 8; ++u) { const int k = (it0 + u) * 32 + kg;
#pragma unroll
                for (int w = 0; w < 9; ++w) acc[w] += sl[w * 1024 + k] * w4[u]; }
        }
#pragma unroll
        for (int w = 0; w < 9; ++w) *(LAS f32x4*)(red + (kg * 9 + w) * 64 + cq * 4) = acc[w];
        __syncthreads();
        for (int idx = tid; idx < 9 * 64; idx += 512) { const int w = idx >> 6, n = idx & 63; float s = 0.f;
#pragma unroll
            for (int g = 0; g < 32; ++g) s += red[(g * 9 + w) * 64 + n];
            MOD[(size_t)(l * 9 + w) * 6144 + n0 + n] = s + p->ada_b[l * 6144 + n0 + n]; }
        __syncthreads();
    }
    if (blockIdx.x == gridDim.x - 1) {
        float* rope = (float*)(ws + WS_ROPE); float* nls = (float*)(ws + WS_NLS);
        for (int idx = tid; idx < 1024; idx += 512) { const int pos = idx >> 4, i = idx & 15;
            const float inv = __builtin_exp2f(-(float)i * (13.287712379549449f / 16.0f));
            const float angf = (float)pos * inv; const double ang = (double)angf;
            const double twopi = 6.283185307179586476925287; const double r = ang - twopi * __builtin_rint(ang / twopi);
            const double r2 = r * r; double cterm = 1.0, sterm = r, cs = 1.0, sn = r;
            for (int k = 1; k <= 14; ++k) { cterm *= -r2 / (double)((2 * k - 1) * (2 * k)); sterm *= -r2 / (double)((2 * k) * (2 * k + 1)); cs += cterm; sn += sterm; }
            rope[idx * 2] = (float)cs; rope[idx * 2 + 1] = (float)sn; }
        for (int idx = tid; idx < 2 * DRNN; idx += 512) { const float lm = p->lam[idx]; nls[idx] = -8.0f * log1pf(__expf(-lm)); }
        { unsigned* fl = (unsigned*)(ws + WS_FLAG); for (int idx = tid; idx < 1440 * 16; idx += 512) fl[idx] = 0u; }
    }
    transpose_range(p, ws, lds, 0, TR_L0 + TR_LRU + TR_MLP1, blockIdx.x * 8 + wave, gridDim.x * 8, wave, lane);
}

template <bool HAS_Y, bool HAS_H>
__device__ __forceinline__ void row_phase(const float* xin_lat, const float* xin_ctx, float* xout_lat, float* xout_ctx, const bf16_t* Y, const bf16_t* SLAB, bf16_t* H,
                                          const float* gy, const float* gh, const float* mod_g, int gate_idx, const float* mod_h, int shift_idx, int scale_idx,
                                          int nrows, int gw, int ngw, int lane) {
    const int rpw = (nrows + ngw - 1) / ngw, r_begin = gw * rpw, r_end = (r_begin + rpw < nrows) ? r_begin + rpw : nrows;
    f32x4 xn[4]; u32x2 yn[4], ys[3][4];
    f32x4 vgy[4], vgh[4], vgt[4], vsh[4], vsc[4];
#pragma unroll
    for (int j = 0; j < 4; ++j) { if (HAS_Y) vgy[j] = *(const f32x4*)(gy + lane * 4 + 256 * j); if (HAS_H) vgh[j] = *(const f32x4*)(gh + lane * 4 + 256 * j); }
    int cur_who = -1;
#define ROW_LOAD(r) do { const int r_ = (r); const bool lat_ = r_ < ML; \
        const float* xi_ = lat_ ? xin_lat + (size_t)r_ * DM : xin_ctx + (size_t)(r_ - ML) * DM; \
        _Pragma("unroll") for (int j = 0; j < 4; ++j) xn[j] = *(const f32x4*)(xi_ + lane * 4 + 256 * j); \
        if (HAS_Y) { if (SLAB != nullptr && !lat_) { const bf16_t* yp_ = SLAB + (size_t)(r_ - ML) * DM + lane * 4; \
                _Pragma("unroll") for (int j = 0; j < 4; ++j) { yn[j] = *(const u32x2*)(yp_ + 256 * j); ys[0][j] = *(const u32x2*)(yp_ + 256 * j + (size_t)MC * DM); ys[1][j] = *(const u32x2*)(yp_ + 256 * j + (size_t)2 * MC * DM); ys[2][j] = *(const u32x2*)(yp_ + 256 * j + (size_t)3 * MC * DM); } } \
            else { _Pragma("unroll") for (int j = 0; j < 4; ++j) yn[j] = *(const u32x2*)(Y + (size_t)r_ * DM + lane * 4 + 256 * j); } } } while (0)
    if (r_begin < r_end) ROW_LOAD(r_begin);
    for (int row = r_begin; row < r_end; ++row) {
        const bool lat = row < ML; const int who = lat ? (row >> 11) : 8;
        if (who != cur_who) { cur_who = who;
#pragma unroll
            for (int j = 0; j < 4; ++j) { const int col = lane * 4 + 256 * j;
                if (HAS_Y) vgt[j] = *(const f32x4*)(mod_g + (size_t)who * 6144 + gate_idx * 1024 + col);
                if (HAS_H) { vsh[j] = *(const f32x4*)(mod_h + (size_t)who * 6144 + shift_idx * 1024 + col); vsc[j] = *(const f32x4*)(mod_h + (size_t)who * 6144 + scale_idx * 1024 + col) + 1.0f; } } }
        f32x4 xv[4], yv[4];
#pragma unroll
        for (int j = 0; j < 4; ++j) xv[j] = xn[j];
        if (HAS_Y) {
#pragma unroll
            for (int j = 0; j < 4; ++j) { yv[j] = bf4_to_f32(yn[j]);
                if (SLAB != nullptr && !lat) yv[j] = (yv[j] + bf4_to_f32(ys[0][j])) + (bf4_to_f32(ys[1][j]) + bf4_to_f32(ys[2][j])); }
        }
        asm volatile("" ::: "memory");
        if (row + 1 < r_end) ROW_LOAD(row + 1);
        if (HAS_Y) {
            float s = 0.f;
#pragma unroll
            for (int j = 0; j < 4; ++j) s += (yv[j][0] * yv[j][0] + yv[j][1] * yv[j][1]) + (yv[j][2] * yv[j][2] + yv[j][3] * yv[j][3]);
            const float rstd = 1.0f / sqrtf(wave_sum(s) * (1.0f / DM) + EPS);
            float* xo = lat ? xout_lat + (size_t)row * DM : xout_ctx + (size_t)(row - ML) * DM;
#pragma unroll
            for (int j = 0; j < 4; ++j) { xv[j] = xv[j] + vgt[j] * (yv[j] * rstd * vgy[j]); *(f32x4*)(xo + lane * 4 + 256 * j) = xv[j]; }
        }
        if (HAS_H) {
            float s = 0.f;
#pragma unroll
            for (int j = 0; j < 4; ++j) s += (xv[j][0] * xv[j][0] + xv[j][1] * xv[j][1]) + (xv[j][2] * xv[j][2] + xv[j][3] * xv[j][3]);
            const float rstd = 1.0f / sqrtf(wave_sum(s) * (1.0f / DM) + EPS);
#pragma unroll
            for (int j = 0; j < 4; ++j) { const f32x4 hv = (xv[j] * rstd * vgh[j]) * vsc[j] + vsh[j]; *(u32x2*)(H + (size_t)row * DM + lane * 4 + 256 * j) = f32_to_bf4(hv); }
        }
    }
#undef ROW_LOAD
}

__device__ __forceinline__ void attn_phase(LAS unsigned char* lds, const bf16_t* Q, bf16_t* O, const bf16_t* Kb, const bf16_t* VT, const bf16_t* VTC, const float* sink, int tid, int lane, int wave) {
    constexpr int PITCH = 72;
    LAS bf16_t* Ks = (LAS bf16_t*)lds;
    LAS bf16_t* Vs = (LAS bf16_t*)(lds + 2 * 64 * PITCH * 2);
    const int lr = lane & 15, lg = lane >> 4;
    const int skey = tid >> 3, spiece = tid & 7;
    for (int unit = blockIdx.x; unit < 576; unit += gridDim.x) {
        int b, kvh, qrow0, qblk, nloc, lt0; bool latu = unit < 512;
        if (latu) { b = unit >> 6; const int rem = unit & 63; qblk = rem >> 2; kvh = rem & 3; qrow0 = b * SEQ + qblk * 128; lt0 = (qblk == 0) ? 2 : 0; nloc = ((qblk == 15) ? 4 : 6) - lt0; }
        else { const int cu = unit - 512; b = cu >> 3; kvh = (cu & 7) >> 1; qblk = 0; qrow0 = ML + b * CTX + (cu & 1) * 128; lt0 = 0; nloc = 0; }
        const int nlo = (latu && qblk > 0) ? 2 : 0, nmid = latu ? 2 : 0, nup = (latu && qblk < 15) ? 2 : 0;
        const int n1 = nlo, n2 = nlo + nmid, n3 = n2 + 4, nT = n3 + nup; (void)nloc; (void)lt0;
        const int head = kvh * 4 + (wave >> 1);
        const int qr0 = qrow0 + (wave & 1) * 64;
        const bf16_t* qbase = Q + (size_t)qr0 * 1024 + head * 64;
        bf16_t* obase = O + (size_t)qr0 * 1024 + head * 64;
        LAS unsigned char* Qs = lds + 40960 + wave * 8192;
#pragma unroll
        for (int qt = 0; qt < 4; ++qt)
#pragma unroll
            for (int dh = 0; dh < 2; ++dh) *(LAS bf16x8*)(Qs + (qt * 2 + dh) * 1024 + lane * 16) = *(const bf16x8*)(qbase + (unsigned)((qt * 16 + lr) * 1024 + dh * 32 + lg * 8));
        f32x4 o[4][4];
#pragma unroll
        for (int qt = 0; qt < 4; ++qt)
#pragma unroll
            for (int dt = 0; dt < 4; ++dt) o[qt][dt] = (f32x4){0.f, 0.f, 0.f, 0.f};
        float m2[4], ls[4];
        { const float sk = sink[head] * LOG2E;
#pragma unroll
          for (int qt = 0; qt < 4; ++qt) { m2[qt] = sk; ls[qt] = (lg == 0) ? 1.0f : 0.0f; } }
        u32x4 kreg, vreg;
#define ATT_TOK0(j_) ((qblk - 1) * 128 + (((j_) < n1) ? (j_) : (((j_) < n2) ? 2 + (j_) - n1 : 4 + (j_) - n3)) * 64)
#define ATT_LOAD(j) do { const int _j = (j); if (_j < n2 || _j >= n3) { const int tok0 = ATT_TOK0(_j); \
                const bf16_t* kb_ = Kb + (size_t)(b * SEQ + tok0) * 256 + kvh * 64; const bf16_t* vb_ = VT + (size_t)(b * 4 + kvh) * 64 * SEQ + tok0; \
                kreg = *(const u32x4*)(kb_ + (unsigned)(skey * 256 + spiece * 8)); vreg = *(const u32x4*)(vb_ + (unsigned)(skey * SEQ + spiece * 8)); } \
            else { const int tok0 = (_j - n2) * 64; \
                const bf16_t* kb_ = Kb + (size_t)(ML + b * CTX + tok0) * 256 + kvh * 64; const bf16_t* vb_ = VTC + (size_t)(b * 4 + kvh) * 64 * CTX + tok0; \
                kreg = *(const u32x4*)(kb_ + (unsigned)(skey * 256 + spiece * 8)); vreg = *(const u32x4*)(vb_ + (unsigned)(skey * CTX + spiece * 8)); } } while (0)
#define ATT_STORE(buf) do { *(LAS u32x4*)(Ks + (buf) * 64 * PITCH + skey * PITCH + spiece * 8) = kreg; *(LAS u32x4*)(Vs + (buf) * 64 * PITCH + skey * PITCH + spiece * 8) = vreg; } while (0)
        __syncthreads();
        ATT_LOAD(0); ATT_STORE(0);
        __syncthreads();
#define ATT_BODY(MM) { \
            const int buf = j & 1; \
            if (j + 1 < nT) ATT_LOAD(j + 1); \
            const LAS bf16_t* Kt = Ks + buf * 64 * PITCH; const LAS bf16_t* Vt = Vs + buf * 64 * PITCH; \
            const int ktok0 = ATT_TOK0(j); \
            bf16x8 kf[4][2]; \
            _Pragma("unroll") \
            for (int ks = 0; ks < 4; ++ks) \
            _Pragma("unroll") \
                for (int dh = 0; dh < 2; ++dh) kf[ks][dh] = *(const LAS bf16x8*)(Kt + (ks * 16 + lr) * PITCH + dh * 32 + lg * 8); \
            _Pragma("unroll") \
            for (int hq = 0; hq < 2; ++hq) { \
            bf16x8 pb[2][2]; \
            _Pragma("unroll") \
            for (int q2 = 0; q2 < 2; ++q2) { \
                const int qt = hq * 2 + q2; \
                f32x4 s[4]; \
                const bf16x8 qf0 = *(const LAS bf16x8*)(Qs + (qt * 2 + 0) * 1024 + lane * 16), qf1 = *(const LAS bf16x8*)(Qs + (qt * 2 + 1) * 1024 + lane * 16); \
            _Pragma("unroll") \
                for (int ks = 0; ks < 4; ++ks) { s[ks] = __builtin_amdgcn_mfma_f32_16x16x32_bf16(kf[ks][0], qf0, (f32x4){0.f, 0.f, 0.f, 0.f}, 0, 0, 0); \
                    s[ks] = __builtin_amdgcn_mfma_f32_16x16x32_bf16(kf[ks][1], qf1, s[ks], 0, 0, 0); } \
                if (MM == 1) {    \
                    const int lim = qblk * 128 + (wave & 1) * 64 + qt * 16 + lr - 128 - ktok0 - lg * 4; \
            _Pragma("unroll") \
                    for (int ks = 0; ks < 4; ++ks) \
            _Pragma("unroll") \
                        for (int jj = 0; jj < 4; ++jj) s[ks][jj] = (ks * 16 + jj >= lim) ? s[ks][jj] : -1e30f; \
                } else if (MM == 2) {    \
                    const int lim = qblk * 128 + (wave & 1) * 64 + qt * 16 + lr + 128 - ktok0 - lg * 4; \
            _Pragma("unroll") \
                    for (int ks = 0; ks < 4; ++ks) \
            _Pragma("unroll") \
                        for (int jj = 0; jj < 4; ++jj) s[ks][jj] = (ks * 16 + jj <= lim) ? s[ks][jj] : -1e30f; \
                } \
                float mx = -3e38f; \
            _Pragma("unroll") \
                for (int ks = 0; ks < 4; ++ks) mx = fmaxf(mx, fmaxf(fmaxf(s[ks][0], s[ks][1]), fmaxf(s[ks][2], s[ks][3]))); \
                mx = fmaxf(mx, __shfl_xor(mx, 16)); mx = fmaxf(mx, __shfl_xor(mx, 32)); \
                const float mnew = fmaxf(m2[qt], mx * LOG2E); \
                const float alpha = __builtin_amdgcn_exp2f(m2[qt] - mnew); \
                m2[qt] = mnew; \
                float rs = 0.f; \
            _Pragma("unroll") \
                for (int ks = 0; ks < 4; ++ks) \
            _Pragma("unroll") \
                    for (int jj = 0; jj < 4; ++jj) { const float pv = __builtin_amdgcn_exp2f(s[ks][jj] * LOG2E - mnew); s[ks][jj] = pv; rs += pv; } \
                ls[qt] = ls[qt] * alpha + rs; \
            _Pragma("unroll") \
                for (int dt = 0; dt < 4; ++dt) o[qt][dt] = o[qt][dt] * alpha; \
            _Pragma("unroll") \
                for (int c2 = 0; c2 < 2; ++c2) { u32x4 w; w.x = cvt_pk_bf16(s[2 * c2][0], s[2 * c2][1]); w.y = cvt_pk_bf16(s[2 * c2][2], s[2 * c2][3]); w.z = cvt_pk_bf16(s[2 * c2 + 1][0], s[2 * c2 + 1][1]); w.w = cvt_pk_bf16(s[2 * c2 + 1][2], s[2 * c2 + 1][3]); \
                    pb[q2][c2] = __builtin_bit_cast(bf16x8, w); } \
            } \
            _Pragma("unroll") \
            for (int c2 = 0; c2 < 2; ++c2) \
            _Pragma("unroll") \
                for (int dt = 0; dt < 4; ++dt) { \
                    const LAS bf16_t* vp = Vt + (dt * 16 + lr) * PITCH + c2 * 32 + lg * 4; \
                    const u32x2 v0 = *(const LAS u32x2*)vp, v1 = *(const LAS u32x2*)(vp + 16); \
                    const u32x4 vv = {v0.x, v0.y, v1.x, v1.y}; \
                    const bf16x8 vf = __builtin_bit_cast(bf16x8, vv); \
            _Pragma("unroll") \
                    for (int q2 = 0; q2 < 2; ++q2) o[hq * 2 + q2][dt] = __builtin_amdgcn_mfma_f32_16x16x32_bf16(vf, pb[q2][c2], o[hq * 2 + q2][dt], 0, 0, 0); \
                } \
            } \
            if (j + 1 < nT) ATT_STORE(buf ^ 1); \
            __syncthreads(); \
        }
        int j = 0;
#pragma unroll 1
        for (; j < n1; ++j) ATT_BODY(1)
#pragma unroll 1
        for (; j < n3; ++j) ATT_BODY(0)
#pragma unroll 1
        for (; j < nT; ++j) ATT_BODY(2)
#undef ATT_BODY
#pragma unroll
        for (int qt = 0; qt < 4; ++qt) {
            float l = ls[qt]; l += __shfl_xor(l, 16); l += __shfl_xor(l, 32);
            const float inv = 1.0f / l;
            int lro = lr * 1024 + lg * 4; asm volatile("" : "+v"(lro));
            bf16_t* op = obase + (unsigned)(qt * 16 * 1024 + lro);
#pragma unroll
            for (int dt = 0; dt < 4; ++dt) *(u32x2*)(op + dt * 16) = f32_to_bf4(o[qt][dt] * inv);
        }
    }
#undef ATT_LOAD
#undef ATT_TOK0
#undef ATT_STORE
}

__device__ __forceinline__ void conv_phase(const bf16_t* R, bf16_t* U, const float* cw, const float* cb, int gtid, int nthreads) {
    for (int idx = gtid; idx < MT * 160; idx += nthreads) {
        const int row = idx / 160, ch = (idx % 160) * 8;
        int t, T; if (row < ML) { t = row & 2047; T = SEQ; } else { t = (row - ML) & 255; T = CTX; }
        float acc[8];
        { const f32x4 b0 = *(const f32x4*)(cb + ch), b1 = *(const f32x4*)(cb + ch + 4); acc[0] = b0[0]; acc[1] = b0[1]; acc[2] = b0[2]; acc[3] = b0[3]; acc[4] = b1[0]; acc[5] = b1[1]; acc[6] = b1[2]; acc[7] = b1[3]; }
#pragma unroll
        for (int tap = 0; tap < 4; ++tap) { const int tt = t + tap - 2;
            if (tt >= 0 && tt < T) { const u32x4 rv = *(const u32x4*)(R + (size_t)(row + tap - 2) * DRNN + ch);
                const f32x4 w0 = *(const f32x4*)(cw + tap * DRNN + ch), w1 = *(const f32x4*)(cw + tap * DRNN + ch + 4);
                acc[0] += w0[0] * bf_lo(rv.x); acc[1] += w0[1] * bf_hi(rv.x); acc[2] += w0[2] * bf_lo(rv.y); acc[3] += w0[3] * bf_hi(rv.y);
                acc[4] += w1[0] * bf_lo(rv.z); acc[5] += w1[1] * bf_hi(rv.z); acc[6] += w1[2] * bf_lo(rv.w); acc[7] += w1[3] * bf_hi(rv.w); } }
        u32x4 o; o.x = cvt_pk_bf16(acc[0], acc[1]); o.y = cvt_pk_bf16(acc[2], acc[3]); o.z = cvt_pk_bf16(acc[4], acc[5]); o.w = cvt_pk_bf16(acc[6], acc[7]);
        *(u32x4*)(U + (size_t)row * DRNN + ch) = o;
    }
}
__device__ __forceinline__ int scan_row0(int bl, int c) { return (c < 8) ? (8192 + bl * CTX + c * 32) : (bl * SEQ + (c - 8) * 32); }
__device__ __forceinline__ void scanA_phase(const bf16_t* LA, const bf16_t* BX, float* SP, float* SH, int gtid, int nthreads) {
    for (int idx = gtid; idx < 2 * 4 * 72 * 640; idx += nthreads) {
        const int cp = idx % 640, r1 = idx / 640, c = r1 % 72, r2 = r1 / 72, bl = r2 & 3, dir = r2 >> 2;
        const int row0 = scan_row0(bl, c);
        const size_t base = ((size_t)dir * 9216 + row0) * DRNN + cp * 2;
        float P0 = 1.f, P1 = 1.f, H0 = 0.f, H1 = 0.f;
#pragma unroll 8
        for (int i = 0; i < 32; ++i) { const int ii = dir ? (31 - i) : i;
            const unsigned lw = *(const unsigned*)(LA + base + (size_t)ii * DRNN), bw = *(const unsigned*)(BX + base + (size_t)ii * DRNN);
            const float a0 = __expf(bf_lo(lw)), a1 = __expf(bf_hi(lw));
            P0 *= a0; P1 *= a1; H0 = a0 * H0 + bf_lo(bw); H1 = a1 * H1 + bf_hi(bw); }
        const size_t so = ((size_t)(dir * 4 + bl) * 72 + c) * DRNN + cp * 2;
        *(f32x2*)(SP + so) = (f32x2){P0, P1}; *(f32x2*)(SH + so) = (f32x2){H0, H1};
    }
}
__device__ __forceinline__ void scanB_phase(const float* SP, const float* SH, float* CIN, int gtid, int nthreads) {
    for (int idx = gtid; idx < 2 * 4 * DRNN; idx += nthreads) {
        const int ch = idx % DRNN, r = idx / DRNN, bl = r & 3, dir = r >> 2;
        const size_t base = ((size_t)(dir * 4 + bl) * 72) * DRNN + ch;
        float carry = 0.f;
#pragma unroll 1
        for (int s0 = 0; s0 < 72; s0 += 24) {
            float pv[24], hv[24];
#pragma unroll
            for (int s = 0; s < 24; ++s) { const int sq = s0 + s; const int c = dir ? (sq < 8 ? 7 - sq : 79 - sq) : sq; pv[s] = SP[base + (size_t)c * DRNN]; hv[s] = SH[base + (size_t)c * DRNN]; }
#pragma unroll
            for (int s = 0; s < 24; ++s) { const int sq = s0 + s; const int c = dir ? (sq < 8 ? 7 - sq : 79 - sq) : sq; CIN[base + (size_t)c * DRNN] = carry; carry = pv[s] * carry + hv[s]; }
        }
    }
}
__device__ __forceinline__ void scanC_phase(const bf16_t* LA, const bf16_t* BX, const float* CIN, bf16_t* REC, int half, int gtid, int nthreads) {
    for (int idx = gtid; idx < 4 * 64 * 640; idx += nthreads) {
        const int cp = idx % 640, r1 = idx / 640, lc = r1 & 63, bl = r1 >> 6;
        const int row0 = bl * SEQ + lc * 32;
        const size_t b0 = ((size_t)row0) * DRNN + cp * 2, b1 = ((size_t)9216 + row0) * DRNN + cp * 2;
        const f32x2 cf = *(const f32x2*)(CIN + ((size_t)(0 * 4 + bl) * 72 + 8 + lc) * DRNN + cp * 2);
        const f32x2 cbk = *(const f32x2*)(CIN + ((size_t)(1 * 4 + bl) * 72 + 8 + lc) * DRNN + cp * 2);
        float hf0[32], hf1[32];
        float h0 = cf[0], h1 = cf[1];
#pragma unroll
        for (int i = 0; i < 32; ++i) { const unsigned lw = *(const unsigned*)(LA + b0 + (size_t)i * DRNN), bw = *(const unsigned*)(BX + b0 + (size_t)i * DRNN);
            h0 = __expf(bf_lo(lw)) * h0 + bf_lo(bw); h1 = __expf(bf_hi(lw)) * h1 + bf_hi(bw); hf0[i] = h0; hf1[i] = h1; }
        h0 = cbk[0]; h1 = cbk[1];
        bf16_t* out = REC + ((size_t)(half * 4 + bl) * SEQ + lc * 32) * DRNN + cp * 2;
#pragma unroll
        for (int i = 31; i >= 0; --i) { const unsigned lw = *(const unsigned*)(LA + b1 + (size_t)i * DRNN), bw = *(const unsigned*)(BX + b1 + (size_t)i * DRNN);
            h0 = __expf(bf_lo(lw)) * h0 + bf_lo(bw); h1 = __expf(bf_hi(lw)) * h1 + bf_hi(bw);
            *(unsigned*)(out + (size_t)i * DRNN) = cvt_pk_bf16(hf0[i] + h0, hf1[i] + h1); }
    }
}

#ifndef PH_MASK
#define PH_MASK 0xFFFFFFFFu
#endif
#define PH(k) ((PH_MASK >> (k)) & 1u)
#ifndef REP_MASK
#define REP_MASK 0u
#endif
#define REP_BEGIN(k) _Pragma("unroll 1") for (int rep_ = 0; rep_ < (((REP_MASK >> (k)) & 1u) ? 2 : 1); ++rep_) {
#define REP_END }
__device__ __forceinline__ ParamsK kparams() { ParamsK q = (ParamsK)__builtin_amdgcn_kernarg_segment_ptr(); asm volatile("" : "+s"(q)); return q; }
#define PHASE_BEGIN ParamsK kp = kparams(); unsigned char* ws = kp->ws; (void)ws; \
    int tid = threadIdx.x; asm volatile("" : "+v"(tid)); const int lane = tid & 63, wave = __builtin_amdgcn_readfirstlane(tid >> 6); \
    const int gw = bid * 8 + wave, gtid = bid * 512 + tid; (void)lane; (void)gw; (void)gtid;
#define P_MOD0 ((float*)(ws + WS_MOD))
#define P_MOD1 ((float*)(ws + WS_MOD) + 9 * 6144)
#define P_CTXRES ((float*)(ws + WS_CTXRES))
#define P_H ((bf16_t*)(ws + WS_H))
#define P_SLAB ((bf16_t*)(ws + WS_SLAB))
#define P_Q ((bf16_t*)(ws + WS_Q))
#define P_O ((bf16_t*)(ws + WS_O))
#define P_K ((bf16_t*)(ws + WS_K))
#define P_VT ((bf16_t*)(ws + WS_VT))
#define P_VTC ((bf16_t*)(ws + WS_VTC))
#define P_ACT ((bf16_t*)(ws + WS_ACT))
#define P_U ((bf16_t*)(ws + WS_U))
#define P_RECF ((bf16_t*)(ws + WS_RECF))
#define P_RECB ((bf16_t*)(ws + WS_RECB))
#define P_LA ((bf16_t*)(ws + WS_LA))
#define P_BX ((bf16_t*)(ws + WS_BX))
#define P_RPRE ((bf16_t*)(ws + WS_RPRE))
#define P_SP ((float*)(ws + WS_SP))
#define P_SH ((float*)(ws + WS_SH))
#define P_CIN ((float*)(ws + WS_CIN))
#define G0 (kp->norm_g)
#define G1 (kp->norm_g + 4 * DM)

__global__ void __launch_bounds__(512, 2) fwd_megakernel(Params p) {
    extern __shared__ __attribute__((aligned(16))) unsigned char lds_raw[];
    LAS unsigned char* lds = (LAS unsigned char*)lds_raw;
    const int G = gridDim.x, bid = blockIdx.x;
    const int ngw = G * 8, nthreads = G * 512;
    using namespace pg8;
    if (threadIdx.x < 4) ((volatile LAS unsigned*)(lds + 132096))[threadIdx.x] = 0u;
    __syncthreads();
    XcdBarrier xbar = xcd_barrier_post((unsigned*)(p.ws + WS_BAR), (volatile LAS unsigned*)(lds + 132096));
    if (PH(0)) { PHASE_BEGIN prologue(kp, lds, tid, lane, wave); }
    xcd_barrier(xbar);
#ifdef EXTRA_SYNCS
#pragma unroll 1
    for (int es = 0; es < EXTRA_SYNCS; ++es) xcd_barrier(xbar);
#endif
    REP_BEGIN(1)
    if (PH(1)) { PHASE_BEGIN row_phase<false, true>(kp->x, kp->ctx, nullptr, nullptr, nullptr, nullptr, P_H, nullptr, G0, nullptr, 0, P_MOD0, 0, 1, MT, gw, ngw, lane); }
    xcd_barrier(xbar);
    REP_END
    if (PH(2)) {
        PHASE_BEGIN
        Gemm g{P_H, (const bf16_t*)(ws + WS_WQKV), DM, DM, DM}; Sched S; S.init(MT / 256, NQKV / 256, G, bid);
        EpiQKV E{P_Q, P_K, P_VT, P_VTC, (const float*)(ws + WS_ROPE)};
        gemm_phase<EpiQKV, true, true>(lds, g, S, E);
    }
    xcd_barrier(xbar);
    REP_BEGIN(3)
    if (PH(3)) { PHASE_BEGIN attn_phase(lds, P_Q, P_O, P_K, P_VT, P_VTC, kp->sink, tid, lane, wave); }
    xcd_barrier(xbar);
    REP_END
    if (PH(4)) {
        PHASE_BEGIN
        { Gemm g{P_O, (const bf16_t*)(ws + WS_WO), DM, DM, DM}; Sched S; S.init(ML / 256, DM / 256, G, bid);
          EpiPlain<0> E{P_H, DM};
          gemm_phase<EpiPlain<0>, true, true>(lds, g, S, E); }
        { Gemm g{P_O, (const bf16_t*)(ws + WS_WO), DM, DM, 256}; Sched S; S.init(8, 4 * 4, G, bid, 2, 256);
          EpiSlabCtx E{P_SLAB, 256};
          gemm_phase<EpiSlabCtx, true, true>(lds, g, S, E); }
    }
    xcd_barrier(xbar);
    if (PH(5)) { PHASE_BEGIN row_phase<true, true>(kp->x, kp->ctx, kp->out, P_CTXRES, P_H, P_SLAB, P_H, G0 + DM, G0 + 2 * DM, P_MOD0, 2, P_MOD0, 3, 4, MT, gw, ngw, lane); }
    xcd_barrier(xbar);
    if (PH(6)) {
        PHASE_BEGIN
        Gemm g{P_H, (const bf16_t*)(ws + WS_W1), DM, DM, DM}; Sched S; S.init(MT / 256, DFF / 256, G, bid);
        EpiPlain<1> E{P_ACT, DFF};
        gemm_phase<EpiPlain<1>, true, true>(lds, g, S, E);
    }
    xcd_barrier(xbar);
    if (PH(7)) {
        PHASE_BEGIN
        { Gemm g{P_ACT, (const bf16_t*)(ws + WS_W2), DFF, DFF, DFF}; Sched S; S.init(ML / 256, DM / 256, G, bid);
          EpiPlain<0> E{P_H, DM};
          gemm_phase<EpiPlain<0>, true, true>(lds, g, S, E); }
        { Gemm g{P_ACT, (const bf16_t*)(ws + WS_W2), DFF, DFF, 1024}; Sched S; S.init(8, 4 * 4, G, bid, 2, 1024);
          EpiSlabCtx E{P_SLAB, 1024};
          gemm_phase<EpiSlabCtx, true, true>(lds, g, S, E); }
    }
    xcd_barrier(xbar);
    if (PH(8)) { PHASE_BEGIN row_phase<true, true>(kp->out, P_CTXRES, kp->out, P_CTXRES, P_H, P_SLAB, P_H, G0 + 3 * DM, G1, P_MOD0, 5, P_MOD1, 0, 1, MT, gw, ngw, lane); }
    xcd_barrier(xbar);
    if (PH(9)) {
        PHASE_BEGIN
        Gemm g{P_H, (const bf16_t*)(ws + WS_WIN), DM, DM, DM}; Sched S; S.init(MT / 256, DRNN / 256, G, bid, 4, 0);
        EpiInProj E{P_RPRE, (bf16_t*)(ws + WS_CTXRES)};
        gemm_phase<EpiInProj, true, true>(lds, g, S, E);
    }
    xcd_barrier(xbar);
    REP_BEGIN(10)
    if (PH(10)) { PHASE_BEGIN conv_phase(P_RPRE, P_U, kp->conv_w, kp->conv_b, gtid, nthreads); }
    xcd_barrier(xbar);
    REP_END
    if (PH(11)) {
        PHASE_BEGIN
        Gemm g{P_U, (const bf16_t*)(ws + WS_WG), DRNN, 256, 256}; Sched S; S.init(1, 1, G, bid, 3, 0);
        EpiGatesScan E{P_U, P_RECF, P_RECB, kp->b_a, kp->b_i, (const float*)(ws + WS_NLS), (float*)(ws + WS_CARRY), (unsigned*)(ws + WS_FLAG)};
        gemm_phase<EpiGatesScan, true, true>(lds, g, S, E);
    }
    xcd_barrier(xbar);
    if (PH(15)) {
        PHASE_BEGIN
        Gemm g{P_H, (const bf16_t*)(ws + WS_WIN), DM, DM, DM}; Sched S; S.init(ML / 256, 4, G, bid);
        EpiGateMul E{P_RECF, P_RECB};
        gemm_phase<EpiGateMul, true, true>(lds, g, S, E);
        {
            const bf16_t* GB = (const bf16_t*)(ws + WS_CTXRES); bf16_t* Z = P_RECF; const bf16_t* RB = P_RECB;
            for (int idx = gtid; idx < ML * 32; idx += nthreads) { const int row = idx >> 5, c8 = (idx & 31) * 8;
                const u32x4 gv = *(const u32x4*)(GB + (size_t)row * 256 + c8); const size_t o = (size_t)row * DRNN + 1024 + c8;
                const u32x4 fv = *(const u32x4*)(Z + o), bv = *(const u32x4*)(RB + o); u32x4 w;
                w.x = cvt_pk_bf16(bf_lo(gv.x) * (bf_lo(fv.x) + bf_lo(bv.x)), bf_hi(gv.x) * (bf_hi(fv.x) + bf_hi(bv.x)));
                w.y = cvt_pk_bf16(bf_lo(gv.y) * (bf_lo(fv.y) + bf_lo(bv.y)), bf_hi(gv.y) * (bf_hi(fv.y) + bf_hi(bv.y)));
                w.z = cvt_pk_bf16(bf_lo(gv.z) * (bf_lo(fv.z) + bf_lo(bv.z)), bf_hi(gv.z) * (bf_hi(fv.z) + bf_hi(bv.z)));
                w.w = cvt_pk_bf16(bf_lo(gv.w) * (bf_lo(fv.w) + bf_lo(bv.w)), bf_hi(gv.w) * (bf_hi(fv.w) + bf_hi(bv.w)));
                *(u32x4*)(Z + o) = w; }
        }
    }
    xcd_barrier(xbar);
    if (PH(16)) {
        PHASE_BEGIN
        Gemm g{P_RECF, (const bf16_t*)(ws + WS_WOUT), DRNN, DRNN, DRNN}; Sched S; S.init(ML / 256, DM / 256, G, bid);
        EpiPlain<0> E{P_H, DM};
        gemm_phase<EpiPlain<0>, true, true>(lds, g, S, E);
    }
    xcd_barrier(xbar);
    if (PH(17)) { PHASE_BEGIN row_phase<true, true>(kp->out, P_CTXRES, kp->out, P_CTXRES, P_H, nullptr, P_H, G1 + DM, G1 + 2 * DM, P_MOD1, 2, P_MOD1, 3, 4, ML, gw, ngw, lane); }
    xcd_barrier(xbar);
    if (PH(18)) {
        PHASE_BEGIN
        Gemm g{P_H, (const bf16_t*)(ws + WS_W1 + 16 * MiB), DM, DM, DM}; Sched S; S.init(ML / 256, DFF / 256, G, bid);
        EpiPlain<1> E{P_ACT, DFF};
        gemm_phase<EpiPlain<1>, true, true>(lds, g, S, E);
    }
    xcd_barrier(xbar);
    if (PH(19)) {
        PHASE_BEGIN
        Gemm g{P_ACT, (const bf16_t*)(ws + WS_W2 + 16 * MiB), DFF, DFF, DFF}; Sched S; S.init(ML / 256, DM / 256, G, bid);
        EpiPlain<0> E{P_H, DM};
        gemm_phase<EpiPlain<0>, true, true>(lds, g, S, E);
    }
    xcd_barrier(xbar);
    if (PH(20)) { PHASE_BEGIN row_phase<true, false>(kp->out, P_CTXRES, kp->out, P_CTXRES, P_H, nullptr, nullptr, G1 + 3 * DM, nullptr, P_MOD1, 5, nullptr, 0, 0, ML, gw, ngw, lane); }
}

extern "C" void kernel_launch(void* const* d_in, const int* in_sizes, int n_in, void* d_out, int out_size, void* d_ws, size_t ws_size, hipStream_t stream) {
    static int grid_blocks = 0;
    if (grid_blocks == 0) {
        if (n_in != 21 || ws_size < WS_END) { fprintf(stderr, "kernel_launch: unexpected n_in %d / ws_size %zu\n", n_in, ws_size); grid_blocks = -1; return; }
        int dev = 0, cus = 0, per_cu = 0;
        hipGetDevice(&dev);
        hipDeviceGetAttribute(&cus, hipDeviceAttributeMultiprocessorCount, dev);
        if (hipFuncSetAttribute((const void*)fwd_megakernel, hipFuncAttributeMaxDynamicSharedMemorySize, LDS_BYTES) != hipSuccess) { fprintf(stderr, "hipFuncSetAttribute failed\n"); grid_blocks = -1; return; }
        if (hipOccupancyMaxActiveBlocksPerMultiprocessor(&per_cu, (const void*)fwd_megakernel, 512, LDS_BYTES) != hipSuccess || per_cu < 1) { fprintf(stderr, "occupancy query failed (%d)\n", per_cu); (void)hipGetLastError(); per_cu = 1; }
        grid_blocks = cus * 1;
    }
    if (grid_blocks < 0) return;
    Params p{};
    p.x = (const float*)d_in[0]; p.c = (const float*)d_in[1]; p.ctx = (const float*)d_in[2]; p.c_ctx = (const float*)d_in[3];
    p.ada_w = (const float*)d_in[4]; p.ada_b = (const float*)d_in[5]; p.norm_g = (const float*)d_in[6]; p.mlp_w1 = (const float*)d_in[7]; p.mlp_w2 = (const float*)d_in[8];
    p.w_qkv = (const float*)d_in[9]; p.w_o = (const float*)d_in[10]; p.sink = (const float*)d_in[11];
    p.w_in = (const float*)d_in[12]; p.conv_w = (const float*)d_in[13]; p.conv_b = (const float*)d_in[14]; p.w_a = (const float*)d_in[15]; p.b_a = (const float*)d_in[16];
    p.w_i = (const float*)d_in[17]; p.b_i = (const float*)d_in[18]; p.lam = (const float*)d_in[19]; p.w_out = (const float*)d_in[20];
    p.out = (float*)d_out; p.ws = (unsigned char*)d_ws;
    if (hipMemsetAsync((unsigned char*)d_ws + WS_BAR, 0, XCD_BAR_WORDS * 4, stream) != hipSuccess) { fprintf(stderr, "memset of barrier words failed\n"); return; }
    void* args[] = {&p};
    hipError_t e = hipLaunchCooperativeKernel((const void*)fwd_megakernel, dim3(grid_blocks), dim3(512), args, LDS_BYTES, stream);
    if (e != hipSuccess) fprintf(stderr, "cooperative launch failed: %s (grid %d)\n", hipGetErrorString(e), grid_blocks);
}
```

```cpp
#include <hip/hip_runtime.h>
#include <hip/hip_cooperative_groups.h>
#include <cstdio>
#include <cstdint>
namespace cg = cooperative_groups;

#define LAS __attribute__((address_space(3)))
typedef unsigned short bf16_t;
typedef short bf16x8 __attribute__((ext_vector_type(8)));
typedef float f32x4 __attribute__((ext_vector_type(4)));
typedef float f32x2 __attribute__((ext_vector_type(2)));
typedef unsigned u32x4 __attribute__((ext_vector_type(4)));
typedef unsigned u32x2 __attribute__((ext_vector_type(2)));

constexpr int DM = 1024, NB = 8, SEQ = 2048, CTX = 256;
constexpr int ML = NB * SEQ;
constexpr int MC = NB * CTX;
constexpr int MT = ML + MC;
constexpr int NQKV = 1536, DFF = 4096, DRNN = 1280;
constexpr float EPS = 1e-6f;
constexpr float LOG2E = 1.4426950408889634f;

constexpr size_t MiB = 1u << 20;
constexpr size_t WS_MOD = 0;
constexpr size_t WS_ROPE = 448 * 1024;
constexpr size_t WS_NLS = 460 * 1024;
constexpr size_t WS_BAR = 480 * 1024;
constexpr size_t WS_WQKV = 1 * MiB, WS_WO = 4 * MiB, WS_W1 = 6 * MiB, WS_W2 = 14 * MiB;
constexpr size_t WS_WIN = 38 * MiB, WS_WG = 43 * MiB, WS_WOUT = 46 * MiB;
constexpr size_t WS_CTXRES = 49 * MiB;
constexpr size_t WS_H = 57 * MiB;
constexpr size_t WS_R3 = 93 * MiB;
constexpr size_t WS_Q = WS_R3, WS_K = 129 * MiB, WS_VT = 138 * MiB, WS_VTC = 146 * MiB;
constexpr size_t WS_O = 150 * MiB;
constexpr size_t WS_ACT = WS_R3;
constexpr size_t WS_U = WS_R3;
constexpr size_t WS_RECF = 138 * MiB;
constexpr size_t WS_RECB = 178 * MiB;
constexpr size_t WS_LA = 138 * MiB;
constexpr size_t WS_BX = 183 * MiB;
constexpr size_t WS_RPRE = 138 * MiB;
constexpr size_t WS_SP = 228 * MiB, WS_SH = 231 * MiB, WS_CIN = 234 * MiB;
constexpr size_t WS_SLAB = 238 * MiB;
constexpr size_t WS_CARRY = 219 * MiB;
constexpr size_t WS_FLAG = 512 * 1024;
constexpr size_t WS_X3 = 222 * MiB;
constexpr size_t WS_END = 256 * MiB;
constexpr int LDS_BYTES = 135168;

__device__ __forceinline__ unsigned f2bf(float f) { unsigned u = __builtin_bit_cast(unsigned, f); return (u + 0x7fffu + ((u >> 16) & 1u)) >> 16; }
__device__ __forceinline__ unsigned cvt_pk_bf16(float lo, float hi) { unsigned r; asm volatile("v_cvt_pk_bf16_f32 %0, %1, %2" : "=v"(r) : "v"(lo), "v"(hi)); return r; }
__device__ __forceinline__ float bf_lo(unsigned w) { return __builtin_bit_cast(float, w << 16); }
__device__ __forceinline__ float bf_hi(unsigned w) { return __builtin_bit_cast(float, w & 0xffff0000u); }
__device__ __forceinline__ f32x4 bf4_to_f32(u32x2 w) { return (f32x4){bf_lo(w.x), bf_hi(w.x), bf_lo(w.y), bf_hi(w.y)}; }
__device__ __forceinline__ u32x2 f32_to_bf4(f32x4 v) { u32x2 w; w.x = cvt_pk_bf16(v[0], v[1]); w.y = cvt_pk_bf16(v[2], v[3]); return w; }
__device__ __forceinline__ float wave_sum(float v) {
#pragma unroll
    for (int o = 1; o < 64; o <<= 1) v += __shfl_xor(v, o);
    return v;
}
__device__ __forceinline__ float fsigmoid(float x) { return __builtin_amdgcn_rcpf(1.0f + __expf(-x)); }

namespace pg8 {
constexpr int BM = 256, BK = 64, HALF = 128, HTB = HALF * BK * 2, STAGE_BYTES = 8 * HTB, NXCD = 8, WGM = 8;
__device__ __forceinline__ int lds_byte(int r, int c) { const int st = (r >> 4) * 2 + (c >> 5), rr = r & 15, cc = c & 31, ob = rr * 64 + cc * 2; return st * 1024 + (ob ^ (((ob >> 9) & 1) << 5)); }
__device__ __forceinline__ void stage_rc(int b, int& R, int& C) { const int st = b / 1024, sb = b % 1024, swz = sb ^ (((sb >> 9) & 1) << 5); R = (st >> 1) * 16 + swz / 64; C = (st & 1) * 32 + (swz % 64) / 2; }

struct Unit { int pm, pn, koff, po, kboff, rev, lin; };
struct Gemm { const bf16_t* A; const bf16_t* Bt; int lda, ldb, K; };

struct Sched {
    int nM, nN, nwg, G, c, mode, half;
    __device__ void init(int nM_, int nN_, int G_, int c_, int mode_ = 0, int half_ = 0) { nM = nM_; nN = nN_; nwg = nM * nN; G = G_; c = c_; mode = mode_; half = half_; }
    __device__ bool next(int i, Unit& u) const {
        if (mode == 3) {
            const int L = i * G + c; if (L >= 1440) return false;
            const int ti = L / 160, s = L % 160;
            const int chalf = s & 1, dir = (s >> 1) & 1, bb = s >> 2, blk = bb % 5, b = bb / 5;
            u.pm = (ti == 0) ? 64 + b : (dir ? b * 8 + (8 - ti) : b * 8 + (ti - 1));
            u.pn = (dir * 5 + blk) * 2 + chalf; u.koff = blk * 256; u.kboff = 0; u.po = ti; u.rev = dir; u.lin = L;
            return true;
        }
        if (mode == 4) {
            const int L4 = i * G + c; if (L4 >= 424) return false;
            if (L4 >= 360) { u.pm = L4 - 360; u.pn = 4; u.koff = 0; u.po = u.pm; u.kboff = 0; u.rev = 0; u.lin = 0; return true; }
        }
        const long L = (long)i * G + c; if (L >= nwg) return false;
        int wgid = (int)L; { const int q = nwg / NXCD, r = nwg % NXCD, xcd = wgid % NXCD, off = wgid / NXCD; wgid = (xcd < r ? xcd * (q + 1) : r * (q + 1) + (xcd - r) * q) + off; }
        const int nig = WGM * nN, gid = wgid / nig, fm = gid * WGM, gsz = (nM - fm) < WGM ? (nM - fm) : WGM;
        const int pmi = fm + ((wgid % nig) % gsz), pn = (wgid % nig) / gsz;
        u.pm = pmi; u.pn = pn; u.koff = 0; u.po = pmi; u.kboff = 0; u.rev = 0; u.lin = 0;
        if (mode == 2) { u.pm = 64 + pmi; u.pn = pn & 3; u.koff = (pn >> 2) * half; u.kboff = u.koff; }
        if (mode == 4) u.pn += 5;
        if (mode == 1) { u.pm = pmi < 32 ? 32 * half + pmi : 64 + 4 * half + (pmi - 32); u.koff = ((pn >> 1) % 5) * 256; }
        return true;
    }
};

template <class Epi, bool ALIGN_EPI, bool SP2>
__device__ __forceinline__ void gemm_phase(LAS unsigned char* lds, const Gemm g, const Sched& S, const Epi& E) {
    int tid = threadIdx.x; asm volatile("" : "+v"(tid));
    const int wid = __builtin_amdgcn_readfirstlane(tid >> 6), lane = tid & 63, wr = wid >> 2, wc = wid & 3, fr = lane & 15, fq = lane >> 4;
    const int K = g.K, nt = K / BK;
    unsigned voffAf[2], voffAr[2], voffB[2];
#pragma unroll
    for (int i = 0; i < 2; ++i) { int R, C; stage_rc(tid * 16 + i * 8192, R, C);
        voffAf[i] = (unsigned)(R * g.lda + C) * 2u; voffAr[i] = (unsigned)((127 - R) * g.lda + C) * 2u; voffB[i] = (unsigned)(R * g.ldb + C) * 2u; }
    const size_t kstep = (size_t)(BK * 2);
    const long hstepAf = (long)HALF * g.lda * 2; const size_t hstepB = (size_t)HALF * g.ldb * 2;
    const unsigned ldsw = (unsigned)wid * 1024u;
    const int aoff = lds_byte(wr * 64 + fr, fq * 8), boff = lds_byte(wc * 32 + fr, fq * 8);
#define PG8_SA(b, h) (((b) * 2 + (h)) * HTB)
#define PG8_SB(b, h) ((4 + (b) * 2 + (h)) * HTB)
#define PG8_STAGE(bufoff, gbase, voff) do { _Pragma("unroll") for (int _i = 0; _i < 2; ++_i) \
        __builtin_amdgcn_global_load_lds((const unsigned*)((const char*)(gbase) + (voff)[_i]), (LAS unsigned*)(lds + (bufoff) + ldsw + _i * 8192), 16, 0, 0); } while (0)
#define PG8_LDA(dst, b, h) do { _Pragma("unroll") for (int m = 0; m < 4; ++m) _Pragma("unroll") for (int k = 0; k < 2; ++k) dst[m][k] = *(const LAS bf16x8*)(lds + PG8_SA(b, h) + aoff + m * 2048 + k * 1024); } while (0)
#define PG8_LDB(dst, b, h) do { _Pragma("unroll") for (int n = 0; n < 2; ++n) _Pragma("unroll") for (int k = 0; k < 2; ++k) dst[n][k] = *(const LAS bf16x8*)(lds + PG8_SB(b, h) + boff + n * 2048 + k * 1024); } while (0)
#define PG8_MMA(ai, bj, At, Bt) do { __builtin_amdgcn_s_setprio(1); _Pragma("unroll") for (int m = 0; m < 4; ++m) _Pragma("unroll") for (int n = 0; n < 2; ++n) _Pragma("unroll") for (int k = 0; k < 2; ++k) \
        acc[ai][bj][m][n] = __builtin_amdgcn_mfma_f32_16x16x32_bf16(Bt[n][k], At[m][k], acc[ai][bj][m][n], 0, 0, 0); __builtin_amdgcn_s_setprio(0); } while (0)
#define PG8_WAIT_V(n) asm volatile("s_waitcnt vmcnt(" #n ")" ::: "memory")
#define PG8_WAIT_L(n) asm volatile("s_waitcnt lgkmcnt(" #n ")" ::: "memory")
#define PG8_BAR __builtin_amdgcn_s_barrier()
#define PG8_SCHED __builtin_amdgcn_sched_barrier(0)
    Unit cur, nxt; int ui = 0;
    if (!S.next(0, cur)) return;
    f32x4 acc[2][2][4][2];
#pragma unroll
    for (int a = 0; a < 2; ++a)
#pragma unroll
        for (int b = 0; b < 2; ++b)
#pragma unroll
            for (int m = 0; m < 4; ++m)
#pragma unroll
                for (int n = 0; n < 2; ++n) acc[a][b][m][n] = (f32x4){0.f, 0.f, 0.f, 0.f};
    bf16x8 At[4][2], B0[2][2], B1[2][2];
#define PG8_UNIT_A(u_) ((const char*)g.A + ((size_t)(u_).pm * BM * g.lda + (u_).koff) * 2 + (Epi::WITH_LDS && (u_).rev ? hstepAf : 0))
    const char* cA = PG8_UNIT_A(cur);
    unsigned voffA[2] = {voffAf[0], voffAf[1]}; long hstepA = hstepAf;
    if (Epi::WITH_LDS && cur.rev) { voffA[0] = voffAr[0]; voffA[1] = voffAr[1]; hstepA = -hstepAf; } const char* cB = (const char*)g.Bt + ((size_t)cur.pn * BM * g.ldb + cur.kboff) * 2;
    if constexpr (SP2) {
        PG8_STAGE(PG8_SB(0, 0), cB, voffB); PG8_STAGE(PG8_SB(0, 1), cB + hstepB, voffB); PG8_STAGE(PG8_SA(0, 0), cA, voffA); PG8_STAGE(PG8_SA(0, 1), cA + hstepA, voffA);
        if (wr == 1) PG8_BAR;
        PG8_WAIT_V(2); PG8_BAR;
        PG8_STAGE(PG8_SB(1, 0), cB + kstep, voffB); PG8_STAGE(PG8_SA(1, 0), cA + kstep, voffA); PG8_STAGE(PG8_SB(1, 1), cB + hstepB + kstep, voffB);
        PG8_WAIT_V(6); PG8_BAR;
    } else {
        PG8_STAGE(PG8_SB(0, 0), cB, voffB); PG8_STAGE(PG8_SA(0, 0), cA, voffA); PG8_STAGE(PG8_SB(0, 1), cB + hstepB, voffB); PG8_STAGE(PG8_SA(0, 1), cA + hstepA, voffA);
        if (wr == 1) PG8_BAR;
        PG8_WAIT_V(4); PG8_BAR;
        PG8_STAGE(PG8_SB(1, 0), cB + kstep, voffB); PG8_STAGE(PG8_SA(1, 0), cA + kstep, voffA); PG8_STAGE(PG8_SB(1, 1), cB + hstepB + kstep, voffB);
        PG8_WAIT_V(6); PG8_BAR;
    }
    for (;;) {
        const bool has_next = S.next(ui + 1, nxt);
        const char* nA = has_next ? PG8_UNIT_A(nxt) : cA;
        unsigned voffN[2] = {voffA[0], voffA[1]}; long hstepN = hstepA;
        if (Epi::WITH_LDS && has_next) { const bool nr = nxt.rev != 0; voffN[0] = nr ? voffAr[0] : voffAf[0]; voffN[1] = nr ? voffAr[1] : voffAf[1]; hstepN = nr ? -hstepAf : hstepAf; }
        const char* nB = has_next ? (const char*)g.Bt + ((size_t)nxt.pn * BM * g.ldb + nxt.kboff) * 2 : cB;
#pragma unroll 1
        for (int t = 0; t < nt; t += 2) {
            const bool last = (t == nt - 2);
            const char* a1 = cA + (size_t)(t + 1) * kstep;
            const char* a2 = last ? nA : cA + (size_t)(t + 2) * kstep; const char* b2 = last ? nB : cB + (size_t)(t + 2) * kstep;
            const char* a3 = a2 + kstep; const char* b3 = b2 + kstep;
            unsigned voff2[2] = {voffA[0], voffA[1]}; long hstep2 = hstepA;
            if (Epi::WITH_LDS && last) { voff2[0] = voffN[0]; voff2[1] = voffN[1]; hstep2 = hstepN; }
            if constexpr (SP2) {
            PG8_LDB(B0, 0, 0); PG8_LDB(B1, 0, 1); PG8_SCHED; PG8_LDA(At, 0, 0); PG8_STAGE(PG8_SA(1, 1), a1 + hstepA, voffA);
            PG8_WAIT_V(8); PG8_WAIT_L(0); PG8_BAR; PG8_MMA(0, 0, At, B0); PG8_MMA(0, 1, At, B1); PG8_BAR; PG8_SCHED;
            PG8_LDA(At, 0, 1); PG8_STAGE(PG8_SB(0, 0), b2, voffB); PG8_STAGE(PG8_SB(0, 1), b2 + hstepB, voffB); PG8_STAGE(PG8_SA(0, 0), a2, voff2);
            PG8_WAIT_V(8); PG8_WAIT_L(0); PG8_BAR; PG8_MMA(1, 0, At, B0); PG8_MMA(1, 1, At, B1); PG8_BAR; PG8_SCHED;
            PG8_LDB(B0, 1, 0); PG8_LDB(B1, 1, 1); PG8_SCHED; PG8_LDA(At, 1, 0); PG8_STAGE(PG8_SA(0, 1), a2 + hstep2, voff2);
            PG8_WAIT_V(8); PG8_WAIT_L(0); PG8_BAR; PG8_MMA(0, 0, At, B0); PG8_MMA(0, 1, At, B1); PG8_BAR; PG8_SCHED;
            PG8_LDA(At, 1, 1); PG8_STAGE(PG8_SB(1, 0), b3, voffB); PG8_STAGE(PG8_SB(1, 1), b3 + hstepB, voffB); PG8_STAGE(PG8_SA(1, 0), a3, voff2);
            PG8_WAIT_V(8); PG8_WAIT_L(0); PG8_BAR; PG8_MMA(1, 0, At, B0); PG8_MMA(1, 1, At, B1); PG8_BAR; PG8_SCHED;
            } else {
            PG8_LDB(B0, 0, 0); PG8_SCHED; PG8_LDA(At, 0, 0); PG8_STAGE(PG8_SA(1, 1), a1 + hstepA, voffA);
            PG8_WAIT_L(8); PG8_BAR; PG8_WAIT_L(0); PG8_MMA(0, 0, At, B0); PG8_BAR; PG8_SCHED;
            PG8_LDB(B1, 0, 1); PG8_STAGE(PG8_SB(0, 0), b2, voffB);
            PG8_BAR; PG8_WAIT_L(0); PG8_MMA(0, 1, At, B1); PG8_BAR;
            PG8_LDA(At, 0, 1); PG8_STAGE(PG8_SA(0, 0), a2, voff2);
            PG8_BAR; PG8_WAIT_L(0); PG8_MMA(1, 0, At, B0); PG8_BAR; PG8_SCHED;
            PG8_STAGE(PG8_SB(0, 1), b2 + hstepB, voffB);
            PG8_WAIT_V(6); PG8_BAR; PG8_MMA(1, 1, At, B1); PG8_BAR;
            PG8_LDB(B0, 1, 0); PG8_SCHED; PG8_LDA(At, 1, 0); PG8_STAGE(PG8_SA(0, 1), a2 + hstep2, voff2);
            PG8_WAIT_L(8); PG8_BAR; PG8_WAIT_L(0); PG8_MMA(0, 0, At, B0); PG8_BAR; PG8_SCHED;
            PG8_LDB(B1, 1, 1); PG8_STAGE(PG8_SB(1, 0), b3, voffB);
            PG8_BAR; PG8_WAIT_L(0); PG8_MMA(0, 1, At, B1); PG8_BAR;
            PG8_LDA(At, 1, 1); PG8_STAGE(PG8_SA(1, 0), a3, voff2);
            PG8_BAR; PG8_WAIT_L(0); PG8_MMA(1, 0, At, B0); PG8_BAR; PG8_SCHED;
            PG8_STAGE(PG8_SB(1, 1), b3 + hstepB, voffB);
            PG8_WAIT_V(6); PG8_BAR; PG8_MMA(1, 1, At, B1); PG8_BAR;
            }
        }
        if constexpr (ALIGN_EPI) { if (wr == 0) PG8_BAR; }
        if constexpr (Epi::WITH_LDS) E.run(acc, cur, wr, wc, lane, lds); else E(acc, cur, wr, wc, fr, fq);
        if (!has_next) break;
#pragma unroll
        for (int a = 0; a < 2; ++a)
#pragma unroll
            for (int b = 0; b < 2; ++b)
#pragma unroll
                for (int m = 0; m < 4; ++m)
#pragma unroll
                    for (int n = 0; n < 2; ++n) acc[a][b][m][n] = (f32x4){0.f, 0.f, 0.f, 0.f};
        cur = nxt; cA = nA; cB = nB; ++ui; voffA[0] = voffN[0]; voffA[1] = voffN[1]; hstepA = hstepN;
        if constexpr (ALIGN_EPI) { if (wr == 1) PG8_BAR; }
    }
    PG8_WAIT_V(0);
    if constexpr (!ALIGN_EPI) { if (wr == 0) PG8_BAR; }
    PG8_BAR;
#undef PG8_UNIT_A
#undef PG8_SA
#undef PG8_SB
#undef PG8_STAGE
#undef PG8_LDA
#undef PG8_LDB
#undef PG8_MMA
#undef PG8_WAIT_V
#undef PG8_WAIT_L
#undef PG8_BAR
#undef PG8_SCHED
}

template <int ACT> struct EpiPlain {
    static constexpr bool WITH_LDS = false;
    bf16_t* O; int ldc;
    __device__ __forceinline__ void operator()(const f32x4 (&acc)[2][2][4][2], const Unit& u, int wr, int wc, int fr_, int fq_) const {
        int fr = fr_, fq = fq_; asm volatile("" : "+v"(fr), "+v"(fq));
        const int col0 = u.pn * BM + wc * 32 + fq * 4;
#pragma unroll
        for (int ai = 0; ai < 2; ++ai)
#pragma unroll
            for (int m = 0; m < 4; ++m) { bf16_t* rowp = O + (size_t)(u.pm * BM + ai * HALF + wr * 64 + m * 16 + fr) * ldc + col0;
#pragma unroll
                for (int bj = 0; bj < 2; ++bj)
#pragma unroll
                    for (int n = 0; n < 2; ++n) { f32x4 v = acc[ai][bj][m][n];
                        if (ACT == 1) { v = __builtin_elementwise_max(v, (f32x4){0.f, 0.f, 0.f, 0.f}); v = v * v; }
                        *(u32x2*)(rowp + bj * HALF + n * 16) = f32_to_bf4(v); } }
    }
};

struct EpiSlabCtx {
    static constexpr bool WITH_LDS = false;
    bf16_t* S; int ksz;
    __device__ __forceinline__ void operator()(const f32x4 (&acc)[2][2][4][2], const Unit& u, int wr, int wc, int fr_, int fq_) const {
        int fr = fr_, fq = fq_; asm volatile("" : "+v"(fr), "+v"(fq));
        const int col0 = u.pn * BM + wc * 32 + fq * 4;
        bf16_t* base = S + (size_t)(u.koff / ksz) * MC * DM;
#pragma unroll
        for (int ai = 0; ai < 2; ++ai)
#pragma unroll
            for (int m = 0; m < 4; ++m) { bf16_t* rowp = base + (size_t)(u.pm * BM - ML + ai * HALF + wr * 64 + m * 16 + fr) * DM + col0;
#pragma unroll
                for (int bj = 0; bj < 2; ++bj)
#pragma unroll
                    for (int n = 0; n < 2; ++n) *(u32x2*)(rowp + bj * HALF + n * 16) = f32_to_bf4(acc[ai][bj][m][n]); }
    }
};

struct EpiQKV {
    static constexpr bool WITH_LDS = false;
    bf16_t* Q; bf16_t* Kb; bf16_t* VT; bf16_t* VTC; const float* rope;
    __device__ __forceinline__ void operator()(const f32x4 (&acc)[2][2][4][2], const Unit& u, int wr, int wc, int fr_, int fq_) const {
        int fr = fr_, fq = fq_; asm volatile("" : "+v"(fr), "+v"(fq));
        const bool lat = u.pm < 64;
        if (u.pn < 5) {
#pragma unroll
            for (int ai = 0; ai < 2; ++ai)
#pragma unroll
                for (int m = 0; m < 4; ++m) {
                    const int row = u.pm * BM + ai * HALF + wr * 64 + m * 16 + fr;
                    f32x4 cs0 = {1.f, 0.f, 1.f, 0.f}, cs1 = {1.f, 0.f, 1.f, 0.f};
                    if (lat) { const int t = row & 2047; const int pos = (wc & 1) ? (t & 63) : (t >> 6); const f32x4* pp = (const f32x4*)(rope + (pos * 16 + 4 * fq) * 2); cs0 = pp[0]; cs1 = pp[1]; }
                    const f32x4 cv = {cs0[0], cs0[2], cs1[0], cs1[2]}, sv = {cs0[1], cs0[3], cs1[1], cs1[3]};
#pragma unroll
                    for (int bj = 0; bj < 2; ++bj) {
                        const f32x4 a = acc[ai][bj][m][0], b = acc[ai][bj][m][1];
                        f32x4 na = a * cv - b * sv, nb = b * cv + a * sv;
                        if (u.pn < 4) { na = na * 0.125f; nb = nb * 0.125f;
                            bf16_t* d = Q + (size_t)row * 1024 + u.pn * 256 + bj * HALF + wc * 32 + fq * 4;
                            *(u32x2*)d = f32_to_bf4(na); *(u32x2*)(d + 16) = f32_to_bf4(nb);
                        } else {
                            bf16_t* d = Kb + (size_t)row * 256 + bj * HALF + wc * 32 + fq * 4;
                            *(u32x2*)d = f32_to_bf4(na); *(u32x2*)(d + 16) = f32_to_bf4(nb);
                        }
                    }
                }
        } else {
#pragma unroll
            for (int ai = 0; ai < 2; ++ai)
#pragma unroll
                for (int m = 0; m < 4; ++m) {
                    const int row = u.pm * BM + ai * HALF + wr * 64 + m * 16 + fr;
                    bf16_t* base; size_t stride;
                    if (lat) { const int b = row >> 11, t = row & 2047; base = VT + (size_t)b * 256 * 2048 + t; stride = 2048; }
                    else { const int rc = row - ML; const int b = rc >> 8, t = rc & 255; base = VTC + (size_t)b * 256 * 256 + t; stride = 256; }
#pragma unroll
                    for (int bj = 0; bj < 2; ++bj)
#pragma unroll
                        for (int n = 0; n < 2; ++n)
#pragma unroll
                            for (int j = 0; j < 4; ++j) { const int vc = bj * HALF + wc * 32 + n * 16 + fq * 4 + j; base[(size_t)vc * stride] = (bf16_t)f2bf(acc[ai][bj][m][n][j]); }
                }
        }
    }
};

struct EpiInProj {
    static constexpr bool WITH_LDS = false;
    bf16_t* R; bf16_t* GB;
    __device__ __forceinline__ void operator()(const f32x4 (&acc)[2][2][4][2], const Unit& u, int wr, int wc, int fr_, int fq_) const {
        int fr = fr_, fq = fq_; asm volatile("" : "+v"(fr), "+v"(fq));
        const bool rec = u.pn >= 5;
        const int col0 = (rec ? (u.pn - 5) * BM : 0) + wc * 32 + fq * 4; const int ldc = rec ? DRNN : 256; bf16_t* O = rec ? R : GB;
#pragma unroll
        for (int ai = 0; ai < 2; ++ai)
#pragma unroll
            for (int m = 0; m < 4; ++m) { bf16_t* rowp = O + (size_t)(u.pm * BM + ai * HALF + wr * 64 + m * 16 + fr) * ldc + col0;
#pragma unroll
                for (int bj = 0; bj < 2; ++bj)
#pragma unroll
                    for (int n = 0; n < 2; ++n) { f32x4 v = acc[ai][bj][m][n];
                        if (!rec) {
#pragma unroll
                            for (int j = 0; j < 4; ++j) { const float x = v[j]; v[j] = x * fsigmoid(1.5957691216057308f * (x + 0.044715f * x * x * x)); } }
                        *(u32x2*)(rowp + bj * HALF + n * 16) = f32_to_bf4(v); } }
    }
};

struct EpiGates {
    static constexpr bool WITH_LDS = false;
    const bf16_t* U; bf16_t* LA; bf16_t* BX; const float* ba; const float* bi; const float* nls;
    __device__ __forceinline__ void operator()(const f32x4 (&acc)[2][2][4][2], const Unit& u, int wr, int wc, int fr_, int fq_) const {
        int fr = fr_, fq = fq_; asm volatile("" : "+v"(fr), "+v"(fq));
        const int tile = u.pn >> 1, dir = tile / 5, blk = tile % 5, chalf = u.pn & 1;
        const int ch0 = blk * 256 + chalf * 128 + wc * 32 + fq * 4;
#pragma unroll
        for (int n = 0; n < 2; ++n) {
            const int ch = ch0 + n * 16;
            const f32x4 bav = *(const f32x4*)(ba + dir * DRNN + ch), biv = *(const f32x4*)(bi + dir * DRNN + ch), nl = *(const f32x4*)(nls + dir * DRNN + ch);
#pragma unroll
            for (int ai = 0; ai < 2; ++ai)
#pragma unroll
                for (int m = 0; m < 4; ++m) {
                    const int rin = ai * HALF + wr * 64 + m * 16 + fr;
                    const size_t rowg = (size_t)u.pm * BM + rin, rowl = (size_t)u.po * BM + rin;
                    const f32x4 uv = bf4_to_f32(*(const u32x2*)(U + rowg * DRNN + ch));
                    f32x4 lav, bxv;
#pragma unroll
                    for (int j = 0; j < 4; ++j) {
                        const float r = fsigmoid(acc[ai][0][m][n][j] + bav[j]);
                        const float ig = fsigmoid(acc[ai][1][m][n][j] + biv[j]);
                        const float la = nl[j] * r, x = 2.0f * la;
                        float om;
                        if (x > -0.5f) { float q = 1.0f / 720.0f; q = q * x + 1.0f / 120.0f; q = q * x + 1.0f / 24.0f; q = q * x + 1.0f / 6.0f; q = q * x + 0.5f; q = q * x + 1.0f; om = -x * q; }
                        else om = 1.0f - __expf(x);
                        lav[j] = la; bxv[j] = __builtin_amdgcn_sqrtf(om) * (ig * uv[j]);
                    }
                    const size_t o = ((size_t)dir * 9216 + rowl) * DRNN + ch;
                    *(u32x2*)(LA + o) = f32_to_bf4(lav); *(u32x2*)(BX + o) = f32_to_bf4(bxv);
                    asm volatile("" ::: "memory");
                }
        }
    }
};

#define SC_STEP(d) \
    "v_fmac_f32_dpp %1, %1, %0 row_shr:" #d " row_mask:0xf bank_mask:0xf\n\t" "v_mul_f32_dpp %0, %0, %0 row_shr:" #d " row_mask:0xf bank_mask:0xf\n\t" \
    "v_fmac_f32_dpp %3, %3, %2 row_shr:" #d " row_mask:0xf bank_mask:0xf\n\t" "v_mul_f32_dpp %2, %2, %2 row_shr:" #d " row_mask:0xf bank_mask:0xf\n\t" \
    "v_fmac_f32_dpp %5, %5, %4 row_shr:" #d " row_mask:0xf bank_mask:0xf\n\t" "v_mul_f32_dpp %4, %4, %4 row_shr:" #d " row_mask:0xf bank_mask:0xf\n\t" \
    "v_fmac_f32_dpp %7, %7, %6 row_shr:" #d " row_mask:0xf bank_mask:0xf\n\t" "v_mul_f32_dpp %6, %6, %6 row_shr:" #d " row_mask:0xf bank_mask:0xf\n\t"
__device__ __forceinline__ void scan16x4(float& a0, float& b0, float& a1, float& b1, float& a2, float& b2, float& a3, float& b3) {
    asm volatile("s_nop 1\n\t" SC_STEP(1) SC_STEP(2) SC_STEP(4) SC_STEP(8)
                 : "+v"(a0), "+v"(b0), "+v"(a1), "+v"(b1), "+v"(a2), "+v"(b2), "+v"(a3), "+v"(b3));
}
struct EpiGatesScan {
    static constexpr bool WITH_LDS = true;
    const bf16_t* U; bf16_t* RECF; bf16_t* RECB; const float* ba; const float* bi; const float* nls; float* CARRY; unsigned* FLAG;
    __device__ __forceinline__ void run(f32x4 (&acc)[2][2][4][2], const Unit& u, int wr, int wc, int lane_, LAS unsigned char* lds) const {
        int lane = lane_; asm volatile("" : "+v"(lane));
        const int fr = lane & 15, fq = lane >> 4;
        LAS float* carry = (LAS float*)(lds + 131072);
        const int tile = u.pn >> 1, dir = tile / 5, blk = tile % 5, chalf = u.pn & 1;
        const int ch0 = blk * 256 + chalf * 128 + wc * 32 + fq * 4;
        const int rmask = dir ? 255 : 0;
        bf16_t* REC = dir ? RECB : RECF;
#pragma unroll
        for (int n = 0; n < 2; ++n) {
            const int ch = ch0 + n * 16;
            const f32x4 bav2 = *(const f32x4*)(ba + dir * DRNN + ch) * (-LOG2E), biv2 = *(const f32x4*)(bi + dir * DRNN + ch) * (-LOG2E), nl = *(const f32x4*)(nls + dir * DRNN + ch);
            const f32x4 nl2 = nl * LOG2E, nlx = nl * 2.0f;
#pragma unroll
            for (int ai = 0; ai < 2; ++ai)
#pragma unroll
                for (int m = 0; m < 4; ++m) {
                    const size_t rowg = (size_t)u.pm * BM + ((ai * HALF + wr * 64 + m * 16 + fr) ^ rmask);
                    const f32x4 uv = bf4_to_f32(*(const u32x2*)(U + rowg * DRNN + ch));
                    float av[4], bv[4];
#pragma unroll
                    for (int j = 0; j < 4; ++j) {
                        const float r = __builtin_amdgcn_rcpf(1.0f + __builtin_amdgcn_exp2f(acc[ai][0][m][n][j] * (-LOG2E) + bav2[j]));
                        const float ig = __builtin_amdgcn_rcpf(1.0f + __builtin_amdgcn_exp2f(acc[ai][1][m][n][j] * (-LOG2E) + biv2[j]));
                        const float x = nlx[j] * r, a = __builtin_amdgcn_exp2f(nl2[j] * r);
                        const float om = (x > -0.0625f) ? -x * (1.0f + x * (0.5f + x * (1.0f / 6.0f + x * (1.0f / 24.0f)))) : 1.0f - a * a;
                        av[j] = a; bv[j] = __builtin_amdgcn_sqrtf(om) * (ig * uv[j]);
                    }
                    scan16x4(av[0], bv[0], av[1], bv[1], av[2], bv[2], av[3], bv[3]);
#pragma unroll
                    for (int j = 0; j < 4; ++j) { acc[ai][0][m][n][j] = av[j]; acc[ai][1][m][n][j] = bv[j]; }
                    __builtin_amdgcn_sched_barrier(0);
                }
        }
        const int tid_ = threadIdx.x;
        if (u.po > 0 && tid_ < 64) {
            unsigned* fl = FLAG + (size_t)(u.lin - 160) * 16; unsigned sp = 0;
            while (__hip_atomic_load(fl, __ATOMIC_RELAXED, __HIP_MEMORY_SCOPE_AGENT) == 0u) { __builtin_amdgcn_s_sleep(2); if (++sp > (1u << 22)) break; }
        }
        asm volatile("s_waitcnt vmcnt(0) lgkmcnt(0)" ::: "memory"); __builtin_amdgcn_s_barrier(); asm volatile("" ::: "memory");
        if (tid_ < 128) carry[tid_] = (u.po > 0) ? __hip_atomic_load(CARRY + (size_t)(u.lin - 160) * 128 + tid_, __ATOMIC_RELAXED, __HIP_MEMORY_SCOPE_AGENT) : 0.0f;
        asm volatile("s_waitcnt vmcnt(0) lgkmcnt(0)" ::: "memory"); __builtin_amdgcn_s_barrier(); asm volatile("" ::: "memory");
        const bool emit = u.pm < 64;
        const int lastl = (lane & 48) | 15;
#pragma unroll
        for (int seg = 0; seg < 4; ++seg) {
            const int ai = seg >> 1, wrs = seg & 1;
            if (wr == wrs) {
                f32x4 hg[2];
#pragma unroll
                for (int n = 0; n < 2; ++n) hg[n] = *(const LAS f32x4*)(carry + wc * 32 + n * 16 + fq * 4);
#pragma unroll
                for (int m = 0; m < 4; ++m) {
                    f32x4 h[2];
#pragma unroll
                    for (int n = 0; n < 2; ++n) h[n] = acc[ai][0][m][n] * hg[n] + acc[ai][1][m][n];
                    if (emit) { bf16_t* rp = REC + ((size_t)u.pm * BM + ((ai * HALF + wr * 64 + m * 16 + fr) ^ rmask)) * DRNN + ch0;
#pragma unroll
                        for (int n = 0; n < 2; ++n) *(u32x2*)(rp + n * 16) = f32_to_bf4(h[n]); }
#pragma unroll
                    for (int n = 0; n < 2; ++n)
#pragma unroll
                        for (int j = 0; j < 4; ++j) hg[n][j] = __shfl(h[n][j], lastl);
                }
                if (fr == 0) {
#pragma unroll
                    for (int n = 0; n < 2; ++n) *(LAS f32x4*)(carry + wc * 32 + n * 16 + fq * 4) = hg[n];
                }
            }
            asm volatile("s_waitcnt lgkmcnt(0)" ::: "memory"); __builtin_amdgcn_s_barrier(); asm volatile("" ::: "memory");
        }
        if (u.po < 8) {
            if (tid_ < 128) __hip_atomic_store(CARRY + (size_t)u.lin * 128 + tid_, carry[tid_], __ATOMIC_RELAXED, __HIP_MEMORY_SCOPE_AGENT);
            asm volatile("s_waitcnt vmcnt(0) lgkmcnt(0)" ::: "memory"); __builtin_amdgcn_s_barrier(); asm volatile("" ::: "memory");
            if (tid_ == 0) __hip_atomic_store(FLAG + (size_t)u.lin * 16, 1u, __ATOMIC_RELAXED, __HIP_MEMORY_SCOPE_AGENT);
        }
    }
};

struct EpiGateMul {
    static constexpr bool WITH_LDS = false;
    bf16_t* Z; const bf16_t* RB;
    __device__ __forceinline__ void operator()(const f32x4 (&acc)[2][2][4][2], const Unit& u, int wr, int wc, int fr_, int fq_) const {
        int fr = fr_, fq = fq_; asm volatile("" : "+v"(fr), "+v"(fq));
        const int col0 = u.pn * BM + wc * 32 + fq * 4;
#pragma unroll
        for (int ai = 0; ai < 2; ++ai)
#pragma unroll
            for (int m = 0; m < 4; ++m) { bf16_t* rowp = Z + (size_t)(u.pm * BM + ai * HALF + wr * 64 + m * 16 + fr) * DRNN + col0;
#pragma unroll
                for (int bj = 0; bj < 2; ++bj)
#pragma unroll
                    for (int n = 0; n < 2; ++n) { const f32x4 v = acc[ai][bj][m][n]; const f32x4 rc = bf4_to_f32(*(const u32x2*)(rowp + bj * HALF + n * 16)) + bf4_to_f32(*(const u32x2*)(RB + (rowp - Z) + bj * HALF + n * 16)); f32x4 o;
#pragma unroll
                        for (int j = 0; j < 4; ++j) { const float x = v[j]; const float z2 = 1.5957691216057308f * (x + 0.044715f * x * x * x); o[j] = x * fsigmoid(z2) * rc[j]; }
                        *(u32x2*)(rowp + bj * HALF + n * 16) = f32_to_bf4(o); }
                asm volatile("" ::: "memory"); }
    }
};
}


#define XB_TMO      128
#define XB_XCNT(j)  (256  + 64 * (j))
#define XB_XSUB(j)  (1280 + 64 * (j))
#define XB_XGEN(j)  (2304 + 64 * (j))
#define XB_TOP      3328
#define XB_TOPGEN   3392
#define XCD_BAR_WORDS 3456
#define XB_SPIN_CAP (1u << 18)
__device__ __forceinline__ unsigned xb_ld(unsigned* p)              { return __hip_atomic_load(p, __ATOMIC_RELAXED, __HIP_MEMORY_SCOPE_AGENT); }
__device__ __forceinline__ unsigned xb_add(unsigned* p, unsigned v) { return __hip_atomic_fetch_add(p, v, __ATOMIC_RELAXED, __HIP_MEMORY_SCOPE_AGENT); }
__device__ __forceinline__ unsigned xb_xcc_id() { return (unsigned)__builtin_amdgcn_s_getreg((3 << 11) | 20) & 0xFu; }
#define XB_SPIN(cond, bar) do { unsigned _sp = 0; while (cond) { __builtin_amdgcn_s_sleep(1); \
    if ((++_sp & 255u) == 0u) { if (xb_ld(&(bar)[XB_TMO])) break; if (_sp > XB_SPIN_CAP) { atomicAdd(&(bar)[XB_TMO], 1u); break; } } } } while (0)
struct XcdBarrier { unsigned* bar; unsigned x; volatile LAS unsigned* st; };
__device__ __forceinline__ XcdBarrier xcd_barrier_post(unsigned* bar, volatile LAS unsigned* st) {
    XcdBarrier b; b.bar = bar; b.x = xb_xcc_id(); b.st = st;
    if (threadIdx.x == 0) (void)xb_add(&bar[XB_XCNT(b.x)], 1u);
    return b;
}
__device__ __forceinline__ void xcd_barrier_complete(unsigned* bar, unsigned x, unsigned& nloc, unsigned& nx) {
    const unsigned G = gridDim.x * gridDim.y * gridDim.z;
    unsigned sum, cnt, mine, sp = 0u;
    for (;;) {
        sum = 0u; cnt = 0u; mine = 0u;
#pragma unroll
        for (unsigned j = 0; j < 16; ++j) { const unsigned c = xb_ld(&bar[XB_XCNT(j)]); sum += c; cnt += (c > 0u) ? 1u : 0u; mine = (j == x) ? c : mine; }
        if (sum == G) break;
        __builtin_amdgcn_s_sleep(1);
        if ((++sp & 255u) == 0u) { if (xb_ld(&bar[XB_TMO])) break; if (sp > XB_SPIN_CAP) { atomicAdd(&bar[XB_TMO], 1u); break; } }
    }
    nloc = mine > 0u ? mine : 1u; nx = cnt > 0u ? cnt : 1u;
}
__device__ __forceinline__ void xcd_barrier(const XcdBarrier& b) {
    asm volatile("s_waitcnt vmcnt(0)" ::: "memory");
    __syncthreads();
    if (threadIdx.x == 0) {
        unsigned* bar = b.bar;
        __builtin_amdgcn_s_waitcnt(0);
        unsigned nloc = b.st[0], nx = b.st[1];
        if (nloc == 0u) { xcd_barrier_complete(bar, b.x, nloc, nx); b.st[0] = nloc; b.st[1] = nx; }
        const unsigned old = xb_add(&bar[XB_XSUB(b.x)], 1u);
        const unsigned gen = old / nloc;
        if (old + 1u == (gen + 1u) * nloc) {
            __builtin_amdgcn_fence(__ATOMIC_RELEASE, "agent");
            asm volatile("s_waitcnt vmcnt(0)" ::: "memory");
            const unsigned og = xb_add(&bar[XB_TOP], 1u);
            const unsigned tg = og / nx;
            if (og + 1u == (tg + 1u) * nx) xb_add(&bar[XB_TOPGEN], 1u);
            else XB_SPIN(xb_ld(&bar[XB_TOPGEN]) == tg, bar);
            __builtin_amdgcn_fence(__ATOMIC_ACQUIRE, "agent");
            xb_add(&bar[XB_XGEN(b.x)], 1u);
            asm volatile("s_waitcnt vmcnt(0)" ::: "memory");
        } else {
            XB_SPIN(xb_ld(&bar[XB_XGEN(b.x)]) == gen, bar);
            __builtin_amdgcn_fence(__ATOMIC_ACQUIRE, "agent");
            asm volatile("s_waitcnt vmcnt(0)" ::: "memory");
        }
    }
    __syncthreads();
}

struct Params {
    const float *x, *c, *ctx, *c_ctx, *ada_w, *ada_b, *norm_g, *mlp_w1, *mlp_w2, *w_qkv, *w_o, *sink;
    const float *w_in, *conv_w, *conv_b, *w_a, *b_a, *w_i, *b_i, *lam, *w_out;
    float* out; unsigned char* ws;
};

typedef const __attribute__((address_space(4))) Params* ParamsK;
__device__ __forceinline__ void transpose_item(const float* W, int ldw, bf16_t* WT, int ldwt, int k0, int n0, int dst_row0, LAS float* scr, int lane) {
#pragma unroll 8
    for (int i = 0; i < 32; ++i) { const int kk = 2 * i + (lane >> 5); scr[kk * 33 + (lane & 31)] = W[(size_t)(k0 + kk) * ldw + n0 + (lane & 31)]; }
    asm volatile("s_waitcnt lgkmcnt(0)" ::: "memory");
    const int c = lane & 7;
#pragma unroll
    for (int j = 0; j < 4; ++j) { const int n = (lane >> 3) + 8 * j; const LAS float* s = scr + (8 * c) * 33 + n;
        u32x4 o; o.x = cvt_pk_bf16(s[0 * 33], s[1 * 33]); o.y = cvt_pk_bf16(s[2 * 33], s[3 * 33]); o.z = cvt_pk_bf16(s[4 * 33], s[5 * 33]); o.w = cvt_pk_bf16(s[6 * 33], s[7 * 33]);
        *(u32x4*)(WT + (size_t)(dst_row0 + n) * ldwt + k0 + 8 * c) = o; }
    asm volatile("s_waitcnt lgkmcnt(0)" ::: "memory");
}
__device__ __forceinline__ void transpose_plain(const float* W, int K, int N, bf16_t* WT, int r, LAS float* scr, int lane) {
    const int nblk = N / 32, kb = r / nblk, nb = r % nblk;
    transpose_item(W, N, WT, K, 64 * kb, 32 * nb, 32 * nb, scr, lane);
}

constexpr int I_QKV = 16 * 48, I_O = 16 * 32, I_1 = 16 * 128, I_2 = 64 * 32, I_IN = 16 * 80, I_OUT = 20 * 32, I_G = 40 * 16;
constexpr int TR_L0 = I_QKV + I_O + I_1 + I_2, TR_LRU = I_IN + I_OUT + I_G, TR_MLP1 = I_1 + I_2;
struct TrItem { const float* W; bf16_t* WT; int ldw, ldwt, k0, n0, drow; };
__device__ __forceinline__ TrItem tr_decode(ParamsK p, unsigned char* ws, int it) {
    TrItem d; int r = it;
#define TR_PLAIN(Wp, K_, N_, WTp) do { const int nblk_ = (N_) / 32, kb_ = r / nblk_, nb_ = r % nblk_; d.W = (Wp); d.WT = (WTp); d.ldw = (N_); d.ldwt = (K_); d.k0 = 64 * kb_; d.n0 = 32 * nb_; d.drow = 32 * nb_; return d; } while (0)
    if (r < I_QKV) TR_PLAIN(p->w_qkv, 1024, NQKV, (bf16_t*)(ws + WS_WQKV)); r -= I_QKV;
    if (r < I_O) TR_PLAIN(p->w_o, 1024, 1024, (bf16_t*)(ws + WS_WO)); r -= I_O;
    if (r < I_1) TR_PLAIN(p->mlp_w1, 1024, DFF, (bf16_t*)(ws + WS_W1)); r -= I_1;
    if (r < I_2) TR_PLAIN(p->mlp_w2, DFF, 1024, (bf16_t*)(ws + WS_W2)); r -= I_2;
    if (r < I_IN) TR_PLAIN(p->w_in, 1024, 2 * DRNN, (bf16_t*)(ws + WS_WIN)); r -= I_IN;
    if (r < I_OUT) TR_PLAIN(p->w_out, DRNN, 1024, (bf16_t*)(ws + WS_WOUT)); r -= I_OUT;
    if (r < I_G) {
        const int sm = r >> 4, ii = r & 15, kb = ii >> 2, nb = ii & 3;
        const int chalf = sm & 1, blk = (sm >> 1) % 5, dg = (sm >> 1) / 5, gate = dg & 1, dir = dg >> 1;
        d.W = (gate ? p->w_i : p->w_a) + (size_t)(dir * 5 + blk) * 256 * 256; d.WT = (bf16_t*)(ws + WS_WG); d.ldw = 256; d.ldwt = 256;
        d.k0 = 64 * kb; d.n0 = chalf * 128 + nb * 32; d.drow = ((dir * 5 + blk) * 2 + chalf) * 256 + gate * 128 + nb * 32; return d; }
    r -= I_G;
    if (r < I_1) TR_PLAIN(p->mlp_w1 + (size_t)1024 * DFF, 1024, DFF, (bf16_t*)(ws + WS_W1 + 16 * MiB)); r -= I_1;
    TR_PLAIN(p->mlp_w2 + (size_t)1024 * DFF, DFF, 1024, (bf16_t*)(ws + WS_W2 + 16 * MiB));
#undef TR_PLAIN
}
__device__ __forceinline__ void transpose_range(ParamsK p, unsigned char* ws, LAS unsigned char* lds, int first, int count, int w, int nw, int wave, int lane) {
    LAS float* scr = (LAS float*)(lds + wave * 16384);
    int it = first + w; if (it >= first + count) return;
    float cur[32], nxt[32];
    TrItem d = tr_decode(p, ws, it);
#pragma unroll
    for (int i = 0; i < 32; ++i) cur[i] = d.W[(size_t)(d.k0 + 2 * i + (lane >> 5)) * d.ldw + d.n0 + (lane & 31)];
    for (;;) {
        const int itn = it + nw; const bool more = itn < first + count;
        TrItem dn = d;
        if (more) { dn = tr_decode(p, ws, itn);
#pragma unroll
            for (int i = 0; i < 32; ++i) nxt[i] = dn.W[(size_t)(dn.k0 + 2 * i + (lane >> 5)) * dn.ldw + dn.n0 + (lane & 31)]; }
#pragma unroll
        for (int i = 0; i < 32; ++i) scr[(2 * i + (lane >> 5)) * 33 + (lane & 31)] = cur[i];
        asm volatile("s_waitcnt lgkmcnt(0)" ::: "memory");
        const int c = lane & 7;
#pragma unroll
        for (int j = 0; j < 4; ++j) { const int n = (lane >> 3) + 8 * j; const LAS float* s = scr + (8 * c) * 33 + n;
            u32x4 o; o.x = cvt_pk_bf16(s[0 * 33], s[1 * 33]); o.y = cvt_pk_bf16(s[2 * 33], s[3 * 33]); o.z = cvt_pk_bf16(s[4 * 33], s[5 * 33]); o.w = cvt_pk_bf16(s[6 * 33], s[7 * 33]);
            *(u32x4*)(d.WT + (size_t)(d.drow + n) * d.ldwt + d.k0 + 8 * c) = o; }
        asm volatile("s_waitcnt lgkmcnt(0)" ::: "memory");
        if (!more) break;
#pragma unroll
        for (int i = 0; i < 32; ++i) cur[i] = nxt[i];
        d = dn; it = itn;
    }
}
__device__ __forceinline__ void idle_transposes(ParamsK p, unsigned char* ws, LAS unsigned char* lds, int first, int count, int nwg, int G, int bid, int wave, int lane) {
    const int rem = nwg % G;
    if (rem == 0) transpose_range(p, ws, lds, first, count, bid * 8 + wave, G * 8, wave, lane);
    else if (bid >= rem) transpose_range(p, ws, lds, first, count, (bid - rem) * 8 + wave, (G - rem) * 8, wave, lane);
    __syncthreads();
}

__device__ __forceinline__ void prologue(ParamsK p, LAS unsigned char* lds, int tid, int lane, int wave) {
    unsigned char* ws = p->ws;
    float* MOD = (float*)(ws + WS_MOD);
    if (blockIdx.x < 192) {
        LAS float* sl = (LAS float*)lds;
        LAS float* red = (LAS float*)(lds + 36864);
        for (int idx = tid; idx < 9216; idx += 512) { const int w = idx >> 10, k = idx & 1023; const float v = (w < 8) ? p->c[w * 1024 + k] : p->c_ctx[k]; sl[idx] = v / (1.0f + __expf(-v)); }
        __syncthreads();
        const int l = blockIdx.x / 96, n0 = (blockIdx.x % 96) * 64, kg = tid >> 4, cq = tid & 15;
        f32x4 acc[9];
#pragma unroll
        for (int w = 0; w < 9; ++w) acc[w] = (f32x4){0.f, 0.f, 0.f, 0.f};
        const float* wb = p->ada_w + (size_t)l * 1024 * 6144 + n0 + cq * 4;
#pragma unroll 1
        for (int it0 = 0; it0 < 32; it0 += 8) {
            f32x4 w4[8];
#pragma unroll
            for (int u = 0; u < 8; ++u) w4[u] = *(const f32x4*)(wb + (size_t)((it0 + u) * 32 + kg) * 6144);
#pragma unroll
            for (int u = 0; u < 8; ++u) { const int k = (it0 + u) * 32 + kg;
#pragma unroll
                for (int w = 0; w < 9; ++w) acc[w] += sl[w * 1024 + k] * w4[u]; }
        }
#pragma unroll
        for (int w = 0; w < 9; ++w) *(LAS f32x4*)(red + (kg * 9 + w) * 64 + cq * 4) = acc[w];
        __syncthreads();
        for (int idx = tid; idx < 9 * 64; idx += 512) { const int w = idx >> 6, n = idx & 63; float s = 0.f;
#pragma unroll
            for (int g = 0; g < 32; ++g) s += red[(g * 9 + w) * 64 + n];
            MOD[(size_t)(l * 9 + w) * 6144 + n0 + n] = s + p->ada_b[l * 6144 + n0 + n]; }
        __syncthreads();
    }
    if (blockIdx.x == gridDim.x - 1) {
        float* rope = (float*)(ws + WS_ROPE); float* nls = (float*)(ws + WS_NLS);
        for (int idx = tid; idx < 1024; idx += 512) { const int pos = idx >> 4, i = idx & 15;
            const float inv = __builtin_exp2f(-(float)i * (13.287712379549449f / 16.0f));
            const float angf = (float)pos * inv; const double ang = (double)angf;
            const double twopi = 6.283185307179586476925287; const double r = ang - twopi * __builtin_rint(ang / twopi);
            const double r2 = r * r; double cterm = 1.0, sterm = r, cs = 1.0, sn = r;
            for (int k = 1; k <= 14; ++k) { cterm *= -r2 / (double)((2 * k - 1) * (2 * k)); sterm *= -r2 / (double)((2 * k) * (2 * k + 1)); cs += cterm; sn += sterm; }
            rope[idx * 2] = (float)cs; rope[idx * 2 + 1] = (float)sn; }
        for (int idx = tid; idx < 2 * DRNN; idx += 512) { const float lm = p->lam[idx]; nls[idx] = -8.0f * log1pf(__expf(-lm)); }
        { unsigned* fl = (unsigned*)(ws + WS_FLAG); for (int idx = tid; idx < 1440 * 16; idx += 512) fl[idx] = 0u; }
    }
    transpose_range(p, ws, lds, 0, TR_L0 + TR_LRU + TR_MLP1, blockIdx.x * 8 + wave, gridDim.x * 8, wave, lane);
}

template <bool HAS_Y, bool HAS_H, bool XIN_BF, bool XOUT_BF>
__device__ __forceinline__ void row_phase(const void* xin_lat, const void* xin_ctx, void* xout_lat, void* xout_ctx, const bf16_t* Y, const bf16_t* SLAB, bf16_t* H,
                                          const float* gy, const float* gh, const float* mod_g, int gate_idx, const float* mod_h, int shift_idx, int scale_idx,
                                          int nrows, int gw, int ngw, int lane) {
    const int rpw = (nrows + ngw - 1) / ngw, r_begin = gw * rpw, r_end = (r_begin + rpw < nrows) ? r_begin + rpw : nrows;
    f32x4 xn[4]; u32x2 xb[4], yn[4], ys[3][4];
    f32x4 vgy[4], vgh[4], vgt[4], vsh[4], vsc[4];
#pragma unroll
    for (int j = 0; j < 4; ++j) { if (HAS_Y) vgy[j] = *(const f32x4*)(gy + lane * 4 + 256 * j); if (HAS_H) vgh[j] = *(const f32x4*)(gh + lane * 4 + 256 * j); }
    int cur_who = -1;
#define ROW_LOAD(r) do { const int r_ = (r); const bool lat_ = r_ < ML; const size_t ro_ = lat_ ? (size_t)r_ * DM : (size_t)(r_ - ML) * DM; \
        if (XIN_BF) { const bf16_t* xi_ = (const bf16_t*)(lat_ ? xin_lat : xin_ctx) + ro_; _Pragma("unroll") for (int j = 0; j < 4; ++j) xb[j] = *(const u32x2*)(xi_ + lane * 4 + 256 * j); } \
        else { const float* xi_ = (const float*)(lat_ ? xin_lat : xin_ctx) + ro_; _Pragma("unroll") for (int j = 0; j < 4; ++j) xn[j] = *(const f32x4*)(xi_ + lane * 4 + 256 * j); } \
        if (HAS_Y) { if (SLAB != nullptr && !lat_) { const bf16_t* yp_ = SLAB + (size_t)(r_ - ML) * DM + lane * 4; \
                _Pragma("unroll") for (int j = 0; j < 4; ++j) { yn[j] = *(const u32x2*)(yp_ + 256 * j); ys[0][j] = *(const u32x2*)(yp_ + 256 * j + (size_t)MC * DM); ys[1][j] = *(const u32x2*)(yp_ + 256 * j + (size_t)2 * MC * DM); ys[2][j] = *(const u32x2*)(yp_ + 256 * j + (size_t)3 * MC * DM); } } \
            else { _Pragma("unroll") for (int j = 0; j < 4; ++j) yn[j] = *(const u32x2*)(Y + (size_t)r_ * DM + lane * 4 + 256 * j); } } } while (0)
    if (r_begin < r_end) ROW_LOAD(r_begin);
    for (int row = r_begin; row < r_end; ++row) {
        const bool lat = row < ML; const int who = lat ? (row >> 11) : 8;
        if (who != cur_who) { cur_who = who;
#pragma unroll
            for (int j = 0; j < 4; ++j) { const int col = lane * 4 + 256 * j;
                if (HAS_Y) vgt[j] = *(const f32x4*)(mod_g + (size_t)who * 6144 + gate_idx * 1024 + col);
                if (HAS_H) { vsh[j] = *(const f32x4*)(mod_h + (size_t)who * 6144 + shift_idx * 1024 + col); vsc[j] = *(const f32x4*)(mod_h + (size_t)who * 6144 + scale_idx * 1024 + col) + 1.0f; } } }
        f32x4 xv[4], yv[4];
#pragma unroll
        for (int j = 0; j < 4; ++j) xv[j] = XIN_BF ? bf4_to_f32(xb[j]) : xn[j];
        if (HAS_Y) {
#pragma unroll
            for (int j = 0; j < 4; ++j) { yv[j] = bf4_to_f32(yn[j]);
                if (SLAB != nullptr && !lat) yv[j] = (yv[j] + bf4_to_f32(ys[0][j])) + (bf4_to_f32(ys[1][j]) + bf4_to_f32(ys[2][j])); }
        }
        asm volatile("" ::: "memory");
        if (row + 1 < r_end) ROW_LOAD(row + 1);
        if (HAS_Y) {
            float s = 0.f;
#pragma unroll
            for (int j = 0; j < 4; ++j) s += (yv[j][0] * yv[j][0] + yv[j][1] * yv[j][1]) + (yv[j][2] * yv[j][2] + yv[j][3] * yv[j][3]);
            const float rstd = 1.0f / sqrtf(wave_sum(s) * (1.0f / DM) + EPS);
            const size_t ro = lat ? (size_t)row * DM : (size_t)(row - ML) * DM;
#pragma unroll
            for (int j = 0; j < 4; ++j) { xv[j] = xv[j] + vgt[j] * (yv[j] * rstd * vgy[j]);
                if (XOUT_BF) { const u32x2 w = f32_to_bf4(xv[j]); *(u32x2*)((bf16_t*)(lat ? xout_lat : xout_ctx) + ro + lane * 4 + 256 * j) = w; xv[j] = bf4_to_f32(w); }
                else *(f32x4*)((float*)(lat ? xout_lat : xout_ctx) + ro + lane * 4 + 256 * j) = xv[j]; }
        }
        if (HAS_H) {
            float s = 0.f;
#pragma unroll
            for (int j = 0; j < 4; ++j) s += (xv[j][0] * xv[j][0] + xv[j][1] * xv[j][1]) + (xv[j][2] * xv[j][2] + xv[j][3] * xv[j][3]);
            const float rstd = 1.0f / sqrtf(wave_sum(s) * (1.0f / DM) + EPS);
#pragma unroll
            for (int j = 0; j < 4; ++j) { const f32x4 hv = (xv[j] * rstd * vgh[j]) * vsc[j] + vsh[j]; *(u32x2*)(H + (size_t)row * DM + lane * 4 + 256 * j) = f32_to_bf4(hv); }
        }
    }
#undef ROW_LOAD
}

__device__ __forceinline__ void attn_phase(LAS unsigned char* lds, const bf16_t* Q, bf16_t* O, const bf16_t* Kb, const bf16_t* VT, const bf16_t* VTC, const float* sink, int tid, int lane, int wave) {
    constexpr int PITCH = 72;
    LAS bf16_t* Ks = (LAS bf16_t*)lds;
    LAS bf16_t* Vs = (LAS bf16_t*)(lds + 2 * 64 * PITCH * 2);
    const int lr = lane & 15, lg = lane >> 4;
    const int skey = tid >> 3, spiece = tid & 7;
    for (int unit = blockIdx.x; unit < 576; unit += gridDim.x) {
        int b, kvh, qrow0, qblk, nloc, lt0; bool latu = unit < 512;
        if (latu) { b = unit >> 6; const int rem = unit & 63; qblk = rem >> 2; kvh = rem & 3; qrow0 = b * SEQ + qblk * 128; lt0 = (qblk == 0) ? 2 : 0; nloc = ((qblk == 15) ? 4 : 6) - lt0; }
        else { const int cu = unit - 512; b = cu >> 3; kvh = (cu & 7) >> 1; qblk = 0; qrow0 = ML + b * CTX + (cu & 1) * 128; lt0 = 0; nloc = 0; }
        const int nlo = (latu && qblk > 0) ? 2 : 0, nmid = latu ? 2 : 0, nup = (latu && qblk < 15) ? 2 : 0;
        const int n1 = nlo, n2 = nlo + nmid, n3 = n2 + 4, nT = n3 + nup; (void)nloc; (void)lt0;
        const int head = kvh * 4 + (wave >> 1);
        const int qr0 = qrow0 + (wave & 1) * 64;
        const bf16_t* qbase = Q + (size_t)qr0 * 1024 + head * 64;
        bf16_t* obase = O + (size_t)qr0 * 1024 + head * 64;
        LAS unsigned char* Qs = lds + 40960 + wave * 8192;
#pragma unroll
        for (int qt = 0; qt < 4; ++qt)
#pragma unroll
            for (int dh = 0; dh < 2; ++dh) *(LAS bf16x8*)(Qs + (qt * 2 + dh) * 1024 + lane * 16) = *(const bf16x8*)(qbase + (unsigned)((qt * 16 + lr) * 1024 + dh * 32 + lg * 8));
        f32x4 o[4][4];
#pragma unroll
        for (int qt = 0; qt < 4; ++qt)
#pragma unroll
            for (int dt = 0; dt < 4; ++dt) o[qt][dt] = (f32x4){0.f, 0.f, 0.f, 0.f};
        float m2[4], ls[4];
        { const float sk = sink[head] * LOG2E;
#pragma unroll
          for (int qt = 0; qt < 4; ++qt) { m2[qt] = sk; ls[qt] = (lg == 0) ? 1.0f : 0.0f; } }
        u32x4 kreg, vreg;
#define ATT_TOK0(j_) ((qblk - 1) * 128 + (((j_) < n1) ? (j_) : (((j_) < n2) ? 2 + (j_) - n1 : 4 + (j_) - n3)) * 64)
#define ATT_LOAD(j) do { const int _j = (j); if (_j < n2 || _j >= n3) { const int tok0 = ATT_TOK0(_j); \
                const bf16_t* kb_ = Kb + (size_t)(b * SEQ + tok0) * 256 + kvh * 64; const bf16_t* vb_ = VT + (size_t)(b * 4 + kvh) * 64 * SEQ + tok0; \
                kreg = *(const u32x4*)(kb_ + (unsigned)(skey * 256 + spiece * 8)); vreg = *(const u32x4*)(vb_ + (unsigned)(skey * SEQ + spiece * 8)); } \
            else { const int tok0 = (_j - n2) * 64; \
                const bf16_t* kb_ = Kb + (size_t)(ML + b * CTX + tok0) * 256 + kvh * 64; const bf16_t* vb_ = VTC + (size_t)(b * 4 + kvh) * 64 * CTX + tok0; \
                kreg = *(const u32x4*)(kb_ + (unsigned)(skey * 256 + spiece * 8)); vreg = *(const u32x4*)(vb_ + (unsigned)(skey * CTX + spiece * 8)); } } while (0)
#define ATT_STORE(buf) do { *(LAS u32x4*)(Ks + (buf) * 64 * PITCH + skey * PITCH + spiece * 8) = kreg; *(LAS u32x4*)(Vs + (buf) * 64 * PITCH + skey * PITCH + spiece * 8) = vreg; } while (0)
        __syncthreads();
        ATT_LOAD(0); ATT_STORE(0);
        __syncthreads();
#define ATT_BODY(MM) { \
            const int buf = j & 1; \
            if (j + 1 < nT) ATT_LOAD(j + 1); \
            const LAS bf16_t* Kt = Ks + buf * 64 * PITCH; const LAS bf16_t* Vt = Vs + buf * 64 * PITCH; \
            const int ktok0 = ATT_TOK0(j); \
            bf16x8 kf[4][2]; \
            _Pragma("unroll") \
            for (int ks = 0; ks < 4; ++ks) \
            _Pragma("unroll") \
                for (int dh = 0; dh < 2; ++dh) kf[ks][dh] = *(const LAS bf16x8*)(Kt + (ks * 16 + lr) * PITCH + dh * 32 + lg * 8); \
            _Pragma("unroll") \
            for (int hq = 0; hq < 2; ++hq) { \
            bf16x8 pb[2][2]; \
            _Pragma("unroll") \
            for (int q2 = 0; q2 < 2; ++q2) { \
                const int qt = hq * 2 + q2; \
                f32x4 s[4]; \
                const bf16x8 qf0 = *(const LAS bf16x8*)(Qs + (qt * 2 + 0) * 1024 + lane * 16), qf1 = *(const LAS bf16x8*)(Qs + (qt * 2 + 1) * 1024 + lane * 16); \
            _Pragma("unroll") \
                for (int ks = 0; ks < 4; ++ks) { s[ks] = __builtin_amdgcn_mfma_f32_16x16x32_bf16(kf[ks][0], qf0, (f32x4){0.f, 0.f, 0.f, 0.f}, 0, 0, 0); \
                    s[ks] = __builtin_amdgcn_mfma_f32_16x16x32_bf16(kf[ks][1], qf1, s[ks], 0, 0, 0); } \
                if (MM == 1) {    \
                    const int lim = qblk * 128 + (wave & 1) * 64 + qt * 16 + lr - 128 - ktok0 - lg * 4; \
            _Pragma("unroll") \
                    for (int ks = 0; ks < 4; ++ks) \
            _Pragma("unroll") \
                        for (int jj = 0; jj < 4; ++jj) s[ks][jj] = (ks * 16 + jj >= lim) ? s[ks][jj] : -1e30f; \
                } else if (MM == 2) {    \
                    const int lim = qblk * 128 + (wave & 1) * 64 + qt * 16 + lr + 128 - ktok0 - lg * 4; \
            _Pragma("unroll") \
                    for (int ks = 0; ks < 4; ++ks) \
            _Pragma("unroll") \
                        for (int jj = 0; jj < 4; ++jj) s[ks][jj] = (ks * 16 + jj <= lim) ? s[ks][jj] : -1e30f; \
                } \
                float mx = -3e38f; \
            _Pragma("unroll") \
                for (int ks = 0; ks < 4; ++ks) mx = fmaxf(mx, fmaxf(fmaxf(s[ks][0], s[ks][1]), fmaxf(s[ks][2], s[ks][3]))); \
                mx = fmaxf(mx, __shfl_xor(mx, 16)); mx = fmaxf(mx, __shfl_xor(mx, 32)); \
                const float mnew = fmaxf(m2[qt], mx * LOG2E); \
                const float alpha = __builtin_amdgcn_exp2f(m2[qt] - mnew); \
                m2[qt] = mnew; \
                float rs = 0.f; \
            _Pragma("unroll") \
                for (int ks = 0; ks < 4; ++ks) \
            _Pragma("unroll") \
                    for (int jj = 0; jj < 4; ++jj) { const float pv = __builtin_amdgcn_exp2f(s[ks][jj] * LOG2E - mnew); s[ks][jj] = pv; rs += pv; } \
                ls[qt] = ls[qt] * alpha + rs; \
            _Pragma("unroll") \
                for (int dt = 0; dt < 4; ++dt) o[qt][dt] = o[qt][dt] * alpha; \
            _Pragma("unroll") \
                for (int c2 = 0; c2 < 2; ++c2) { u32x4 w; w.x = cvt_pk_bf16(s[2 * c2][0], s[2 * c2][1]); w.y = cvt_pk_bf16(s[2 * c2][2], s[2 * c2][3]); w.z = cvt_pk_bf16(s[2 * c2 + 1][0], s[2 * c2 + 1][1]); w.w = cvt_pk_bf16(s[2 * c2 + 1][2], s[2 * c2 + 1][3]); \
                    pb[q2][c2] = __builtin_bit_cast(bf16x8, w); } \
            } \
            _Pragma("unroll") \
            for (int c2 = 0; c2 < 2; ++c2) \
            _Pragma("unroll") \
                for (int dt = 0; dt < 4; ++dt) { \
                    const LAS bf16_t* vp = Vt + (dt * 16 + lr) * PITCH + c2 * 32 + lg * 4; \
                    const u32x2 v0 = *(const LAS u32x2*)vp, v1 = *(const LAS u32x2*)(vp + 16); \
                    const u32x4 vv = {v0.x, v0.y, v1.x, v1.y}; \
                    const bf16x8 vf = __builtin_bit_cast(bf16x8, vv); \
            _Pragma("unroll") \
                    for (int q2 = 0; q2 < 2; ++q2) o[hq * 2 + q2][dt] = __builtin_amdgcn_mfma_f32_16x16x32_bf16(vf, pb[q2][c2], o[hq * 2 + q2][dt], 0, 0, 0); \
                } \
            } \
            if (j + 1 < nT) ATT_STORE(buf ^ 1); \
            __syncthreads(); \
        }
        int j = 0;
#pragma unroll 1
        for (; j < n1; ++j) ATT_BODY(1)
#pragma unroll 1
        for (; j < n3; ++j) ATT_BODY(0)
#pragma unroll 1
        for (; j < nT; ++j) ATT_BODY(2)
#undef ATT_BODY
#pragma unroll
        for (int qt = 0; qt < 4; ++qt) {
            float l = ls[qt]; l += __shfl_xor(l, 16); l += __shfl_xor(l, 32);
            const float inv = 1.0f / l;
            int lro = lr * 1024 + lg * 4; asm volatile("" : "+v"(lro));
            bf16_t* op = obase + (unsigned)(qt * 16 * 1024 + lro);
#pragma unroll
            for (int dt = 0; dt < 4; ++dt) *(u32x2*)(op + dt * 16) = f32_to_bf4(o[qt][dt] * inv);
        }
    }
#undef ATT_LOAD
#undef ATT_TOK0
#undef ATT_STORE
}

__device__ __forceinline__ void conv_phase(const bf16_t* R, bf16_t* U, const float* cw, const float* cb, int gtid, int nthreads) {
    for (int idx = gtid; idx < MT * 160; idx += nthreads) {
        const int row = idx / 160, ch = (idx % 160) * 8;
        int t, T; if (row < ML) { t = row & 2047; T = SEQ; } else { t = (row - ML) & 255; T = CTX; }
        float acc[8];
        { const f32x4 b0 = *(const f32x4*)(cb + ch), b1 = *(const f32x4*)(cb + ch + 4); acc[0] = b0[0]; acc[1] = b0[1]; acc[2] = b0[2]; acc[3] = b0[3]; acc[4] = b1[0]; acc[5] = b1[1]; acc[6] = b1[2]; acc[7] = b1[3]; }
#pragma unroll
        for (int tap = 0; tap < 4; ++tap) { const int tt = t + tap - 2;
            if (tt >= 0 && tt < T) { const u32x4 rv = *(const u32x4*)(R + (size_t)(row + tap - 2) * DRNN + ch);
                const f32x4 w0 = *(const f32x4*)(cw + tap * DRNN + ch), w1 = *(const f32x4*)(cw + tap * DRNN + ch + 4);
                acc[0] += w0[0] * bf_lo(rv.x); acc[1] += w0[1] * bf_hi(rv.x); acc[2] += w0[2] * bf_lo(rv.y); acc[3] += w0[3] * bf_hi(rv.y);
                acc[4] += w1[0] * bf_lo(rv.z); acc[5] += w1[1] * bf_hi(rv.z); acc[6] += w1[2] * bf_lo(rv.w); acc[7] += w1[3] * bf_hi(rv.w); } }
        u32x4 o; o.x = cvt_pk_bf16(acc[0], acc[1]); o.y = cvt_pk_bf16(acc[2], acc[3]); o.z = cvt_pk_bf16(acc[4], acc[5]); o.w = cvt_pk_bf16(acc[6], acc[7]);
        *(u32x4*)(U + (size_t)row * DRNN + ch) = o;
    }
}
__device__ __forceinline__ int scan_row0(int bl, int c) { return (c < 8) ? (8192 + bl * CTX + c * 32) : (bl * SEQ + (c - 8) * 32); }
__device__ __forceinline__ void scanA_phase(const bf16_t* LA, const bf16_t* BX, float* SP, float* SH, int gtid, int nthreads) {
    for (int idx = gtid; idx < 2 * 4 * 72 * 640; idx += nthreads) {
        const int cp = idx % 640, r1 = idx / 640, c = r1 % 72, r2 = r1 / 72, bl = r2 & 3, dir = r2 >> 2;
        const int row0 = scan_row0(bl, c);
        const size_t base = ((size_t)dir * 9216 + row0) * DRNN + cp * 2;
        float P0 = 1.f, P1 = 1.f, H0 = 0.f, H1 = 0.f;
#pragma unroll 8
        for (int i = 0; i < 32; ++i) { const int ii = dir ? (31 - i) : i;
            const unsigned lw = *(const unsigned*)(LA + base + (size_t)ii * DRNN), bw = *(const unsigned*)(BX + base + (size_t)ii * DRNN);
            const float a0 = __expf(bf_lo(lw)), a1 = __expf(bf_hi(lw));
            P0 *= a0; P1 *= a1; H0 = a0 * H0 + bf_lo(bw); H1 = a1 * H1 + bf_hi(bw); }
        const size_t so = ((size_t)(dir * 4 + bl) * 72 + c) * DRNN + cp * 2;
        *(f32x2*)(SP + so) = (f32x2){P0, P1}; *(f32x2*)(SH + so) = (f32x2){H0, H1};
    }
}
__device__ __forceinline__ void scanB_phase(const float* SP, const float* SH, float* CIN, int gtid, int nthreads) {
    for (int idx = gtid; idx < 2 * 4 * DRNN; idx += nthreads) {
        const int ch = idx % DRNN, r = idx / DRNN, bl = r & 3, dir = r >> 2;
        const size_t base = ((size_t)(dir * 4 + bl) * 72) * DRNN + ch;
        float carry = 0.f;
#pragma unroll 1
        for (int s0 = 0; s0 < 72; s0 += 24) {
            float pv[24], hv[24];
#pragma unroll
            for (int s = 0; s < 24; ++s) { const int sq = s0 + s; const int c = dir ? (sq < 8 ? 7 - sq : 79 - sq) : sq; pv[s] = SP[base + (size_t)c * DRNN]; hv[s] = SH[base + (size_t)c * DRNN]; }
#pragma unroll
            for (int s = 0; s < 24; ++s) { const int sq = s0 + s; const int c = dir ? (sq < 8 ? 7 - sq : 79 - sq) : sq; CIN[base + (size_t)c * DRNN] = carry; carry = pv[s] * carry + hv[s]; }
        }
    }
}
__device__ __forceinline__ void scanC_phase(const bf16_t* LA, const bf16_t* BX, const float* CIN, bf16_t* REC, int half, int gtid, int nthreads) {
    for (int idx = gtid; idx < 4 * 64 * 640; idx += nthreads) {
        const int cp = idx % 640, r1 = idx / 640, lc = r1 & 63, bl = r1 >> 6;
        const int row0 = bl * SEQ + lc * 32;
        const size_t b0 = ((size_t)row0) * DRNN + cp * 2, b1 = ((size_t)9216 + row0) * DRNN + cp * 2;
        const f32x2 cf = *(const f32x2*)(CIN + ((size_t)(0 * 4 + bl) * 72 + 8 + lc) * DRNN + cp * 2);
        const f32x2 cbk = *(const f32x2*)(CIN + ((size_t)(1 * 4 + bl) * 72 + 8 + lc) * DRNN + cp * 2);
        float hf0[32], hf1[32];
        float h0 = cf[0], h1 = cf[1];
#pragma unroll
        for (int i = 0; i < 32; ++i) { const unsigned lw = *(const unsigned*)(LA + b0 + (size_t)i * DRNN), bw = *(const unsigned*)(BX + b0 + (size_t)i * DRNN);
            h0 = __expf(bf_lo(lw)) * h0 + bf_lo(bw); h1 = __expf(bf_hi(lw)) * h1 + bf_hi(bw); hf0[i] = h0; hf1[i] = h1; }
        h0 = cbk[0]; h1 = cbk[1];
        bf16_t* out = REC + ((size_t)(half * 4 + bl) * SEQ + lc * 32) * DRNN + cp * 2;
#pragma unroll
        for (int i = 31; i >= 0; --i) { const unsigned lw = *(const unsigned*)(LA + b1 + (size_t)i * DRNN), bw = *(const unsigned*)(BX + b1 + (size_t)i * DRNN);
            h0 = __expf(bf_lo(lw)) * h0 + bf_lo(bw); h1 = __expf(bf_hi(lw)) * h1 + bf_hi(bw);
            *(unsigned*)(out + (size_t)i * DRNN) = cvt_pk_bf16(hf0[i] + h0, hf1[i] + h1); }
    }
}

#ifndef PH_MASK
#define PH_MASK 0xFFFFFFFFu
#endif
#define PH(k) ((PH_MASK >> (k)) & 1u)
#ifndef REP_MASK
#define REP_MASK 0u
#endif
#define REP_BEGIN(k) _Pragma("unroll 1") for (int rep_ = 0; rep_ < (((REP_MASK >> (k)) & 1u) ? 2 : 1); ++rep_) {
#define REP_END }
__device__ __forceinline__ ParamsK kparams() { ParamsK q = (ParamsK)__builtin_amdgcn_kernarg_segment_ptr(); asm volatile("" : "+s"(q)); return q; }
#define PHASE_BEGIN ParamsK kp = kparams(); unsigned char* ws = kp->ws; (void)ws; \
    int tid = threadIdx.x; asm volatile("" : "+v"(tid)); const int lane = tid & 63, wave = __builtin_amdgcn_readfirstlane(tid >> 6); \
    const int gw = bid * 8 + wave, gtid = bid * 512 + tid; (void)lane; (void)gw; (void)gtid;
#define P_MOD0 ((float*)(ws + WS_MOD))
#define P_MOD1 ((float*)(ws + WS_MOD) + 9 * 6144)
#define P_CTXRES ((float*)(ws + WS_CTXRES))
#define P_H ((bf16_t*)(ws + WS_H))
#define P_SLAB ((bf16_t*)(ws + WS_SLAB))
#define P_Q ((bf16_t*)(ws + WS_Q))
#define P_O ((bf16_t*)(ws + WS_O))
#define P_K ((bf16_t*)(ws + WS_K))
#define P_VT ((bf16_t*)(ws + WS_VT))
#define P_VTC ((bf16_t*)(ws + WS_VTC))
#define P_ACT ((bf16_t*)(ws + WS_ACT))
#define P_U ((bf16_t*)(ws + WS_U))
#define P_RECF ((bf16_t*)(ws + WS_RECF))
#define P_RECB ((bf16_t*)(ws + WS_RECB))
#define P_LA ((bf16_t*)(ws + WS_LA))
#define P_BX ((bf16_t*)(ws + WS_BX))
#define P_RPRE ((bf16_t*)(ws + WS_RPRE))
#define P_SP ((float*)(ws + WS_SP))
#define P_SH ((float*)(ws + WS_SH))
#define P_CIN ((float*)(ws + WS_CIN))
#define G0 (kp->norm_g)
#define G1 (kp->norm_g + 4 * DM)

__global__ void __launch_bounds__(512, 2) fwd_megakernel(Params p) {
    extern __shared__ __attribute__((aligned(16))) unsigned char lds_raw[];
    LAS unsigned char* lds = (LAS unsigned char*)lds_raw;
    const int G = gridDim.x, bid = blockIdx.x;
    const int ngw = G * 8, nthreads = G * 512;
    using namespace pg8;
    if (threadIdx.x < 4) ((volatile LAS unsigned*)(lds + 132096))[threadIdx.x] = 0u;
    __syncthreads();
    XcdBarrier xbar = xcd_barrier_post((unsigned*)(p.ws + WS_BAR), (volatile LAS unsigned*)(lds + 132096));
    if (PH(0)) { PHASE_BEGIN prologue(kp, lds, tid, lane, wave); }
    xcd_barrier(xbar);
#ifdef EXTRA_SYNCS
#pragma unroll 1
    for (int es = 0; es < EXTRA_SYNCS; ++es) xcd_barrier(xbar);
#endif
    REP_BEGIN(1)
    if (PH(1)) { PHASE_BEGIN row_phase<false, true, false, false>(kp->x, kp->ctx, nullptr, nullptr, nullptr, nullptr, P_H, nullptr, G0, nullptr, 0, P_MOD0, 0, 1, MT, gw, ngw, lane); }
    xcd_barrier(xbar);
    REP_END
    if (PH(2)) {
        PHASE_BEGIN
        Gemm g{P_H, (const bf16_t*)(ws + WS_WQKV), DM, DM, DM}; Sched S; S.init(MT / 256, NQKV / 256, G, bid);
        EpiQKV E{P_Q, P_K, P_VT, P_VTC, (const float*)(ws + WS_ROPE)};
        gemm_phase<EpiQKV, true, true>(lds, g, S, E);
    }
    xcd_barrier(xbar);
    REP_BEGIN(3)
    if (PH(3)) { PHASE_BEGIN attn_phase(lds, P_Q, P_O, P_K, P_VT, P_VTC, kp->sink, tid, lane, wave); }
    xcd_barrier(xbar);
    REP_END
    if (PH(4)) {
        PHASE_BEGIN
        { Gemm g{P_O, (const bf16_t*)(ws + WS_WO), DM, DM, DM}; Sched S; S.init(ML / 256, DM / 256, G, bid);
          EpiPlain<0> E{P_H, DM};
          gemm_phase<EpiPlain<0>, true, true>(lds, g, S, E); }
        { Gemm g{P_O, (const bf16_t*)(ws + WS_WO), DM, DM, 256}; Sched S; S.init(8, 4 * 4, G, bid, 2, 256);
          EpiSlabCtx E{P_SLAB, 256};
          gemm_phase<EpiSlabCtx, true, true>(lds, g, S, E); }
    }
    xcd_barrier(xbar);
    if (PH(5)) { PHASE_BEGIN row_phase<true, true, false, true>(kp->x, kp->ctx, kp->out, P_CTXRES, P_H, P_SLAB, P_H, G0 + DM, G0 + 2 * DM, P_MOD0, 2, P_MOD0, 3, 4, MT, gw, ngw, lane); }
    xcd_barrier(xbar);
    if (PH(6)) {
        PHASE_BEGIN
        Gemm g{P_H, (const bf16_t*)(ws + WS_W1), DM, DM, DM}; Sched S; S.init(MT / 256, DFF / 256, G, bid);
        EpiPlain<1> E{P_ACT, DFF};
        gemm_phase<EpiPlain<1>, true, true>(lds, g, S, E);
    }
    xcd_barrier(xbar);
    if (PH(7)) {
        PHASE_BEGIN
        { Gemm g{P_ACT, (const bf16_t*)(ws + WS_W2), DFF, DFF, DFF}; Sched S; S.init(ML / 256, DM / 256, G, bid);
          EpiPlain<0> E{P_H, DM};
          gemm_phase<EpiPlain<0>, true, true>(lds, g, S, E); }
        { Gemm g{P_ACT, (const bf16_t*)(ws + WS_W2), DFF, DFF, 1024}; Sched S; S.init(8, 4 * 4, G, bid, 2, 1024);
          EpiSlabCtx E{P_SLAB, 1024};
          gemm_phase<EpiSlabCtx, true, true>(lds, g, S, E); }
    }
    xcd_barrier(xbar);
    if (PH(8)) { PHASE_BEGIN row_phase<true, true, true, true>(kp->out, P_CTXRES, kp->out, P_CTXRES, P_H, P_SLAB, P_H, G0 + 3 * DM, G1, P_MOD0, 5, P_MOD1, 0, 1, MT, gw, ngw, lane); }
    xcd_barrier(xbar);
    if (PH(9)) {
        PHASE_BEGIN
        Gemm g{P_H, (const bf16_t*)(ws + WS_WIN), DM, DM, DM}; Sched S; S.init(MT / 256, DRNN / 256, G, bid, 4, 0);
        EpiInProj E{P_RPRE, (bf16_t*)(ws + WS_CTXRES)};
        gemm_phase<EpiInProj, true, true>(lds, g, S, E);
    }
    xcd_barrier(xbar);
    REP_BEGIN(10)
    if (PH(10)) { PHASE_BEGIN conv_phase(P_RPRE, P_U, kp->conv_w, kp->conv_b, gtid, nthreads); }
    xcd_barrier(xbar);
    REP_END
    if (PH(11)) {
        PHASE_BEGIN
        Gemm g{P_U, (const bf16_t*)(ws + WS_WG), DRNN, 256, 256}; Sched S; S.init(1, 1, G, bid, 3, 0);
        EpiGatesScan E{P_U, P_RECF, P_RECB, kp->b_a, kp->b_i, (const float*)(ws + WS_NLS), (float*)(ws + WS_CARRY), (unsigned*)(ws + WS_FLAG)};
        gemm_phase<EpiGatesScan, true, true>(lds, g, S, E);
    }
    xcd_barrier(xbar);
    if (PH(15)) {
        PHASE_BEGIN
        Gemm g{P_H, (const bf16_t*)(ws + WS_WIN), DM, DM, DM}; Sched S; S.init(ML / 256, 4, G, bid);
        EpiGateMul E{P_RECF, P_RECB};
        gemm_phase<EpiGateMul, true, true>(lds, g, S, E);
        {
            const bf16_t* GB = (const bf16_t*)(ws + WS_CTXRES); bf16_t* Z = P_RECF; const bf16_t* RB = P_RECB;
            for (int idx = gtid; idx < ML * 32; idx += nthreads) { const int row = idx >> 5, c8 = (idx & 31) * 8;
                const u32x4 gv = *(const u32x4*)(GB + (size_t)row * 256 + c8); const size_t o = (size_t)row * DRNN + 1024 + c8;
                const u32x4 fv = *(const u32x4*)(Z + o), bv = *(const u32x4*)(RB + o); u32x4 w;
                w.x = cvt_pk_bf16(bf_lo(gv.x) * (bf_lo(fv.x) + bf_lo(bv.x)), bf_hi(gv.x) * (bf_hi(fv.x) + bf_hi(bv.x)));
                w.y = cvt_pk_bf16(bf_lo(gv.y) * (bf_lo(fv.y) + bf_lo(bv.y)), bf_hi(gv.y) * (bf_hi(fv.y) + bf_hi(bv.y)));
                w.z = cvt_pk_bf16(bf_lo(gv.z) * (bf_lo(fv.z) + bf_lo(bv.z)), bf_hi(gv.z) * (bf_hi(fv.z) + bf_hi(bv.z)));
                w.w = cvt_pk_bf16(bf_lo(gv.w) * (bf_lo(fv.w) + bf_lo(bv.w)), bf_hi(gv.w) * (bf_hi(fv.w) + bf_hi(bv.w)));
                *(u32x4*)(Z + o) = w; }
        }
    }
    xcd_barrier(xbar);
    if (PH(16)) {
        PHASE_BEGIN
        Gemm g{P_RECF, (const bf16_t*)(ws + WS_WOUT), DRNN, DRNN, DRNN}; Sched S; S.init(ML / 256, DM / 256, G, bid);
        EpiPlain<0> E{P_H, DM};
        gemm_phase<EpiPlain<0>, true, true>(lds, g, S, E);
    }
    xcd_barrier(xbar);
    if (PH(17)) { PHASE_BEGIN row_phase<true, true, true, true>(kp->out, P_CTXRES, ws + WS_X3, P_CTXRES, P_H, nullptr, P_H, G1 + DM, G1 + 2 * DM, P_MOD1, 2, P_MOD1, 3, 4, ML, gw, ngw, lane); }
    xcd_barrier(xbar);
    if (PH(18)) {
        PHASE_BEGIN
        Gemm g{P_H, (const bf16_t*)(ws + WS_W1 + 16 * MiB), DM, DM, DM}; Sched S; S.init(ML / 256, DFF / 256, G, bid);
        EpiPlain<1> E{P_ACT, DFF};
        gemm_phase<EpiPlain<1>, true, true>(lds, g, S, E);
    }
    xcd_barrier(xbar);
    if (PH(19)) {
        PHASE_BEGIN
        Gemm g{P_ACT, (const bf16_t*)(ws + WS_W2 + 16 * MiB), DFF, DFF, DFF}; Sched S; S.init(ML / 256, DM / 256, G, bid);
        EpiPlain<0> E{P_H, DM};
        gemm_phase<EpiPlain<0>, true, true>(lds, g, S, E);
    }
    xcd_barrier(xbar);
    if (PH(20)) { PHASE_BEGIN row_phase<true, false, true, false>(ws + WS_X3, P_CTXRES, kp->out, P_CTXRES, P_H, nullptr, nullptr, G1 + 3 * DM, nullptr, P_MOD1, 5, nullptr, 0, 0, ML, gw, ngw, lane); }
}

extern "C" void kernel_launch(void* const* d_in, const int* in_sizes, int n_in, void* d_out, int out_size, void* d_ws, size_t ws_size, hipStream_t stream) {
    static int grid_blocks = 0;
    if (grid_blocks == 0) {
        if (n_in != 21 || ws_size < WS_END) { fprintf(stderr, "kernel_launch: unexpected n_in %d / ws_size %zu\n", n_in, ws_size); grid_blocks = -1; return; }
        int dev = 0, cus = 0, per_cu = 0;
        hipGetDevice(&dev);
        hipDeviceGetAttribute(&cus, hipDeviceAttributeMultiprocessorCount, dev);
        if (hipFuncSetAttribute((const void*)fwd_megakernel, hipFuncAttributeMaxDynamicSharedMemorySize, LDS_BYTES) != hipSuccess) { fprintf(stderr, "hipFuncSetAttribute failed\n"); grid_blocks = -1; return; }
        if (hipOccupancyMaxActiveBlocksPerMultiprocessor(&per_cu, (const void*)fwd_megakernel, 512, LDS_BYTES) != hipSuccess || per_cu < 1) { fprintf(stderr, "occupancy query failed (%d)\n", per_cu); (void)hipGetLastError(); per_cu = 1; }
        grid_blocks = cus * 1;
    }
    if (grid_blocks < 0) return;
    Params p{};
    p.x = (const float*)d_in[0]; p.c = (const float*)d_in[1]; p.ctx = (const float*)d_in[2]; p.c_ctx = (const float*)d_in[3];
    p.ada_w = (const float*)d_in[4]; p.ada_b = (const float*)d_in[5]; p.norm_g = (const float*)d_in[6]; p.mlp_w1 = (const float*)d_in[7]; p.mlp_w2 = (const float*)d_in[8];
    p.w_qkv = (const float*)d_in[9]; p.w_o = (const float*)d_in[10]; p.sink = (const float*)d_in[11];
    p.w_in = (const float*)d_in[12]; p.conv_w = (const float*)d_in[13]; p.conv_b = (const float*)d_in[14]; p.w_a = (const float*)d_in[15]; p.b_a = (const float*)d_in[16];
    p.w_i = (const float*)d_in[17]; p.b_i = (const float*)d_in[18]; p.lam = (const float*)d_in[19]; p.w_out = (const float*)d_in[20];
    p.out = (float*)d_out; p.ws = (unsigned char*)d_ws;
    if (hipMemsetAsync((unsigned char*)d_ws + WS_BAR, 0, XCD_BAR_WORDS * 4, stream) != hipSuccess) { fprintf(stderr, "memset of barrier words failed\n"); return; }
    void* args[] = {&p};
    hipError_t e = hipLaunchCooperativeKernel((const void*)fwd_megakernel, dim3(grid_blocks), dim3(512), args, LDS_BYTES, stream);
    if (e != hipSuccess) fprintf(stderr, "cooperative launch failed: %s (grid %d)\n", hipGetErrorString(e), grid_blocks);
}
```

```cpp
#include <hip/hip_runtime.h>
#include <hip/hip_cooperative_groups.h>
#include <cstdio>
#include <cstdint>
namespace cg = cooperative_groups;

#define LAS __attribute__((address_space(3)))
typedef unsigned short bf16_t;
typedef short bf16x8 __attribute__((ext_vector_type(8)));
typedef float f32x4 __attribute__((ext_vector_type(4)));
typedef float f32x2 __attribute__((ext_vector_type(2)));
typedef unsigned u32x4 __attribute__((ext_vector_type(4)));
typedef unsigned u32x2 __attribute__((ext_vector_type(2)));

constexpr int DM = 1024, NB = 8, SEQ = 2048, CTX = 256;
constexpr int ML = NB * SEQ;
constexpr int MC = NB * CTX;
constexpr int MT = ML + MC;
constexpr int NQKV = 1536, DFF = 4096, DRNN = 1280;
constexpr float EPS = 1e-6f;
constexpr float LOG2E = 1.4426950408889634f;

constexpr size_t MiB = 1u << 20;
constexpr size_t WS_MOD = 0;
constexpr size_t WS_ROPE = 448 * 1024;
constexpr size_t WS_NLS = 460 * 1024;
constexpr size_t WS_BAR = 480 * 1024;
constexpr size_t WS_WQKV = 1 * MiB, WS_WO = 4 * MiB, WS_W1 = 6 * MiB, WS_W2 = 14 * MiB;
constexpr size_t WS_WIN = 38 * MiB, WS_WG = 43 * MiB, WS_WOUT = 46 * MiB;
constexpr size_t WS_CTXRES = 49 * MiB;
constexpr size_t WS_H = 57 * MiB;
constexpr size_t WS_R3 = 93 * MiB;
constexpr size_t WS_Q = WS_R3, WS_K = 129 * MiB, WS_VT = 138 * MiB, WS_VTC = 146 * MiB;
constexpr size_t WS_O = 150 * MiB;
constexpr size_t WS_ACT = WS_R3;
constexpr size_t WS_U = WS_R3;
constexpr size_t WS_RECF = 138 * MiB;
constexpr size_t WS_RECB = 178 * MiB;
constexpr size_t WS_LA = 138 * MiB;
constexpr size_t WS_BX = 183 * MiB;
constexpr size_t WS_RPRE = 138 * MiB;
constexpr size_t WS_SP = 228 * MiB, WS_SH = 231 * MiB, WS_CIN = 234 * MiB;
constexpr size_t WS_SLAB = 238 * MiB;
constexpr size_t WS_CARRY = 219 * MiB;
constexpr size_t WS_FLAG = 512 * 1024;
constexpr size_t WS_X3 = 222 * MiB;
constexpr size_t WS_END = 256 * MiB;
constexpr int LDS_BYTES = 143360;

__device__ __forceinline__ unsigned f2bf(float f) { unsigned u = __builtin_bit_cast(unsigned, f); return (u + 0x7fffu + ((u >> 16) & 1u)) >> 16; }
__device__ __forceinline__ unsigned cvt_pk_bf16(float lo, float hi) { unsigned r; asm volatile("v_cvt_pk_bf16_f32 %0, %1, %2" : "=v"(r) : "v"(lo), "v"(hi)); return r; }
__device__ __forceinline__ float bf_lo(unsigned w) { return __builtin_bit_cast(float, w << 16); }
__device__ __forceinline__ float bf_hi(unsigned w) { return __builtin_bit_cast(float, w & 0xffff0000u); }
__device__ __forceinline__ f32x4 bf4_to_f32(u32x2 w) { return (f32x4){bf_lo(w.x), bf_hi(w.x), bf_lo(w.y), bf_hi(w.y)}; }
__device__ __forceinline__ u32x2 f32_to_bf4(f32x4 v) { u32x2 w; w.x = cvt_pk_bf16(v[0], v[1]); w.y = cvt_pk_bf16(v[2], v[3]); return w; }
__device__ __forceinline__ float wave_sum(float v) {
#pragma unroll
    for (int o = 1; o < 64; o <<= 1) v += __shfl_xor(v, o);
    return v;
}
__device__ __forceinline__ float fsigmoid(float x) { return __builtin_amdgcn_rcpf(1.0f + __expf(-x)); }

namespace pg8 {
constexpr int BM = 256, BK = 64, HALF = 128, HTB = HALF * BK * 2, STAGE_BYTES = 8 * HTB, NXCD = 8, WGM = 8;
__device__ __forceinline__ int lds_byte(int r, int c) { const int st = (r >> 4) * 2 + (c >> 5), rr = r & 15, cc = c & 31, ob = rr * 64 + cc * 2; return st * 1024 + (ob ^ (((ob >> 9) & 1) << 5)); }
__device__ __forceinline__ void stage_rc(int b, int& R, int& C) { const int st = b / 1024, sb = b % 1024, swz = sb ^ (((sb >> 9) & 1) << 5); R = (st >> 1) * 16 + swz / 64; C = (st & 1) * 32 + (swz % 64) / 2; }

struct Unit { int pm, pn, koff, po, kboff, rev, lin; };
struct Gemm { const bf16_t* A; const bf16_t* Bt; int lda, ldb, K; };

struct Sched {
    int nM, nN, nwg, G, c, mode, half;
    __device__ void init(int nM_, int nN_, int G_, int c_, int mode_ = 0, int half_ = 0) { nM = nM_; nN = nN_; nwg = nM * nN; G = G_; c = c_; mode = mode_; half = half_; }
    __device__ bool next(int i, Unit& u) const {
        if (mode == 3) {
            const int L = i * G + c; if (L >= 1440) return false;
            const int ti = L / 160, s = L % 160;
            const int chalf = s & 1, dir = (s >> 1) & 1, bb = s >> 2, blk = bb % 5, b = bb / 5;
            u.pm = (ti == 0) ? 64 + b : (dir ? b * 8 + (8 - ti) : b * 8 + (ti - 1));
            u.pn = (dir * 5 + blk) * 2 + chalf; u.koff = blk * 256; u.kboff = 0; u.po = ti; u.rev = dir; u.lin = L;
            return true;
        }
        if (mode == 4) {
            const int L4 = i * G + c; if (L4 >= 424) return false;
            if (L4 >= 360) { u.pm = L4 - 360; u.pn = 4; u.koff = 0; u.po = u.pm; u.kboff = 0; u.rev = 0; u.lin = 0; return true; }
        }
        const long L = (long)i * G + c; if (L >= nwg) return false;
        int wgid = (int)L; { const int q = nwg / NXCD, r = nwg % NXCD, xcd = wgid % NXCD, off = wgid / NXCD; wgid = (xcd < r ? xcd * (q + 1) : r * (q + 1) + (xcd - r) * q) + off; }
        const int nig = WGM * nN, gid = wgid / nig, fm = gid * WGM, gsz = (nM - fm) < WGM ? (nM - fm) : WGM;
        const int pmi = fm + ((wgid % nig) % gsz), pn = (wgid % nig) / gsz;
        u.pm = pmi; u.pn = pn; u.koff = 0; u.po = pmi; u.kboff = 0; u.rev = 0; u.lin = 0;
        if (mode == 2) { u.pm = 64 + pmi; u.pn = pn & 3; u.koff = (pn >> 2) * half; u.kboff = u.koff; }
        if (mode == 4) u.pn += 5;
        if (mode == 1) { u.pm = pmi < 32 ? 32 * half + pmi : 64 + 4 * half + (pmi - 32); u.koff = ((pn >> 1) % 5) * 256; }
        return true;
    }
};

template <class Epi, bool ALIGN_EPI, bool SP2>
__device__ __forceinline__ void gemm_phase(LAS unsigned char* lds, const Gemm g, const Sched& S, const Epi& E) {
    int tid = threadIdx.x; asm volatile("" : "+v"(tid));
    const int wid = __builtin_amdgcn_readfirstlane(tid >> 6), lane = tid & 63, wr = wid >> 2, wc = wid & 3, fr = lane & 15, fq = lane >> 4;
    const int K = g.K, nt = K / BK;
    unsigned voffAf[2], voffAr[2], voffB[2];
#pragma unroll
    for (int i = 0; i < 2; ++i) { int R, C; stage_rc(tid * 16 + i * 8192, R, C);
        voffAf[i] = (unsigned)(R * g.lda + C) * 2u; voffAr[i] = (unsigned)((127 - R) * g.lda + C) * 2u; voffB[i] = (unsigned)(R * g.ldb + C) * 2u; }
    const size_t kstep = (size_t)(BK * 2);
    const long hstepAf = (long)HALF * g.lda * 2; const size_t hstepB = (size_t)HALF * g.ldb * 2;
    const unsigned ldsw = (unsigned)wid * 1024u;
    const int aoff = lds_byte(wr * 64 + fr, fq * 8), boff = lds_byte(wc * 32 + fr, fq * 8);
#define PG8_SA(b, h) (((b) * 2 + (h)) * HTB)
#define PG8_SB(b, h) ((4 + (b) * 2 + (h)) * HTB)
#define PG8_STAGE(bufoff, gbase, voff) do { _Pragma("unroll") for (int _i = 0; _i < 2; ++_i) \
        __builtin_amdgcn_global_load_lds((const unsigned*)((const char*)(gbase) + (voff)[_i]), (LAS unsigned*)(lds + (bufoff) + ldsw + _i * 8192), 16, 0, 0); } while (0)
#define PG8_LDA(dst, b, h) do { _Pragma("unroll") for (int m = 0; m < 4; ++m) _Pragma("unroll") for (int k = 0; k < 2; ++k) dst[m][k] = *(const LAS bf16x8*)(lds + PG8_SA(b, h) + aoff + m * 2048 + k * 1024); } while (0)
#define PG8_LDB(dst, b, h) do { _Pragma("unroll") for (int n = 0; n < 2; ++n) _Pragma("unroll") for (int k = 0; k < 2; ++k) dst[n][k] = *(const LAS bf16x8*)(lds + PG8_SB(b, h) + boff + n * 2048 + k * 1024); } while (0)
#define PG8_MMA(ai, bj, At, Bt) do { __builtin_amdgcn_s_setprio(1); _Pragma("unroll") for (int m = 0; m < 4; ++m) _Pragma("unroll") for (int n = 0; n < 2; ++n) _Pragma("unroll") for (int k = 0; k < 2; ++k) \
        acc[ai][bj][m][n] = __builtin_amdgcn_mfma_f32_16x16x32_bf16(Bt[n][k], At[m][k], acc[ai][bj][m][n], 0, 0, 0); __builtin_amdgcn_s_setprio(0); } while (0)
#define PG8_WAIT_V(n) asm volatile("s_waitcnt vmcnt(" #n ")" ::: "memory")
#define PG8_WAIT_L(n) asm volatile("s_waitcnt lgkmcnt(" #n ")" ::: "memory")
#define PG8_BAR __builtin_amdgcn_s_barrier()
#define PG8_SCHED __builtin_amdgcn_sched_barrier(0)
    Unit cur, nxt; int ui = 0;
    if (!S.next(0, cur)) return;
    f32x4 acc[2][2][4][2];
#pragma unroll
    for (int a = 0; a < 2; ++a)
#pragma unroll
        for (int b = 0; b < 2; ++b)
#pragma unroll
            for (int m = 0; m < 4; ++m)
#pragma unroll
                for (int n = 0; n < 2; ++n) acc[a][b][m][n] = (f32x4){0.f, 0.f, 0.f, 0.f};
    bf16x8 At[4][2], B0[2][2], B1[2][2];
#define PG8_UNIT_A(u_) ((const char*)g.A + ((size_t)(u_).pm * BM * g.lda + (u_).koff) * 2 + (Epi::WITH_LDS && (u_).rev ? hstepAf : 0))
    const char* cA = PG8_UNIT_A(cur);
    unsigned voffA[2] = {voffAf[0], voffAf[1]}; long hstepA = hstepAf;
    if (Epi::WITH_LDS && cur.rev) { voffA[0] = voffAr[0]; voffA[1] = voffAr[1]; hstepA = -hstepAf; } const char* cB = (const char*)g.Bt + ((size_t)cur.pn * BM * g.ldb + cur.kboff) * 2;
    if constexpr (SP2) {
        PG8_STAGE(PG8_SB(0, 0), cB, voffB); PG8_STAGE(PG8_SB(0, 1), cB + hstepB, voffB); PG8_STAGE(PG8_SA(0, 0), cA, voffA); PG8_STAGE(PG8_SA(0, 1), cA + hstepA, voffA);
        if (wr == 1) PG8_BAR;
        PG8_WAIT_V(2); PG8_BAR;
        PG8_STAGE(PG8_SB(1, 0), cB + kstep, voffB); PG8_STAGE(PG8_SA(1, 0), cA + kstep, voffA); PG8_STAGE(PG8_SB(1, 1), cB + hstepB + kstep, voffB);
        PG8_WAIT_V(6); PG8_BAR;
    } else {
        PG8_STAGE(PG8_SB(0, 0), cB, voffB); PG8_STAGE(PG8_SA(0, 0), cA, voffA); PG8_STAGE(PG8_SB(0, 1), cB + hstepB, voffB); PG8_STAGE(PG8_SA(0, 1), cA + hstepA, voffA);
        if (wr == 1) PG8_BAR;
        PG8_WAIT_V(4); PG8_BAR;
        PG8_STAGE(PG8_SB(1, 0), cB + kstep, voffB); PG8_STAGE(PG8_SA(1, 0), cA + kstep, voffA); PG8_STAGE(PG8_SB(1, 1), cB + hstepB + kstep, voffB);
        PG8_WAIT_V(6); PG8_BAR;
    }
    for (;;) {
        const bool has_next = S.next(ui + 1, nxt);
        const char* nA = has_next ? PG8_UNIT_A(nxt) : cA;
        unsigned voffN[2] = {voffA[0], voffA[1]}; long hstepN = hstepA;
        if (Epi::WITH_LDS && has_next) { const bool nr = nxt.rev != 0; voffN[0] = nr ? voffAr[0] : voffAf[0]; voffN[1] = nr ? voffAr[1] : voffAf[1]; hstepN = nr ? -hstepAf : hstepAf; }
        const char* nB = has_next ? (const char*)g.Bt + ((size_t)nxt.pn * BM * g.ldb + nxt.kboff) * 2 : cB;
#pragma unroll 1
        for (int t = 0; t < nt; t += 2) {
            const bool last = (t == nt - 2);
            const char* a1 = cA + (size_t)(t + 1) * kstep;
            const char* a2 = last ? nA : cA + (size_t)(t + 2) * kstep; const char* b2 = last ? nB : cB + (size_t)(t + 2) * kstep;
            const char* a3 = a2 + kstep; const char* b3 = b2 + kstep;
            unsigned voff2[2] = {voffA[0], voffA[1]}; long hstep2 = hstepA;
            if (Epi::WITH_LDS && last) { voff2[0] = voffN[0]; voff2[1] = voffN[1]; hstep2 = hstepN; }
            if constexpr (SP2) {
            PG8_LDB(B0, 0, 0); PG8_LDB(B1, 0, 1); PG8_SCHED; PG8_LDA(At, 0, 0); PG8_STAGE(PG8_SA(1, 1), a1 + hstepA, voffA);
            PG8_WAIT_V(8); PG8_WAIT_L(0); PG8_BAR; PG8_MMA(0, 0, At, B0); PG8_MMA(0, 1, At, B1); PG8_BAR; PG8_SCHED;
            PG8_LDA(At, 0, 1); PG8_STAGE(PG8_SB(0, 0), b2, voffB); PG8_STAGE(PG8_SB(0, 1), b2 + hstepB, voffB); PG8_STAGE(PG8_SA(0, 0), a2, voff2);
            PG8_WAIT_V(8); PG8_WAIT_L(0); PG8_BAR; PG8_MMA(1, 0, At, B0); PG8_MMA(1, 1, At, B1); PG8_BAR; PG8_SCHED;
            PG8_LDB(B0, 1, 0); PG8_LDB(B1, 1, 1); PG8_SCHED; PG8_LDA(At, 1, 0); PG8_STAGE(PG8_SA(0, 1), a2 + hstep2, voff2);
            PG8_WAIT_V(8); PG8_WAIT_L(0); PG8_BAR; PG8_MMA(0, 0, At, B0); PG8_MMA(0, 1, At, B1); PG8_BAR; PG8_SCHED;
            PG8_LDA(At, 1, 1); PG8_STAGE(PG8_SB(1, 0), b3, voffB); PG8_STAGE(PG8_SB(1, 1), b3 + hstepB, voffB); PG8_STAGE(PG8_SA(1, 0), a3, voff2);
            PG8_WAIT_V(8); PG8_WAIT_L(0); PG8_BAR; PG8_MMA(1, 0, At, B0); PG8_MMA(1, 1, At, B1); PG8_BAR; PG8_SCHED;
            } else {
            PG8_LDB(B0, 0, 0); PG8_SCHED; PG8_LDA(At, 0, 0); PG8_STAGE(PG8_SA(1, 1), a1 + hstepA, voffA);
            PG8_WAIT_L(8); PG8_BAR; PG8_WAIT_L(0); PG8_MMA(0, 0, At, B0); PG8_BAR; PG8_SCHED;
            PG8_LDB(B1, 0, 1); PG8_STAGE(PG8_SB(0, 0), b2, voffB);
            PG8_BAR; PG8_WAIT_L(0); PG8_MMA(0, 1, At, B1); PG8_BAR;
            PG8_LDA(At, 0, 1); PG8_STAGE(PG8_SA(0, 0), a2, voff2);
            PG8_BAR; PG8_WAIT_L(0); PG8_MMA(1, 0, At, B0); PG8_BAR; PG8_SCHED;
            PG8_STAGE(PG8_SB(0, 1), b2 + hstepB, voffB);
            PG8_WAIT_V(6); PG8_BAR; PG8_MMA(1, 1, At, B1); PG8_BAR;
            PG8_LDB(B0, 1, 0); PG8_SCHED; PG8_LDA(At, 1, 0); PG8_STAGE(PG8_SA(0, 1), a2 + hstep2, voff2);
            PG8_WAIT_L(8); PG8_BAR; PG8_WAIT_L(0); PG8_MMA(0, 0, At, B0); PG8_BAR; PG8_SCHED;
            PG8_LDB(B1, 1, 1); PG8_STAGE(PG8_SB(1, 0), b3, voffB);
            PG8_BAR; PG8_WAIT_L(0); PG8_MMA(0, 1, At, B1); PG8_BAR;
            PG8_LDA(At, 1, 1); PG8_STAGE(PG8_SA(1, 0), a3, voff2);
            PG8_BAR; PG8_WAIT_L(0); PG8_MMA(1, 0, At, B0); PG8_BAR; PG8_SCHED;
            PG8_STAGE(PG8_SB(1, 1), b3 + hstepB, voffB);
            PG8_WAIT_V(6); PG8_BAR; PG8_MMA(1, 1, At, B1); PG8_BAR;
            }
        }
        if constexpr (ALIGN_EPI) { if (wr == 0) PG8_BAR; }
        if constexpr (Epi::WITH_LDS) E.run(acc, cur, wr, wc, lane, lds); else E(acc, cur, wr, wc, fr, fq);
        if (!has_next) break;
#pragma unroll
        for (int a = 0; a < 2; ++a)
#pragma unroll
            for (int b = 0; b < 2; ++b)
#pragma unroll
                for (int m = 0; m < 4; ++m)
#pragma unroll
                    for (int n = 0; n < 2; ++n) acc[a][b][m][n] = (f32x4){0.f, 0.f, 0.f, 0.f};
        cur = nxt; cA = nA; cB = nB; ++ui; voffA[0] = voffN[0]; voffA[1] = voffN[1]; hstepA = hstepN;
        if constexpr (ALIGN_EPI) { if (wr == 1) PG8_BAR; }
    }
    PG8_WAIT_V(0);
    if constexpr (!ALIGN_EPI) { if (wr == 0) PG8_BAR; }
    PG8_BAR;
#undef PG8_UNIT_A
#undef PG8_SA
#undef PG8_SB
#undef PG8_STAGE
#undef PG8_LDA
#undef PG8_LDB
#undef PG8_MMA
#undef PG8_WAIT_V
#undef PG8_WAIT_L
#undef PG8_BAR
#undef PG8_SCHED
}

template <int ACT> struct EpiPlain {
    static constexpr bool WITH_LDS = false;
    bf16_t* O; int ldc;
    __device__ __forceinline__ void operator()(const f32x4 (&acc)[2][2][4][2], const Unit& u, int wr, int wc, int fr_, int fq_) const {
        int fr = fr_, fq = fq_; asm volatile("" : "+v"(fr), "+v"(fq));
        const int col0 = u.pn * BM + wc * 32 + fq * 4;
#pragma unroll
        for (int ai = 0; ai < 2; ++ai)
#pragma unroll
            for (int m = 0; m < 4; ++m) { bf16_t* rowp = O + (size_t)(u.pm * BM + ai * HALF + wr * 64 + m * 16 + fr) * ldc + col0;
#pragma unroll
                for (int bj = 0; bj < 2; ++bj)
#pragma unroll
                    for (int n = 0; n < 2; ++n) { f32x4 v = acc[ai][bj][m][n];
                        if (ACT == 1) { v = __builtin_elementwise_max(v, (f32x4){0.f, 0.f, 0.f, 0.f}); v = v * v; }
                        *(u32x2*)(rowp + bj * HALF + n * 16) = f32_to_bf4(v); } }
    }
};

struct EpiSlabCtx {
    static constexpr bool WITH_LDS = false;
    bf16_t* S; int ksz;
    __device__ __forceinline__ void operator()(const f32x4 (&acc)[2][2][4][2], const Unit& u, int wr, int wc, int fr_, int fq_) const {
        int fr = fr_, fq = fq_; asm volatile("" : "+v"(fr), "+v"(fq));
        const int col0 = u.pn * BM + wc * 32 + fq * 4;
        bf16_t* base = S + (size_t)(u.koff / ksz) * MC * DM;
#pragma unroll
        for (int ai = 0; ai < 2; ++ai)
#pragma unroll
            for (int m = 0; m < 4; ++m) { bf16_t* rowp = base + (size_t)(u.pm * BM - ML + ai * HALF + wr * 64 + m * 16 + fr) * DM + col0;
#pragma unroll
                for (int bj = 0; bj < 2; ++bj)
#pragma unroll
                    for (int n = 0; n < 2; ++n) *(u32x2*)(rowp + bj * HALF + n * 16) = f32_to_bf4(acc[ai][bj][m][n]); }
    }
};

struct EpiQKV {
    static constexpr bool WITH_LDS = false;
    bf16_t* Q; bf16_t* Kb; bf16_t* VT; bf16_t* VTC; const float* rope;
    __device__ __forceinline__ void operator()(const f32x4 (&acc)[2][2][4][2], const Unit& u, int wr, int wc, int fr_, int fq_) const {
        int fr = fr_, fq = fq_; asm volatile("" : "+v"(fr), "+v"(fq));
        const bool lat = u.pm < 64;
        if (u.pn < 5) {
#pragma unroll
            for (int ai = 0; ai < 2; ++ai)
#pragma unroll
                for (int m = 0; m < 4; ++m) {
                    const int row = u.pm * BM + ai * HALF + wr * 64 + m * 16 + fr;
                    f32x4 cs0 = {1.f, 0.f, 1.f, 0.f}, cs1 = {1.f, 0.f, 1.f, 0.f};
                    if (lat) { const int t = row & 2047; const int pos = (wc & 1) ? (t & 63) : (t >> 6); const f32x4* pp = (const f32x4*)(rope + (pos * 16 + 4 * fq) * 2); cs0 = pp[0]; cs1 = pp[1]; }
                    const f32x4 cv = {cs0[0], cs0[2], cs1[0], cs1[2]}, sv = {cs0[1], cs0[3], cs1[1], cs1[3]};
#pragma unroll
                    for (int bj = 0; bj < 2; ++bj) {
                        const f32x4 a = acc[ai][bj][m][0], b = acc[ai][bj][m][1];
                        f32x4 na = a * cv - b * sv, nb = b * cv + a * sv;
                        if (u.pn < 4) { na = na * 0.125f; nb = nb * 0.125f;
                            bf16_t* d = Q + (size_t)row * 1024 + u.pn * 256 + bj * HALF + wc * 32 + fq * 4;
                            *(u32x2*)d = f32_to_bf4(na); *(u32x2*)(d + 16) = f32_to_bf4(nb);
                        } else {
                            bf16_t* d = Kb + (size_t)row * 256 + bj * HALF + wc * 32 + fq * 4;
                            *(u32x2*)d = f32_to_bf4(na); *(u32x2*)(d + 16) = f32_to_bf4(nb);
                        }
                    }
                }
        } else {
#pragma unroll
            for (int ai = 0; ai < 2; ++ai)
#pragma unroll
                for (int m = 0; m < 4; ++m) {
                    const int row = u.pm * BM + ai * HALF + wr * 64 + m * 16 + fr;
                    bf16_t* base; size_t stride;
                    if (lat) { const int b = row >> 11, t = row & 2047; base = VT + (size_t)b * 256 * 2048 + t; stride = 2048; }
                    else { const int rc = row - ML; const int b = rc >> 8, t = rc & 255; base = VTC + (size_t)b * 256 * 256 + t; stride = 256; }
#pragma unroll
                    for (int bj = 0; bj < 2; ++bj)
#pragma unroll
                        for (int n = 0; n < 2; ++n)
#pragma unroll
                            for (int j = 0; j < 4; ++j) { const int vc = bj * HALF + wc * 32 + n * 16 + fq * 4 + j; base[(size_t)vc * stride] = (bf16_t)f2bf(acc[ai][bj][m][n][j]); }
                }
        }
    }
};

struct EpiInProj {
    static constexpr bool WITH_LDS = false;
    bf16_t* R; bf16_t* GB;
    __device__ __forceinline__ void operator()(const f32x4 (&acc)[2][2][4][2], const Unit& u, int wr, int wc, int fr_, int fq_) const {
        int fr = fr_, fq = fq_; asm volatile("" : "+v"(fr), "+v"(fq));
        const bool rec = u.pn >= 5;
        const int col0 = (rec ? (u.pn - 5) * BM : 0) + wc * 32 + fq * 4; const int ldc = rec ? DRNN : 256; bf16_t* O = rec ? R : GB;
#pragma unroll
        for (int ai = 0; ai < 2; ++ai)
#pragma unroll
            for (int m = 0; m < 4; ++m) { bf16_t* rowp = O + (size_t)(u.pm * BM + ai * HALF + wr * 64 + m * 16 + fr) * ldc + col0;
#pragma unroll
                for (int bj = 0; bj < 2; ++bj)
#pragma unroll
                    for (int n = 0; n < 2; ++n) { f32x4 v = acc[ai][bj][m][n];
                        if (!rec) {
#pragma unroll
                            for (int j = 0; j < 4; ++j) { const float x = v[j]; v[j] = x * fsigmoid(1.5957691216057308f * (x + 0.044715f * x * x * x)); } }
                        *(u32x2*)(rowp + bj * HALF + n * 16) = f32_to_bf4(v); } }
    }
};

struct EpiGates {
    static constexpr bool WITH_LDS = false;
    const bf16_t* U; bf16_t* LA; bf16_t* BX; const float* ba; const float* bi; const float* nls;
    __device__ __forceinline__ void operator()(const f32x4 (&acc)[2][2][4][2], const Unit& u, int wr, int wc, int fr_, int fq_) const {
        int fr = fr_, fq = fq_; asm volatile("" : "+v"(fr), "+v"(fq));
        const int tile = u.pn >> 1, dir = tile / 5, blk = tile % 5, chalf = u.pn & 1;
        const int ch0 = blk * 256 + chalf * 128 + wc * 32 + fq * 4;
#pragma unroll
        for (int n = 0; n < 2; ++n) {
            const int ch = ch0 + n * 16;
            const f32x4 bav = *(const f32x4*)(ba + dir * DRNN + ch), biv = *(const f32x4*)(bi + dir * DRNN + ch), nl = *(const f32x4*)(nls + dir * DRNN + ch);
#pragma unroll
            for (int ai = 0; ai < 2; ++ai)
#pragma unroll
                for (int m = 0; m < 4; ++m) {
                    const int rin = ai * HALF + wr * 64 + m * 16 + fr;
                    const size_t rowg = (size_t)u.pm * BM + rin, rowl = (size_t)u.po * BM + rin;
                    const f32x4 uv = bf4_to_f32(*(const u32x2*)(U + rowg * DRNN + ch));
                    f32x4 lav, bxv;
#pragma unroll
                    for (int j = 0; j < 4; ++j) {
                        const float r = fsigmoid(acc[ai][0][m][n][j] + bav[j]);
                        const float ig = fsigmoid(acc[ai][1][m][n][j] + biv[j]);
                        const float la = nl[j] * r, x = 2.0f * la;
                        float om;
                        if (x > -0.5f) { float q = 1.0f / 720.0f; q = q * x + 1.0f / 120.0f; q = q * x + 1.0f / 24.0f; q = q * x + 1.0f / 6.0f; q = q * x + 0.5f; q = q * x + 1.0f; om = -x * q; }
                        else om = 1.0f - __expf(x);
                        lav[j] = la; bxv[j] = __builtin_amdgcn_sqrtf(om) * (ig * uv[j]);
                    }
                    const size_t o = ((size_t)dir * 9216 + rowl) * DRNN + ch;
                    *(u32x2*)(LA + o) = f32_to_bf4(lav); *(u32x2*)(BX + o) = f32_to_bf4(bxv);
                    asm volatile("" ::: "memory");
                }
        }
    }
};

#define SC_STEP(d) \
    "v_fmac_f32_dpp %1, %1, %0 row_shr:" #d " row_mask:0xf bank_mask:0xf\n\t" "v_mul_f32_dpp %0, %0, %0 row_shr:" #d " row_mask:0xf bank_mask:0xf\n\t" \
    "v_fmac_f32_dpp %3, %3, %2 row_shr:" #d " row_mask:0xf bank_mask:0xf\n\t" "v_mul_f32_dpp %2, %2, %2 row_shr:" #d " row_mask:0xf bank_mask:0xf\n\t" \
    "v_fmac_f32_dpp %5, %5, %4 row_shr:" #d " row_mask:0xf bank_mask:0xf\n\t" "v_mul_f32_dpp %4, %4, %4 row_shr:" #d " row_mask:0xf bank_mask:0xf\n\t" \
    "v_fmac_f32_dpp %7, %7, %6 row_shr:" #d " row_mask:0xf bank_mask:0xf\n\t" "v_mul_f32_dpp %6, %6, %6 row_shr:" #d " row_mask:0xf bank_mask:0xf\n\t"
__device__ __forceinline__ void scan16x4(float& a0, float& b0, float& a1, float& b1, float& a2, float& b2, float& a3, float& b3) {
    asm volatile("s_nop 1\n\t" SC_STEP(1) SC_STEP(2) SC_STEP(4) SC_STEP(8)
                 : "+v"(a0), "+v"(b0), "+v"(a1), "+v"(b1), "+v"(a2), "+v"(b2), "+v"(a3), "+v"(b3));
}
struct EpiGatesScan {
    static constexpr bool WITH_LDS = true;
    const bf16_t* U; bf16_t* RECF; bf16_t* RECB; const float* ba; const float* bi; const float* nls; unsigned long long* CARRY;
    __device__ __forceinline__ void run(f32x4 (&acc)[2][2][4][2], const Unit& u, int wr, int wc, int lane_, LAS unsigned char* lds) const {
        int lane = lane_; asm volatile("" : "+v"(lane));
        const int fr = lane & 15, fq = lane >> 4;
        const int tile = u.pn >> 1, dir = tile / 5, blk = tile % 5, chalf = u.pn & 1;
        const int ch0 = blk * 256 + chalf * 128 + wc * 32 + fq * 4;
        const int rmask = dir ? 255 : 0;
        bf16_t* REC = dir ? RECB : RECF;
#pragma unroll
        for (int n = 0; n < 2; ++n) {
            const int ch = ch0 + n * 16;
            const f32x4 bav2 = *(const f32x4*)(ba + dir * DRNN + ch) * (-LOG2E), biv2 = *(const f32x4*)(bi + dir * DRNN + ch) * (-LOG2E), nl = *(const f32x4*)(nls + dir * DRNN + ch);
            const f32x4 nl2 = nl * LOG2E, nlx = nl * 2.0f;
#pragma unroll
            for (int ai = 0; ai < 2; ++ai)
#pragma unroll
                for (int m = 0; m < 4; ++m) {
                    const size_t rowg = (size_t)u.pm * BM + ((ai * HALF + wr * 64 + m * 16 + fr) ^ rmask);
                    const f32x4 uv = bf4_to_f32(*(const u32x2*)(U + rowg * DRNN + ch));
                    float av[4], bv[4];
#pragma unroll
                    for (int j = 0; j < 4; ++j) {
                        const float r = __builtin_amdgcn_rcpf(1.0f + __builtin_amdgcn_exp2f(acc[ai][0][m][n][j] * (-LOG2E) + bav2[j]));
                        const float ig = __builtin_amdgcn_rcpf(1.0f + __builtin_amdgcn_exp2f(acc[ai][1][m][n][j] * (-LOG2E) + biv2[j]));
                        const float x = nlx[j] * r, a = __builtin_amdgcn_exp2f(nl2[j] * r);
                        const float om = (x > -0.0625f) ? -x * (1.0f + x * (0.5f + x * (1.0f / 6.0f + x * (1.0f / 24.0f)))) : 1.0f - a * a;
                        av[j] = a; bv[j] = __builtin_amdgcn_sqrtf(om) * (ig * uv[j]);
                    }
                    scan16x4(av[0], bv[0], av[1], bv[1], av[2], bv[2], av[3], bv[3]);
#pragma unroll
                    for (int j = 0; j < 4; ++j) { acc[ai][0][m][n][j] = av[j]; acc[ai][1][m][n][j] = bv[j]; }
                    __builtin_amdgcn_sched_barrier(0);
                }
        }
        LAS f32x2* segtot = (LAS f32x2*)(lds + 133120);
        LAS float* segcarry = (LAS float*)(lds + 137216);
#pragma unroll
        for (int ai = 0; ai < 2; ++ai)
#pragma unroll
            for (int n = 0; n < 2; ++n) {
                f32x4 As = acc[ai][0][0][n], Bs = acc[ai][1][0][n];
#pragma unroll
                for (int m = 1; m < 4; ++m) { Bs = acc[ai][0][m][n] * Bs + acc[ai][1][m][n]; As = acc[ai][0][m][n] * As; }
                if (fr == 15) {
#pragma unroll
                    for (int j = 0; j < 4; ++j) segtot[(2 * ai + wr) * 128 + wc * 32 + n * 16 + fq * 4 + j] = (f32x2){As[j], Bs[j]};
                }
            }
        asm volatile("s_waitcnt lgkmcnt(0)" ::: "memory"); __builtin_amdgcn_s_barrier(); asm volatile("" ::: "memory");
        const int tid_ = threadIdx.x;
        if (tid_ < 128) {
            float h = 0.0f;
            if (u.po > 0) { unsigned long long* gp = CARRY + (size_t)(u.lin - 160) * 128 + tid_; unsigned long long v; unsigned sp = 0;
                for (;;) { v = __hip_atomic_load(gp, __ATOMIC_RELAXED, __HIP_MEMORY_SCOPE_AGENT); if ((v >> 32) != 0ull) break; __builtin_amdgcn_s_sleep(1); if (++sp > (1u << 22)) break; }
                h = __uint_as_float((unsigned)v); }
#pragma unroll
            for (int sg = 0; sg < 4; ++sg) { segcarry[sg * 128 + tid_] = h; const f32x2 t = segtot[sg * 128 + tid_]; h = t[0] * h + t[1]; }
            if (u.po < 8) __hip_atomic_store(CARRY + (size_t)u.lin * 128 + tid_, (1ull << 32) | (unsigned long long)__float_as_uint(h), __ATOMIC_RELAXED, __HIP_MEMORY_SCOPE_AGENT);
        }
        asm volatile("s_waitcnt lgkmcnt(0)" ::: "memory"); __builtin_amdgcn_s_barrier(); asm volatile("" ::: "memory");
        const bool emit = u.pm < 64;
        const int lastl = (lane & 48) | 15;
        if (emit) {
#pragma unroll
            for (int ai = 0; ai < 2; ++ai) {
                f32x4 hg[2];
#pragma unroll
                for (int n = 0; n < 2; ++n) hg[n] = *(const LAS f32x4*)(segcarry + (2 * ai + wr) * 128 + wc * 32 + n * 16 + fq * 4);
#pragma unroll
                for (int m = 0; m < 4; ++m) {
                    f32x4 h[2];
#pragma unroll
                    for (int n = 0; n < 2; ++n) h[n] = acc[ai][0][m][n] * hg[n] + acc[ai][1][m][n];
                    bf16_t* rp = REC + ((size_t)u.pm * BM + ((ai * HALF + wr * 64 + m * 16 + fr) ^ rmask)) * DRNN + ch0;
#pragma unroll
                    for (int n = 0; n < 2; ++n) *(u32x2*)(rp + n * 16) = f32_to_bf4(h[n]);
                    if (m < 3) {
#pragma unroll
                        for (int n = 0; n < 2; ++n)
#pragma unroll
                            for (int j = 0; j < 4; ++j) hg[n][j] = __shfl(h[n][j], lastl);
                    }
                }
            }
        }
    }
};

struct EpiGateMul {
    static constexpr bool WITH_LDS = false;
    bf16_t* Z; const bf16_t* RB;
    __device__ __forceinline__ void operator()(const f32x4 (&acc)[2][2][4][2], const Unit& u, int wr, int wc, int fr_, int fq_) const {
        int fr = fr_, fq = fq_; asm volatile("" : "+v"(fr), "+v"(fq));
        const int col0 = u.pn * BM + wc * 32 + fq * 4;
#pragma unroll
        for (int ai = 0; ai < 2; ++ai)
#pragma unroll
            for (int m = 0; m < 4; ++m) { bf16_t* rowp = Z + (size_t)(u.pm * BM + ai * HALF + wr * 64 + m * 16 + fr) * DRNN + col0;
#pragma unroll
                for (int bj = 0; bj < 2; ++bj)
#pragma unroll
                    for (int n = 0; n < 2; ++n) { const f32x4 v = acc[ai][bj][m][n]; const f32x4 rc = bf4_to_f32(*(const u32x2*)(rowp + bj * HALF + n * 16)) + bf4_to_f32(*(const u32x2*)(RB + (rowp - Z) + bj * HALF + n * 16)); f32x4 o;
#pragma unroll
                        for (int j = 0; j < 4; ++j) { const float x = v[j]; const float z2 = 1.5957691216057308f * (x + 0.044715f * x * x * x); o[j] = x * fsigmoid(z2) * rc[j]; }
                        *(u32x2*)(rowp + bj * HALF + n * 16) = f32_to_bf4(o); }
                asm volatile("" ::: "memory"); }
    }
};
}


#define XB_TMO      128
#define XB_XCNT(j)  (256  + 64 * (j))
#define XB_XSUB(j)  (1280 + 64 * (j))
#define XB_XGEN(j)  (2304 + 64 * (j))
#define XB_TOP      3328
#define XB_TOPGEN   3392
#define XCD_BAR_WORDS 3456
#define XB_SPIN_CAP (1u << 18)
__device__ __forceinline__ unsigned xb_ld(unsigned* p)              { return __hip_atomic_load(p, __ATOMIC_RELAXED, __HIP_MEMORY_SCOPE_AGENT); }
__device__ __forceinline__ unsigned xb_add(unsigned* p, unsigned v) { return __hip_atomic_fetch_add(p, v, __ATOMIC_RELAXED, __HIP_MEMORY_SCOPE_AGENT); }
__device__ __forceinline__ unsigned xb_xcc_id() { return (unsigned)__builtin_amdgcn_s_getreg((3 << 11) | 20) & 0xFu; }
#define XB_SPIN(cond, bar) do { unsigned _sp = 0; while (cond) { __builtin_amdgcn_s_sleep(1); \
    if ((++_sp & 255u) == 0u) { if (xb_ld(&(bar)[XB_TMO])) break; if (_sp > XB_SPIN_CAP) { atomicAdd(&(bar)[XB_TMO], 1u); break; } } } } while (0)
struct XcdBarrier { unsigned* bar; unsigned x; volatile LAS unsigned* st; };
__device__ __forceinline__ XcdBarrier xcd_barrier_post(unsigned* bar, volatile LAS unsigned* st) {
    XcdBarrier b; b.bar = bar; b.x = xb_xcc_id(); b.st = st;
    if (threadIdx.x == 0) (void)xb_add(&bar[XB_XCNT(b.x)], 1u);
    return b;
}
__device__ __forceinline__ void xcd_barrier_complete(unsigned* bar, unsigned x, unsigned& nloc, unsigned& nx) {
    const unsigned G = gridDim.x * gridDim.y * gridDim.z;
    unsigned sum, cnt, mine, sp = 0u;
    for (;;) {
        sum = 0u; cnt = 0u; mine = 0u;
#pragma unroll
        for (unsigned j = 0; j < 16; ++j) { const unsigned c = xb_ld(&bar[XB_XCNT(j)]); sum += c; cnt += (c > 0u) ? 1u : 0u; mine = (j == x) ? c : mine; }
        if (sum == G) break;
        __builtin_amdgcn_s_sleep(1);
        if ((++sp & 255u) == 0u) { if (xb_ld(&bar[XB_TMO])) break; if (sp > XB_SPIN_CAP) { atomicAdd(&bar[XB_TMO], 1u); break; } }
    }
    nloc = mine > 0u ? mine : 1u; nx = cnt > 0u ? cnt : 1u;
}
__device__ __forceinline__ void xcd_barrier(const XcdBarrier& b) {
    asm volatile("s_waitcnt vmcnt(0)" ::: "memory");
    __syncthreads();
    if (threadIdx.x == 0) {
        unsigned* bar = b.bar;
        __builtin_amdgcn_s_waitcnt(0);
        unsigned nloc = b.st[0], nx = b.st[1];
        if (nloc == 0u) { xcd_barrier_complete(bar, b.x, nloc, nx); b.st[0] = nloc; b.st[1] = nx; }
        const unsigned old = xb_add(&bar[XB_XSUB(b.x)], 1u);
        const unsigned gen = old / nloc;
        if (old + 1u == (gen + 1u) * nloc) {
            __builtin_amdgcn_fence(__ATOMIC_RELEASE, "agent");
            asm volatile("s_waitcnt vmcnt(0)" ::: "memory");
            const unsigned og = xb_add(&bar[XB_TOP], 1u);
            const unsigned tg = og / nx;
            if (og + 1u == (tg + 1u) * nx) xb_add(&bar[XB_TOPGEN], 1u);
            else XB_SPIN(xb_ld(&bar[XB_TOPGEN]) == tg, bar);
            __builtin_amdgcn_fence(__ATOMIC_ACQUIRE, "agent");
            xb_add(&bar[XB_XGEN(b.x)], 1u);
            asm volatile("s_waitcnt vmcnt(0)" ::: "memory");
        } else {
            XB_SPIN(xb_ld(&bar[XB_XGEN(b.x)]) == gen, bar);
            __builtin_amdgcn_fence(__ATOMIC_ACQUIRE, "agent");
            asm volatile("s_waitcnt vmcnt(0)" ::: "memory");
        }
    }
    __syncthreads();
}

struct Params {
    const float *x, *c, *ctx, *c_ctx, *ada_w, *ada_b, *norm_g, *mlp_w1, *mlp_w2, *w_qkv, *w_o, *sink;
    const float *w_in, *conv_w, *conv_b, *w_a, *b_a, *w_i, *b_i, *lam, *w_out;
    float* out; unsigned char* ws;
};

typedef const __attribute__((address_space(4))) Params* ParamsK;
__device__ __forceinline__ void transpose_item(const float* W, int ldw, bf16_t* WT, int ldwt, int k0, int n0, int dst_row0, LAS float* scr, int lane) {
#pragma unroll 8
    for (int i = 0; i < 32; ++i) { const int kk = 2 * i + (lane >> 5); scr[kk * 33 + (lane & 31)] = W[(size_t)(k0 + kk) * ldw + n0 + (lane & 31)]; }
    asm volatile("s_waitcnt lgkmcnt(0)" ::: "memory");
    const int c = lane & 7;
#pragma unroll
    for (int j = 0; j < 4; ++j) { const int n = (lane >> 3) + 8 * j; const LAS float* s = scr + (8 * c) * 33 + n;
        u32x4 o; o.x = cvt_pk_bf16(s[0 * 33], s[1 * 33]); o.y = cvt_pk_bf16(s[2 * 33], s[3 * 33]); o.z = cvt_pk_bf16(s[4 * 33], s[5 * 33]); o.w = cvt_pk_bf16(s[6 * 33], s[7 * 33]);
        *(u32x4*)(WT + (size_t)(dst_row0 + n) * ldwt + k0 + 8 * c) = o; }
    asm volatile("s_waitcnt lgkmcnt(0)" ::: "memory");
}
__device__ __forceinline__ void transpose_plain(const float* W, int K, int N, bf16_t* WT, int r, LAS float* scr, int lane) {
    const int nblk = N / 32, kb = r / nblk, nb = r % nblk;
    transpose_item(W, N, WT, K, 64 * kb, 32 * nb, 32 * nb, scr, lane);
}

constexpr int I_QKV = 16 * 48, I_O = 16 * 32, I_1 = 16 * 128, I_2 = 64 * 32, I_IN = 16 * 80, I_OUT = 20 * 32, I_G = 40 * 16;
constexpr int TR_L0 = I_QKV + I_O + I_1 + I_2, TR_LRU = I_IN + I_OUT + I_G, TR_MLP1 = I_1 + I_2;
struct TrItem { const float* W; bf16_t* WT; int ldw, ldwt, k0, n0, drow; };
__device__ __forceinline__ TrItem tr_decode(ParamsK p, unsigned char* ws, int it) {
    TrItem d; int r = it;
#define TR_PLAIN(Wp, K_, N_, WTp) do { const int nblk_ = (N_) / 32, kb_ = r / nblk_, nb_ = r % nblk_; d.W = (Wp); d.WT = (WTp); d.ldw = (N_); d.ldwt = (K_); d.k0 = 64 * kb_; d.n0 = 32 * nb_; d.drow = 32 * nb_; return d; } while (0)
    if (r < I_QKV) TR_PLAIN(p->w_qkv, 1024, NQKV, (bf16_t*)(ws + WS_WQKV)); r -= I_QKV;
    if (r < I_O) TR_PLAIN(p->w_o, 1024, 1024, (bf16_t*)(ws + WS_WO)); r -= I_O;
    if (r < I_1) TR_PLAIN(p->mlp_w1, 1024, DFF, (bf16_t*)(ws + WS_W1)); r -= I_1;
    if (r < I_2) TR_PLAIN(p->mlp_w2, DFF, 1024, (bf16_t*)(ws + WS_W2)); r -= I_2;
    if (r < I_IN) TR_PLAIN(p->w_in, 1024, 2 * DRNN, (bf16_t*)(ws + WS_WIN)); r -= I_IN;
    if (r < I_OUT) TR_PLAIN(p->w_out, DRNN, 1024, (bf16_t*)(ws + WS_WOUT)); r -= I_OUT;
    if (r < I_G) {
        const int sm = r >> 4, ii = r & 15, kb = ii >> 2, nb = ii & 3;
        const int chalf = sm & 1, blk = (sm >> 1) % 5, dg = (sm >> 1) / 5, gate = dg & 1, dir = dg >> 1;
        d.W = (gate ? p->w_i : p->w_a) + (size_t)(dir * 5 + blk) * 256 * 256; d.WT = (bf16_t*)(ws + WS_WG); d.ldw = 256; d.ldwt = 256;
        d.k0 = 64 * kb; d.n0 = chalf * 128 + nb * 32; d.drow = ((dir * 5 + blk) * 2 + chalf) * 256 + gate * 128 + nb * 32; return d; }
    r -= I_G;
    if (r < I_1) TR_PLAIN(p->mlp_w1 + (size_t)1024 * DFF, 1024, DFF, (bf16_t*)(ws + WS_W1 + 16 * MiB)); r -= I_1;
    TR_PLAIN(p->mlp_w2 + (size_t)1024 * DFF, DFF, 1024, (bf16_t*)(ws + WS_W2 + 16 * MiB));
#undef TR_PLAIN
}
__device__ __forceinline__ void transpose_range(ParamsK p, unsigned char* ws, LAS unsigned char* lds, int first, int count, int w, int nw, int wave, int lane) {
    LAS float* scr = (LAS float*)(lds + wave * 16384);
    int it = first + w; if (it >= first + count) return;
    float cur[32], nxt[32];
    TrItem d = tr_decode(p, ws, it);
#pragma unroll
    for (int i = 0; i < 32; ++i) cur[i] = d.W[(size_t)(d.k0 + 2 * i + (lane >> 5)) * d.ldw + d.n0 + (lane & 31)];
    for (;;) {
        const int itn = it + nw; const bool more = itn < first + count;
        TrItem dn = d;
        if (more) { dn = tr_decode(p, ws, itn);
#pragma unroll
            for (int i = 0; i < 32; ++i) nxt[i] = dn.W[(size_t)(dn.k0 + 2 * i + (lane >> 5)) * dn.ldw + dn.n0 + (lane & 31)]; }
#pragma unroll
        for (int i = 0; i < 32; ++i) scr[(2 * i + (lane >> 5)) * 33 + (lane & 31)] = cur[i];
        asm volatile("s_waitcnt lgkmcnt(0)" ::: "memory");
        const int c = lane & 7;
#pragma unroll
        for (int j = 0; j < 4; ++j) { const int n = (lane >> 3) + 8 * j; const LAS float* s = scr + (8 * c) * 33 + n;
            u32x4 o; o.x = cvt_pk_bf16(s[0 * 33], s[1 * 33]); o.y = cvt_pk_bf16(s[2 * 33], s[3 * 33]); o.z = cvt_pk_bf16(s[4 * 33], s[5 * 33]); o.w = cvt_pk_bf16(s[6 * 33], s[7 * 33]);
            *(u32x4*)(d.WT + (size_t)(d.drow + n) * d.ldwt + d.k0 + 8 * c) = o; }
        asm volatile("s_waitcnt lgkmcnt(0)" ::: "memory");
        if (!more) break;
#pragma unroll
        for (int i = 0; i < 32; ++i) cur[i] = nxt[i];
        d = dn; it = itn;
    }
}
__device__ __forceinline__ void idle_transposes(ParamsK p, unsigned char* ws, LAS unsigned char* lds, int first, int count, int nwg, int G, int bid, int wave, int lane) {
    const int rem = nwg % G;
    if (rem == 0) transpose_range(p, ws, lds, first, count, bid * 8 + wave, G * 8, wave, lane);
    else if (bid >= rem) transpose_range(p, ws, lds, first, count, (bid - rem) * 8 + wave, (G - rem) * 8, wave, lane);
    __syncthreads();
}

__device__ __forceinline__ void prologue(ParamsK p, LAS unsigned char* lds, int tid, int lane, int wave) {
    unsigned char* ws = p->ws;
    float* MOD = (float*)(ws + WS_MOD);
    if (blockIdx.x < 192) {
        LAS float* sl = (LAS float*)lds;
        LAS float* red = (LAS float*)(lds + 36864);
        for (int idx = tid; idx < 9216; idx += 512) { const int w = idx >> 10, k = idx & 1023; const float v = (w < 8) ? p->c[w * 1024 + k] : p->c_ctx[k]; sl[idx] = v / (1.0f + __expf(-v)); }
        __syncthreads();
        const int l = blockIdx.x / 96, n0 = (blockIdx.x % 96) * 64, kg = tid >> 4, cq = tid & 15;
        f32x4 acc[9];
#pragma unroll
        for (int w = 0; w < 9; ++w) acc[w] = (f32x4){0.f, 0.f, 0.f, 0.f};
        const float* wb = p->ada_w + (size_t)l * 1024 * 6144 + n0 + cq * 4;
#pragma unroll 1
        for (int it0 = 0; it0 < 32; it0 += 8) {
            f32x4 w4[8];
#pragma unroll
            for (int u = 0; u < 8; ++u) w4[u] = *(const f32x4*)(wb + (size_t)((it0 + u) * 32 + kg) * 6144);
#pragma unroll
            for (int u = 0; u < 8; ++u) { const int k = (it0 + u) * 32 + kg;
#pragma unroll
                for (int w = 0; w < 9; ++w) acc[w] += sl[w * 1024 + k] * w4[u]; }
        }
#pragma unroll
        for (int w = 0; w < 9; ++w) *(LAS f32x4*)(red + (kg * 9 + w) * 64 + cq * 4) = acc[w];
        __syncthreads();
        for (int idx = tid; idx < 9 * 64; idx += 512) { const int w = idx >> 6, n = idx & 63; float s = 0.f;
#pragma unroll
            for (int g = 0; g < 32; ++g) s += red[(g * 9 + w) * 64 + n];
            MOD[(size_t)(l * 9 + w) * 6144 + n0 + n] = s + p->ada_b[l * 6144 + n0 + n]; }
        __syncthreads();
    }
    if (blockIdx.x == gridDim.x - 1) {
        float* rope = (float*)(ws + WS_ROPE); float* nls = (float*)(ws + WS_NLS);
        for (int idx = tid; idx < 1024; idx += 512) { const int pos = idx >> 4, i = idx & 15;
            const float inv = __builtin_exp2f(-(float)i * (13.287712379549449f / 16.0f));
            const float angf = (float)pos * inv; const double ang = (double)angf;
            const double twopi = 6.283185307179586476925287; const double r = ang - twopi * __builtin_rint(ang / twopi);
            const double r2 = r * r; double cterm = 1.0, sterm = r, cs = 1.0, sn = r;
            for (int k = 1; k <= 14; ++k) { cterm *= -r2 / (double)((2 * k - 1) * (2 * k)); sterm *= -r2 / (double)((2 * k) * (2 * k + 1)); cs += cterm; sn += sterm; }
            rope[idx * 2] = (float)cs; rope[idx * 2 + 1] = (float)sn; }
        for (int idx = tid; idx < 2 * DRNN; idx += 512) { const float lm = p->lam[idx]; nls[idx] = -8.0f * log1pf(__expf(-lm)); }
        { unsigned* fl = (unsigned*)(ws + WS_FLAG); for (int idx = tid; idx < 1440 * 16; idx += 512) fl[idx] = 0u; }
    }
    transpose_range(p, ws, lds, 0, TR_L0 + TR_LRU + TR_MLP1, blockIdx.x * 8 + wave, gridDim.x * 8, wave, lane);
}

template <bool HAS_Y, bool HAS_H, bool XIN_BF, bool XOUT_BF>
__device__ __forceinline__ void row_phase(const void* xin_lat, const void* xin_ctx, void* xout_lat, void* xout_ctx, const bf16_t* Y, const bf16_t* SLAB, bf16_t* H,
                                          const float* gy, const float* gh, const float* mod_g, int gate_idx, const float* mod_h, int shift_idx, int scale_idx,
                                          int nrows, int gw, int ngw, int lane) {
    const int rpw = (nrows + ngw - 1) / ngw, r_begin = gw * rpw, r_end = (r_begin + rpw < nrows) ? r_begin + rpw : nrows;
    f32x4 xn[4]; u32x2 xb[4], yn[4], ys[3][4];
    f32x4 vgy[4], vgh[4], vgt[4], vsh[4], vsc[4];
#pragma unroll
    for (int j = 0; j < 4; ++j) { if (HAS_Y) vgy[j] = *(const f32x4*)(gy + lane * 4 + 256 * j); if (HAS_H) vgh[j] = *(const f32x4*)(gh + lane * 4 + 256 * j); }
    int cur_who = -1;
#define ROW_LOAD(r) do { const int r_ = (r); const bool lat_ = r_ < ML; const size_t ro_ = lat_ ? (size_t)r_ * DM : (size_t)(r_ - ML) * DM; \
        if (XIN_BF) { const bf16_t* xi_ = (const bf16_t*)(lat_ ? xin_lat : xin_ctx) + ro_; _Pragma("unroll") for (int j = 0; j < 4; ++j) xb[j] = *(const u32x2*)(xi_ + lane * 4 + 256 * j); } \
        else { const float* xi_ = (const float*)(lat_ ? xin_lat : xin_ctx) + ro_; _Pragma("unroll") for (int j = 0; j < 4; ++j) xn[j] = *(const f32x4*)(xi_ + lane * 4 + 256 * j); } \
        if (HAS_Y) { if (SLAB != nullptr && !lat_) { const bf16_t* yp_ = SLAB + (size_t)(r_ - ML) * DM + lane * 4; \
                _Pragma("unroll") for (int j = 0; j < 4; ++j) { yn[j] = *(const u32x2*)(yp_ + 256 * j); ys[0][j] = *(const u32x2*)(yp_ + 256 * j + (size_t)MC * DM); ys[1][j] = *(const u32x2*)(yp_ + 256 * j + (size_t)2 * MC * DM); ys[2][j] = *(const u32x2*)(yp_ + 256 * j + (size_t)3 * MC * DM); } } \
            else { _Pragma("unroll") for (int j = 0; j < 4; ++j) yn[j] = *(const u32x2*)(Y + (size_t)r_ * DM + lane * 4 + 256 * j); } } } while (0)
    if (r_begin < r_end) ROW_LOAD(r_begin);
    for (int row = r_begin; row < r_end; ++row) {
        const bool lat = row < ML; const int who = lat ? (row >> 11) : 8;
        if (who != cur_who) { cur_who = who;
#pragma unroll
            for (int j = 0; j < 4; ++j) { const int col = lane * 4 + 256 * j;
                if (HAS_Y) vgt[j] = *(const f32x4*)(mod_g + (size_t)who * 6144 + gate_idx * 1024 + col);
                if (HAS_H) { vsh[j] = *(const f32x4*)(mod_h + (size_t)who * 6144 + shift_idx * 1024 + col); vsc[j] = *(const f32x4*)(mod_h + (size_t)who * 6144 + scale_idx * 1024 + col) + 1.0f; } } }
        f32x4 xv[4], yv[4];
#pragma unroll
        for (int j = 0; j < 4; ++j) xv[j] = XIN_BF ? bf4_to_f32(xb[j]) : xn[j];
        if (HAS_Y) {
#pragma unroll
            for (int j = 0; j < 4; ++j) { yv[j] = bf4_to_f32(yn[j]);
                if (SLAB != nullptr && !lat) yv[j] = (yv[j] + bf4_to_f32(ys[0][j])) + (bf4_to_f32(ys[1][j]) + bf4_to_f32(ys[2][j])); }
        }
        asm volatile("" ::: "memory");
        if (row + 1 < r_end) ROW_LOAD(row + 1);
        if (HAS_Y) {
            float s = 0.f;
#pragma unroll
            for (int j = 0; j < 4; ++j) s += (yv[j][0] * yv[j][0] + yv[j][1] * yv[j][1]) + (yv[j][2] * yv[j][2] + yv[j][3] * yv[j][3]);
            const float rstd = 1.0f / sqrtf(wave_sum(s) * (1.0f / DM) + EPS);
            const size_t ro = lat ? (size_t)row * DM : (size_t)(row - ML) * DM;
#pragma unroll
            for (int j = 0; j < 4; ++j) { xv[j] = xv[j] + vgt[j] * (yv[j] * rstd * vgy[j]);
                if (XOUT_BF) { const u32x2 w = f32_to_bf4(xv[j]); *(u32x2*)((bf16_t*)(lat ? xout_lat : xout_ctx) + ro + lane * 4 + 256 * j) = w; xv[j] = bf4_to_f32(w); }
                else *(f32x4*)((float*)(lat ? xout_lat : xout_ctx) + ro + lane * 4 + 256 * j) = xv[j]; }
        }
        if (HAS_H) {
            float s = 0.f;
#pragma unroll
            for (int j = 0; j < 4; ++j) s += (xv[j][0] * xv[j][0] + xv[j][1] * xv[j][1]) + (xv[j][2] * xv[j][2] + xv[j][3] * xv[j][3]);
            const float rstd = 1.0f / sqrtf(wave_sum(s) * (1.0f / DM) + EPS);
#pragma unroll
            for (int j = 0; j < 4; ++j) { const f32x4 hv = (xv[j] * rstd * vgh[j]) * vsc[j] + vsh[j]; *(u32x2*)(H + (size_t)row * DM + lane * 4 + 256 * j) = f32_to_bf4(hv); }
        }
    }
#undef ROW_LOAD
}

__device__ __forceinline__ void attn_phase(LAS unsigned char* lds, const bf16_t* Q, bf16_t* O, const bf16_t* Kb, const bf16_t* VT, const bf16_t* VTC, const float* sink, int tid, int lane, int wave) {
    constexpr int PITCH = 72;
    LAS bf16_t* Ks = (LAS bf16_t*)lds;
    LAS bf16_t* Vs = (LAS bf16_t*)(lds + 2 * 64 * PITCH * 2);
    const int lr = lane & 15, lg = lane >> 4;
    const int skey = tid >> 3, spiece = tid & 7;
    for (int unit = blockIdx.x; unit < 576; unit += gridDim.x) {
        int b, kvh, qrow0, qblk, nloc, lt0; bool latu = unit < 512;
        if (latu) { b = unit >> 6; const int rem = unit & 63; qblk = rem >> 2; kvh = rem & 3; qrow0 = b * SEQ + qblk * 128; lt0 = (qblk == 0) ? 2 : 0; nloc = ((qblk == 15) ? 4 : 6) - lt0; }
        else { const int cu = unit - 512; b = cu >> 3; kvh = (cu & 7) >> 1; qblk = 0; qrow0 = ML + b * CTX + (cu & 1) * 128; lt0 = 0; nloc = 0; }
        const int nlo = (latu && qblk > 0) ? 2 : 0, nmid = latu ? 2 : 0, nup = (latu && qblk < 15) ? 2 : 0;
        const int n1 = nlo, n2 = nlo + nmid, n3 = n2 + 4, nT = n3 + nup; (void)nloc; (void)lt0;
        const int head = kvh * 4 + (wave >> 1);
        const int qr0 = qrow0 + (wave & 1) * 64;
        const bf16_t* qbase = Q + (size_t)qr0 * 1024 + head * 64;
        bf16_t* obase = O + (size_t)qr0 * 1024 + head * 64;
        LAS unsigned char* Qs = lds + 40960 + wave * 8192;
#pragma unroll
        for (int qt = 0; qt < 4; ++qt)
#pragma unroll
            for (int dh = 0; dh < 2; ++dh) *(LAS bf16x8*)(Qs + (qt * 2 + dh) * 1024 + lane * 16) = *(const bf16x8*)(qbase + (unsigned)((qt * 16 + lr) * 1024 + dh * 32 + lg * 8));
        f32x4 o[4][4];
#pragma unroll
        for (int qt = 0; qt < 4; ++qt)
#pragma unroll
            for (int dt = 0; dt < 4; ++dt) o[qt][dt] = (f32x4){0.f, 0.f, 0.f, 0.f};
        float m2[4], ls[4];
        { const float sk = sink[head] * LOG2E;
#pragma unroll
          for (int qt = 0; qt < 4; ++qt) { m2[qt] = sk; ls[qt] = (lg == 0) ? 1.0f : 0.0f; } }
        u32x4 kreg, vreg;
#define ATT_TOK0(j_) ((qblk - 1) * 128 + (((j_) < n1) ? (j_) : (((j_) < n2) ? 2 + (j_) - n1 : 4 + (j_) - n3)) * 64)
#define ATT_LOAD(j) do { const int _j = (j); if (_j < n2 || _j >= n3) { const int tok0 = ATT_TOK0(_j); \
                const bf16_t* kb_ = Kb + (size_t)(b * SEQ + tok0) * 256 + kvh * 64; const bf16_t* vb_ = VT + (size_t)(b * 4 + kvh) * 64 * SEQ + tok0; \
                kreg = *(const u32x4*)(kb_ + (unsigned)(skey * 256 + spiece * 8)); vreg = *(const u32x4*)(vb_ + (unsigned)(skey * SEQ + spiece * 8)); } \
            else { const int tok0 = (_j - n2) * 64; \
                const bf16_t* kb_ = Kb + (size_t)(ML + b * CTX + tok0) * 256 + kvh * 64; const bf16_t* vb_ = VTC + (size_t)(b * 4 + kvh) * 64 * CTX + tok0; \
                kreg = *(const u32x4*)(kb_ + (unsigned)(skey * 256 + spiece * 8)); vreg = *(const u32x4*)(vb_ + (unsigned)(skey * CTX + spiece * 8)); } } while (0)
#define ATT_STORE(buf) do { *(LAS u32x4*)(Ks + (buf) * 64 * PITCH + skey * PITCH + spiece * 8) = kreg; *(LAS u32x4*)(Vs + (buf) * 64 * PITCH + skey * PITCH + spiece * 8) = vreg; } while (0)
        __syncthreads();
        ATT_LOAD(0); ATT_STORE(0);
        __syncthreads();
#define ATT_BODY(MM) { \
            const int buf = j & 1; \
            if (j + 1 < nT) ATT_LOAD(j + 1); \
            const LAS bf16_t* Kt = Ks + buf * 64 * PITCH; const LAS bf16_t* Vt = Vs + buf * 64 * PITCH; \
            const int ktok0 = ATT_TOK0(j); \
            bf16x8 kf[4][2]; \
            _Pragma("unroll") \
            for (int ks = 0; ks < 4; ++ks) \
            _Pragma("unroll") \
                for (int dh = 0; dh < 2; ++dh) kf[ks][dh] = *(const LAS bf16x8*)(Kt + (ks * 16 + lr) * PITCH + dh * 32 + lg * 8); \
            _Pragma("unroll") \
            for (int hq = 0; hq < 2; ++hq) { \
            bf16x8 pb[2][2]; \
            _Pragma("unroll") \
            for (int q2 = 0; q2 < 2; ++q2) { \
                const int qt = hq * 2 + q2; \
                f32x4 s[4]; \
                const bf16x8 qf0 = *(const LAS bf16x8*)(Qs + (qt * 2 + 0) * 1024 + lane * 16), qf1 = *(const LAS bf16x8*)(Qs + (qt * 2 + 1) * 1024 + lane * 16); \
            _Pragma("unroll") \
                for (int ks = 0; ks < 4; ++ks) { s[ks] = __builtin_amdgcn_mfma_f32_16x16x32_bf16(kf[ks][0], qf0, (f32x4){0.f, 0.f, 0.f, 0.f}, 0, 0, 0); \
                    s[ks] = __builtin_amdgcn_mfma_f32_16x16x32_bf16(kf[ks][1], qf1, s[ks], 0, 0, 0); } \
                if (MM == 1) {    \
                    const int lim = qblk * 128 + (wave & 1) * 64 + qt * 16 + lr - 128 - ktok0 - lg * 4; \
            _Pragma("unroll") \
                    for (int ks = 0; ks < 4; ++ks) \
            _Pragma("unroll") \
                        for (int jj = 0; jj < 4; ++jj) s[ks][jj] = (ks * 16 + jj >= lim) ? s[ks][jj] : -1e30f; \
                } else if (MM == 2) {    \
                    const int lim = qblk * 128 + (wave & 1) * 64 + qt * 16 + lr + 128 - ktok0 - lg * 4; \
            _Pragma("unroll") \
                    for (int ks = 0; ks < 4; ++ks) \
            _Pragma("unroll") \
                        for (int jj = 0; jj < 4; ++jj) s[ks][jj] = (ks * 16 + jj <= lim) ? s[ks][jj] : -1e30f; \
                } \
                float mx = -3e38f; \
            _Pragma("unroll") \
                for (int ks = 0; ks < 4; ++ks) mx = fmaxf(mx, fmaxf(fmaxf(s[ks][0], s[ks][1]), fmaxf(s[ks][2], s[ks][3]))); \
                mx = fmaxf(mx, __shfl_xor(mx, 16)); mx = fmaxf(mx, __shfl_xor(mx, 32)); \
                const float mnew = fmaxf(m2[qt], mx * LOG2E); \
                const float alpha = __builtin_amdgcn_exp2f(m2[qt] - mnew); \
                m2[qt] = mnew; \
                float rs = 0.f; \
            _Pragma("unroll") \
                for (int ks = 0; ks < 4; ++ks) \
            _Pragma("unroll") \
                    for (int jj = 0; jj < 4; ++jj) { const float pv = __builtin_amdgcn_exp2f(s[ks][jj] * LOG2E - mnew); s[ks][jj] = pv; rs += pv; } \
                ls[qt] = ls[qt] * alpha + rs; \
            _Pragma("unroll") \
                for (int dt = 0; dt < 4; ++dt) o[qt][dt] = o[qt][dt] * alpha; \
            _Pragma("unroll") \
                for (int c2 = 0; c2 < 2; ++c2) { u32x4 w; w.x = cvt_pk_bf16(s[2 * c2][0], s[2 * c2][1]); w.y = cvt_pk_bf16(s[2 * c2][2], s[2 * c2][3]); w.z = cvt_pk_bf16(s[2 * c2 + 1][0], s[2 * c2 + 1][1]); w.w = cvt_pk_bf16(s[2 * c2 + 1][2], s[2 * c2 + 1][3]); \
                    pb[q2][c2] = __builtin_bit_cast(bf16x8, w); } \
            } \
            _Pragma("unroll") \
            for (int c2 = 0; c2 < 2; ++c2) \
            _Pragma("unroll") \
                for (int dt = 0; dt < 4; ++dt) { \
                    const LAS bf16_t* vp = Vt + (dt * 16 + lr) * PITCH + c2 * 32 + lg * 4; \
                    const u32x2 v0 = *(const LAS u32x2*)vp, v1 = *(const LAS u32x2*)(vp + 16); \
                    const u32x4 vv = {v0.x, v0.y, v1.x, v1.y}; \
                    const bf16x8 vf = __builtin_bit_cast(bf16x8, vv); \
            _Pragma("unroll") \
                    for (int q2 = 0; q2 < 2; ++q2) o[hq * 2 + q2][dt] = __builtin_amdgcn_mfma_f32_16x16x32_bf16(vf, pb[q2][c2], o[hq * 2 + q2][dt], 0, 0, 0); \
                } \
            } \
            if (j + 1 < nT) ATT_STORE(buf ^ 1); \
            __syncthreads(); \
        }
        int j = 0;
#pragma unroll 1
        for (; j < n1; ++j) ATT_BODY(1)
#pragma unroll 1
        for (; j < n3; ++j) ATT_BODY(0)
#pragma unroll 1
        for (; j < nT; ++j) ATT_BODY(2)
#undef ATT_BODY
#pragma unroll
        for (int qt = 0; qt < 4; ++qt) {
            float l = ls[qt]; l += __shfl_xor(l, 16); l += __shfl_xor(l, 32);
            const float inv = 1.0f / l;
            int lro = lr * 1024 + lg * 4; asm volatile("" : "+v"(lro));
            bf16_t* op = obase + (unsigned)(qt * 16 * 1024 + lro);
#pragma unroll
            for (int dt = 0; dt < 4; ++dt) *(u32x2*)(op + dt * 16) = f32_to_bf4(o[qt][dt] * inv);
        }
    }
#undef ATT_LOAD
#undef ATT_TOK0
#undef ATT_STORE
}

__device__ __forceinline__ void conv_phase(const bf16_t* R, bf16_t* U, const float* cw, const float* cb, int gtid, int nthreads) {
    for (int idx = gtid; idx < MT * 160; idx += nthreads) {
        const int row = idx / 160, ch = (idx % 160) * 8;
        int t, T; if (row < ML) { t = row & 2047; T = SEQ; } else { t = (row - ML) & 255; T = CTX; }
        float acc[8];
        { const f32x4 b0 = *(const f32x4*)(cb + ch), b1 = *(const f32x4*)(cb + ch + 4); acc[0] = b0[0]; acc[1] = b0[1]; acc[2] = b0[2]; acc[3] = b0[3]; acc[4] = b1[0]; acc[5] = b1[1]; acc[6] = b1[2]; acc[7] = b1[3]; }
#pragma unroll
        for (int tap = 0; tap < 4; ++tap) { const int tt = t + tap - 2;
            if (tt >= 0 && tt < T) { const u32x4 rv = *(const u32x4*)(R + (size_t)(row + tap - 2) * DRNN + ch);
                const f32x4 w0 = *(const f32x4*)(cw + tap * DRNN + ch), w1 = *(const f32x4*)(cw + tap * DRNN + ch + 4);
                acc[0] += w0[0] * bf_lo(rv.x); acc[1] += w0[1] * bf_hi(rv.x); acc[2] += w0[2] * bf_lo(rv.y); acc[3] += w0[3] * bf_hi(rv.y);
                acc[4] += w1[0] * bf_lo(rv.z); acc[5] += w1[1] * bf_hi(rv.z); acc[6] += w1[2] * bf_lo(rv.w); acc[7] += w1[3] * bf_hi(rv.w); } }
        u32x4 o; o.x = cvt_pk_bf16(acc[0], acc[1]); o.y = cvt_pk_bf16(acc[2], acc[3]); o.z = cvt_pk_bf16(acc[4], acc[5]); o.w = cvt_pk_bf16(acc[6], acc[7]);
        *(u32x4*)(U + (size_t)row * DRNN + ch) = o;
    }
}
__device__ __forceinline__ int scan_row0(int bl, int c) { return (c < 8) ? (8192 + bl * CTX + c * 32) : (bl * SEQ + (c - 8) * 32); }
__device__ __forceinline__ void scanA_phase(const bf16_t* LA, const bf16_t* BX, float* SP, float* SH, int gtid, int nthreads) {
    for (int idx = gtid; idx < 2 * 4 * 72 * 640; idx += nthreads) {
        const int cp = idx % 640, r1 = idx / 640, c = r1 % 72, r2 = r1 / 72, bl = r2 & 3, dir = r2 >> 2;
        const int row0 = scan_row0(bl, c);
        const size_t base = ((size_t)dir * 9216 + row0) * DRNN + cp * 2;
        float P0 = 1.f, P1 = 1.f, H0 = 0.f, H1 = 0.f;
#pragma unroll 8
        for (int i = 0; i < 32; ++i) { const int ii = dir ? (31 - i) : i;
            const unsigned lw = *(const unsigned*)(LA + base + (size_t)ii * DRNN), bw = *(const unsigned*)(BX + base + (size_t)ii * DRNN);
            const float a0 = __expf(bf_lo(lw)), a1 = __expf(bf_hi(lw));
            P0 *= a0; P1 *= a1; H0 = a0 * H0 + bf_lo(bw); H1 = a1 * H1 + bf_hi(bw); }
        const size_t so = ((size_t)(dir * 4 + bl) * 72 + c) * DRNN + cp * 2;
        *(f32x2*)(SP + so) = (f32x2){P0, P1}; *(f32x2*)(SH + so) = (f32x2){H0, H1};
    }
}
__device__ __forceinline__ void scanB_phase(const float* SP, const float* SH, float* CIN, int gtid, int nthreads) {
    for (int idx = gtid; idx < 2 * 4 * DRNN; idx += nthreads) {
        const int ch = idx % DRNN, r = idx / DRNN, bl = r & 3, dir = r >> 2;
        const size_t base = ((size_t)(dir * 4 + bl) * 72) * DRNN + ch;
        float carry = 0.f;
#pragma unroll 1
        for (int s0 = 0; s0 < 72; s0 += 24) {
            float pv[24], hv[24];
#pragma unroll
            for (int s = 0; s < 24; ++s) { const int sq = s0 + s; const int c = dir ? (sq < 8 ? 7 - sq : 79 - sq) : sq; pv[s] = SP[base + (size_t)c * DRNN]; hv[s] = SH[base + (size_t)c * DRNN]; }
#pragma unroll
            for (int s = 0; s < 24; ++s) { const int sq = s0 + s; const int c = dir ? (sq < 8 ? 7 - sq : 79 - sq) : sq; CIN[base + (size_t)c * DRNN] = carry; carry = pv[s] * carry + hv[s]; }
        }
    }
}
__device__ __forceinline__ void scanC_phase(const bf16_t* LA, const bf16_t* BX, const float* CIN, bf16_t* REC, int half, int gtid, int nthreads) {
    for (int idx = gtid; idx < 4 * 64 * 640; idx += nthreads) {
        const int cp = idx % 640, r1 = idx / 640, lc = r1 & 63, bl = r1 >> 6;
        const int row0 = bl * SEQ + lc * 32;
        const size_t b0 = ((size_t)row0) * DRNN + cp * 2, b1 = ((size_t)9216 + row0) * DRNN + cp * 2;
        const f32x2 cf = *(const f32x2*)(CIN + ((size_t)(0 * 4 + bl) * 72 + 8 + lc) * DRNN + cp * 2);
        const f32x2 cbk = *(const f32x2*)(CIN + ((size_t)(1 * 4 + bl) * 72 + 8 + lc) * DRNN + cp * 2);
        float hf0[32], hf1[32];
        float h0 = cf[0], h1 = cf[1];
#pragma unroll
        for (int i = 0; i < 32; ++i) { const unsigned lw = *(const unsigned*)(LA + b0 + (size_t)i * DRNN), bw = *(const unsigned*)(BX + b0 + (size_t)i * DRNN);
            h0 = __expf(bf_lo(lw)) * h0 + bf_lo(bw); h1 = __expf(bf_hi(lw)) * h1 + bf_hi(bw); hf0[i] = h0; hf1[i] = h1; }
        h0 = cbk[0]; h1 = cbk[1];
        bf16_t* out = REC + ((size_t)(half * 4 + bl) * SEQ + lc * 32) * DRNN + cp * 2;
#pragma unroll
        for (int i = 31; i >= 0; --i) { const unsigned lw = *(const unsigned*)(LA + b1 + (size_t)i * DRNN), bw = *(const unsigned*)(BX + b1 + (size_t)i * DRNN);
            h0 = __expf(bf_lo(lw)) * h0 + bf_lo(bw); h1 = __expf(bf_hi(lw)) * h1 + bf_hi(bw);
            *(unsigned*)(out + (size_t)i * DRNN) = cvt_pk_bf16(hf0[i] + h0, hf1[i] + h1); }
    }
}

#ifndef PH_MASK
#define PH_MASK 0xFFFFFFFFu
#endif
#define PH(k) ((PH_MASK >> (k)) & 1u)
#ifndef REP_MASK
#define REP_MASK 0u
#endif
#define REP_BEGIN(k) _Pragma("unroll 1") for (int rep_ = 0; rep_ < (((REP_MASK >> (k)) & 1u) ? 2 : 1); ++rep_) {
#define REP_END }
__device__ __forceinline__ ParamsK kparams() { ParamsK q = (ParamsK)__builtin_amdgcn_kernarg_segment_ptr(); asm volatile("" : "+s"(q)); return q; }
#define PHASE_BEGIN ParamsK kp = kparams(); unsigned char* ws = kp->ws; (void)ws; \
    int tid = threadIdx.x; asm volatile("" : "+v"(tid)); const int lane = tid & 63, wave = __builtin_amdgcn_readfirstlane(tid >> 6); \
    const int gw = bid * 8 + wave, gtid = bid * 512 + tid; (void)lane; (void)gw; (void)gtid;
#define P_MOD0 ((float*)(ws + WS_MOD))
#define P_MOD1 ((float*)(ws + WS_MOD) + 9 * 6144)
#define P_CTXRES ((float*)(ws + WS_CTXRES))
#define P_H ((bf16_t*)(ws + WS_H))
#define P_SLAB ((bf16_t*)(ws + WS_SLAB))
#define P_Q ((bf16_t*)(ws + WS_Q))
#define P_O ((bf16_t*)(ws + WS_O))
#define P_K ((bf16_t*)(ws + WS_K))
#define P_VT ((bf16_t*)(ws + WS_VT))
#define P_VTC ((bf16_t*)(ws + WS_VTC))
#define P_ACT ((bf16_t*)(ws + WS_ACT))
#define P_U ((bf16_t*)(ws + WS_U))
#define P_RECF ((bf16_t*)(ws + WS_RECF))
#define P_RECB ((bf16_t*)(ws + WS_RECB))
#define P_LA ((bf16_t*)(ws + WS_LA))
#define P_BX ((bf16_t*)(ws + WS_BX))
#define P_RPRE ((bf16_t*)(ws + WS_RPRE))
#define P_SP ((float*)(ws + WS_SP))
#define P_SH ((float*)(ws + WS_SH))
#define P_CIN ((float*)(ws + WS_CIN))
#define G0 (kp->norm_g)
#define G1 (kp->norm_g + 4 * DM)

__global__ void __launch_bounds__(512, 2) fwd_megakernel(Params p) {
    extern __shared__ __attribute__((aligned(16))) unsigned char lds_raw[];
    LAS unsigned char* lds = (LAS unsigned char*)lds_raw;
    const int G = gridDim.x, bid = blockIdx.x;
    const int ngw = G * 8, nthreads = G * 512;
    using namespace pg8;
    if (threadIdx.x < 4) ((volatile LAS unsigned*)(lds + 132096))[threadIdx.x] = 0u;
    __syncthreads();
    XcdBarrier xbar = xcd_barrier_post((unsigned*)(p.ws + WS_BAR), (volatile LAS unsigned*)(lds + 132096));
    if (PH(0)) { PHASE_BEGIN prologue(kp, lds, tid, lane, wave); }
    xcd_barrier(xbar);
#ifdef EXTRA_SYNCS
#pragma unroll 1
    for (int es = 0; es < EXTRA_SYNCS; ++es) xcd_barrier(xbar);
#endif
    REP_BEGIN(1)
    if (PH(1)) { PHASE_BEGIN row_phase<false, true, false, false>(kp->x, kp->ctx, nullptr, nullptr, nullptr, nullptr, P_H, nullptr, G0, nullptr, 0, P_MOD0, 0, 1, MT, gw, ngw, lane); }
    xcd_barrier(xbar);
    REP_END
    if (PH(2)) {
        PHASE_BEGIN
        Gemm g{P_H, (const bf16_t*)(ws + WS_WQKV), DM, DM, DM}; Sched S; S.init(MT / 256, NQKV / 256, G, bid);
        EpiQKV E{P_Q, P_K, P_VT, P_VTC, (const float*)(ws + WS_ROPE)};
        gemm_phase<EpiQKV, true, true>(lds, g, S, E);
    }
    xcd_barrier(xbar);
    REP_BEGIN(3)
    if (PH(3)) { PHASE_BEGIN attn_phase(lds, P_Q, P_O, P_K, P_VT, P_VTC, kp->sink, tid, lane, wave); }
    xcd_barrier(xbar);
    REP_END
    if (PH(4)) {
        PHASE_BEGIN
        { Gemm g{P_O, (const bf16_t*)(ws + WS_WO), DM, DM, DM}; Sched S; S.init(ML / 256, DM / 256, G, bid);
          EpiPlain<0> E{P_H, DM};
          gemm_phase<EpiPlain<0>, true, true>(lds, g, S, E); }
        { Gemm g{P_O, (const bf16_t*)(ws + WS_WO), DM, DM, 256}; Sched S; S.init(8, 4 * 4, G, bid, 2, 256);
          EpiSlabCtx E{P_SLAB, 256};
          gemm_phase<EpiSlabCtx, true, true>(lds, g, S, E); }
    }
    xcd_barrier(xbar);
    if (PH(5)) { PHASE_BEGIN row_phase<true, true, false, true>(kp->x, kp->ctx, kp->out, P_CTXRES, P_H, P_SLAB, P_H, G0 + DM, G0 + 2 * DM, P_MOD0, 2, P_MOD0, 3, 4, MT, gw, ngw, lane); }
    xcd_barrier(xbar);
    if (PH(6)) {
        PHASE_BEGIN
        Gemm g{P_H, (const bf16_t*)(ws + WS_W1), DM, DM, DM}; Sched S; S.init(MT / 256, DFF / 256, G, bid);
        EpiPlain<1> E{P_ACT, DFF};
        gemm_phase<EpiPlain<1>, true, true>(lds, g, S, E);
    }
    xcd_barrier(xbar);
    if (PH(7)) {
        PHASE_BEGIN
        { Gemm g{P_ACT, (const bf16_t*)(ws + WS_W2), DFF, DFF, DFF}; Sched S; S.init(ML / 256, DM / 256, G, bid);
          EpiPlain<0> E{P_H, DM};
          gemm_phase<EpiPlain<0>, true, true>(lds, g, S, E); }
        { Gemm g{P_ACT, (const bf16_t*)(ws + WS_W2), DFF, DFF, 1024}; Sched S; S.init(8, 4 * 4, G, bid, 2, 1024);
          EpiSlabCtx E{P_SLAB, 1024};
          gemm_phase<EpiSlabCtx, true, true>(lds, g, S, E); }
    }
    xcd_barrier(xbar);
    if (PH(8)) { PHASE_BEGIN row_phase<true, true, true, true>(kp->out, P_CTXRES, kp->out, P_CTXRES, P_H, P_SLAB, P_H, G0 + 3 * DM, G1, P_MOD0, 5, P_MOD1, 0, 1, MT, gw, ngw, lane); }
    xcd_barrier(xbar);
    if (PH(9)) {
        PHASE_BEGIN
        Gemm g{P_H, (const bf16_t*)(ws + WS_WIN), DM, DM, DM}; Sched S; S.init(MT / 256, DRNN / 256, G, bid, 4, 0);
        EpiInProj E{P_RPRE, (bf16_t*)(ws + WS_CTXRES)};
        gemm_phase<EpiInProj, true, true>(lds, g, S, E);
    }
    xcd_barrier(xbar);
    REP_BEGIN(10)
    if (PH(10)) { PHASE_BEGIN conv_phase(P_RPRE, P_U, kp->conv_w, kp->conv_b, gtid, nthreads);
        u32x4* cz = (u32x4*)(ws + WS_CARRY); for (int idx = gtid; idx < 1440 * 128 * 8 / 16; idx += nthreads) cz[idx] = (u32x4){0u, 0u, 0u, 0u}; }
    xcd_barrier(xbar);
    REP_END
    if (PH(11)) {
        PHASE_BEGIN
        Gemm g{P_U, (const bf16_t*)(ws + WS_WG), DRNN, 256, 256}; Sched S; S.init(1, 1, G, bid, 3, 0);
        EpiGatesScan E{P_U, P_RECF, P_RECB, kp->b_a, kp->b_i, (const float*)(ws + WS_NLS), (unsigned long long*)(ws + WS_CARRY)};
        gemm_phase<EpiGatesScan, true, true>(lds, g, S, E);
    }
    xcd_barrier(xbar);
    if (PH(15)) {
        PHASE_BEGIN
        Gemm g{P_H, (const bf16_t*)(ws + WS_WIN), DM, DM, DM}; Sched S; S.init(ML / 256, 4, G, bid);
        EpiGateMul E{P_RECF, P_RECB};
        gemm_phase<EpiGateMul, true, true>(lds, g, S, E);
        {
            const bf16_t* GB = (const bf16_t*)(ws + WS_CTXRES); bf16_t* Z = P_RECF; const bf16_t* RB = P_RECB;
            for (int idx = gtid; idx < ML * 32; idx += nthreads) { const int row = idx >> 5, c8 = (idx & 31) * 8;
                const u32x4 gv = *(const u32x4*)(GB + (size_t)row * 256 + c8); const size_t o = (size_t)row * DRNN + 1024 + c8;
                const u32x4 fv = *(const u32x4*)(Z + o), bv = *(const u32x4*)(RB + o); u32x4 w;
                w.x = cvt_pk_bf16(bf_lo(gv.x) * (bf_lo(fv.x) + bf_lo(bv.x)), bf_hi(gv.x) * (bf_hi(fv.x) + bf_hi(bv.x)));
                w.y = cvt_pk_bf16(bf_lo(gv.y) * (bf_lo(fv.y) + bf_lo(bv.y)), bf_hi(gv.y) * (bf_hi(fv.y) + bf_hi(bv.y)));
                w.z = cvt_pk_bf16(bf_lo(gv.z) * (bf_lo(fv.z) + bf_lo(bv.z)), bf_hi(gv.z) * (bf_hi(fv.z) + bf_hi(bv.z)));
                w.w = cvt_pk_bf16(bf_lo(gv.w) * (bf_lo(fv.w) + bf_lo(bv.w)), bf_hi(gv.w) * (bf_hi(fv.w) + bf_hi(bv.w)));
                *(u32x4*)(Z + o) = w; }
        }
    }
    xcd_barrier(xbar);
    if (PH(16)) {
        PHASE_BEGIN
        Gemm g{P_RECF, (const bf16_t*)(ws + WS_WOUT), DRNN, DRNN, DRNN}; Sched S; S.init(ML / 256, DM / 256, G, bid);
        EpiPlain<0> E{P_H, DM};
        gemm_phase<EpiPlain<0>, true, true>(lds, g, S, E);
    }
    xcd_barrier(xbar);
    if (PH(17)) { PHASE_BEGIN row_phase<true, true, true, true>(kp->out, P_CTXRES, ws + WS_X3, P_CTXRES, P_H, nullptr, P_H, G1 + DM, G1 + 2 * DM, P_MOD1, 2, P_MOD1, 3, 4, ML, gw, ngw, lane); }
    xcd_barrier(xbar);
    if (PH(18)) {
        PHASE_BEGIN
        Gemm g{P_H, (const bf16_t*)(ws + WS_W1 + 16 * MiB), DM, DM, DM}; Sched S; S.init(ML / 256, DFF / 256, G, bid);
        EpiPlain<1> E{P_ACT, DFF};
        gemm_phase<EpiPlain<1>, true, true>(lds, g, S, E);
    }
    xcd_barrier(xbar);
    if (PH(19)) {
        PHASE_BEGIN
        Gemm g{P_ACT, (const bf16_t*)(ws + WS_W2 + 16 * MiB), DFF, DFF, DFF}; Sched S; S.init(ML / 256, DM / 256, G, bid);
        EpiPlain<0> E{P_H, DM};
        gemm_phase<EpiPlain<0>, true, true>(lds, g, S, E);
    }
    xcd_barrier(xbar);
    if (PH(20)) { PHASE_BEGIN row_phase<true, false, true, false>(ws + WS_X3, P_CTXRES, kp->out, P_CTXRES, P_H, nullptr, nullptr, G1 + 3 * DM, nullptr, P_MOD1, 5, nullptr, 0, 0, ML, gw, ngw, lane); }
}

extern "C" void kernel_launch(void* const* d_in, const int* in_sizes, int n_in, void* d_out, int out_size, void* d_ws, size_t ws_size, hipStream_t stream) {
    static int grid_blocks = 0;
    if (grid_blocks == 0) {
        if (n_in != 21 || ws_size < WS_END) { fprintf(stderr, "kernel_launch: unexpected n_in %d / ws_size %zu\n", n_in, ws_size); grid_blocks = -1; return; }
        int dev = 0, cus = 0, per_cu = 0;
        hipGetDevice(&dev);
        hipDeviceGetAttribute(&cus, hipDeviceAttributeMultiprocessorCount, dev);
        if (hipFuncSetAttribute((const void*)fwd_megakernel, hipFuncAttributeMaxDynamicSharedMemorySize, LDS_BYTES) != hipSuccess) { fprintf(stderr, "hipFuncSetAttribute failed\n"); grid_blocks = -1; return; }
        if (hipOccupancyMaxActiveBlocksPerMultiprocessor(&per_cu, (const void*)fwd_megakernel, 512, LDS_BYTES) != hipSuccess || per_cu < 1) { fprintf(stderr, "occupancy query failed (%d)\n", per_cu); (void)hipGetLastError(); per_cu = 1; }
        grid_blocks = cus * 1;
    }
    if (grid_blocks < 0) return;
    Params p{};
    p.x = (const float*)d_in[0]; p.c = (const float*)d_in[1]; p.ctx = (const float*)d_in[2]; p.c_ctx = (const float*)d_in[3];
    p.ada_w = (const float*)d_in[4]; p.ada_b = (const float*)d_in[5]; p.norm_g = (const float*)d_in[6]; p.mlp_w1 = (const float*)d_in[7]; p.mlp_w2 = (const float*)d_in[8];
    p.w_qkv = (const float*)d_in[9]; p.w_o = (const float*)d_in[10]; p.sink = (const float*)d_in[11];
    p.w_in = (const float*)d_in[12]; p.conv_w = (const float*)d_in[13]; p.conv_b = (const float*)d_in[14]; p.w_a = (const float*)d_in[15]; p.b_a = (const float*)d_in[16];
    p.w_i = (const float*)d_in[17]; p.b_i = (const float*)d_in[18]; p.lam = (const float*)d_in[19]; p.w_out = (const float*)d_in[20];
    p.out = (float*)d_out; p.ws = (unsigned char*)d_ws;
    if (hipMemsetAsync((unsigned char*)d_ws + WS_BAR, 0, XCD_BAR_WORDS * 4, stream) != hipSuccess) { fprintf(stderr, "memset of barrier words failed\n"); return; }
    void* args[] = {&p};
    hipError_t e = hipLaunchCooperativeKernel((const void*)fwd_megakernel, dim3(grid_blocks), dim3(512), args, LDS_BYTES, stream);
    if (e != hipSuccess) fprintf(stderr, "cooperative launch failed: %s (grid %d)\n", hipGetErrorString(e), grid_blocks);
}
```

```cpp
#include <hip/hip_runtime.h>
#include <hip/hip_cooperative_groups.h>
#include <cstdio>
#include <cstdint>
namespace cg = cooperative_groups;

#define LAS __attribute__((address_space(3)))
typedef unsigned short bf16_t;
typedef short bf16x8 __attribute__((ext_vector_type(8)));
typedef float f32x4 __attribute__((ext_vector_type(4)));
typedef float f32x2 __attribute__((ext_vector_type(2)));
typedef unsigned u32x4 __attribute__((ext_vector_type(4)));
typedef unsigned u32x2 __attribute__((ext_vector_type(2)));

constexpr int DM = 1024, NB = 8, SEQ = 2048, CTX = 256;
constexpr int ML = NB * SEQ;
constexpr int MC = NB * CTX;
constexpr int MT = ML + MC;
constexpr int NQKV = 1536, DFF = 4096, DRNN = 1280;
constexpr float EPS = 1e-6f;
constexpr float LOG2E = 1.4426950408889634f;

constexpr size_t MiB = 1u << 20;
constexpr size_t WS_MOD = 0;
constexpr size_t WS_ROPE = 448 * 1024;
constexpr size_t WS_NLS = 460 * 1024;
constexpr size_t WS_BAR = 480 * 1024;
constexpr size_t WS_WQKV = 1 * MiB, WS_WO = 4 * MiB, WS_W1 = 6 * MiB, WS_W2 = 14 * MiB;
constexpr size_t WS_WIN = 38 * MiB, WS_WG = 43 * MiB, WS_WOUT = 46 * MiB;
constexpr size_t WS_CTXRES = 49 * MiB;
constexpr size_t WS_H = 57 * MiB;
constexpr size_t WS_R3 = 93 * MiB;
constexpr size_t WS_Q = WS_R3, WS_K = 129 * MiB, WS_VT = 138 * MiB, WS_VTC = 146 * MiB;
constexpr size_t WS_O = 150 * MiB;
constexpr size_t WS_ACT = WS_R3;
constexpr size_t WS_U = WS_R3;
constexpr size_t WS_RECF = 138 * MiB;
constexpr size_t WS_RECB = 178 * MiB;
constexpr size_t WS_LA = 138 * MiB;
constexpr size_t WS_BX = 183 * MiB;
constexpr size_t WS_RPRE = 138 * MiB;
constexpr size_t WS_SP = 228 * MiB, WS_SH = 231 * MiB, WS_CIN = 234 * MiB;
constexpr size_t WS_SLAB = 238 * MiB;
constexpr size_t WS_CARRY = 219 * MiB;
constexpr size_t WS_FLAG = 512 * 1024;
constexpr size_t WS_X3 = 222 * MiB;
constexpr size_t WS_END = 256 * MiB;
constexpr int LDS_BYTES = 143360;

__device__ __forceinline__ unsigned f2bf(float f) { unsigned u = __builtin_bit_cast(unsigned, f); return (u + 0x7fffu + ((u >> 16) & 1u)) >> 16; }
__device__ __forceinline__ unsigned cvt_pk_bf16(float lo, float hi) { unsigned r; asm volatile("v_cvt_pk_bf16_f32 %0, %1, %2" : "=v"(r) : "v"(lo), "v"(hi)); return r; }
__device__ __forceinline__ float bf_lo(unsigned w) { return __builtin_bit_cast(float, w << 16); }
__device__ __forceinline__ float bf_hi(unsigned w) { return __builtin_bit_cast(float, w & 0xffff0000u); }
__device__ __forceinline__ f32x4 bf4_to_f32(u32x2 w) { return (f32x4){bf_lo(w.x), bf_hi(w.x), bf_lo(w.y), bf_hi(w.y)}; }
__device__ __forceinline__ u32x2 f32_to_bf4(f32x4 v) { u32x2 w; w.x = cvt_pk_bf16(v[0], v[1]); w.y = cvt_pk_bf16(v[2], v[3]); return w; }
__device__ __forceinline__ float wave_sum(float v) {
#pragma unroll
    for (int o = 1; o < 64; o <<= 1) v += __shfl_xor(v, o);
    return v;
}
__device__ __forceinline__ float fsigmoid(float x) { return __builtin_amdgcn_rcpf(1.0f + __expf(-x)); }

namespace pg8 {
constexpr int BM = 256, BK = 64, HALF = 128, HTB = HALF * BK * 2, STAGE_BYTES = 8 * HTB, NXCD = 8, WGM = 8;
__device__ __forceinline__ int lds_byte(int r, int c) { const int st = (r >> 4) * 2 + (c >> 5), rr = r & 15, cc = c & 31, ob = rr * 64 + cc * 2; return st * 1024 + (ob ^ (((ob >> 9) & 1) << 5)); }
__device__ __forceinline__ void stage_rc(int b, int& R, int& C) { const int st = b / 1024, sb = b % 1024, swz = sb ^ (((sb >> 9) & 1) << 5); R = (st >> 1) * 16 + swz / 64; C = (st & 1) * 32 + (swz % 64) / 2; }

__device__ __forceinline__ int perm32(int rho) { const int n = rho >> 4, i = rho & 15; return 8 * (i >> 2) + 4 * n + (i & 3); }
struct Unit { int pm, pn, koff, po, kboff, rev, lin; };
struct Gemm { const bf16_t* A; const bf16_t* Bt; int lda, ldb, K; };

struct Sched {
    int nM, nN, nwg, G, c, mode, half;
    __device__ void init(int nM_, int nN_, int G_, int c_, int mode_ = 0, int half_ = 0) { nM = nM_; nN = nN_; nwg = nM * nN; G = G_; c = c_; mode = mode_; half = half_; }
    __device__ bool next(int i, Unit& u) const {
        if (mode == 3) {
            const int L = i * G + c; if (L >= 1440) return false;
            const int ti = L / 160, s = L % 160;
            const int chalf = s & 1, dir = (s >> 1) & 1, bb = s >> 2, blk = bb % 5, b = bb / 5;
            u.pm = (ti == 0) ? 64 + b : (dir ? b * 8 + (8 - ti) : b * 8 + (ti - 1));
            u.pn = (dir * 5 + blk) * 2 + chalf; u.koff = blk * 256; u.kboff = 0; u.po = ti; u.rev = dir; u.lin = L;
            return true;
        }
        if (mode == 4) {
            const int L4 = i * G + c; if (L4 >= 424) return false;
            if (L4 >= 360) { u.pm = L4 - 360; u.pn = 4; u.koff = 0; u.po = u.pm; u.kboff = 0; u.rev = 0; u.lin = 0; return true; }
        }
        const long L = (long)i * G + c; if (L >= nwg) return false;
        int wgid = (int)L; { const int q = nwg / NXCD, r = nwg % NXCD, xcd = wgid % NXCD, off = wgid / NXCD; wgid = (xcd < r ? xcd * (q + 1) : r * (q + 1) + (xcd - r) * q) + off; }
        const int nig = WGM * nN, gid = wgid / nig, fm = gid * WGM, gsz = (nM - fm) < WGM ? (nM - fm) : WGM;
        const int pmi = fm + ((wgid % nig) % gsz), pn = (wgid % nig) / gsz;
        u.pm = pmi; u.pn = pn; u.koff = 0; u.po = pmi; u.kboff = 0; u.rev = 0; u.lin = 0;
        if (mode == 2) { u.pm = 64 + pmi; u.pn = pn & 3; u.koff = (pn >> 2) * half; u.kboff = u.koff; }
        if (mode == 4) u.pn += 5;
        if (mode == 1) { u.pm = pmi < 32 ? 32 * half + pmi : 64 + 4 * half + (pmi - 32); u.koff = ((pn >> 1) % 5) * 256; }
        return true;
    }
};

template <class Epi, bool ALIGN_EPI, bool SP2>
__device__ __forceinline__ void gemm_phase(LAS unsigned char* lds, const Gemm g, const Sched& S, const Epi& E) {
    int tid = threadIdx.x; asm volatile("" : "+v"(tid));
    const int wid = __builtin_amdgcn_readfirstlane(tid >> 6), lane = tid & 63, wr = wid >> 2, wc = wid & 3, fr = lane & 15, fq = lane >> 4;
    const int K = g.K, nt = K / BK;
    unsigned voffAf[2], voffAr[2], voffB[2];
#pragma unroll
    for (int i = 0; i < 2; ++i) { int R, C; stage_rc(tid * 16 + i * 8192, R, C);
        const int Rb = Epi::PERM ? ((R & ~31) + perm32(R & 31)) : R;
        voffAf[i] = (unsigned)(R * g.lda + C) * 2u; voffAr[i] = (unsigned)((127 - R) * g.lda + C) * 2u; voffB[i] = (unsigned)(Rb * g.ldb + C) * 2u; }
    const size_t kstep = (size_t)(BK * 2);
    const long hstepAf = (long)HALF * g.lda * 2; const size_t hstepB = (size_t)HALF * g.ldb * 2;
    const unsigned ldsw = (unsigned)wid * 1024u;
    const int aoff = lds_byte(wr * 64 + fr, fq * 8), boff = lds_byte(wc * 32 + fr, fq * 8);
#define PG8_SA(b, h) (((b) * 2 + (h)) * HTB)
#define PG8_SB(b, h) ((4 + (b) * 2 + (h)) * HTB)
#define PG8_STAGE(bufoff, gbase, voff) do { _Pragma("unroll") for (int _i = 0; _i < 2; ++_i) \
        __builtin_amdgcn_global_load_lds((const unsigned*)((const char*)(gbase) + (voff)[_i]), (LAS unsigned*)(lds + (bufoff) + ldsw + _i * 8192), 16, 0, 0); } while (0)
#define PG8_LDA(dst, b, h) do { _Pragma("unroll") for (int m = 0; m < 4; ++m) _Pragma("unroll") for (int k = 0; k < 2; ++k) dst[m][k] = *(const LAS bf16x8*)(lds + PG8_SA(b, h) + aoff + m * 2048 + k * 1024); } while (0)
#define PG8_LDB(dst, b, h) do { _Pragma("unroll") for (int n = 0; n < 2; ++n) _Pragma("unroll") for (int k = 0; k < 2; ++k) dst[n][k] = *(const LAS bf16x8*)(lds + PG8_SB(b, h) + boff + n * 2048 + k * 1024); } while (0)
#define PG8_MMA(ai, bj, At, Bt) do { __builtin_amdgcn_s_setprio(1); _Pragma("unroll") for (int m = 0; m < 4; ++m) _Pragma("unroll") for (int n = 0; n < 2; ++n) _Pragma("unroll") for (int k = 0; k < 2; ++k) \
        acc[ai][bj][m][n] = __builtin_amdgcn_mfma_f32_16x16x32_bf16(Bt[n][k], At[m][k], acc[ai][bj][m][n], 0, 0, 0); __builtin_amdgcn_s_setprio(0); } while (0)
#define PG8_WAIT_V(n) asm volatile("s_waitcnt vmcnt(" #n ")" ::: "memory")
#define PG8_WAIT_L(n) asm volatile("s_waitcnt lgkmcnt(" #n ")" ::: "memory")
#define PG8_BAR __builtin_amdgcn_s_barrier()
#define PG8_SCHED __builtin_amdgcn_sched_barrier(0)
    Unit cur, nxt; int ui = 0;
    if (!S.next(0, cur)) return;
    f32x4 acc[2][2][4][2];
#pragma unroll
    for (int a = 0; a < 2; ++a)
#pragma unroll
        for (int b = 0; b < 2; ++b)
#pragma unroll
            for (int m = 0; m < 4; ++m)
#pragma unroll
                for (int n = 0; n < 2; ++n) acc[a][b][m][n] = (f32x4){0.f, 0.f, 0.f, 0.f};
    bf16x8 At[4][2], B0[2][2], B1[2][2];
#define PG8_UNIT_A(u_) ((const char*)g.A + ((size_t)(u_).pm * BM * g.lda + (u_).koff) * 2 + (Epi::WITH_LDS && (u_).rev ? hstepAf : 0))
    const char* cA = PG8_UNIT_A(cur);
    unsigned voffA[2] = {voffAf[0], voffAf[1]}; long hstepA = hstepAf;
    if (Epi::WITH_LDS && cur.rev) { voffA[0] = voffAr[0]; voffA[1] = voffAr[1]; hstepA = -hstepAf; } const char* cB = (const char*)g.Bt + ((size_t)cur.pn * BM * g.ldb + cur.kboff) * 2;
    if constexpr (SP2) {
        PG8_STAGE(PG8_SB(0, 0), cB, voffB); PG8_STAGE(PG8_SB(0, 1), cB + hstepB, voffB); PG8_STAGE(PG8_SA(0, 0), cA, voffA); PG8_STAGE(PG8_SA(0, 1), cA + hstepA, voffA);
        if (wr == 1) PG8_BAR;
        PG8_WAIT_V(2); PG8_BAR;
        PG8_STAGE(PG8_SB(1, 0), cB + kstep, voffB); PG8_STAGE(PG8_SA(1, 0), cA + kstep, voffA); PG8_STAGE(PG8_SB(1, 1), cB + hstepB + kstep, voffB);
        PG8_WAIT_V(6); PG8_BAR;
    } else {
        PG8_STAGE(PG8_SB(0, 0), cB, voffB); PG8_STAGE(PG8_SA(0, 0), cA, voffA); PG8_STAGE(PG8_SB(0, 1), cB + hstepB, voffB); PG8_STAGE(PG8_SA(0, 1), cA + hstepA, voffA);
        if (wr == 1) PG8_BAR;
        PG8_WAIT_V(4); PG8_BAR;
        PG8_STAGE(PG8_SB(1, 0), cB + kstep, voffB); PG8_STAGE(PG8_SA(1, 0), cA + kstep, voffA); PG8_STAGE(PG8_SB(1, 1), cB + hstepB + kstep, voffB);
        PG8_WAIT_V(6); PG8_BAR;
    }
    for (;;) {
        const bool has_next = S.next(ui + 1, nxt);
        const char* nA = has_next ? PG8_UNIT_A(nxt) : cA;
        unsigned voffN[2] = {voffA[0], voffA[1]}; long hstepN = hstepA;
        if (Epi::WITH_LDS && has_next) { const bool nr = nxt.rev != 0; voffN[0] = nr ? voffAr[0] : voffAf[0]; voffN[1] = nr ? voffAr[1] : voffAf[1]; hstepN = nr ? -hstepAf : hstepAf; }
        const char* nB = has_next ? (const char*)g.Bt + ((size_t)nxt.pn * BM * g.ldb + nxt.kboff) * 2 : cB;
#pragma unroll 1
        for (int t = 0; t < nt; t += 2) {
            const bool last = (t == nt - 2);
            const char* a1 = cA + (size_t)(t + 1) * kstep;
            const char* a2 = last ? nA : cA + (size_t)(t + 2) * kstep; const char* b2 = last ? nB : cB + (size_t)(t + 2) * kstep;
            const char* a3 = a2 + kstep; const char* b3 = b2 + kstep;
            unsigned voff2[2] = {voffA[0], voffA[1]}; long hstep2 = hstepA;
            if (Epi::WITH_LDS && last) { voff2[0] = voffN[0]; voff2[1] = voffN[1]; hstep2 = hstepN; }
            if constexpr (SP2) {
            PG8_LDB(B0, 0, 0); PG8_LDB(B1, 0, 1); PG8_SCHED; PG8_LDA(At, 0, 0); PG8_STAGE(PG8_SA(1, 1), a1 + hstepA, voffA);
            PG8_WAIT_V(8); PG8_WAIT_L(0); PG8_BAR; PG8_MMA(0, 0, At, B0); PG8_MMA(0, 1, At, B1); PG8_BAR; PG8_SCHED;
            PG8_LDA(At, 0, 1); PG8_STAGE(PG8_SB(0, 0), b2, voffB); PG8_STAGE(PG8_SB(0, 1), b2 + hstepB, voffB); PG8_STAGE(PG8_SA(0, 0), a2, voff2);
            PG8_WAIT_V(8); PG8_WAIT_L(0); PG8_BAR; PG8_MMA(1, 0, At, B0); PG8_MMA(1, 1, At, B1); PG8_BAR; PG8_SCHED;
            PG8_LDB(B0, 1, 0); PG8_LDB(B1, 1, 1); PG8_SCHED; PG8_LDA(At, 1, 0); PG8_STAGE(PG8_SA(0, 1), a2 + hstep2, voff2);
            PG8_WAIT_V(8); PG8_WAIT_L(0); PG8_BAR; PG8_MMA(0, 0, At, B0); PG8_MMA(0, 1, At, B1); PG8_BAR; PG8_SCHED;
            PG8_LDA(At, 1, 1); PG8_STAGE(PG8_SB(1, 0), b3, voffB); PG8_STAGE(PG8_SB(1, 1), b3 + hstepB, voffB); PG8_STAGE(PG8_SA(1, 0), a3, voff2);
            PG8_WAIT_V(8); PG8_WAIT_L(0); PG8_BAR; PG8_MMA(1, 0, At, B0); PG8_MMA(1, 1, At, B1); PG8_BAR; PG8_SCHED;
            } else {
            PG8_LDB(B0, 0, 0); PG8_SCHED; PG8_LDA(At, 0, 0); PG8_STAGE(PG8_SA(1, 1), a1 + hstepA, voffA);
            PG8_WAIT_L(8); PG8_BAR; PG8_WAIT_L(0); PG8_MMA(0, 0, At, B0); PG8_BAR; PG8_SCHED;
            PG8_LDB(B1, 0, 1); PG8_STAGE(PG8_SB(0, 0), b2, voffB);
            PG8_BAR; PG8_WAIT_L(0); PG8_MMA(0, 1, At, B1); PG8_BAR;
            PG8_LDA(At, 0, 1); PG8_STAGE(PG8_SA(0, 0), a2, voff2);
            PG8_BAR; PG8_WAIT_L(0); PG8_MMA(1, 0, At, B0); PG8_BAR; PG8_SCHED;
            PG8_STAGE(PG8_SB(0, 1), b2 + hstepB, voffB);
            PG8_WAIT_V(6); PG8_BAR; PG8_MMA(1, 1, At, B1); PG8_BAR;
            PG8_LDB(B0, 1, 0); PG8_SCHED; PG8_LDA(At, 1, 0); PG8_STAGE(PG8_SA(0, 1), a2 + hstep2, voff2);
            PG8_WAIT_L(8); PG8_BAR; PG8_WAIT_L(0); PG8_MMA(0, 0, At, B0); PG8_BAR; PG8_SCHED;
            PG8_LDB(B1, 1, 1); PG8_STAGE(PG8_SB(1, 0), b3, voffB);
            PG8_BAR; PG8_WAIT_L(0); PG8_MMA(0, 1, At, B1); PG8_BAR;
            PG8_LDA(At, 1, 1); PG8_STAGE(PG8_SA(1, 0), a3, voff2);
            PG8_BAR; PG8_WAIT_L(0); PG8_MMA(1, 0, At, B0); PG8_BAR; PG8_SCHED;
            PG8_STAGE(PG8_SB(1, 1), b3 + hstepB, voffB);
            PG8_WAIT_V(6); PG8_BAR; PG8_MMA(1, 1, At, B1); PG8_BAR;
            }
        }
        if constexpr (ALIGN_EPI) { if (wr == 0) PG8_BAR; }
        if constexpr (Epi::WITH_LDS) E.run(acc, cur, wr, wc, lane, lds); else E(acc, cur, wr, wc, fr, fq);
        if (!has_next) break;
#pragma unroll
        for (int a = 0; a < 2; ++a)
#pragma unroll
            for (int b = 0; b < 2; ++b)
#pragma unroll
                for (int m = 0; m < 4; ++m)
#pragma unroll
                    for (int n = 0; n < 2; ++n) acc[a][b][m][n] = (f32x4){0.f, 0.f, 0.f, 0.f};
        cur = nxt; cA = nA; cB = nB; ++ui; voffA[0] = voffN[0]; voffA[1] = voffN[1]; hstepA = hstepN;
        if constexpr (ALIGN_EPI) { if (wr == 1) PG8_BAR; }
    }
    PG8_WAIT_V(0);
    if constexpr (!ALIGN_EPI) { if (wr == 0) PG8_BAR; }
    PG8_BAR;
#undef PG8_UNIT_A
#undef PG8_SA
#undef PG8_SB
#undef PG8_STAGE
#undef PG8_LDA
#undef PG8_LDB
#undef PG8_MMA
#undef PG8_WAIT_V
#undef PG8_WAIT_L
#undef PG8_BAR
#undef PG8_SCHED
}

template <int ACT> struct EpiPlain {
    static constexpr bool WITH_LDS = false, PERM = true;
    bf16_t* O; int ldc;
    __device__ __forceinline__ void operator()(const f32x4 (&acc)[2][2][4][2], const Unit& u, int wr, int wc, int fr_, int fq_) const {
        int fr = fr_, fq = fq_; asm volatile("" : "+v"(fr), "+v"(fq));
        const int col0 = u.pn * BM + wc * 32 + fq * 8;
#pragma unroll
        for (int ai = 0; ai < 2; ++ai)
#pragma unroll
            for (int m = 0; m < 4; ++m) { bf16_t* rowp = O + (size_t)(u.pm * BM + ai * HALF + wr * 64 + m * 16 + fr) * ldc + col0;
#pragma unroll
                for (int bj = 0; bj < 2; ++bj) { f32x4 v0 = acc[ai][bj][m][0], v1 = acc[ai][bj][m][1];
                    if (ACT == 1) { v0 = __builtin_elementwise_max(v0, (f32x4){0.f, 0.f, 0.f, 0.f}); v0 = v0 * v0; v1 = __builtin_elementwise_max(v1, (f32x4){0.f, 0.f, 0.f, 0.f}); v1 = v1 * v1; }
                    u32x4 w; w.x = cvt_pk_bf16(v0[0], v0[1]); w.y = cvt_pk_bf16(v0[2], v0[3]); w.z = cvt_pk_bf16(v1[0], v1[1]); w.w = cvt_pk_bf16(v1[2], v1[3]);
                    *(u32x4*)(rowp + bj * HALF) = w; } }
    }
};

struct EpiSlabCtx {
    static constexpr bool WITH_LDS = false, PERM = false;
    bf16_t* S; int ksz;
    __device__ __forceinline__ void operator()(const f32x4 (&acc)[2][2][4][2], const Unit& u, int wr, int wc, int fr_, int fq_) const {
        int fr = fr_, fq = fq_; asm volatile("" : "+v"(fr), "+v"(fq));
        const int col0 = u.pn * BM + wc * 32 + fq * 4;
        bf16_t* base = S + (size_t)(u.koff / ksz) * MC * DM;
#pragma unroll
        for (int ai = 0; ai < 2; ++ai)
#pragma unroll
            for (int m = 0; m < 4; ++m) { bf16_t* rowp = base + (size_t)(u.pm * BM - ML + ai * HALF + wr * 64 + m * 16 + fr) * DM + col0;
#pragma unroll
                for (int bj = 0; bj < 2; ++bj)
#pragma unroll
                    for (int n = 0; n < 2; ++n) *(u32x2*)(rowp + bj * HALF + n * 16) = f32_to_bf4(acc[ai][bj][m][n]); }
    }
};

struct EpiQKV {
    static constexpr bool WITH_LDS = false, PERM = false;
    bf16_t* Q; bf16_t* Kb; bf16_t* VT; bf16_t* VTC; const float* rope;
    __device__ __forceinline__ void operator()(const f32x4 (&acc)[2][2][4][2], const Unit& u, int wr, int wc, int fr_, int fq_) const {
        int fr = fr_, fq = fq_; asm volatile("" : "+v"(fr), "+v"(fq));
        const bool lat = u.pm < 64;
        if (u.pn < 5) {
#pragma unroll
            for (int ai = 0; ai < 2; ++ai)
#pragma unroll
                for (int m = 0; m < 4; ++m) {
                    const int row = u.pm * BM + ai * HALF + wr * 64 + m * 16 + fr;
                    f32x4 cs0 = {1.f, 0.f, 1.f, 0.f}, cs1 = {1.f, 0.f, 1.f, 0.f};
                    if (lat) { const int t = row & 2047; const int pos = (wc & 1) ? (t & 63) : (t >> 6); const f32x4* pp = (const f32x4*)(rope + (pos * 16 + 4 * fq) * 2); cs0 = pp[0]; cs1 = pp[1]; }
                    const f32x4 cv = {cs0[0], cs0[2], cs1[0], cs1[2]}, sv = {cs0[1], cs0[3], cs1[1], cs1[3]};
#pragma unroll
                    for (int bj = 0; bj < 2; ++bj) {
                        const f32x4 a = acc[ai][bj][m][0], b = acc[ai][bj][m][1];
                        f32x4 na = a * cv - b * sv, nb = b * cv + a * sv;
                        if (u.pn < 4) { na = na * 0.125f; nb = nb * 0.125f;
                            bf16_t* d = Q + (size_t)row * 1024 + u.pn * 256 + bj * HALF + wc * 32 + fq * 4;
                            *(u32x2*)d = f32_to_bf4(na); *(u32x2*)(d + 16) = f32_to_bf4(nb);
                        } else {
                            bf16_t* d = Kb + (size_t)row * 256 + bj * HALF + wc * 32 + fq * 4;
                            *(u32x2*)d = f32_to_bf4(na); *(u32x2*)(d + 16) = f32_to_bf4(nb);
                        }
                    }
                }
        } else {
#pragma unroll
            for (int ai = 0; ai < 2; ++ai)
#pragma unroll
                for (int m = 0; m < 4; ++m) {
                    const int row = u.pm * BM + ai * HALF + wr * 64 + m * 16 + fr;
                    bf16_t* base; size_t stride;
                    if (lat) { const int b = row >> 11, t = row & 2047; base = VT + (size_t)b * 256 * 2048 + t; stride = 2048; }
                    else { const int rc = row - ML; const int b = rc >> 8, t = rc & 255; base = VTC + (size_t)b * 256 * 256 + t; stride = 256; }
#pragma unroll
                    for (int bj = 0; bj < 2; ++bj)
#pragma unroll
                        for (int n = 0; n < 2; ++n)
#pragma unroll
                            for (int j = 0; j < 4; ++j) { const int vc = bj * HALF + wc * 32 + n * 16 + fq * 4 + j; base[(size_t)vc * stride] = (bf16_t)f2bf(acc[ai][bj][m][n][j]); }
                }
        }
    }
};

struct EpiInProj {
    static constexpr bool WITH_LDS = false, PERM = false;
    bf16_t* R; bf16_t* GB;
    __device__ __forceinline__ void operator()(const f32x4 (&acc)[2][2][4][2], const Unit& u, int wr, int wc, int fr_, int fq_) const {
        int fr = fr_, fq = fq_; asm volatile("" : "+v"(fr), "+v"(fq));
        const bool rec = u.pn >= 5;
        const int col0 = (rec ? (u.pn - 5) * BM : 0) + wc * 32 + fq * 4; const int ldc = rec ? DRNN : 256; bf16_t* O = rec ? R : GB;
#pragma unroll
        for (int ai = 0; ai < 2; ++ai)
#pragma unroll
            for (int m = 0; m < 4; ++m) { bf16_t* rowp = O + (size_t)(u.pm * BM + ai * HALF + wr * 64 + m * 16 + fr) * ldc + col0;
#pragma unroll
                for (int bj = 0; bj < 2; ++bj)
#pragma unroll
                    for (int n = 0; n < 2; ++n) { f32x4 v = acc[ai][bj][m][n];
                        if (!rec) {
#pragma unroll
                            for (int j = 0; j < 4; ++j) { const float x = v[j]; v[j] = x * fsigmoid(1.5957691216057308f * (x + 0.044715f * x * x * x)); } }
                        *(u32x2*)(rowp + bj * HALF + n * 16) = f32_to_bf4(v); } }
    }
};

struct EpiGates {
    static constexpr bool WITH_LDS = false, PERM = false;
    const bf16_t* U; bf16_t* LA; bf16_t* BX; const float* ba; const float* bi; const float* nls;
    __device__ __forceinline__ void operator()(const f32x4 (&acc)[2][2][4][2], const Unit& u, int wr, int wc, int fr_, int fq_) const {
        int fr = fr_, fq = fq_; asm volatile("" : "+v"(fr), "+v"(fq));
        const int tile = u.pn >> 1, dir = tile / 5, blk = tile % 5, chalf = u.pn & 1;
        const int ch0 = blk * 256 + chalf * 128 + wc * 32 + fq * 4;
#pragma unroll
        for (int n = 0; n < 2; ++n) {
            const int ch = ch0 + n * 16;
            const f32x4 bav = *(const f32x4*)(ba + dir * DRNN + ch), biv = *(const f32x4*)(bi + dir * DRNN + ch), nl = *(const f32x4*)(nls + dir * DRNN + ch);
#pragma unroll
            for (int ai = 0; ai < 2; ++ai)
#pragma unroll
                for (int m = 0; m < 4; ++m) {
                    const int rin = ai * HALF + wr * 64 + m * 16 + fr;
                    const size_t rowg = (size_t)u.pm * BM + rin, rowl = (size_t)u.po * BM + rin;
                    const f32x4 uv = bf4_to_f32(*(const u32x2*)(U + rowg * DRNN + ch));
                    f32x4 lav, bxv;
#pragma unroll
                    for (int j = 0; j < 4; ++j) {
                        const float r = fsigmoid(acc[ai][0][m][n][j] + bav[j]);
                        const float ig = fsigmoid(acc[ai][1][m][n][j] + biv[j]);
                        const float la = nl[j] * r, x = 2.0f * la;
                        float om;
                        if (x > -0.5f) { float q = 1.0f / 720.0f; q = q * x + 1.0f / 120.0f; q = q * x + 1.0f / 24.0f; q = q * x + 1.0f / 6.0f; q = q * x + 0.5f; q = q * x + 1.0f; om = -x * q; }
                        else om = 1.0f - __expf(x);
                        lav[j] = la; bxv[j] = __builtin_amdgcn_sqrtf(om) * (ig * uv[j]);
                    }
                    const size_t o = ((size_t)dir * 9216 + rowl) * DRNN + ch;
                    *(u32x2*)(LA + o) = f32_to_bf4(lav); *(u32x2*)(BX + o) = f32_to_bf4(bxv);
                    asm volatile("" ::: "memory");
                }
        }
    }
};

#define SC_STEP(d) \
    "v_fmac_f32_dpp %1, %1, %0 row_shr:" #d " row_mask:0xf bank_mask:0xf\n\t" "v_mul_f32_dpp %0, %0, %0 row_shr:" #d " row_mask:0xf bank_mask:0xf\n\t" \
    "v_fmac_f32_dpp %3, %3, %2 row_shr:" #d " row_mask:0xf bank_mask:0xf\n\t" "v_mul_f32_dpp %2, %2, %2 row_shr:" #d " row_mask:0xf bank_mask:0xf\n\t" \
    "v_fmac_f32_dpp %5, %5, %4 row_shr:" #d " row_mask:0xf bank_mask:0xf\n\t" "v_mul_f32_dpp %4, %4, %4 row_shr:" #d " row_mask:0xf bank_mask:0xf\n\t" \
    "v_fmac_f32_dpp %7, %7, %6 row_shr:" #d " row_mask:0xf bank_mask:0xf\n\t" "v_mul_f32_dpp %6, %6, %6 row_shr:" #d " row_mask:0xf bank_mask:0xf\n\t"
__device__ __forceinline__ void scan16x4(float& a0, float& b0, float& a1, float& b1, float& a2, float& b2, float& a3, float& b3) {
    asm volatile("s_nop 1\n\t" SC_STEP(1) SC_STEP(2) SC_STEP(4) SC_STEP(8)
                 : "+v"(a0), "+v"(b0), "+v"(a1), "+v"(b1), "+v"(a2), "+v"(b2), "+v"(a3), "+v"(b3));
}
struct EpiGatesScan {
    static constexpr bool WITH_LDS = true, PERM = false;
    const bf16_t* U; bf16_t* RECF; bf16_t* RECB; const float* ba; const float* bi; const float* nls; unsigned long long* CARRY;
    __device__ __forceinline__ void run(f32x4 (&acc)[2][2][4][2], const Unit& u, int wr, int wc, int lane_, LAS unsigned char* lds) const {
        int lane = lane_; asm volatile("" : "+v"(lane));
        const int fr = lane & 15, fq = lane >> 4;
        const int tile = u.pn >> 1, dir = tile / 5, blk = tile % 5, chalf = u.pn & 1;
        const int ch0 = blk * 256 + chalf * 128 + wc * 32 + fq * 4;
        const int rmask = dir ? 255 : 0;
        bf16_t* REC = dir ? RECB : RECF;
#pragma unroll
        for (int n = 0; n < 2; ++n) {
            const int ch = ch0 + n * 16;
            const f32x4 bav2 = *(const f32x4*)(ba + dir * DRNN + ch) * (-LOG2E), biv2 = *(const f32x4*)(bi + dir * DRNN + ch) * (-LOG2E), nl = *(const f32x4*)(nls + dir * DRNN + ch);
            const f32x4 nl2 = nl * LOG2E, nlx = nl * 2.0f;
#pragma unroll
            for (int ai = 0; ai < 2; ++ai)
#pragma unroll
                for (int m = 0; m < 4; ++m) {
                    const size_t rowg = (size_t)u.pm * BM + ((ai * HALF + wr * 64 + m * 16 + fr) ^ rmask);
                    const f32x4 uv = bf4_to_f32(*(const u32x2*)(U + rowg * DRNN + ch));
                    float av[4], bv[4];
#pragma unroll
                    for (int j = 0; j < 4; ++j) {
                        const float r = __builtin_amdgcn_rcpf(1.0f + __builtin_amdgcn_exp2f(acc[ai][0][m][n][j] * (-LOG2E) + bav2[j]));
                        const float ig = __builtin_amdgcn_rcpf(1.0f + __builtin_amdgcn_exp2f(acc[ai][1][m][n][j] * (-LOG2E) + biv2[j]));
                        const float x = nlx[j] * r, a = __builtin_amdgcn_exp2f(nl2[j] * r);
                        const float om = (x > -0.0625f) ? -x * (1.0f + x * (0.5f + x * (1.0f / 6.0f + x * (1.0f / 24.0f)))) : 1.0f - a * a;
                        av[j] = a; bv[j] = __builtin_amdgcn_sqrtf(om) * (ig * uv[j]);
                    }
                    scan16x4(av[0], bv[0], av[1], bv[1], av[2], bv[2], av[3], bv[3]);
#pragma unroll
                    for (int j = 0; j < 4; ++j) { acc[ai][0][m][n][j] = av[j]; acc[ai][1][m][n][j] = bv[j]; }
                    __builtin_amdgcn_sched_barrier(0);
                }
        }
        LAS f32x2* segtot = (LAS f32x2*)(lds + 133120);
        LAS float* segcarry = (LAS float*)(lds + 137216);
#pragma unroll
        for (int ai = 0; ai < 2; ++ai)
#pragma unroll
            for (int n = 0; n < 2; ++n) {
                f32x4 As = acc[ai][0][0][n], Bs = acc[ai][1][0][n];
#pragma unroll
                for (int m = 1; m < 4; ++m) { Bs = acc[ai][0][m][n] * Bs + acc[ai][1][m][n]; As = acc[ai][0][m][n] * As; }
                if (fr == 15) {
#pragma unroll
                    for (int j = 0; j < 4; ++j) segtot[(2 * ai + wr) * 128 + wc * 32 + n * 16 + fq * 4 + j] = (f32x2){As[j], Bs[j]};
                }
            }
        asm volatile("s_waitcnt lgkmcnt(0)" ::: "memory"); __builtin_amdgcn_s_barrier(); asm volatile("" ::: "memory");
        const int tid_ = threadIdx.x;
        if (tid_ < 128) {
            float h = 0.0f;
            if (u.po > 0) { unsigned long long* gp = CARRY + (size_t)(u.lin - 160) * 128 + tid_; unsigned long long v; unsigned sp = 0;
                for (;;) { v = __hip_atomic_load(gp, __ATOMIC_RELAXED, __HIP_MEMORY_SCOPE_AGENT); if ((v >> 32) != 0ull) break; __builtin_amdgcn_s_sleep(1); if (++sp > (1u << 22)) break; }
                h = __uint_as_float((unsigned)v); }
#pragma unroll
            for (int sg = 0; sg < 4; ++sg) { segcarry[sg * 128 + tid_] = h; const f32x2 t = segtot[sg * 128 + tid_]; h = t[0] * h + t[1]; }
            if (u.po < 8) __hip_atomic_store(CARRY + (size_t)u.lin * 128 + tid_, (1ull << 32) | (unsigned long long)__float_as_uint(h), __ATOMIC_RELAXED, __HIP_MEMORY_SCOPE_AGENT);
        }
        asm volatile("s_waitcnt lgkmcnt(0)" ::: "memory"); __builtin_amdgcn_s_barrier(); asm volatile("" ::: "memory");
        const bool emit = u.pm < 64;
        const int lastl = (lane & 48) | 15;
        if (emit) {
#pragma unroll
            for (int ai = 0; ai < 2; ++ai) {
                f32x4 hg[2];
#pragma unroll
                for (int n = 0; n < 2; ++n) hg[n] = *(const LAS f32x4*)(segcarry + (2 * ai + wr) * 128 + wc * 32 + n * 16 + fq * 4);
#pragma unroll
                for (int m = 0; m < 4; ++m) {
                    f32x4 h[2];
#pragma unroll
                    for (int n = 0; n < 2; ++n) h[n] = acc[ai][0][m][n] * hg[n] + acc[ai][1][m][n];
                    bf16_t* rp = REC + ((size_t)u.pm * BM + ((ai * HALF + wr * 64 + m * 16 + fr) ^ rmask)) * DRNN + ch0;
#pragma unroll
                    for (int n = 0; n < 2; ++n) *(u32x2*)(rp + n * 16) = f32_to_bf4(h[n]);
                    if (m < 3) {
#pragma unroll
                        for (int n = 0; n < 2; ++n)
#pragma unroll
                            for (int j = 0; j < 4; ++j) hg[n][j] = __shfl(h[n][j], lastl);
                    }
                }
            }
        }
    }
};

struct EpiGateMul {
    static constexpr bool WITH_LDS = false, PERM = false;
    bf16_t* Z; const bf16_t* RB;
    __device__ __forceinline__ void operator()(const f32x4 (&acc)[2][2][4][2], const Unit& u, int wr, int wc, int fr_, int fq_) const {
        int fr = fr_, fq = fq_; asm volatile("" : "+v"(fr), "+v"(fq));
        const int col0 = u.pn * BM + wc * 32 + fq * 4;
#pragma unroll
        for (int ai = 0; ai < 2; ++ai)
#pragma unroll
            for (int m = 0; m < 4; ++m) { bf16_t* rowp = Z + (size_t)(u.pm * BM + ai * HALF + wr * 64 + m * 16 + fr) * DRNN + col0;
#pragma unroll
                for (int bj = 0; bj < 2; ++bj)
#pragma unroll
                    for (int n = 0; n < 2; ++n) { const f32x4 v = acc[ai][bj][m][n]; const f32x4 rc = bf4_to_f32(*(const u32x2*)(rowp + bj * HALF + n * 16)) + bf4_to_f32(*(const u32x2*)(RB + (rowp - Z) + bj * HALF + n * 16)); f32x4 o;
#pragma unroll
                        for (int j = 0; j < 4; ++j) { const float x = v[j]; const float z2 = 1.5957691216057308f * (x + 0.044715f * x * x * x); o[j] = x * fsigmoid(z2) * rc[j]; }
                        *(u32x2*)(rowp + bj * HALF + n * 16) = f32_to_bf4(o); }
                asm volatile("" ::: "memory"); }
    }
};
}


#define XB_TMO      128
#define XB_XCNT(j)  (256  + 64 * (j))
#define XB_XSUB(j)  (1280 + 64 * (j))
#define XB_XGEN(j)  (2304 + 64 * (j))
#define XB_TOP      3328
#define XB_TOPGEN   3392
#define XCD_BAR_WORDS 3456
#define XB_SPIN_CAP (1u << 18)
__device__ __forceinline__ unsigned xb_ld(unsigned* p)              { return __hip_atomic_load(p, __ATOMIC_RELAXED, __HIP_MEMORY_SCOPE_AGENT); }
__device__ __forceinline__ unsigned xb_add(unsigned* p, unsigned v) { return __hip_atomic_fetch_add(p, v, __ATOMIC_RELAXED, __HIP_MEMORY_SCOPE_AGENT); }
__device__ __forceinline__ unsigned xb_xcc_id() { return (unsigned)__builtin_amdgcn_s_getreg((3 << 11) | 20) & 0xFu; }
#define XB_SPIN(cond, bar) do { unsigned _sp = 0; while (cond) { __builtin_amdgcn_s_sleep(1); \
    if ((++_sp & 255u) == 0u) { if (xb_ld(&(bar)[XB_TMO])) break; if (_sp > XB_SPIN_CAP) { atomicAdd(&(bar)[XB_TMO], 1u); break; } } } } while (0)
struct XcdBarrier { unsigned* bar; unsigned x; volatile LAS unsigned* st; };
__device__ __forceinline__ XcdBarrier xcd_barrier_post(unsigned* bar, volatile LAS unsigned* st) {
    XcdBarrier b; b.bar = bar; b.x = xb_xcc_id(); b.st = st;
    if (threadIdx.x == 0) (void)xb_add(&bar[XB_XCNT(b.x)], 1u);
    return b;
}
__device__ __forceinline__ void xcd_barrier_complete(unsigned* bar, unsigned x, unsigned& nloc, unsigned& nx) {
    const unsigned G = gridDim.x * gridDim.y * gridDim.z;
    unsigned sum, cnt, mine, sp = 0u;
    for (;;) {
        sum = 0u; cnt = 0u; mine = 0u;
#pragma unroll
        for (unsigned j = 0; j < 16; ++j) { const unsigned c = xb_ld(&bar[XB_XCNT(j)]); sum += c; cnt += (c > 0u) ? 1u : 0u; mine = (j == x) ? c : mine; }
        if (sum == G) break;
        __builtin_amdgcn_s_sleep(1);
        if ((++sp & 255u) == 0u) { if (xb_ld(&bar[XB_TMO])) break; if (sp > XB_SPIN_CAP) { atomicAdd(&bar[XB_TMO], 1u); break; } }
    }
    nloc = mine > 0u ? mine : 1u; nx = cnt > 0u ? cnt : 1u;
}
__device__ __forceinline__ void xcd_barrier(const XcdBarrier& b) {
    asm volatile("s_waitcnt vmcnt(0)" ::: "memory");
    __syncthreads();
    if (threadIdx.x == 0) {
        unsigned* bar = b.bar;
        __builtin_amdgcn_s_waitcnt(0);
        unsigned nloc = b.st[0], nx = b.st[1];
        if (nloc == 0u) { xcd_barrier_complete(bar, b.x, nloc, nx); b.st[0] = nloc; b.st[1] = nx; }
        const unsigned old = xb_add(&bar[XB_XSUB(b.x)], 1u);
        const unsigned gen = old / nloc;
        if (old + 1u == (gen + 1u) * nloc) {
            __builtin_amdgcn_fence(__ATOMIC_RELEASE, "agent");
            asm volatile("s_waitcnt vmcnt(0)" ::: "memory");
            const unsigned og = xb_add(&bar[XB_TOP], 1u);
            const unsigned tg = og / nx;
            if (og + 1u == (tg + 1u) * nx) xb_add(&bar[XB_TOPGEN], 1u);
            else XB_SPIN(xb_ld(&bar[XB_TOPGEN]) == tg, bar);
            __builtin_amdgcn_fence(__ATOMIC_ACQUIRE, "agent");
            xb_add(&bar[XB_XGEN(b.x)], 1u);
            asm volatile("s_waitcnt vmcnt(0)" ::: "memory");
        } else {
            XB_SPIN(xb_ld(&bar[XB_XGEN(b.x)]) == gen, bar);
            __builtin_amdgcn_fence(__ATOMIC_ACQUIRE, "agent");
            asm volatile("s_waitcnt vmcnt(0)" ::: "memory");
        }
    }
    __syncthreads();
}

struct Params {
    const float *x, *c, *ctx, *c_ctx, *ada_w, *ada_b, *norm_g, *mlp_w1, *mlp_w2, *w_qkv, *w_o, *sink;
    const float *w_in, *conv_w, *conv_b, *w_a, *b_a, *w_i, *b_i, *lam, *w_out;
    float* out; unsigned char* ws;
};

typedef const __attribute__((address_space(4))) Params* ParamsK;
__device__ __forceinline__ void transpose_item(const float* W, int ldw, bf16_t* WT, int ldwt, int k0, int n0, int dst_row0, LAS float* scr, int lane) {
#pragma unroll 8
    for (int i = 0; i < 32; ++i) { const int kk = 2 * i + (lane >> 5); scr[kk * 33 + (lane & 31)] = W[(size_t)(k0 + kk) * ldw + n0 + (lane & 31)]; }
    asm volatile("s_waitcnt lgkmcnt(0)" ::: "memory");
    const int c = lane & 7;
#pragma unroll
    for (int j = 0; j < 4; ++j) { const int n = (lane >> 3) + 8 * j; const LAS float* s = scr + (8 * c) * 33 + n;
        u32x4 o; o.x = cvt_pk_bf16(s[0 * 33], s[1 * 33]); o.y = cvt_pk_bf16(s[2 * 33], s[3 * 33]); o.z = cvt_pk_bf16(s[4 * 33], s[5 * 33]); o.w = cvt_pk_bf16(s[6 * 33], s[7 * 33]);
        *(u32x4*)(WT + (size_t)(dst_row0 + n) * ldwt + k0 + 8 * c) = o; }
    asm volatile("s_waitcnt lgkmcnt(0)" ::: "memory");
}
__device__ __forceinline__ void transpose_plain(const float* W, int K, int N, bf16_t* WT, int r, LAS float* scr, int lane) {
    const int nblk = N / 32, kb = r / nblk, nb = r % nblk;
    transpose_item(W, N, WT, K, 64 * kb, 32 * nb, 32 * nb, scr, lane);
}

constexpr int I_QKV = 16 * 48, I_O = 16 * 32, I_1 = 16 * 128, I_2 = 64 * 32, I_IN = 16 * 80, I_OUT = 20 * 32, I_G = 40 * 16;
constexpr int TR_L0 = I_QKV + I_O + I_1 + I_2, TR_LRU = I_IN + I_OUT + I_G, TR_MLP1 = I_1 + I_2;
struct TrItem { const float* W; bf16_t* WT; int ldw, ldwt, k0, n0, drow; };
__device__ __forceinline__ TrItem tr_decode(ParamsK p, unsigned char* ws, int it) {
    TrItem d; int r = it;
#define TR_PLAIN(Wp, K_, N_, WTp) do { const int nblk_ = (N_) / 32, kb_ = r / nblk_, nb_ = r % nblk_; d.W = (Wp); d.WT = (WTp); d.ldw = (N_); d.ldwt = (K_); d.k0 = 64 * kb_; d.n0 = 32 * nb_; d.drow = 32 * nb_; return d; } while (0)
    if (r < I_QKV) TR_PLAIN(p->w_qkv, 1024, NQKV, (bf16_t*)(ws + WS_WQKV)); r -= I_QKV;
    if (r < I_O) TR_PLAIN(p->w_o, 1024, 1024, (bf16_t*)(ws + WS_WO)); r -= I_O;
    if (r < I_1) TR_PLAIN(p->mlp_w1, 1024, DFF, (bf16_t*)(ws + WS_W1)); r -= I_1;
    if (r < I_2) TR_PLAIN(p->mlp_w2, DFF, 1024, (bf16_t*)(ws + WS_W2)); r -= I_2;
    if (r < I_IN) TR_PLAIN(p->w_in, 1024, 2 * DRNN, (bf16_t*)(ws + WS_WIN)); r -= I_IN;
    if (r < I_OUT) TR_PLAIN(p->w_out, DRNN, 1024, (bf16_t*)(ws + WS_WOUT)); r -= I_OUT;
    if (r < I_G) {
        const int sm = r >> 4, ii = r & 15, kb = ii >> 2, nb = ii & 3;
        const int chalf = sm & 1, blk = (sm >> 1) % 5, dg = (sm >> 1) / 5, gate = dg & 1, dir = dg >> 1;
        d.W = (gate ? p->w_i : p->w_a) + (size_t)(dir * 5 + blk) * 256 * 256; d.WT = (bf16_t*)(ws + WS_WG); d.ldw = 256; d.ldwt = 256;
        d.k0 = 64 * kb; d.n0 = chalf * 128 + nb * 32; d.drow = ((dir * 5 + blk) * 2 + chalf) * 256 + gate * 128 + nb * 32; return d; }
    r -= I_G;
    if (r < I_1) TR_PLAIN(p->mlp_w1 + (size_t)1024 * DFF, 1024, DFF, (bf16_t*)(ws + WS_W1 + 16 * MiB)); r -= I_1;
    TR_PLAIN(p->mlp_w2 + (size_t)1024 * DFF, DFF, 1024, (bf16_t*)(ws + WS_W2 + 16 * MiB));
#undef TR_PLAIN
}
__device__ __forceinline__ void transpose_range(ParamsK p, unsigned char* ws, LAS unsigned char* lds, int first, int count, int w, int nw, int wave, int lane) {
    LAS float* scr = (LAS float*)(lds + wave * 16384);
    int it = first + w; if (it >= first + count) return;
    float cur[32], nxt[32];
    TrItem d = tr_decode(p, ws, it);
#pragma unroll
    for (int i = 0; i < 32; ++i) cur[i] = d.W[(size_t)(d.k0 + 2 * i + (lane >> 5)) * d.ldw + d.n0 + (lane & 31)];
    for (;;) {
        const int itn = it + nw; const bool more = itn < first + count;
        TrItem dn = d;
        if (more) { dn = tr_decode(p, ws, itn);
#pragma unroll
            for (int i = 0; i < 32; ++i) nxt[i] = dn.W[(size_t)(dn.k0 + 2 * i + (lane >> 5)) * dn.ldw + dn.n0 + (lane & 31)]; }
#pragma unroll
        for (int i = 0; i < 32; ++i) scr[(2 * i + (lane >> 5)) * 33 + (lane & 31)] = cur[i];
        asm volatile("s_waitcnt lgkmcnt(0)" ::: "memory");
        const int c = lane & 7;
#pragma unroll
        for (int j = 0; j < 4; ++j) { const int n = (lane >> 3) + 8 * j; const LAS float* s = scr + (8 * c) * 33 + n;
            u32x4 o; o.x = cvt_pk_bf16(s[0 * 33], s[1 * 33]); o.y = cvt_pk_bf16(s[2 * 33], s[3 * 33]); o.z = cvt_pk_bf16(s[4 * 33], s[5 * 33]); o.w = cvt_pk_bf16(s[6 * 33], s[7 * 33]);
            *(u32x4*)(d.WT + (size_t)(d.drow + n) * d.ldwt + d.k0 + 8 * c) = o; }
        asm volatile("s_waitcnt lgkmcnt(0)" ::: "memory");
        if (!more) break;
#pragma unroll
        for (int i = 0; i < 32; ++i) cur[i] = nxt[i];
        d = dn; it = itn;
    }
}
__device__ __forceinline__ void idle_transposes(ParamsK p, unsigned char* ws, LAS unsigned char* lds, int first, int count, int nwg, int G, int bid, int wave, int lane) {
    const int rem = nwg % G;
    if (rem == 0) transpose_range(p, ws, lds, first, count, bid * 8 + wave, G * 8, wave, lane);
    else if (bid >= rem) transpose_range(p, ws, lds, first, count, (bid - rem) * 8 + wave, (G - rem) * 8, wave, lane);
    __syncthreads();
}

__device__ __forceinline__ void prologue(ParamsK p, LAS unsigned char* lds, int tid, int lane, int wave) {
    unsigned char* ws = p->ws;
    float* MOD = (float*)(ws + WS_MOD);
    if (blockIdx.x < 192) {
        LAS float* sl = (LAS float*)lds;
        LAS float* red = (LAS float*)(lds + 36864);
        for (int idx = tid; idx < 9216; idx += 512) { const int w = idx >> 10, k = idx & 1023; const float v = (w < 8) ? p->c[w * 1024 + k] : p->c_ctx[k]; sl[idx] = v / (1.0f + __expf(-v)); }
        __syncthreads();
        const int l = blockIdx.x / 96, n0 = (blockIdx.x % 96) * 64, kg = tid >> 4, cq = tid & 15;
        f32x4 acc[9];
#pragma unroll
        for (int w = 0; w < 9; ++w) acc[w] = (f32x4){0.f, 0.f, 0.f, 0.f};
        const float* wb = p->ada_w + (size_t)l * 1024 * 6144 + n0 + cq * 4;
#pragma unroll 1
        for (int it0 = 0; it0 < 32; it0 += 8) {
            f32x4 w4[8];
#pragma unroll
            for (int u = 0; u < 8; ++u) w4[u] = *(const f32x4*)(wb + (size_t)((it0 + u) * 32 + kg) * 6144);
#pragma unroll
            for (int u = 0; u < 8; ++u) { const int k = (it0 + u) * 32 + kg;
#pragma unroll
                for (int w = 0; w < 9; ++w) acc[w] += sl[w * 1024 + k] * w4[u]; }
        }
#pragma unroll
        for (int w = 0; w < 9; ++w) *(LAS f32x4*)(red + (kg * 9 + w) * 64 + cq * 4) = acc[w];
        __syncthreads();
        for (int idx = tid; idx < 9 * 64; idx += 512) { const int w = idx >> 6, n = idx & 63; float s = 0.f;
#pragma unroll
            for (int g = 0; g < 32; ++g) s += red[(g * 9 + w) * 64 + n];
            MOD[(size_t)(l * 9 + w) * 6144 + n0 + n] = s + p->ada_b[l * 6144 + n0 + n]; }
        __syncthreads();
    }
    if (blockIdx.x == gridDim.x - 1) {
        float* rope = (float*)(ws + WS_ROPE); float* nls = (float*)(ws + WS_NLS);
        for (int idx = tid; idx < 1024; idx += 512) { const int pos = idx >> 4, i = idx & 15;
            const float inv = __builtin_exp2f(-(float)i * (13.287712379549449f / 16.0f));
            const float angf = (float)pos * inv; const double ang = (double)angf;
            const double twopi = 6.283185307179586476925287; const double r = ang - twopi * __builtin_rint(ang / twopi);
            const double r2 = r * r; double cterm = 1.0, sterm = r, cs = 1.0, sn = r;
            for (int k = 1; k <= 14; ++k) { cterm *= -r2 / (double)((2 * k - 1) * (2 * k)); sterm *= -r2 / (double)((2 * k) * (2 * k + 1)); cs += cterm; sn += sterm; }
            rope[idx * 2] = (float)cs; rope[idx * 2 + 1] = (float)sn; }
        for (int idx = tid; idx < 2 * DRNN; idx += 512) { const float lm = p->lam[idx]; nls[idx] = -8.0f * log1pf(__expf(-lm)); }
        { unsigned* fl = (unsigned*)(ws + WS_FLAG); for (int idx = tid; idx < 1440 * 16; idx += 512) fl[idx] = 0u; }
    }
    transpose_range(p, ws, lds, 0, TR_L0 + TR_LRU + TR_MLP1, blockIdx.x * 8 + wave, gridDim.x * 8, wave, lane);
}

template <bool HAS_Y, bool HAS_H, bool XIN_BF, bool XOUT_BF>
__device__ __forceinline__ void row_phase(const void* xin_lat, const void* xin_ctx, void* xout_lat, void* xout_ctx, const bf16_t* Y, const bf16_t* SLAB, bf16_t* H,
                                          const float* gy, const float* gh, const float* mod_g, int gate_idx, const float* mod_h, int shift_idx, int scale_idx,
                                          int nrows, int gw, int ngw, int lane) {
    const int rpw = (nrows + ngw - 1) / ngw, r_begin = gw * rpw, r_end = (r_begin + rpw < nrows) ? r_begin + rpw : nrows;
    f32x4 xn[4]; u32x2 xb[4], yn[4], ys[3][4];
    f32x4 vgy[4], vgh[4], vgt[4], vsh[4], vsc[4];
#pragma unroll
    for (int j = 0; j < 4; ++j) { if (HAS_Y) vgy[j] = *(const f32x4*)(gy + lane * 4 + 256 * j); if (HAS_H) vgh[j] = *(const f32x4*)(gh + lane * 4 + 256 * j); }
    int cur_who = -1;
#define ROW_LOAD(r) do { const int r_ = (r); const bool lat_ = r_ < ML; const size_t ro_ = lat_ ? (size_t)r_ * DM : (size_t)(r_ - ML) * DM; \
        if (XIN_BF) { const bf16_t* xi_ = (const bf16_t*)(lat_ ? xin_lat : xin_ctx) + ro_; _Pragma("unroll") for (int j = 0; j < 4; ++j) xb[j] = *(const u32x2*)(xi_ + lane * 4 + 256 * j); } \
        else { const float* xi_ = (const float*)(lat_ ? xin_lat : xin_ctx) + ro_; _Pragma("unroll") for (int j = 0; j < 4; ++j) xn[j] = *(const f32x4*)(xi_ + lane * 4 + 256 * j); } \
        if (HAS_Y) { if (SLAB != nullptr && !lat_) { const bf16_t* yp_ = SLAB + (size_t)(r_ - ML) * DM + lane * 4; \
                _Pragma("unroll") for (int j = 0; j < 4; ++j) { yn[j] = *(const u32x2*)(yp_ + 256 * j); ys[0][j] = *(const u32x2*)(yp_ + 256 * j + (size_t)MC * DM); ys[1][j] = *(const u32x2*)(yp_ + 256 * j + (size_t)2 * MC * DM); ys[2][j] = *(const u32x2*)(yp_ + 256 * j + (size_t)3 * MC * DM); } } \
            else { _Pragma("unroll") for (int j = 0; j < 4; ++j) yn[j] = *(const u32x2*)(Y + (size_t)r_ * DM + lane * 4 + 256 * j); } } } while (0)
    if (r_begin < r_end) ROW_LOAD(r_begin);
    for (int row = r_begin; row < r_end; ++row) {
        const bool lat = row < ML; const int who = lat ? (row >> 11) : 8;
        if (who != cur_who) { cur_who = who;
#pragma unroll
            for (int j = 0; j < 4; ++j) { const int col = lane * 4 + 256 * j;
                if (HAS_Y) vgt[j] = *(const f32x4*)(mod_g + (size_t)who * 6144 + gate_idx * 1024 + col);
                if (HAS_H) { vsh[j] = *(const f32x4*)(mod_h + (size_t)who * 6144 + shift_idx * 1024 + col); vsc[j] = *(const f32x4*)(mod_h + (size_t)who * 6144 + scale_idx * 1024 + col) + 1.0f; } } }
        f32x4 xv[4], yv[4];
#pragma unroll
        for (int j = 0; j < 4; ++j) xv[j] = XIN_BF ? bf4_to_f32(xb[j]) : xn[j];
        if (HAS_Y) {
#pragma unroll
            for (int j = 0; j < 4; ++j) { yv[j] = bf4_to_f32(yn[j]);
                if (SLAB != nullptr && !lat) yv[j] = (yv[j] + bf4_to_f32(ys[0][j])) + (bf4_to_f32(ys[1][j]) + bf4_to_f32(ys[2][j])); }
        }
        asm volatile("" ::: "memory");
        if (row + 1 < r_end) ROW_LOAD(row + 1);
        if (HAS_Y) {
            float s = 0.f;
#pragma unroll
            for (int j = 0; j < 4; ++j) s += (yv[j][0] * yv[j][0] + yv[j][1] * yv[j][1]) + (yv[j][2] * yv[j][2] + yv[j][3] * yv[j][3]);
            const float rstd = 1.0f / sqrtf(wave_sum(s) * (1.0f / DM) + EPS);
            const size_t ro = lat ? (size_t)row * DM : (size_t)(row - ML) * DM;
#pragma unroll
            for (int j = 0; j < 4; ++j) { xv[j] = xv[j] + vgt[j] * (yv[j] * rstd * vgy[j]);
                if (XOUT_BF) { const u32x2 w = f32_to_bf4(xv[j]); *(u32x2*)((bf16_t*)(lat ? xout_lat : xout_ctx) + ro + lane * 4 + 256 * j) = w; xv[j] = bf4_to_f32(w); }
                else *(f32x4*)((float*)(lat ? xout_lat : xout_ctx) + ro + lane * 4 + 256 * j) = xv[j]; }
        }
        if (HAS_H) {
            float s = 0.f;
#pragma unroll
            for (int j = 0; j < 4; ++j) s += (xv[j][0] * xv[j][0] + xv[j][1] * xv[j][1]) + (xv[j][2] * xv[j][2] + xv[j][3] * xv[j][3]);
            const float rstd = 1.0f / sqrtf(wave_sum(s) * (1.0f / DM) + EPS);
#pragma unroll
            for (int j = 0; j < 4; ++j) { const f32x4 hv = (xv[j] * rstd * vgh[j]) * vsc[j] + vsh[j]; *(u32x2*)(H + (size_t)row * DM + lane * 4 + 256 * j) = f32_to_bf4(hv); }
        }
    }
#undef ROW_LOAD
}

__device__ __forceinline__ void attn_phase(LAS unsigned char* lds, const bf16_t* Q, bf16_t* O, const bf16_t* Kb, const bf16_t* VT, const bf16_t* VTC, const float* sink, int tid, int lane, int wave) {
    constexpr int PITCH = 72;
    LAS bf16_t* Ks = (LAS bf16_t*)lds;
    LAS bf16_t* Vs = (LAS bf16_t*)(lds + 2 * 64 * PITCH * 2);
    const int lr = lane & 15, lg = lane >> 4;
    const int skey = tid >> 3, spiece = tid & 7;
    for (int unit = blockIdx.x; unit < 576; unit += gridDim.x) {
        int b, kvh, qrow0, qblk, nloc, lt0; bool latu = unit < 512;
        if (latu) { b = unit >> 6; const int rem = unit & 63; qblk = rem >> 2; kvh = rem & 3; qrow0 = b * SEQ + qblk * 128; lt0 = (qblk == 0) ? 2 : 0; nloc = ((qblk == 15) ? 4 : 6) - lt0; }
        else { const int cu = unit - 512; b = cu >> 3; kvh = (cu & 7) >> 1; qblk = 0; qrow0 = ML + b * CTX + (cu & 1) * 128; lt0 = 0; nloc = 0; }
        const int nlo = (latu && qblk > 0) ? 2 : 0, nmid = latu ? 2 : 0, nup = (latu && qblk < 15) ? 2 : 0;
        const int n1 = nlo, n2 = nlo + nmid, n3 = n2 + 4, nT = n3 + nup; (void)nloc; (void)lt0;
        const int head = kvh * 4 + (wave >> 1);
        const int qr0 = qrow0 + (wave & 1) * 64;
        const bf16_t* qbase = Q + (size_t)qr0 * 1024 + head * 64;
        bf16_t* obase = O + (size_t)qr0 * 1024 + head * 64;
        LAS unsigned char* Qs = lds + 40960 + wave * 8192;
#pragma unroll
        for (int qt = 0; qt < 4; ++qt)
#pragma unroll
            for (int dh = 0; dh < 2; ++dh) *(LAS bf16x8*)(Qs + (qt * 2 + dh) * 1024 + lane * 16) = *(const bf16x8*)(qbase + (unsigned)((qt * 16 + lr) * 1024 + dh * 32 + lg * 8));
        f32x4 o[4][4];
#pragma unroll
        for (int qt = 0; qt < 4; ++qt)
#pragma unroll
            for (int dt = 0; dt < 4; ++dt) o[qt][dt] = (f32x4){0.f, 0.f, 0.f, 0.f};
        float m2[4], ls[4];
        { const float sk = sink[head] * LOG2E;
#pragma unroll
          for (int qt = 0; qt < 4; ++qt) { m2[qt] = sk; ls[qt] = (lg == 0) ? 1.0f : 0.0f; } }
        u32x4 kreg, vreg;
#define ATT_TOK0(j_) ((qblk - 1) * 128 + (((j_) < n1) ? (j_) : (((j_) < n2) ? 2 + (j_) - n1 : 4 + (j_) - n3)) * 64)
#define ATT_LOAD(j) do { const int _j = (j); if (_j < n2 || _j >= n3) { const int tok0 = ATT_TOK0(_j); \
                const bf16_t* kb_ = Kb + (size_t)(b * SEQ + tok0) * 256 + kvh * 64; const bf16_t* vb_ = VT + (size_t)(b * 4 + kvh) * 64 * SEQ + tok0; \
                kreg = *(const u32x4*)(kb_ + (unsigned)(skey * 256 + spiece * 8)); vreg = *(const u32x4*)(vb_ + (unsigned)(skey * SEQ + spiece * 8)); } \
            else { const int tok0 = (_j - n2) * 64; \
                const bf16_t* kb_ = Kb + (size_t)(ML + b * CTX + tok0) * 256 + kvh * 64; const bf16_t* vb_ = VTC + (size_t)(b * 4 + kvh) * 64 * CTX + tok0; \
                kreg = *(const u32x4*)(kb_ + (unsigned)(skey * 256 + spiece * 8)); vreg = *(const u32x4*)(vb_ + (unsigned)(skey * CTX + spiece * 8)); } } while (0)
#define ATT_STORE(buf) do { *(LAS u32x4*)(Ks + (buf) * 64 * PITCH + skey * PITCH + spiece * 8) = kreg; *(LAS u32x4*)(Vs + (buf) * 64 * PITCH + skey * PITCH + spiece * 8) = vreg; } while (0)
        __syncthreads();
        ATT_LOAD(0); ATT_STORE(0);
        __syncthreads();
#define ATT_BODY(MM) { \
            const int buf = j & 1; \
            if (j + 1 < nT) ATT_LOAD(j + 1); \
            const LAS bf16_t* Kt = Ks + buf * 64 * PITCH; const LAS bf16_t* Vt = Vs + buf * 64 * PITCH; \
            const int ktok0 = ATT_TOK0(j); \
            bf16x8 kf[4][2]; \
            _Pragma("unroll") \
            for (int ks = 0; ks < 4; ++ks) \
            _Pragma("unroll") \
                for (int dh = 0; dh < 2; ++dh) kf[ks][dh] = *(const LAS bf16x8*)(Kt + (ks * 16 + lr) * PITCH + dh * 32 + lg * 8); \
            _Pragma("unroll") \
            for (int hq = 0; hq < 2; ++hq) { \
            bf16x8 pb[2][2]; \
            _Pragma("unroll") \
            for (int q2 = 0; q2 < 2; ++q2) { \
                const int qt = hq * 2 + q2; \
                f32x4 s[4]; \
                const bf16x8 qf0 = *(const LAS bf16x8*)(Qs + (qt * 2 + 0) * 1024 + lane * 16), qf1 = *(const LAS bf16x8*)(Qs + (qt * 2 + 1) * 1024 + lane * 16); \
            _Pragma("unroll") \
                for (int ks = 0; ks < 4; ++ks) { s[ks] = __builtin_amdgcn_mfma_f32_16x16x32_bf16(kf[ks][0], qf0, (f32x4){0.f, 0.f, 0.f, 0.f}, 0, 0, 0); \
                    s[ks] = __builtin_amdgcn_mfma_f32_16x16x32_bf16(kf[ks][1], qf1, s[ks], 0, 0, 0); } \
                if (MM == 1) {    \
                    const int lim = qblk * 128 + (wave & 1) * 64 + qt * 16 + lr - 128 - ktok0 - lg * 4; \
            _Pragma("unroll") \
                    for (int ks = 0; ks < 4; ++ks) \
            _Pragma("unroll") \
                        for (int jj = 0; jj < 4; ++jj) s[ks][jj] = (ks * 16 + jj >= lim) ? s[ks][jj] : -1e30f; \
                } else if (MM == 2) {    \
                    const int lim = qblk * 128 + (wave & 1) * 64 + qt * 16 + lr + 128 - ktok0 - lg * 4; \
            _Pragma("unroll") \
                    for (int ks = 0; ks < 4; ++ks) \
            _Pragma("unroll") \
                        for (int jj = 0; jj < 4; ++jj) s[ks][jj] = (ks * 16 + jj <= lim) ? s[ks][jj] : -1e30f; \
                } \
                float mx = -3e38f; \
            _Pragma("unroll") \
                for (int ks = 0; ks < 4; ++ks) mx = fmaxf(mx, fmaxf(fmaxf(s[ks][0], s[ks][1]), fmaxf(s[ks][2], s[ks][3]))); \
                mx = fmaxf(mx, __shfl_xor(mx, 16)); mx = fmaxf(mx, __shfl_xor(mx, 32)); \
                const float mnew = fmaxf(m2[qt], mx * LOG2E); \
                const float alpha = __builtin_amdgcn_exp2f(m2[qt] - mnew); \
                m2[qt] = mnew; \
                float rs = 0.f; \
            _Pragma("unroll") \
                for (int ks = 0; ks < 4; ++ks) \
            _Pragma("unroll") \
                    for (int jj = 0; jj < 4; ++jj) { const float pv = __builtin_amdgcn_exp2f(s[ks][jj] * LOG2E - mnew); s[ks][jj] = pv; rs += pv; } \
                ls[qt] = ls[qt] * alpha + rs; \
            _Pragma("unroll") \
                for (int dt = 0; dt < 4; ++dt) o[qt][dt] = o[qt][dt] * alpha; \
            _Pragma("unroll") \
                for (int c2 = 0; c2 < 2; ++c2) { u32x4 w; w.x = cvt_pk_bf16(s[2 * c2][0], s[2 * c2][1]); w.y = cvt_pk_bf16(s[2 * c2][2], s[2 * c2][3]); w.z = cvt_pk_bf16(s[2 * c2 + 1][0], s[2 * c2 + 1][1]); w.w = cvt_pk_bf16(s[2 * c2 + 1][2], s[2 * c2 + 1][3]); \
                    pb[q2][c2] = __builtin_bit_cast(bf16x8, w); } \
            } \
            _Pragma("unroll") \
            for (int c2 = 0; c2 < 2; ++c2) \
            _Pragma("unroll") \
                for (int dt = 0; dt < 4; ++dt) { \
                    const LAS bf16_t* vp = Vt + (dt * 16 + lr) * PITCH + c2 * 32 + lg * 4; \
                    const u32x2 v0 = *(const LAS u32x2*)vp, v1 = *(const LAS u32x2*)(vp + 16); \
                    const u32x4 vv = {v0.x, v0.y, v1.x, v1.y}; \
                    const bf16x8 vf = __builtin_bit_cast(bf16x8, vv); \
            _Pragma("unroll") \
                    for (int q2 = 0; q2 < 2; ++q2) o[hq * 2 + q2][dt] = __builtin_amdgcn_mfma_f32_16x16x32_bf16(vf, pb[q2][c2], o[hq * 2 + q2][dt], 0, 0, 0); \
                } \
            } \
            if (j + 1 < nT) ATT_STORE(buf ^ 1); \
            __syncthreads(); \
        }
        int j = 0;
#pragma unroll 1
        for (; j < n1; ++j) ATT_BODY(1)
#pragma unroll 1
        for (; j < n3; ++j) ATT_BODY(0)
#pragma unroll 1
        for (; j < nT; ++j) ATT_BODY(2)
#undef ATT_BODY
#pragma unroll
        for (int qt = 0; qt < 4; ++qt) {
            float l = ls[qt]; l += __shfl_xor(l, 16); l += __shfl_xor(l, 32);
            const float inv = 1.0f / l;
            int lro = lr * 1024 + lg * 4; asm volatile("" : "+v"(lro));
            bf16_t* op = obase + (unsigned)(qt * 16 * 1024 + lro);
#pragma unroll
            for (int dt = 0; dt < 4; ++dt) *(u32x2*)(op + dt * 16) = f32_to_bf4(o[qt][dt] * inv);
        }
    }
#undef ATT_LOAD
#undef ATT_TOK0
#undef ATT_STORE
}

__device__ __forceinline__ void conv_phase(const bf16_t* R, bf16_t* U, const float* cw, const float* cb, int gtid, int nthreads) {
    for (int idx = gtid; idx < MT * 160; idx += nthreads) {
        const int row = idx / 160, ch = (idx % 160) * 8;
        int t, T; if (row < ML) { t = row & 2047; T = SEQ; } else { t = (row - ML) & 255; T = CTX; }
        float acc[8];
        { const f32x4 b0 = *(const f32x4*)(cb + ch), b1 = *(const f32x4*)(cb + ch + 4); acc[0] = b0[0]; acc[1] = b0[1]; acc[2] = b0[2]; acc[3] = b0[3]; acc[4] = b1[0]; acc[5] = b1[1]; acc[6] = b1[2]; acc[7] = b1[3]; }
#pragma unroll
        for (int tap = 0; tap < 4; ++tap) { const int tt = t + tap - 2;
            if (tt >= 0 && tt < T) { const u32x4 rv = *(const u32x4*)(R + (size_t)(row + tap - 2) * DRNN + ch);
                const f32x4 w0 = *(const f32x4*)(cw + tap * DRNN + ch), w1 = *(const f32x4*)(cw + tap * DRNN + ch + 4);
                acc[0] += w0[0] * bf_lo(rv.x); acc[1] += w0[1] * bf_hi(rv.x); acc[2] += w0[2] * bf_lo(rv.y); acc[3] += w0[3] * bf_hi(rv.y);
                acc[4] += w1[0] * bf_lo(rv.z); acc[5] += w1[1] * bf_hi(rv.z); acc[6] += w1[2] * bf_lo(rv.w); acc[7] += w1[3] * bf_hi(rv.w); } }
        u32x4 o; o.x = cvt_pk_bf16(acc[0], acc[1]); o.y = cvt_pk_bf16(acc[2], acc[3]); o.z = cvt_pk_bf16(acc[4], acc[5]); o.w = cvt_pk_bf16(acc[6], acc[7]);
        *(u32x4*)(U + (size_t)row * DRNN + ch) = o;
    }
}
__device__ __forceinline__ int scan_row0(int bl, int c) { return (c < 8) ? (8192 + bl * CTX + c * 32) : (bl * SEQ + (c - 8) * 32); }
__device__ __forceinline__ void scanA_phase(const bf16_t* LA, const bf16_t* BX, float* SP, float* SH, int gtid, int nthreads) {
    for (int idx = gtid; idx < 2 * 4 * 72 * 640; idx += nthreads) {
        const int cp = idx % 640, r1 = idx / 640, c = r1 % 72, r2 = r1 / 72, bl = r2 & 3, dir = r2 >> 2;
        const int row0 = scan_row0(bl, c);
        const size_t base = ((size_t)dir * 9216 + row0) * DRNN + cp * 2;
        float P0 = 1.f, P1 = 1.f, H0 = 0.f, H1 = 0.f;
#pragma unroll 8
        for (int i = 0; i < 32; ++i) { const int ii = dir ? (31 - i) : i;
            const unsigned lw = *(const unsigned*)(LA + base + (size_t)ii * DRNN), bw = *(const unsigned*)(BX + base + (size_t)ii * DRNN);
            const float a0 = __expf(bf_lo(lw)), a1 = __expf(bf_hi(lw));
            P0 *= a0; P1 *= a1; H0 = a0 * H0 + bf_lo(bw); H1 = a1 * H1 + bf_hi(bw); }
        const size_t so = ((size_t)(dir * 4 + bl) * 72 + c) * DRNN + cp * 2;
        *(f32x2*)(SP + so) = (f32x2){P0, P1}; *(f32x2*)(SH + so) = (f32x2){H0, H1};
    }
}
__device__ __forceinline__ void scanB_phase(const float* SP, const float* SH, float* CIN, int gtid, int nthreads) {
    for (int idx = gtid; idx < 2 * 4 * DRNN; idx += nthreads) {
        const int ch = idx % DRNN, r = idx / DRNN, bl = r & 3, dir = r >> 2;
        const size_t base = ((size_t)(dir * 4 + bl) * 72) * DRNN + ch;
        float carry = 0.f;
#pragma unroll 1
        for (int s0 = 0; s0 < 72; s0 += 24) {
            float pv[24], hv[24];
#pragma unroll
            for (int s = 0; s < 24; ++s) { const int sq = s0 + s; const int c = dir ? (sq < 8 ? 7 - sq : 79 - sq) : sq; pv[s] = SP[base + (size_t)c * DRNN]; hv[s] = SH[base + (size_t)c * DRNN]; }
#pragma unroll
            for (int s = 0; s < 24; ++s) { const int sq = s0 + s; const int c = dir ? (sq < 8 ? 7 - sq : 79 - sq) : sq; CIN[base + (size_t)c * DRNN] = carry; carry = pv[s] * carry + hv[s]; }
        }
    }
}
__device__ __forceinline__ void scanC_phase(const bf16_t* LA, const bf16_t* BX, const float* CIN, bf16_t* REC, int half, int gtid, int nthreads) {
    for (int idx = gtid; idx < 4 * 64 * 640; idx += nthreads) {
        const int cp = idx % 640, r1 = idx / 640, lc = r1 & 63, bl = r1 >> 6;
        const int row0 = bl * SEQ + lc * 32;
        const size_t b0 = ((size_t)row0) * DRNN + cp * 2, b1 = ((size_t)9216 + row0) * DRNN + cp * 2;
        const f32x2 cf = *(const f32x2*)(CIN + ((size_t)(0 * 4 + bl) * 72 + 8 + lc) * DRNN + cp * 2);
        const f32x2 cbk = *(const f32x2*)(CIN + ((size_t)(1 * 4 + bl) * 72 + 8 + lc) * DRNN + cp * 2);
        float hf0[32], hf1[32];
        float h0 = cf[0], h1 = cf[1];
#pragma unroll
        for (int i = 0; i < 32; ++i) { const unsigned lw = *(const unsigned*)(LA + b0 + (size_t)i * DRNN), bw = *(const unsigned*)(BX + b0 + (size_t)i * DRNN);
            h0 = __expf(bf_lo(lw)) * h0 + bf_lo(bw); h1 = __expf(bf_hi(lw)) * h1 + bf_hi(bw); hf0[i] = h0; hf1[i] = h1; }
        h0 = cbk[0]; h1 = cbk[1];
        bf16_t* out = REC + ((size_t)(half * 4 + bl) * SEQ + lc * 32) * DRNN + cp * 2;
#pragma unroll
        for (int i = 31; i >= 0; --i) { const unsigned lw = *(const unsigned*)(LA + b1 + (size_t)i * DRNN), bw = *(const unsigned*)(BX + b1 + (size_t)i * DRNN);
            h0 = __expf(bf_lo(lw)) * h0 + bf_lo(bw); h1 = __expf(bf_hi(lw)) * h1 + bf_hi(bw);
            *(unsigned*)(out + (size_t)i * DRNN) = cvt_pk_bf16(hf0[i] + h0, hf1[i] + h1); }
    }
}

#ifndef PH_MASK
#define PH_MASK 0xFFFFFFFFu
#endif
#define PH(k) ((PH_MASK >> (k)) & 1u)
#ifndef REP_MASK
#define REP_MASK 0u
#endif
#define REP_BEGIN(k) _Pragma("unroll 1") for (int rep_ = 0; rep_ < (((REP_MASK >> (k)) & 1u) ? 2 : 1); ++rep_) {
#define REP_END }
__device__ __forceinline__ ParamsK kparams() { ParamsK q = (ParamsK)__builtin_amdgcn_kernarg_segment_ptr(); asm volatile("" : "+s"(q)); return q; }
#define PHASE_BEGIN ParamsK kp = kparams(); unsigned char* ws = kp->ws; (void)ws; \
    int tid = threadIdx.x; asm volatile("" : "+v"(tid)); const int lane = tid & 63, wave = __builtin_amdgcn_readfirstlane(tid >> 6); \
    const int gw = bid * 8 + wave, gtid = bid * 512 + tid; (void)lane; (void)gw; (void)gtid;
#define P_MOD0 ((float*)(ws + WS_MOD))
#define P_MOD1 ((float*)(ws + WS_MOD) + 9 * 6144)
#define P_CTXRES ((float*)(ws + WS_CTXRES))
#define P_H ((bf16_t*)(ws + WS_H))
#define P_SLAB ((bf16_t*)(ws + WS_SLAB))
#define P_Q ((bf16_t*)(ws + WS_Q))
#define P_O ((bf16_t*)(ws + WS_O))
#define P_K ((bf16_t*)(ws + WS_K))
#define P_VT ((bf16_t*)(ws + WS_VT))
#define P_VTC ((bf16_t*)(ws + WS_VTC))
#define P_ACT ((bf16_t*)(ws + WS_ACT))
#define P_U ((bf16_t*)(ws + WS_U))
#define P_RECF ((bf16_t*)(ws + WS_RECF))
#define P_RECB ((bf16_t*)(ws + WS_RECB))
#define P_LA ((bf16_t*)(ws + WS_LA))
#define P_BX ((bf16_t*)(ws + WS_BX))
#define P_RPRE ((bf16_t*)(ws + WS_RPRE))
#define P_SP ((float*)(ws + WS_SP))
#define P_SH ((float*)(ws + WS_SH))
#define P_CIN ((float*)(ws + WS_CIN))
#define G0 (kp->norm_g)
#define G1 (kp->norm_g + 4 * DM)

__global__ void __launch_bounds__(512, 2) fwd_megakernel(Params p) {
    extern __shared__ __attribute__((aligned(16))) unsigned char lds_raw[];
    LAS unsigned char* lds = (LAS unsigned char*)lds_raw;
    const int G = gridDim.x, bid = blockIdx.x;
    const int ngw = G * 8, nthreads = G * 512;
    using namespace pg8;
    if (threadIdx.x < 4) ((volatile LAS unsigned*)(lds + 132096))[threadIdx.x] = 0u;
    __syncthreads();
    XcdBarrier xbar = xcd_barrier_post((unsigned*)(p.ws + WS_BAR), (volatile LAS unsigned*)(lds + 132096));
    if (PH(0)) { PHASE_BEGIN prologue(kp, lds, tid, lane, wave); }
    xcd_barrier(xbar);
#ifdef EXTRA_SYNCS
#pragma unroll 1
    for (int es = 0; es < EXTRA_SYNCS; ++es) xcd_barrier(xbar);
#endif
    REP_BEGIN(1)
    if (PH(1)) { PHASE_BEGIN row_phase<false, true, false, false>(kp->x, kp->ctx, nullptr, nullptr, nullptr, nullptr, P_H, nullptr, G0, nullptr, 0, P_MOD0, 0, 1, MT, gw, ngw, lane); }
    xcd_barrier(xbar);
    REP_END
    if (PH(2)) {
        PHASE_BEGIN
        Gemm g{P_H, (const bf16_t*)(ws + WS_WQKV), DM, DM, DM}; Sched S; S.init(MT / 256, NQKV / 256, G, bid);
        EpiQKV E{P_Q, P_K, P_VT, P_VTC, (const float*)(ws + WS_ROPE)};
        gemm_phase<EpiQKV, true, true>(lds, g, S, E);
    }
    xcd_barrier(xbar);
    REP_BEGIN(3)
    if (PH(3)) { PHASE_BEGIN attn_phase(lds, P_Q, P_O, P_K, P_VT, P_VTC, kp->sink, tid, lane, wave); }
    xcd_barrier(xbar);
    REP_END
    if (PH(4)) {
        PHASE_BEGIN
        { Gemm g{P_O, (const bf16_t*)(ws + WS_WO), DM, DM, DM}; Sched S; S.init(ML / 256, DM / 256, G, bid);
          EpiPlain<0> E{P_H, DM};
          gemm_phase<EpiPlain<0>, true, true>(lds, g, S, E); }
        { Gemm g{P_O, (const bf16_t*)(ws + WS_WO), DM, DM, 256}; Sched S; S.init(8, 4 * 4, G, bid, 2, 256);
          EpiSlabCtx E{P_SLAB, 256};
          gemm_phase<EpiSlabCtx, true, true>(lds, g, S, E); }
    }
    xcd_barrier(xbar);
    if (PH(5)) { PHASE_BEGIN row_phase<true, true, false, true>(kp->x, kp->ctx, kp->out, P_CTXRES, P_H, P_SLAB, P_H, G0 + DM, G0 + 2 * DM, P_MOD0, 2, P_MOD0, 3, 4, MT, gw, ngw, lane); }
    xcd_barrier(xbar);
    if (PH(6)) {
        PHASE_BEGIN
        Gemm g{P_H, (const bf16_t*)(ws + WS_W1), DM, DM, DM}; Sched S; S.init(MT / 256, DFF / 256, G, bid);
        EpiPlain<1> E{P_ACT, DFF};
        gemm_phase<EpiPlain<1>, true, true>(lds, g, S, E);
    }
    xcd_barrier(xbar);
    if (PH(7)) {
        PHASE_BEGIN
        { Gemm g{P_ACT, (const bf16_t*)(ws + WS_W2), DFF, DFF, DFF}; Sched S; S.init(ML / 256, DM / 256, G, bid);
          EpiPlain<0> E{P_H, DM};
          gemm_phase<EpiPlain<0>, true, true>(lds, g, S, E); }
        { Gemm g{P_ACT, (const bf16_t*)(ws + WS_W2), DFF, DFF, 1024}; Sched S; S.init(8, 4 * 4, G, bid, 2, 1024);
          EpiSlabCtx E{P_SLAB, 1024};
          gemm_phase<EpiSlabCtx, true, true>(lds, g, S, E); }
    }
    xcd_barrier(xbar);
    if (PH(8)) { PHASE_BEGIN row_phase<true, true, true, true>(kp->out, P_CTXRES, kp->out, P_CTXRES, P_H, P_SLAB, P_H, G0 + 3 * DM, G1, P_MOD0, 5, P_MOD1, 0, 1, MT, gw, ngw, lane); }
    xcd_barrier(xbar);
    if (PH(9)) {
        PHASE_BEGIN
        Gemm g{P_H, (const bf16_t*)(ws + WS_WIN), DM, DM, DM}; Sched S; S.init(MT / 256, DRNN / 256, G, bid, 4, 0);
        EpiInProj E{P_RPRE, (bf16_t*)(ws + WS_CTXRES)};
        gemm_phase<EpiInProj, true, true>(lds, g, S, E);
    }
    xcd_barrier(xbar);
    REP_BEGIN(10)
    if (PH(10)) { PHASE_BEGIN conv_phase(P_RPRE, P_U, kp->conv_w, kp->conv_b, gtid, nthreads);
        u32x4* cz = (u32x4*)(ws + WS_CARRY); for (int idx = gtid; idx < 1440 * 128 * 8 / 16; idx += nthreads) cz[idx] = (u32x4){0u, 0u, 0u, 0u}; }
    xcd_barrier(xbar);
    REP_END
    if (PH(11)) {
        PHASE_BEGIN
        Gemm g{P_U, (const bf16_t*)(ws + WS_WG), DRNN, 256, 256}; Sched S; S.init(1, 1, G, bid, 3, 0);
        EpiGatesScan E{P_U, P_RECF, P_RECB, kp->b_a, kp->b_i, (const float*)(ws + WS_NLS), (unsigned long long*)(ws + WS_CARRY)};
        gemm_phase<EpiGatesScan, true, true>(lds, g, S, E);
    }
    xcd_barrier(xbar);
    if (PH(15)) {
        PHASE_BEGIN
        Gemm g{P_H, (const bf16_t*)(ws + WS_WIN), DM, DM, DM}; Sched S; S.init(ML / 256, 4, G, bid);
        EpiGateMul E{P_RECF, P_RECB};
        gemm_phase<EpiGateMul, true, true>(lds, g, S, E);
        {
            const bf16_t* GB = (const bf16_t*)(ws + WS_CTXRES); bf16_t* Z = P_RECF; const bf16_t* RB = P_RECB;
            for (int idx = gtid; idx < ML * 32; idx += nthreads) { const int row = idx >> 5, c8 = (idx & 31) * 8;
                const u32x4 gv = *(const u32x4*)(GB + (size_t)row * 256 + c8); const size_t o = (size_t)row * DRNN + 1024 + c8;
                const u32x4 fv = *(const u32x4*)(Z + o), bv = *(const u32x4*)(RB + o); u32x4 w;
                w.x = cvt_pk_bf16(bf_lo(gv.x) * (bf_lo(fv.x) + bf_lo(bv.x)), bf_hi(gv.x) * (bf_hi(fv.x) + bf_hi(bv.x)));
                w.y = cvt_pk_bf16(bf_lo(gv.y) * (bf_lo(fv.y) + bf_lo(bv.y)), bf_hi(gv.y) * (bf_hi(fv.y) + bf_hi(bv.y)));
                w.z = cvt_pk_bf16(bf_lo(gv.z) * (bf_lo(fv.z) + bf_lo(bv.z)), bf_hi(gv.z) * (bf_hi(fv.z) + bf_hi(bv.z)));
                w.w = cvt_pk_bf16(bf_lo(gv.w) * (bf_lo(fv.w) + bf_lo(bv.w)), bf_hi(gv.w) * (bf_hi(fv.w) + bf_hi(bv.w)));
                *(u32x4*)(Z + o) = w; }
        }
    }
    xcd_barrier(xbar);
    if (PH(16)) {
        PHASE_BEGIN
        Gemm g{P_RECF, (const bf16_t*)(ws + WS_WOUT), DRNN, DRNN, DRNN}; Sched S; S.init(ML / 256, DM / 256, G, bid);
        EpiPlain<0> E{P_H, DM};
        gemm_phase<EpiPlain<0>, true, true>(lds, g, S, E);
    }
    xcd_barrier(xbar);
    if (PH(17)) { PHASE_BEGIN row_phase<true, true, true, true>(kp->out, P_CTXRES, ws + WS_X3, P_CTXRES, P_H, nullptr, P_H, G1 + DM, G1 + 2 * DM, P_MOD1, 2, P_MOD1, 3, 4, ML, gw, ngw, lane); }
    xcd_barrier(xbar);
    if (PH(18)) {
        PHASE_BEGIN
        Gemm g{P_H, (const bf16_t*)(ws + WS_W1 + 16 * MiB), DM, DM, DM}; Sched S; S.init(ML / 256, DFF / 256, G, bid);
        EpiPlain<1> E{P_ACT, DFF};
        gemm_phase<EpiPlain<1>, true, true>(lds, g, S, E);
    }
    xcd_barrier(xbar);
    if (PH(19)) {
        PHASE_BEGIN
        Gemm g{P_ACT, (const bf16_t*)(ws + WS_W2 + 16 * MiB), DFF, DFF, DFF}; Sched S; S.init(ML / 256, DM / 256, G, bid);
        EpiPlain<0> E{P_H, DM};
        gemm_phase<EpiPlain<0>, true, true>(lds, g, S, E);
    }
    xcd_barrier(xbar);
    if (PH(20)) { PHASE_BEGIN row_phase<true, false, true, false>(ws + WS_X3, P_CTXRES, kp->out, P_CTXRES, P_H, nullptr, nullptr, G1 + 3 * DM, nullptr, P_MOD1, 5, nullptr, 0, 0, ML, gw, ngw, lane); }
}

extern "C" void kernel_launch(void* const* d_in, const int* in_sizes, int n_in, void* d_out, int out_size, void* d_ws, size_t ws_size, hipStream_t stream) {
    static int grid_blocks = 0;
    if (grid_blocks == 0) {
        if (n_in != 21 || ws_size < WS_END) { fprintf(stderr, "kernel_launch: unexpected n_in %d / ws_size %zu\n", n_in, ws_size); grid_blocks = -1; return; }
        int dev = 0, cus = 0, per_cu = 0;
        hipGetDevice(&dev);
        hipDeviceGetAttribute(&cus, hipDeviceAttributeMultiprocessorCount, dev);
        if (hipFuncSetAttribute((const void*)fwd_megakernel, hipFuncAttributeMaxDynamicSharedMemorySize, LDS_BYTES) != hipSuccess) { fprintf(stderr, "hipFuncSetAttribute failed\n"); grid_blocks = -1; return; }
        if (hipOccupancyMaxActiveBlocksPerMultiprocessor(&per_cu, (const void*)fwd_megakernel, 512, LDS_BYTES) != hipSuccess || per_cu < 1) { fprintf(stderr, "occupancy query failed (%d)\n", per_cu); (void)hipGetLastError(); per_cu = 1; }
        grid_blocks = cus * 1;
    }
    if (grid_blocks < 0) return;
    Params p{};
    p.x = (const float*)d_in[0]; p.c = (const float*)d_in[1]; p.ctx = (const float*)d_in[2]; p.c_ctx = (const float*)d_in[3];
    p.ada_w = (const float*)d_in[4]; p.ada_b = (const float*)d_in[5]; p.norm_g = (const float*)d_in[6]; p.mlp_w1 = (const float*)d_in[7]; p.mlp_w2 = (const float*)d_in[8];
    p.w_qkv = (const float*)d_in[9]; p.w_o = (const float*)d_in[10]; p.sink = (const float*)d_in[11];
    p.w_in = (const float*)d_in[12]; p.conv_w = (const float*)d_in[13]; p.conv_b = (const float*)d_in[14]; p.w_a = (const float*)d_in[15]; p.b_a = (const float*)d_in[16];
    p.w_i = (const float*)d_in[17]; p.b_i = (const float*)d_in[18]; p.lam = (const float*)d_in[19]; p.w_out = (const float*)d_in[20];
    p.out = (float*)d_out; p.ws = (unsigned char*)d_ws;
    if (hipMemsetAsync((unsigned char*)d_ws + WS_BAR, 0, XCD_BAR_WORDS * 4, stream) != hipSuccess) { fprintf(stderr, "memset of barrier words failed\n"); return; }
    void* args[] = {&p};
    hipError_t e = hipLaunchCooperativeKernel((const void*)fwd_megakernel, dim3(grid_blocks), dim3(512), args, LDS_BYTES, stream);
    if (e != hipSuccess) fprintf(stderr, "cooperative launch failed: %s (grid %d)\n", hipGetErrorString(e), grid_blocks);
}
```

```cpp
#include <hip/hip_runtime.h>
#include <hip/hip_cooperative_groups.h>
#include <cstdio>
#include <cstdint>
namespace cg = cooperative_groups;

#define LAS __attribute__((address_space(3)))
typedef unsigned short bf16_t;
typedef short bf16x8 __attribute__((ext_vector_type(8)));
typedef float f32x4 __attribute__((ext_vector_type(4)));
typedef float f32x2 __attribute__((ext_vector_type(2)));
typedef unsigned u32x4 __attribute__((ext_vector_type(4)));
typedef unsigned u32x2 __attribute__((ext_vector_type(2)));

constexpr int DM = 1024, NB = 8, SEQ = 2048, CTX = 256;
constexpr int ML = NB * SEQ;
constexpr int MC = NB * CTX;
constexpr int MT = ML + MC;
constexpr int NQKV = 1536, DFF = 4096, DRNN = 1280;
constexpr float EPS = 1e-6f;
constexpr float LOG2E = 1.4426950408889634f;

constexpr size_t MiB = 1u << 20;
constexpr size_t WS_MOD = 0;
constexpr size_t WS_ROPE = 448 * 1024;
constexpr size_t WS_NLS = 460 * 1024;
constexpr size_t WS_BAR = 480 * 1024;
constexpr size_t WS_WQKV = 1 * MiB, WS_WO = 4 * MiB, WS_W1 = 6 * MiB, WS_W2 = 14 * MiB;
constexpr size_t WS_WIN = 38 * MiB, WS_WG = 43 * MiB, WS_WOUT = 46 * MiB;
constexpr size_t WS_CTXRES = 49 * MiB;
constexpr size_t WS_H = 57 * MiB;
constexpr size_t WS_R3 = 93 * MiB;
constexpr size_t WS_Q = WS_R3, WS_K = 129 * MiB, WS_VT = 138 * MiB, WS_VTC = 146 * MiB;
constexpr size_t WS_O = 150 * MiB;
constexpr size_t WS_ACT = WS_R3;
constexpr size_t WS_U = WS_R3;
constexpr size_t WS_RECF = 138 * MiB;
constexpr size_t WS_RECB = 178 * MiB;
constexpr size_t WS_LA = 138 * MiB;
constexpr size_t WS_BX = 183 * MiB;
constexpr size_t WS_RPRE = 138 * MiB;
constexpr size_t WS_SP = 228 * MiB, WS_SH = 231 * MiB, WS_CIN = 234 * MiB;
constexpr size_t WS_SLAB = 238 * MiB;
constexpr size_t WS_CARRY = 219 * MiB;
constexpr size_t WS_FLAG = 512 * 1024;
constexpr size_t WS_X3 = 222 * MiB;
constexpr size_t WS_END = 256 * MiB;
constexpr int LDS_BYTES = 143360;

__device__ __forceinline__ unsigned f2bf(float f) { unsigned u = __builtin_bit_cast(unsigned, f); return (u + 0x7fffu + ((u >> 16) & 1u)) >> 16; }
__device__ __forceinline__ unsigned cvt_pk_bf16(float lo, float hi) { unsigned r; asm volatile("v_cvt_pk_bf16_f32 %0, %1, %2" : "=v"(r) : "v"(lo), "v"(hi)); return r; }
__device__ __forceinline__ float bf_lo(unsigned w) { return __builtin_bit_cast(float, w << 16); }
__device__ __forceinline__ float bf_hi(unsigned w) { return __builtin_bit_cast(float, w & 0xffff0000u); }
__device__ __forceinline__ f32x4 bf4_to_f32(u32x2 w) { return (f32x4){bf_lo(w.x), bf_hi(w.x), bf_lo(w.y), bf_hi(w.y)}; }
__device__ __forceinline__ u32x2 f32_to_bf4(f32x4 v) { u32x2 w; w.x = cvt_pk_bf16(v[0], v[1]); w.y = cvt_pk_bf16(v[2], v[3]); return w; }
__device__ __forceinline__ float wave_sum(float v) {
#pragma unroll
    for (int o = 1; o < 64; o <<= 1) v += __shfl_xor(v, o);
    return v;
}
__device__ __forceinline__ float fsigmoid(float x) { return __builtin_amdgcn_rcpf(1.0f + __expf(-x)); }

namespace pg8 {
constexpr int BM = 256, BK = 64, HALF = 128, HTB = HALF * BK * 2, STAGE_BYTES = 8 * HTB, NXCD = 8, WGM = 8;
__device__ __forceinline__ int lds_byte(int r, int c) { const int st = (r >> 4) * 2 + (c >> 5), rr = r & 15, cc = c & 31, ob = rr * 64 + cc * 2; return st * 1024 + (ob ^ (((ob >> 9) & 1) << 5)); }
__device__ __forceinline__ void stage_rc(int b, int& R, int& C) { const int st = b / 1024, sb = b % 1024, swz = sb ^ (((sb >> 9) & 1) << 5); R = (st >> 1) * 16 + swz / 64; C = (st & 1) * 32 + (swz % 64) / 2; }

__device__ __forceinline__ int perm32(int rho) { const int n = rho >> 4, i = rho & 15; return 8 * (i >> 2) + 4 * n + (i & 3); }
struct Unit { int pm, pn, koff, po, kboff, rev, lin; };
struct Gemm { const bf16_t* A; const bf16_t* Bt; int lda, ldb, K; };

struct Sched {
    int nM, nN, nwg, G, c, mode, half;
    __device__ void init(int nM_, int nN_, int G_, int c_, int mode_ = 0, int half_ = 0) { nM = nM_; nN = nN_; nwg = nM * nN; G = G_; c = c_; mode = mode_; half = half_; }
    __device__ bool next(int i, Unit& u) const {
        if (mode == 3) {
            const int L = i * G + c; if (L >= 1440) return false;
            const int ti = L / 160, s = L % 160;
            const int chalf = s & 1, dir = (s >> 1) & 1, bb = s >> 2, blk = bb % 5, b = bb / 5;
            u.pm = (ti == 0) ? 64 + b : (dir ? b * 8 + (8 - ti) : b * 8 + (ti - 1));
            u.pn = (dir * 5 + blk) * 2 + chalf; u.koff = blk * 256; u.kboff = 0; u.po = ti; u.rev = dir; u.lin = L;
            return true;
        }
        if (mode == 4) {
            const int L4 = i * G + c; if (L4 >= 424) return false;
            if (L4 >= 360) { u.pm = L4 - 360; u.pn = 4; u.koff = 0; u.po = u.pm; u.kboff = 0; u.rev = 0; u.lin = 0; return true; }
        }
        const long L = (long)i * G + c; if (L >= nwg) return false;
        int wgid = (int)L; { const int q = nwg / NXCD, r = nwg % NXCD, xcd = wgid % NXCD, off = wgid / NXCD; wgid = (xcd < r ? xcd * (q + 1) : r * (q + 1) + (xcd - r) * q) + off; }
        const int nig = WGM * nN, gid = wgid / nig, fm = gid * WGM, gsz = (nM - fm) < WGM ? (nM - fm) : WGM;
        const int pmi = fm + ((wgid % nig) % gsz), pn = (wgid % nig) / gsz;
        u.pm = pmi; u.pn = pn; u.koff = 0; u.po = pmi; u.kboff = 0; u.rev = 0; u.lin = 0;
        if (mode == 2) { u.pm = 64 + pmi; u.pn = pn & 3; u.koff = (pn >> 2) * half; u.kboff = u.koff; }
        if (mode == 4) u.pn += 5;
        if (mode == 1) { u.pm = pmi < 32 ? 32 * half + pmi : 64 + 4 * half + (pmi - 32); u.koff = ((pn >> 1) % 5) * 256; }
        return true;
    }
};

template <class Epi, bool ALIGN_EPI, bool SP2>
__device__ __forceinline__ void gemm_phase(LAS unsigned char* lds, const Gemm g, const Sched& S, const Epi& E) {
    int tid = threadIdx.x; asm volatile("" : "+v"(tid));
    const int wid = __builtin_amdgcn_readfirstlane(tid >> 6), lane = tid & 63, wr = wid >> 2, wc = wid & 3, fr = lane & 15, fq = lane >> 4;
    const int K = g.K, nt = K / BK;
    unsigned voffAf[2], voffAr[2], voffB[2];
#pragma unroll
    for (int i = 0; i < 2; ++i) { int R, C; stage_rc(tid * 16 + i * 8192, R, C);
        const int Rb = Epi::PERM ? ((R & ~31) + perm32(R & 31)) : R;
        voffAf[i] = (unsigned)(R * g.lda + C) * 2u; voffAr[i] = (unsigned)((127 - R) * g.lda + C) * 2u; voffB[i] = (unsigned)(Rb * g.ldb + C) * 2u; }
    const size_t kstep = (size_t)(BK * 2);
    const long hstepAf = (long)HALF * g.lda * 2; const size_t hstepB = (size_t)HALF * g.ldb * 2;
    const unsigned ldsw = (unsigned)wid * 1024u;
    const int aoff = lds_byte(wr * 64 + fr, fq * 8), boff = lds_byte(wc * 32 + fr, fq * 8);
#define PG8_SA(b, h) (((b) * 2 + (h)) * HTB)
#define PG8_SB(b, h) ((4 + (b) * 2 + (h)) * HTB)
#define PG8_STAGE(bufoff, gbase, voff) do { _Pragma("unroll") for (int _i = 0; _i < 2; ++_i) \
        __builtin_amdgcn_global_load_lds((const unsigned*)((const char*)(gbase) + (voff)[_i]), (LAS unsigned*)(lds + (bufoff) + ldsw + _i * 8192), 16, 0, 0); } while (0)
#define PG8_LDA(dst, b, h) do { _Pragma("unroll") for (int m = 0; m < 4; ++m) _Pragma("unroll") for (int k = 0; k < 2; ++k) dst[m][k] = *(const LAS bf16x8*)(lds + PG8_SA(b, h) + aoff + m * 2048 + k * 1024); } while (0)
#define PG8_LDB(dst, b, h) do { _Pragma("unroll") for (int n = 0; n < 2; ++n) _Pragma("unroll") for (int k = 0; k < 2; ++k) dst[n][k] = *(const LAS bf16x8*)(lds + PG8_SB(b, h) + boff + n * 2048 + k * 1024); } while (0)
#define PG8_MMA(ai, bj, At, Bt) do { __builtin_amdgcn_s_setprio(1); _Pragma("unroll") for (int m = 0; m < 4; ++m) _Pragma("unroll") for (int n = 0; n < 2; ++n) _Pragma("unroll") for (int k = 0; k < 2; ++k) \
        acc[ai][bj][m][n] = __builtin_amdgcn_mfma_f32_16x16x32_bf16(Bt[n][k], At[m][k], acc[ai][bj][m][n], 0, 0, 0); __builtin_amdgcn_s_setprio(0); } while (0)
#define PG8_WAIT_V(n) asm volatile("s_waitcnt vmcnt(" #n ")" ::: "memory")
#define PG8_WAIT_L(n) asm volatile("s_waitcnt lgkmcnt(" #n ")" ::: "memory")
#define PG8_BAR __builtin_amdgcn_s_barrier()
#define PG8_SCHED __builtin_amdgcn_sched_barrier(0)
    Unit cur, nxt; int ui = 0;
    if (!S.next(0, cur)) return;
    f32x4 acc[2][2][4][2];
#pragma unroll
    for (int a = 0; a < 2; ++a)
#pragma unroll
        for (int b = 0; b < 2; ++b)
#pragma unroll
            for (int m = 0; m < 4; ++m)
#pragma unroll
                for (int n = 0; n < 2; ++n) acc[a][b][m][n] = (f32x4){0.f, 0.f, 0.f, 0.f};
    bf16x8 At[4][2], B0[2][2], B1[2][2];
#define PG8_UNIT_A(u_) ((const char*)g.A + ((size_t)(u_).pm * BM * g.lda + (u_).koff) * 2 + (Epi::WITH_LDS && (u_).rev ? hstepAf : 0))
    const char* cA = PG8_UNIT_A(cur);
    unsigned voffA[2] = {voffAf[0], voffAf[1]}; long hstepA = hstepAf;
    if (Epi::WITH_LDS && cur.rev) { voffA[0] = voffAr[0]; voffA[1] = voffAr[1]; hstepA = -hstepAf; } const char* cB = (const char*)g.Bt + ((size_t)cur.pn * BM * g.ldb + cur.kboff) * 2;
    if constexpr (SP2) {
        PG8_STAGE(PG8_SB(0, 0), cB, voffB); PG8_STAGE(PG8_SB(0, 1), cB + hstepB, voffB); PG8_STAGE(PG8_SA(0, 0), cA, voffA); PG8_STAGE(PG8_SA(0, 1), cA + hstepA, voffA);
        if (wr == 1) PG8_BAR;
        PG8_WAIT_V(2); PG8_BAR;
        PG8_STAGE(PG8_SB(1, 0), cB + kstep, voffB); PG8_STAGE(PG8_SA(1, 0), cA + kstep, voffA); PG8_STAGE(PG8_SB(1, 1), cB + hstepB + kstep, voffB);
        PG8_WAIT_V(6); PG8_BAR;
    } else {
        PG8_STAGE(PG8_SB(0, 0), cB, voffB); PG8_STAGE(PG8_SA(0, 0), cA, voffA); PG8_STAGE(PG8_SB(0, 1), cB + hstepB, voffB); PG8_STAGE(PG8_SA(0, 1), cA + hstepA, voffA);
        if (wr == 1) PG8_BAR;
        PG8_WAIT_V(4); PG8_BAR;
        PG8_STAGE(PG8_SB(1, 0), cB + kstep, voffB); PG8_STAGE(PG8_SA(1, 0), cA + kstep, voffA); PG8_STAGE(PG8_SB(1, 1), cB + hstepB + kstep, voffB);
        PG8_WAIT_V(6); PG8_BAR;
    }
    for (;;) {
        const bool has_next = S.next(ui + 1, nxt);
        const char* nA = has_next ? PG8_UNIT_A(nxt) : cA;
        unsigned voffN[2] = {voffA[0], voffA[1]}; long hstepN = hstepA;
        if (Epi::WITH_LDS && has_next) { const bool nr = nxt.rev != 0; voffN[0] = nr ? voffAr[0] : voffAf[0]; voffN[1] = nr ? voffAr[1] : voffAf[1]; hstepN = nr ? -hstepAf : hstepAf; }
        const char* nB = has_next ? (const char*)g.Bt + ((size_t)nxt.pn * BM * g.ldb + nxt.kboff) * 2 : cB;
#pragma unroll 1
        for (int t = 0; t < nt; t += 2) {
            const bool last = (t == nt - 2);
            const char* a1 = cA + (size_t)(t + 1) * kstep;
            const char* a2 = last ? nA : cA + (size_t)(t + 2) * kstep; const char* b2 = last ? nB : cB + (size_t)(t + 2) * kstep;
            const char* a3 = a2 + kstep; const char* b3 = b2 + kstep;
            unsigned voff2[2] = {voffA[0], voffA[1]}; long hstep2 = hstepA;
            if (Epi::WITH_LDS && last) { voff2[0] = voffN[0]; voff2[1] = voffN[1]; hstep2 = hstepN; }
            if constexpr (SP2) {
            PG8_LDB(B0, 0, 0); PG8_LDB(B1, 0, 1); PG8_SCHED; PG8_LDA(At, 0, 0); PG8_STAGE(PG8_SA(1, 1), a1 + hstepA, voffA);
            PG8_WAIT_V(8); PG8_WAIT_L(0); PG8_BAR; PG8_MMA(0, 0, At, B0); PG8_MMA(0, 1, At, B1); PG8_BAR; PG8_SCHED;
            PG8_LDA(At, 0, 1); PG8_STAGE(PG8_SB(0, 0), b2, voffB); PG8_STAGE(PG8_SB(0, 1), b2 + hstepB, voffB); PG8_STAGE(PG8_SA(0, 0), a2, voff2);
            PG8_WAIT_V(8); PG8_WAIT_L(0); PG8_BAR; PG8_MMA(1, 0, At, B0); PG8_MMA(1, 1, At, B1); PG8_BAR; PG8_SCHED;
            PG8_LDB(B0, 1, 0); PG8_LDB(B1, 1, 1); PG8_SCHED; PG8_LDA(At, 1, 0); PG8_STAGE(PG8_SA(0, 1), a2 + hstep2, voff2);
            PG8_WAIT_V(8); PG8_WAIT_L(0); PG8_BAR; PG8_MMA(0, 0, At, B0); PG8_MMA(0, 1, At, B1); PG8_BAR; PG8_SCHED;
            PG8_LDA(At, 1, 1); PG8_STAGE(PG8_SB(1, 0), b3, voffB); PG8_STAGE(PG8_SB(1, 1), b3 + hstepB, voffB); PG8_STAGE(PG8_SA(1, 0), a3, voff2);
            PG8_WAIT_V(8); PG8_WAIT_L(0); PG8_BAR; PG8_MMA(1, 0, At, B0); PG8_MMA(1, 1, At, B1); PG8_BAR; PG8_SCHED;
            } else {
            PG8_LDB(B0, 0, 0); PG8_SCHED; PG8_LDA(At, 0, 0); PG8_STAGE(PG8_SA(1, 1), a1 + hstepA, voffA);
            PG8_WAIT_L(8); PG8_BAR; PG8_WAIT_L(0); PG8_MMA(0, 0, At, B0); PG8_BAR; PG8_SCHED;
            PG8_LDB(B1, 0, 1); PG8_STAGE(PG8_SB(0, 0), b2, voffB);
            PG8_BAR; PG8_WAIT_L(0); PG8_MMA(0, 1, At, B1); PG8_BAR;
            PG8_LDA(At, 0, 1); PG8_STAGE(PG8_SA(0, 0), a2, voff2);
            PG8_BAR; PG8_WAIT_L(0); PG8_MMA(1, 0, At, B0); PG8_BAR; PG8_SCHED;
            PG8_STAGE(PG8_SB(0, 1), b2 + hstepB, voffB);
            PG8_WAIT_V(6); PG8_BAR; PG8_MMA(1, 1, At, B1); PG8_BAR;
            PG8_LDB(B0, 1, 0); PG8_SCHED; PG8_LDA(At, 1, 0); PG8_STAGE(PG8_SA(0, 1), a2 + hstep2, voff2);
            PG8_WAIT_L(8); PG8_BAR; PG8_WAIT_L(0); PG8_MMA(0, 0, At, B0); PG8_BAR; PG8_SCHED;
            PG8_LDB(B1, 1, 1); PG8_STAGE(PG8_SB(1, 0), b3, voffB);
            PG8_BAR; PG8_WAIT_L(0); PG8_MMA(0, 1, At, B1); PG8_BAR;
            PG8_LDA(At, 1, 1); PG8_STAGE(PG8_SA(1, 0), a3, voff2);
            PG8_BAR; PG8_WAIT_L(0); PG8_MMA(1, 0, At, B0); PG8_BAR; PG8_SCHED;
            PG8_STAGE(PG8_SB(1, 1), b3 + hstepB, voffB);
            PG8_WAIT_V(6); PG8_BAR; PG8_MMA(1, 1, At, B1); PG8_BAR;
            }
        }
        if constexpr (ALIGN_EPI) { if (wr == 0) PG8_BAR; }
        if constexpr (Epi::WITH_LDS) E.run(acc, cur, wr, wc, lane, lds); else E(acc, cur, wr, wc, fr, fq);
        if (!has_next) break;
#pragma unroll
        for (int a = 0; a < 2; ++a)
#pragma unroll
            for (int b = 0; b < 2; ++b)
#pragma unroll
                for (int m = 0; m < 4; ++m)
#pragma unroll
                    for (int n = 0; n < 2; ++n) acc[a][b][m][n] = (f32x4){0.f, 0.f, 0.f, 0.f};
        cur = nxt; cA = nA; cB = nB; ++ui; voffA[0] = voffN[0]; voffA[1] = voffN[1]; hstepA = hstepN;
        if constexpr (ALIGN_EPI) { if (wr == 1) PG8_BAR; }
    }
    PG8_WAIT_V(0);
    if constexpr (!ALIGN_EPI) { if (wr == 0) PG8_BAR; }
    PG8_BAR;
#undef PG8_UNIT_A
#undef PG8_SA
#undef PG8_SB
#undef PG8_STAGE
#undef PG8_LDA
#undef PG8_LDB
#undef PG8_MMA
#undef PG8_WAIT_V
#undef PG8_WAIT_L
#undef PG8_BAR
#undef PG8_SCHED
}

template <int ACT> struct EpiPlain {
    static constexpr bool WITH_LDS = false, PERM = true;
    bf16_t* O; int ldc;
    __device__ __forceinline__ void operator()(const f32x4 (&acc)[2][2][4][2], const Unit& u, int wr, int wc, int fr_, int fq_) const {
        int fr = fr_, fq = fq_; asm volatile("" : "+v"(fr), "+v"(fq));
        const int col0 = u.pn * BM + wc * 32 + fq * 8;
#pragma unroll
        for (int ai = 0; ai < 2; ++ai)
#pragma unroll
            for (int m = 0; m < 4; ++m) { bf16_t* rowp = O + (size_t)(u.pm * BM + ai * HALF + wr * 64 + m * 16 + fr) * ldc + col0;
#pragma unroll
                for (int bj = 0; bj < 2; ++bj) { f32x4 v0 = acc[ai][bj][m][0], v1 = acc[ai][bj][m][1];
                    if (ACT == 1) { v0 = __builtin_elementwise_max(v0, (f32x4){0.f, 0.f, 0.f, 0.f}); v0 = v0 * v0; v1 = __builtin_elementwise_max(v1, (f32x4){0.f, 0.f, 0.f, 0.f}); v1 = v1 * v1; }
                    u32x4 w; w.x = cvt_pk_bf16(v0[0], v0[1]); w.y = cvt_pk_bf16(v0[2], v0[3]); w.z = cvt_pk_bf16(v1[0], v1[1]); w.w = cvt_pk_bf16(v1[2], v1[3]);
                    *(u32x4*)(rowp + bj * HALF) = w; } }
    }
};

struct EpiSlabCtx {
    static constexpr bool WITH_LDS = false, PERM = true;
    bf16_t* S; int ksz;
    __device__ __forceinline__ void operator()(const f32x4 (&acc)[2][2][4][2], const Unit& u, int wr, int wc, int fr_, int fq_) const {
        int fr = fr_, fq = fq_; asm volatile("" : "+v"(fr), "+v"(fq));
        const int col0 = u.pn * BM + wc * 32 + fq * 8;
        bf16_t* base = S + (size_t)(u.koff / ksz) * MC * DM;
#pragma unroll
        for (int ai = 0; ai < 2; ++ai)
#pragma unroll
            for (int m = 0; m < 4; ++m) { bf16_t* rowp = base + (size_t)(u.pm * BM - ML + ai * HALF + wr * 64 + m * 16 + fr) * DM + col0;
#pragma unroll
                for (int bj = 0; bj < 2; ++bj) { const f32x4 v0 = acc[ai][bj][m][0], v1 = acc[ai][bj][m][1];
                    u32x4 w; w.x = cvt_pk_bf16(v0[0], v0[1]); w.y = cvt_pk_bf16(v0[2], v0[3]); w.z = cvt_pk_bf16(v1[0], v1[1]); w.w = cvt_pk_bf16(v1[2], v1[3]);
                    *(u32x4*)(rowp + bj * HALF) = w; } }
    }
};

struct EpiQKV {
    static constexpr bool WITH_LDS = false, PERM = false;
    bf16_t* Q; bf16_t* Kb; bf16_t* VT; bf16_t* VTC; const float* rope;
    __device__ __forceinline__ void operator()(const f32x4 (&acc)[2][2][4][2], const Unit& u, int wr, int wc, int fr_, int fq_) const {
        int fr = fr_, fq = fq_; asm volatile("" : "+v"(fr), "+v"(fq));
        const bool lat = u.pm < 64;
        if (u.pn < 5) {
#pragma unroll
            for (int ai = 0; ai < 2; ++ai)
#pragma unroll
                for (int m = 0; m < 4; ++m) {
                    const int row = u.pm * BM + ai * HALF + wr * 64 + m * 16 + fr;
                    f32x4 cs0 = {1.f, 0.f, 1.f, 0.f}, cs1 = {1.f, 0.f, 1.f, 0.f};
                    if (lat) { const int t = row & 2047; const int pos = (wc & 1) ? (t & 63) : (t >> 6); const f32x4* pp = (const f32x4*)(rope + (pos * 16 + 4 * fq) * 2); cs0 = pp[0]; cs1 = pp[1]; }
                    const f32x4 cv = {cs0[0], cs0[2], cs1[0], cs1[2]}, sv = {cs0[1], cs0[3], cs1[1], cs1[3]};
#pragma unroll
                    for (int bj = 0; bj < 2; ++bj) {
                        const f32x4 a = acc[ai][bj][m][0], b = acc[ai][bj][m][1];
                        f32x4 na = a * cv - b * sv, nb = b * cv + a * sv;
                        if (u.pn < 4) { na = na * 0.125f; nb = nb * 0.125f; }
                        bf16_t* d = (u.pn < 4) ? Q + (size_t)row * 1024 + u.pn * 256 + bj * HALF + wc * 32 + fq * 8 : Kb + (size_t)row * 256 + bj * HALF + wc * 32 + fq * 8;
                        u32x4 w; w.x = cvt_pk_bf16(na[0], na[1]); w.y = cvt_pk_bf16(na[2], na[3]); w.z = cvt_pk_bf16(nb[0], nb[1]); w.w = cvt_pk_bf16(nb[2], nb[3]);
                        *(u32x4*)d = w;
                    }
                }
        } else {
#pragma unroll
            for (int ai = 0; ai < 2; ++ai)
#pragma unroll
                for (int m = 0; m < 4; ++m) {
                    const int row = u.pm * BM + ai * HALF + wr * 64 + m * 16 + fr;
                    bf16_t* base; size_t stride;
                    if (lat) { const int b = row >> 11, t = row & 2047; base = VT + (size_t)b * 256 * 2048 + t; stride = 2048; }
                    else { const int rc = row - ML; const int b = rc >> 8, t = rc & 255; base = VTC + (size_t)b * 256 * 256 + t; stride = 256; }
#pragma unroll
                    for (int bj = 0; bj < 2; ++bj)
#pragma unroll
                        for (int n = 0; n < 2; ++n)
#pragma unroll
                            for (int j = 0; j < 4; ++j) { const int vc = bj * HALF + wc * 32 + n * 16 + fq * 4 + j; base[(size_t)vc * stride] = (bf16_t)f2bf(acc[ai][bj][m][n][j]); }
                }
        }
    }
};

struct EpiInProj {
    static constexpr bool WITH_LDS = false, PERM = true;
    bf16_t* R; bf16_t* GB;
    __device__ __forceinline__ void operator()(const f32x4 (&acc)[2][2][4][2], const Unit& u, int wr, int wc, int fr_, int fq_) const {
        int fr = fr_, fq = fq_; asm volatile("" : "+v"(fr), "+v"(fq));
        const bool rec = u.pn >= 5;
        const int col0 = (rec ? (u.pn - 5) * BM : 0) + wc * 32 + fq * 8; const int ldc = rec ? DRNN : 256; bf16_t* O = rec ? R : GB;
#pragma unroll
        for (int ai = 0; ai < 2; ++ai)
#pragma unroll
            for (int m = 0; m < 4; ++m) { bf16_t* rowp = O + (size_t)(u.pm * BM + ai * HALF + wr * 64 + m * 16 + fr) * ldc + col0;
#pragma unroll
                for (int bj = 0; bj < 2; ++bj) { f32x4 v0 = acc[ai][bj][m][0], v1 = acc[ai][bj][m][1];
                    if (!rec) {
#pragma unroll
                        for (int j = 0; j < 4; ++j) { const float x = v0[j]; v0[j] = x * fsigmoid(1.5957691216057308f * (x + 0.044715f * x * x * x)); const float y = v1[j]; v1[j] = y * fsigmoid(1.5957691216057308f * (y + 0.044715f * y * y * y)); } }
                    u32x4 w; w.x = cvt_pk_bf16(v0[0], v0[1]); w.y = cvt_pk_bf16(v0[2], v0[3]); w.z = cvt_pk_bf16(v1[0], v1[1]); w.w = cvt_pk_bf16(v1[2], v1[3]);
                    *(u32x4*)(rowp + bj * HALF) = w; } }
    }
};

struct EpiGates {
    static constexpr bool WITH_LDS = false, PERM = false;
    const bf16_t* U; bf16_t* LA; bf16_t* BX; const float* ba; const float* bi; const float* nls;
    __device__ __forceinline__ void operator()(const f32x4 (&acc)[2][2][4][2], const Unit& u, int wr, int wc, int fr_, int fq_) const {
        int fr = fr_, fq = fq_; asm volatile("" : "+v"(fr), "+v"(fq));
        const int tile = u.pn >> 1, dir = tile / 5, blk = tile % 5, chalf = u.pn & 1;
        const int ch0 = blk * 256 + chalf * 128 + wc * 32 + fq * 4;
#pragma unroll
        for (int n = 0; n < 2; ++n) {
            const int ch = ch0 + n * 16;
            const f32x4 bav = *(const f32x4*)(ba + dir * DRNN + ch), biv = *(const f32x4*)(bi + dir * DRNN + ch), nl = *(const f32x4*)(nls + dir * DRNN + ch);
#pragma unroll
            for (int ai = 0; ai < 2; ++ai)
#pragma unroll
                for (int m = 0; m < 4; ++m) {
                    const int rin = ai * HALF + wr * 64 + m * 16 + fr;
                    const size_t rowg = (size_t)u.pm * BM + rin, rowl = (size_t)u.po * BM + rin;
                    const f32x4 uv = bf4_to_f32(*(const u32x2*)(U + rowg * DRNN + ch));
                    f32x4 lav, bxv;
#pragma unroll
                    for (int j = 0; j < 4; ++j) {
                        const float r = fsigmoid(acc[ai][0][m][n][j] + bav[j]);
                        const float ig = fsigmoid(acc[ai][1][m][n][j] + biv[j]);
                        const float la = nl[j] * r, x = 2.0f * la;
                        float om;
                        if (x > -0.5f) { float q = 1.0f / 720.0f; q = q * x + 1.0f / 120.0f; q = q * x + 1.0f / 24.0f; q = q * x + 1.0f / 6.0f; q = q * x + 0.5f; q = q * x + 1.0f; om = -x * q; }
                        else om = 1.0f - __expf(x);
                        lav[j] = la; bxv[j] = __builtin_amdgcn_sqrtf(om) * (ig * uv[j]);
                    }
                    const size_t o = ((size_t)dir * 9216 + rowl) * DRNN + ch;
                    *(u32x2*)(LA + o) = f32_to_bf4(lav); *(u32x2*)(BX + o) = f32_to_bf4(bxv);
                    asm volatile("" ::: "memory");
                }
        }
    }
};

#define SC_STEP(d) \
    "v_fmac_f32_dpp %1, %1, %0 row_shr:" #d " row_mask:0xf bank_mask:0xf\n\t" "v_mul_f32_dpp %0, %0, %0 row_shr:" #d " row_mask:0xf bank_mask:0xf\n\t" \
    "v_fmac_f32_dpp %3, %3, %2 row_shr:" #d " row_mask:0xf bank_mask:0xf\n\t" "v_mul_f32_dpp %2, %2, %2 row_shr:" #d " row_mask:0xf bank_mask:0xf\n\t" \
    "v_fmac_f32_dpp %5, %5, %4 row_shr:" #d " row_mask:0xf bank_mask:0xf\n\t" "v_mul_f32_dpp %4, %4, %4 row_shr:" #d " row_mask:0xf bank_mask:0xf\n\t" \
    "v_fmac_f32_dpp %7, %7, %6 row_shr:" #d " row_mask:0xf bank_mask:0xf\n\t" "v_mul_f32_dpp %6, %6, %6 row_shr:" #d " row_mask:0xf bank_mask:0xf\n\t"
__device__ __forceinline__ void scan16x4(float& a0, float& b0, float& a1, float& b1, float& a2, float& b2, float& a3, float& b3) {
    asm volatile("s_nop 1\n\t" SC_STEP(1) SC_STEP(2) SC_STEP(4) SC_STEP(8)
                 : "+v"(a0), "+v"(b0), "+v"(a1), "+v"(b1), "+v"(a2), "+v"(b2), "+v"(a3), "+v"(b3));
}
struct EpiGatesScan {
    static constexpr bool WITH_LDS = true, PERM = true;
    const bf16_t* U; bf16_t* RECF; bf16_t* RECB; const float* ba; const float* bi; const float* nls; unsigned long long* CARRY;
    __device__ __forceinline__ void run(f32x4 (&acc)[2][2][4][2], const Unit& u, int wr, int wc, int lane_, LAS unsigned char* lds) const {
        int lane = lane_; asm volatile("" : "+v"(lane));
        const int fr = lane & 15, fq = lane >> 4;
        const int tile = u.pn >> 1, dir = tile / 5, blk = tile % 5, chalf = u.pn & 1;
        const int ch0 = blk * 256 + chalf * 128 + wc * 32 + fq * 8;
        const int rmask = dir ? 255 : 0;
        bf16_t* REC = dir ? RECB : RECF;
#pragma unroll
        for (int n = 0; n < 2; ++n) {
            const int ch = ch0 + n * 4;
            const f32x4 bav2 = *(const f32x4*)(ba + dir * DRNN + ch) * (-LOG2E), biv2 = *(const f32x4*)(bi + dir * DRNN + ch) * (-LOG2E), nl = *(const f32x4*)(nls + dir * DRNN + ch);
            const f32x4 nl2 = nl * LOG2E, nlx = nl * 2.0f;
#pragma unroll
            for (int ai = 0; ai < 2; ++ai)
#pragma unroll
                for (int m = 0; m < 4; ++m) {
                    const size_t rowg = (size_t)u.pm * BM + ((ai * HALF + wr * 64 + m * 16 + fr) ^ rmask);
                    const f32x4 uv = bf4_to_f32(*(const u32x2*)(U + rowg * DRNN + ch));
                    float av[4], bv[4];
#pragma unroll
                    for (int j = 0; j < 4; ++j) {
                        const float r = __builtin_amdgcn_rcpf(1.0f + __builtin_amdgcn_exp2f(acc[ai][0][m][n][j] * (-LOG2E) + bav2[j]));
                        const float ig = __builtin_amdgcn_rcpf(1.0f + __builtin_amdgcn_exp2f(acc[ai][1][m][n][j] * (-LOG2E) + biv2[j]));
                        const float x = nlx[j] * r, a = __builtin_amdgcn_exp2f(nl2[j] * r);
                        const float om = (x > -0.0625f) ? -x * (1.0f + x * (0.5f + x * (1.0f / 6.0f + x * (1.0f / 24.0f)))) : 1.0f - a * a;
                        av[j] = a; bv[j] = __builtin_amdgcn_sqrtf(om) * (ig * uv[j]);
                    }
                    scan16x4(av[0], bv[0], av[1], bv[1], av[2], bv[2], av[3], bv[3]);
#pragma unroll
                    for (int j = 0; j < 4; ++j) { acc[ai][0][m][n][j] = av[j]; acc[ai][1][m][n][j] = bv[j]; }
                    __builtin_amdgcn_sched_barrier(0);
                }
        }
        LAS f32x2* segtot = (LAS f32x2*)(lds + 133120);
        LAS float* segcarry = (LAS float*)(lds + 137216);
#pragma unroll
        for (int ai = 0; ai < 2; ++ai)
#pragma unroll
            for (int n = 0; n < 2; ++n) {
                f32x4 As = acc[ai][0][0][n], Bs = acc[ai][1][0][n];
#pragma unroll
                for (int m = 1; m < 4; ++m) { Bs = acc[ai][0][m][n] * Bs + acc[ai][1][m][n]; As = acc[ai][0][m][n] * As; }
                if (fr == 15) {
#pragma unroll
                    for (int j = 0; j < 4; ++j) segtot[(2 * ai + wr) * 128 + wc * 32 + n * 16 + fq * 4 + j] = (f32x2){As[j], Bs[j]};
                }
            }
        asm volatile("s_waitcnt lgkmcnt(0)" ::: "memory"); __builtin_amdgcn_s_barrier(); asm volatile("" ::: "memory");
        const int tid_ = threadIdx.x;
        if (tid_ < 128) {
            float h = 0.0f;
            if (u.po > 0) { unsigned long long* gp = CARRY + (size_t)(u.lin - 160) * 128 + tid_; unsigned long long v; unsigned sp = 0;
                for (;;) { v = __hip_atomic_load(gp, __ATOMIC_RELAXED, __HIP_MEMORY_SCOPE_AGENT); if ((v >> 32) != 0ull) break; __builtin_amdgcn_s_sleep(1); if (++sp > (1u << 22)) break; }
                h = __uint_as_float((unsigned)v); }
#pragma unroll
            for (int sg = 0; sg < 4; ++sg) { segcarry[sg * 128 + tid_] = h; const f32x2 t = segtot[sg * 128 + tid_]; h = t[0] * h + t[1]; }
            if (u.po < 8) __hip_atomic_store(CARRY + (size_t)u.lin * 128 + tid_, (1ull << 32) | (unsigned long long)__float_as_uint(h), __ATOMIC_RELAXED, __HIP_MEMORY_SCOPE_AGENT);
        }
        asm volatile("s_waitcnt lgkmcnt(0)" ::: "memory"); __builtin_amdgcn_s_barrier(); asm volatile("" ::: "memory");
        const bool emit = u.pm < 64;
        const int lastl = (lane & 48) | 15;
        if (emit) {
#pragma unroll
            for (int ai = 0; ai < 2; ++ai) {
                f32x4 hg[2];
#pragma unroll
                for (int n = 0; n < 2; ++n) hg[n] = *(const LAS f32x4*)(segcarry + (2 * ai + wr) * 128 + wc * 32 + n * 16 + fq * 4);
#pragma unroll
                for (int m = 0; m < 4; ++m) {
                    f32x4 h[2];
#pragma unroll
                    for (int n = 0; n < 2; ++n) h[n] = acc[ai][0][m][n] * hg[n] + acc[ai][1][m][n];
                    bf16_t* rp = REC + ((size_t)u.pm * BM + ((ai * HALF + wr * 64 + m * 16 + fr) ^ rmask)) * DRNN + ch0;
                    { u32x4 w; w.x = cvt_pk_bf16(h[0][0], h[0][1]); w.y = cvt_pk_bf16(h[0][2], h[0][3]); w.z = cvt_pk_bf16(h[1][0], h[1][1]); w.w = cvt_pk_bf16(h[1][2], h[1][3]); *(u32x4*)rp = w; }
                    if (m < 3) {
#pragma unroll
                        for (int n = 0; n < 2; ++n)
#pragma unroll
                            for (int j = 0; j < 4; ++j) hg[n][j] = __shfl(h[n][j], lastl);
                    }
                }
            }
        }
    }
};

struct EpiGateMul {
    static constexpr bool WITH_LDS = false, PERM = true;
    bf16_t* Z; const bf16_t* RB;
    __device__ __forceinline__ void operator()(const f32x4 (&acc)[2][2][4][2], const Unit& u, int wr, int wc, int fr_, int fq_) const {
        int fr = fr_, fq = fq_; asm volatile("" : "+v"(fr), "+v"(fq));
        const int col0 = u.pn * BM + wc * 32 + fq * 8;
        const size_t off0 = (size_t)(u.pm * BM + wr * 64 + fr) * DRNN + col0;
#pragma unroll
        for (int ai = 0; ai < 2; ++ai)
#pragma unroll
            for (int m = 0; m < 4; ++m) { const size_t o_ = off0 + (size_t)(ai * HALF + m * 16) * DRNN;
                u32x4 cf[2], cb[2];
#pragma unroll
                for (int bj = 0; bj < 2; ++bj) { cf[bj] = *(const u32x4*)(Z + o_ + bj * HALF); cb[bj] = *(const u32x4*)(RB + o_ + bj * HALF); }
#pragma unroll
                for (int bj = 0; bj < 2; ++bj) { const f32x4 v0 = acc[ai][bj][m][0], v1 = acc[ai][bj][m][1];
                    const f32x4 r0 = bf4_to_f32((u32x2){cf[bj].x, cf[bj].y}) + bf4_to_f32((u32x2){cb[bj].x, cb[bj].y}), r1 = bf4_to_f32((u32x2){cf[bj].z, cf[bj].w}) + bf4_to_f32((u32x2){cb[bj].z, cb[bj].w});
                    f32x4 o0, o1;
#pragma unroll
                    for (int j = 0; j < 4; ++j) { const float x = v0[j]; o0[j] = x * fsigmoid(1.5957691216057308f * (x + 0.044715f * x * x * x)) * r0[j];
                                                  const float y = v1[j]; o1[j] = y * fsigmoid(1.5957691216057308f * (y + 0.044715f * y * y * y)) * r1[j]; }
                    u32x4 w; w.x = cvt_pk_bf16(o0[0], o0[1]); w.y = cvt_pk_bf16(o0[2], o0[3]); w.z = cvt_pk_bf16(o1[0], o1[1]); w.w = cvt_pk_bf16(o1[2], o1[3]);
                    *(u32x4*)(Z + o_ + bj * HALF) = w; }
                asm volatile("" ::: "memory"); }
    }
};
}


#define XB_TMO      128
#define XB_XCNT(j)  (256  + 64 * (j))
#define XB_XSUB(j)  (1280 + 64 * (j))
#define XB_XGEN(j)  (2304 + 64 * (j))
#define XB_TOP      3328
#define XB_TOPGEN   3392
#define XCD_BAR_WORDS 3456
#define XB_SPIN_CAP (1u << 18)
__device__ __forceinline__ unsigned xb_ld(unsigned* p)              { return __hip_atomic_load(p, __ATOMIC_RELAXED, __HIP_MEMORY_SCOPE_AGENT); }
__device__ __forceinline__ unsigned xb_add(unsigned* p, unsigned v) { return __hip_atomic_fetch_add(p, v, __ATOMIC_RELAXED, __HIP_MEMORY_SCOPE_AGENT); }
__device__ __forceinline__ unsigned xb_xcc_id() { return (unsigned)__builtin_amdgcn_s_getreg((3 << 11) | 20) & 0xFu; }
#define XB_SPIN(cond, bar) do { unsigned _sp = 0; while (cond) { __builtin_amdgcn_s_sleep(1); \
    if ((++_sp & 255u) == 0u) { if (xb_ld(&(bar)[XB_TMO])) break; if (_sp > XB_SPIN_CAP) { atomicAdd(&(bar)[XB_TMO], 1u); break; } } } } while (0)
struct XcdBarrier { unsigned* bar; unsigned x; volatile LAS unsigned* st; };
__device__ __forceinline__ XcdBarrier xcd_barrier_post(unsigned* bar, volatile LAS unsigned* st) {
    XcdBarrier b; b.bar = bar; b.x = xb_xcc_id(); b.st = st;
    if (threadIdx.x == 0) (void)xb_add(&bar[XB_XCNT(b.x)], 1u);
    return b;
}
__device__ __forceinline__ void xcd_barrier_complete(unsigned* bar, unsigned x, unsigned& nloc, unsigned& nx) {
    const unsigned G = gridDim.x * gridDim.y * gridDim.z;
    unsigned sum, cnt, mine, sp = 0u;
    for (;;) {
        sum = 0u; cnt = 0u; mine = 0u;
#pragma unroll
        for (unsigned j = 0; j < 16; ++j) { const unsigned c = xb_ld(&bar[XB_XCNT(j)]); sum += c; cnt += (c > 0u) ? 1u : 0u; mine = (j == x) ? c : mine; }
        if (sum == G) break;
        __builtin_amdgcn_s_sleep(1);
        if ((++sp & 255u) == 0u) { if (xb_ld(&bar[XB_TMO])) break; if (sp > XB_SPIN_CAP) { atomicAdd(&bar[XB_TMO], 1u); break; } }
    }
    nloc = mine > 0u ? mine : 1u; nx = cnt > 0u ? cnt : 1u;
}
__device__ __forceinline__ void xcd_barrier(const XcdBarrier& b) {
    asm volatile("s_waitcnt vmcnt(0)" ::: "memory");
    __syncthreads();
    if (threadIdx.x == 0) {
        unsigned* bar = b.bar;
        __builtin_amdgcn_s_waitcnt(0);
        unsigned nloc = b.st[0], nx = b.st[1];
        if (nloc == 0u) { xcd_barrier_complete(bar, b.x, nloc, nx); b.st[0] = nloc; b.st[1] = nx; }
        const unsigned old = xb_add(&bar[XB_XSUB(b.x)], 1u);
        const unsigned gen = old / nloc;
        if (old + 1u == (gen + 1u) * nloc) {
            __builtin_amdgcn_fence(__ATOMIC_RELEASE, "agent");
            asm volatile("s_waitcnt vmcnt(0)" ::: "memory");
            const unsigned og = xb_add(&bar[XB_TOP], 1u);
            const unsigned tg = og / nx;
            if (og + 1u == (tg + 1u) * nx) xb_add(&bar[XB_TOPGEN], 1u);
            else XB_SPIN(xb_ld(&bar[XB_TOPGEN]) == tg, bar);
            __builtin_amdgcn_fence(__ATOMIC_ACQUIRE, "agent");
            xb_add(&bar[XB_XGEN(b.x)], 1u);
            asm volatile("s_waitcnt vmcnt(0)" ::: "memory");
        } else {
            XB_SPIN(xb_ld(&bar[XB_XGEN(b.x)]) == gen, bar);
            __builtin_amdgcn_fence(__ATOMIC_ACQUIRE, "agent");
            asm volatile("s_waitcnt vmcnt(0)" ::: "memory");
        }
    }
    __syncthreads();
}

struct Params {
    const float *x, *c, *ctx, *c_ctx, *ada_w, *ada_b, *norm_g, *mlp_w1, *mlp_w2, *w_qkv, *w_o, *sink;
    const float *w_in, *conv_w, *conv_b, *w_a, *b_a, *w_i, *b_i, *lam, *w_out;
    float* out; unsigned char* ws;
};

typedef const __attribute__((address_space(4))) Params* ParamsK;
__device__ __forceinline__ void transpose_item(const float* W, int ldw, bf16_t* WT, int ldwt, int k0, int n0, int dst_row0, LAS float* scr, int lane) {
#pragma unroll 8
    for (int i = 0; i < 32; ++i) { const int kk = 2 * i + (lane >> 5); scr[kk * 33 + (lane & 31)] = W[(size_t)(k0 + kk) * ldw + n0 + (lane & 31)]; }
    asm volatile("s_waitcnt lgkmcnt(0)" ::: "memory");
    const int c = lane & 7;
#pragma unroll
    for (int j = 0; j < 4; ++j) { const int n = (lane >> 3) + 8 * j; const LAS float* s = scr + (8 * c) * 33 + n;
        u32x4 o; o.x = cvt_pk_bf16(s[0 * 33], s[1 * 33]); o.y = cvt_pk_bf16(s[2 * 33], s[3 * 33]); o.z = cvt_pk_bf16(s[4 * 33], s[5 * 33]); o.w = cvt_pk_bf16(s[6 * 33], s[7 * 33]);
        *(u32x4*)(WT + (size_t)(dst_row0 + n) * ldwt + k0 + 8 * c) = o; }
    asm volatile("s_waitcnt lgkmcnt(0)" ::: "memory");
}
__device__ __forceinline__ void transpose_plain(const float* W, int K, int N, bf16_t* WT, int r, LAS float* scr, int lane) {
    const int nblk = N / 32, kb = r / nblk, nb = r % nblk;
    transpose_item(W, N, WT, K, 64 * kb, 32 * nb, 32 * nb, scr, lane);
}

constexpr int I_QKV = 16 * 48, I_O = 16 * 32, I_1 = 16 * 128, I_2 = 64 * 32, I_IN = 16 * 80, I_OUT = 20 * 32, I_G = 40 * 16;
constexpr int TR_L0 = I_QKV + I_O + I_1 + I_2, TR_LRU = I_IN + I_OUT + I_G, TR_MLP1 = I_1 + I_2;
struct TrItem { const float* W; bf16_t* WT; int ldw, ldwt, k0, n0, drow; };
__device__ __forceinline__ TrItem tr_decode(ParamsK p, unsigned char* ws, int it) {
    TrItem d; int r = it;
#define TR_PLAIN(Wp, K_, N_, WTp) do { const int nblk_ = (N_) / 32, kb_ = r / nblk_, nb_ = r % nblk_; d.W = (Wp); d.WT = (WTp); d.ldw = (N_); d.ldwt = (K_); d.k0 = 64 * kb_; d.n0 = 32 * nb_; d.drow = 32 * nb_; return d; } while (0)
    if (r < I_QKV) TR_PLAIN(p->w_qkv, 1024, NQKV, (bf16_t*)(ws + WS_WQKV)); r -= I_QKV;
    if (r < I_O) TR_PLAIN(p->w_o, 1024, 1024, (bf16_t*)(ws + WS_WO)); r -= I_O;
    if (r < I_1) TR_PLAIN(p->mlp_w1, 1024, DFF, (bf16_t*)(ws + WS_W1)); r -= I_1;
    if (r < I_2) TR_PLAIN(p->mlp_w2, DFF, 1024, (bf16_t*)(ws + WS_W2)); r -= I_2;
    if (r < I_IN) TR_PLAIN(p->w_in, 1024, 2 * DRNN, (bf16_t*)(ws + WS_WIN)); r -= I_IN;
    if (r < I_OUT) TR_PLAIN(p->w_out, DRNN, 1024, (bf16_t*)(ws + WS_WOUT)); r -= I_OUT;
    if (r < I_G) {
        const int sm = r >> 4, ii = r & 15, kb = ii >> 2, nb = ii & 3;
        const int chalf = sm & 1, blk = (sm >> 1) % 5, dg = (sm >> 1) / 5, gate = dg & 1, dir = dg >> 1;
        d.W = (gate ? p->w_i : p->w_a) + (size_t)(dir * 5 + blk) * 256 * 256; d.WT = (bf16_t*)(ws + WS_WG); d.ldw = 256; d.ldwt = 256;
        d.k0 = 64 * kb; d.n0 = chalf * 128 + nb * 32; d.drow = ((dir * 5 + blk) * 2 + chalf) * 256 + gate * 128 + nb * 32; return d; }
    r -= I_G;
    if (r < I_1) TR_PLAIN(p->mlp_w1 + (size_t)1024 * DFF, 1024, DFF, (bf16_t*)(ws + WS_W1 + 16 * MiB)); r -= I_1;
    TR_PLAIN(p->mlp_w2 + (size_t)1024 * DFF, DFF, 1024, (bf16_t*)(ws + WS_W2 + 16 * MiB));
#undef TR_PLAIN
}
__device__ __forceinline__ void transpose_range(ParamsK p, unsigned char* ws, LAS unsigned char* lds, int first, int count, int w, int nw, int wave, int lane) {
    LAS float* scr = (LAS float*)(lds + wave * 16384);
    int it = first + w; if (it >= first + count) return;
    float cur[32], nxt[32];
    TrItem d = tr_decode(p, ws, it);
#pragma unroll
    for (int i = 0; i < 32; ++i) cur[i] = d.W[(size_t)(d.k0 + 2 * i + (lane >> 5)) * d.ldw + d.n0 + (lane & 31)];
    for (;;) {
        const int itn = it + nw; const bool more = itn < first + count;
        TrItem dn = d;
        if (more) { dn = tr_decode(p, ws, itn);
#pragma unroll
            for (int i = 0; i < 32; ++i) nxt[i] = dn.W[(size_t)(dn.k0 + 2 * i + (lane >> 5)) * dn.ldw + dn.n0 + (lane & 31)]; }
#pragma unroll
        for (int i = 0; i < 32; ++i) scr[(2 * i + (lane >> 5)) * 33 + (lane & 31)] = cur[i];
        asm volatile("s_waitcnt lgkmcnt(0)" ::: "memory");
        const int c = lane & 7;
#pragma unroll
        for (int j = 0; j < 4; ++j) { const int n = (lane >> 3) + 8 * j; const LAS float* s = scr + (8 * c) * 33 + n;
            u32x4 o; o.x = cvt_pk_bf16(s[0 * 33], s[1 * 33]); o.y = cvt_pk_bf16(s[2 * 33], s[3 * 33]); o.z = cvt_pk_bf16(s[4 * 33], s[5 * 33]); o.w = cvt_pk_bf16(s[6 * 33], s[7 * 33]);
            *(u32x4*)(d.WT + (size_t)(d.drow + n) * d.ldwt + d.k0 + 8 * c) = o; }
        asm volatile("s_waitcnt lgkmcnt(0)" ::: "memory");
        if (!more) break;
#pragma unroll
        for (int i = 0; i < 32; ++i) cur[i] = nxt[i];
        d = dn; it = itn;
    }
}
__device__ __forceinline__ void idle_transposes(ParamsK p, unsigned char* ws, LAS unsigned char* lds, int first, int count, int nwg, int G, int bid, int wave, int lane) {
    const int rem = nwg % G;
    if (rem == 0) transpose_range(p, ws, lds, first, count, bid * 8 + wave, G * 8, wave, lane);
    else if (bid >= rem) transpose_range(p, ws, lds, first, count, (bid - rem) * 8 + wave, (G - rem) * 8, wave, lane);
    __syncthreads();
}

__device__ __forceinline__ void prologue(ParamsK p, LAS unsigned char* lds, int tid, int lane, int wave) {
    unsigned char* ws = p->ws;
    float* MOD = (float*)(ws + WS_MOD);
    if (blockIdx.x < 192) {
        LAS float* sl = (LAS float*)lds;
        LAS float* red = (LAS float*)(lds + 36864);
        for (int idx = tid; idx < 9216; idx += 512) { const int w = idx >> 10, k = idx & 1023; const float v = (w < 8) ? p->c[w * 1024 + k] : p->c_ctx[k]; sl[idx] = v / (1.0f + __expf(-v)); }
        __syncthreads();
        const int l = blockIdx.x / 96, n0 = (blockIdx.x % 96) * 64, kg = tid >> 4, cq = tid & 15;
        f32x4 acc[9];
#pragma unroll
        for (int w = 0; w < 9; ++w) acc[w] = (f32x4){0.f, 0.f, 0.f, 0.f};
        const float* wb = p->ada_w + (size_t)l * 1024 * 6144 + n0 + cq * 4;
#pragma unroll 1
        for (int it0 = 0; it0 < 32; it0 += 8) {
            f32x4 w4[8];
#pragma unroll
            for (int u = 0; u < 8; ++u) w4[u] = *(const f32x4*)(wb + (size_t)((it0 + u) * 32 + kg) * 6144);
#pragma unroll
            for (int u = 0; u < 8; ++u) { const int k = (it0 + u) * 32 + kg;
#pragma unroll
                for (int w = 0; w < 9; ++w) acc[w] += sl[w * 1024 + k] * w4[u]; }
        }
#pragma unroll
        for (int w = 0; w < 9; ++w) *(LAS f32x4*)(red + (kg * 9 + w) * 64 + cq * 4) = acc[w];
        __syncthreads();
        for (int idx = tid; idx < 9 * 64; idx += 512) { const int w = idx >> 6, n = idx & 63; float s = 0.f;
#pragma unroll
            for (int g = 0; g < 32; ++g) s += red[(g * 9 + w) * 64 + n];
            MOD[(size_t)(l * 9 + w) * 6144 + n0 + n] = s + p->ada_b[l * 6144 + n0 + n]; }
        __syncthreads();
    }
    if (blockIdx.x == gridDim.x - 1) {
        float* rope = (float*)(ws + WS_ROPE); float* nls = (float*)(ws + WS_NLS);
        for (int idx = tid; idx < 1024; idx += 512) { const int pos = idx >> 4, i = idx & 15;
            const float inv = __builtin_exp2f(-(float)i * (13.287712379549449f / 16.0f));
            const float angf = (float)pos * inv; const double ang = (double)angf;
            const double twopi = 6.283185307179586476925287; const double r = ang - twopi * __builtin_rint(ang / twopi);
            const double r2 = r * r; double cterm = 1.0, sterm = r, cs = 1.0, sn = r;
            for (int k = 1; k <= 14; ++k) { cterm *= -r2 / (double)((2 * k - 1) * (2 * k)); sterm *= -r2 / (double)((2 * k) * (2 * k + 1)); cs += cterm; sn += sterm; }
            rope[idx * 2] = (float)cs; rope[idx * 2 + 1] = (float)sn; }
        for (int idx = tid; idx < 2 * DRNN; idx += 512) { const float lm = p->lam[idx]; nls[idx] = -8.0f * log1pf(__expf(-lm)); }
        { unsigned* fl = (unsigned*)(ws + WS_FLAG); for (int idx = tid; idx < 1440 * 16; idx += 512) fl[idx] = 0u; }
    }
    transpose_range(p, ws, lds, 0, TR_L0 + TR_LRU + TR_MLP1, blockIdx.x * 8 + wave, gridDim.x * 8, wave, lane);
}

template <bool HAS_Y, bool HAS_H, bool XIN_BF, bool XOUT_BF>
__device__ __forceinline__ void row_phase(const void* xin_lat, const void* xin_ctx, void* xout_lat, void* xout_ctx, const bf16_t* Y, const bf16_t* SLAB, bf16_t* H,
                                          const float* gy, const float* gh, const float* mod_g, int gate_idx, const float* mod_h, int shift_idx, int scale_idx,
                                          int nrows, int gw, int ngw, int lane) {
    const int rpw = (nrows + ngw - 1) / ngw, r_begin = gw * rpw, r_end = (r_begin + rpw < nrows) ? r_begin + rpw : nrows;
    f32x4 xn[4]; u32x2 xb[4], yn[4], ys[3][4];
    f32x4 vgy[4], vgh[4], vgt[4], vsh[4], vsc[4];
#pragma unroll
    for (int j = 0; j < 4; ++j) { if (HAS_Y) vgy[j] = *(const f32x4*)(gy + lane * 4 + 256 * j); if (HAS_H) vgh[j] = *(const f32x4*)(gh + lane * 4 + 256 * j); }
    int cur_who = -1;
#define ROW_LOAD(r) do { const int r_ = (r); const bool lat_ = r_ < ML; const size_t ro_ = lat_ ? (size_t)r_ * DM : (size_t)(r_ - ML) * DM; \
        if (XIN_BF) { const bf16_t* xi_ = (const bf16_t*)(lat_ ? xin_lat : xin_ctx) + ro_; _Pragma("unroll") for (int j = 0; j < 4; ++j) xb[j] = *(const u32x2*)(xi_ + lane * 4 + 256 * j); } \
        else { const float* xi_ = (const float*)(lat_ ? xin_lat : xin_ctx) + ro_; _Pragma("unroll") for (int j = 0; j < 4; ++j) xn[j] = *(const f32x4*)(xi_ + lane * 4 + 256 * j); } \
        if (HAS_Y) { if (SLAB != nullptr && !lat_) { const bf16_t* yp_ = SLAB + (size_t)(r_ - ML) * DM + lane * 4; \
                _Pragma("unroll") for (int j = 0; j < 4; ++j) { yn[j] = *(const u32x2*)(yp_ + 256 * j); ys[0][j] = *(const u32x2*)(yp_ + 256 * j + (size_t)MC * DM); ys[1][j] = *(const u32x2*)(yp_ + 256 * j + (size_t)2 * MC * DM); ys[2][j] = *(const u32x2*)(yp_ + 256 * j + (size_t)3 * MC * DM); } } \
            else { _Pragma("unroll") for (int j = 0; j < 4; ++j) yn[j] = *(const u32x2*)(Y + (size_t)r_ * DM + lane * 4 + 256 * j); } } } while (0)
    if (r_begin < r_end) ROW_LOAD(r_begin);
    for (int row = r_begin; row < r_end; ++row) {
        const bool lat = row < ML; const int who = lat ? (row >> 11) : 8;
        if (who != cur_who) { cur_who = who;
#pragma unroll
            for (int j = 0; j < 4; ++j) { const int col = lane * 4 + 256 * j;
                if (HAS_Y) vgt[j] = *(const f32x4*)(mod_g + (size_t)who * 6144 + gate_idx * 1024 + col);
                if (HAS_H) { vsh[j] = *(const f32x4*)(mod_h + (size_t)who * 6144 + shift_idx * 1024 + col); vsc[j] = *(const f32x4*)(mod_h + (size_t)who * 6144 + scale_idx * 1024 + col) + 1.0f; } } }
        f32x4 xv[4], yv[4];
#pragma unroll
        for (int j = 0; j < 4; ++j) xv[j] = XIN_BF ? bf4_to_f32(xb[j]) : xn[j];
        if (HAS_Y) {
#pragma unroll
            for (int j = 0; j < 4; ++j) { yv[j] = bf4_to_f32(yn[j]);
                if (SLAB != nullptr && !lat) yv[j] = (yv[j] + bf4_to_f32(ys[0][j])) + (bf4_to_f32(ys[1][j]) + bf4_to_f32(ys[2][j])); }
        }
        asm volatile("" ::: "memory");
        if (row + 1 < r_end) ROW_LOAD(row + 1);
        if (HAS_Y) {
            float s = 0.f;
#pragma unroll
            for (int j = 0; j < 4; ++j) s += (yv[j][0] * yv[j][0] + yv[j][1] * yv[j][1]) + (yv[j][2] * yv[j][2] + yv[j][3] * yv[j][3]);
            const float rstd = 1.0f / sqrtf(wave_sum(s) * (1.0f / DM) + EPS);
            const size_t ro = lat ? (size_t)row * DM : (size_t)(row - ML) * DM;
#pragma unroll
            for (int j = 0; j < 4; ++j) { xv[j] = xv[j] + vgt[j] * (yv[j] * rstd * vgy[j]);
                if (XOUT_BF) { const u32x2 w = f32_to_bf4(xv[j]); *(u32x2*)((bf16_t*)(lat ? xout_lat : xout_ctx) + ro + lane * 4 + 256 * j) = w; xv[j] = bf4_to_f32(w); }
                else *(f32x4*)((float*)(lat ? xout_lat : xout_ctx) + ro + lane * 4 + 256 * j) = xv[j]; }
        }
        if (HAS_H) {
            float s = 0.f;
#pragma unroll
            for (int j = 0; j < 4; ++j) s += (xv[j][0] * xv[j][0] + xv[j][1] * xv[j][1]) + (xv[j][2] * xv[j][2] + xv[j][3] * xv[j][3]);
            const float rstd = 1.0f / sqrtf(wave_sum(s) * (1.0f / DM) + EPS);
#pragma unroll
            for (int j = 0; j < 4; ++j) { const f32x4 hv = (xv[j] * rstd * vgh[j]) * vsc[j] + vsh[j]; *(u32x2*)(H + (size_t)row * DM + lane * 4 + 256 * j) = f32_to_bf4(hv); }
        }
    }
#undef ROW_LOAD
}

__device__ __forceinline__ void attn_phase(LAS unsigned char* lds, const bf16_t* Q, bf16_t* O, const bf16_t* Kb, const bf16_t* VT, const bf16_t* VTC, const float* sink, int tid, int lane, int wave) {
    constexpr int PITCH = 72;
    LAS bf16_t* Ks = (LAS bf16_t*)lds;
    LAS bf16_t* Vs = (LAS bf16_t*)(lds + 2 * 64 * PITCH * 2);
    const int lr = lane & 15, lg = lane >> 4;
    const int skey = tid >> 3, spiece = tid & 7;
    for (int unit = blockIdx.x; unit < 576; unit += gridDim.x) {
        int b, kvh, qrow0, qblk, nloc, lt0; bool latu = unit < 512;
        if (latu) { b = unit >> 6; const int rem = unit & 63; qblk = rem >> 2; kvh = rem & 3; qrow0 = b * SEQ + qblk * 128; lt0 = (qblk == 0) ? 2 : 0; nloc = ((qblk == 15) ? 4 : 6) - lt0; }
        else { const int cu = unit - 512; b = cu >> 3; kvh = (cu & 7) >> 1; qblk = 0; qrow0 = ML + b * CTX + (cu & 1) * 128; lt0 = 0; nloc = 0; }
        const int nlo = (latu && qblk > 0) ? 2 : 0, nmid = latu ? 2 : 0, nup = (latu && qblk < 15) ? 2 : 0;
        const int n1 = nlo, n2 = nlo + nmid, n3 = n2 + 4, nT = n3 + nup; (void)nloc; (void)lt0;
        const int head = kvh * 4 + (wave >> 1);
        const int qr0 = qrow0 + (wave & 1) * 64;
        const bf16_t* qbase = Q + (size_t)qr0 * 1024 + head * 64;
        bf16_t* obase = O + (size_t)qr0 * 1024 + head * 64;
        LAS unsigned char* Qs = lds + 40960 + wave * 8192;
#pragma unroll
        for (int qt = 0; qt < 4; ++qt)
#pragma unroll
            for (int dh = 0; dh < 2; ++dh) *(LAS bf16x8*)(Qs + (qt * 2 + dh) * 1024 + lane * 16) = *(const bf16x8*)(qbase + (unsigned)((qt * 16 + lr) * 1024 + dh * 32 + lg * 8));
        f32x4 o[4][4];
#pragma unroll
        for (int qt = 0; qt < 4; ++qt)
#pragma unroll
            for (int dt = 0; dt < 4; ++dt) o[qt][dt] = (f32x4){0.f, 0.f, 0.f, 0.f};
        float m2[4], ls[4];
        { const float sk = sink[head] * LOG2E;
#pragma unroll
          for (int qt = 0; qt < 4; ++qt) { m2[qt] = sk; ls[qt] = (lg == 0) ? 1.0f : 0.0f; } }
        u32x4 kreg, vreg;
#define ATT_TOK0(j_) ((qblk - 1) * 128 + (((j_) < n1) ? (j_) : (((j_) < n2) ? 2 + (j_) - n1 : 4 + (j_) - n3)) * 64)
#define ATT_LOAD(j) do { const int _j = (j); if (_j < n2 || _j >= n3) { const int tok0 = ATT_TOK0(_j); \
                const bf16_t* kb_ = Kb + (size_t)(b * SEQ + tok0) * 256 + kvh * 64; const bf16_t* vb_ = VT + (size_t)(b * 4 + kvh) * 64 * SEQ + tok0; \
                kreg = *(const u32x4*)(kb_ + (unsigned)(skey * 256 + spiece * 8)); vreg = *(const u32x4*)(vb_ + (unsigned)(skey * SEQ + spiece * 8)); } \
            else { const int tok0 = (_j - n2) * 64; \
                const bf16_t* kb_ = Kb + (size_t)(ML + b * CTX + tok0) * 256 + kvh * 64; const bf16_t* vb_ = VTC + (size_t)(b * 4 + kvh) * 64 * CTX + tok0; \
                kreg = *(const u32x4*)(kb_ + (unsigned)(skey * 256 + spiece * 8)); vreg = *(const u32x4*)(vb_ + (unsigned)(skey * CTX + spiece * 8)); } } while (0)
#define ATT_STORE(buf) do { *(LAS u32x4*)(Ks + (buf) * 64 * PITCH + skey * PITCH + spiece * 8) = kreg; *(LAS u32x4*)(Vs + (buf) * 64 * PITCH + skey * PITCH + spiece * 8) = vreg; } while (0)
        __syncthreads();
        ATT_LOAD(0); ATT_STORE(0);
        __syncthreads();
#define ATT_BODY(MM) { \
            const int buf = j & 1; \
            if (j + 1 < nT) ATT_LOAD(j + 1); \
            const LAS bf16_t* Kt = Ks + buf * 64 * PITCH; const LAS bf16_t* Vt = Vs + buf * 64 * PITCH; \
            const int ktok0 = ATT_TOK0(j); \
            bf16x8 kf[4][2]; \
            _Pragma("unroll") \
            for (int ks = 0; ks < 4; ++ks) \
            _Pragma("unroll") \
                for (int dh = 0; dh < 2; ++dh) kf[ks][dh] = *(const LAS bf16x8*)(Kt + (ks * 16 + lr) * PITCH + dh * 32 + lg * 8); \
            _Pragma("unroll") \
            for (int hq = 0; hq < 2; ++hq) { \
            bf16x8 pb[2][2]; \
            _Pragma("unroll") \
            for (int q2 = 0; q2 < 2; ++q2) { \
                const int qt = hq * 2 + q2; \
                f32x4 s[4]; \
                const bf16x8 qf0 = *(const LAS bf16x8*)(Qs + (qt * 2 + 0) * 1024 + lane * 16), qf1 = *(const LAS bf16x8*)(Qs + (qt * 2 + 1) * 1024 + lane * 16); \
            _Pragma("unroll") \
                for (int ks = 0; ks < 4; ++ks) { s[ks] = __builtin_amdgcn_mfma_f32_16x16x32_bf16(kf[ks][0], qf0, (f32x4){0.f, 0.f, 0.f, 0.f}, 0, 0, 0); \
                    s[ks] = __builtin_amdgcn_mfma_f32_16x16x32_bf16(kf[ks][1], qf1, s[ks], 0, 0, 0); } \
                if (MM == 1) {    \
                    const int lim = qblk * 128 + (wave & 1) * 64 + qt * 16 + lr - 128 - ktok0 - lg * 4; \
            _Pragma("unroll") \
                    for (int ks = 0; ks < 4; ++ks) \
            _Pragma("unroll") \
                        for (int jj = 0; jj < 4; ++jj) s[ks][jj] = (ks * 16 + jj >= lim) ? s[ks][jj] : -1e30f; \
                } else if (MM == 2) {    \
                    const int lim = qblk * 128 + (wave & 1) * 64 + qt * 16 + lr + 128 - ktok0 - lg * 4; \
            _Pragma("unroll") \
                    for (int ks = 0; ks < 4; ++ks) \
            _Pragma("unroll") \
                        for (int jj = 0; jj < 4; ++jj) s[ks][jj] = (ks * 16 + jj <= lim) ? s[ks][jj] : -1e30f; \
                } \
                float mx = -3e38f; \
            _Pragma("unroll") \
                for (int ks = 0; ks < 4; ++ks) mx = fmaxf(mx, fmaxf(fmaxf(s[ks][0], s[ks][1]), fmaxf(s[ks][2], s[ks][3]))); \
                mx = fmaxf(mx, __shfl_xor(mx, 16)); mx = fmaxf(mx, __shfl_xor(mx, 32)); \
                const float mnew = fmaxf(m2[qt], mx * LOG2E); \
                const float alpha = __builtin_amdgcn_exp2f(m2[qt] - mnew); \
                m2[qt] = mnew; \
                float rs = 0.f; \
            _Pragma("unroll") \
                for (int ks = 0; ks < 4; ++ks) \
            _Pragma("unroll") \
                    for (int jj = 0; jj < 4; ++jj) { const float pv = __builtin_amdgcn_exp2f(s[ks][jj] * LOG2E - mnew); s[ks][jj] = pv; rs += pv; } \
                ls[qt] = ls[qt] * alpha + rs; \
            _Pragma("unroll") \
                for (int dt = 0; dt < 4; ++dt) o[qt][dt] = o[qt][dt] * alpha; \
            _Pragma("unroll") \
                for (int c2 = 0; c2 < 2; ++c2) { u32x4 w; w.x = cvt_pk_bf16(s[2 * c2][0], s[2 * c2][1]); w.y = cvt_pk_bf16(s[2 * c2][2], s[2 * c2][3]); w.z = cvt_pk_bf16(s[2 * c2 + 1][0], s[2 * c2 + 1][1]); w.w = cvt_pk_bf16(s[2 * c2 + 1][2], s[2 * c2 + 1][3]); \
                    pb[q2][c2] = __builtin_bit_cast(bf16x8, w); } \
            } \
            _Pragma("unroll") \
            for (int c2 = 0; c2 < 2; ++c2) \
            _Pragma("unroll") \
                for (int dt = 0; dt < 4; ++dt) { \
                    const LAS bf16_t* vp = Vt + (dt * 16 + lr) * PITCH + c2 * 32 + lg * 4; \
                    const u32x2 v0 = *(const LAS u32x2*)vp, v1 = *(const LAS u32x2*)(vp + 16); \
                    const u32x4 vv = {v0.x, v0.y, v1.x, v1.y}; \
                    const bf16x8 vf = __builtin_bit_cast(bf16x8, vv); \
            _Pragma("unroll") \
                    for (int q2 = 0; q2 < 2; ++q2) o[hq * 2 + q2][dt] = __builtin_amdgcn_mfma_f32_16x16x32_bf16(vf, pb[q2][c2], o[hq * 2 + q2][dt], 0, 0, 0); \
                } \
            } \
            if (j + 1 < nT) ATT_STORE(buf ^ 1); \
            __syncthreads(); \
        }
        int j = 0;
#pragma unroll 1
        for (; j < n1; ++j) ATT_BODY(1)
#pragma unroll 1
        for (; j < n3; ++j) ATT_BODY(0)
#pragma unroll 1
        for (; j < nT; ++j) ATT_BODY(2)
#undef ATT_BODY
#pragma unroll
        for (int qt = 0; qt < 4; ++qt) {
            float l = ls[qt]; l += __shfl_xor(l, 16); l += __shfl_xor(l, 32);
            const float inv = 1.0f / l;
            int lro = lr * 1024 + lg * 4; asm volatile("" : "+v"(lro));
            bf16_t* op = obase + (unsigned)(qt * 16 * 1024 + lro);
#pragma unroll
            for (int dt = 0; dt < 4; ++dt) *(u32x2*)(op + dt * 16) = f32_to_bf4(o[qt][dt] * inv);
        }
    }
#undef ATT_LOAD
#undef ATT_TOK0
#undef ATT_STORE
}

__device__ __forceinline__ void conv_phase(const bf16_t* R, bf16_t* U, const float* cw, const float* cb, int gtid, int nthreads) {
    for (int idx = gtid; idx < MT * 160; idx += nthreads) {
        const int row = idx / 160, ch = (idx % 160) * 8;
        int t, T; if (row < ML) { t = row & 2047; T = SEQ; } else { t = (row - ML) & 255; T = CTX; }
        float acc[8];
        { const f32x4 b0 = *(const f32x4*)(cb + ch), b1 = *(const f32x4*)(cb + ch + 4); acc[0] = b0[0]; acc[1] = b0[1]; acc[2] = b0[2]; acc[3] = b0[3]; acc[4] = b1[0]; acc[5] = b1[1]; acc[6] = b1[2]; acc[7] = b1[3]; }
#pragma unroll
        for (int tap = 0; tap < 4; ++tap) { const int tt = t + tap - 2;
            if (tt >= 0 && tt < T) { const u32x4 rv = *(const u32x4*)(R + (size_t)(row + tap - 2) * DRNN + ch);
                const f32x4 w0 = *(const f32x4*)(cw + tap * DRNN + ch), w1 = *(const f32x4*)(cw + tap * DRNN + ch + 4);
                acc[0] += w0[0] * bf_lo(rv.x); acc[1] += w0[1] * bf_hi(rv.x); acc[2] += w0[2] * bf_lo(rv.y); acc[3] += w0[3] * bf_hi(rv.y);
                acc[4] += w1[0] * bf_lo(rv.z); acc[5] += w1[1] * bf_hi(rv.z); acc[6] += w1[2] * bf_lo(rv.w); acc[7] += w1[3] * bf_hi(rv.w); } }
        u32x4 o; o.x = cvt_pk_bf16(acc[0], acc[1]); o.y = cvt_pk_bf16(acc[2], acc[3]); o.z = cvt_pk_bf16(acc[4], acc[5]); o.w = cvt_pk_bf16(acc[6], acc[7]);
        *(u32x4*)(U + (size_t)row * DRNN + ch) = o;
    }
}
__device__ __forceinline__ int scan_row0(int bl, int c) { return (c < 8) ? (8192 + bl * CTX + c * 32) : (bl * SEQ + (c - 8) * 32); }
__device__ __forceinline__ void scanA_phase(const bf16_t* LA, const bf16_t* BX, float* SP, float* SH, int gtid, int nthreads) {
    for (int idx = gtid; idx < 2 * 4 * 72 * 640; idx += nthreads) {
        const int cp = idx % 640, r1 = idx / 640, c = r1 % 72, r2 = r1 / 72, bl = r2 & 3, dir = r2 >> 2;
        const int row0 = scan_row0(bl, c);
        const size_t base = ((size_t)dir * 9216 + row0) * DRNN + cp * 2;
        float P0 = 1.f, P1 = 1.f, H0 = 0.f, H1 = 0.f;
#pragma unroll 8
        for (int i = 0; i < 32; ++i) { const int ii = dir ? (31 - i) : i;
            const unsigned lw = *(const unsigned*)(LA + base + (size_t)ii * DRNN), bw = *(const unsigned*)(BX + base + (size_t)ii * DRNN);
            const float a0 = __expf(bf_lo(lw)), a1 = __expf(bf_hi(lw));
            P0 *= a0; P1 *= a1; H0 = a0 * H0 + bf_lo(bw); H1 = a1 * H1 + bf_hi(bw); }
        const size_t so = ((size_t)(dir * 4 + bl) * 72 + c) * DRNN + cp * 2;
        *(f32x2*)(SP + so) = (f32x2){P0, P1}; *(f32x2*)(SH + so) = (f32x2){H0, H1};
    }
}
__device__ __forceinline__ void scanB_phase(const float* SP, const float* SH, float* CIN, int gtid, int nthreads) {
    for (int idx = gtid; idx < 2 * 4 * DRNN; idx += nthreads) {
        const int ch = idx % DRNN, r = idx / DRNN, bl = r & 3, dir = r >> 2;
        const size_t base = ((size_t)(dir * 4 + bl) * 72) * DRNN + ch;
        float carry = 0.f;
#pragma unroll 1
        for (int s0 = 0; s0 < 72; s0 += 24) {
            float pv[24], hv[24];
#pragma unroll
            for (int s = 0; s < 24; ++s) { const int sq = s0 + s; const int c = dir ? (sq < 8 ? 7 - sq : 79 - sq) : sq; pv[s] = SP[base + (size_t)c * DRNN]; hv[s] = SH[base + (size_t)c * DRNN]; }
#pragma unroll
            for (int s = 0; s < 24; ++s) { const int sq = s0 + s; const int c = dir ? (sq < 8 ? 7 - sq : 79 - sq) : sq; CIN[base + (size_t)c * DRNN] = carry; carry = pv[s] * carry + hv[s]; }
        }
    }
}
__device__ __forceinline__ void scanC_phase(const bf16_t* LA, const bf16_t* BX, const float* CIN, bf16_t* REC, int half, int gtid, int nthreads) {
    for (int idx = gtid; idx < 4 * 64 * 640; idx += nthreads) {
        const int cp = idx % 640, r1 = idx / 640, lc = r1 & 63, bl = r1 >> 6;
        const int row0 = bl * SEQ + lc * 32;
        const size_t b0 = ((size_t)row0) * DRNN + cp * 2, b1 = ((size_t)9216 + row0) * DRNN + cp * 2;
        const f32x2 cf = *(const f32x2*)(CIN + ((size_t)(0 * 4 + bl) * 72 + 8 + lc) * DRNN + cp * 2);
        const f32x2 cbk = *(const f32x2*)(CIN + ((size_t)(1 * 4 + bl) * 72 + 8 + lc) * DRNN + cp * 2);
        float hf0[32], hf1[32];
        float h0 = cf[0], h1 = cf[1];
#pragma unroll
        for (int i = 0; i < 32; ++i) { const unsigned lw = *(const unsigned*)(LA + b0 + (size_t)i * DRNN), bw = *(const unsigned*)(BX + b0 + (size_t)i * DRNN);
            h0 = __expf(bf_lo(lw)) * h0 + bf_lo(bw); h1 = __expf(bf_hi(lw)) * h1 + bf_hi(bw); hf0[i] = h0; hf1[i] = h1; }
        h0 = cbk[0]; h1 = cbk[1];
        bf16_t* out = REC + ((size_t)(half * 4 + bl) * SEQ + lc * 32) * DRNN + cp * 2;
#pragma unroll
        for (int i = 31; i >= 0; --i) { const unsigned lw = *(const unsigned*)(LA + b1 + (size_t)i * DRNN), bw = *(const unsigned*)(BX + b1 + (size_t)i * DRNN);
            h0 = __expf(bf_lo(lw)) * h0 + bf_lo(bw); h1 = __expf(bf_hi(lw)) * h1 + bf_hi(bw);
            *(unsigned*)(out + (size_t)i * DRNN) = cvt_pk_bf16(hf0[i] + h0, hf1[i] + h1); }
    }
}

#ifndef PH_MASK
#define PH_MASK 0xFFFFFFFFu
#endif
#define PH(k) ((PH_MASK >> (k)) & 1u)
#ifndef REP_MASK
#define REP_MASK 0u
#endif
#define REP_BEGIN(k) _Pragma("unroll 1") for (int rep_ = 0; rep_ < (((REP_MASK >> (k)) & 1u) ? 2 : 1); ++rep_) {
#define REP_END }
__device__ __forceinline__ ParamsK kparams() { ParamsK q = (ParamsK)__builtin_amdgcn_kernarg_segment_ptr(); asm volatile("" : "+s"(q)); return q; }
#define PHASE_BEGIN ParamsK kp = kparams(); unsigned char* ws = kp->ws; (void)ws; \
    int tid = threadIdx.x; asm volatile("" : "+v"(tid)); const int lane = tid & 63, wave = __builtin_amdgcn_readfirstlane(tid >> 6); \
    const int gw = bid * 8 + wave, gtid = bid * 512 + tid; (void)lane; (void)gw; (void)gtid;
#define P_MOD0 ((float*)(ws + WS_MOD))
#define P_MOD1 ((float*)(ws + WS_MOD) + 9 * 6144)
#define P_CTXRES ((float*)(ws + WS_CTXRES))
#define P_H ((bf16_t*)(ws + WS_H))
#define P_SLAB ((bf16_t*)(ws + WS_SLAB))
#define P_Q ((bf16_t*)(ws + WS_Q))
#define P_O ((bf16_t*)(ws + WS_O))
#define P_K ((bf16_t*)(ws + WS_K))
#define P_VT ((bf16_t*)(ws + WS_VT))
#define P_VTC ((bf16_t*)(ws + WS_VTC))
#define P_ACT ((bf16_t*)(ws + WS_ACT))
#define P_U ((bf16_t*)(ws + WS_U))
#define P_RECF ((bf16_t*)(ws + WS_RECF))
#define P_RECB ((bf16_t*)(ws + WS_RECB))
#define P_LA ((bf16_t*)(ws + WS_LA))
#define P_BX ((bf16_t*)(ws + WS_BX))
#define P_RPRE ((bf16_t*)(ws + WS_RPRE))
#define P_SP ((float*)(ws + WS_SP))
#define P_SH ((float*)(ws + WS_SH))
#define P_CIN ((float*)(ws + WS_CIN))
#define G0 (kp->norm_g)
#define G1 (kp->norm_g + 4 * DM)

__global__ void __launch_bounds__(512, 2) fwd_megakernel(Params p) {
    extern __shared__ __attribute__((aligned(16))) unsigned char lds_raw[];
    LAS unsigned char* lds = (LAS unsigned char*)lds_raw;
    const int G = gridDim.x, bid = blockIdx.x;
    const int ngw = G * 8, nthreads = G * 512;
    using namespace pg8;
    if (threadIdx.x < 4) ((volatile LAS unsigned*)(lds + 132096))[threadIdx.x] = 0u;
    __syncthreads();
    XcdBarrier xbar = xcd_barrier_post((unsigned*)(p.ws + WS_BAR), (volatile LAS unsigned*)(lds + 132096));
    if (PH(0)) { PHASE_BEGIN prologue(kp, lds, tid, lane, wave); }
    xcd_barrier(xbar);
#ifdef EXTRA_SYNCS
#pragma unroll 1
    for (int es = 0; es < EXTRA_SYNCS; ++es) xcd_barrier(xbar);
#endif
    REP_BEGIN(1)
    if (PH(1)) { PHASE_BEGIN row_phase<false, true, false, false>(kp->x, kp->ctx, nullptr, nullptr, nullptr, nullptr, P_H, nullptr, G0, nullptr, 0, P_MOD0, 0, 1, MT, gw, ngw, lane); }
    xcd_barrier(xbar);
    REP_END
    if (PH(2)) {
        PHASE_BEGIN
        Gemm g{P_H, (const bf16_t*)(ws + WS_WQKV), DM, DM, DM}; Sched S; S.init(MT / 256, NQKV / 256, G, bid);
        EpiQKV E{P_Q, P_K, P_VT, P_VTC, (const float*)(ws + WS_ROPE)};
        gemm_phase<EpiQKV, true, true>(lds, g, S, E);
    }
    xcd_barrier(xbar);
    REP_BEGIN(3)
    if (PH(3)) { PHASE_BEGIN attn_phase(lds, P_Q, P_O, P_K, P_VT, P_VTC, kp->sink, tid, lane, wave); }
    xcd_barrier(xbar);
    REP_END
    if (PH(4)) {
        PHASE_BEGIN
        { Gemm g{P_O, (const bf16_t*)(ws + WS_WO), DM, DM, DM}; Sched S; S.init(ML / 256, DM / 256, G, bid);
          EpiPlain<0> E{P_H, DM};
          gemm_phase<EpiPlain<0>, true, true>(lds, g, S, E); }
        { Gemm g{P_O, (const bf16_t*)(ws + WS_WO), DM, DM, 256}; Sched S; S.init(8, 4 * 4, G, bid, 2, 256);
          EpiSlabCtx E{P_SLAB, 256};
          gemm_phase<EpiSlabCtx, true, true>(lds, g, S, E); }
    }
    xcd_barrier(xbar);
    if (PH(5)) { PHASE_BEGIN row_phase<true, true, false, true>(kp->x, kp->ctx, kp->out, P_CTXRES, P_H, P_SLAB, P_H, G0 + DM, G0 + 2 * DM, P_MOD0, 2, P_MOD0, 3, 4, MT, gw, ngw, lane); }
    xcd_barrier(xbar);
    if (PH(6)) {
        PHASE_BEGIN
        Gemm g{P_H, (const bf16_t*)(ws + WS_W1), DM, DM, DM}; Sched S; S.init(MT / 256, DFF / 256, G, bid);
        EpiPlain<1> E{P_ACT, DFF};
        gemm_phase<EpiPlain<1>, true, true>(lds, g, S, E);
    }
    xcd_barrier(xbar);
    if (PH(7)) {
        PHASE_BEGIN
        { Gemm g{P_ACT, (const bf16_t*)(ws + WS_W2), DFF, DFF, DFF}; Sched S; S.init(ML / 256, DM / 256, G, bid);
          EpiPlain<0> E{P_H, DM};
          gemm_phase<EpiPlain<0>, true, true>(lds, g, S, E); }
        { Gemm g{P_ACT, (const bf16_t*)(ws + WS_W2), DFF, DFF, 1024}; Sched S; S.init(8, 4 * 4, G, bid, 2, 1024);
          EpiSlabCtx E{P_SLAB, 1024};
          gemm_phase<EpiSlabCtx, true, true>(lds, g, S, E); }
    }
    xcd_barrier(xbar);
    if (PH(8)) { PHASE_BEGIN row_phase<true, true, true, true>(kp->out, P_CTXRES, kp->out, P_CTXRES, P_H, P_SLAB, P_H, G0 + 3 * DM, G1, P_MOD0, 5, P_MOD1, 0, 1, MT, gw, ngw, lane); }
    xcd_barrier(xbar);
    if (PH(9)) {
        PHASE_BEGIN
        Gemm g{P_H, (const bf16_t*)(ws + WS_WIN), DM, DM, DM}; Sched S; S.init(MT / 256, DRNN / 256, G, bid, 4, 0);
        EpiInProj E{P_RPRE, (bf16_t*)(ws + WS_CTXRES)};
        gemm_phase<EpiInProj, true, true>(lds, g, S, E);
    }
    xcd_barrier(xbar);
    REP_BEGIN(10)
    if (PH(10)) { PHASE_BEGIN conv_phase(P_RPRE, P_U, kp->conv_w, kp->conv_b, gtid, nthreads);
        u32x4* cz = (u32x4*)(ws + WS_CARRY); for (int idx = gtid; idx < 1440 * 128 * 8 / 16; idx += nthreads) cz[idx] = (u32x4){0u, 0u, 0u, 0u}; }
    xcd_barrier(xbar);
    REP_END
    if (PH(11)) {
        PHASE_BEGIN
        Gemm g{P_U, (const bf16_t*)(ws + WS_WG), DRNN, 256, 256}; Sched S; S.init(1, 1, G, bid, 3, 0);
        EpiGatesScan E{P_U, P_RECF, P_RECB, kp->b_a, kp->b_i, (const float*)(ws + WS_NLS), (unsigned long long*)(ws + WS_CARRY)};
        gemm_phase<EpiGatesScan, true, true>(lds, g, S, E);
    }
    xcd_barrier(xbar);
    if (PH(15)) {
        PHASE_BEGIN
        Gemm g{P_H, (const bf16_t*)(ws + WS_WIN), DM, DM, DM}; Sched S; S.init(ML / 256, 4, G, bid);
        EpiGateMul E{P_RECF, P_RECB};
        gemm_phase<EpiGateMul, true, true>(lds, g, S, E);
        {
            const bf16_t* GB = (const bf16_t*)(ws + WS_CTXRES); bf16_t* Z = P_RECF; const bf16_t* RB = P_RECB;
            for (int idx = gtid; idx < ML * 32; idx += nthreads) { const int row = idx >> 5, c8 = (idx & 31) * 8;
                const u32x4 gv = *(const u32x4*)(GB + (size_t)row * 256 + c8); const size_t o = (size_t)row * DRNN + 1024 + c8;
                const u32x4 fv = *(const u32x4*)(Z + o), bv = *(const u32x4*)(RB + o); u32x4 w;
                w.x = cvt_pk_bf16(bf_lo(gv.x) * (bf_lo(fv.x) + bf_lo(bv.x)), bf_hi(gv.x) * (bf_hi(fv.x) + bf_hi(bv.x)));
                w.y = cvt_pk_bf16(bf_lo(gv.y) * (bf_lo(fv.y) + bf_lo(bv.y)), bf_hi(gv.y) * (bf_hi(fv.y) + bf_hi(bv.y)));
                w.z = cvt_pk_bf16(bf_lo(gv.z) * (bf_lo(fv.z) + bf_lo(bv.z)), bf_hi(gv.z) * (bf_hi(fv.z) + bf_hi(bv.z)));
                w.w = cvt_pk_bf16(bf_lo(gv.w) * (bf_lo(fv.w) + bf_lo(bv.w)), bf_hi(gv.w) * (bf_hi(fv.w) + bf_hi(bv.w)));
                *(u32x4*)(Z + o) = w; }
        }
    }
    xcd_barrier(xbar);
    if (PH(16)) {
        PHASE_BEGIN
        Gemm g{P_RECF, (const bf16_t*)(ws + WS_WOUT), DRNN, DRNN, DRNN}; Sched S; S.init(ML / 256, DM / 256, G, bid);
        EpiPlain<0> E{P_H, DM};
        gemm_phase<EpiPlain<0>, true, true>(lds, g, S, E);
    }
    xcd_barrier(xbar);
    if (PH(17)) { PHASE_BEGIN row_phase<true, true, true, true>(kp->out, P_CTXRES, ws + WS_X3, P_CTXRES, P_H, nullptr, P_H, G1 + DM, G1 + 2 * DM, P_MOD1, 2, P_MOD1, 3, 4, ML, gw, ngw, lane); }
    xcd_barrier(xbar);
    if (PH(18)) {
        PHASE_BEGIN
        Gemm g{P_H, (const bf16_t*)(ws + WS_W1 + 16 * MiB), DM, DM, DM}; Sched S; S.init(ML / 256, DFF / 256, G, bid);
        EpiPlain<1> E{P_ACT, DFF};
        gemm_phase<EpiPlain<1>, true, true>(lds, g, S, E);
    }
    xcd_barrier(xbar);
    if (PH(19)) {
        PHASE_BEGIN
        Gemm g{P_ACT, (const bf16_t*)(ws + WS_W2 + 16 * MiB), DFF, DFF, DFF}; Sched S; S.init(ML / 256, DM / 256, G, bid);
        EpiPlain<0> E{P_H, DM};
        gemm_phase<EpiPlain<0>, true, true>(lds, g, S, E);
    }
    xcd_barrier(xbar);
    if (PH(20)) { PHASE_BEGIN row_phase<true, false, true, false>(ws + WS_X3, P_CTXRES, kp->out, P_CTXRES, P_H, nullptr, nullptr, G1 + 3 * DM, nullptr, P_MOD1, 5, nullptr, 0, 0, ML, gw, ngw, lane); }
}

extern "C" void kernel_launch(void* const* d_in, const int* in_sizes, int n_in, void* d_out, int out_size, void* d_ws, size_t ws_size, hipStream_t stream) {
    static int grid_blocks = 0;
    if (grid_blocks == 0) {
        if (n_in != 21 || ws_size < WS_END) { fprintf(stderr, "kernel_launch: unexpected n_in %d / ws_size %zu\n", n_in, ws_size); grid_blocks = -1; return; }
        int dev = 0, cus = 0, per_cu = 0;
        hipGetDevice(&dev);
        hipDeviceGetAttribute(&cus, hipDeviceAttributeMultiprocessorCount, dev);
        if (hipFuncSetAttribute((const void*)fwd_megakernel, hipFuncAttributeMaxDynamicSharedMemorySize, LDS_BYTES) != hipSuccess) { fprintf(stderr, "hipFuncSetAttribute failed\n"); grid_blocks = -1; return; }
        if (hipOccupancyMaxActiveBlocksPerMultiprocessor(&per_cu, (const void*)fwd_megakernel, 512, LDS_BYTES) != hipSuccess || per_cu < 1) { fprintf(stderr, "occupancy query failed (%d)\n", per_cu); (void)hipGetLastError(); per_cu = 1; }
        grid_blocks = cus * 1;
    }
    if (grid_blocks < 0) return;
    Params p{};
    p.x = (const float*)d_in[0]; p.c = (const float*)d_in[1]; p.ctx = (const float*)d_in[2]; p.c_ctx = (const float*)d_in[3];
    p.ada_w = (const float*)d_in[4]; p.ada_b = (const float*)d_in[5]; p.norm_g = (const float*)d_in[6]; p.mlp_w1 = (const float*)d_in[7]; p.mlp_w2 = (const float*)d_in[8];
    p.w_qkv = (const float*)d_in[9]; p.w_o = (const float*)d_in[10]; p.sink = (const float*)d_in[11];
    p.w_in = (const float*)d_in[12]; p.conv_w = (const float*)d_in[13]; p.conv_b = (const float*)d_in[14]; p.w_a = (const float*)d_in[15]; p.b_a = (const float*)d_in[16];
    p.w_i = (const float*)d_in[17]; p.b_i = (const float*)d_in[18]; p.lam = (const float*)d_in[19]; p.w_out = (const float*)d_in[20];
    p.out = (float*)d_out; p.ws = (unsigned char*)d_ws;
    if (hipMemsetAsync((unsigned char*)d_ws + WS_BAR, 0, XCD_BAR_WORDS * 4, stream) != hipSuccess) { fprintf(stderr, "memset of barrier words failed\n"); return; }
    void* args[] = {&p};
    hipError_t e = hipLaunchCooperativeKernel((const void*)fwd_megakernel, dim3(grid_blocks), dim3(512), args, LDS_BYTES, stream);
    if (e != hipSuccess) fprintf(stderr, "cooperative launch failed: %s (grid %d)\n", hipGetErrorString(e), grid_blocks);
}
```

```cpp
#include <hip/hip_runtime.h>
#include <hip/hip_cooperative_groups.h>
#include <cstdio>
#include <cstdint>
namespace cg = cooperative_groups;

#define LAS __attribute__((address_space(3)))
typedef unsigned short bf16_t;
typedef short bf16x8 __attribute__((ext_vector_type(8)));
typedef float f32x4 __attribute__((ext_vector_type(4)));
typedef float f32x2 __attribute__((ext_vector_type(2)));
typedef unsigned u32x4 __attribute__((ext_vector_type(4)));
typedef unsigned u32x2 __attribute__((ext_vector_type(2)));

constexpr int DM = 1024, NB = 8, SEQ = 2048, CTX = 256;
constexpr int ML = NB * SEQ;
constexpr int MC = NB * CTX;
constexpr int MT = ML + MC;
constexpr int NQKV = 1536, DFF = 4096, DRNN = 1280;
constexpr float EPS = 1e-6f;
constexpr float LOG2E = 1.4426950408889634f;

constexpr size_t MiB = 1u << 20;
constexpr size_t WS_MOD = 0;
constexpr size_t WS_ROPE = 448 * 1024;
constexpr size_t WS_NLS = 460 * 1024;
constexpr size_t WS_BAR = 480 * 1024;
constexpr size_t WS_WQKV = 1 * MiB, WS_WO = 4 * MiB, WS_W1 = 6 * MiB, WS_W2 = 14 * MiB;
constexpr size_t WS_WIN = 38 * MiB, WS_WG = 43 * MiB, WS_WOUT = 46 * MiB;
constexpr size_t WS_CTXRES = 49 * MiB;
constexpr size_t WS_H = 57 * MiB;
constexpr size_t WS_R3 = 93 * MiB;
constexpr size_t WS_Q = WS_R3, WS_K = 129 * MiB, WS_VT = 138 * MiB, WS_VTC = 146 * MiB;
constexpr size_t WS_O = 150 * MiB;
constexpr size_t WS_ACT = WS_R3;
constexpr size_t WS_U = WS_R3;
constexpr size_t WS_RECF = 138 * MiB;
constexpr size_t WS_RECB = 178 * MiB;
constexpr size_t WS_LA = 138 * MiB;
constexpr size_t WS_BX = 183 * MiB;
constexpr size_t WS_RPRE = 138 * MiB;
constexpr size_t WS_SP = 228 * MiB, WS_SH = 231 * MiB, WS_CIN = 234 * MiB;
constexpr size_t WS_SLAB = 238 * MiB;
constexpr size_t WS_CARRY = 219 * MiB;
constexpr size_t WS_FLAG = 512 * 1024;
constexpr size_t WS_X3 = 222 * MiB;
constexpr size_t WS_END = 256 * MiB;
constexpr int LDS_BYTES = 143360;

__device__ __forceinline__ unsigned f2bf(float f) { unsigned u = __builtin_bit_cast(unsigned, f); return (u + 0x7fffu + ((u >> 16) & 1u)) >> 16; }
__device__ __forceinline__ unsigned cvt_pk_bf16(float lo, float hi) { unsigned r; asm volatile("v_cvt_pk_bf16_f32 %0, %1, %2" : "=v"(r) : "v"(lo), "v"(hi)); return r; }
__device__ __forceinline__ float bf_lo(unsigned w) { return __builtin_bit_cast(float, w << 16); }
__device__ __forceinline__ float bf_hi(unsigned w) { return __builtin_bit_cast(float, w & 0xffff0000u); }
__device__ __forceinline__ f32x4 bf4_to_f32(u32x2 w) { return (f32x4){bf_lo(w.x), bf_hi(w.x), bf_lo(w.y), bf_hi(w.y)}; }
__device__ __forceinline__ u32x2 f32_to_bf4(f32x4 v) { u32x2 w; w.x = cvt_pk_bf16(v[0], v[1]); w.y = cvt_pk_bf16(v[2], v[3]); return w; }
__device__ __forceinline__ float wave_sum(float v) {
#pragma unroll
    for (int o = 1; o < 64; o <<= 1) v += __shfl_xor(v, o);
    return v;
}
__device__ __forceinline__ float fsigmoid(float x) { return __builtin_amdgcn_rcpf(1.0f + __expf(-x)); }

namespace pg8 {
constexpr int BM = 256, BK = 64, HALF = 128, HTB = HALF * BK * 2, STAGE_BYTES = 8 * HTB, NXCD = 8, WGM = 8;
__device__ __forceinline__ int lds_byte(int r, int c) { const int st = (r >> 4) * 2 + (c >> 5), rr = r & 15, cc = c & 31, ob = rr * 64 + cc * 2; return st * 1024 + (ob ^ (((ob >> 9) & 1) << 5)); }
__device__ __forceinline__ void stage_rc(int b, int& R, int& C) { const int st = b / 1024, sb = b % 1024, swz = sb ^ (((sb >> 9) & 1) << 5); R = (st >> 1) * 16 + swz / 64; C = (st & 1) * 32 + (swz % 64) / 2; }

__device__ __forceinline__ int perm32(int rho) { const int n = rho >> 4, i = rho & 15; return 8 * (i >> 2) + 4 * n + (i & 3); }
struct Unit { int pm, pn, koff, po, kboff, rev, lin; };
struct Gemm { const bf16_t* A; const bf16_t* Bt; int lda, ldb, K; };

struct Sched {
    int nM, nN, nwg, G, c, mode, half;
    __device__ void init(int nM_, int nN_, int G_, int c_, int mode_ = 0, int half_ = 0) { nM = nM_; nN = nN_; nwg = nM * nN; G = G_; c = c_; mode = mode_; half = half_; }
    __device__ bool next(int i, Unit& u) const {
        if (mode == 3) {
            const int L = i * G + c; if (L >= 1440) return false;
            const int ti = L / 160, s = L % 160;
            const int chalf = s & 1, dir = (s >> 1) & 1, bb = s >> 2, blk = bb % 5, b = bb / 5;
            u.pm = (ti == 0) ? 64 + b : (dir ? b * 8 + (8 - ti) : b * 8 + (ti - 1));
            u.pn = (dir * 5 + blk) * 2 + chalf; u.koff = blk * 256; u.kboff = 0; u.po = ti; u.rev = dir; u.lin = L;
            return true;
        }
        if (mode == 4) {
            const int L4 = i * G + c; if (L4 >= 424) return false;
            if (L4 >= 360) { u.pm = L4 - 360; u.pn = 4; u.koff = 0; u.po = u.pm; u.kboff = 0; u.rev = 0; u.lin = 0; return true; }
        }
        const long L = (long)i * G + c; if (L >= nwg) return false;
        int wgid = (int)L; { const int q = nwg / NXCD, r = nwg % NXCD, xcd = wgid % NXCD, off = wgid / NXCD; wgid = (xcd < r ? xcd * (q + 1) : r * (q + 1) + (xcd - r) * q) + off; }
        const int nig = WGM * nN, gid = wgid / nig, fm = gid * WGM, gsz = (nM - fm) < WGM ? (nM - fm) : WGM;
        const int pmi = fm + ((wgid % nig) % gsz), pn = (wgid % nig) / gsz;
        u.pm = pmi; u.pn = pn; u.koff = 0; u.po = pmi; u.kboff = 0; u.rev = 0; u.lin = 0;
        if (mode == 2) { u.pm = 64 + pmi; u.pn = pn & 3; u.koff = (pn >> 2) * half; u.kboff = u.koff; }
        if (mode == 4) u.pn += 5;
        if (mode == 1) { u.pm = pmi < 32 ? 32 * half + pmi : 64 + 4 * half + (pmi - 32); u.koff = ((pn >> 1) % 5) * 256; }
        return true;
    }
};

template <class Epi, bool ALIGN_EPI, bool SP2>
__device__ __forceinline__ void gemm_phase(LAS unsigned char* lds, const Gemm g, const Sched& S, const Epi& E) {
    int tid = threadIdx.x; asm volatile("" : "+v"(tid));
    const int wid = __builtin_amdgcn_readfirstlane(tid >> 6), lane = tid & 63, wr = wid >> 2, wc = wid & 3, fr = lane & 15, fq = lane >> 4;
    const int K = g.K, nt = K / BK;
    unsigned voffAf[2], voffAr[2], voffB[2];
#pragma unroll
    for (int i = 0; i < 2; ++i) { int R, C; stage_rc(tid * 16 + i * 8192, R, C);
        const int Rb = Epi::PERM ? ((R & ~31) + perm32(R & 31)) : R;
        voffAf[i] = (unsigned)(R * g.lda + C) * 2u; voffAr[i] = (unsigned)((127 - R) * g.lda + C) * 2u; voffB[i] = (unsigned)(Rb * g.ldb + C) * 2u; }
    const size_t kstep = (size_t)(BK * 2);
    const long hstepAf = (long)HALF * g.lda * 2; const size_t hstepB = (size_t)HALF * g.ldb * 2;
    const unsigned ldsw = (unsigned)wid * 1024u;
    const int aoff = lds_byte(wr * 64 + fr, fq * 8), boff = lds_byte(wc * 32 + fr, fq * 8);
#define PG8_SA(b, h) (((b) * 2 + (h)) * HTB)
#define PG8_SB(b, h) ((4 + (b) * 2 + (h)) * HTB)
#define PG8_STAGE(bufoff, gbase, voff) do { _Pragma("unroll") for (int _i = 0; _i < 2; ++_i) \
        __builtin_amdgcn_global_load_lds((const unsigned*)((const char*)(gbase) + (voff)[_i]), (LAS unsigned*)(lds + (bufoff) + ldsw + _i * 8192), 16, 0, 0); } while (0)
#define PG8_LDA(dst, b, h) do { _Pragma("unroll") for (int m = 0; m < 4; ++m) _Pragma("unroll") for (int k = 0; k < 2; ++k) dst[m][k] = *(const LAS bf16x8*)(lds + PG8_SA(b, h) + aoff + m * 2048 + k * 1024); } while (0)
#define PG8_LDB(dst, b, h) do { _Pragma("unroll") for (int n = 0; n < 2; ++n) _Pragma("unroll") for (int k = 0; k < 2; ++k) dst[n][k] = *(const LAS bf16x8*)(lds + PG8_SB(b, h) + boff + n * 2048 + k * 1024); } while (0)
#define PG8_MMA(ai, bj, At, Bt) do { __builtin_amdgcn_s_setprio(1); _Pragma("unroll") for (int m = 0; m < 4; ++m) _Pragma("unroll") for (int n = 0; n < 2; ++n) _Pragma("unroll") for (int k = 0; k < 2; ++k) \
        acc[ai][bj][m][n] = __builtin_amdgcn_mfma_f32_16x16x32_bf16(Bt[n][k], At[m][k], acc[ai][bj][m][n], 0, 0, 0); __builtin_amdgcn_s_setprio(0); } while (0)
#define PG8_WAIT_V(n) asm volatile("s_waitcnt vmcnt(" #n ")" ::: "memory")
#define PG8_WAIT_L(n) asm volatile("s_waitcnt lgkmcnt(" #n ")" ::: "memory")
#define PG8_BAR __builtin_amdgcn_s_barrier()
#define PG8_SCHED __builtin_amdgcn_sched_barrier(0)
    Unit cur, nxt; int ui = 0;
    if (!S.next(0, cur)) return;
    f32x4 acc[2][2][4][2];
#pragma unroll
    for (int a = 0; a < 2; ++a)
#pragma unroll
        for (int b = 0; b < 2; ++b)
#pragma unroll
            for (int m = 0; m < 4; ++m)
#pragma unroll
                for (int n = 0; n < 2; ++n) acc[a][b][m][n] = (f32x4){0.f, 0.f, 0.f, 0.f};
    bf16x8 At[4][2], B0[2][2], B1[2][2];
#define PG8_UNIT_A(u_) ((const char*)g.A + ((size_t)(u_).pm * BM * g.lda + (u_).koff) * 2 + (Epi::WITH_LDS && (u_).rev ? hstepAf : 0))
    const char* cA = PG8_UNIT_A(cur);
    unsigned voffA[2] = {voffAf[0], voffAf[1]}; long hstepA = hstepAf;
    if (Epi::WITH_LDS && cur.rev) { voffA[0] = voffAr[0]; voffA[1] = voffAr[1]; hstepA = -hstepAf; } const char* cB = (const char*)g.Bt + ((size_t)cur.pn * BM * g.ldb + cur.kboff) * 2;
    if constexpr (SP2) {
        PG8_STAGE(PG8_SB(0, 0), cB, voffB); PG8_STAGE(PG8_SB(0, 1), cB + hstepB, voffB); PG8_STAGE(PG8_SA(0, 0), cA, voffA); PG8_STAGE(PG8_SA(0, 1), cA + hstepA, voffA);
        if (wr == 1) PG8_BAR;
        PG8_WAIT_V(2); PG8_BAR;
        PG8_STAGE(PG8_SB(1, 0), cB + kstep, voffB); PG8_STAGE(PG8_SA(1, 0), cA + kstep, voffA); PG8_STAGE(PG8_SB(1, 1), cB + hstepB + kstep, voffB);
        PG8_WAIT_V(6); PG8_BAR;
    } else {
        PG8_STAGE(PG8_SB(0, 0), cB, voffB); PG8_STAGE(PG8_SA(0, 0), cA, voffA); PG8_STAGE(PG8_SB(0, 1), cB + hstepB, voffB); PG8_STAGE(PG8_SA(0, 1), cA + hstepA, voffA);
        if (wr == 1) PG8_BAR;
        PG8_WAIT_V(4); PG8_BAR;
        PG8_STAGE(PG8_SB(1, 0), cB + kstep, voffB); PG8_STAGE(PG8_SA(1, 0), cA + kstep, voffA); PG8_STAGE(PG8_SB(1, 1), cB + hstepB + kstep, voffB);
        PG8_WAIT_V(6); PG8_BAR;
    }
    for (;;) {
        const bool has_next = S.next(ui + 1, nxt);
        const char* nA = has_next ? PG8_UNIT_A(nxt) : cA;
        unsigned voffN[2] = {voffA[0], voffA[1]}; long hstepN = hstepA;
        if (Epi::WITH_LDS && has_next) { const bool nr = nxt.rev != 0; voffN[0] = nr ? voffAr[0] : voffAf[0]; voffN[1] = nr ? voffAr[1] : voffAf[1]; hstepN = nr ? -hstepAf : hstepAf; }
        const char* nB = has_next ? (const char*)g.Bt + ((size_t)nxt.pn * BM * g.ldb + nxt.kboff) * 2 : cB;
#pragma unroll 1
        for (int t = 0; t < nt; t += 2) {
            const bool last = (t == nt - 2);
            const char* a1 = cA + (size_t)(t + 1) * kstep;
            const char* a2 = last ? nA : cA + (size_t)(t + 2) * kstep; const char* b2 = last ? nB : cB + (size_t)(t + 2) * kstep;
            const char* a3 = a2 + kstep; const char* b3 = b2 + kstep;
            unsigned voff2[2] = {voffA[0], voffA[1]}; long hstep2 = hstepA;
            if (Epi::WITH_LDS && last) { voff2[0] = voffN[0]; voff2[1] = voffN[1]; hstep2 = hstepN; }
            if constexpr (SP2) {
            PG8_LDB(B0, 0, 0); PG8_LDB(B1, 0, 1); PG8_SCHED; PG8_LDA(At, 0, 0); PG8_STAGE(PG8_SA(1, 1), a1 + hstepA, voffA);
            PG8_WAIT_V(8); PG8_WAIT_L(0); PG8_BAR; PG8_MMA(0, 0, At, B0); PG8_MMA(0, 1, At, B1); PG8_BAR; PG8_SCHED;
            PG8_LDA(At, 0, 1); PG8_STAGE(PG8_SB(0, 0), b2, voffB); PG8_STAGE(PG8_SB(0, 1), b2 + hstepB, voffB); PG8_STAGE(PG8_SA(0, 0), a2, voff2);
            PG8_WAIT_V(8); PG8_WAIT_L(0); PG8_BAR; PG8_MMA(1, 0, At, B0); PG8_MMA(1, 1, At, B1); PG8_BAR; PG8_SCHED;
            PG8_LDB(B0, 1, 0); PG8_LDB(B1, 1, 1); PG8_SCHED; PG8_LDA(At, 1, 0); PG8_STAGE(PG8_SA(0, 1), a2 + hstep2, voff2);
            PG8_WAIT_V(8); PG8_WAIT_L(0); PG8_BAR; PG8_MMA(0, 0, At, B0); PG8_MMA(0, 1, At, B1); PG8_BAR; PG8_SCHED;
            PG8_LDA(At, 1, 1); PG8_STAGE(PG8_SB(1, 0), b3, voffB); PG8_STAGE(PG8_SB(1, 1), b3 + hstepB, voffB); PG8_STAGE(PG8_SA(1, 0), a3, voff2);
            PG8_WAIT_V(8); PG8_WAIT_L(0); PG8_BAR; PG8_MMA(1, 0, At, B0); PG8_MMA(1, 1, At, B1); PG8_BAR; PG8_SCHED;
            } else {
            PG8_LDB(B0, 0, 0); PG8_SCHED; PG8_LDA(At, 0, 0); PG8_STAGE(PG8_SA(1, 1), a1 + hstepA, voffA);
            PG8_WAIT_L(8); PG8_BAR; PG8_WAIT_L(0); PG8_MMA(0, 0, At, B0); PG8_BAR; PG8_SCHED;
            PG8_LDB(B1, 0, 1); PG8_STAGE(PG8_SB(0, 0), b2, voffB);
            PG8_BAR; PG8_WAIT_L(0); PG8_MMA(0, 1, At, B1); PG8_BAR;
            PG8_LDA(At, 0, 1); PG8_STAGE(PG8_SA(0, 0), a2, voff2);
            PG8_BAR; PG8_WAIT_L(0); PG8_MMA(1, 0, At, B0); PG8_BAR; PG8_SCHED;
            PG8_STAGE(PG8_SB(0, 1), b2 + hstepB, voffB);
            PG8_WAIT_V(6); PG8_BAR; PG8_MMA(1, 1, At, B1); PG8_BAR;
            PG8_LDB(B0, 1, 0); PG8_SCHED; PG8_LDA(At, 1, 0); PG8_STAGE(PG8_SA(0, 1), a2 + hstep2, voff2);
            PG8_WAIT_L(8); PG8_BAR; PG8_WAIT_L(0); PG8_MMA(0, 0, At, B0); PG8_BAR; PG8_SCHED;
            PG8_LDB(B1, 1, 1); PG8_STAGE(PG8_SB(1, 0), b3, voffB);
            PG8_BAR; PG8_WAIT_L(0); PG8_MMA(0, 1, At, B1); PG8_BAR;
            PG8_LDA(At, 1, 1); PG8_STAGE(PG8_SA(1, 0), a3, voff2);
            PG8_BAR; PG8_WAIT_L(0); PG8_MMA(1, 0, At, B0); PG8_BAR; PG8_SCHED;
            PG8_STAGE(PG8_SB(1, 1), b3 + hstepB, voffB);
            PG8_WAIT_V(6); PG8_BAR; PG8_MMA(1, 1, At, B1); PG8_BAR;
            }
        }
        if constexpr (ALIGN_EPI) { if (wr == 0) PG8_BAR; }
        if constexpr (Epi::WITH_LDS) E.run(acc, cur, wr, wc, lane, lds); else E(acc, cur, wr, wc, fr, fq);
        if (!has_next) break;
#pragma unroll
        for (int a = 0; a < 2; ++a)
#pragma unroll
            for (int b = 0; b < 2; ++b)
#pragma unroll
                for (int m = 0; m < 4; ++m)
#pragma unroll
                    for (int n = 0; n < 2; ++n) acc[a][b][m][n] = (f32x4){0.f, 0.f, 0.f, 0.f};
        cur = nxt; cA = nA; cB = nB; ++ui; voffA[0] = voffN[0]; voffA[1] = voffN[1]; hstepA = hstepN;
        if constexpr (ALIGN_EPI) { if (wr == 1) PG8_BAR; }
    }
    PG8_WAIT_V(0);
    if constexpr (!ALIGN_EPI) { if (wr == 0) PG8_BAR; }
    PG8_BAR;
#undef PG8_UNIT_A
#undef PG8_SA
#undef PG8_SB
#undef PG8_STAGE
#undef PG8_LDA
#undef PG8_LDB
#undef PG8_MMA
#undef PG8_WAIT_V
#undef PG8_WAIT_L
#undef PG8_BAR
#undef PG8_SCHED
}

template <int ACT> struct EpiPlain {
    static constexpr bool WITH_LDS = false, PERM = true;
    bf16_t* O; int ldc;
    __device__ __forceinline__ void operator()(const f32x4 (&acc)[2][2][4][2], const Unit& u, int wr, int wc, int fr_, int fq_) const {
        int fr = fr_, fq = fq_; asm volatile("" : "+v"(fr), "+v"(fq));
        const int col0 = u.pn * BM + wc * 32 + fq * 8;
#pragma unroll
        for (int ai = 0; ai < 2; ++ai)
#pragma unroll
            for (int m = 0; m < 4; ++m) { bf16_t* rowp = O + (size_t)(u.pm * BM + ai * HALF + wr * 64 + m * 16 + fr) * ldc + col0;
#pragma unroll
                for (int bj = 0; bj < 2; ++bj) { f32x4 v0 = acc[ai][bj][m][0], v1 = acc[ai][bj][m][1];
                    if (ACT == 1) { v0 = __builtin_elementwise_max(v0, (f32x4){0.f, 0.f, 0.f, 0.f}); v0 = v0 * v0; v1 = __builtin_elementwise_max(v1, (f32x4){0.f, 0.f, 0.f, 0.f}); v1 = v1 * v1; }
                    u32x4 w; w.x = cvt_pk_bf16(v0[0], v0[1]); w.y = cvt_pk_bf16(v0[2], v0[3]); w.z = cvt_pk_bf16(v1[0], v1[1]); w.w = cvt_pk_bf16(v1[2], v1[3]);
                    *(u32x4*)(rowp + bj * HALF) = w; } }
    }
};

struct EpiSlabCtx {
    static constexpr bool WITH_LDS = false, PERM = true;
    bf16_t* S; int ksz;
    __device__ __forceinline__ void operator()(const f32x4 (&acc)[2][2][4][2], const Unit& u, int wr, int wc, int fr_, int fq_) const {
        int fr = fr_, fq = fq_; asm volatile("" : "+v"(fr), "+v"(fq));
        const int col0 = u.pn * BM + wc * 32 + fq * 8;
        bf16_t* base = S + (size_t)(u.koff / ksz) * MC * DM;
#pragma unroll
        for (int ai = 0; ai < 2; ++ai)
#pragma unroll
            for (int m = 0; m < 4; ++m) { bf16_t* rowp = base + (size_t)(u.pm * BM - ML + ai * HALF + wr * 64 + m * 16 + fr) * DM + col0;
#pragma unroll
                for (int bj = 0; bj < 2; ++bj) { const f32x4 v0 = acc[ai][bj][m][0], v1 = acc[ai][bj][m][1];
                    u32x4 w; w.x = cvt_pk_bf16(v0[0], v0[1]); w.y = cvt_pk_bf16(v0[2], v0[3]); w.z = cvt_pk_bf16(v1[0], v1[1]); w.w = cvt_pk_bf16(v1[2], v1[3]);
                    *(u32x4*)(rowp + bj * HALF) = w; } }
    }
};

struct EpiQKV {
    static constexpr bool WITH_LDS = false, PERM = false;
    bf16_t* Q; bf16_t* Kb; bf16_t* VT; bf16_t* VTC; const float* rope;
    __device__ __forceinline__ void operator()(const f32x4 (&acc)[2][2][4][2], const Unit& u, int wr, int wc, int fr_, int fq_) const {
        int fr = fr_, fq = fq_; asm volatile("" : "+v"(fr), "+v"(fq));
        const bool lat = u.pm < 64;
        if (u.pn < 5) {
#pragma unroll
            for (int ai = 0; ai < 2; ++ai)
#pragma unroll
                for (int m = 0; m < 4; ++m) {
                    const int row = u.pm * BM + ai * HALF + wr * 64 + m * 16 + fr;
                    f32x4 cs0 = {1.f, 0.f, 1.f, 0.f}, cs1 = {1.f, 0.f, 1.f, 0.f};
                    if (lat) { const int t = row & 2047; const int pos = (wc & 1) ? (t & 63) : (t >> 6); const f32x4* pp = (const f32x4*)(rope + (pos * 16 + 4 * fq) * 2); cs0 = pp[0]; cs1 = pp[1]; }
                    const f32x4 cv = {cs0[0], cs0[2], cs1[0], cs1[2]}, sv = {cs0[1], cs0[3], cs1[1], cs1[3]};
#pragma unroll
                    for (int bj = 0; bj < 2; ++bj) {
                        const f32x4 a = acc[ai][bj][m][0], b = acc[ai][bj][m][1];
                        f32x4 na = a * cv - b * sv, nb = b * cv + a * sv;
                        if (u.pn < 4) { na = na * 0.125f; nb = nb * 0.125f; }
                        bf16_t* d = (u.pn < 4) ? Q + (size_t)row * 1024 + u.pn * 256 + bj * HALF + wc * 32 + fq * 8 : Kb + (size_t)row * 256 + bj * HALF + wc * 32 + fq * 8;
                        u32x4 w; w.x = cvt_pk_bf16(na[0], na[1]); w.y = cvt_pk_bf16(na[2], na[3]); w.z = cvt_pk_bf16(nb[0], nb[1]); w.w = cvt_pk_bf16(nb[2], nb[3]);
                        *(u32x4*)d = w;
                    }
                }
        } else {
#pragma unroll
            for (int ai = 0; ai < 2; ++ai)
#pragma unroll
                for (int m = 0; m < 4; ++m) {
                    const int row = u.pm * BM + ai * HALF + wr * 64 + m * 16 + fr;
                    bf16_t* base; size_t stride;
                    if (lat) { const int b = row >> 11, t = row & 2047; base = VT + (size_t)b * 256 * 2048 + t; stride = 2048; }
                    else { const int rc = row - ML; const int b = rc >> 8, t = rc & 255; base = VTC + (size_t)b * 256 * 256 + t; stride = 256; }
#pragma unroll
                    for (int bj = 0; bj < 2; ++bj)
#pragma unroll
                        for (int n = 0; n < 2; ++n)
#pragma unroll
                            for (int j = 0; j < 4; ++j) { const int vc = bj * HALF + wc * 32 + n * 16 + fq * 4 + j; base[(size_t)vc * stride] = (bf16_t)f2bf(acc[ai][bj][m][n][j]); }
                }
        }
    }
};

struct EpiInProj {
    static constexpr bool WITH_LDS = false, PERM = true;
    bf16_t* R; bf16_t* GB;
    __device__ __forceinline__ void operator()(const f32x4 (&acc)[2][2][4][2], const Unit& u, int wr, int wc, int fr_, int fq_) const {
        int fr = fr_, fq = fq_; asm volatile("" : "+v"(fr), "+v"(fq));
        const bool rec = u.pn >= 5;
        const int col0 = (rec ? (u.pn - 5) * BM : 0) + wc * 32 + fq * 8; const int ldc = rec ? DRNN : 256; bf16_t* O = rec ? R : GB;
#pragma unroll
        for (int ai = 0; ai < 2; ++ai)
#pragma unroll
            for (int m = 0; m < 4; ++m) { bf16_t* rowp = O + (size_t)(u.pm * BM + ai * HALF + wr * 64 + m * 16 + fr) * ldc + col0;
#pragma unroll
                for (int bj = 0; bj < 2; ++bj) { f32x4 v0 = acc[ai][bj][m][0], v1 = acc[ai][bj][m][1];
                    if (!rec) {
#pragma unroll
                        for (int j = 0; j < 4; ++j) { const float x = v0[j]; v0[j] = x * fsigmoid(1.5957691216057308f * (x + 0.044715f * x * x * x)); const float y = v1[j]; v1[j] = y * fsigmoid(1.5957691216057308f * (y + 0.044715f * y * y * y)); } }
                    u32x4 w; w.x = cvt_pk_bf16(v0[0], v0[1]); w.y = cvt_pk_bf16(v0[2], v0[3]); w.z = cvt_pk_bf16(v1[0], v1[1]); w.w = cvt_pk_bf16(v1[2], v1[3]);
                    *(u32x4*)(rowp + bj * HALF) = w; } }
    }
};

struct EpiGates {
    static constexpr bool WITH_LDS = false, PERM = false;
    const bf16_t* U; bf16_t* LA; bf16_t* BX; const float* ba; const float* bi; const float* nls;
    __device__ __forceinline__ void operator()(const f32x4 (&acc)[2][2][4][2], const Unit& u, int wr, int wc, int fr_, int fq_) const {
        int fr = fr_, fq = fq_; asm volatile("" : "+v"(fr), "+v"(fq));
        const int tile = u.pn >> 1, dir = tile / 5, blk = tile % 5, chalf = u.pn & 1;
        const int ch0 = blk * 256 + chalf * 128 + wc * 32 + fq * 4;
#pragma unroll
        for (int n = 0; n < 2; ++n) {
            const int ch = ch0 + n * 16;
            const f32x4 bav = *(const f32x4*)(ba + dir * DRNN + ch), biv = *(const f32x4*)(bi + dir * DRNN + ch), nl = *(const f32x4*)(nls + dir * DRNN + ch);
#pragma unroll
            for (int ai = 0; ai < 2; ++ai)
#pragma unroll
                for (int m = 0; m < 4; ++m) {
                    const int rin = ai * HALF + wr * 64 + m * 16 + fr;
                    const size_t rowg = (size_t)u.pm * BM + rin, rowl = (size_t)u.po * BM + rin;
                    const f32x4 uv = bf4_to_f32(*(const u32x2*)(U + rowg * DRNN + ch));
                    f32x4 lav, bxv;
#pragma unroll
                    for (int j = 0; j < 4; ++j) {
                        const float r = fsigmoid(acc[ai][0][m][n][j] + bav[j]);
                        const float ig = fsigmoid(acc[ai][1][m][n][j] + biv[j]);
                        const float la = nl[j] * r, x = 2.0f * la;
                        float om;
                        if (x > -0.5f) { float q = 1.0f / 720.0f; q = q * x + 1.0f / 120.0f; q = q * x + 1.0f / 24.0f; q = q * x + 1.0f / 6.0f; q = q * x + 0.5f; q = q * x + 1.0f; om = -x * q; }
                        else om = 1.0f - __expf(x);
                        lav[j] = la; bxv[j] = __builtin_amdgcn_sqrtf(om) * (ig * uv[j]);
                    }
                    const size_t o = ((size_t)dir * 9216 + rowl) * DRNN + ch;
                    *(u32x2*)(LA + o) = f32_to_bf4(lav); *(u32x2*)(BX + o) = f32_to_bf4(bxv);
                    asm volatile("" ::: "memory");
                }
        }
    }
};

#define SC_STEP(d) \
    "v_fmac_f32_dpp %1, %1, %0 row_shr:" #d " row_mask:0xf bank_mask:0xf\n\t" "v_mul_f32_dpp %0, %0, %0 row_shr:" #d " row_mask:0xf bank_mask:0xf\n\t" \
    "v_fmac_f32_dpp %3, %3, %2 row_shr:" #d " row_mask:0xf bank_mask:0xf\n\t" "v_mul_f32_dpp %2, %2, %2 row_shr:" #d " row_mask:0xf bank_mask:0xf\n\t" \
    "v_fmac_f32_dpp %5, %5, %4 row_shr:" #d " row_mask:0xf bank_mask:0xf\n\t" "v_mul_f32_dpp %4, %4, %4 row_shr:" #d " row_mask:0xf bank_mask:0xf\n\t" \
    "v_fmac_f32_dpp %7, %7, %6 row_shr:" #d " row_mask:0xf bank_mask:0xf\n\t" "v_mul_f32_dpp %6, %6, %6 row_shr:" #d " row_mask:0xf bank_mask:0xf\n\t"
__device__ __forceinline__ void scan16x4(float& a0, float& b0, float& a1, float& b1, float& a2, float& b2, float& a3, float& b3) {
    asm volatile("s_nop 1\n\t" SC_STEP(1) SC_STEP(2) SC_STEP(4) SC_STEP(8)
                 : "+v"(a0), "+v"(b0), "+v"(a1), "+v"(b1), "+v"(a2), "+v"(b2), "+v"(a3), "+v"(b3));
}
struct EpiGatesScan {
    static constexpr bool WITH_LDS = true, PERM = true;
    const bf16_t* U; bf16_t* RECF; bf16_t* RECB; const float* ba; const float* bi; const float* nls; unsigned long long* CARRY;
    __device__ __forceinline__ void run(f32x4 (&acc)[2][2][4][2], const Unit& u, int wr, int wc, int lane_, LAS unsigned char* lds) const {
        int lane = lane_; asm volatile("" : "+v"(lane));
        const int fr = lane & 15, fq = lane >> 4;
        const int tile = u.pn >> 1, dir = tile / 5, blk = tile % 5, chalf = u.pn & 1;
        const int ch0 = blk * 256 + chalf * 128 + wc * 32 + fq * 8;
        const int rmask = dir ? 255 : 0;
        bf16_t* REC = dir ? RECB : RECF;
#pragma unroll
        for (int n = 0; n < 2; ++n) {
            const int ch = ch0 + n * 4;
            const f32x4 bav2 = *(const f32x4*)(ba + dir * DRNN + ch) * (-LOG2E), biv2 = *(const f32x4*)(bi + dir * DRNN + ch) * (-LOG2E), nl = *(const f32x4*)(nls + dir * DRNN + ch);
            const f32x4 nl2 = nl * LOG2E, nlx = nl * 2.0f;
#pragma unroll
            for (int ai = 0; ai < 2; ++ai)
#pragma unroll
                for (int m = 0; m < 4; ++m) {
                    const size_t rowg = (size_t)u.pm * BM + ((ai * HALF + wr * 64 + m * 16 + fr) ^ rmask);
                    const f32x4 uv = bf4_to_f32(*(const u32x2*)(U + rowg * DRNN + ch));
                    float av[4], bv[4];
#pragma unroll
                    for (int j = 0; j < 4; ++j) {
                        const float r = __builtin_amdgcn_rcpf(1.0f + __builtin_amdgcn_exp2f(acc[ai][0][m][n][j] * (-LOG2E) + bav2[j]));
                        const float ig = __builtin_amdgcn_rcpf(1.0f + __builtin_amdgcn_exp2f(acc[ai][1][m][n][j] * (-LOG2E) + biv2[j]));
                        const float x = nlx[j] * r, a = __builtin_amdgcn_exp2f(nl2[j] * r);
                        const float om = (x > -0.0625f) ? -x * (1.0f + x * (0.5f + x * (1.0f / 6.0f + x * (1.0f / 24.0f)))) : 1.0f - a * a;
                        av[j] = a; bv[j] = __builtin_amdgcn_sqrtf(om) * (ig * uv[j]);
                    }
                    scan16x4(av[0], bv[0], av[1], bv[1], av[2], bv[2], av[3], bv[3]);
#pragma unroll
                    for (int j = 0; j < 4; ++j) { acc[ai][0][m][n][j] = av[j]; acc[ai][1][m][n][j] = bv[j]; }
                    __builtin_amdgcn_sched_barrier(0);
                }
        }
        LAS f32x2* segtot = (LAS f32x2*)(lds + 133120);
        LAS float* segcarry = (LAS float*)(lds + 137216);
#pragma unroll
        for (int ai = 0; ai < 2; ++ai)
#pragma unroll
            for (int n = 0; n < 2; ++n) {
                f32x4 As = acc[ai][0][0][n], Bs = acc[ai][1][0][n];
#pragma unroll
                for (int m = 1; m < 4; ++m) { Bs = acc[ai][0][m][n] * Bs + acc[ai][1][m][n]; As = acc[ai][0][m][n] * As; }
                if (fr == 15) {
#pragma unroll
                    for (int j = 0; j < 4; ++j) segtot[(2 * ai + wr) * 128 + wc * 32 + n * 16 + fq * 4 + j] = (f32x2){As[j], Bs[j]};
                }
            }
        asm volatile("s_waitcnt lgkmcnt(0)" ::: "memory"); __builtin_amdgcn_s_barrier(); asm volatile("" ::: "memory");
        const int tid_ = threadIdx.x;
        if (tid_ < 128) {
            float h = 0.0f;
            if (u.po > 0) { unsigned long long* gp = CARRY + (size_t)(u.lin - 160) * 128 + tid_; unsigned long long v; unsigned sp = 0;
                for (;;) { v = __hip_atomic_load(gp, __ATOMIC_RELAXED, __HIP_MEMORY_SCOPE_AGENT); if ((v >> 32) != 0ull) break; __builtin_amdgcn_s_sleep(1); if (++sp > (1u << 22)) break; }
                h = __uint_as_float((unsigned)v); }
#pragma unroll
            for (int sg = 0; sg < 4; ++sg) { segcarry[sg * 128 + tid_] = h; const f32x2 t = segtot[sg * 128 + tid_]; h = t[0] * h + t[1]; }
            if (u.po < 8) __hip_atomic_store(CARRY + (size_t)u.lin * 128 + tid_, (1ull << 32) | (unsigned long long)__float_as_uint(h), __ATOMIC_RELAXED, __HIP_MEMORY_SCOPE_AGENT);
        }
        asm volatile("s_waitcnt lgkmcnt(0)" ::: "memory"); __builtin_amdgcn_s_barrier(); asm volatile("" ::: "memory");
        const bool emit = u.pm < 64;
        const int lastl = (lane & 48) | 15;
        if (emit) {
#pragma unroll
            for (int ai = 0; ai < 2; ++ai) {
                f32x4 hg[2];
#pragma unroll
                for (int n = 0; n < 2; ++n) hg[n] = *(const LAS f32x4*)(segcarry + (2 * ai + wr) * 128 + wc * 32 + n * 16 + fq * 4);
#pragma unroll
                for (int m = 0; m < 4; ++m) {
                    f32x4 h[2];
#pragma unroll
                    for (int n = 0; n < 2; ++n) h[n] = acc[ai][0][m][n] * hg[n] + acc[ai][1][m][n];
                    bf16_t* rp = REC + ((size_t)u.pm * BM + ((ai * HALF + wr * 64 + m * 16 + fr) ^ rmask)) * DRNN + ch0;
                    { u32x4 w; w.x = cvt_pk_bf16(h[0][0], h[0][1]); w.y = cvt_pk_bf16(h[0][2], h[0][3]); w.z = cvt_pk_bf16(h[1][0], h[1][1]); w.w = cvt_pk_bf16(h[1][2], h[1][3]); *(u32x4*)rp = w; }
                    if (m < 3) {
#pragma unroll
                        for (int n = 0; n < 2; ++n)
#pragma unroll
                            for (int j = 0; j < 4; ++j) hg[n][j] = __shfl(h[n][j], lastl);
                    }
                }
            }
        }
    }
};

struct EpiGateMul {
    static constexpr bool WITH_LDS = false, PERM = true;
    bf16_t* Z; const bf16_t* RB;
    __device__ __forceinline__ void operator()(const f32x4 (&acc)[2][2][4][2], const Unit& u, int wr, int wc, int fr_, int fq_) const {
        int fr = fr_, fq = fq_; asm volatile("" : "+v"(fr), "+v"(fq));
        const int col0 = u.pn * BM + wc * 32 + fq * 8;
        const size_t off0 = (size_t)(u.pm * BM + wr * 64 + fr) * DRNN + col0;
#pragma unroll
        for (int ai = 0; ai < 2; ++ai)
#pragma unroll
            for (int m = 0; m < 4; ++m) { const size_t o_ = off0 + (size_t)(ai * HALF + m * 16) * DRNN;
                u32x4 cf[2], cb[2];
#pragma unroll
                for (int bj = 0; bj < 2; ++bj) { cf[bj] = *(const u32x4*)(Z + o_ + bj * HALF); cb[bj] = *(const u32x4*)(RB + o_ + bj * HALF); }
#pragma unroll
                for (int bj = 0; bj < 2; ++bj) { const f32x4 v0 = acc[ai][bj][m][0], v1 = acc[ai][bj][m][1];
                    const f32x4 r0 = bf4_to_f32((u32x2){cf[bj].x, cf[bj].y}) + bf4_to_f32((u32x2){cb[bj].x, cb[bj].y}), r1 = bf4_to_f32((u32x2){cf[bj].z, cf[bj].w}) + bf4_to_f32((u32x2){cb[bj].z, cb[bj].w});
                    f32x4 o0, o1;
#pragma unroll
                    for (int j = 0; j < 4; ++j) { const float x = v0[j]; o0[j] = x * fsigmoid(1.5957691216057308f * (x + 0.044715f * x * x * x)) * r0[j];
                                                  const float y = v1[j]; o1[j] = y * fsigmoid(1.5957691216057308f * (y + 0.044715f * y * y * y)) * r1[j]; }
                    u32x4 w; w.x = cvt_pk_bf16(o0[0], o0[1]); w.y = cvt_pk_bf16(o0[2], o0[3]); w.z = cvt_pk_bf16(o1[0], o1[1]); w.w = cvt_pk_bf16(o1[2], o1[3]);
                    *(u32x4*)(Z + o_ + bj * HALF) = w; }
                asm volatile("" ::: "memory"); }
    }
};
}


#define XB_TMO      128
#define XB_XCNT(j)  (256  + 64 * (j))
#define XB_XSUB(j)  (1280 + 64 * (j))
#define XB_XGEN(j)  (2304 + 64 * (j))
#define XB_TOP      3328
#define XB_TOPGEN   3392
#define XCD_BAR_WORDS 3456
#define XB_SPIN_CAP (1u << 18)
__device__ __forceinline__ unsigned xb_ld(unsigned* p)              { return __hip_atomic_load(p, __ATOMIC_RELAXED, __HIP_MEMORY_SCOPE_AGENT); }
__device__ __forceinline__ unsigned xb_add(unsigned* p, unsigned v) { return __hip_atomic_fetch_add(p, v, __ATOMIC_RELAXED, __HIP_MEMORY_SCOPE_AGENT); }
__device__ __forceinline__ unsigned xb_xcc_id() { return (unsigned)__builtin_amdgcn_s_getreg((3 << 11) | 20) & 0xFu; }
#define XB_SPIN(cond, bar) do { unsigned _sp = 0; while (cond) { __builtin_amdgcn_s_sleep(1); \
    if ((++_sp & 255u) == 0u) { if (xb_ld(&(bar)[XB_TMO])) break; if (_sp > XB_SPIN_CAP) { atomicAdd(&(bar)[XB_TMO], 1u); break; } } } } while (0)
struct XcdBarrier { unsigned* bar; unsigned x; volatile LAS unsigned* st; };
__device__ __forceinline__ XcdBarrier xcd_barrier_post(unsigned* bar, volatile LAS unsigned* st) {
    XcdBarrier b; b.bar = bar; b.x = xb_xcc_id(); b.st = st;
    if (threadIdx.x == 0) (void)xb_add(&bar[XB_XCNT(b.x)], 1u);
    return b;
}
__device__ __forceinline__ void xcd_barrier_complete(unsigned* bar, unsigned x, unsigned& nloc, unsigned& nx) {
    const unsigned G = gridDim.x * gridDim.y * gridDim.z;
    unsigned sum, cnt, mine, sp = 0u;
    for (;;) {
        sum = 0u; cnt = 0u; mine = 0u;
#pragma unroll
        for (unsigned j = 0; j < 16; ++j) { const unsigned c = xb_ld(&bar[XB_XCNT(j)]); sum += c; cnt += (c > 0u) ? 1u : 0u; mine = (j == x) ? c : mine; }
        if (sum == G) break;
        __builtin_amdgcn_s_sleep(1);
        if ((++sp & 255u) == 0u) { if (xb_ld(&bar[XB_TMO])) break; if (sp > XB_SPIN_CAP) { atomicAdd(&bar[XB_TMO], 1u); break; } }
    }
    nloc = mine > 0u ? mine : 1u; nx = cnt > 0u ? cnt : 1u;
}
__device__ __forceinline__ void xcd_barrier(const XcdBarrier& b) {
    asm volatile("s_waitcnt vmcnt(0)" ::: "memory");
    __syncthreads();
    if (threadIdx.x == 0) {
        unsigned* bar = b.bar;
        __builtin_amdgcn_s_waitcnt(0);
        unsigned nloc = b.st[0], nx = b.st[1];
        if (nloc == 0u) { xcd_barrier_complete(bar, b.x, nloc, nx); b.st[0] = nloc; b.st[1] = nx; }
        const unsigned old = xb_add(&bar[XB_XSUB(b.x)], 1u);
        const unsigned gen = old / nloc;
        if (old + 1u == (gen + 1u) * nloc) {
            __builtin_amdgcn_fence(__ATOMIC_RELEASE, "agent");
            asm volatile("s_waitcnt vmcnt(0)" ::: "memory");
            const unsigned og = xb_add(&bar[XB_TOP], 1u);
            const unsigned tg = og / nx;
            if (og + 1u == (tg + 1u) * nx) xb_add(&bar[XB_TOPGEN], 1u);
            else XB_SPIN(xb_ld(&bar[XB_TOPGEN]) == tg, bar);
            __builtin_amdgcn_fence(__ATOMIC_ACQUIRE, "agent");
            xb_add(&bar[XB_XGEN(b.x)], 1u);
            asm volatile("s_waitcnt vmcnt(0)" ::: "memory");
        } else {
            XB_SPIN(xb_ld(&bar[XB_XGEN(b.x)]) == gen, bar);
            __builtin_amdgcn_fence(__ATOMIC_ACQUIRE, "agent");
            asm volatile("s_waitcnt vmcnt(0)" ::: "memory");
        }
    }
    __syncthreads();
}

struct Params {
    const float *x, *c, *ctx, *c_ctx, *ada_w, *ada_b, *norm_g, *mlp_w1, *mlp_w2, *w_qkv, *w_o, *sink;
    const float *w_in, *conv_w, *conv_b, *w_a, *b_a, *w_i, *b_i, *lam, *w_out;
    float* out; unsigned char* ws;
};

typedef const __attribute__((address_space(4))) Params* ParamsK;
__device__ __forceinline__ void transpose_item(const float* W, int ldw, bf16_t* WT, int ldwt, int k0, int n0, int dst_row0, LAS float* scr, int lane) {
#pragma unroll 8
    for (int i = 0; i < 32; ++i) { const int kk = 2 * i + (lane >> 5); scr[kk * 33 + (lane & 31)] = W[(size_t)(k0 + kk) * ldw + n0 + (lane & 31)]; }
    asm volatile("s_waitcnt lgkmcnt(0)" ::: "memory");
    const int c = lane & 7;
#pragma unroll
    for (int j = 0; j < 4; ++j) { const int n = (lane >> 3) + 8 * j; const LAS float* s = scr + (8 * c) * 33 + n;
        u32x4 o; o.x = cvt_pk_bf16(s[0 * 33], s[1 * 33]); o.y = cvt_pk_bf16(s[2 * 33], s[3 * 33]); o.z = cvt_pk_bf16(s[4 * 33], s[5 * 33]); o.w = cvt_pk_bf16(s[6 * 33], s[7 * 33]);
        *(u32x4*)(WT + (size_t)(dst_row0 + n) * ldwt + k0 + 8 * c) = o; }
    asm volatile("s_waitcnt lgkmcnt(0)" ::: "memory");
}
__device__ __forceinline__ void transpose_plain(const float* W, int K, int N, bf16_t* WT, int r, LAS float* scr, int lane) {
    const int nblk = N / 32, kb = r / nblk, nb = r % nblk;
    transpose_item(W, N, WT, K, 64 * kb, 32 * nb, 32 * nb, scr, lane);
}

constexpr int I_QKV = 16 * 48, I_O = 16 * 32, I_1 = 16 * 128, I_2 = 64 * 32, I_IN = 16 * 80, I_OUT = 20 * 32, I_G = 40 * 16;
constexpr int TR_L0 = I_QKV + I_O + I_1 + I_2, TR_LRU = I_IN + I_OUT + I_G, TR_MLP1 = I_1 + I_2;
struct TrItem { const float* W; bf16_t* WT; int ldw, ldwt, k0, n0, drow; };
__device__ __forceinline__ TrItem tr_decode(ParamsK p, unsigned char* ws, int it) {
    TrItem d; int r = it;
#define TR_PLAIN(Wp, K_, N_, WTp) do { const int nblk_ = (N_) / 32, kb_ = r / nblk_, nb_ = r % nblk_; d.W = (Wp); d.WT = (WTp); d.ldw = (N_); d.ldwt = (K_); d.k0 = 64 * kb_; d.n0 = 32 * nb_; d.drow = 32 * nb_; return d; } while (0)
    if (r < I_QKV) TR_PLAIN(p->w_qkv, 1024, NQKV, (bf16_t*)(ws + WS_WQKV)); r -= I_QKV;
    if (r < I_O) TR_PLAIN(p->w_o, 1024, 1024, (bf16_t*)(ws + WS_WO)); r -= I_O;
    if (r < I_1) TR_PLAIN(p->mlp_w1, 1024, DFF, (bf16_t*)(ws + WS_W1)); r -= I_1;
    if (r < I_2) TR_PLAIN(p->mlp_w2, DFF, 1024, (bf16_t*)(ws + WS_W2)); r -= I_2;
    if (r < I_IN) TR_PLAIN(p->w_in, 1024, 2 * DRNN, (bf16_t*)(ws + WS_WIN)); r -= I_IN;
    if (r < I_OUT) TR_PLAIN(p->w_out, DRNN, 1024, (bf16_t*)(ws + WS_WOUT)); r -= I_OUT;
    if (r < I_G) {
        const int sm = r >> 4, ii = r & 15, kb = ii >> 2, nb = ii & 3;
        const int chalf = sm & 1, blk = (sm >> 1) % 5, dg = (sm >> 1) / 5, gate = dg & 1, dir = dg >> 1;
        d.W = (gate ? p->w_i : p->w_a) + (size_t)(dir * 5 + blk) * 256 * 256; d.WT = (bf16_t*)(ws + WS_WG); d.ldw = 256; d.ldwt = 256;
        d.k0 = 64 * kb; d.n0 = chalf * 128 + nb * 32; d.drow = ((dir * 5 + blk) * 2 + chalf) * 256 + gate * 128 + nb * 32; return d; }
    r -= I_G;
    if (r < I_1) TR_PLAIN(p->mlp_w1 + (size_t)1024 * DFF, 1024, DFF, (bf16_t*)(ws + WS_W1 + 16 * MiB)); r -= I_1;
    TR_PLAIN(p->mlp_w2 + (size_t)1024 * DFF, DFF, 1024, (bf16_t*)(ws + WS_W2 + 16 * MiB));
#undef TR_PLAIN
}
__device__ __forceinline__ void transpose_range(ParamsK p, unsigned char* ws, LAS unsigned char* lds, int first, int count, int w, int nw, int wave, int lane) {
    LAS float* scr = (LAS float*)(lds + wave * 16384);
    int it = first + w; if (it >= first + count) return;
    float cur[32], nxt[32];
    TrItem d = tr_decode(p, ws, it);
#pragma unroll
    for (int i = 0; i < 32; ++i) cur[i] = d.W[(size_t)(d.k0 + 2 * i + (lane >> 5)) * d.ldw + d.n0 + (lane & 31)];
    for (;;) {
        const int itn = it + nw; const bool more = itn < first + count;
        TrItem dn = d;
        if (more) { dn = tr_decode(p, ws, itn);
#pragma unroll
            for (int i = 0; i < 32; ++i) nxt[i] = dn.W[(size_t)(dn.k0 + 2 * i + (lane >> 5)) * dn.ldw + dn.n0 + (lane & 31)]; }
#pragma unroll
        for (int i = 0; i < 32; ++i) scr[(2 * i + (lane >> 5)) * 33 + (lane & 31)] = cur[i];
        asm volatile("s_waitcnt lgkmcnt(0)" ::: "memory");
        const int c = lane & 7;
#pragma unroll
        for (int j = 0; j < 4; ++j) { const int n = (lane >> 3) + 8 * j; const LAS float* s = scr + (8 * c) * 33 + n;
            u32x4 o; o.x = cvt_pk_bf16(s[0 * 33], s[1 * 33]); o.y = cvt_pk_bf16(s[2 * 33], s[3 * 33]); o.z = cvt_pk_bf16(s[4 * 33], s[5 * 33]); o.w = cvt_pk_bf16(s[6 * 33], s[7 * 33]);
            *(u32x4*)(d.WT + (size_t)(d.drow + n) * d.ldwt + d.k0 + 8 * c) = o; }
        asm volatile("s_waitcnt lgkmcnt(0)" ::: "memory");
        if (!more) break;
#pragma unroll
        for (int i = 0; i < 32; ++i) cur[i] = nxt[i];
        d = dn; it = itn;
    }
}
__device__ __forceinline__ void idle_transposes(ParamsK p, unsigned char* ws, LAS unsigned char* lds, int first, int count, int nwg, int G, int bid, int wave, int lane) {
    const int rem = nwg % G;
    if (rem == 0) transpose_range(p, ws, lds, first, count, bid * 8 + wave, G * 8, wave, lane);
    else if (bid >= rem) transpose_range(p, ws, lds, first, count, (bid - rem) * 8 + wave, (G - rem) * 8, wave, lane);
    __syncthreads();
}

__device__ __forceinline__ void prologue(ParamsK p, LAS unsigned char* lds, int tid, int lane, int wave) {
    unsigned char* ws = p->ws;
    float* MOD = (float*)(ws + WS_MOD);
    if (blockIdx.x < 192) {
        LAS float* sl = (LAS float*)lds;
        LAS float* red = (LAS float*)(lds + 36864);
        for (int idx = tid; idx < 9216; idx += 512) { const int w = idx >> 10, k = idx & 1023; const float v = (w < 8) ? p->c[w * 1024 + k] : p->c_ctx[k]; sl[idx] = v / (1.0f + __expf(-v)); }
        __syncthreads();
        const int l = blockIdx.x / 96, n0 = (blockIdx.x % 96) * 64, kg = tid >> 4, cq = tid & 15;
        f32x4 acc[9];
#pragma unroll
        for (int w = 0; w < 9; ++w) acc[w] = (f32x4){0.f, 0.f, 0.f, 0.f};
        const float* wb = p->ada_w + (size_t)l * 1024 * 6144 + n0 + cq * 4;
#pragma unroll 1
        for (int it0 = 0; it0 < 32; it0 += 8) {
            f32x4 w4[8];
#pragma unroll
            for (int u = 0; u < 8; ++u) w4[u] = *(const f32x4*)(wb + (size_t)((it0 + u) * 32 + kg) * 6144);
#pragma unroll
            for (int u = 0; u < 8; ++u) { const int k = (it0 + u) * 32 + kg;
#pragma unroll
                for (int w = 0; w < 9; ++w) acc[w] += sl[w * 1024 + k] * w4[u]; }
        }
#pragma unroll
        for (int w = 0; w < 9; ++w) *(LAS f32x4*)(red + (kg * 9 + w) * 64 + cq * 4) = acc[w];
        __syncthreads();
        for (int idx = tid; idx < 9 * 64; idx += 512) { const int w = idx >> 6, n = idx & 63; float s = 0.f;
#pragma unroll
            for (int g = 0; g < 32; ++g) s += red[(g * 9 + w) * 64 + n];
            MOD[(size_t)(l * 9 + w) * 6144 + n0 + n] = s + p->ada_b[l * 6144 + n0 + n]; }
        __syncthreads();
    }
    if (blockIdx.x == gridDim.x - 1) {
        float* rope = (float*)(ws + WS_ROPE); float* nls = (float*)(ws + WS_NLS);
        for (int idx = tid; idx < 1024; idx += 512) { const int pos = idx >> 4, i = idx & 15;
            const float inv = __builtin_exp2f(-(float)i * (13.287712379549449f / 16.0f));
            const float angf = (float)pos * inv; const double ang = (double)angf;
            const double twopi = 6.283185307179586476925287; const double r = ang - twopi * __builtin_rint(ang / twopi);
            const double r2 = r * r; double cterm = 1.0, sterm = r, cs = 1.0, sn = r;
            for (int k = 1; k <= 14; ++k) { cterm *= -r2 / (double)((2 * k - 1) * (2 * k)); sterm *= -r2 / (double)((2 * k) * (2 * k + 1)); cs += cterm; sn += sterm; }
            rope[idx * 2] = (float)cs; rope[idx * 2 + 1] = (float)sn; }
        for (int idx = tid; idx < 2 * DRNN; idx += 512) { const float lm = p->lam[idx]; nls[idx] = -8.0f * log1pf(__expf(-lm)); }
        { unsigned* fl = (unsigned*)(ws + WS_FLAG); for (int idx = tid; idx < 1440 * 16; idx += 512) fl[idx] = 0u; }
    }
    transpose_range(p, ws, lds, 0, TR_L0 + TR_LRU + TR_MLP1, blockIdx.x * 8 + wave, gridDim.x * 8, wave, lane);
}

template <bool HAS_Y, bool HAS_H, bool XIN_BF, bool XOUT_BF>
__device__ __forceinline__ void row_phase(const void* xin_lat, const void* xin_ctx, void* xout_lat, void* xout_ctx, const bf16_t* Y, const bf16_t* SLAB, bf16_t* H,
                                          const float* gy, const float* gh, const float* mod_g, int gate_idx, const float* mod_h, int shift_idx, int scale_idx,
                                          int nrows, int gw, int ngw, int lane) {
    const int rpw = (nrows + ngw - 1) / ngw, r_begin = gw * rpw, r_end = (r_begin + rpw < nrows) ? r_begin + rpw : nrows;
#define RCOL(k) (((k) >> 1) * 512 + lane * 8 + ((k) & 1) * 4)
#define BF8_LO(V_) bf4_to_f32((u32x2){(V_).x, (V_).y})
#define BF8_HI(V_) bf4_to_f32((u32x2){(V_).z, (V_).w})
    f32x4 xn[4]; u32x4 xb[2], yn[2], ys[3][2];
    f32x4 vgy[4], vgh[4], vgt[4], vsh[4], vsc[4];
#pragma unroll
    for (int k = 0; k < 4; ++k) { if (HAS_Y) vgy[k] = *(const f32x4*)(gy + RCOL(k)); if (HAS_H) vgh[k] = *(const f32x4*)(gh + RCOL(k)); }
    int cur_who = -1;
#define ROW_LOAD(r) do { const int r_ = (r); const bool lat_ = r_ < ML; const size_t ro_ = lat_ ? (size_t)r_ * DM : (size_t)(r_ - ML) * DM; \
        if (XIN_BF) { const bf16_t* xi_ = (const bf16_t*)(lat_ ? xin_lat : xin_ctx) + ro_; _Pragma("unroll") for (int j = 0; j < 2; ++j) xb[j] = *(const u32x4*)(xi_ + j * 512 + lane * 8); } \
        else { const float* xi_ = (const float*)(lat_ ? xin_lat : xin_ctx) + ro_; _Pragma("unroll") for (int k = 0; k < 4; ++k) xn[k] = *(const f32x4*)(xi_ + RCOL(k)); } \
        if (HAS_Y) { if (SLAB != nullptr && !lat_) { const bf16_t* yp_ = SLAB + (size_t)(r_ - ML) * DM + lane * 8; \
                _Pragma("unroll") for (int j = 0; j < 2; ++j) { yn[j] = *(const u32x4*)(yp_ + 512 * j); ys[0][j] = *(const u32x4*)(yp_ + 512 * j + (size_t)MC * DM); ys[1][j] = *(const u32x4*)(yp_ + 512 * j + (size_t)2 * MC * DM); ys[2][j] = *(const u32x4*)(yp_ + 512 * j + (size_t)3 * MC * DM); } } \
            else { _Pragma("unroll") for (int j = 0; j < 2; ++j) yn[j] = *(const u32x4*)(Y + (size_t)r_ * DM + j * 512 + lane * 8); } } } while (0)
    if (r_begin < r_end) ROW_LOAD(r_begin);
    for (int row = r_begin; row < r_end; ++row) {
        const bool lat = row < ML; const int who = lat ? (row >> 11) : 8;
        if (who != cur_who) { cur_who = who;
#pragma unroll
            for (int k = 0; k < 4; ++k) { const int col = RCOL(k);
                if (HAS_Y) vgt[k] = *(const f32x4*)(mod_g + (size_t)who * 6144 + gate_idx * 1024 + col);
                if (HAS_H) { vsh[k] = *(const f32x4*)(mod_h + (size_t)who * 6144 + shift_idx * 1024 + col); vsc[k] = *(const f32x4*)(mod_h + (size_t)who * 6144 + scale_idx * 1024 + col) + 1.0f; } } }
        f32x4 xv[4], yv[4];
#pragma unroll
        for (int j = 0; j < 2; ++j) { xv[2 * j] = XIN_BF ? BF8_LO(xb[j]) : xn[2 * j]; xv[2 * j + 1] = XIN_BF ? BF8_HI(xb[j]) : xn[2 * j + 1]; }
        if (HAS_Y) {
#pragma unroll
            for (int j = 0; j < 2; ++j) { yv[2 * j] = BF8_LO(yn[j]); yv[2 * j + 1] = BF8_HI(yn[j]);
                if (SLAB != nullptr && !lat) { yv[2 * j] = (yv[2 * j] + BF8_LO(ys[0][j])) + (BF8_LO(ys[1][j]) + BF8_LO(ys[2][j])); yv[2 * j + 1] = (yv[2 * j + 1] + BF8_HI(ys[0][j])) + (BF8_HI(ys[1][j]) + BF8_HI(ys[2][j])); } }
        }
        asm volatile("" ::: "memory");
        if (row + 1 < r_end) ROW_LOAD(row + 1);
        if (HAS_Y) {
            float s = 0.f;
#pragma unroll
            for (int k = 0; k < 4; ++k) s += (yv[k][0] * yv[k][0] + yv[k][1] * yv[k][1]) + (yv[k][2] * yv[k][2] + yv[k][3] * yv[k][3]);
            const float rstd = 1.0f / sqrtf(wave_sum(s) * (1.0f / DM) + EPS);
            const size_t ro = lat ? (size_t)row * DM : (size_t)(row - ML) * DM;
#pragma unroll
            for (int k = 0; k < 4; ++k) xv[k] = xv[k] + vgt[k] * (yv[k] * rstd * vgy[k]);
            if (XOUT_BF) {
#pragma unroll
                for (int j = 0; j < 2; ++j) { u32x4 w; w.x = cvt_pk_bf16(xv[2 * j][0], xv[2 * j][1]); w.y = cvt_pk_bf16(xv[2 * j][2], xv[2 * j][3]); w.z = cvt_pk_bf16(xv[2 * j + 1][0], xv[2 * j + 1][1]); w.w = cvt_pk_bf16(xv[2 * j + 1][2], xv[2 * j + 1][3]);
                    *(u32x4*)((bf16_t*)(lat ? xout_lat : xout_ctx) + ro + j * 512 + lane * 8) = w; xv[2 * j] = BF8_LO(w); xv[2 * j + 1] = BF8_HI(w); }
            } else {
#pragma unroll
                for (int k = 0; k < 4; ++k) *(f32x4*)((float*)(lat ? xout_lat : xout_ctx) + ro + RCOL(k)) = xv[k];
            }
        }
        if (HAS_H) {
            float s = 0.f;
#pragma unroll
            for (int k = 0; k < 4; ++k) s += (xv[k][0] * xv[k][0] + xv[k][1] * xv[k][1]) + (xv[k][2] * xv[k][2] + xv[k][3] * xv[k][3]);
            const float rstd = 1.0f / sqrtf(wave_sum(s) * (1.0f / DM) + EPS);
#pragma unroll
            for (int j = 0; j < 2; ++j) { const f32x4 h0 = (xv[2 * j] * rstd * vgh[2 * j]) * vsc[2 * j] + vsh[2 * j], h1 = (xv[2 * j + 1] * rstd * vgh[2 * j + 1]) * vsc[2 * j + 1] + vsh[2 * j + 1];
                u32x4 w; w.x = cvt_pk_bf16(h0[0], h0[1]); w.y = cvt_pk_bf16(h0[2], h0[3]); w.z = cvt_pk_bf16(h1[0], h1[1]); w.w = cvt_pk_bf16(h1[2], h1[3]);
                *(u32x4*)(H + (size_t)row * DM + j * 512 + lane * 8) = w; }
        }
    }
#undef ROW_LOAD
#undef RCOL
#undef BF8_LO
#undef BF8_HI
}

__device__ __forceinline__ void attn_phase(LAS unsigned char* lds, const bf16_t* Q, bf16_t* O, const bf16_t* Kb, const bf16_t* VT, const bf16_t* VTC, const float* sink, int tid, int lane, int wave) {
    constexpr int PITCH = 72;
    LAS bf16_t* Ks = (LAS bf16_t*)lds;
    LAS bf16_t* Vs = (LAS bf16_t*)(lds + 2 * 64 * PITCH * 2);
    const int lr = lane & 15, lg = lane >> 4;
    const int skey = tid >> 3, spiece = tid & 7;
    for (int unit = blockIdx.x; unit < 576; unit += gridDim.x) {
        int b, kvh, qrow0, qblk, nloc, lt0; bool latu = unit < 512;
        if (latu) { b = unit >> 6; const int rem = unit & 63; qblk = rem >> 2; kvh = rem & 3; qrow0 = b * SEQ + qblk * 128; lt0 = (qblk == 0) ? 2 : 0; nloc = ((qblk == 15) ? 4 : 6) - lt0; }
        else { const int cu = unit - 512; b = cu >> 3; kvh = (cu & 7) >> 1; qblk = 0; qrow0 = ML + b * CTX + (cu & 1) * 128; lt0 = 0; nloc = 0; }
        const int nlo = (latu && qblk > 0) ? 2 : 0, nmid = latu ? 2 : 0, nup = (latu && qblk < 15) ? 2 : 0;
        const int n1 = nlo, n2 = nlo + nmid, n3 = n2 + 4, nT = n3 + nup; (void)nloc; (void)lt0;
        const int head = kvh * 4 + (wave >> 1);
        const int qr0 = qrow0 + (wave & 1) * 64;
        const bf16_t* qbase = Q + (size_t)qr0 * 1024 + head * 64;
        bf16_t* obase = O + (size_t)qr0 * 1024 + head * 64;
        LAS unsigned char* Qs = lds + 40960 + wave * 8192;
#pragma unroll
        for (int qt = 0; qt < 4; ++qt)
#pragma unroll
            for (int dh = 0; dh < 2; ++dh) *(LAS bf16x8*)(Qs + (qt * 2 + dh) * 1024 + lane * 16) = *(const bf16x8*)(qbase + (unsigned)((qt * 16 + lr) * 1024 + dh * 32 + lg * 8));
        f32x4 o[4][4];
#pragma unroll
        for (int qt = 0; qt < 4; ++qt)
#pragma unroll
            for (int dt = 0; dt < 4; ++dt) o[qt][dt] = (f32x4){0.f, 0.f, 0.f, 0.f};
        float m2[4], ls[4];
        { const float sk = sink[head] * LOG2E;
#pragma unroll
          for (int qt = 0; qt < 4; ++qt) { m2[qt] = sk; ls[qt] = (lg == 0) ? 1.0f : 0.0f; } }
        u32x4 kreg, vreg;
#define ATT_TOK0(j_) ((qblk - 1) * 128 + (((j_) < n1) ? (j_) : (((j_) < n2) ? 2 + (j_) - n1 : 4 + (j_) - n3)) * 64)
#define ATT_LOAD(j) do { const int _j = (j); if (_j < n2 || _j >= n3) { const int tok0 = ATT_TOK0(_j); \
                const bf16_t* kb_ = Kb + (size_t)(b * SEQ + tok0) * 256 + kvh * 64; const bf16_t* vb_ = VT + (size_t)(b * 4 + kvh) * 64 * SEQ + tok0; \
                kreg = *(const u32x4*)(kb_ + (unsigned)(skey * 256 + spiece * 8)); vreg = *(const u32x4*)(vb_ + (unsigned)(skey * SEQ + spiece * 8)); } \
            else { const int tok0 = (_j - n2) * 64; \
                const bf16_t* kb_ = Kb + (size_t)(ML + b * CTX + tok0) * 256 + kvh * 64; const bf16_t* vb_ = VTC + (size_t)(b * 4 + kvh) * 64 * CTX + tok0; \
                kreg = *(const u32x4*)(kb_ + (unsigned)(skey * 256 + spiece * 8)); vreg = *(const u32x4*)(vb_ + (unsigned)(skey * CTX + spiece * 8)); } } while (0)
#define ATT_STORE(buf) do { *(LAS u32x4*)(Ks + (buf) * 64 * PITCH + skey * PITCH + spiece * 8) = kreg; *(LAS u32x4*)(Vs + (buf) * 64 * PITCH + skey * PITCH + spiece * 8) = vreg; } while (0)
        __syncthreads();
        ATT_LOAD(0); ATT_STORE(0);
        __syncthreads();
#define ATT_BODY(MM) { \
            const int buf = j & 1; \
            if (j + 1 < nT) ATT_LOAD(j + 1); \
            const LAS bf16_t* Kt = Ks + buf * 64 * PITCH; const LAS bf16_t* Vt = Vs + buf * 64 * PITCH; \
            const int ktok0 = ATT_TOK0(j); \
            bf16x8 kf[4][2]; \
            _Pragma("unroll") \
            for (int ks = 0; ks < 4; ++ks) \
            _Pragma("unroll") \
                for (int dh = 0; dh < 2; ++dh) kf[ks][dh] = *(const LAS bf16x8*)(Kt + (ks * 16 + lr) * PITCH + dh * 32 + lg * 8); \
            _Pragma("unroll") \
            for (int hq = 0; hq < 2; ++hq) { \
            bf16x8 pb[2][2]; \
            _Pragma("unroll") \
            for (int q2 = 0; q2 < 2; ++q2) { \
                const int qt = hq * 2 + q2; \
                f32x4 s[4]; \
                const bf16x8 qf0 = *(const LAS bf16x8*)(Qs + (qt * 2 + 0) * 1024 + lane * 16), qf1 = *(const LAS bf16x8*)(Qs + (qt * 2 + 1) * 1024 + lane * 16); \
            _Pragma("unroll") \
                for (int ks = 0; ks < 4; ++ks) { s[ks] = __builtin_amdgcn_mfma_f32_16x16x32_bf16(kf[ks][0], qf0, (f32x4){0.f, 0.f, 0.f, 0.f}, 0, 0, 0); \
                    s[ks] = __builtin_amdgcn_mfma_f32_16x16x32_bf16(kf[ks][1], qf1, s[ks], 0, 0, 0); } \
                if (MM == 1) {    \
                    const int lim = qblk * 128 + (wave & 1) * 64 + qt * 16 + lr - 128 - ktok0 - lg * 4; \
            _Pragma("unroll") \
                    for (int ks = 0; ks < 4; ++ks) \
            _Pragma("unroll") \
                        for (int jj = 0; jj < 4; ++jj) s[ks][jj] = (ks * 16 + jj >= lim) ? s[ks][jj] : -1e30f; \
                } else if (MM == 2) {    \
                    const int lim = qblk * 128 + (wave & 1) * 64 + qt * 16 + lr + 128 - ktok0 - lg * 4; \
            _Pragma("unroll") \
                    for (int ks = 0; ks < 4; ++ks) \
            _Pragma("unroll") \
                        for (int jj = 0; jj < 4; ++jj) s[ks][jj] = (ks * 16 + jj <= lim) ? s[ks][jj] : -1e30f; \
                } \
                float mx = -3e38f; \
            _Pragma("unroll") \
                for (int ks = 0; ks < 4; ++ks) mx = fmaxf(mx, fmaxf(fmaxf(s[ks][0], s[ks][1]), fmaxf(s[ks][2], s[ks][3]))); \
                mx = fmaxf(mx, __shfl_xor(mx, 16)); mx = fmaxf(mx, __shfl_xor(mx, 32)); \
                const float mnew = fmaxf(m2[qt], mx * LOG2E); \
                const float alpha = __builtin_amdgcn_exp2f(m2[qt] - mnew); \
                m2[qt] = mnew; \
                float rs = 0.f; \
            _Pragma("unroll") \
                for (int ks = 0; ks < 4; ++ks) \
            _Pragma("unroll") \
                    for (int jj = 0; jj < 4; ++jj) { const float pv = __builtin_amdgcn_exp2f(s[ks][jj] * LOG2E - mnew); s[ks][jj] = pv; rs += pv; } \
                ls[qt] = ls[qt] * alpha + rs; \
            _Pragma("unroll") \
                for (int dt = 0; dt < 4; ++dt) o[qt][dt] = o[qt][dt] * alpha; \
            _Pragma("unroll") \
                for (int c2 = 0; c2 < 2; ++c2) { u32x4 w; w.x = cvt_pk_bf16(s[2 * c2][0], s[2 * c2][1]); w.y = cvt_pk_bf16(s[2 * c2][2], s[2 * c2][3]); w.z = cvt_pk_bf16(s[2 * c2 + 1][0], s[2 * c2 + 1][1]); w.w = cvt_pk_bf16(s[2 * c2 + 1][2], s[2 * c2 + 1][3]); \
                    pb[q2][c2] = __builtin_bit_cast(bf16x8, w); } \
            } \
            _Pragma("unroll") \
            for (int c2 = 0; c2 < 2; ++c2) \
            _Pragma("unroll") \
                for (int dt = 0; dt < 4; ++dt) { \
                    const LAS bf16_t* vp = Vt + (dt * 16 + lr) * PITCH + c2 * 32 + lg * 4; \
                    const u32x2 v0 = *(const LAS u32x2*)vp, v1 = *(const LAS u32x2*)(vp + 16); \
                    const u32x4 vv = {v0.x, v0.y, v1.x, v1.y}; \
                    const bf16x8 vf = __builtin_bit_cast(bf16x8, vv); \
            _Pragma("unroll") \
                    for (int q2 = 0; q2 < 2; ++q2) o[hq * 2 + q2][dt] = __builtin_amdgcn_mfma_f32_16x16x32_bf16(vf, pb[q2][c2], o[hq * 2 + q2][dt], 0, 0, 0); \
                } \
            } \
            if (j + 1 < nT) ATT_STORE(buf ^ 1); \
            __syncthreads(); \
        }
        int j = 0;
#pragma unroll 1
        for (; j < n1; ++j) ATT_BODY(1)
#pragma unroll 1
        for (; j < n3; ++j) ATT_BODY(0)
#pragma unroll 1
        for (; j < nT; ++j) ATT_BODY(2)
#undef ATT_BODY
#pragma unroll
        for (int qt = 0; qt < 4; ++qt) {
            float l = ls[qt]; l += __shfl_xor(l, 16); l += __shfl_xor(l, 32);
            const float inv = 1.0f / l;
            int lro = lr * 1024 + lg * 4; asm volatile("" : "+v"(lro));
            bf16_t* op = obase + (unsigned)(qt * 16 * 1024 + lro);
#pragma unroll
            for (int dt = 0; dt < 4; ++dt) *(u32x2*)(op + dt * 16) = f32_to_bf4(o[qt][dt] * inv);
        }
    }
#undef ATT_LOAD
#undef ATT_TOK0
#undef ATT_STORE
}

__device__ __forceinline__ void conv_phase(const bf16_t* R, bf16_t* U, const float* cw, const float* cb, int gtid, int nthreads) {
    for (int idx = gtid; idx < MT * 160; idx += nthreads) {
        const int row = idx / 160, ch = (idx % 160) * 8;
        int t, T; if (row < ML) { t = row & 2047; T = SEQ; } else { t = (row - ML) & 255; T = CTX; }
        float acc[8];
        { const f32x4 b0 = *(const f32x4*)(cb + ch), b1 = *(const f32x4*)(cb + ch + 4); acc[0] = b0[0]; acc[1] = b0[1]; acc[2] = b0[2]; acc[3] = b0[3]; acc[4] = b1[0]; acc[5] = b1[1]; acc[6] = b1[2]; acc[7] = b1[3]; }
#pragma unroll
        for (int tap = 0; tap < 4; ++tap) { const int tt = t + tap - 2;
            if (tt >= 0 && tt < T) { const u32x4 rv = *(const u32x4*)(R + (size_t)(row + tap - 2) * DRNN + ch);
                const f32x4 w0 = *(const f32x4*)(cw + tap * DRNN + ch), w1 = *(const f32x4*)(cw + tap * DRNN + ch + 4);
                acc[0] += w0[0] * bf_lo(rv.x); acc[1] += w0[1] * bf_hi(rv.x); acc[2] += w0[2] * bf_lo(rv.y); acc[3] += w0[3] * bf_hi(rv.y);
                acc[4] += w1[0] * bf_lo(rv.z); acc[5] += w1[1] * bf_hi(rv.z); acc[6] += w1[2] * bf_lo(rv.w); acc[7] += w1[3] * bf_hi(rv.w); } }
        u32x4 o; o.x = cvt_pk_bf16(acc[0], acc[1]); o.y = cvt_pk_bf16(acc[2], acc[3]); o.z = cvt_pk_bf16(acc[4], acc[5]); o.w = cvt_pk_bf16(acc[6], acc[7]);
        *(u32x4*)(U + (size_t)row * DRNN + ch) = o;
    }
}
__device__ __forceinline__ int scan_row0(int bl, int c) { return (c < 8) ? (8192 + bl * CTX + c * 32) : (bl * SEQ + (c - 8) * 32); }
__device__ __forceinline__ void scanA_phase(const bf16_t* LA, const bf16_t* BX, float* SP, float* SH, int gtid, int nthreads) {
    for (int idx = gtid; idx < 2 * 4 * 72 * 640; idx += nthreads) {
        const int cp = idx % 640, r1 = idx / 640, c = r1 % 72, r2 = r1 / 72, bl = r2 & 3, dir = r2 >> 2;
        const int row0 = scan_row0(bl, c);
        const size_t base = ((size_t)dir * 9216 + row0) * DRNN + cp * 2;
        float P0 = 1.f, P1 = 1.f, H0 = 0.f, H1 = 0.f;
#pragma unroll 8
        for (int i = 0; i < 32; ++i) { const int ii = dir ? (31 - i) : i;
            const unsigned lw = *(const unsigned*)(LA + base + (size_t)ii * DRNN), bw = *(const unsigned*)(BX + base + (size_t)ii * DRNN);
            const float a0 = __expf(bf_lo(lw)), a1 = __expf(bf_hi(lw));
            P0 *= a0; P1 *= a1; H0 = a0 * H0 + bf_lo(bw); H1 = a1 * H1 + bf_hi(bw); }
        const size_t so = ((size_t)(dir * 4 + bl) * 72 + c) * DRNN + cp * 2;
        *(f32x2*)(SP + so) = (f32x2){P0, P1}; *(f32x2*)(SH + so) = (f32x2){H0, H1};
    }
}
__device__ __forceinline__ void scanB_phase(const float* SP, const float* SH, float* CIN, int gtid, int nthreads) {
    for (int idx = gtid; idx < 2 * 4 * DRNN; idx += nthreads) {
        const int ch = idx % DRNN, r = idx / DRNN, bl = r & 3, dir = r >> 2;
        const size_t base = ((size_t)(dir * 4 + bl) * 72) * DRNN + ch;
        float carry = 0.f;
#pragma unroll 1
        for (int s0 = 0; s0 < 72; s0 += 24) {
            float pv[24], hv[24];
#pragma unroll
            for (int s = 0; s < 24; ++s) { const int sq = s0 + s; const int c = dir ? (sq < 8 ? 7 - sq : 79 - sq) : sq; pv[s] = SP[base + (size_t)c * DRNN]; hv[s] = SH[base + (size_t)c * DRNN]; }
#pragma unroll
            for (int s = 0; s < 24; ++s) { const int sq = s0 + s; const int c = dir ? (sq < 8 ? 7 - sq : 79 - sq) : sq; CIN[base + (size_t)c * DRNN] = carry; carry = pv[s] * carry + hv[s]; }
        }
    }
}
__device__ __forceinline__ void scanC_phase(const bf16_t* LA, const bf16_t* BX, const float* CIN, bf16_t* REC, int half, int gtid, int nthreads) {
    for (int idx = gtid; idx < 4 * 64 * 640; idx += nthreads) {
        const int cp = idx % 640, r1 = idx / 640, lc = r1 & 63, bl = r1 >> 6;
        const int row0 = bl * SEQ + lc * 32;
        const size_t b0 = ((size_t)row0) * DRNN + cp * 2, b1 = ((size_t)9216 + row0) * DRNN + cp * 2;
        const f32x2 cf = *(const f32x2*)(CIN + ((size_t)(0 * 4 + bl) * 72 + 8 + lc) * DRNN + cp * 2);
        const f32x2 cbk = *(const f32x2*)(CIN + ((size_t)(1 * 4 + bl) * 72 + 8 + lc) * DRNN + cp * 2);
        float hf0[32], hf1[32];
        float h0 = cf[0], h1 = cf[1];
#pragma unroll
        for (int i = 0; i < 32; ++i) { const unsigned lw = *(const unsigned*)(LA + b0 + (size_t)i * DRNN), bw = *(const unsigned*)(BX + b0 + (size_t)i * DRNN);
            h0 = __expf(bf_lo(lw)) * h0 + bf_lo(bw); h1 = __expf(bf_hi(lw)) * h1 + bf_hi(bw); hf0[i] = h0; hf1[i] = h1; }
        h0 = cbk[0]; h1 = cbk[1];
        bf16_t* out = REC + ((size_t)(half * 4 + bl) * SEQ + lc * 32) * DRNN + cp * 2;
#pragma unroll
        for (int i = 31; i >= 0; --i) { const unsigned lw = *(const unsigned*)(LA + b1 + (size_t)i * DRNN), bw = *(const unsigned*)(BX + b1 + (size_t)i * DRNN);
            h0 = __expf(bf_lo(lw)) * h0 + bf_lo(bw); h1 = __expf(bf_hi(lw)) * h1 + bf_hi(bw);
            *(unsigned*)(out + (size_t)i * DRNN) = cvt_pk_bf16(hf0[i] + h0, hf1[i] + h1); }
    }
}

#ifndef PH_MASK
#define PH_MASK 0xFFFFFFFFu
#endif
#define PH(k) ((PH_MASK >> (k)) & 1u)
#ifndef REP_MASK
#define REP_MASK 0u
#endif
#define REP_BEGIN(k) _Pragma("unroll 1") for (int rep_ = 0; rep_ < (((REP_MASK >> (k)) & 1u) ? 2 : 1); ++rep_) {
#define REP_END }
__device__ __forceinline__ ParamsK kparams() { ParamsK q = (ParamsK)__builtin_amdgcn_kernarg_segment_ptr(); asm volatile("" : "+s"(q)); return q; }
#define PHASE_BEGIN ParamsK kp = kparams(); unsigned char* ws = kp->ws; (void)ws; \
    int tid = threadIdx.x; asm volatile("" : "+v"(tid)); const int lane = tid & 63, wave = __builtin_amdgcn_readfirstlane(tid >> 6); \
    const int gw = bid * 8 + wave, gtid = bid * 512 + tid; (void)lane; (void)gw; (void)gtid;
#define P_MOD0 ((float*)(ws + WS_MOD))
#define P_MOD1 ((float*)(ws + WS_MOD) + 9 * 6144)
#define P_CTXRES ((float*)(ws + WS_CTXRES))
#define P_H ((bf16_t*)(ws + WS_H))
#define P_SLAB ((bf16_t*)(ws + WS_SLAB))
#define P_Q ((bf16_t*)(ws + WS_Q))
#define P_O ((bf16_t*)(ws + WS_O))
#define P_K ((bf16_t*)(ws + WS_K))
#define P_VT ((bf16_t*)(ws + WS_VT))
#define P_VTC ((bf16_t*)(ws + WS_VTC))
#define P_ACT ((bf16_t*)(ws + WS_ACT))
#define P_U ((bf16_t*)(ws + WS_U))
#define P_RECF ((bf16_t*)(ws + WS_RECF))
#define P_RECB ((bf16_t*)(ws + WS_RECB))
#define P_LA ((bf16_t*)(ws + WS_LA))
#define P_BX ((bf16_t*)(ws + WS_BX))
#define P_RPRE ((bf16_t*)(ws + WS_RPRE))
#define P_SP ((float*)(ws + WS_SP))
#define P_SH ((float*)(ws + WS_SH))
#define P_CIN ((float*)(ws + WS_CIN))
#define G0 (kp->norm_g)
#define G1 (kp->norm_g + 4 * DM)

__global__ void __launch_bounds__(512, 2) fwd_megakernel(Params p) {
    extern __shared__ __attribute__((aligned(16))) unsigned char lds_raw[];
    LAS unsigned char* lds = (LAS unsigned char*)lds_raw;
    const int G = gridDim.x, bid = blockIdx.x;
    const int ngw = G * 8, nthreads = G * 512;
    using namespace pg8;
    if (threadIdx.x < 4) ((volatile LAS unsigned*)(lds + 132096))[threadIdx.x] = 0u;
    __syncthreads();
    XcdBarrier xbar = xcd_barrier_post((unsigned*)(p.ws + WS_BAR), (volatile LAS unsigned*)(lds + 132096));
    if (PH(0)) { PHASE_BEGIN prologue(kp, lds, tid, lane, wave); }
    xcd_barrier(xbar);
#ifdef EXTRA_SYNCS
#pragma unroll 1
    for (int es = 0; es < EXTRA_SYNCS; ++es) xcd_barrier(xbar);
#endif
    REP_BEGIN(1)
    if (PH(1)) { PHASE_BEGIN row_phase<false, true, false, false>(kp->x, kp->ctx, nullptr, nullptr, nullptr, nullptr, P_H, nullptr, G0, nullptr, 0, P_MOD0, 0, 1, MT, gw, ngw, lane); }
    xcd_barrier(xbar);
    REP_END
    if (PH(2)) {
        PHASE_BEGIN
        Gemm g{P_H, (const bf16_t*)(ws + WS_WQKV), DM, DM, DM}; Sched S; S.init(MT / 256, NQKV / 256, G, bid);
        EpiQKV E{P_Q, P_K, P_VT, P_VTC, (const float*)(ws + WS_ROPE)};
        gemm_phase<EpiQKV, true, true>(lds, g, S, E);
    }
    xcd_barrier(xbar);
    REP_BEGIN(3)
    if (PH(3)) { PHASE_BEGIN attn_phase(lds, P_Q, P_O, P_K, P_VT, P_VTC, kp->sink, tid, lane, wave); }
    xcd_barrier(xbar);
    REP_END
    if (PH(4)) {
        PHASE_BEGIN
        { Gemm g{P_O, (const bf16_t*)(ws + WS_WO), DM, DM, DM}; Sched S; S.init(ML / 256, DM / 256, G, bid);
          EpiPlain<0> E{P_H, DM};
          gemm_phase<EpiPlain<0>, true, true>(lds, g, S, E); }
        { Gemm g{P_O, (const bf16_t*)(ws + WS_WO), DM, DM, 256}; Sched S; S.init(8, 4 * 4, G, bid, 2, 256);
          EpiSlabCtx E{P_SLAB, 256};
          gemm_phase<EpiSlabCtx, true, true>(lds, g, S, E); }
    }
    xcd_barrier(xbar);
    if (PH(5)) { PHASE_BEGIN row_phase<true, true, false, true>(kp->x, kp->ctx, kp->out, P_CTXRES, P_H, P_SLAB, P_H, G0 + DM, G0 + 2 * DM, P_MOD0, 2, P_MOD0, 3, 4, MT, gw, ngw, lane); }
    xcd_barrier(xbar);
    if (PH(6)) {
        PHASE_BEGIN
        Gemm g{P_H, (const bf16_t*)(ws + WS_W1), DM, DM, DM}; Sched S; S.init(MT / 256, DFF / 256, G, bid);
        EpiPlain<1> E{P_ACT, DFF};
        gemm_phase<EpiPlain<1>, true, true>(lds, g, S, E);
    }
    xcd_barrier(xbar);
    if (PH(7)) {
        PHASE_BEGIN
        { Gemm g{P_ACT, (const bf16_t*)(ws + WS_W2), DFF, DFF, DFF}; Sched S; S.init(ML / 256, DM / 256, G, bid);
          EpiPlain<0> E{P_H, DM};
          gemm_phase<EpiPlain<0>, true, true>(lds, g, S, E); }
        { Gemm g{P_ACT, (const bf16_t*)(ws + WS_W2), DFF, DFF, 1024}; Sched S; S.init(8, 4 * 4, G, bid, 2, 1024);
          EpiSlabCtx E{P_SLAB, 1024};
          gemm_phase<EpiSlabCtx, true, true>(lds, g, S, E); }
    }
    xcd_barrier(xbar);
    if (PH(8)) { PHASE_BEGIN row_phase<true, true, true, true>(kp->out, P_CTXRES, kp->out, P_CTXRES, P_H, P_SLAB, P_H, G0 + 3 * DM, G1, P_MOD0, 5, P_MOD1, 0, 1, MT, gw, ngw, lane); }
    xcd_barrier(xbar);
    if (PH(9)) {
        PHASE_BEGIN
        Gemm g{P_H, (const bf16_t*)(ws + WS_WIN), DM, DM, DM}; Sched S; S.init(MT / 256, DRNN / 256, G, bid, 4, 0);
        EpiInProj E{P_RPRE, (bf16_t*)(ws + WS_CTXRES)};
        gemm_phase<EpiInProj, true, true>(lds, g, S, E);
    }
    xcd_barrier(xbar);
    REP_BEGIN(10)
    if (PH(10)) { PHASE_BEGIN conv_phase(P_RPRE, P_U, kp->conv_w, kp->conv_b, gtid, nthreads);
        u32x4* cz = (u32x4*)(ws + WS_CARRY); for (int idx = gtid; idx < 1440 * 128 * 8 / 16; idx += nthreads) cz[idx] = (u32x4){0u, 0u, 0u, 0u}; }
    xcd_barrier(xbar);
    REP_END
    if (PH(11)) {
        PHASE_BEGIN
        Gemm g{P_U, (const bf16_t*)(ws + WS_WG), DRNN, 256, 256}; Sched S; S.init(1, 1, G, bid, 3, 0);
        EpiGatesScan E{P_U, P_RECF, P_RECB, kp->b_a, kp->b_i, (const float*)(ws + WS_NLS), (unsigned long long*)(ws + WS_CARRY)};
        gemm_phase<EpiGatesScan, true, true>(lds, g, S, E);
    }
    xcd_barrier(xbar);
    if (PH(15)) {
        PHASE_BEGIN
        Gemm g{P_H, (const bf16_t*)(ws + WS_WIN), DM, DM, DM}; Sched S; S.init(ML / 256, 4, G, bid);
        EpiGateMul E{P_RECF, P_RECB};
        gemm_phase<EpiGateMul, true, true>(lds, g, S, E);
        {
            const bf16_t* GB = (const bf16_t*)(ws + WS_CTXRES); bf16_t* Z = P_RECF; const bf16_t* RB = P_RECB;
            for (int idx = gtid; idx < ML * 32; idx += nthreads) { const int row = idx >> 5, c8 = (idx & 31) * 8;
                const u32x4 gv = *(const u32x4*)(GB + (size_t)row * 256 + c8); const size_t o = (size_t)row * DRNN + 1024 + c8;
                const u32x4 fv = *(const u32x4*)(Z + o), bv = *(const u32x4*)(RB + o); u32x4 w;
                w.x = cvt_pk_bf16(bf_lo(gv.x) * (bf_lo(fv.x) + bf_lo(bv.x)), bf_hi(gv.x) * (bf_hi(fv.x) + bf_hi(bv.x)));
                w.y = cvt_pk_bf16(bf_lo(gv.y) * (bf_lo(fv.y) + bf_lo(bv.y)), bf_hi(gv.y) * (bf_hi(fv.y) + bf_hi(bv.y)));
                w.z = cvt_pk_bf16(bf_lo(gv.z) * (bf_lo(fv.z) + bf_lo(bv.z)), bf_hi(gv.z) * (bf_hi(fv.z) + bf_hi(bv.z)));
                w.w = cvt_pk_bf16(bf_lo(gv.w) * (bf_lo(fv.w) + bf_lo(bv.w)), bf_hi(gv.w) * (bf_hi(fv.w) + bf_hi(bv.w)));
                *(u32x4*)(Z + o) = w; }
        }
    }
    xcd_barrier(xbar);
    if (PH(16)) {
        PHASE_BEGIN
        Gemm g{P_RECF, (const bf16_t*)(ws + WS_WOUT), DRNN, DRNN, DRNN}; Sched S; S.init(ML / 256, DM / 256, G, bid);
        EpiPlain<0> E{P_H, DM};
        gemm_phase<EpiPlain<0>, true, true>(lds, g, S, E);
    }
    xcd_barrier(xbar);
    if (PH(17)) { PHASE_BEGIN row_phase<true, true, true, true>(kp->out, P_CTXRES, ws + WS_X3, P_CTXRES, P_H, nullptr, P_H, G1 + DM, G1 + 2 * DM, P_MOD1, 2, P_MOD1, 3, 4, ML, gw, ngw, lane); }
    xcd_barrier(xbar);
    if (PH(18)) {
        PHASE_BEGIN
        Gemm g{P_H, (const bf16_t*)(ws + WS_W1 + 16 * MiB), DM, DM, DM}; Sched S; S.init(ML / 256, DFF / 256, G, bid);
        EpiPlain<1> E{P_ACT, DFF};
        gemm_phase<EpiPlain<1>, true, true>(lds, g, S, E);
    }
    xcd_barrier(xbar);
    if (PH(19)) {
        PHASE_BEGIN
        Gemm g{P_ACT, (const bf16_t*)(ws + WS_W2 + 16 * MiB), DFF, DFF, DFF}; Sched S; S.init(ML / 256, DM / 256, G, bid);
        EpiPlain<0> E{P_H, DM};
        gemm_phase<EpiPlain<0>, true, true>(lds, g, S, E);
    }
    xcd_barrier(xbar);
    if (PH(20)) { PHASE_BEGIN row_phase<true, false, true, false>(ws + WS_X3, P_CTXRES, kp->out, P_CTXRES, P_H, nullptr, nullptr, G1 + 3 * DM, nullptr, P_MOD1, 5, nullptr, 0, 0, ML, gw, ngw, lane); }
}

extern "C" void kernel_launch(void* const* d_in, const int* in_sizes, int n_in, void* d_out, int out_size, void* d_ws, size_t ws_size, hipStream_t stream) {
    static int grid_blocks = 0;
    if (grid_blocks == 0) {
        if (n_in != 21 || ws_size < WS_END) { fprintf(stderr, "kernel_launch: unexpected n_in %d / ws_size %zu\n", n_in, ws_size); grid_blocks = -1; return; }
        int dev = 0, cus = 0, per_cu = 0;
        hipGetDevice(&dev);
        hipDeviceGetAttribute(&cus, hipDeviceAttributeMultiprocessorCount, dev);
        if (hipFuncSetAttribute((const void*)fwd_megakernel, hipFuncAttributeMaxDynamicSharedMemorySize, LDS_BYTES) != hipSuccess) { fprintf(stderr, "hipFuncSetAttribute failed\n"); grid_blocks = -1; return; }
        if (hipOccupancyMaxActiveBlocksPerMultiprocessor(&per_cu, (const void*)fwd_megakernel, 512, LDS_BYTES) != hipSuccess || per_cu < 1) { fprintf(stderr, "occupancy query failed (%d)\n", per_cu); (void)hipGetLastError(); per_cu = 1; }
        grid_blocks = cus * 1;
    }
    if (grid_blocks < 0) return;
    Params p{};
    p.x = (const float*)d_in[0]; p.c = (const float*)d_in[1]; p.ctx = (const float*)d_in[2]; p.c_ctx = (const float*)d_in[3];
    p.ada_w = (const float*)d_in[4]; p.ada_b = (const float*)d_in[5]; p.norm_g = (const float*)d_in[6]; p.mlp_w1 = (const float*)d_in[7]; p.mlp_w2 = (const float*)d_in[8];
    p.w_qkv = (const float*)d_in[9]; p.w_o = (const float*)d_in[10]; p.sink = (const float*)d_in[11];
    p.w_in = (const float*)d_in[12]; p.conv_w = (const float*)d_in[13]; p.conv_b = (const float*)d_in[14]; p.w_a = (const float*)d_in[15]; p.b_a = (const float*)d_in[16];
    p.w_i = (const float*)d_in[17]; p.b_i = (const float*)d_in[18]; p.lam = (const float*)d_in[19]; p.w_out = (const float*)d_in[20];
    p.out = (float*)d_out; p.ws = (unsigned char*)d_ws;
    if (hipMemsetAsync((unsigned char*)d_ws + WS_BAR, 0, XCD_BAR_WORDS * 4, stream) != hipSuccess) { fprintf(stderr, "memset of barrier words failed\n"); return; }
    void* args[] = {&p};
    hipError_t e = hipLaunchCooperativeKernel((const void*)fwd_megakernel, dim3(grid_blocks), dim3(512), args, LDS_BYTES, stream);
    if (e != hipSuccess) fprintf(stderr, "cooperative launch failed: %s (grid %d)\n", hipGetErrorString(e), grid_blocks);
}
```

```cpp
#include <hip/hip_runtime.h>
#include <hip/hip_cooperative_groups.h>
#include <cstdio>
#include <cstdint>
namespace cg = cooperative_groups;

#define LAS __attribute__((address_space(3)))
typedef unsigned short bf16_t;
typedef short bf16x8 __attribute__((ext_vector_type(8)));
typedef float f32x4 __attribute__((ext_vector_type(4)));
typedef float f32x2 __attribute__((ext_vector_type(2)));
typedef unsigned u32x4 __attribute__((ext_vector_type(4)));
typedef unsigned u32x2 __attribute__((ext_vector_type(2)));

constexpr int DM = 1024, NB = 8, SEQ = 2048, CTX = 256;
constexpr int ML = NB * SEQ;
constexpr int MC = NB * CTX;
constexpr int MT = ML + MC;
constexpr int NQKV = 1536, DFF = 4096, DRNN = 1280;
constexpr float EPS = 1e-6f;
constexpr float LOG2E = 1.4426950408889634f;

constexpr size_t MiB = 1u << 20;
constexpr size_t WS_MOD = 0;
constexpr size_t WS_ROPE = 448 * 1024;
constexpr size_t WS_NLS = 460 * 1024;
constexpr size_t WS_BAR = 480 * 1024;
constexpr size_t WS_WQKV = 1 * MiB, WS_WO = 4 * MiB, WS_W1 = 6 * MiB, WS_W2 = 14 * MiB;
constexpr size_t WS_WIN = 38 * MiB, WS_WG = 43 * MiB, WS_WOUT = 46 * MiB;
constexpr size_t WS_CTXRES = 49 * MiB;
constexpr size_t WS_H = 57 * MiB;
constexpr size_t WS_R3 = 93 * MiB;
constexpr size_t WS_Q = WS_R3, WS_K = 129 * MiB, WS_VT = 138 * MiB, WS_VTC = 146 * MiB;
constexpr size_t WS_O = 150 * MiB;
constexpr size_t WS_ACT = WS_R3;
constexpr size_t WS_U = WS_R3;
constexpr size_t WS_RECF = 138 * MiB;
constexpr size_t WS_RECB = 178 * MiB;
constexpr size_t WS_LA = 138 * MiB;
constexpr size_t WS_BX = 183 * MiB;
constexpr size_t WS_RPRE = 138 * MiB;
constexpr size_t WS_SP = 228 * MiB, WS_SH = 231 * MiB, WS_CIN = 234 * MiB;
constexpr size_t WS_SLAB = 238 * MiB;
constexpr size_t WS_CARRY = 219 * MiB;
constexpr size_t WS_CNT = 500 * 1024;
constexpr size_t WS_FLAG = 512 * 1024;
constexpr size_t WS_X3 = 222 * MiB;
constexpr size_t WS_END = 256 * MiB;
constexpr int LDS_BYTES = 143360;

__device__ __forceinline__ unsigned f2bf(float f) { unsigned u = __builtin_bit_cast(unsigned, f); return (u + 0x7fffu + ((u >> 16) & 1u)) >> 16; }
__device__ __forceinline__ unsigned cvt_pk_bf16(float lo, float hi) { unsigned r; asm volatile("v_cvt_pk_bf16_f32 %0, %1, %2" : "=v"(r) : "v"(lo), "v"(hi)); return r; }
__device__ __forceinline__ float bf_lo(unsigned w) { return __builtin_bit_cast(float, w << 16); }
__device__ __forceinline__ float bf_hi(unsigned w) { return __builtin_bit_cast(float, w & 0xffff0000u); }
__device__ __forceinline__ f32x4 bf4_to_f32(u32x2 w) { return (f32x4){bf_lo(w.x), bf_hi(w.x), bf_lo(w.y), bf_hi(w.y)}; }
__device__ __forceinline__ u32x2 f32_to_bf4(f32x4 v) { u32x2 w; w.x = cvt_pk_bf16(v[0], v[1]); w.y = cvt_pk_bf16(v[2], v[3]); return w; }
__device__ __forceinline__ void store16_wt(void* p, u32x4 w) { asm volatile("global_store_dwordx4 %0, %1, off sc1\n\ts_nop 1" :: "v"(p), "v"(w) : "memory"); }
__device__ __forceinline__ float wave_sum(float v) {
#pragma unroll
    for (int o = 1; o < 64; o <<= 1) v += __shfl_xor(v, o);
    return v;
}
__device__ __forceinline__ float fsigmoid(float x) { return __builtin_amdgcn_rcpf(1.0f + __expf(-x)); }

namespace pg8 {
constexpr int BM = 256, BK = 64, HALF = 128, HTB = HALF * BK * 2, STAGE_BYTES = 8 * HTB, NXCD = 8, WGM = 8;
__device__ __forceinline__ int lds_byte(int r, int c) { const int st = (r >> 4) * 2 + (c >> 5), rr = r & 15, cc = c & 31, ob = rr * 64 + cc * 2; return st * 1024 + (ob ^ (((ob >> 9) & 1) << 5)); }
__device__ __forceinline__ void stage_rc(int b, int& R, int& C) { const int st = b / 1024, sb = b % 1024, swz = sb ^ (((sb >> 9) & 1) << 5); R = (st >> 1) * 16 + swz / 64; C = (st & 1) * 32 + (swz % 64) / 2; }

__device__ __forceinline__ int perm32(int rho) { const int n = rho >> 4, i = rho & 15; return 8 * (i >> 2) + 4 * n + (i & 3); }
struct Unit { int pm, pn, koff, po, kboff, rev, lin; };
struct Gemm { const bf16_t* A; const bf16_t* Bt; int lda, ldb, K; };

struct Sched {
    int nM, nN, nwg, G, c, mode, half;
    __device__ void init(int nM_, int nN_, int G_, int c_, int mode_ = 0, int half_ = 0) { nM = nM_; nN = nN_; nwg = nM * nN; G = G_; c = c_; mode = mode_; half = half_; }
    __device__ bool next(int i, Unit& u) const {
        if (mode == 3) {
            const int L = i * G + c; if (L >= 1440) return false;
            const int ti = L / 160, s = L % 160;
            const int chalf = s & 1, dir = (s >> 1) & 1, bb = s >> 2, blk = bb % 5, b = bb / 5;
            u.pm = (ti == 0) ? 64 + b : (dir ? b * 8 + (8 - ti) : b * 8 + (ti - 1));
            u.pn = (dir * 5 + blk) * 2 + chalf; u.koff = blk * 256; u.kboff = 0; u.po = ti; u.rev = dir; u.lin = L;
            return true;
        }
        if (mode == 5) {
            const int L5 = i * G + c; if (L5 >= 128 + nwg) return false;
            if (L5 < 128) { u.pm = 64 + (L5 >> 4); u.pn = L5 & 15; u.koff = 0; u.po = u.pm; u.kboff = 0; u.rev = 0; u.lin = 0; return true; }
            int wgid = L5 - 128; { const int q = nwg / NXCD, r = nwg % NXCD, xcd = wgid % NXCD, off = wgid / NXCD; wgid = (xcd < r ? xcd * (q + 1) : r * (q + 1) + (xcd - r) * q) + off; }
            const int nig = WGM * nN, gid = wgid / nig, fm = gid * WGM, gsz = (nM - fm) < WGM ? (nM - fm) : WGM;
            u.pm = fm + ((wgid % nig) % gsz); u.pn = (wgid % nig) / gsz; u.koff = 0; u.po = u.pm; u.kboff = 0; u.rev = 0; u.lin = 0;
            return true;
        }
        if (mode == 4) {
            const int L4 = i * G + c; if (L4 >= 424) return false;
            if (L4 >= 360) { u.pm = L4 - 360; u.pn = 4; u.koff = 0; u.po = u.pm; u.kboff = 0; u.rev = 0; u.lin = 0; return true; }
        }
        const long L = (long)i * G + c; if (L >= nwg) return false;
        int wgid = (int)L; { const int q = nwg / NXCD, r = nwg % NXCD, xcd = wgid % NXCD, off = wgid / NXCD; wgid = (xcd < r ? xcd * (q + 1) : r * (q + 1) + (xcd - r) * q) + off; }
        const int nig = WGM * nN, gid = wgid / nig, fm = gid * WGM, gsz = (nM - fm) < WGM ? (nM - fm) : WGM;
        const int pmi = fm + ((wgid % nig) % gsz), pn = (wgid % nig) / gsz;
        u.pm = pmi; u.pn = pn; u.koff = 0; u.po = pmi; u.kboff = 0; u.rev = 0; u.lin = 0;
        if (mode == 2) { u.pm = 64 + pmi; u.pn = pn & 3; u.koff = (pn >> 2) * half; u.kboff = u.koff; }
        if (mode == 4) u.pn += 5;
        if (mode == 1) { u.pm = pmi < 32 ? 32 * half + pmi : 64 + 4 * half + (pmi - 32); u.koff = ((pn >> 1) % 5) * 256; }
        return true;
    }
};

template <class Epi, bool ALIGN_EPI, bool SP2>
__device__ __forceinline__ void gemm_phase(LAS unsigned char* lds, const Gemm g, const Sched& S, const Epi& E) {
    int tid = threadIdx.x; asm volatile("" : "+v"(tid));
    const int wid = __builtin_amdgcn_readfirstlane(tid >> 6), lane = tid & 63, wr = wid >> 2, wc = wid & 3, fr = lane & 15, fq = lane >> 4;
    const int K = g.K, nt = K / BK;
    unsigned voffAf[2], voffAr[2], voffB[2];
#pragma unroll
    for (int i = 0; i < 2; ++i) { int R, C; stage_rc(tid * 16 + i * 8192, R, C);
        const int Rb = Epi::PERM ? ((R & ~31) + perm32(R & 31)) : R;
        voffAf[i] = (unsigned)(R * g.lda + C) * 2u; voffAr[i] = (unsigned)((127 - R) * g.lda + C) * 2u; voffB[i] = (unsigned)(Rb * g.ldb + C) * 2u; }
    const size_t kstep = (size_t)(BK * 2);
    const long hstepAf = (long)HALF * g.lda * 2; const size_t hstepB = (size_t)HALF * g.ldb * 2;
    const unsigned ldsw = (unsigned)wid * 1024u;
    const int aoff = lds_byte(wr * 64 + fr, fq * 8), boff = lds_byte(wc * 32 + fr, fq * 8);
#define PG8_SA(b, h) (((b) * 2 + (h)) * HTB)
#define PG8_SB(b, h) ((4 + (b) * 2 + (h)) * HTB)
#define PG8_STAGE(bufoff, gbase, voff) do { _Pragma("unroll") for (int _i = 0; _i < 2; ++_i) \
        __builtin_amdgcn_global_load_lds((const unsigned*)((const char*)(gbase) + (voff)[_i]), (LAS unsigned*)(lds + (bufoff) + ldsw + _i * 8192), 16, 0, 0); } while (0)
#define PG8_LDA(dst, b, h) do { _Pragma("unroll") for (int m = 0; m < 4; ++m) _Pragma("unroll") for (int k = 0; k < 2; ++k) dst[m][k] = *(const LAS bf16x8*)(lds + PG8_SA(b, h) + aoff + m * 2048 + k * 1024); } while (0)
#define PG8_LDB(dst, b, h) do { _Pragma("unroll") for (int n = 0; n < 2; ++n) _Pragma("unroll") for (int k = 0; k < 2; ++k) dst[n][k] = *(const LAS bf16x8*)(lds + PG8_SB(b, h) + boff + n * 2048 + k * 1024); } while (0)
#define PG8_MMA(ai, bj, At, Bt) do { __builtin_amdgcn_s_setprio(1); _Pragma("unroll") for (int m = 0; m < 4; ++m) _Pragma("unroll") for (int n = 0; n < 2; ++n) _Pragma("unroll") for (int k = 0; k < 2; ++k) \
        acc[ai][bj][m][n] = __builtin_amdgcn_mfma_f32_16x16x32_bf16(Bt[n][k], At[m][k], acc[ai][bj][m][n], 0, 0, 0); __builtin_amdgcn_s_setprio(0); } while (0)
#define PG8_WAIT_V(n) asm volatile("s_waitcnt vmcnt(" #n ")" ::: "memory")
#define PG8_WAIT_L(n) asm volatile("s_waitcnt lgkmcnt(" #n ")" ::: "memory")
#define PG8_BAR __builtin_amdgcn_s_barrier()
#define PG8_SCHED __builtin_amdgcn_sched_barrier(0)
    Unit cur, nxt; int ui = 0;
    if (!S.next(0, cur)) return;
    f32x4 acc[2][2][4][2];
#pragma unroll
    for (int a = 0; a < 2; ++a)
#pragma unroll
        for (int b = 0; b < 2; ++b)
#pragma unroll
            for (int m = 0; m < 4; ++m)
#pragma unroll
                for (int n = 0; n < 2; ++n) acc[a][b][m][n] = (f32x4){0.f, 0.f, 0.f, 0.f};
    bf16x8 At[4][2], B0[2][2], B1[2][2];
#define PG8_UNIT_A(u_) ((const char*)g.A + ((size_t)(u_).pm * BM * g.lda + (u_).koff) * 2 + (Epi::WITH_LDS && (u_).rev ? hstepAf : 0))
    const char* cA = PG8_UNIT_A(cur);
    unsigned voffA[2] = {voffAf[0], voffAf[1]}; long hstepA = hstepAf;
    if (Epi::WITH_LDS && cur.rev) { voffA[0] = voffAr[0]; voffA[1] = voffAr[1]; hstepA = -hstepAf; } const char* cB = (const char*)g.Bt + ((size_t)cur.pn * BM * g.ldb + cur.kboff) * 2;
    if constexpr (SP2) {
        PG8_STAGE(PG8_SB(0, 0), cB, voffB); PG8_STAGE(PG8_SB(0, 1), cB + hstepB, voffB); PG8_STAGE(PG8_SA(0, 0), cA, voffA); PG8_STAGE(PG8_SA(0, 1), cA + hstepA, voffA);
        if (wr == 1) PG8_BAR;
        PG8_WAIT_V(2); PG8_BAR;
        PG8_STAGE(PG8_SB(1, 0), cB + kstep, voffB); PG8_STAGE(PG8_SA(1, 0), cA + kstep, voffA); PG8_STAGE(PG8_SB(1, 1), cB + hstepB + kstep, voffB);
        PG8_WAIT_V(6); PG8_BAR;
    } else {
        PG8_STAGE(PG8_SB(0, 0), cB, voffB); PG8_STAGE(PG8_SA(0, 0), cA, voffA); PG8_STAGE(PG8_SB(0, 1), cB + hstepB, voffB); PG8_STAGE(PG8_SA(0, 1), cA + hstepA, voffA);
        if (wr == 1) PG8_BAR;
        PG8_WAIT_V(4); PG8_BAR;
        PG8_STAGE(PG8_SB(1, 0), cB + kstep, voffB); PG8_STAGE(PG8_SA(1, 0), cA + kstep, voffA); PG8_STAGE(PG8_SB(1, 1), cB + hstepB + kstep, voffB);
        PG8_WAIT_V(6); PG8_BAR;
    }
    for (;;) {
        const bool has_next = S.next(ui + 1, nxt);
        const char* nA = has_next ? PG8_UNIT_A(nxt) : cA;
        unsigned voffN[2] = {voffA[0], voffA[1]}; long hstepN = hstepA;
        if (Epi::WITH_LDS && has_next) { const bool nr = nxt.rev != 0; voffN[0] = nr ? voffAr[0] : voffAf[0]; voffN[1] = nr ? voffAr[1] : voffAf[1]; hstepN = nr ? -hstepAf : hstepAf; }
        const char* nB = has_next ? (const char*)g.Bt + ((size_t)nxt.pn * BM * g.ldb + nxt.kboff) * 2 : cB;
#pragma unroll 1
        for (int t = 0; t < nt; t += 2) {
            const bool last = (t == nt - 2);
            const char* a1 = cA + (size_t)(t + 1) * kstep;
            const char* a2 = last ? nA : cA + (size_t)(t + 2) * kstep; const char* b2 = last ? nB : cB + (size_t)(t + 2) * kstep;
            const char* a3 = a2 + kstep; const char* b3 = b2 + kstep;
            unsigned voff2[2] = {voffA[0], voffA[1]}; long hstep2 = hstepA;
            if (Epi::WITH_LDS && last) { voff2[0] = voffN[0]; voff2[1] = voffN[1]; hstep2 = hstepN; }
            if constexpr (SP2) {
            PG8_LDB(B0, 0, 0); PG8_LDB(B1, 0, 1); PG8_SCHED; PG8_LDA(At, 0, 0); PG8_STAGE(PG8_SA(1, 1), a1 + hstepA, voffA);
            PG8_WAIT_V(8); PG8_WAIT_L(0); PG8_BAR; PG8_MMA(0, 0, At, B0); PG8_MMA(0, 1, At, B1); PG8_BAR; PG8_SCHED;
            PG8_LDA(At, 0, 1); PG8_STAGE(PG8_SB(0, 0), b2, voffB); PG8_STAGE(PG8_SB(0, 1), b2 + hstepB, voffB); PG8_STAGE(PG8_SA(0, 0), a2, voff2);
            PG8_WAIT_V(8); PG8_WAIT_L(0); PG8_BAR; PG8_MMA(1, 0, At, B0); PG8_MMA(1, 1, At, B1); PG8_BAR; PG8_SCHED;
            PG8_LDB(B0, 1, 0); PG8_LDB(B1, 1, 1); PG8_SCHED; PG8_LDA(At, 1, 0); PG8_STAGE(PG8_SA(0, 1), a2 + hstep2, voff2);
            PG8_WAIT_V(8); PG8_WAIT_L(0); PG8_BAR; PG8_MMA(0, 0, At, B0); PG8_MMA(0, 1, At, B1); PG8_BAR; PG8_SCHED;
            PG8_LDA(At, 1, 1); PG8_STAGE(PG8_SB(1, 0), b3, voffB); PG8_STAGE(PG8_SB(1, 1), b3 + hstepB, voffB); PG8_STAGE(PG8_SA(1, 0), a3, voff2);
            PG8_WAIT_V(8); PG8_WAIT_L(0); PG8_BAR; PG8_MMA(1, 0, At, B0); PG8_MMA(1, 1, At, B1); PG8_BAR; PG8_SCHED;
            } else {
            PG8_LDB(B0, 0, 0); PG8_SCHED; PG8_LDA(At, 0, 0); PG8_STAGE(PG8_SA(1, 1), a1 + hstepA, voffA);
            PG8_WAIT_L(8); PG8_BAR; PG8_WAIT_L(0); PG8_MMA(0, 0, At, B0); PG8_BAR; PG8_SCHED;
            PG8_LDB(B1, 0, 1); PG8_STAGE(PG8_SB(0, 0), b2, voffB);
            PG8_BAR; PG8_WAIT_L(0); PG8_MMA(0, 1, At, B1); PG8_BAR;
            PG8_LDA(At, 0, 1); PG8_STAGE(PG8_SA(0, 0), a2, voff2);
            PG8_BAR; PG8_WAIT_L(0); PG8_MMA(1, 0, At, B0); PG8_BAR; PG8_SCHED;
            PG8_STAGE(PG8_SB(0, 1), b2 + hstepB, voffB);
            PG8_WAIT_V(6); PG8_BAR; PG8_MMA(1, 1, At, B1); PG8_BAR;
            PG8_LDB(B0, 1, 0); PG8_SCHED; PG8_LDA(At, 1, 0); PG8_STAGE(PG8_SA(0, 1), a2 + hstep2, voff2);
            PG8_WAIT_L(8); PG8_BAR; PG8_WAIT_L(0); PG8_MMA(0, 0, At, B0); PG8_BAR; PG8_SCHED;
            PG8_LDB(B1, 1, 1); PG8_STAGE(PG8_SB(1, 0), b3, voffB);
            PG8_BAR; PG8_WAIT_L(0); PG8_MMA(0, 1, At, B1); PG8_BAR;
            PG8_LDA(At, 1, 1); PG8_STAGE(PG8_SA(1, 0), a3, voff2);
            PG8_BAR; PG8_WAIT_L(0); PG8_MMA(1, 0, At, B0); PG8_BAR; PG8_SCHED;
            PG8_STAGE(PG8_SB(1, 1), b3 + hstepB, voffB);
            PG8_WAIT_V(6); PG8_BAR; PG8_MMA(1, 1, At, B1); PG8_BAR;
            }
        }
        if constexpr (ALIGN_EPI) { if (wr == 0) PG8_BAR; }
        if constexpr (Epi::WITH_LDS) E.run(acc, cur, wr, wc, lane, lds); else E(acc, cur, wr, wc, fr, fq);
        if (!has_next) break;
#pragma unroll
        for (int a = 0; a < 2; ++a)
#pragma unroll
            for (int b = 0; b < 2; ++b)
#pragma unroll
                for (int m = 0; m < 4; ++m)
#pragma unroll
                    for (int n = 0; n < 2; ++n) acc[a][b][m][n] = (f32x4){0.f, 0.f, 0.f, 0.f};
        cur = nxt; cA = nA; cB = nB; ++ui; voffA[0] = voffN[0]; voffA[1] = voffN[1]; hstepA = hstepN;
        if constexpr (ALIGN_EPI) { if (wr == 1) PG8_BAR; }
    }
    PG8_WAIT_V(0);
    if constexpr (!ALIGN_EPI) { if (wr == 0) PG8_BAR; }
    PG8_BAR;
#undef PG8_UNIT_A
#undef PG8_SA
#undef PG8_SB
#undef PG8_STAGE
#undef PG8_LDA
#undef PG8_LDB
#undef PG8_MMA
#undef PG8_WAIT_V
#undef PG8_WAIT_L
#undef PG8_BAR
#undef PG8_SCHED
}

template <int ACT> struct EpiPlain {
    static constexpr bool WITH_LDS = false, PERM = true;
    bf16_t* O; int ldc; unsigned* done_cnt = nullptr;
    __device__ __forceinline__ void operator()(const f32x4 (&acc)[2][2][4][2], const Unit& u, int wr, int wc, int fr_, int fq_) const {
        int fr = fr_, fq = fq_; asm volatile("" : "+v"(fr), "+v"(fq));
        const int col0 = u.pn * BM + wc * 32 + fq * 8;
#pragma unroll
        for (int ai = 0; ai < 2; ++ai)
#pragma unroll
            for (int m = 0; m < 4; ++m) { bf16_t* rowp = O + (size_t)(u.pm * BM + ai * HALF + wr * 64 + m * 16 + fr) * ldc + col0;
#pragma unroll
                for (int bj = 0; bj < 2; ++bj) { f32x4 v0 = acc[ai][bj][m][0], v1 = acc[ai][bj][m][1];
                    if (ACT == 1) { v0 = __builtin_elementwise_max(v0, (f32x4){0.f, 0.f, 0.f, 0.f}); v0 = v0 * v0; v1 = __builtin_elementwise_max(v1, (f32x4){0.f, 0.f, 0.f, 0.f}); v1 = v1 * v1; }
                    u32x4 w; w.x = cvt_pk_bf16(v0[0], v0[1]); w.y = cvt_pk_bf16(v0[2], v0[3]); w.z = cvt_pk_bf16(v1[0], v1[1]); w.w = cvt_pk_bf16(v1[2], v1[3]);
                    if (ACT == 1 && done_cnt != nullptr && u.pm >= 64) store16_wt(rowp + bj * HALF, w); else *(u32x4*)(rowp + bj * HALF) = w; } }
        if (ACT == 1 && done_cnt != nullptr && u.pm >= 64) {
            asm volatile("s_waitcnt vmcnt(0)" ::: "memory"); __builtin_amdgcn_s_barrier(); asm volatile("" ::: "memory");
            if (threadIdx.x == 0) __hip_atomic_fetch_add(done_cnt, 1u, __ATOMIC_RELAXED, __HIP_MEMORY_SCOPE_AGENT);
        }
    }
};

struct EpiSlabCtx {
    static constexpr bool WITH_LDS = false, PERM = true;
    bf16_t* S; int ksz;
    __device__ __forceinline__ void operator()(const f32x4 (&acc)[2][2][4][2], const Unit& u, int wr, int wc, int fr_, int fq_) const {
        int fr = fr_, fq = fq_; asm volatile("" : "+v"(fr), "+v"(fq));
        const int col0 = u.pn * BM + wc * 32 + fq * 8;
        bf16_t* base = S + (size_t)(u.koff / ksz) * MC * DM;
#pragma unroll
        for (int ai = 0; ai < 2; ++ai)
#pragma unroll
            for (int m = 0; m < 4; ++m) { bf16_t* rowp = base + (size_t)(u.pm * BM - ML + ai * HALF + wr * 64 + m * 16 + fr) * DM + col0;
#pragma unroll
                for (int bj = 0; bj < 2; ++bj) { const f32x4 v0 = acc[ai][bj][m][0], v1 = acc[ai][bj][m][1];
                    u32x4 w; w.x = cvt_pk_bf16(v0[0], v0[1]); w.y = cvt_pk_bf16(v0[2], v0[3]); w.z = cvt_pk_bf16(v1[0], v1[1]); w.w = cvt_pk_bf16(v1[2], v1[3]);
                    *(u32x4*)(rowp + bj * HALF) = w; } }
    }
};

struct EpiQKV {
    static constexpr bool WITH_LDS = false, PERM = false;
    bf16_t* Q; bf16_t* Kb; bf16_t* VT; bf16_t* VTC; const float* rope;
    __device__ __forceinline__ void operator()(const f32x4 (&acc)[2][2][4][2], const Unit& u, int wr, int wc, int fr_, int fq_) const {
        int fr = fr_, fq = fq_; asm volatile("" : "+v"(fr), "+v"(fq));
        const bool lat = u.pm < 64;
        if (u.pn < 5) {
#pragma unroll
            for (int ai = 0; ai < 2; ++ai)
#pragma unroll
                for (int m = 0; m < 4; ++m) {
                    const int row = u.pm * BM + ai * HALF + wr * 64 + m * 16 + fr;
                    f32x4 cs0 = {1.f, 0.f, 1.f, 0.f}, cs1 = {1.f, 0.f, 1.f, 0.f};
                    if (lat) { const int t = row & 2047; const int pos = (wc & 1) ? (t & 63) : (t >> 6); const f32x4* pp = (const f32x4*)(rope + (pos * 16 + 4 * fq) * 2); cs0 = pp[0]; cs1 = pp[1]; }
                    const f32x4 cv = {cs0[0], cs0[2], cs1[0], cs1[2]}, sv = {cs0[1], cs0[3], cs1[1], cs1[3]};
#pragma unroll
                    for (int bj = 0; bj < 2; ++bj) {
                        const f32x4 a = acc[ai][bj][m][0], b = acc[ai][bj][m][1];
                        f32x4 na = a * cv - b * sv, nb = b * cv + a * sv;
                        if (u.pn < 4) { na = na * 0.125f; nb = nb * 0.125f; }
                        bf16_t* d = (u.pn < 4) ? Q + (size_t)row * 1024 + u.pn * 256 + bj * HALF + wc * 32 + fq * 8 : Kb + (size_t)row * 256 + bj * HALF + wc * 32 + fq * 8;
                        u32x4 w; w.x = cvt_pk_bf16(na[0], na[1]); w.y = cvt_pk_bf16(na[2], na[3]); w.z = cvt_pk_bf16(nb[0], nb[1]); w.w = cvt_pk_bf16(nb[2], nb[3]);
                        *(u32x4*)d = w;
                    }
                }
        } else {
#pragma unroll
            for (int ai = 0; ai < 2; ++ai)
#pragma unroll
                for (int m = 0; m < 4; ++m) {
                    const int row = u.pm * BM + ai * HALF + wr * 64 + m * 16 + fr;
                    bf16_t* base; size_t stride;
                    if (lat) { const int b = row >> 11, t = row & 2047; base = VT + (size_t)b * 256 * 2048 + t; stride = 2048; }
                    else { const int rc = row - ML; const int b = rc >> 8, t = rc & 255; base = VTC + (size_t)b * 256 * 256 + t; stride = 256; }
#pragma unroll
                    for (int bj = 0; bj < 2; ++bj)
#pragma unroll
                        for (int n = 0; n < 2; ++n)
#pragma unroll
                            for (int j = 0; j < 4; ++j) { const int vc = bj * HALF + wc * 32 + n * 16 + fq * 4 + j; base[(size_t)vc * stride] = (bf16_t)f2bf(acc[ai][bj][m][n][j]); }
                }
        }
    }
};

struct EpiInProj {
    static constexpr bool WITH_LDS = false, PERM = true;
    bf16_t* R; bf16_t* GB;
    __device__ __forceinline__ void operator()(const f32x4 (&acc)[2][2][4][2], const Unit& u, int wr, int wc, int fr_, int fq_) const {
        int fr = fr_, fq = fq_; asm volatile("" : "+v"(fr), "+v"(fq));
        const bool rec = u.pn >= 5;
        const int col0 = (rec ? (u.pn - 5) * BM : 0) + wc * 32 + fq * 8; const int ldc = rec ? DRNN : 256; bf16_t* O = rec ? R : GB;
#pragma unroll
        for (int ai = 0; ai < 2; ++ai)
#pragma unroll
            for (int m = 0; m < 4; ++m) { bf16_t* rowp = O + (size_t)(u.pm * BM + ai * HALF + wr * 64 + m * 16 + fr) * ldc + col0;
#pragma unroll
                for (int bj = 0; bj < 2; ++bj) { f32x4 v0 = acc[ai][bj][m][0], v1 = acc[ai][bj][m][1];
                    if (!rec) {
#pragma unroll
                        for (int j = 0; j < 4; ++j) { const float x = v0[j]; v0[j] = x * fsigmoid(1.5957691216057308f * (x + 0.044715f * x * x * x)); const float y = v1[j]; v1[j] = y * fsigmoid(1.5957691216057308f * (y + 0.044715f * y * y * y)); } }
                    u32x4 w; w.x = cvt_pk_bf16(v0[0], v0[1]); w.y = cvt_pk_bf16(v0[2], v0[3]); w.z = cvt_pk_bf16(v1[0], v1[1]); w.w = cvt_pk_bf16(v1[2], v1[3]);
                    *(u32x4*)(rowp + bj * HALF) = w; } }
    }
};

struct EpiGates {
    static constexpr bool WITH_LDS = false, PERM = false;
    const bf16_t* U; bf16_t* LA; bf16_t* BX; const float* ba; const float* bi; const float* nls;
    __device__ __forceinline__ void operator()(const f32x4 (&acc)[2][2][4][2], const Unit& u, int wr, int wc, int fr_, int fq_) const {
        int fr = fr_, fq = fq_; asm volatile("" : "+v"(fr), "+v"(fq));
        const int tile = u.pn >> 1, dir = tile / 5, blk = tile % 5, chalf = u.pn & 1;
        const int ch0 = blk * 256 + chalf * 128 + wc * 32 + fq * 4;
#pragma unroll
        for (int n = 0; n < 2; ++n) {
            const int ch = ch0 + n * 16;
            const f32x4 bav = *(const f32x4*)(ba + dir * DRNN + ch), biv = *(const f32x4*)(bi + dir * DRNN + ch), nl = *(const f32x4*)(nls + dir * DRNN + ch);
#pragma unroll
            for (int ai = 0; ai < 2; ++ai)
#pragma unroll
                for (int m = 0; m < 4; ++m) {
                    const int rin = ai * HALF + wr * 64 + m * 16 + fr;
                    const size_t rowg = (size_t)u.pm * BM + rin, rowl = (size_t)u.po * BM + rin;
                    const f32x4 uv = bf4_to_f32(*(const u32x2*)(U + rowg * DRNN + ch));
                    f32x4 lav, bxv;
#pragma unroll
                    for (int j = 0; j < 4; ++j) {
                        const float r = fsigmoid(acc[ai][0][m][n][j] + bav[j]);
                        const float ig = fsigmoid(acc[ai][1][m][n][j] + biv[j]);
                        const float la = nl[j] * r, x = 2.0f * la;
                        float om;
                        if (x > -0.5f) { float q = 1.0f / 720.0f; q = q * x + 1.0f / 120.0f; q = q * x + 1.0f / 24.0f; q = q * x + 1.0f / 6.0f; q = q * x + 0.5f; q = q * x + 1.0f; om = -x * q; }
                        else om = 1.0f - __expf(x);
                        lav[j] = la; bxv[j] = __builtin_amdgcn_sqrtf(om) * (ig * uv[j]);
                    }
                    const size_t o = ((size_t)dir * 9216 + rowl) * DRNN + ch;
                    *(u32x2*)(LA + o) = f32_to_bf4(lav); *(u32x2*)(BX + o) = f32_to_bf4(bxv);
                    asm volatile("" ::: "memory");
                }
        }
    }
};

#define SC_STEP(d) \
    "v_fmac_f32_dpp %1, %1, %0 row_shr:" #d " row_mask:0xf bank_mask:0xf\n\t" "v_mul_f32_dpp %0, %0, %0 row_shr:" #d " row_mask:0xf bank_mask:0xf\n\t" \
    "v_fmac_f32_dpp %3, %3, %2 row_shr:" #d " row_mask:0xf bank_mask:0xf\n\t" "v_mul_f32_dpp %2, %2, %2 row_shr:" #d " row_mask:0xf bank_mask:0xf\n\t" \
    "v_fmac_f32_dpp %5, %5, %4 row_shr:" #d " row_mask:0xf bank_mask:0xf\n\t" "v_mul_f32_dpp %4, %4, %4 row_shr:" #d " row_mask:0xf bank_mask:0xf\n\t" \
    "v_fmac_f32_dpp %7, %7, %6 row_shr:" #d " row_mask:0xf bank_mask:0xf\n\t" "v_mul_f32_dpp %6, %6, %6 row_shr:" #d " row_mask:0xf bank_mask:0xf\n\t"
__device__ __forceinline__ void scan16x4(float& a0, float& b0, float& a1, float& b1, float& a2, float& b2, float& a3, float& b3) {
    asm volatile("s_nop 1\n\t" SC_STEP(1) SC_STEP(2) SC_STEP(4) SC_STEP(8)
                 : "+v"(a0), "+v"(b0), "+v"(a1), "+v"(b1), "+v"(a2), "+v"(b2), "+v"(a3), "+v"(b3));
}
struct EpiGatesScan {
    static constexpr bool WITH_LDS = true, PERM = true;
    const bf16_t* U; bf16_t* RECF; bf16_t* RECB; const float* ba; const float* bi; const float* nls; unsigned long long* CARRY;
    __device__ __forceinline__ void run(f32x4 (&acc)[2][2][4][2], const Unit& u, int wr, int wc, int lane_, LAS unsigned char* lds) const {
        int lane = lane_; asm volatile("" : "+v"(lane));
        const int fr = lane & 15, fq = lane >> 4;
        const int tile = u.pn >> 1, dir = tile / 5, blk = tile % 5, chalf = u.pn & 1;
        const int ch0 = blk * 256 + chalf * 128 + wc * 32 + fq * 8;
        const int rmask = dir ? 255 : 0;
        bf16_t* REC = dir ? RECB : RECF;
#pragma unroll
        for (int n = 0; n < 2; ++n) {
            const int ch = ch0 + n * 4;
            const f32x4 bav2 = *(const f32x4*)(ba + dir * DRNN + ch) * (-LOG2E), biv2 = *(const f32x4*)(bi + dir * DRNN + ch) * (-LOG2E), nl = *(const f32x4*)(nls + dir * DRNN + ch);
            const f32x4 nl2 = nl * LOG2E, nlx = nl * 2.0f;
#pragma unroll
            for (int ai = 0; ai < 2; ++ai)
#pragma unroll
                for (int m = 0; m < 4; ++m) {
                    const size_t rowg = (size_t)u.pm * BM + ((ai * HALF + wr * 64 + m * 16 + fr) ^ rmask);
                    const f32x4 uv = bf4_to_f32(*(const u32x2*)(U + rowg * DRNN + ch));
                    float av[4], bv[4];
#pragma unroll
                    for (int j = 0; j < 4; ++j) {
                        const float r = __builtin_amdgcn_rcpf(1.0f + __builtin_amdgcn_exp2f(acc[ai][0][m][n][j] * (-LOG2E) + bav2[j]));
                        const float ig = __builtin_amdgcn_rcpf(1.0f + __builtin_amdgcn_exp2f(acc[ai][1][m][n][j] * (-LOG2E) + biv2[j]));
                        const float x = nlx[j] * r, a = __builtin_amdgcn_exp2f(nl2[j] * r);
                        const float om = (x > -0.0625f) ? -x * (1.0f + x * (0.5f + x * (1.0f / 6.0f + x * (1.0f / 24.0f)))) : 1.0f - a * a;
                        av[j] = a; bv[j] = __builtin_amdgcn_sqrtf(om) * (ig * uv[j]);
                    }
                    scan16x4(av[0], bv[0], av[1], bv[1], av[2], bv[2], av[3], bv[3]);
#pragma unroll
                    for (int j = 0; j < 4; ++j) { acc[ai][0][m][n][j] = av[j]; acc[ai][1][m][n][j] = bv[j]; }
                    __builtin_amdgcn_sched_barrier(0);
                }
        }
        LAS f32x2* segtot = (LAS f32x2*)(lds + 133120);
        LAS float* segcarry = (LAS float*)(lds + 137216);
#pragma unroll
        for (int ai = 0; ai < 2; ++ai)
#pragma unroll
            for (int n = 0; n < 2; ++n) {
                f32x4 As = acc[ai][0][0][n], Bs = acc[ai][1][0][n];
#pragma unroll
                for (int m = 1; m < 4; ++m) { Bs = acc[ai][0][m][n] * Bs + acc[ai][1][m][n]; As = acc[ai][0][m][n] * As; }
                if (fr == 15) {
#pragma unroll
                    for (int j = 0; j < 4; ++j) segtot[(2 * ai + wr) * 128 + wc * 32 + n * 16 + fq * 4 + j] = (f32x2){As[j], Bs[j]};
                }
            }
        asm volatile("s_waitcnt lgkmcnt(0)" ::: "memory"); __builtin_amdgcn_s_barrier(); asm volatile("" ::: "memory");
        const int tid_ = threadIdx.x;
        if (tid_ < 128) {
            float h = 0.0f;
            if (u.po > 0) { unsigned long long* gp = CARRY + (size_t)(u.lin - 160) * 128 + tid_; unsigned long long v; unsigned sp = 0;
                for (;;) { v = __hip_atomic_load(gp, __ATOMIC_RELAXED, __HIP_MEMORY_SCOPE_AGENT); if ((v >> 32) != 0ull) break; __builtin_amdgcn_s_sleep(1); if (++sp > (1u << 22)) break; }
                h = __uint_as_float((unsigned)v); }
#pragma unroll
            for (int sg = 0; sg < 4; ++sg) { segcarry[sg * 128 + tid_] = h; const f32x2 t = segtot[sg * 128 + tid_]; h = t[0] * h + t[1]; }
            if (u.po < 8) __hip_atomic_store(CARRY + (size_t)u.lin * 128 + tid_, (1ull << 32) | (unsigned long long)__float_as_uint(h), __ATOMIC_RELAXED, __HIP_MEMORY_SCOPE_AGENT);
        }
        asm volatile("s_waitcnt lgkmcnt(0)" ::: "memory"); __builtin_amdgcn_s_barrier(); asm volatile("" ::: "memory");
        const bool emit = u.pm < 64;
        const int lastl = (lane & 48) | 15;
        if (emit) {
#pragma unroll
            for (int ai = 0; ai < 2; ++ai) {
                f32x4 hg[2];
#pragma unroll
                for (int n = 0; n < 2; ++n) hg[n] = *(const LAS f32x4*)(segcarry + (2 * ai + wr) * 128 + wc * 32 + n * 16 + fq * 4);
#pragma unroll
                for (int m = 0; m < 4; ++m) {
                    f32x4 h[2];
#pragma unroll
                    for (int n = 0; n < 2; ++n) h[n] = acc[ai][0][m][n] * hg[n] + acc[ai][1][m][n];
                    bf16_t* rp = REC + ((size_t)u.pm * BM + ((ai * HALF + wr * 64 + m * 16 + fr) ^ rmask)) * DRNN + ch0;
                    { u32x4 w; w.x = cvt_pk_bf16(h[0][0], h[0][1]); w.y = cvt_pk_bf16(h[0][2], h[0][3]); w.z = cvt_pk_bf16(h[1][0], h[1][1]); w.w = cvt_pk_bf16(h[1][2], h[1][3]); *(u32x4*)rp = w; }
                    if (m < 3) {
#pragma unroll
                        for (int n = 0; n < 2; ++n)
#pragma unroll
                            for (int j = 0; j < 4; ++j) hg[n][j] = __shfl(h[n][j], lastl);
                    }
                }
            }
        }
    }
};

struct EpiGateMul {
    static constexpr bool WITH_LDS = false, PERM = true;
    bf16_t* Z; const bf16_t* RB;
    __device__ __forceinline__ void operator()(const f32x4 (&acc)[2][2][4][2], const Unit& u, int wr, int wc, int fr_, int fq_) const {
        int fr = fr_, fq = fq_; asm volatile("" : "+v"(fr), "+v"(fq));
        const int col0 = u.pn * BM + wc * 32 + fq * 8;
        const size_t off0 = (size_t)(u.pm * BM + wr * 64 + fr) * DRNN + col0;
#pragma unroll
        for (int ai = 0; ai < 2; ++ai)
#pragma unroll
            for (int m = 0; m < 4; ++m) { const size_t o_ = off0 + (size_t)(ai * HALF + m * 16) * DRNN;
                u32x4 cf[2], cb[2];
#pragma unroll
                for (int bj = 0; bj < 2; ++bj) { cf[bj] = *(const u32x4*)(Z + o_ + bj * HALF); cb[bj] = *(const u32x4*)(RB + o_ + bj * HALF); }
#pragma unroll
                for (int bj = 0; bj < 2; ++bj) { const f32x4 v0 = acc[ai][bj][m][0], v1 = acc[ai][bj][m][1];
                    const f32x4 r0 = bf4_to_f32((u32x2){cf[bj].x, cf[bj].y}) + bf4_to_f32((u32x2){cb[bj].x, cb[bj].y}), r1 = bf4_to_f32((u32x2){cf[bj].z, cf[bj].w}) + bf4_to_f32((u32x2){cb[bj].z, cb[bj].w});
                    f32x4 o0, o1;
#pragma unroll
                    for (int j = 0; j < 4; ++j) { const float x = v0[j]; o0[j] = x * fsigmoid(1.5957691216057308f * (x + 0.044715f * x * x * x)) * r0[j];
                                                  const float y = v1[j]; o1[j] = y * fsigmoid(1.5957691216057308f * (y + 0.044715f * y * y * y)) * r1[j]; }
                    u32x4 w; w.x = cvt_pk_bf16(o0[0], o0[1]); w.y = cvt_pk_bf16(o0[2], o0[3]); w.z = cvt_pk_bf16(o1[0], o1[1]); w.w = cvt_pk_bf16(o1[2], o1[3]);
                    *(u32x4*)(Z + o_ + bj * HALF) = w; }
                asm volatile("" ::: "memory"); }
    }
};
}


#define XB_TMO      128
#define XB_XCNT(j)  (256  + 64 * (j))
#define XB_XSUB(j)  (1280 + 64 * (j))
#define XB_XGEN(j)  (2304 + 64 * (j))
#define XB_TOP      3328
#define XB_TOPGEN   3392
#define XCD_BAR_WORDS 3456
#define XB_SPIN_CAP (1u << 18)
__device__ __forceinline__ unsigned xb_ld(unsigned* p)              { return __hip_atomic_load(p, __ATOMIC_RELAXED, __HIP_MEMORY_SCOPE_AGENT); }
__device__ __forceinline__ unsigned xb_add(unsigned* p, unsigned v) { return __hip_atomic_fetch_add(p, v, __ATOMIC_RELAXED, __HIP_MEMORY_SCOPE_AGENT); }
__device__ __forceinline__ unsigned xb_xcc_id() { return (unsigned)__builtin_amdgcn_s_getreg((3 << 11) | 20) & 0xFu; }
#define XB_SPIN(cond, bar) do { unsigned _sp = 0; while (cond) { __builtin_amdgcn_s_sleep(1); \
    if ((++_sp & 255u) == 0u) { if (xb_ld(&(bar)[XB_TMO])) break; if (_sp > XB_SPIN_CAP) { atomicAdd(&(bar)[XB_TMO], 1u); break; } } } } while (0)
struct XcdBarrier { unsigned* bar; unsigned x; volatile LAS unsigned* st; };
__device__ __forceinline__ XcdBarrier xcd_barrier_post(unsigned* bar, volatile LAS unsigned* st) {
    XcdBarrier b; b.bar = bar; b.x = xb_xcc_id(); b.st = st;
    if (threadIdx.x == 0) (void)xb_add(&bar[XB_XCNT(b.x)], 1u);
    return b;
}
__device__ __forceinline__ void xcd_barrier_complete(unsigned* bar, unsigned x, unsigned& nloc, unsigned& nx) {
    const unsigned G = gridDim.x * gridDim.y * gridDim.z;
    unsigned sum, cnt, mine, sp = 0u;
    for (;;) {
        sum = 0u; cnt = 0u; mine = 0u;
#pragma unroll
        for (unsigned j = 0; j < 16; ++j) { const unsigned c = xb_ld(&bar[XB_XCNT(j)]); sum += c; cnt += (c > 0u) ? 1u : 0u; mine = (j == x) ? c : mine; }
        if (sum == G) break;
        __builtin_amdgcn_s_sleep(1);
        if ((++sp & 255u) == 0u) { if (xb_ld(&bar[XB_TMO])) break; if (sp > XB_SPIN_CAP) { atomicAdd(&bar[XB_TMO], 1u); break; } }
    }
    nloc = mine > 0u ? mine : 1u; nx = cnt > 0u ? cnt : 1u;
}
__device__ __forceinline__ void xcd_barrier(const XcdBarrier& b) {
    asm volatile("s_waitcnt vmcnt(0)" ::: "memory");
    __syncthreads();
    if (threadIdx.x == 0) {
        unsigned* bar = b.bar;
        __builtin_amdgcn_s_waitcnt(0);
        unsigned nloc = b.st[0], nx = b.st[1];
        if (nloc == 0u) { xcd_barrier_complete(bar, b.x, nloc, nx); b.st[0] = nloc; b.st[1] = nx; }
        const unsigned old = xb_add(&bar[XB_XSUB(b.x)], 1u);
        const unsigned gen = old / nloc;
        if (old + 1u == (gen + 1u) * nloc) {
            __builtin_amdgcn_fence(__ATOMIC_RELEASE, "agent");
            asm volatile("s_waitcnt vmcnt(0)" ::: "memory");
            const unsigned og = xb_add(&bar[XB_TOP], 1u);
            const unsigned tg = og / nx;
            if (og + 1u == (tg + 1u) * nx) xb_add(&bar[XB_TOPGEN], 1u);
            else XB_SPIN(xb_ld(&bar[XB_TOPGEN]) == tg, bar);
            __builtin_amdgcn_fence(__ATOMIC_ACQUIRE, "agent");
            xb_add(&bar[XB_XGEN(b.x)], 1u);
            asm volatile("s_waitcnt vmcnt(0)" ::: "memory");
        } else {
            XB_SPIN(xb_ld(&bar[XB_XGEN(b.x)]) == gen, bar);
            __builtin_amdgcn_fence(__ATOMIC_ACQUIRE, "agent");
            asm volatile("s_waitcnt vmcnt(0)" ::: "memory");
        }
    }
    __syncthreads();
}

struct Params {
    const float *x, *c, *ctx, *c_ctx, *ada_w, *ada_b, *norm_g, *mlp_w1, *mlp_w2, *w_qkv, *w_o, *sink;
    const float *w_in, *conv_w, *conv_b, *w_a, *b_a, *w_i, *b_i, *lam, *w_out;
    float* out; unsigned char* ws;
};

typedef const __attribute__((address_space(4))) Params* ParamsK;
__device__ __forceinline__ void transpose_item(const float* W, int ldw, bf16_t* WT, int ldwt, int k0, int n0, int dst_row0, LAS float* scr, int lane) {
#pragma unroll 8
    for (int i = 0; i < 32; ++i) { const int kk = 2 * i + (lane >> 5); scr[kk * 33 + (lane & 31)] = W[(size_t)(k0 + kk) * ldw + n0 + (lane & 31)]; }
    asm volatile("s_waitcnt lgkmcnt(0)" ::: "memory");
    const int c = lane & 7;
#pragma unroll
    for (int j = 0; j < 4; ++j) { const int n = (lane >> 3) + 8 * j; const LAS float* s = scr + (8 * c) * 33 + n;
        u32x4 o; o.x = cvt_pk_bf16(s[0 * 33], s[1 * 33]); o.y = cvt_pk_bf16(s[2 * 33], s[3 * 33]); o.z = cvt_pk_bf16(s[4 * 33], s[5 * 33]); o.w = cvt_pk_bf16(s[6 * 33], s[7 * 33]);
        *(u32x4*)(WT + (size_t)(dst_row0 + n) * ldwt + k0 + 8 * c) = o; }
    asm volatile("s_waitcnt lgkmcnt(0)" ::: "memory");
}
__device__ __forceinline__ void transpose_plain(const float* W, int K, int N, bf16_t* WT, int r, LAS float* scr, int lane) {
    const int nblk = N / 32, kb = r / nblk, nb = r % nblk;
    transpose_item(W, N, WT, K, 64 * kb, 32 * nb, 32 * nb, scr, lane);
}

constexpr int I_QKV = 16 * 48, I_O = 16 * 32, I_1 = 16 * 128, I_2 = 64 * 32, I_IN = 16 * 80, I_OUT = 20 * 32, I_G = 40 * 16;
constexpr int TR_L0 = I_QKV + I_O + I_1 + I_2, TR_LRU = I_IN + I_OUT + I_G, TR_MLP1 = I_1 + I_2;
struct TrItem { const float* W; bf16_t* WT; int ldw, ldwt, k0, n0, drow; };
__device__ __forceinline__ TrItem tr_decode(ParamsK p, unsigned char* ws, int it) {
    TrItem d; int r = it;
#define TR_PLAIN(Wp, K_, N_, WTp) do { const int nblk_ = (N_) / 32, kb_ = r / nblk_, nb_ = r % nblk_; d.W = (Wp); d.WT = (WTp); d.ldw = (N_); d.ldwt = (K_); d.k0 = 64 * kb_; d.n0 = 32 * nb_; d.drow = 32 * nb_; return d; } while (0)
    if (r < I_QKV) TR_PLAIN(p->w_qkv, 1024, NQKV, (bf16_t*)(ws + WS_WQKV)); r -= I_QKV;
    if (r < I_O) TR_PLAIN(p->w_o, 1024, 1024, (bf16_t*)(ws + WS_WO)); r -= I_O;
    if (r < I_1) TR_PLAIN(p->mlp_w1, 1024, DFF, (bf16_t*)(ws + WS_W1)); r -= I_1;
    if (r < I_2) TR_PLAIN(p->mlp_w2, DFF, 1024, (bf16_t*)(ws + WS_W2)); r -= I_2;
    if (r < I_IN) TR_PLAIN(p->w_in, 1024, 2 * DRNN, (bf16_t*)(ws + WS_WIN)); r -= I_IN;
    if (r < I_OUT) TR_PLAIN(p->w_out, DRNN, 1024, (bf16_t*)(ws + WS_WOUT)); r -= I_OUT;
    if (r < I_G) {
        const int sm = r >> 4, ii = r & 15, kb = ii >> 2, nb = ii & 3;
        const int chalf = sm & 1, blk = (sm >> 1) % 5, dg = (sm >> 1) / 5, gate = dg & 1, dir = dg >> 1;
        d.W = (gate ? p->w_i : p->w_a) + (size_t)(dir * 5 + blk) * 256 * 256; d.WT = (bf16_t*)(ws + WS_WG); d.ldw = 256; d.ldwt = 256;
        d.k0 = 64 * kb; d.n0 = chalf * 128 + nb * 32; d.drow = ((dir * 5 + blk) * 2 + chalf) * 256 + gate * 128 + nb * 32; return d; }
    r -= I_G;
    if (r < I_1) TR_PLAIN(p->mlp_w1 + (size_t)1024 * DFF, 1024, DFF, (bf16_t*)(ws + WS_W1 + 16 * MiB)); r -= I_1;
    TR_PLAIN(p->mlp_w2 + (size_t)1024 * DFF, DFF, 1024, (bf16_t*)(ws + WS_W2 + 16 * MiB));
#undef TR_PLAIN
}
__device__ __forceinline__ void transpose_range(ParamsK p, unsigned char* ws, LAS unsigned char* lds, int first, int count, int w, int nw, int wave, int lane) {
    LAS float* scr = (LAS float*)(lds + wave * 16384);
    int it = first + w; if (it >= first + count) return;
    float cur[32], nxt[32];
    TrItem d = tr_decode(p, ws, it);
#pragma unroll
    for (int i = 0; i < 32; ++i) cur[i] = d.W[(size_t)(d.k0 + 2 * i + (lane >> 5)) * d.ldw + d.n0 + (lane & 31)];
    for (;;) {
        const int itn = it + nw; const bool more = itn < first + count;
        TrItem dn = d;
        if (more) { dn = tr_decode(p, ws, itn);
#pragma unroll
            for (int i = 0; i < 32; ++i) nxt[i] = dn.W[(size_t)(dn.k0 + 2 * i + (lane >> 5)) * dn.ldw + dn.n0 + (lane & 31)]; }
#pragma unroll
        for (int i = 0; i < 32; ++i) scr[(2 * i + (lane >> 5)) * 33 + (lane & 31)] = cur[i];
        asm volatile("s_waitcnt lgkmcnt(0)" ::: "memory");
        const int c = lane & 7;
#pragma unroll
        for (int j = 0; j < 4; ++j) { const int n = (lane >> 3) + 8 * j; const LAS float* s = scr + (8 * c) * 33 + n;
            u32x4 o; o.x = cvt_pk_bf16(s[0 * 33], s[1 * 33]); o.y = cvt_pk_bf16(s[2 * 33], s[3 * 33]); o.z = cvt_pk_bf16(s[4 * 33], s[5 * 33]); o.w = cvt_pk_bf16(s[6 * 33], s[7 * 33]);
            *(u32x4*)(d.WT + (size_t)(d.drow + n) * d.ldwt + d.k0 + 8 * c) = o; }
        asm volatile("s_waitcnt lgkmcnt(0)" ::: "memory");
        if (!more) break;
#pragma unroll
        for (int i = 0; i < 32; ++i) cur[i] = nxt[i];
        d = dn; it = itn;
    }
}
__device__ __forceinline__ void idle_transposes(ParamsK p, unsigned char* ws, LAS unsigned char* lds, int first, int count, int nwg, int G, int bid, int wave, int lane) {
    const int rem = nwg % G;
    if (rem == 0) transpose_range(p, ws, lds, first, count, bid * 8 + wave, G * 8, wave, lane);
    else if (bid >= rem) transpose_range(p, ws, lds, first, count, (bid - rem) * 8 + wave, (G - rem) * 8, wave, lane);
    __syncthreads();
}

__device__ __forceinline__ void prologue(ParamsK p, LAS unsigned char* lds, int tid, int lane, int wave) {
    unsigned char* ws = p->ws;
    float* MOD = (float*)(ws + WS_MOD);
    if (blockIdx.x < 192) {
        LAS float* sl = (LAS float*)lds;
        LAS float* red = (LAS float*)(lds + 36864);
        for (int idx = tid; idx < 9216; idx += 512) { const int w = idx >> 10, k = idx & 1023; const float v = (w < 8) ? p->c[w * 1024 + k] : p->c_ctx[k]; sl[idx] = v / (1.0f + __expf(-v)); }
        __syncthreads();
        const int l = blockIdx.x / 96, n0 = (blockIdx.x % 96) * 64, kg = tid >> 4, cq = tid & 15;
        f32x4 acc[9];
#pragma unroll
        for (int w = 0; w < 9; ++w) acc[w] = (f32x4){0.f, 0.f, 0.f, 0.f};
        const float* wb = p->ada_w + (size_t)l * 1024 * 6144 + n0 + cq * 4;
#pragma unroll 1
        for (int it0 = 0; it0 < 32; it0 += 8) {
            f32x4 w4[8];
#pragma unroll
            for (int u = 0; u < 8; ++u) w4[u] = *(const f32x4*)(wb + (size_t)((it0 + u) * 32 + kg) * 6144);
#pragma unroll
            for (int u = 0; u < 8; ++u) { const int k = (it0 + u) * 32 + kg;
#pragma unroll
                for (int w = 0; w < 9; ++w) acc[w] += sl[w * 1024 + k] * w4[u]; }
        }
#pragma unroll
        for (int w = 0; w < 9; ++w) *(LAS f32x4*)(red + (kg * 9 + w) * 64 + cq * 4) = acc[w];
        __syncthreads();
        for (int idx = tid; idx < 9 * 64; idx += 512) { const int w = idx >> 6, n = idx & 63; float s = 0.f;
#pragma unroll
            for (int g = 0; g < 32; ++g) s += red[(g * 9 + w) * 64 + n];
            MOD[(size_t)(l * 9 + w) * 6144 + n0 + n] = s + p->ada_b[l * 6144 + n0 + n]; }
        __syncthreads();
    }
    if (blockIdx.x == gridDim.x - 1) {
        float* rope = (float*)(ws + WS_ROPE); float* nls = (float*)(ws + WS_NLS);
        for (int idx = tid; idx < 1024; idx += 512) { const int pos = idx >> 4, i = idx & 15;
            const float inv = __builtin_exp2f(-(float)i * (13.287712379549449f / 16.0f));
            const float angf = (float)pos * inv; const double ang = (double)angf;
            const double twopi = 6.283185307179586476925287; const double r = ang - twopi * __builtin_rint(ang / twopi);
            const double r2 = r * r; double cterm = 1.0, sterm = r, cs = 1.0, sn = r;
            for (int k = 1; k <= 14; ++k) { cterm *= -r2 / (double)((2 * k - 1) * (2 * k)); sterm *= -r2 / (double)((2 * k) * (2 * k + 1)); cs += cterm; sn += sterm; }
            rope[idx * 2] = (float)cs; rope[idx * 2 + 1] = (float)sn; }
        for (int idx = tid; idx < 2 * DRNN; idx += 512) { const float lm = p->lam[idx]; nls[idx] = -8.0f * log1pf(__expf(-lm)); }
        { unsigned* fl = (unsigned*)(ws + WS_FLAG); for (int idx = tid; idx < 1440 * 16; idx += 512) fl[idx] = 0u; }
        if (tid == 0) *(unsigned*)(ws + WS_CNT) = 0u;
    }
    transpose_range(p, ws, lds, 0, TR_L0 + TR_LRU + TR_MLP1, blockIdx.x * 8 + wave, gridDim.x * 8, wave, lane);
}

template <bool HAS_Y, bool HAS_H, bool XIN_BF, bool XOUT_BF>
__device__ __forceinline__ void row_phase(const void* xin_lat, const void* xin_ctx, void* xout_lat, void* xout_ctx, const bf16_t* Y, const bf16_t* SLAB, bf16_t* H,
                                          const float* gy, const float* gh, const float* mod_g, int gate_idx, const float* mod_h, int shift_idx, int scale_idx,
                                          int nrows, int gw, int ngw, int lane) {
    const int rpw = (nrows + ngw - 1) / ngw, r_begin = gw * rpw, r_end = (r_begin + rpw < nrows) ? r_begin + rpw : nrows;
#define RCOL(k) (((k) >> 1) * 512 + lane * 8 + ((k) & 1) * 4)
#define BF8_LO(V_) bf4_to_f32((u32x2){(V_).x, (V_).y})
#define BF8_HI(V_) bf4_to_f32((u32x2){(V_).z, (V_).w})
    f32x4 xn[4]; u32x4 xb[2], yn[2], ys[3][2];
    f32x4 vgy[4], vgh[4], vgt[4], vsh[4], vsc[4];
#pragma unroll
    for (int k = 0; k < 4; ++k) { if (HAS_Y) vgy[k] = *(const f32x4*)(gy + RCOL(k)); if (HAS_H) vgh[k] = *(const f32x4*)(gh + RCOL(k)); }
    int cur_who = -1;
#define ROW_LOAD(r) do { const int r_ = (r); const bool lat_ = r_ < ML; const size_t ro_ = lat_ ? (size_t)r_ * DM : (size_t)(r_ - ML) * DM; \
        if (XIN_BF) { const bf16_t* xi_ = (const bf16_t*)(lat_ ? xin_lat : xin_ctx) + ro_; _Pragma("unroll") for (int j = 0; j < 2; ++j) xb[j] = *(const u32x4*)(xi_ + j * 512 + lane * 8); } \
        else { const float* xi_ = (const float*)(lat_ ? xin_lat : xin_ctx) + ro_; _Pragma("unroll") for (int k = 0; k < 4; ++k) xn[k] = *(const f32x4*)(xi_ + RCOL(k)); } \
        if (HAS_Y) { if (SLAB != nullptr && !lat_) { const bf16_t* yp_ = SLAB + (size_t)(r_ - ML) * DM + lane * 8; \
                _Pragma("unroll") for (int j = 0; j < 2; ++j) { yn[j] = *(const u32x4*)(yp_ + 512 * j); ys[0][j] = *(const u32x4*)(yp_ + 512 * j + (size_t)MC * DM); ys[1][j] = *(const u32x4*)(yp_ + 512 * j + (size_t)2 * MC * DM); ys[2][j] = *(const u32x4*)(yp_ + 512 * j + (size_t)3 * MC * DM); } } \
            else { _Pragma("unroll") for (int j = 0; j < 2; ++j) yn[j] = *(const u32x4*)(Y + (size_t)r_ * DM + j * 512 + lane * 8); } } } while (0)
    if (r_begin < r_end) ROW_LOAD(r_begin);
    for (int row = r_begin; row < r_end; ++row) {
        const bool lat = row < ML; const int who = lat ? (row >> 11) : 8;
        if (who != cur_who) { cur_who = who;
#pragma unroll
            for (int k = 0; k < 4; ++k) { const int col = RCOL(k);
                if (HAS_Y) vgt[k] = *(const f32x4*)(mod_g + (size_t)who * 6144 + gate_idx * 1024 + col);
                if (HAS_H) { vsh[k] = *(const f32x4*)(mod_h + (size_t)who * 6144 + shift_idx * 1024 + col); vsc[k] = *(const f32x4*)(mod_h + (size_t)who * 6144 + scale_idx * 1024 + col) + 1.0f; } } }
        f32x4 xv[4], yv[4];
#pragma unroll
        for (int j = 0; j < 2; ++j) { xv[2 * j] = XIN_BF ? BF8_LO(xb[j]) : xn[2 * j]; xv[2 * j + 1] = XIN_BF ? BF8_HI(xb[j]) : xn[2 * j + 1]; }
        if (HAS_Y) {
#pragma unroll
            for (int j = 0; j < 2; ++j) { yv[2 * j] = BF8_LO(yn[j]); yv[2 * j + 1] = BF8_HI(yn[j]);
                if (SLAB != nullptr && !lat) { yv[2 * j] = (yv[2 * j] + BF8_LO(ys[0][j])) + (BF8_LO(ys[1][j]) + BF8_LO(ys[2][j])); yv[2 * j + 1] = (yv[2 * j + 1] + BF8_HI(ys[0][j])) + (BF8_HI(ys[1][j]) + BF8_HI(ys[2][j])); } }
        }
        asm volatile("" ::: "memory");
        if (row + 1 < r_end) ROW_LOAD(row + 1);
        if (HAS_Y) {
            float s = 0.f;
#pragma unroll
            for (int k = 0; k < 4; ++k) s += (yv[k][0] * yv[k][0] + yv[k][1] * yv[k][1]) + (yv[k][2] * yv[k][2] + yv[k][3] * yv[k][3]);
            const float rstd = 1.0f / sqrtf(wave_sum(s) * (1.0f / DM) + EPS);
            const size_t ro = lat ? (size_t)row * DM : (size_t)(row - ML) * DM;
#pragma unroll
            for (int k = 0; k < 4; ++k) xv[k] = xv[k] + vgt[k] * (yv[k] * rstd * vgy[k]);
            if (XOUT_BF) {
#pragma unroll
                for (int j = 0; j < 2; ++j) { u32x4 w; w.x = cvt_pk_bf16(xv[2 * j][0], xv[2 * j][1]); w.y = cvt_pk_bf16(xv[2 * j][2], xv[2 * j][3]); w.z = cvt_pk_bf16(xv[2 * j + 1][0], xv[2 * j + 1][1]); w.w = cvt_pk_bf16(xv[2 * j + 1][2], xv[2 * j + 1][3]);
                    *(u32x4*)((bf16_t*)(lat ? xout_lat : xout_ctx) + ro + j * 512 + lane * 8) = w; xv[2 * j] = BF8_LO(w); xv[2 * j + 1] = BF8_HI(w); }
            } else {
#pragma unroll
                for (int k = 0; k < 4; ++k) *(f32x4*)((float*)(lat ? xout_lat : xout_ctx) + ro + RCOL(k)) = xv[k];
            }
        }
        if (HAS_H) {
            float s = 0.f;
#pragma unroll
            for (int k = 0; k < 4; ++k) s += (xv[k][0] * xv[k][0] + xv[k][1] * xv[k][1]) + (xv[k][2] * xv[k][2] + xv[k][3] * xv[k][3]);
            const float rstd = 1.0f / sqrtf(wave_sum(s) * (1.0f / DM) + EPS);
#pragma unroll
            for (int j = 0; j < 2; ++j) { const f32x4 h0 = (xv[2 * j] * rstd * vgh[2 * j]) * vsc[2 * j] + vsh[2 * j], h1 = (xv[2 * j + 1] * rstd * vgh[2 * j + 1]) * vsc[2 * j + 1] + vsh[2 * j + 1];
                u32x4 w; w.x = cvt_pk_bf16(h0[0], h0[1]); w.y = cvt_pk_bf16(h0[2], h0[3]); w.z = cvt_pk_bf16(h1[0], h1[1]); w.w = cvt_pk_bf16(h1[2], h1[3]);
                *(u32x4*)(H + (size_t)row * DM + j * 512 + lane * 8) = w; }
        }
    }
#undef ROW_LOAD
#undef RCOL
#undef BF8_LO
#undef BF8_HI
}

__device__ __forceinline__ void attn_phase(LAS unsigned char* lds, const bf16_t* Q, bf16_t* O, const bf16_t* Kb, const bf16_t* VT, const bf16_t* VTC, const float* sink, int tid, int lane, int wave) {
    constexpr int PITCH = 72;
    LAS bf16_t* Ks = (LAS bf16_t*)lds;
    LAS bf16_t* Vs = (LAS bf16_t*)(lds + 2 * 64 * PITCH * 2);
    const int lr = lane & 15, lg = lane >> 4;
    const int skey = tid >> 3, spiece = tid & 7;
    for (int unit = blockIdx.x; unit < 576; unit += gridDim.x) {
        int b, kvh, qrow0, qblk, nloc, lt0; bool latu = unit < 512;
        if (latu) { b = unit >> 6; const int rem = unit & 63; qblk = rem >> 2; kvh = rem & 3; qrow0 = b * SEQ + qblk * 128; lt0 = (qblk == 0) ? 2 : 0; nloc = ((qblk == 15) ? 4 : 6) - lt0; }
        else { const int cu = unit - 512; b = cu >> 3; kvh = (cu & 7) >> 1; qblk = 0; qrow0 = ML + b * CTX + (cu & 1) * 128; lt0 = 0; nloc = 0; }
        const int nlo = (latu && qblk > 0) ? 2 : 0, nmid = latu ? 2 : 0, nup = (latu && qblk < 15) ? 2 : 0;
        const int n1 = nlo, n2 = nlo + nmid, n3 = n2 + 4, nT = n3 + nup; (void)nloc; (void)lt0;
        const int head = kvh * 4 + (wave >> 1);
        const int qr0 = qrow0 + (wave & 1) * 64;
        const bf16_t* qbase = Q + (size_t)qr0 * 1024 + head * 64;
        bf16_t* obase = O + (size_t)qr0 * 1024 + head * 64;
        LAS unsigned char* Qs = lds + 40960 + wave * 8192;
#pragma unroll
        for (int qt = 0; qt < 4; ++qt)
#pragma unroll
            for (int dh = 0; dh < 2; ++dh) *(LAS bf16x8*)(Qs + (qt * 2 + dh) * 1024 + lane * 16) = *(const bf16x8*)(qbase + (unsigned)((qt * 16 + lr) * 1024 + dh * 32 + lg * 8));
        f32x4 o[4][4];
#pragma unroll
        for (int qt = 0; qt < 4; ++qt)
#pragma unroll
            for (int dt = 0; dt < 4; ++dt) o[qt][dt] = (f32x4){0.f, 0.f, 0.f, 0.f};
        float m2[4], ls[4];
        { const float sk = sink[head] * LOG2E;
#pragma unroll
          for (int qt = 0; qt < 4; ++qt) { m2[qt] = sk; ls[qt] = (lg == 0) ? 1.0f : 0.0f; } }
        u32x4 kreg, vreg;
#define ATT_TOK0(j_) ((qblk - 1) * 128 + (((j_) < n1) ? (j_) : (((j_) < n2) ? 2 + (j_) - n1 : 4 + (j_) - n3)) * 64)
#define ATT_LOAD(j) do { const int _j = (j); if (_j < n2 || _j >= n3) { const int tok0 = ATT_TOK0(_j); \
                const bf16_t* kb_ = Kb + (size_t)(b * SEQ + tok0) * 256 + kvh * 64; const bf16_t* vb_ = VT + (size_t)(b * 4 + kvh) * 64 * SEQ + tok0; \
                kreg = *(const u32x4*)(kb_ + (unsigned)(skey * 256 + spiece * 8)); vreg = *(const u32x4*)(vb_ + (unsigned)(skey * SEQ + spiece * 8)); } \
            else { const int tok0 = (_j - n2) * 64; \
                const bf16_t* kb_ = Kb + (size_t)(ML + b * CTX + tok0) * 256 + kvh * 64; const bf16_t* vb_ = VTC + (size_t)(b * 4 + kvh) * 64 * CTX + tok0; \
                kreg = *(const u32x4*)(kb_ + (unsigned)(skey * 256 + spiece * 8)); vreg = *(const u32x4*)(vb_ + (unsigned)(skey * CTX + spiece * 8)); } } while (0)
#define ATT_STORE(buf) do { *(LAS u32x4*)(Ks + (buf) * 64 * PITCH + skey * PITCH + spiece * 8) = kreg; *(LAS u32x4*)(Vs + (buf) * 64 * PITCH + skey * PITCH + spiece * 8) = vreg; } while (0)
        __syncthreads();
        ATT_LOAD(0); ATT_STORE(0);
        __syncthreads();
#define ATT_BODY(MM) { \
            const int buf = j & 1; \
            if (j + 1 < nT) ATT_LOAD(j + 1); \
            const LAS bf16_t* Kt = Ks + buf * 64 * PITCH; const LAS bf16_t* Vt = Vs + buf * 64 * PITCH; \
            const int ktok0 = ATT_TOK0(j); \
            bf16x8 kf[4][2]; \
            _Pragma("unroll") \
            for (int ks = 0; ks < 4; ++ks) \
            _Pragma("unroll") \
                for (int dh = 0; dh < 2; ++dh) kf[ks][dh] = *(const LAS bf16x8*)(Kt + (ks * 16 + lr) * PITCH + dh * 32 + lg * 8); \
            _Pragma("unroll") \
            for (int hq = 0; hq < 2; ++hq) { \
            bf16x8 pb[2][2]; \
            _Pragma("unroll") \
            for (int q2 = 0; q2 < 2; ++q2) { \
                const int qt = hq * 2 + q2; \
                f32x4 s[4]; \
                const bf16x8 qf0 = *(const LAS bf16x8*)(Qs + (qt * 2 + 0) * 1024 + lane * 16), qf1 = *(const LAS bf16x8*)(Qs + (qt * 2 + 1) * 1024 + lane * 16); \
            _Pragma("unroll") \
                for (int ks = 0; ks < 4; ++ks) { s[ks] = __builtin_amdgcn_mfma_f32_16x16x32_bf16(kf[ks][0], qf0, (f32x4){0.f, 0.f, 0.f, 0.f}, 0, 0, 0); \
                    s[ks] = __builtin_amdgcn_mfma_f32_16x16x32_bf16(kf[ks][1], qf1, s[ks], 0, 0, 0); } \
                if (MM == 1) {    \
                    const int lim = qblk * 128 + (wave & 1) * 64 + qt * 16 + lr - 128 - ktok0 - lg * 4; \
            _Pragma("unroll") \
                    for (int ks = 0; ks < 4; ++ks) \
            _Pragma("unroll") \
                        for (int jj = 0; jj < 4; ++jj) s[ks][jj] = (ks * 16 + jj >= lim) ? s[ks][jj] : -1e30f; \
                } else if (MM == 2) {    \
                    const int lim = qblk * 128 + (wave & 1) * 64 + qt * 16 + lr + 128 - ktok0 - lg * 4; \
            _Pragma("unroll") \
                    for (int ks = 0; ks < 4; ++ks) \
            _Pragma("unroll") \
                        for (int jj = 0; jj < 4; ++jj) s[ks][jj] = (ks * 16 + jj <= lim) ? s[ks][jj] : -1e30f; \
                } \
                float mx = -3e38f; \
            _Pragma("unroll") \
                for (int ks = 0; ks < 4; ++ks) mx = fmaxf(mx, fmaxf(fmaxf(s[ks][0], s[ks][1]), fmaxf(s[ks][2], s[ks][3]))); \
                mx = fmaxf(mx, __shfl_xor(mx, 16)); mx = fmaxf(mx, __shfl_xor(mx, 32)); \
                const float mnew = fmaxf(m2[qt], mx * LOG2E); \
                const float alpha = __builtin_amdgcn_exp2f(m2[qt] - mnew); \
                m2[qt] = mnew; \
                float rs = 0.f; \
            _Pragma("unroll") \
                for (int ks = 0; ks < 4; ++ks) \
            _Pragma("unroll") \
                    for (int jj = 0; jj < 4; ++jj) { const float pv = __builtin_amdgcn_exp2f(s[ks][jj] * LOG2E - mnew); s[ks][jj] = pv; rs += pv; } \
                ls[qt] = ls[qt] * alpha + rs; \
            _Pragma("unroll") \
                for (int dt = 0; dt < 4; ++dt) o[qt][dt] = o[qt][dt] * alpha; \
            _Pragma("unroll") \
                for (int c2 = 0; c2 < 2; ++c2) { u32x4 w; w.x = cvt_pk_bf16(s[2 * c2][0], s[2 * c2][1]); w.y = cvt_pk_bf16(s[2 * c2][2], s[2 * c2][3]); w.z = cvt_pk_bf16(s[2 * c2 + 1][0], s[2 * c2 + 1][1]); w.w = cvt_pk_bf16(s[2 * c2 + 1][2], s[2 * c2 + 1][3]); \
                    pb[q2][c2] = __builtin_bit_cast(bf16x8, w); } \
            } \
            _Pragma("unroll") \
            for (int c2 = 0; c2 < 2; ++c2) \
            _Pragma("unroll") \
                for (int dt = 0; dt < 4; ++dt) { \
                    const LAS bf16_t* vp = Vt + (dt * 16 + lr) * PITCH + c2 * 32 + lg * 4; \
                    const u32x2 v0 = *(const LAS u32x2*)vp, v1 = *(const LAS u32x2*)(vp + 16); \
                    const u32x4 vv = {v0.x, v0.y, v1.x, v1.y}; \
                    const bf16x8 vf = __builtin_bit_cast(bf16x8, vv); \
            _Pragma("unroll") \
                    for (int q2 = 0; q2 < 2; ++q2) o[hq * 2 + q2][dt] = __builtin_amdgcn_mfma_f32_16x16x32_bf16(vf, pb[q2][c2], o[hq * 2 + q2][dt], 0, 0, 0); \
                } \
            } \
            if (j + 1 < nT) ATT_STORE(buf ^ 1); \
            __syncthreads(); \
        }
        int j = 0;
#pragma unroll 1
        for (; j < n1; ++j) ATT_BODY(1)
#pragma unroll 1
        for (; j < n3; ++j) ATT_BODY(0)
#pragma unroll 1
        for (; j < nT; ++j) ATT_BODY(2)
#undef ATT_BODY
#pragma unroll
        for (int qt = 0; qt < 4; ++qt) {
            float l = ls[qt]; l += __shfl_xor(l, 16); l += __shfl_xor(l, 32);
            const float inv = 1.0f / l;
            int lro = lr * 1024 + lg * 4; asm volatile("" : "+v"(lro));
            bf16_t* op = obase + (unsigned)(qt * 16 * 1024 + lro);
#pragma unroll
            for (int dt = 0; dt < 4; ++dt) *(u32x2*)(op + dt * 16) = f32_to_bf4(o[qt][dt] * inv);
        }
    }
#undef ATT_LOAD
#undef ATT_TOK0
#undef ATT_STORE
}

__device__ __forceinline__ void conv_phase(const bf16_t* R, bf16_t* U, const float* cw, const float* cb, int gtid, int nthreads) {
    for (int idx = gtid; idx < MT * 160; idx += nthreads) {
        const int row = idx / 160, ch = (idx % 160) * 8;
        int t, T; if (row < ML) { t = row & 2047; T = SEQ; } else { t = (row - ML) & 255; T = CTX; }
        float acc[8];
        { const f32x4 b0 = *(const f32x4*)(cb + ch), b1 = *(const f32x4*)(cb + ch + 4); acc[0] = b0[0]; acc[1] = b0[1]; acc[2] = b0[2]; acc[3] = b0[3]; acc[4] = b1[0]; acc[5] = b1[1]; acc[6] = b1[2]; acc[7] = b1[3]; }
#pragma unroll
        for (int tap = 0; tap < 4; ++tap) { const int tt = t + tap - 2;
            if (tt >= 0 && tt < T) { const u32x4 rv = *(const u32x4*)(R + (size_t)(row + tap - 2) * DRNN + ch);
                const f32x4 w0 = *(const f32x4*)(cw + tap * DRNN + ch), w1 = *(const f32x4*)(cw + tap * DRNN + ch + 4);
                acc[0] += w0[0] * bf_lo(rv.x); acc[1] += w0[1] * bf_hi(rv.x); acc[2] += w0[2] * bf_lo(rv.y); acc[3] += w0[3] * bf_hi(rv.y);
                acc[4] += w1[0] * bf_lo(rv.z); acc[5] += w1[1] * bf_hi(rv.z); acc[6] += w1[2] * bf_lo(rv.w); acc[7] += w1[3] * bf_hi(rv.w); } }
        u32x4 o; o.x = cvt_pk_bf16(acc[0], acc[1]); o.y = cvt_pk_bf16(acc[2], acc[3]); o.z = cvt_pk_bf16(acc[4], acc[5]); o.w = cvt_pk_bf16(acc[6], acc[7]);
        *(u32x4*)(U + (size_t)row * DRNN + ch) = o;
    }
}
__device__ __forceinline__ int scan_row0(int bl, int c) { return (c < 8) ? (8192 + bl * CTX + c * 32) : (bl * SEQ + (c - 8) * 32); }
__device__ __forceinline__ void scanA_phase(const bf16_t* LA, const bf16_t* BX, float* SP, float* SH, int gtid, int nthreads) {
    for (int idx = gtid; idx < 2 * 4 * 72 * 640; idx += nthreads) {
        const int cp = idx % 640, r1 = idx / 640, c = r1 % 72, r2 = r1 / 72, bl = r2 & 3, dir = r2 >> 2;
        const int row0 = scan_row0(bl, c);
        const size_t base = ((size_t)dir * 9216 + row0) * DRNN + cp * 2;
        float P0 = 1.f, P1 = 1.f, H0 = 0.f, H1 = 0.f;
#pragma unroll 8
        for (int i = 0; i < 32; ++i) { const int ii = dir ? (31 - i) : i;
            const unsigned lw = *(const unsigned*)(LA + base + (size_t)ii * DRNN), bw = *(const unsigned*)(BX + base + (size_t)ii * DRNN);
            const float a0 = __expf(bf_lo(lw)), a1 = __expf(bf_hi(lw));
            P0 *= a0; P1 *= a1; H0 = a0 * H0 + bf_lo(bw); H1 = a1 * H1 + bf_hi(bw); }
        const size_t so = ((size_t)(dir * 4 + bl) * 72 + c) * DRNN + cp * 2;
        *(f32x2*)(SP + so) = (f32x2){P0, P1}; *(f32x2*)(SH + so) = (f32x2){H0, H1};
    }
}
__device__ __forceinline__ void scanB_phase(const float* SP, const float* SH, float* CIN, int gtid, int nthreads) {
    for (int idx = gtid; idx < 2 * 4 * DRNN; idx += nthreads) {
        const int ch = idx % DRNN, r = idx / DRNN, bl = r & 3, dir = r >> 2;
        const size_t base = ((size_t)(dir * 4 + bl) * 72) * DRNN + ch;
        float carry = 0.f;
#pragma unroll 1
        for (int s0 = 0; s0 < 72; s0 += 24) {
            float pv[24], hv[24];
#pragma unroll
            for (int s = 0; s < 24; ++s) { const int sq = s0 + s; const int c = dir ? (sq < 8 ? 7 - sq : 79 - sq) : sq; pv[s] = SP[base + (size_t)c * DRNN]; hv[s] = SH[base + (size_t)c * DRNN]; }
#pragma unroll
            for (int s = 0; s < 24; ++s) { const int sq = s0 + s; const int c = dir ? (sq < 8 ? 7 - sq : 79 - sq) : sq; CIN[base + (size_t)c * DRNN] = carry; carry = pv[s] * carry + hv[s]; }
        }
    }
}
__device__ __forceinline__ void scanC_phase(const bf16_t* LA, const bf16_t* BX, const float* CIN, bf16_t* REC, int half, int gtid, int nthreads) {
    for (int idx = gtid; idx < 4 * 64 * 640; idx += nthreads) {
        const int cp = idx % 640, r1 = idx / 640, lc = r1 & 63, bl = r1 >> 6;
        const int row0 = bl * SEQ + lc * 32;
        const size_t b0 = ((size_t)row0) * DRNN + cp * 2, b1 = ((size_t)9216 + row0) * DRNN + cp * 2;
        const f32x2 cf = *(const f32x2*)(CIN + ((size_t)(0 * 4 + bl) * 72 + 8 + lc) * DRNN + cp * 2);
        const f32x2 cbk = *(const f32x2*)(CIN + ((size_t)(1 * 4 + bl) * 72 + 8 + lc) * DRNN + cp * 2);
        float hf0[32], hf1[32];
        float h0 = cf[0], h1 = cf[1];
#pragma unroll
        for (int i = 0; i < 32; ++i) { const unsigned lw = *(const unsigned*)(LA + b0 + (size_t)i * DRNN), bw = *(const unsigned*)(BX + b0 + (size_t)i * DRNN);
            h0 = __expf(bf_lo(lw)) * h0 + bf_lo(bw); h1 = __expf(bf_hi(lw)) * h1 + bf_hi(bw); hf0[i] = h0; hf1[i] = h1; }
        h0 = cbk[0]; h1 = cbk[1];
        bf16_t* out = REC + ((size_t)(half * 4 + bl) * SEQ + lc * 32) * DRNN + cp * 2;
#pragma unroll
        for (int i = 31; i >= 0; --i) { const unsigned lw = *(const unsigned*)(LA + b1 + (size_t)i * DRNN), bw = *(const unsigned*)(BX + b1 + (size_t)i * DRNN);
            h0 = __expf(bf_lo(lw)) * h0 + bf_lo(bw); h1 = __expf(bf_hi(lw)) * h1 + bf_hi(bw);
            *(unsigned*)(out + (size_t)i * DRNN) = cvt_pk_bf16(hf0[i] + h0, hf1[i] + h1); }
    }
}

#ifndef PH_MASK
#define PH_MASK 0xFFFFFFFFu
#endif
#define PH(k) ((PH_MASK >> (k)) & 1u)
#ifndef REP_MASK
#define REP_MASK 0u
#endif
#define REP_BEGIN(k) _Pragma("unroll 1") for (int rep_ = 0; rep_ < (((REP_MASK >> (k)) & 1u) ? 2 : 1); ++rep_) {
#define REP_END }
__device__ __forceinline__ ParamsK kparams() { ParamsK q = (ParamsK)__builtin_amdgcn_kernarg_segment_ptr(); asm volatile("" : "+s"(q)); return q; }
#define PHASE_BEGIN ParamsK kp = kparams(); unsigned char* ws = kp->ws; (void)ws; \
    int tid = threadIdx.x; asm volatile("" : "+v"(tid)); const int lane = tid & 63, wave = __builtin_amdgcn_readfirstlane(tid >> 6); \
    const int gw = bid * 8 + wave, gtid = bid * 512 + tid; (void)lane; (void)gw; (void)gtid;
#define P_MOD0 ((float*)(ws + WS_MOD))
#define P_MOD1 ((float*)(ws + WS_MOD) + 9 * 6144)
#define P_CTXRES ((float*)(ws + WS_CTXRES))
#define P_H ((bf16_t*)(ws + WS_H))
#define P_SLAB ((bf16_t*)(ws + WS_SLAB))
#define P_Q ((bf16_t*)(ws + WS_Q))
#define P_O ((bf16_t*)(ws + WS_O))
#define P_K ((bf16_t*)(ws + WS_K))
#define P_VT ((bf16_t*)(ws + WS_VT))
#define P_VTC ((bf16_t*)(ws + WS_VTC))
#define P_ACT ((bf16_t*)(ws + WS_ACT))
#define P_U ((bf16_t*)(ws + WS_U))
#define P_RECF ((bf16_t*)(ws + WS_RECF))
#define P_RECB ((bf16_t*)(ws + WS_RECB))
#define P_LA ((bf16_t*)(ws + WS_LA))
#define P_BX ((bf16_t*)(ws + WS_BX))
#define P_RPRE ((bf16_t*)(ws + WS_RPRE))
#define P_SP ((float*)(ws + WS_SP))
#define P_SH ((float*)(ws + WS_SH))
#define P_CIN ((float*)(ws + WS_CIN))
#define G0 (kp->norm_g)
#define G1 (kp->norm_g + 4 * DM)

__global__ void __launch_bounds__(512, 2) fwd_megakernel(Params p) {
    extern __shared__ __attribute__((aligned(16))) unsigned char lds_raw[];
    LAS unsigned char* lds = (LAS unsigned char*)lds_raw;
    const int G = gridDim.x, bid = blockIdx.x;
    const int ngw = G * 8, nthreads = G * 512;
    using namespace pg8;
    if (threadIdx.x < 4) ((volatile LAS unsigned*)(lds + 132096))[threadIdx.x] = 0u;
    __syncthreads();
    XcdBarrier xbar = xcd_barrier_post((unsigned*)(p.ws + WS_BAR), (volatile LAS unsigned*)(lds + 132096));
    if (PH(0)) { PHASE_BEGIN prologue(kp, lds, tid, lane, wave); }
    xcd_barrier(xbar);
#ifdef EXTRA_SYNCS
#pragma unroll 1
    for (int es = 0; es < EXTRA_SYNCS; ++es) xcd_barrier(xbar);
#endif
    REP_BEGIN(1)
    if (PH(1)) { PHASE_BEGIN row_phase<false, true, false, false>(kp->x, kp->ctx, nullptr, nullptr, nullptr, nullptr, P_H, nullptr, G0, nullptr, 0, P_MOD0, 0, 1, MT, gw, ngw, lane); }
    xcd_barrier(xbar);
    REP_END
    if (PH(2)) {
        PHASE_BEGIN
        Gemm g{P_H, (const bf16_t*)(ws + WS_WQKV), DM, DM, DM}; Sched S; S.init(MT / 256, NQKV / 256, G, bid);
        EpiQKV E{P_Q, P_K, P_VT, P_VTC, (const float*)(ws + WS_ROPE)};
        gemm_phase<EpiQKV, true, true>(lds, g, S, E);
    }
    xcd_barrier(xbar);
    REP_BEGIN(3)
    if (PH(3)) { PHASE_BEGIN attn_phase(lds, P_Q, P_O, P_K, P_VT, P_VTC, kp->sink, tid, lane, wave); }
    xcd_barrier(xbar);
    REP_END
    if (PH(4)) {
        PHASE_BEGIN
        { Gemm g{P_O, (const bf16_t*)(ws + WS_WO), DM, DM, DM}; Sched S; S.init(ML / 256, DM / 256, G, bid);
          EpiPlain<0> E{P_H, DM};
          gemm_phase<EpiPlain<0>, true, true>(lds, g, S, E); }
        { Gemm g{P_O, (const bf16_t*)(ws + WS_WO), DM, DM, 256}; Sched S; S.init(8, 4 * 4, G, bid, 2, 256);
          EpiSlabCtx E{P_SLAB, 256};
          gemm_phase<EpiSlabCtx, true, true>(lds, g, S, E); }
    }
    xcd_barrier(xbar);
    if (PH(5)) { PHASE_BEGIN row_phase<true, true, false, true>(kp->x, kp->ctx, kp->out, P_CTXRES, P_H, P_SLAB, P_H, G0 + DM, G0 + 2 * DM, P_MOD0, 2, P_MOD0, 3, 4, MT, gw, ngw, lane); }
    xcd_barrier(xbar);
    if (PH(6)) {
        PHASE_BEGIN
        unsigned* cnt = (unsigned*)(ws + WS_CNT);
        { Gemm g{P_H, (const bf16_t*)(ws + WS_W1), DM, DM, DM}; Sched S; S.init(ML / 256, DFF / 256, G, bid, 5, 0);
          EpiPlain<1> E{P_ACT, DFF, cnt};
          gemm_phase<EpiPlain<1>, true, true>(lds, g, S, E); }
        const int rem = (128 + (ML / 256) * (DFF / 256)) % G;
        if (rem != 0 && bid >= rem) {
            if (threadIdx.x == 0) { unsigned sp = 0; while (__hip_atomic_load(cnt, __ATOMIC_RELAXED, __HIP_MEMORY_SCOPE_AGENT) < 128u) { __builtin_amdgcn_s_sleep(4); if (++sp > (1u << 22)) break; }
                __builtin_amdgcn_fence(__ATOMIC_ACQUIRE, "agent"); asm volatile("s_waitcnt vmcnt(0)" ::: "memory"); }
            __syncthreads();
            Gemm g{P_ACT, (const bf16_t*)(ws + WS_W2), DFF, DFF, 1024}; Sched S; S.init(8, 4 * 4, G - rem, bid - rem, 2, 1024);
            EpiSlabCtx E{P_SLAB, 1024};
            gemm_phase<EpiSlabCtx, true, true>(lds, g, S, E);
        }
    }
    xcd_barrier(xbar);
    if (PH(7)) {
        PHASE_BEGIN
        { Gemm g{P_ACT, (const bf16_t*)(ws + WS_W2), DFF, DFF, DFF}; Sched S; S.init(ML / 256, DM / 256, G, bid);
          EpiPlain<0> E{P_H, DM};
          gemm_phase<EpiPlain<0>, true, true>(lds, g, S, E); }
        if ((128 + (ML / 256) * (DFF / 256)) % G == 0) {
          Gemm g{P_ACT, (const bf16_t*)(ws + WS_W2), DFF, DFF, 1024}; Sched S; S.init(8, 4 * 4, G, bid, 2, 1024);
          EpiSlabCtx E{P_SLAB, 1024};
          gemm_phase<EpiSlabCtx, true, true>(lds, g, S, E); }
    }
    xcd_barrier(xbar);
    if (PH(8)) { PHASE_BEGIN row_phase<true, true, true, true>(kp->out, P_CTXRES, kp->out, P_CTXRES, P_H, P_SLAB, P_H, G0 + 3 * DM, G1, P_MOD0, 5, P_MOD1, 0, 1, MT, gw, ngw, lane); }
    xcd_barrier(xbar);
    if (PH(9)) {
        PHASE_BEGIN
        Gemm g{P_H, (const bf16_t*)(ws + WS_WIN), DM, DM, DM}; Sched S; S.init(MT / 256, DRNN / 256, G, bid, 4, 0);
        EpiInProj E{P_RPRE, (bf16_t*)(ws + WS_CTXRES)};
        gemm_phase<EpiInProj, true, true>(lds, g, S, E);
    }
    xcd_barrier(xbar);
    REP_BEGIN(10)
    if (PH(10)) { PHASE_BEGIN conv_phase(P_RPRE, P_U, kp->conv_w, kp->conv_b, gtid, nthreads);
        u32x4* cz = (u32x4*)(ws + WS_CARRY); for (int idx = gtid; idx < 1440 * 128 * 8 / 16; idx += nthreads) cz[idx] = (u32x4){0u, 0u, 0u, 0u}; }
    xcd_barrier(xbar);
    REP_END
    if (PH(11)) {
        PHASE_BEGIN
        Gemm g{P_U, (const bf16_t*)(ws + WS_WG), DRNN, 256, 256}; Sched S; S.init(1, 1, G, bid, 3, 0);
        EpiGatesScan E{P_U, P_RECF, P_RECB, kp->b_a, kp->b_i, (const float*)(ws + WS_NLS), (unsigned long long*)(ws + WS_CARRY)};
        gemm_phase<EpiGatesScan, true, true>(lds, g, S, E);
    }
    xcd_barrier(xbar);
    if (PH(15)) {
        PHASE_BEGIN
        Gemm g{P_H, (const bf16_t*)(ws + WS_WIN), DM, DM, DM}; Sched S; S.init(ML / 256, 4, G, bid);
        EpiGateMul E{P_RECF, P_RECB};
        gemm_phase<EpiGateMul, true, true>(lds, g, S, E);
        {
            const bf16_t* GB = (const bf16_t*)(ws + WS_CTXRES); bf16_t* Z = P_RECF; const bf16_t* RB = P_RECB;
            for (int idx = gtid; idx < ML * 32; idx += nthreads) { const int row = idx >> 5, c8 = (idx & 31) * 8;
                const u32x4 gv = *(const u32x4*)(GB + (size_t)row * 256 + c8); const size_t o = (size_t)row * DRNN + 1024 + c8;
                const u32x4 fv = *(const u32x4*)(Z + o), bv = *(const u32x4*)(RB + o); u32x4 w;
                w.x = cvt_pk_bf16(bf_lo(gv.x) * (bf_lo(fv.x) + bf_lo(bv.x)), bf_hi(gv.x) * (bf_hi(fv.x) + bf_hi(bv.x)));
                w.y = cvt_pk_bf16(bf_lo(gv.y) * (bf_lo(fv.y) + bf_lo(bv.y)), bf_hi(gv.y) * (bf_hi(fv.y) + bf_hi(bv.y)));
                w.z = cvt_pk_bf16(bf_lo(gv.z) * (bf_lo(fv.z) + bf_lo(bv.z)), bf_hi(gv.z) * (bf_hi(fv.z) + bf_hi(bv.z)));
                w.w = cvt_pk_bf16(bf_lo(gv.w) * (bf_lo(fv.w) + bf_lo(bv.w)), bf_hi(gv.w) * (bf_hi(fv.w) + bf_hi(bv.w)));
                *(u32x4*)(Z + o) = w; }
        }
    }
    xcd_barrier(xbar);
    if (PH(16)) {
        PHASE_BEGIN
        Gemm g{P_RECF, (const bf16_t*)(ws + WS_WOUT), DRNN, DRNN, DRNN}; Sched S; S.init(ML / 256, DM / 256, G, bid);
        EpiPlain<0> E{P_H, DM};
        gemm_phase<EpiPlain<0>, true, true>(lds, g, S, E);
    }
    xcd_barrier(xbar);
    if (PH(17)) { PHASE_BEGIN row_phase<true, true, true, true>(kp->out, P_CTXRES, ws + WS_X3, P_CTXRES, P_H, nullptr, P_H, G1 + DM, G1 + 2 * DM, P_MOD1, 2, P_MOD1, 3, 4, ML, gw, ngw, lane); }
    xcd_barrier(xbar);
    if (PH(18)) {
        PHASE_BEGIN
        Gemm g{P_H, (const bf16_t*)(ws + WS_W1 + 16 * MiB), DM, DM, DM}; Sched S; S.init(ML / 256, DFF / 256, G, bid);
        EpiPlain<1> E{P_ACT, DFF};
        gemm_phase<EpiPlain<1>, true, true>(lds, g, S, E);
    }
    xcd_barrier(xbar);
    if (PH(19)) {
        PHASE_BEGIN
        Gemm g{P_ACT, (const bf16_t*)(ws + WS_W2 + 16 * MiB), DFF, DFF, DFF}; Sched S; S.init(ML / 256, DM / 256, G, bid);
        EpiPlain<0> E{P_H, DM};
        gemm_phase<EpiPlain<0>, true, true>(lds, g, S, E);
    }
    xcd_barrier(xbar);
    if (PH(20)) { PHASE_BEGIN row_phase<true, false, true, false>(ws + WS_X3, P_CTXRES, kp->out, P_CTXRES, P_H, nullptr, nullptr, G1 + 3 * DM, nullptr, P_MOD1, 5, nullptr, 0, 0, ML, gw, ngw, lane); }
}

extern "C" void kernel_launch(void* const* d_in, const int* in_sizes, int n_in, void* d_out, int out_size, void* d_ws, size_t ws_size, hipStream_t stream) {
    static int grid_blocks = 0;
    if (grid_blocks == 0) {
        if (n_in != 21 || ws_size < WS_END) { fprintf(stderr, "kernel_launch: unexpected n_in %d / ws_size %zu\n", n_in, ws_size); grid_blocks = -1; return; }
        int dev = 0, cus = 0, per_cu = 0;
        hipGetDevice(&dev);
        hipDeviceGetAttribute(&cus, hipDeviceAttributeMultiprocessorCount, dev);
        if (hipFuncSetAttribute((const void*)fwd_megakernel, hipFuncAttributeMaxDynamicSharedMemorySize, LDS_BYTES) != hipSuccess) { fprintf(stderr, "hipFuncSetAttribute failed\n"); grid_blocks = -1; return; }
        if (hipOccupancyMaxActiveBlocksPerMultiprocessor(&per_cu, (const void*)fwd_megakernel, 512, LDS_BYTES) != hipSuccess || per_cu < 1) { fprintf(stderr, "occupancy query failed (%d)\n", per_cu); (void)hipGetLastError(); per_cu = 1; }
        grid_blocks = cus * 1;
    }
    if (grid_blocks < 0) return;
    Params p{};
    p.x = (const float*)d_in[0]; p.c = (const float*)d_in[1]; p.ctx = (const float*)d_in[2]; p.c_ctx = (const float*)d_in[3];
    p.ada_w = (const float*)d_in[4]; p.ada_b = (const float*)d_in[5]; p.norm_g = (const float*)d_in[6]; p.mlp_w1 = (const float*)d_in[7]; p.mlp_w2 = (const float*)d_in[8];
    p.w_qkv = (const float*)d_in[9]; p.w_o = (const float*)d_in[10]; p.sink = (const float*)d_in[11];
    p.w_in = (const float*)d_in[12]; p.conv_w = (const float*)d_in[13]; p.conv_b = (const float*)d_in[14]; p.w_a = (const float*)d_in[15]; p.b_a = (const float*)d_in[16];
    p.w_i = (const float*)d_in[17]; p.b_i = (const float*)d_in[18]; p.lam = (const float*)d_in[19]; p.w_out = (const float*)d_in[20];
    p.out = (float*)d_out; p.ws = (unsigned char*)d_ws;
    if (hipMemsetAsync((unsigned char*)d_ws + WS_BAR, 0, XCD_BAR_WORDS * 4, stream) != hipSuccess) { fprintf(stderr, "memset of barrier words failed\n"); return; }
    void* args[] = {&p};
    hipError_t e = hipLaunchCooperativeKernel((const void*)fwd_megakernel, dim3(grid_blocks), dim3(512), args, LDS_BYTES, stream);
    if (e != hipSuccess) fprintf(stderr, "cooperative launch failed: %s (grid %d)\n", hipGetErrorString(e), grid_blocks);
}
```

```cpp
#include <hip/hip_runtime.h>
#include <hip/hip_cooperative_groups.h>
#include <cstdio>
#include <cstdint>
namespace cg = cooperative_groups;

#define LAS __attribute__((address_space(3)))
typedef unsigned short bf16_t;
typedef short bf16x8 __attribute__((ext_vector_type(8)));
typedef float f32x4 __attribute__((ext_vector_type(4)));
typedef float f32x2 __attribute__((ext_vector_type(2)));
typedef unsigned u32x4 __attribute__((ext_vector_type(4)));
typedef unsigned u32x2 __attribute__((ext_vector_type(2)));

constexpr int DM = 1024, NB = 8, SEQ = 2048, CTX = 256;
constexpr int ML = NB * SEQ;
constexpr int MC = NB * CTX;
constexpr int MT = ML + MC;
constexpr int NQKV = 1536, DFF = 4096, DRNN = 1280;
constexpr float EPS = 1e-6f;
constexpr float LOG2E = 1.4426950408889634f;

constexpr size_t MiB = 1u << 20;
constexpr size_t WS_MOD = 0;
constexpr size_t WS_ROPE = 448 * 1024;
constexpr size_t WS_NLS = 460 * 1024;
constexpr size_t WS_BAR = 480 * 1024;
constexpr size_t WS_WQKV = 1 * MiB, WS_WO = 4 * MiB, WS_W1 = 6 * MiB, WS_W2 = 14 * MiB;
constexpr size_t WS_WIN = 38 * MiB, WS_WG = 43 * MiB, WS_WOUT = 46 * MiB;
constexpr size_t WS_CTXRES = 49 * MiB;
constexpr size_t WS_H = 57 * MiB;
constexpr size_t WS_R3 = 93 * MiB;
constexpr size_t WS_Q = WS_R3, WS_K = 129 * MiB, WS_VT = 138 * MiB, WS_VTC = 146 * MiB;
constexpr size_t WS_O = 150 * MiB;
constexpr size_t WS_ACT = WS_R3;
constexpr size_t WS_U = WS_R3;
constexpr size_t WS_RECF = 138 * MiB;
constexpr size_t WS_RECB = 178 * MiB;
constexpr size_t WS_LA = 138 * MiB;
constexpr size_t WS_BX = 183 * MiB;
constexpr size_t WS_RPRE = 138 * MiB;
constexpr size_t WS_SP = 228 * MiB, WS_SH = 231 * MiB, WS_CIN = 234 * MiB;
constexpr size_t WS_SLAB = 238 * MiB;
constexpr size_t WS_CARRY = 219 * MiB;
constexpr size_t WS_CNT = 500 * 1024;
constexpr size_t WS_FLAG = 512 * 1024;
constexpr size_t WS_X3 = 222 * MiB;
constexpr size_t WS_END = 256 * MiB;
constexpr int LDS_BYTES = 143360;

__device__ __forceinline__ unsigned f2bf(float f) { unsigned u = __builtin_bit_cast(unsigned, f); return (u + 0x7fffu + ((u >> 16) & 1u)) >> 16; }
__device__ __forceinline__ unsigned cvt_pk_bf16(float lo, float hi) { unsigned r; asm volatile("v_cvt_pk_bf16_f32 %0, %1, %2" : "=v"(r) : "v"(lo), "v"(hi)); return r; }
__device__ __forceinline__ float bf_lo(unsigned w) { return __builtin_bit_cast(float, w << 16); }
__device__ __forceinline__ float bf_hi(unsigned w) { return __builtin_bit_cast(float, w & 0xffff0000u); }
__device__ __forceinline__ f32x4 bf4_to_f32(u32x2 w) { return (f32x4){bf_lo(w.x), bf_hi(w.x), bf_lo(w.y), bf_hi(w.y)}; }
__device__ __forceinline__ u32x2 f32_to_bf4(f32x4 v) { u32x2 w; w.x = cvt_pk_bf16(v[0], v[1]); w.y = cvt_pk_bf16(v[2], v[3]); return w; }
__device__ __forceinline__ void store16_wt(void* p, u32x4 w) { asm volatile("global_store_dwordx4 %0, %1, off sc1\n\ts_nop 1" :: "v"(p), "v"(w) : "memory"); }
__device__ __forceinline__ void store2_wt(void* p, unsigned w) { asm volatile("global_store_short %0, %1, off sc1\n\ts_nop 1" :: "v"(p), "v"(w) : "memory"); }
__device__ __forceinline__ float wave_sum(float v) {
#pragma unroll
    for (int o = 1; o < 64; o <<= 1) v += __shfl_xor(v, o);
    return v;
}
__device__ __forceinline__ float fsigmoid(float x) { return __builtin_amdgcn_rcpf(1.0f + __expf(-x)); }

namespace pg8 {
constexpr int BM = 256, BK = 64, HALF = 128, HTB = HALF * BK * 2, STAGE_BYTES = 8 * HTB, NXCD = 8, WGM = 8;
__device__ __forceinline__ int lds_byte(int r, int c) { const int st = (r >> 4) * 2 + (c >> 5), rr = r & 15, cc = c & 31, ob = rr * 64 + cc * 2; return st * 1024 + (ob ^ (((ob >> 9) & 1) << 5)); }
__device__ __forceinline__ void stage_rc(int b, int& R, int& C) { const int st = b / 1024, sb = b % 1024, swz = sb ^ (((sb >> 9) & 1) << 5); R = (st >> 1) * 16 + swz / 64; C = (st & 1) * 32 + (swz % 64) / 2; }

__device__ __forceinline__ int perm32(int rho) { const int n = rho >> 4, i = rho & 15; return 8 * (i >> 2) + 4 * n + (i & 3); }
struct Unit { int pm, pn, koff, po, kboff, rev, lin; };
struct Gemm { const bf16_t* A; const bf16_t* Bt; int lda, ldb, K; };

struct Sched {
    int nM, nN, nwg, G, c, mode, half;
    __device__ void init(int nM_, int nN_, int G_, int c_, int mode_ = 0, int half_ = 0) { nM = nM_; nN = nN_; nwg = nM * nN; G = G_; c = c_; mode = mode_; half = half_; }
    __device__ bool next(int i, Unit& u) const {
        if (mode == 3) {
            const int L = i * G + c; if (L >= 1440) return false;
            const int ti = L / 160, s = L % 160;
            const int chalf = s & 1, dir = (s >> 1) & 1, bb = s >> 2, blk = bb % 5, b = bb / 5;
            u.pm = (ti == 0) ? 64 + b : (dir ? b * 8 + (8 - ti) : b * 8 + (ti - 1));
            u.pn = (dir * 5 + blk) * 2 + chalf; u.koff = blk * 256; u.kboff = 0; u.po = ti; u.rev = dir; u.lin = L;
            return true;
        }
        if (mode == 6) {
            const int L6 = i * G + c; if (L6 >= 48 + nwg) return false;
            if (L6 < 48) { u.pm = 64 + L6 / 6; u.pn = L6 % 6; u.koff = 0; u.po = u.pm; u.kboff = 0; u.rev = 0; u.lin = 0; return true; }
            int wgid = L6 - 48; { const int q = nwg / NXCD, r = nwg % NXCD, xcd = wgid % NXCD, off = wgid / NXCD; wgid = (xcd < r ? xcd * (q + 1) : r * (q + 1) + (xcd - r) * q) + off; }
            const int nig = WGM * nN, gid = wgid / nig, fm = gid * WGM, gsz = (nM - fm) < WGM ? (nM - fm) : WGM;
            u.pm = fm + ((wgid % nig) % gsz); u.pn = (wgid % nig) / gsz; u.koff = 0; u.po = u.pm; u.kboff = 0; u.rev = 0; u.lin = 0;
            return true;
        }
        if (mode == 5) {
            const int L5 = i * G + c; if (L5 >= 128 + nwg) return false;
            if (L5 < 128) { u.pm = 64 + (L5 >> 4); u.pn = L5 & 15; u.koff = 0; u.po = u.pm; u.kboff = 0; u.rev = 0; u.lin = 0; return true; }
            int wgid = L5 - 128; { const int q = nwg / NXCD, r = nwg % NXCD, xcd = wgid % NXCD, off = wgid / NXCD; wgid = (xcd < r ? xcd * (q + 1) : r * (q + 1) + (xcd - r) * q) + off; }
            const int nig = WGM * nN, gid = wgid / nig, fm = gid * WGM, gsz = (nM - fm) < WGM ? (nM - fm) : WGM;
            u.pm = fm + ((wgid % nig) % gsz); u.pn = (wgid % nig) / gsz; u.koff = 0; u.po = u.pm; u.kboff = 0; u.rev = 0; u.lin = 0;
            return true;
        }
        if (mode == 4) {
            const int L4 = i * G + c; if (L4 >= 424) return false;
            if (L4 >= 360) { u.pm = L4 - 360; u.pn = 4; u.koff = 0; u.po = u.pm; u.kboff = 0; u.rev = 0; u.lin = 0; return true; }
        }
        const long L = (long)i * G + c; if (L >= nwg) return false;
        int wgid = (int)L; { const int q = nwg / NXCD, r = nwg % NXCD, xcd = wgid % NXCD, off = wgid / NXCD; wgid = (xcd < r ? xcd * (q + 1) : r * (q + 1) + (xcd - r) * q) + off; }
        const int nig = WGM * nN, gid = wgid / nig, fm = gid * WGM, gsz = (nM - fm) < WGM ? (nM - fm) : WGM;
        const int pmi = fm + ((wgid % nig) % gsz), pn = (wgid % nig) / gsz;
        u.pm = pmi; u.pn = pn; u.koff = 0; u.po = pmi; u.kboff = 0; u.rev = 0; u.lin = 0;
        if (mode == 2) { u.pm = 64 + pmi; u.pn = pn & 3; u.koff = (pn >> 2) * half; u.kboff = u.koff; }
        if (mode == 4) u.pn += 5;
        if (mode == 1) { u.pm = pmi < 32 ? 32 * half + pmi : 64 + 4 * half + (pmi - 32); u.koff = ((pn >> 1) % 5) * 256; }
        return true;
    }
};

template <class Epi, bool ALIGN_EPI, bool SP2>
__device__ __forceinline__ void gemm_phase(LAS unsigned char* lds, const Gemm g, const Sched& S, const Epi& E) {
    int tid = threadIdx.x; asm volatile("" : "+v"(tid));
    const int wid = __builtin_amdgcn_readfirstlane(tid >> 6), lane = tid & 63, wr = wid >> 2, wc = wid & 3, fr = lane & 15, fq = lane >> 4;
    const int K = g.K, nt = K / BK;
    unsigned voffAf[2], voffAr[2], voffB[2];
#pragma unroll
    for (int i = 0; i < 2; ++i) { int R, C; stage_rc(tid * 16 + i * 8192, R, C);
        const int Rb = Epi::PERM ? ((R & ~31) + perm32(R & 31)) : R;
        voffAf[i] = (unsigned)(R * g.lda + C) * 2u; voffAr[i] = (unsigned)((127 - R) * g.lda + C) * 2u; voffB[i] = (unsigned)(Rb * g.ldb + C) * 2u; }
    const size_t kstep = (size_t)(BK * 2);
    const long hstepAf = (long)HALF * g.lda * 2; const size_t hstepB = (size_t)HALF * g.ldb * 2;
    const unsigned ldsw = (unsigned)wid * 1024u;
    const int aoff = lds_byte(wr * 64 + fr, fq * 8), boff = lds_byte(wc * 32 + fr, fq * 8);
#define PG8_SA(b, h) (((b) * 2 + (h)) * HTB)
#define PG8_SB(b, h) ((4 + (b) * 2 + (h)) * HTB)
#define PG8_STAGE(bufoff, gbase, voff) do { _Pragma("unroll") for (int _i = 0; _i < 2; ++_i) \
        __builtin_amdgcn_global_load_lds((const unsigned*)((const char*)(gbase) + (voff)[_i]), (LAS unsigned*)(lds + (bufoff) + ldsw + _i * 8192), 16, 0, 0); } while (0)
#define PG8_LDA(dst, b, h) do { _Pragma("unroll") for (int m = 0; m < 4; ++m) _Pragma("unroll") for (int k = 0; k < 2; ++k) dst[m][k] = *(const LAS bf16x8*)(lds + PG8_SA(b, h) + aoff + m * 2048 + k * 1024); } while (0)
#define PG8_LDB(dst, b, h) do { _Pragma("unroll") for (int n = 0; n < 2; ++n) _Pragma("unroll") for (int k = 0; k < 2; ++k) dst[n][k] = *(const LAS bf16x8*)(lds + PG8_SB(b, h) + boff + n * 2048 + k * 1024); } while (0)
#define PG8_MMA(ai, bj, At, Bt) do { __builtin_amdgcn_s_setprio(1); _Pragma("unroll") for (int m = 0; m < 4; ++m) _Pragma("unroll") for (int n = 0; n < 2; ++n) _Pragma("unroll") for (int k = 0; k < 2; ++k) \
        acc[ai][bj][m][n] = __builtin_amdgcn_mfma_f32_16x16x32_bf16(Bt[n][k], At[m][k], acc[ai][bj][m][n], 0, 0, 0); __builtin_amdgcn_s_setprio(0); } while (0)
#define PG8_WAIT_V(n) asm volatile("s_waitcnt vmcnt(" #n ")" ::: "memory")
#define PG8_WAIT_L(n) asm volatile("s_waitcnt lgkmcnt(" #n ")" ::: "memory")
#define PG8_BAR __builtin_amdgcn_s_barrier()
#define PG8_SCHED __builtin_amdgcn_sched_barrier(0)
    Unit cur, nxt; int ui = 0;
    if (!S.next(0, cur)) return;
    f32x4 acc[2][2][4][2];
#pragma unroll
    for (int a = 0; a < 2; ++a)
#pragma unroll
        for (int b = 0; b < 2; ++b)
#pragma unroll
            for (int m = 0; m < 4; ++m)
#pragma unroll
                for (int n = 0; n < 2; ++n) acc[a][b][m][n] = (f32x4){0.f, 0.f, 0.f, 0.f};
    bf16x8 At[4][2], B0[2][2], B1[2][2];
#define PG8_UNIT_A(u_) ((const char*)g.A + ((size_t)(u_).pm * BM * g.lda + (u_).koff) * 2 + (Epi::WITH_LDS && (u_).rev ? hstepAf : 0))
    const char* cA = PG8_UNIT_A(cur);
    unsigned voffA[2] = {voffAf[0], voffAf[1]}; long hstepA = hstepAf;
    if (Epi::WITH_LDS && cur.rev) { voffA[0] = voffAr[0]; voffA[1] = voffAr[1]; hstepA = -hstepAf; } const char* cB = (const char*)g.Bt + ((size_t)cur.pn * BM * g.ldb + cur.kboff) * 2;
    if constexpr (SP2) {
        PG8_STAGE(PG8_SB(0, 0), cB, voffB); PG8_STAGE(PG8_SB(0, 1), cB + hstepB, voffB); PG8_STAGE(PG8_SA(0, 0), cA, voffA); PG8_STAGE(PG8_SA(0, 1), cA + hstepA, voffA);
        if (wr == 1) PG8_BAR;
        PG8_WAIT_V(2); PG8_BAR;
        PG8_STAGE(PG8_SB(1, 0), cB + kstep, voffB); PG8_STAGE(PG8_SA(1, 0), cA + kstep, voffA); PG8_STAGE(PG8_SB(1, 1), cB + hstepB + kstep, voffB);
        PG8_WAIT_V(6); PG8_BAR;
    } else {
        PG8_STAGE(PG8_SB(0, 0), cB, voffB); PG8_STAGE(PG8_SA(0, 0), cA, voffA); PG8_STAGE(PG8_SB(0, 1), cB + hstepB, voffB); PG8_STAGE(PG8_SA(0, 1), cA + hstepA, voffA);
        if (wr == 1) PG8_BAR;
        PG8_WAIT_V(4); PG8_BAR;
        PG8_STAGE(PG8_SB(1, 0), cB + kstep, voffB); PG8_STAGE(PG8_SA(1, 0), cA + kstep, voffA); PG8_STAGE(PG8_SB(1, 1), cB + hstepB + kstep, voffB);
        PG8_WAIT_V(6); PG8_BAR;
    }
    for (;;) {
        const bool has_next = S.next(ui + 1, nxt);
        const char* nA = has_next ? PG8_UNIT_A(nxt) : cA;
        unsigned voffN[2] = {voffA[0], voffA[1]}; long hstepN = hstepA;
        if (Epi::WITH_LDS && has_next) { const bool nr = nxt.rev != 0; voffN[0] = nr ? voffAr[0] : voffAf[0]; voffN[1] = nr ? voffAr[1] : voffAf[1]; hstepN = nr ? -hstepAf : hstepAf; }
        const char* nB = has_next ? (const char*)g.Bt + ((size_t)nxt.pn * BM * g.ldb + nxt.kboff) * 2 : cB;
#pragma unroll 1
        for (int t = 0; t < nt; t += 2) {
            const bool last = (t == nt - 2);
            const char* a1 = cA + (size_t)(t + 1) * kstep;
            const char* a2 = last ? nA : cA + (size_t)(t + 2) * kstep; const char* b2 = last ? nB : cB + (size_t)(t + 2) * kstep;
            const char* a3 = a2 + kstep; const char* b3 = b2 + kstep;
            unsigned voff2[2] = {voffA[0], voffA[1]}; long hstep2 = hstepA;
            if (Epi::WITH_LDS && last) { voff2[0] = voffN[0]; voff2[1] = voffN[1]; hstep2 = hstepN; }
            if constexpr (SP2) {
            PG8_LDB(B0, 0, 0); PG8_LDB(B1, 0, 1); PG8_SCHED; PG8_LDA(At, 0, 0); PG8_STAGE(PG8_SA(1, 1), a1 + hstepA, voffA);
            PG8_WAIT_V(8); PG8_WAIT_L(0); PG8_BAR; PG8_MMA(0, 0, At, B0); PG8_MMA(0, 1, At, B1); PG8_BAR; PG8_SCHED;
            PG8_LDA(At, 0, 1); PG8_STAGE(PG8_SB(0, 0), b2, voffB); PG8_STAGE(PG8_SB(0, 1), b2 + hstepB, voffB); PG8_STAGE(PG8_SA(0, 0), a2, voff2);
            PG8_WAIT_V(8); PG8_WAIT_L(0); PG8_BAR; PG8_MMA(1, 0, At, B0); PG8_MMA(1, 1, At, B1); PG8_BAR; PG8_SCHED;
            PG8_LDB(B0, 1, 0); PG8_LDB(B1, 1, 1); PG8_SCHED; PG8_LDA(At, 1, 0); PG8_STAGE(PG8_SA(0, 1), a2 + hstep2, voff2);
            PG8_WAIT_V(8); PG8_WAIT_L(0); PG8_BAR; PG8_MMA(0, 0, At, B0); PG8_MMA(0, 1, At, B1); PG8_BAR; PG8_SCHED;
            PG8_LDA(At, 1, 1); PG8_STAGE(PG8_SB(1, 0), b3, voffB); PG8_STAGE(PG8_SB(1, 1), b3 + hstepB, voffB); PG8_STAGE(PG8_SA(1, 0), a3, voff2);
            PG8_WAIT_V(8); PG8_WAIT_L(0); PG8_BAR; PG8_MMA(1, 0, At, B0); PG8_MMA(1, 1, At, B1); PG8_BAR; PG8_SCHED;
            } else {
            PG8_LDB(B0, 0, 0); PG8_SCHED; PG8_LDA(At, 0, 0); PG8_STAGE(PG8_SA(1, 1), a1 + hstepA, voffA);
            PG8_WAIT_L(8); PG8_BAR; PG8_WAIT_L(0); PG8_MMA(0, 0, At, B0); PG8_BAR; PG8_SCHED;
            PG8_LDB(B1, 0, 1); PG8_STAGE(PG8_SB(0, 0), b2, voffB);
            PG8_BAR; PG8_WAIT_L(0); PG8_MMA(0, 1, At, B1); PG8_BAR;
            PG8_LDA(At, 0, 1); PG8_STAGE(PG8_SA(0, 0), a2, voff2);
            PG8_BAR; PG8_WAIT_L(0); PG8_MMA(1, 0, At, B0); PG8_BAR; PG8_SCHED;
            PG8_STAGE(PG8_SB(0, 1), b2 + hstepB, voffB);
            PG8_WAIT_V(6); PG8_BAR; PG8_MMA(1, 1, At, B1); PG8_BAR;
            PG8_LDB(B0, 1, 0); PG8_SCHED; PG8_LDA(At, 1, 0); PG8_STAGE(PG8_SA(0, 1), a2 + hstep2, voff2);
            PG8_WAIT_L(8); PG8_BAR; PG8_WAIT_L(0); PG8_MMA(0, 0, At, B0); PG8_BAR; PG8_SCHED;
            PG8_LDB(B1, 1, 1); PG8_STAGE(PG8_SB(1, 0), b3, voffB);
            PG8_BAR; PG8_WAIT_L(0); PG8_MMA(0, 1, At, B1); PG8_BAR;
            PG8_LDA(At, 1, 1); PG8_STAGE(PG8_SA(1, 0), a3, voff2);
            PG8_BAR; PG8_WAIT_L(0); PG8_MMA(1, 0, At, B0); PG8_BAR; PG8_SCHED;
            PG8_STAGE(PG8_SB(1, 1), b3 + hstepB, voffB);
            PG8_WAIT_V(6); PG8_BAR; PG8_MMA(1, 1, At, B1); PG8_BAR;
            }
        }
        if constexpr (ALIGN_EPI) { if (wr == 0) PG8_BAR; }
        if constexpr (Epi::WITH_LDS) E.run(acc, cur, wr, wc, lane, lds); else E(acc, cur, wr, wc, fr, fq);
        if (!has_next) break;
#pragma unroll
        for (int a = 0; a < 2; ++a)
#pragma unroll
            for (int b = 0; b < 2; ++b)
#pragma unroll
                for (int m = 0; m < 4; ++m)
#pragma unroll
                    for (int n = 0; n < 2; ++n) acc[a][b][m][n] = (f32x4){0.f, 0.f, 0.f, 0.f};
        cur = nxt; cA = nA; cB = nB; ++ui; voffA[0] = voffN[0]; voffA[1] = voffN[1]; hstepA = hstepN;
        if constexpr (ALIGN_EPI) { if (wr == 1) PG8_BAR; }
    }
    PG8_WAIT_V(0);
    if constexpr (!ALIGN_EPI) { if (wr == 0) PG8_BAR; }
    PG8_BAR;
#undef PG8_UNIT_A
#undef PG8_SA
#undef PG8_SB
#undef PG8_STAGE
#undef PG8_LDA
#undef PG8_LDB
#undef PG8_MMA
#undef PG8_WAIT_V
#undef PG8_WAIT_L
#undef PG8_BAR
#undef PG8_SCHED
}

template <int ACT> struct EpiPlain {
    static constexpr bool WITH_LDS = false, PERM = true;
    bf16_t* O; int ldc; unsigned* done_cnt = nullptr;
    __device__ __forceinline__ void operator()(const f32x4 (&acc)[2][2][4][2], const Unit& u, int wr, int wc, int fr_, int fq_) const {
        int fr = fr_, fq = fq_; asm volatile("" : "+v"(fr), "+v"(fq));
        const int col0 = u.pn * BM + wc * 32 + fq * 8;
#pragma unroll
        for (int ai = 0; ai < 2; ++ai)
#pragma unroll
            for (int m = 0; m < 4; ++m) { bf16_t* rowp = O + (size_t)(u.pm * BM + ai * HALF + wr * 64 + m * 16 + fr) * ldc + col0;
#pragma unroll
                for (int bj = 0; bj < 2; ++bj) { f32x4 v0 = acc[ai][bj][m][0], v1 = acc[ai][bj][m][1];
                    if (ACT == 1) { v0 = __builtin_elementwise_max(v0, (f32x4){0.f, 0.f, 0.f, 0.f}); v0 = v0 * v0; v1 = __builtin_elementwise_max(v1, (f32x4){0.f, 0.f, 0.f, 0.f}); v1 = v1 * v1; }
                    u32x4 w; w.x = cvt_pk_bf16(v0[0], v0[1]); w.y = cvt_pk_bf16(v0[2], v0[3]); w.z = cvt_pk_bf16(v1[0], v1[1]); w.w = cvt_pk_bf16(v1[2], v1[3]);
                    if (ACT == 1 && done_cnt != nullptr && u.pm >= 64) store16_wt(rowp + bj * HALF, w); else *(u32x4*)(rowp + bj * HALF) = w; } }
        if (ACT == 1 && done_cnt != nullptr && u.pm >= 64) {
            asm volatile("s_waitcnt vmcnt(0)" ::: "memory"); __builtin_amdgcn_s_barrier(); asm volatile("" ::: "memory");
            if (threadIdx.x == 0) __hip_atomic_fetch_add(done_cnt, 1u, __ATOMIC_RELAXED, __HIP_MEMORY_SCOPE_AGENT);
        }
    }
};

struct EpiSlabCtx {
    static constexpr bool WITH_LDS = false, PERM = true;
    bf16_t* S; int ksz;
    __device__ __forceinline__ void operator()(const f32x4 (&acc)[2][2][4][2], const Unit& u, int wr, int wc, int fr_, int fq_) const {
        int fr = fr_, fq = fq_; asm volatile("" : "+v"(fr), "+v"(fq));
        const int col0 = u.pn * BM + wc * 32 + fq * 8;
        bf16_t* base = S + (size_t)(u.koff / ksz) * MC * DM;
#pragma unroll
        for (int ai = 0; ai < 2; ++ai)
#pragma unroll
            for (int m = 0; m < 4; ++m) { bf16_t* rowp = base + (size_t)(u.pm * BM - ML + ai * HALF + wr * 64 + m * 16 + fr) * DM + col0;
#pragma unroll
                for (int bj = 0; bj < 2; ++bj) { const f32x4 v0 = acc[ai][bj][m][0], v1 = acc[ai][bj][m][1];
                    u32x4 w; w.x = cvt_pk_bf16(v0[0], v0[1]); w.y = cvt_pk_bf16(v0[2], v0[3]); w.z = cvt_pk_bf16(v1[0], v1[1]); w.w = cvt_pk_bf16(v1[2], v1[3]);
                    *(u32x4*)(rowp + bj * HALF) = w; } }
    }
};

struct EpiQKV {
    static constexpr bool WITH_LDS = false, PERM = false;
    bf16_t* Q; bf16_t* Kb; bf16_t* VT; bf16_t* VTC; const float* rope; unsigned* done_cnt = nullptr;
    __device__ __forceinline__ void operator()(const f32x4 (&acc)[2][2][4][2], const Unit& u, int wr, int wc, int fr_, int fq_) const {
        int fr = fr_, fq = fq_; asm volatile("" : "+v"(fr), "+v"(fq));
        const bool lat = u.pm < 64;
        if (u.pn < 5) {
#pragma unroll
            for (int ai = 0; ai < 2; ++ai)
#pragma unroll
                for (int m = 0; m < 4; ++m) {
                    const int row = u.pm * BM + ai * HALF + wr * 64 + m * 16 + fr;
                    f32x4 cs0 = {1.f, 0.f, 1.f, 0.f}, cs1 = {1.f, 0.f, 1.f, 0.f};
                    if (lat) { const int t = row & 2047; const int pos = (wc & 1) ? (t & 63) : (t >> 6); const f32x4* pp = (const f32x4*)(rope + (pos * 16 + 4 * fq) * 2); cs0 = pp[0]; cs1 = pp[1]; }
                    const f32x4 cv = {cs0[0], cs0[2], cs1[0], cs1[2]}, sv = {cs0[1], cs0[3], cs1[1], cs1[3]};
#pragma unroll
                    for (int bj = 0; bj < 2; ++bj) {
                        const f32x4 a = acc[ai][bj][m][0], b = acc[ai][bj][m][1];
                        f32x4 na = a * cv - b * sv, nb = b * cv + a * sv;
                        if (u.pn < 4) { na = na * 0.125f; nb = nb * 0.125f; }
                        bf16_t* d = (u.pn < 4) ? Q + (size_t)row * 1024 + u.pn * 256 + bj * HALF + wc * 32 + fq * 8 : Kb + (size_t)row * 256 + bj * HALF + wc * 32 + fq * 8;
                        u32x4 w; w.x = cvt_pk_bf16(na[0], na[1]); w.y = cvt_pk_bf16(na[2], na[3]); w.z = cvt_pk_bf16(nb[0], nb[1]); w.w = cvt_pk_bf16(nb[2], nb[3]);
                        if (!lat && done_cnt != nullptr) store16_wt(d, w); else *(u32x4*)d = w;
                    }
                }
        } else {
#pragma unroll
            for (int ai = 0; ai < 2; ++ai)
#pragma unroll
                for (int m = 0; m < 4; ++m) {
                    const int row = u.pm * BM + ai * HALF + wr * 64 + m * 16 + fr;
                    bf16_t* base; size_t stride;
                    if (lat) { const int b = row >> 11, t = row & 2047; base = VT + (size_t)b * 256 * 2048 + t; stride = 2048; }
                    else { const int rc = row - ML; const int b = rc >> 8, t = rc & 255; base = VTC + (size_t)b * 256 * 256 + t; stride = 256; }
#pragma unroll
                    for (int bj = 0; bj < 2; ++bj)
#pragma unroll
                        for (int n = 0; n < 2; ++n)
#pragma unroll
                            for (int j = 0; j < 4; ++j) { const int vc = bj * HALF + wc * 32 + n * 16 + fq * 4 + j;
                                if (!lat && done_cnt != nullptr) store2_wt(base + (size_t)vc * stride, f2bf(acc[ai][bj][m][n][j])); else base[(size_t)vc * stride] = (bf16_t)f2bf(acc[ai][bj][m][n][j]); }
                }
        }
        if (!lat && done_cnt != nullptr) {
            asm volatile("s_waitcnt vmcnt(0)" ::: "memory"); __builtin_amdgcn_s_barrier(); asm volatile("" ::: "memory");
            if (threadIdx.x == 0) __hip_atomic_fetch_add(done_cnt, 1u, __ATOMIC_RELAXED, __HIP_MEMORY_SCOPE_AGENT);
        }
    }
};

struct EpiInProj {
    static constexpr bool WITH_LDS = false, PERM = true;
    bf16_t* R; bf16_t* GB;
    __device__ __forceinline__ void operator()(const f32x4 (&acc)[2][2][4][2], const Unit& u, int wr, int wc, int fr_, int fq_) const {
        int fr = fr_, fq = fq_; asm volatile("" : "+v"(fr), "+v"(fq));
        const bool rec = u.pn >= 5;
        const int col0 = (rec ? (u.pn - 5) * BM : 0) + wc * 32 + fq * 8; const int ldc = rec ? DRNN : 256; bf16_t* O = rec ? R : GB;
#pragma unroll
        for (int ai = 0; ai < 2; ++ai)
#pragma unroll
            for (int m = 0; m < 4; ++m) { bf16_t* rowp = O + (size_t)(u.pm * BM + ai * HALF + wr * 64 + m * 16 + fr) * ldc + col0;
#pragma unroll
                for (int bj = 0; bj < 2; ++bj) { f32x4 v0 = acc[ai][bj][m][0], v1 = acc[ai][bj][m][1];
                    if (!rec) {
#pragma unroll
                        for (int j = 0; j < 4; ++j) { const float x = v0[j]; v0[j] = x * fsigmoid(1.5957691216057308f * (x + 0.044715f * x * x * x)); const float y = v1[j]; v1[j] = y * fsigmoid(1.5957691216057308f * (y + 0.044715f * y * y * y)); } }
                    u32x4 w; w.x = cvt_pk_bf16(v0[0], v0[1]); w.y = cvt_pk_bf16(v0[2], v0[3]); w.z = cvt_pk_bf16(v1[0], v1[1]); w.w = cvt_pk_bf16(v1[2], v1[3]);
                    *(u32x4*)(rowp + bj * HALF) = w; } }
    }
};

struct EpiGates {
    static constexpr bool WITH_LDS = false, PERM = false;
    const bf16_t* U; bf16_t* LA; bf16_t* BX; const float* ba; const float* bi; const float* nls;
    __device__ __forceinline__ void operator()(const f32x4 (&acc)[2][2][4][2], const Unit& u, int wr, int wc, int fr_, int fq_) const {
        int fr = fr_, fq = fq_; asm volatile("" : "+v"(fr), "+v"(fq));
        const int tile = u.pn >> 1, dir = tile / 5, blk = tile % 5, chalf = u.pn & 1;
        const int ch0 = blk * 256 + chalf * 128 + wc * 32 + fq * 4;
#pragma unroll
        for (int n = 0; n < 2; ++n) {
            const int ch = ch0 + n * 16;
            const f32x4 bav = *(const f32x4*)(ba + dir * DRNN + ch), biv = *(const f32x4*)(bi + dir * DRNN + ch), nl = *(const f32x4*)(nls + dir * DRNN + ch);
#pragma unroll
            for (int ai = 0; ai < 2; ++ai)
#pragma unroll
                for (int m = 0; m < 4; ++m) {
                    const int rin = ai * HALF + wr * 64 + m * 16 + fr;
                    const size_t rowg = (size_t)u.pm * BM + rin, rowl = (size_t)u.po * BM + rin;
                    const f32x4 uv = bf4_to_f32(*(const u32x2*)(U + rowg * DRNN + ch));
                    f32x4 lav, bxv;
#pragma unroll
                    for (int j = 0; j < 4; ++j) {
                        const float r = fsigmoid(acc[ai][0][m][n][j] + bav[j]);
                        const float ig = fsigmoid(acc[ai][1][m][n][j] + biv[j]);
                        const float la = nl[j] * r, x = 2.0f * la;
                        float om;
                        if (x > -0.5f) { float q = 1.0f / 720.0f; q = q * x + 1.0f / 120.0f; q = q * x + 1.0f / 24.0f; q = q * x + 1.0f / 6.0f; q = q * x + 0.5f; q = q * x + 1.0f; om = -x * q; }
                        else om = 1.0f - __expf(x);
                        lav[j] = la; bxv[j] = __builtin_amdgcn_sqrtf(om) * (ig * uv[j]);
                    }
                    const size_t o = ((size_t)dir * 9216 + rowl) * DRNN + ch;
                    *(u32x2*)(LA + o) = f32_to_bf4(lav); *(u32x2*)(BX + o) = f32_to_bf4(bxv);
                    asm volatile("" ::: "memory");
                }
        }
    }
};

#define SC_STEP(d) \
    "v_fmac_f32_dpp %1, %1, %0 row_shr:" #d " row_mask:0xf bank_mask:0xf\n\t" "v_mul_f32_dpp %0, %0, %0 row_shr:" #d " row_mask:0xf bank_mask:0xf\n\t" \
    "v_fmac_f32_dpp %3, %3, %2 row_shr:" #d " row_mask:0xf bank_mask:0xf\n\t" "v_mul_f32_dpp %2, %2, %2 row_shr:" #d " row_mask:0xf bank_mask:0xf\n\t" \
    "v_fmac_f32_dpp %5, %5, %4 row_shr:" #d " row_mask:0xf bank_mask:0xf\n\t" "v_mul_f32_dpp %4, %4, %4 row_shr:" #d " row_mask:0xf bank_mask:0xf\n\t" \
    "v_fmac_f32_dpp %7, %7, %6 row_shr:" #d " row_mask:0xf bank_mask:0xf\n\t" "v_mul_f32_dpp %6, %6, %6 row_shr:" #d " row_mask:0xf bank_mask:0xf\n\t"
__device__ __forceinline__ void scan16x4(float& a0, float& b0, float& a1, float& b1, float& a2, float& b2, float& a3, float& b3) {
    asm volatile("s_nop 1\n\t" SC_STEP(1) SC_STEP(2) SC_STEP(4) SC_STEP(8)
                 : "+v"(a0), "+v"(b0), "+v"(a1), "+v"(b1), "+v"(a2), "+v"(b2), "+v"(a3), "+v"(b3));
}
struct EpiGatesScan {
    static constexpr bool WITH_LDS = true, PERM = true;
    const bf16_t* U; bf16_t* RECF; bf16_t* RECB; const float* ba; const float* bi; const float* nls; unsigned long long* CARRY;
    __device__ __forceinline__ void run(f32x4 (&acc)[2][2][4][2], const Unit& u, int wr, int wc, int lane_, LAS unsigned char* lds) const {
        int lane = lane_; asm volatile("" : "+v"(lane));
        const int fr = lane & 15, fq = lane >> 4;
        const int tile = u.pn >> 1, dir = tile / 5, blk = tile % 5, chalf = u.pn & 1;
        const int ch0 = blk * 256 + chalf * 128 + wc * 32 + fq * 8;
        const int rmask = dir ? 255 : 0;
        bf16_t* REC = dir ? RECB : RECF;
#pragma unroll
        for (int n = 0; n < 2; ++n) {
            const int ch = ch0 + n * 4;
            const f32x4 bav2 = *(const f32x4*)(ba + dir * DRNN + ch) * (-LOG2E), biv2 = *(const f32x4*)(bi + dir * DRNN + ch) * (-LOG2E), nl = *(const f32x4*)(nls + dir * DRNN + ch);
            const f32x4 nl2 = nl * LOG2E, nlx = nl * 2.0f;
#pragma unroll
            for (int ai = 0; ai < 2; ++ai)
#pragma unroll
                for (int m = 0; m < 4; ++m) {
                    const size_t rowg = (size_t)u.pm * BM + ((ai * HALF + wr * 64 + m * 16 + fr) ^ rmask);
                    const f32x4 uv = bf4_to_f32(*(const u32x2*)(U + rowg * DRNN + ch));
                    float av[4], bv[4];
#pragma unroll
                    for (int j = 0; j < 4; ++j) {
                        const float r = __builtin_amdgcn_rcpf(1.0f + __builtin_amdgcn_exp2f(acc[ai][0][m][n][j] * (-LOG2E) + bav2[j]));
                        const float ig = __builtin_amdgcn_rcpf(1.0f + __builtin_amdgcn_exp2f(acc[ai][1][m][n][j] * (-LOG2E) + biv2[j]));
                        const float x = nlx[j] * r, a = __builtin_amdgcn_exp2f(nl2[j] * r);
                        const float om = (x > -0.0625f) ? -x * (1.0f + x * (0.5f + x * (1.0f / 6.0f + x * (1.0f / 24.0f)))) : 1.0f - a * a;
                        av[j] = a; bv[j] = __builtin_amdgcn_sqrtf(om) * (ig * uv[j]);
                    }
                    scan16x4(av[0], bv[0], av[1], bv[1], av[2], bv[2], av[3], bv[3]);
#pragma unroll
                    for (int j = 0; j < 4; ++j) { acc[ai][0][m][n][j] = av[j]; acc[ai][1][m][n][j] = bv[j]; }
                    __builtin_amdgcn_sched_barrier(0);
                }
        }
        LAS f32x2* segtot = (LAS f32x2*)(lds + 133120);
        LAS float* segcarry = (LAS float*)(lds + 137216);
#pragma unroll
        for (int ai = 0; ai < 2; ++ai)
#pragma unroll
            for (int n = 0; n < 2; ++n) {
                f32x4 As = acc[ai][0][0][n], Bs = acc[ai][1][0][n];
#pragma unroll
                for (int m = 1; m < 4; ++m) { Bs = acc[ai][0][m][n] * Bs + acc[ai][1][m][n]; As = acc[ai][0][m][n] * As; }
                if (fr == 15) {
#pragma unroll
                    for (int j = 0; j < 4; ++j) segtot[(2 * ai + wr) * 128 + wc * 32 + n * 16 + fq * 4 + j] = (f32x2){As[j], Bs[j]};
                }
            }
        asm volatile("s_waitcnt lgkmcnt(0)" ::: "memory"); __builtin_amdgcn_s_barrier(); asm volatile("" ::: "memory");
        const int tid_ = threadIdx.x;
        if (tid_ < 128) {
            float h = 0.0f;
            if (u.po > 0) { unsigned long long* gp = CARRY + (size_t)(u.lin - 160) * 128 + tid_; unsigned long long v; unsigned sp = 0;
                for (;;) { v = __hip_atomic_load(gp, __ATOMIC_RELAXED, __HIP_MEMORY_SCOPE_AGENT); if ((v >> 32) != 0ull) break; __builtin_amdgcn_s_sleep(1); if (++sp > (1u << 22)) break; }
                h = __uint_as_float((unsigned)v); }
#pragma unroll
            for (int sg = 0; sg < 4; ++sg) { segcarry[sg * 128 + tid_] = h; const f32x2 t = segtot[sg * 128 + tid_]; h = t[0] * h + t[1]; }
            if (u.po < 8) __hip_atomic_store(CARRY + (size_t)u.lin * 128 + tid_, (1ull << 32) | (unsigned long long)__float_as_uint(h), __ATOMIC_RELAXED, __HIP_MEMORY_SCOPE_AGENT);
        }
        asm volatile("s_waitcnt lgkmcnt(0)" ::: "memory"); __builtin_amdgcn_s_barrier(); asm volatile("" ::: "memory");
        const bool emit = u.pm < 64;
        const int lastl = (lane & 48) | 15;
        if (emit) {
#pragma unroll
            for (int ai = 0; ai < 2; ++ai) {
                f32x4 hg[2];
#pragma unroll
                for (int n = 0; n < 2; ++n) hg[n] = *(const LAS f32x4*)(segcarry + (2 * ai + wr) * 128 + wc * 32 + n * 16 + fq * 4);
#pragma unroll
                for (int m = 0; m < 4; ++m) {
                    f32x4 h[2];
#pragma unroll
                    for (int n = 0; n < 2; ++n) h[n] = acc[ai][0][m][n] * hg[n] + acc[ai][1][m][n];
                    bf16_t* rp = REC + ((size_t)u.pm * BM + ((ai * HALF + wr * 64 + m * 16 + fr) ^ rmask)) * DRNN + ch0;
                    { u32x4 w; w.x = cvt_pk_bf16(h[0][0], h[0][1]); w.y = cvt_pk_bf16(h[0][2], h[0][3]); w.z = cvt_pk_bf16(h[1][0], h[1][1]); w.w = cvt_pk_bf16(h[1][2], h[1][3]); *(u32x4*)rp = w; }
                    if (m < 3) {
#pragma unroll
                        for (int n = 0; n < 2; ++n)
#pragma unroll
                            for (int j = 0; j < 4; ++j) hg[n][j] = __shfl(h[n][j], lastl);
                    }
                }
            }
        }
    }
};

struct EpiGateMul {
    static constexpr bool WITH_LDS = false, PERM = true;
    bf16_t* Z; const bf16_t* RB;
    __device__ __forceinline__ void operator()(const f32x4 (&acc)[2][2][4][2], const Unit& u, int wr, int wc, int fr_, int fq_) const {
        int fr = fr_, fq = fq_; asm volatile("" : "+v"(fr), "+v"(fq));
        const int col0 = u.pn * BM + wc * 32 + fq * 8;
        const size_t off0 = (size_t)(u.pm * BM + wr * 64 + fr) * DRNN + col0;
#pragma unroll
        for (int ai = 0; ai < 2; ++ai)
#pragma unroll
            for (int m = 0; m < 4; ++m) { const size_t o_ = off0 + (size_t)(ai * HALF + m * 16) * DRNN;
                u32x4 cf[2], cb[2];
#pragma unroll
                for (int bj = 0; bj < 2; ++bj) { cf[bj] = *(const u32x4*)(Z + o_ + bj * HALF); cb[bj] = *(const u32x4*)(RB + o_ + bj * HALF); }
#pragma unroll
                for (int bj = 0; bj < 2; ++bj) { const f32x4 v0 = acc[ai][bj][m][0], v1 = acc[ai][bj][m][1];
                    const f32x4 r0 = bf4_to_f32((u32x2){cf[bj].x, cf[bj].y}) + bf4_to_f32((u32x2){cb[bj].x, cb[bj].y}), r1 = bf4_to_f32((u32x2){cf[bj].z, cf[bj].w}) + bf4_to_f32((u32x2){cb[bj].z, cb[bj].w});
                    f32x4 o0, o1;
#pragma unroll
                    for (int j = 0; j < 4; ++j) { const float x = v0[j]; o0[j] = x * fsigmoid(1.5957691216057308f * (x + 0.044715f * x * x * x)) * r0[j];
                                                  const float y = v1[j]; o1[j] = y * fsigmoid(1.5957691216057308f * (y + 0.044715f * y * y * y)) * r1[j]; }
                    u32x4 w; w.x = cvt_pk_bf16(o0[0], o0[1]); w.y = cvt_pk_bf16(o0[2], o0[3]); w.z = cvt_pk_bf16(o1[0], o1[1]); w.w = cvt_pk_bf16(o1[2], o1[3]);
                    *(u32x4*)(Z + o_ + bj * HALF) = w; }
                asm volatile("" ::: "memory"); }
    }
};
}


#define XB_TMO      128
#define XB_XCNT(j)  (256  + 64 * (j))
#define XB_XSUB(j)  (1280 + 64 * (j))
#define XB_XGEN(j)  (2304 + 64 * (j))
#define XB_TOP      3328
#define XB_TOPGEN   3392
#define XCD_BAR_WORDS 3456
#define XB_SPIN_CAP (1u << 18)
__device__ __forceinline__ unsigned xb_ld(unsigned* p)              { return __hip_atomic_load(p, __ATOMIC_RELAXED, __HIP_MEMORY_SCOPE_AGENT); }
__device__ __forceinline__ unsigned xb_add(unsigned* p, unsigned v) { return __hip_atomic_fetch_add(p, v, __ATOMIC_RELAXED, __HIP_MEMORY_SCOPE_AGENT); }
__device__ __forceinline__ unsigned xb_xcc_id() { return (unsigned)__builtin_amdgcn_s_getreg((3 << 11) | 20) & 0xFu; }
#define XB_SPIN(cond, bar) do { unsigned _sp = 0; while (cond) { __builtin_amdgcn_s_sleep(1); \
    if ((++_sp & 255u) == 0u) { if (xb_ld(&(bar)[XB_TMO])) break; if (_sp > XB_SPIN_CAP) { atomicAdd(&(bar)[XB_TMO], 1u); break; } } } } while (0)
struct XcdBarrier { unsigned* bar; unsigned x; volatile LAS unsigned* st; };
__device__ __forceinline__ XcdBarrier xcd_barrier_post(unsigned* bar, volatile LAS unsigned* st) {
    XcdBarrier b; b.bar = bar; b.x = xb_xcc_id(); b.st = st;
    if (threadIdx.x == 0) (void)xb_add(&bar[XB_XCNT(b.x)], 1u);
    return b;
}
__device__ __forceinline__ void xcd_barrier_complete(unsigned* bar, unsigned x, unsigned& nloc, unsigned& nx) {
    const unsigned G = gridDim.x * gridDim.y * gridDim.z;
    unsigned sum, cnt, mine, sp = 0u;
    for (;;) {
        sum = 0u; cnt = 0u; mine = 0u;
#pragma unroll
        for (unsigned j = 0; j < 16; ++j) { const unsigned c = xb_ld(&bar[XB_XCNT(j)]); sum += c; cnt += (c > 0u) ? 1u : 0u; mine = (j == x) ? c : mine; }
        if (sum == G) break;
        __builtin_amdgcn_s_sleep(1);
        if ((++sp & 255u) == 0u) { if (xb_ld(&bar[XB_TMO])) break; if (sp > XB_SPIN_CAP) { atomicAdd(&bar[XB_TMO], 1u); break; } }
    }
    nloc = mine > 0u ? mine : 1u; nx = cnt > 0u ? cnt : 1u;
}
__device__ __forceinline__ void xcd_barrier(const XcdBarrier& b) {
    asm volatile("s_waitcnt vmcnt(0)" ::: "memory");
    __syncthreads();
    if (threadIdx.x == 0) {
        unsigned* bar = b.bar;
        __builtin_amdgcn_s_waitcnt(0);
        unsigned nloc = b.st[0], nx = b.st[1];
        if (nloc == 0u) { xcd_barrier_complete(bar, b.x, nloc, nx); b.st[0] = nloc; b.st[1] = nx; }
        const unsigned old = xb_add(&bar[XB_XSUB(b.x)], 1u);
        const unsigned gen = old / nloc;
        if (old + 1u == (gen + 1u) * nloc) {
            __builtin_amdgcn_fence(__ATOMIC_RELEASE, "agent");
            asm volatile("s_waitcnt vmcnt(0)" ::: "memory");
            const unsigned og = xb_add(&bar[XB_TOP], 1u);
            const unsigned tg = og / nx;
            if (og + 1u == (tg + 1u) * nx) xb_add(&bar[XB_TOPGEN], 1u);
            else XB_SPIN(xb_ld(&bar[XB_TOPGEN]) == tg, bar);
            __builtin_amdgcn_fence(__ATOMIC_ACQUIRE, "agent");
            xb_add(&bar[XB_XGEN(b.x)], 1u);
            asm volatile("s_waitcnt vmcnt(0)" ::: "memory");
        } else {
            XB_SPIN(xb_ld(&bar[XB_XGEN(b.x)]) == gen, bar);
            __builtin_amdgcn_fence(__ATOMIC_ACQUIRE, "agent");
            asm volatile("s_waitcnt vmcnt(0)" ::: "memory");
        }
    }
    __syncthreads();
}

struct Params {
    const float *x, *c, *ctx, *c_ctx, *ada_w, *ada_b, *norm_g, *mlp_w1, *mlp_w2, *w_qkv, *w_o, *sink;
    const float *w_in, *conv_w, *conv_b, *w_a, *b_a, *w_i, *b_i, *lam, *w_out;
    float* out; unsigned char* ws;
};

typedef const __attribute__((address_space(4))) Params* ParamsK;
__device__ __forceinline__ void transpose_item(const float* W, int ldw, bf16_t* WT, int ldwt, int k0, int n0, int dst_row0, LAS float* scr, int lane) {
#pragma unroll 8
    for (int i = 0; i < 32; ++i) { const int kk = 2 * i + (lane >> 5); scr[kk * 33 + (lane & 31)] = W[(size_t)(k0 + kk) * ldw + n0 + (lane & 31)]; }
    asm volatile("s_waitcnt lgkmcnt(0)" ::: "memory");
    const int c = lane & 7;
#pragma unroll
    for (int j = 0; j < 4; ++j) { const int n = (lane >> 3) + 8 * j; const LAS float* s = scr + (8 * c) * 33 + n;
        u32x4 o; o.x = cvt_pk_bf16(s[0 * 33], s[1 * 33]); o.y = cvt_pk_bf16(s[2 * 33], s[3 * 33]); o.z = cvt_pk_bf16(s[4 * 33], s[5 * 33]); o.w = cvt_pk_bf16(s[6 * 33], s[7 * 33]);
        *(u32x4*)(WT + (size_t)(dst_row0 + n) * ldwt + k0 + 8 * c) = o; }
    asm volatile("s_waitcnt lgkmcnt(0)" ::: "memory");
}
__device__ __forceinline__ void transpose_plain(const float* W, int K, int N, bf16_t* WT, int r, LAS float* scr, int lane) {
    const int nblk = N / 32, kb = r / nblk, nb = r % nblk;
    transpose_item(W, N, WT, K, 64 * kb, 32 * nb, 32 * nb, scr, lane);
}

constexpr int I_QKV = 16 * 48, I_O = 16 * 32, I_1 = 16 * 128, I_2 = 64 * 32, I_IN = 16 * 80, I_OUT = 20 * 32, I_G = 40 * 16;
constexpr int TR_L0 = I_QKV + I_O + I_1 + I_2, TR_LRU = I_IN + I_OUT + I_G, TR_MLP1 = I_1 + I_2;
struct TrItem { const float* W; bf16_t* WT; int ldw, ldwt, k0, n0, drow; };
__device__ __forceinline__ TrItem tr_decode(ParamsK p, unsigned char* ws, int it) {
    TrItem d; int r = it;
#define TR_PLAIN(Wp, K_, N_, WTp) do { const int nblk_ = (N_) / 32, kb_ = r / nblk_, nb_ = r % nblk_; d.W = (Wp); d.WT = (WTp); d.ldw = (N_); d.ldwt = (K_); d.k0 = 64 * kb_; d.n0 = 32 * nb_; d.drow = 32 * nb_; return d; } while (0)
    if (r < I_QKV) TR_PLAIN(p->w_qkv, 1024, NQKV, (bf16_t*)(ws + WS_WQKV)); r -= I_QKV;
    if (r < I_O) TR_PLAIN(p->w_o, 1024, 1024, (bf16_t*)(ws + WS_WO)); r -= I_O;
    if (r < I_1) TR_PLAIN(p->mlp_w1, 1024, DFF, (bf16_t*)(ws + WS_W1)); r -= I_1;
    if (r < I_2) TR_PLAIN(p->mlp_w2, DFF, 1024, (bf16_t*)(ws + WS_W2)); r -= I_2;
    if (r < I_IN) TR_PLAIN(p->w_in, 1024, 2 * DRNN, (bf16_t*)(ws + WS_WIN)); r -= I_IN;
    if (r < I_OUT) TR_PLAIN(p->w_out, DRNN, 1024, (bf16_t*)(ws + WS_WOUT)); r -= I_OUT;
    if (r < I_G) {
        const int sm = r >> 4, ii = r & 15, kb = ii >> 2, nb = ii & 3;
        const int chalf = sm & 1, blk = (sm >> 1) % 5, dg = (sm >> 1) / 5, gate = dg & 1, dir = dg >> 1;
        d.W = (gate ? p->w_i : p->w_a) + (size_t)(dir * 5 + blk) * 256 * 256; d.WT = (bf16_t*)(ws + WS_WG); d.ldw = 256; d.ldwt = 256;
        d.k0 = 64 * kb; d.n0 = chalf * 128 + nb * 32; d.drow = ((dir * 5 + blk) * 2 + chalf) * 256 + gate * 128 + nb * 32; return d; }
    r -= I_G;
    if (r < I_1) TR_PLAIN(p->mlp_w1 + (size_t)1024 * DFF, 1024, DFF, (bf16_t*)(ws + WS_W1 + 16 * MiB)); r -= I_1;
    TR_PLAIN(p->mlp_w2 + (size_t)1024 * DFF, DFF, 1024, (bf16_t*)(ws + WS_W2 + 16 * MiB));
#undef TR_PLAIN
}
__device__ __forceinline__ void transpose_range(ParamsK p, unsigned char* ws, LAS unsigned char* lds, int first, int count, int w, int nw, int wave, int lane) {
    LAS float* scr = (LAS float*)(lds + wave * 16384);
    int it = first + w; if (it >= first + count) return;
    float cur[32], nxt[32];
    TrItem d = tr_decode(p, ws, it);
#pragma unroll
    for (int i = 0; i < 32; ++i) cur[i] = d.W[(size_t)(d.k0 + 2 * i + (lane >> 5)) * d.ldw + d.n0 + (lane & 31)];
    for (;;) {
        const int itn = it + nw; const bool more = itn < first + count;
        TrItem dn = d;
        if (more) { dn = tr_decode(p, ws, itn);
#pragma unroll
            for (int i = 0; i < 32; ++i) nxt[i] = dn.W[(size_t)(dn.k0 + 2 * i + (lane >> 5)) * dn.ldw + dn.n0 + (lane & 31)]; }
#pragma unroll
        for (int i = 0; i < 32; ++i) scr[(2 * i + (lane >> 5)) * 33 + (lane & 31)] = cur[i];
        asm volatile("s_waitcnt lgkmcnt(0)" ::: "memory");
        const int c = lane & 7;
#pragma unroll
        for (int j = 0; j < 4; ++j) { const int n = (lane >> 3) + 8 * j; const LAS float* s = scr + (8 * c) * 33 + n;
            u32x4 o; o.x = cvt_pk_bf16(s[0 * 33], s[1 * 33]); o.y = cvt_pk_bf16(s[2 * 33], s[3 * 33]); o.z = cvt_pk_bf16(s[4 * 33], s[5 * 33]); o.w = cvt_pk_bf16(s[6 * 33], s[7 * 33]);
            *(u32x4*)(d.WT + (size_t)(d.drow + n) * d.ldwt + d.k0 + 8 * c) = o; }
        asm volatile("s_waitcnt lgkmcnt(0)" ::: "memory");
        if (!more) break;
#pragma unroll
        for (int i = 0; i < 32; ++i) cur[i] = nxt[i];
        d = dn; it = itn;
    }
}
__device__ __forceinline__ void idle_transposes(ParamsK p, unsigned char* ws, LAS unsigned char* lds, int first, int count, int nwg, int G, int bid, int wave, int lane) {
    const int rem = nwg % G;
    if (rem == 0) transpose_range(p, ws, lds, first, count, bid * 8 + wave, G * 8, wave, lane);
    else if (bid >= rem) transpose_range(p, ws, lds, first, count, (bid - rem) * 8 + wave, (G - rem) * 8, wave, lane);
    __syncthreads();
}

__device__ __forceinline__ void prologue(ParamsK p, LAS unsigned char* lds, int tid, int lane, int wave) {
    unsigned char* ws = p->ws;
    float* MOD = (float*)(ws + WS_MOD);
    if (blockIdx.x < 192) {
        LAS float* sl = (LAS float*)lds;
        LAS float* red = (LAS float*)(lds + 36864);
        for (int idx = tid; idx < 9216; idx += 512) { const int w = idx >> 10, k = idx & 1023; const float v = (w < 8) ? p->c[w * 1024 + k] : p->c_ctx[k]; sl[idx] = v / (1.0f + __expf(-v)); }
        __syncthreads();
        const int l = blockIdx.x / 96, n0 = (blockIdx.x % 96) * 64, kg = tid >> 4, cq = tid & 15;
        f32x4 acc[9];
#pragma unroll
        for (int w = 0; w < 9; ++w) acc[w] = (f32x4){0.f, 0.f, 0.f, 0.f};
        const float* wb = p->ada_w + (size_t)l * 1024 * 6144 + n0 + cq * 4;
#pragma unroll 1
        for (int it0 = 0; it0 < 32; it0 += 8) {
            f32x4 w4[8];
#pragma unroll
            for (int u = 0; u < 8; ++u) w4[u] = *(const f32x4*)(wb + (size_t)((it0 + u) * 32 + kg) * 6144);
#pragma unroll
            for (int u = 0; u < 8; ++u) { const int k = (it0 + u) * 32 + kg;
#pragma unroll
                for (int w = 0; w < 9; ++w) acc[w] += sl[w * 1024 + k] * w4[u]; }
        }
#pragma unroll
        for (int w = 0; w < 9; ++w) *(LAS f32x4*)(red + (kg * 9 + w) * 64 + cq * 4) = acc[w];
        __syncthreads();
        for (int idx = tid; idx < 9 * 64; idx += 512) { const int w = idx >> 6, n = idx & 63; float s = 0.f;
#pragma unroll
            for (int g = 0; g < 32; ++g) s += red[(g * 9 + w) * 64 + n];
            MOD[(size_t)(l * 9 + w) * 6144 + n0 + n] = s + p->ada_b[l * 6144 + n0 + n]; }
        __syncthreads();
    }
    if (blockIdx.x == gridDim.x - 1) {
        float* rope = (float*)(ws + WS_ROPE); float* nls = (float*)(ws + WS_NLS);
        for (int idx = tid; idx < 1024; idx += 512) { const int pos = idx >> 4, i = idx & 15;
            const float inv = __builtin_exp2f(-(float)i * (13.287712379549449f / 16.0f));
            const float angf = (float)pos * inv; const double ang = (double)angf;
            const double twopi = 6.283185307179586476925287; const double r = ang - twopi * __builtin_rint(ang / twopi);
            const double r2 = r * r; double cterm = 1.0, sterm = r, cs = 1.0, sn = r;
            for (int k = 1; k <= 14; ++k) { cterm *= -r2 / (double)((2 * k - 1) * (2 * k)); sterm *= -r2 / (double)((2 * k) * (2 * k + 1)); cs += cterm; sn += sterm; }
            rope[idx * 2] = (float)cs; rope[idx * 2 + 1] = (float)sn; }
        for (int idx = tid; idx < 2 * DRNN; idx += 512) { const float lm = p->lam[idx]; nls[idx] = -8.0f * log1pf(__expf(-lm)); }
        { unsigned* fl = (unsigned*)(ws + WS_FLAG); for (int idx = tid; idx < 1440 * 16; idx += 512) fl[idx] = 0u; }
        if (tid < 2) ((unsigned*)(ws + WS_CNT))[tid * 16] = 0u;
    }
    transpose_range(p, ws, lds, 0, TR_L0 + TR_LRU + TR_MLP1, blockIdx.x * 8 + wave, gridDim.x * 8, wave, lane);
}

template <bool HAS_Y, bool HAS_H, bool XIN_BF, bool XOUT_BF>
__device__ __forceinline__ void row_phase(const void* xin_lat, const void* xin_ctx, void* xout_lat, void* xout_ctx, const bf16_t* Y, const bf16_t* SLAB, bf16_t* H,
                                          const float* gy, const float* gh, const float* mod_g, int gate_idx, const float* mod_h, int shift_idx, int scale_idx,
                                          int nrows, int gw, int ngw, int lane) {
    const int rpw = (nrows + ngw - 1) / ngw, r_begin = gw * rpw, r_end = (r_begin + rpw < nrows) ? r_begin + rpw : nrows;
#define RCOL(k) (((k) >> 1) * 512 + lane * 8 + ((k) & 1) * 4)
#define BF8_LO(V_) bf4_to_f32((u32x2){(V_).x, (V_).y})
#define BF8_HI(V_) bf4_to_f32((u32x2){(V_).z, (V_).w})
    f32x4 xn[4]; u32x4 xb[2], yn[2], ys[3][2];
    f32x4 vgy[4], vgh[4], vgt[4], vsh[4], vsc[4];
#pragma unroll
    for (int k = 0; k < 4; ++k) { if (HAS_Y) vgy[k] = *(const f32x4*)(gy + RCOL(k)); if (HAS_H) vgh[k] = *(const f32x4*)(gh + RCOL(k)); }
    int cur_who = -1;
#define ROW_LOAD(r) do { const int r_ = (r); const bool lat_ = r_ < ML; const size_t ro_ = lat_ ? (size_t)r_ * DM : (size_t)(r_ - ML) * DM; \
        if (XIN_BF) { const bf16_t* xi_ = (const bf16_t*)(lat_ ? xin_lat : xin_ctx) + ro_; _Pragma("unroll") for (int j = 0; j < 2; ++j) xb[j] = *(const u32x4*)(xi_ + j * 512 + lane * 8); } \
        else { const float* xi_ = (const float*)(lat_ ? xin_lat : xin_ctx) + ro_; _Pragma("unroll") for (int k = 0; k < 4; ++k) xn[k] = *(const f32x4*)(xi_ + RCOL(k)); } \
        if (HAS_Y) { if (SLAB != nullptr && !lat_) { const bf16_t* yp_ = SLAB + (size_t)(r_ - ML) * DM + lane * 8; \
                _Pragma("unroll") for (int j = 0; j < 2; ++j) { yn[j] = *(const u32x4*)(yp_ + 512 * j); ys[0][j] = *(const u32x4*)(yp_ + 512 * j + (size_t)MC * DM); ys[1][j] = *(const u32x4*)(yp_ + 512 * j + (size_t)2 * MC * DM); ys[2][j] = *(const u32x4*)(yp_ + 512 * j + (size_t)3 * MC * DM); } } \
            else { _Pragma("unroll") for (int j = 0; j < 2; ++j) yn[j] = *(const u32x4*)(Y + (size_t)r_ * DM + j * 512 + lane * 8); } } } while (0)
    if (r_begin < r_end) ROW_LOAD(r_begin);
    for (int row = r_begin; row < r_end; ++row) {
        const bool lat = row < ML; const int who = lat ? (row >> 11) : 8;
        if (who != cur_who) { cur_who = who;
#pragma unroll
            for (int k = 0; k < 4; ++k) { const int col = RCOL(k);
                if (HAS_Y) vgt[k] = *(const f32x4*)(mod_g + (size_t)who * 6144 + gate_idx * 1024 + col);
                if (HAS_H) { vsh[k] = *(const f32x4*)(mod_h + (size_t)who * 6144 + shift_idx * 1024 + col); vsc[k] = *(const f32x4*)(mod_h + (size_t)who * 6144 + scale_idx * 1024 + col) + 1.0f; } } }
        f32x4 xv[4], yv[4];
#pragma unroll
        for (int j = 0; j < 2; ++j) { xv[2 * j] = XIN_BF ? BF8_LO(xb[j]) : xn[2 * j]; xv[2 * j + 1] = XIN_BF ? BF8_HI(xb[j]) : xn[2 * j + 1]; }
        if (HAS_Y) {
#pragma unroll
            for (int j = 0; j < 2; ++j) { yv[2 * j] = BF8_LO(yn[j]); yv[2 * j + 1] = BF8_HI(yn[j]);
                if (SLAB != nullptr && !lat) { yv[2 * j] = (yv[2 * j] + BF8_LO(ys[0][j])) + (BF8_LO(ys[1][j]) + BF8_LO(ys[2][j])); yv[2 * j + 1] = (yv[2 * j + 1] + BF8_HI(ys[0][j])) + (BF8_HI(ys[1][j]) + BF8_HI(ys[2][j])); } }
        }
        asm volatile("" ::: "memory");
        if (row + 1 < r_end) ROW_LOAD(row + 1);
        if (HAS_Y) {
            float s = 0.f;
#pragma unroll
            for (int k = 0; k < 4; ++k) s += (yv[k][0] * yv[k][0] + yv[k][1] * yv[k][1]) + (yv[k][2] * yv[k][2] + yv[k][3] * yv[k][3]);
            const float rstd = 1.0f / sqrtf(wave_sum(s) * (1.0f / DM) + EPS);
            const size_t ro = lat ? (size_t)row * DM : (size_t)(row - ML) * DM;
#pragma unroll
            for (int k = 0; k < 4; ++k) xv[k] = xv[k] + vgt[k] * (yv[k] * rstd * vgy[k]);
            if (XOUT_BF) {
#pragma unroll
                for (int j = 0; j < 2; ++j) { u32x4 w; w.x = cvt_pk_bf16(xv[2 * j][0], xv[2 * j][1]); w.y = cvt_pk_bf16(xv[2 * j][2], xv[2 * j][3]); w.z = cvt_pk_bf16(xv[2 * j + 1][0], xv[2 * j + 1][1]); w.w = cvt_pk_bf16(xv[2 * j + 1][2], xv[2 * j + 1][3]);
                    *(u32x4*)((bf16_t*)(lat ? xout_lat : xout_ctx) + ro + j * 512 + lane * 8) = w; xv[2 * j] = BF8_LO(w); xv[2 * j + 1] = BF8_HI(w); }
            } else {
#pragma unroll
                for (int k = 0; k < 4; ++k) *(f32x4*)((float*)(lat ? xout_lat : xout_ctx) + ro + RCOL(k)) = xv[k];
            }
        }
        if (HAS_H) {
            float s = 0.f;
#pragma unroll
            for (int k = 0; k < 4; ++k) s += (xv[k][0] * xv[k][0] + xv[k][1] * xv[k][1]) + (xv[k][2] * xv[k][2] + xv[k][3] * xv[k][3]);
            const float rstd = 1.0f / sqrtf(wave_sum(s) * (1.0f / DM) + EPS);
#pragma unroll
            for (int j = 0; j < 2; ++j) { const f32x4 h0 = (xv[2 * j] * rstd * vgh[2 * j]) * vsc[2 * j] + vsh[2 * j], h1 = (xv[2 * j + 1] * rstd * vgh[2 * j + 1]) * vsc[2 * j + 1] + vsh[2 * j + 1];
                u32x4 w; w.x = cvt_pk_bf16(h0[0], h0[1]); w.y = cvt_pk_bf16(h0[2], h0[3]); w.z = cvt_pk_bf16(h1[0], h1[1]); w.w = cvt_pk_bf16(h1[2], h1[3]);
                *(u32x4*)(H + (size_t)row * DM + j * 512 + lane * 8) = w; }
        }
    }
#undef ROW_LOAD
#undef RCOL
#undef BF8_LO
#undef BF8_HI
}

__device__ __forceinline__ void attn_phase(LAS unsigned char* lds, const bf16_t* Q, bf16_t* O, const bf16_t* Kb, const bf16_t* VT, const bf16_t* VTC, const float* sink, int u_first, int u_end, int u_stride, int tid, int lane, int wave) {
    constexpr int PITCH = 72;
    LAS bf16_t* Ks = (LAS bf16_t*)lds;
    LAS bf16_t* Vs = (LAS bf16_t*)(lds + 2 * 64 * PITCH * 2);
    const int lr = lane & 15, lg = lane >> 4;
    const int skey = tid >> 3, spiece = tid & 7;
    for (int unit = u_first; unit < u_end; unit += u_stride) {
        int b, kvh, qrow0, qblk, nloc, lt0; bool latu = unit < 512;
        if (latu) { b = unit >> 6; const int rem = unit & 63; qblk = rem >> 2; kvh = rem & 3; qrow0 = b * SEQ + qblk * 128; lt0 = (qblk == 0) ? 2 : 0; nloc = ((qblk == 15) ? 4 : 6) - lt0; }
        else { const int cu = unit - 512; b = cu >> 3; kvh = (cu & 7) >> 1; qblk = 0; qrow0 = ML + b * CTX + (cu & 1) * 128; lt0 = 0; nloc = 0; }
        const int nlo = (latu && qblk > 0) ? 2 : 0, nmid = latu ? 2 : 0, nup = (latu && qblk < 15) ? 2 : 0;
        const int n1 = nlo, n2 = nlo + nmid, n3 = n2 + 4, nT = n3 + nup; (void)nloc; (void)lt0;
        const int head = kvh * 4 + (wave >> 1);
        const int qr0 = qrow0 + (wave & 1) * 64;
        const bf16_t* qbase = Q + (size_t)qr0 * 1024 + head * 64;
        bf16_t* obase = O + (size_t)qr0 * 1024 + head * 64;
        LAS unsigned char* Qs = lds + 40960 + wave * 8192;
#pragma unroll
        for (int qt = 0; qt < 4; ++qt)
#pragma unroll
            for (int dh = 0; dh < 2; ++dh) *(LAS bf16x8*)(Qs + (qt * 2 + dh) * 1024 + lane * 16) = *(const bf16x8*)(qbase + (unsigned)((qt * 16 + lr) * 1024 + dh * 32 + lg * 8));
        f32x4 o[4][4];
#pragma unroll
        for (int qt = 0; qt < 4; ++qt)
#pragma unroll
            for (int dt = 0; dt < 4; ++dt) o[qt][dt] = (f32x4){0.f, 0.f, 0.f, 0.f};
        float m2[4], ls[4];
        { const float sk = sink[head] * LOG2E;
#pragma unroll
          for (int qt = 0; qt < 4; ++qt) { m2[qt] = sk; ls[qt] = (lg == 0) ? 1.0f : 0.0f; } }
        u32x4 kreg, vreg;
#define ATT_TOK0(j_) ((qblk - 1) * 128 + (((j_) < n1) ? (j_) : (((j_) < n2) ? 2 + (j_) - n1 : 4 + (j_) - n3)) * 64)
#define ATT_LOAD(j) do { const int _j = (j); if (_j < n2 || _j >= n3) { const int tok0 = ATT_TOK0(_j); \
                const bf16_t* kb_ = Kb + (size_t)(b * SEQ + tok0) * 256 + kvh * 64; const bf16_t* vb_ = VT + (size_t)(b * 4 + kvh) * 64 * SEQ + tok0; \
                kreg = *(const u32x4*)(kb_ + (unsigned)(skey * 256 + spiece * 8)); vreg = *(const u32x4*)(vb_ + (unsigned)(skey * SEQ + spiece * 8)); } \
            else { const int tok0 = (_j - n2) * 64; \
                const bf16_t* kb_ = Kb + (size_t)(ML + b * CTX + tok0) * 256 + kvh * 64; const bf16_t* vb_ = VTC + (size_t)(b * 4 + kvh) * 64 * CTX + tok0; \
                kreg = *(const u32x4*)(kb_ + (unsigned)(skey * 256 + spiece * 8)); vreg = *(const u32x4*)(vb_ + (unsigned)(skey * CTX + spiece * 8)); } } while (0)
#define ATT_STORE(buf) do { *(LAS u32x4*)(Ks + (buf) * 64 * PITCH + skey * PITCH + spiece * 8) = kreg; *(LAS u32x4*)(Vs + (buf) * 64 * PITCH + skey * PITCH + spiece * 8) = vreg; } while (0)
        __syncthreads();
        ATT_LOAD(0); ATT_STORE(0);
        __syncthreads();
#define ATT_BODY(MM) { \
            const int buf = j & 1; \
            if (j + 1 < nT) ATT_LOAD(j + 1); \
            const LAS bf16_t* Kt = Ks + buf * 64 * PITCH; const LAS bf16_t* Vt = Vs + buf * 64 * PITCH; \
            const int ktok0 = ATT_TOK0(j); \
            bf16x8 kf[4][2]; \
            _Pragma("unroll") \
            for (int ks = 0; ks < 4; ++ks) \
            _Pragma("unroll") \
                for (int dh = 0; dh < 2; ++dh) kf[ks][dh] = *(const LAS bf16x8*)(Kt + (ks * 16 + lr) * PITCH + dh * 32 + lg * 8); \
            _Pragma("unroll") \
            for (int hq = 0; hq < 2; ++hq) { \
            bf16x8 pb[2][2]; \
            _Pragma("unroll") \
            for (int q2 = 0; q2 < 2; ++q2) { \
                const int qt = hq * 2 + q2; \
                f32x4 s[4]; \
                const bf16x8 qf0 = *(const LAS bf16x8*)(Qs + (qt * 2 + 0) * 1024 + lane * 16), qf1 = *(const LAS bf16x8*)(Qs + (qt * 2 + 1) * 1024 + lane * 16); \
            _Pragma("unroll") \
                for (int ks = 0; ks < 4; ++ks) { s[ks] = __builtin_amdgcn_mfma_f32_16x16x32_bf16(kf[ks][0], qf0, (f32x4){0.f, 0.f, 0.f, 0.f}, 0, 0, 0); \
                    s[ks] = __builtin_amdgcn_mfma_f32_16x16x32_bf16(kf[ks][1], qf1, s[ks], 0, 0, 0); } \
                if (MM == 1) {    \
                    const int lim = qblk * 128 + (wave & 1) * 64 + qt * 16 + lr - 128 - ktok0 - lg * 4; \
            _Pragma("unroll") \
                    for (int ks = 0; ks < 4; ++ks) \
            _Pragma("unroll") \
                        for (int jj = 0; jj < 4; ++jj) s[ks][jj] = (ks * 16 + jj >= lim) ? s[ks][jj] : -1e30f; \
                } else if (MM == 2) {    \
                    const int lim = qblk * 128 + (wave & 1) * 64 + qt * 16 + lr + 128 - ktok0 - lg * 4; \
            _Pragma("unroll") \
                    for (int ks = 0; ks < 4; ++ks) \
            _Pragma("unroll") \
                        for (int jj = 0; jj < 4; ++jj) s[ks][jj] = (ks * 16 + jj <= lim) ? s[ks][jj] : -1e30f; \
                } \
                float mx = -3e38f; \
            _Pragma("unroll") \
                for (int ks = 0; ks < 4; ++ks) mx = fmaxf(mx, fmaxf(fmaxf(s[ks][0], s[ks][1]), fmaxf(s[ks][2], s[ks][3]))); \
                mx = fmaxf(mx, __shfl_xor(mx, 16)); mx = fmaxf(mx, __shfl_xor(mx, 32)); \
                const float mnew = fmaxf(m2[qt], mx * LOG2E); \
                const float alpha = __builtin_amdgcn_exp2f(m2[qt] - mnew); \
                m2[qt] = mnew; \
                float rs = 0.f; \
            _Pragma("unroll") \
                for (int ks = 0; ks < 4; ++ks) \
            _Pragma("unroll") \
                    for (int jj = 0; jj < 4; ++jj) { const float pv = __builtin_amdgcn_exp2f(s[ks][jj] * LOG2E - mnew); s[ks][jj] = pv; rs += pv; } \
                ls[qt] = ls[qt] * alpha + rs; \
            _Pragma("unroll") \
                for (int dt = 0; dt < 4; ++dt) o[qt][dt] = o[qt][dt] * alpha; \
            _Pragma("unroll") \
                for (int c2 = 0; c2 < 2; ++c2) { u32x4 w; w.x = cvt_pk_bf16(s[2 * c2][0], s[2 * c2][1]); w.y = cvt_pk_bf16(s[2 * c2][2], s[2 * c2][3]); w.z = cvt_pk_bf16(s[2 * c2 + 1][0], s[2 * c2 + 1][1]); w.w = cvt_pk_bf16(s[2 * c2 + 1][2], s[2 * c2 + 1][3]); \
                    pb[q2][c2] = __builtin_bit_cast(bf16x8, w); } \
            } \
            _Pragma("unroll") \
            for (int c2 = 0; c2 < 2; ++c2) \
            _Pragma("unroll") \
                for (int dt = 0; dt < 4; ++dt) { \
                    const LAS bf16_t* vp = Vt + (dt * 16 + lr) * PITCH + c2 * 32 + lg * 4; \
                    const u32x2 v0 = *(const LAS u32x2*)vp, v1 = *(const LAS u32x2*)(vp + 16); \
                    const u32x4 vv = {v0.x, v0.y, v1.x, v1.y}; \
                    const bf16x8 vf = __builtin_bit_cast(bf16x8, vv); \
            _Pragma("unroll") \
                    for (int q2 = 0; q2 < 2; ++q2) o[hq * 2 + q2][dt] = __builtin_amdgcn_mfma_f32_16x16x32_bf16(vf, pb[q2][c2], o[hq * 2 + q2][dt], 0, 0, 0); \
                } \
            } \
            if (j + 1 < nT) ATT_STORE(buf ^ 1); \
            __syncthreads(); \
        }
        int j = 0;
#pragma unroll 1
        for (; j < n1; ++j) ATT_BODY(1)
#pragma unroll 1
        for (; j < n3; ++j) ATT_BODY(0)
#pragma unroll 1
        for (; j < nT; ++j) ATT_BODY(2)
#undef ATT_BODY
#pragma unroll
        for (int qt = 0; qt < 4; ++qt) {
            float l = ls[qt]; l += __shfl_xor(l, 16); l += __shfl_xor(l, 32);
            const float inv = 1.0f / l;
            int lro = lr * 1024 + lg * 4; asm volatile("" : "+v"(lro));
            bf16_t* op = obase + (unsigned)(qt * 16 * 1024 + lro);
#pragma unroll
            for (int dt = 0; dt < 4; ++dt) *(u32x2*)(op + dt * 16) = f32_to_bf4(o[qt][dt] * inv);
        }
    }
#undef ATT_LOAD
#undef ATT_TOK0
#undef ATT_STORE
}

__device__ __forceinline__ void conv_phase(const bf16_t* R, bf16_t* U, const float* cw, const float* cb, int gtid, int nthreads) {
    for (int idx = gtid; idx < MT * 160; idx += nthreads) {
        const int row = idx / 160, ch = (idx % 160) * 8;
        int t, T; if (row < ML) { t = row & 2047; T = SEQ; } else { t = (row - ML) & 255; T = CTX; }
        float acc[8];
        { const f32x4 b0 = *(const f32x4*)(cb + ch), b1 = *(const f32x4*)(cb + ch + 4); acc[0] = b0[0]; acc[1] = b0[1]; acc[2] = b0[2]; acc[3] = b0[3]; acc[4] = b1[0]; acc[5] = b1[1]; acc[6] = b1[2]; acc[7] = b1[3]; }
#pragma unroll
        for (int tap = 0; tap < 4; ++tap) { const int tt = t + tap - 2;
            if (tt >= 0 && tt < T) { const u32x4 rv = *(const u32x4*)(R + (size_t)(row + tap - 2) * DRNN + ch);
                const f32x4 w0 = *(const f32x4*)(cw + tap * DRNN + ch), w1 = *(const f32x4*)(cw + tap * DRNN + ch + 4);
                acc[0] += w0[0] * bf_lo(rv.x); acc[1] += w0[1] * bf_hi(rv.x); acc[2] += w0[2] * bf_lo(rv.y); acc[3] += w0[3] * bf_hi(rv.y);
                acc[4] += w1[0] * bf_lo(rv.z); acc[5] += w1[1] * bf_hi(rv.z); acc[6] += w1[2] * bf_lo(rv.w); acc[7] += w1[3] * bf_hi(rv.w); } }
        u32x4 o; o.x = cvt_pk_bf16(acc[0], acc[1]); o.y = cvt_pk_bf16(acc[2], acc[3]); o.z = cvt_pk_bf16(acc[4], acc[5]); o.w = cvt_pk_bf16(acc[6], acc[7]);
        *(u32x4*)(U + (size_t)row * DRNN + ch) = o;
    }
}
__device__ __forceinline__ int scan_row0(int bl, int c) { return (c < 8) ? (8192 + bl * CTX + c * 32) : (bl * SEQ + (c - 8) * 32); }
__device__ __forceinline__ void scanA_phase(const bf16_t* LA, const bf16_t* BX, float* SP, float* SH, int gtid, int nthreads) {
    for (int idx = gtid; idx < 2 * 4 * 72 * 640; idx += nthreads) {
        const int cp = idx % 640, r1 = idx / 640, c = r1 % 72, r2 = r1 / 72, bl = r2 & 3, dir = r2 >> 2;
        const int row0 = scan_row0(bl, c);
        const size_t base = ((size_t)dir * 9216 + row0) * DRNN + cp * 2;
        float P0 = 1.f, P1 = 1.f, H0 = 0.f, H1 = 0.f;
#pragma unroll 8
        for (int i = 0; i < 32; ++i) { const int ii = dir ? (31 - i) : i;
            const unsigned lw = *(const unsigned*)(LA + base + (size_t)ii * DRNN), bw = *(const unsigned*)(BX + base + (size_t)ii * DRNN);
            const float a0 = __expf(bf_lo(lw)), a1 = __expf(bf_hi(lw));
            P0 *= a0; P1 *= a1; H0 = a0 * H0 + bf_lo(bw); H1 = a1 * H1 + bf_hi(bw); }
        const size_t so = ((size_t)(dir * 4 + bl) * 72 + c) * DRNN + cp * 2;
        *(f32x2*)(SP + so) = (f32x2){P0, P1}; *(f32x2*)(SH + so) = (f32x2){H0, H1};
    }
}
__device__ __forceinline__ void scanB_phase(const float* SP, const float* SH, float* CIN, int gtid, int nthreads) {
    for (int idx = gtid; idx < 2 * 4 * DRNN; idx += nthreads) {
        const int ch = idx % DRNN, r = idx / DRNN, bl = r & 3, dir = r >> 2;
        const size_t base = ((size_t)(dir * 4 + bl) * 72) * DRNN + ch;
        float carry = 0.f;
#pragma unroll 1
        for (int s0 = 0; s0 < 72; s0 += 24) {
            float pv[24], hv[24];
#pragma unroll
            for (int s = 0; s < 24; ++s) { const int sq = s0 + s; const int c = dir ? (sq < 8 ? 7 - sq : 79 - sq) : sq; pv[s] = SP[base + (size_t)c * DRNN]; hv[s] = SH[base + (size_t)c * DRNN]; }
#pragma unroll
            for (int s = 0; s < 24; ++s) { const int sq = s0 + s; const int c = dir ? (sq < 8 ? 7 - sq : 79 - sq) : sq; CIN[base + (size_t)c * DRNN] = carry; carry = pv[s] * carry + hv[s]; }
        }
    }
}
__device__ __forceinline__ void scanC_phase(const bf16_t* LA, const bf16_t* BX, const float* CIN, bf16_t* REC, int half, int gtid, int nthreads) {
    for (int idx = gtid; idx < 4 * 64 * 640; idx += nthreads) {
        const int cp = idx % 640, r1 = idx / 640, lc = r1 & 63, bl = r1 >> 6;
        const int row0 = bl * SEQ + lc * 32;
        const size_t b0 = ((size_t)row0) * DRNN + cp * 2, b1 = ((size_t)9216 + row0) * DRNN + cp * 2;
        const f32x2 cf = *(const f32x2*)(CIN + ((size_t)(0 * 4 + bl) * 72 + 8 + lc) * DRNN + cp * 2);
        const f32x2 cbk = *(const f32x2*)(CIN + ((size_t)(1 * 4 + bl) * 72 + 8 + lc) * DRNN + cp * 2);
        float hf0[32], hf1[32];
        float h0 = cf[0], h1 = cf[1];
#pragma unroll
        for (int i = 0; i < 32; ++i) { const unsigned lw = *(const unsigned*)(LA + b0 + (size_t)i * DRNN), bw = *(const unsigned*)(BX + b0 + (size_t)i * DRNN);
            h0 = __expf(bf_lo(lw)) * h0 + bf_lo(bw); h1 = __expf(bf_hi(lw)) * h1 + bf_hi(bw); hf0[i] = h0; hf1[i] = h1; }
        h0 = cbk[0]; h1 = cbk[1];
        bf16_t* out = REC + ((size_t)(half * 4 + bl) * SEQ + lc * 32) * DRNN + cp * 2;
#pragma unroll
        for (int i = 31; i >= 0; --i) { const unsigned lw = *(const unsigned*)(LA + b1 + (size_t)i * DRNN), bw = *(const unsigned*)(BX + b1 + (size_t)i * DRNN);
            h0 = __expf(bf_lo(lw)) * h0 + bf_lo(bw); h1 = __expf(bf_hi(lw)) * h1 + bf_hi(bw);
            *(unsigned*)(out + (size_t)i * DRNN) = cvt_pk_bf16(hf0[i] + h0, hf1[i] + h1); }
    }
}

#ifndef PH_MASK
#define PH_MASK 0xFFFFFFFFu
#endif
#define PH(k) ((PH_MASK >> (k)) & 1u)
#ifndef REP_MASK
#define REP_MASK 0u
#endif
#define REP_BEGIN(k) _Pragma("unroll 1") for (int rep_ = 0; rep_ < (((REP_MASK >> (k)) & 1u) ? 2 : 1); ++rep_) {
#define REP_END }
__device__ __forceinline__ ParamsK kparams() { ParamsK q = (ParamsK)__builtin_amdgcn_kernarg_segment_ptr(); asm volatile("" : "+s"(q)); return q; }
#define PHASE_BEGIN ParamsK kp = kparams(); unsigned char* ws = kp->ws; (void)ws; \
    int tid = threadIdx.x; asm volatile("" : "+v"(tid)); const int lane = tid & 63, wave = __builtin_amdgcn_readfirstlane(tid >> 6); \
    const int gw = bid * 8 + wave, gtid = bid * 512 + tid; (void)lane; (void)gw; (void)gtid;
#define P_MOD0 ((float*)(ws + WS_MOD))
#define P_MOD1 ((float*)(ws + WS_MOD) + 9 * 6144)
#define P_CTXRES ((float*)(ws + WS_CTXRES))
#define P_H ((bf16_t*)(ws + WS_H))
#define P_SLAB ((bf16_t*)(ws + WS_SLAB))
#define P_Q ((bf16_t*)(ws + WS_Q))
#define P_O ((bf16_t*)(ws + WS_O))
#define P_K ((bf16_t*)(ws + WS_K))
#define P_VT ((bf16_t*)(ws + WS_VT))
#define P_VTC ((bf16_t*)(ws + WS_VTC))
#define P_ACT ((bf16_t*)(ws + WS_ACT))
#define P_U ((bf16_t*)(ws + WS_U))
#define P_RECF ((bf16_t*)(ws + WS_RECF))
#define P_RECB ((bf16_t*)(ws + WS_RECB))
#define P_LA ((bf16_t*)(ws + WS_LA))
#define P_BX ((bf16_t*)(ws + WS_BX))
#define P_RPRE ((bf16_t*)(ws + WS_RPRE))
#define P_SP ((float*)(ws + WS_SP))
#define P_SH ((float*)(ws + WS_SH))
#define P_CIN ((float*)(ws + WS_CIN))
#define G0 (kp->norm_g)
#define G1 (kp->norm_g + 4 * DM)

__global__ void __launch_bounds__(512, 2) fwd_megakernel(Params p) {
    extern __shared__ __attribute__((aligned(16))) unsigned char lds_raw[];
    LAS unsigned char* lds = (LAS unsigned char*)lds_raw;
    const int G = gridDim.x, bid = blockIdx.x;
    const int ngw = G * 8, nthreads = G * 512;
    using namespace pg8;
    if (threadIdx.x < 4) ((volatile LAS unsigned*)(lds + 132096))[threadIdx.x] = 0u;
    __syncthreads();
    XcdBarrier xbar = xcd_barrier_post((unsigned*)(p.ws + WS_BAR), (volatile LAS unsigned*)(lds + 132096));
    if (PH(0)) { PHASE_BEGIN prologue(kp, lds, tid, lane, wave); }
    xcd_barrier(xbar);
#ifdef EXTRA_SYNCS
#pragma unroll 1
    for (int es = 0; es < EXTRA_SYNCS; ++es) xcd_barrier(xbar);
#endif
    REP_BEGIN(1)
    if (PH(1)) { PHASE_BEGIN row_phase<false, true, false, false>(kp->x, kp->ctx, nullptr, nullptr, nullptr, nullptr, P_H, nullptr, G0, nullptr, 0, P_MOD0, 0, 1, MT, gw, ngw, lane); }
    xcd_barrier(xbar);
    REP_END
    if (PH(2)) {
        PHASE_BEGIN
        unsigned* cnt = (unsigned*)(ws + WS_CNT) + 16;
        const int remq = (MT / 256 * (NQKV / 256)) % G;
        { Gemm g{P_H, (const bf16_t*)(ws + WS_WQKV), DM, DM, DM}; Sched S; S.init(ML / 256, NQKV / 256, G, bid, 6, 0);
          EpiQKV E{P_Q, P_K, P_VT, P_VTC, (const float*)(ws + WS_ROPE), remq != 0 ? cnt : nullptr};
          gemm_phase<EpiQKV, true, true>(lds, g, S, E); }
        if (remq != 0 && bid >= remq) {
            if (threadIdx.x == 0) { unsigned sp = 0; while (__hip_atomic_load(cnt, __ATOMIC_RELAXED, __HIP_MEMORY_SCOPE_AGENT) < 48u) { __builtin_amdgcn_s_sleep(4); if (++sp > (1u << 22)) break; }
                __builtin_amdgcn_fence(__ATOMIC_ACQUIRE, "agent"); asm volatile("s_waitcnt vmcnt(0)" ::: "memory"); }
            __syncthreads();
            attn_phase(lds, P_Q, P_O, P_K, P_VT, P_VTC, kp->sink, 512 + (bid - remq), 576, G - remq, tid, lane, wave);
        }
    }
    xcd_barrier(xbar);
    REP_BEGIN(3)
    if (PH(3)) { PHASE_BEGIN attn_phase(lds, P_Q, P_O, P_K, P_VT, P_VTC, kp->sink, bid, ((MT / 256 * (NQKV / 256)) % G != 0) ? 512 : 576, G, tid, lane, wave); }
    xcd_barrier(xbar);
    REP_END
    if (PH(4)) {
        PHASE_BEGIN
        { Gemm g{P_O, (const bf16_t*)(ws + WS_WO), DM, DM, DM}; Sched S; S.init(ML / 256, DM / 256, G, bid);
          EpiPlain<0> E{P_H, DM};
          gemm_phase<EpiPlain<0>, true, true>(lds, g, S, E); }
        { Gemm g{P_O, (const bf16_t*)(ws + WS_WO), DM, DM, 256}; Sched S; S.init(8, 4 * 4, G, bid, 2, 256);
          EpiSlabCtx E{P_SLAB, 256};
          gemm_phase<EpiSlabCtx, true, true>(lds, g, S, E); }
    }
    xcd_barrier(xbar);
    if (PH(5)) { PHASE_BEGIN row_phase<true, true, false, true>(kp->x, kp->ctx, kp->out, P_CTXRES, P_H, P_SLAB, P_H, G0 + DM, G0 + 2 * DM, P_MOD0, 2, P_MOD0, 3, 4, MT, gw, ngw, lane); }
    xcd_barrier(xbar);
    if (PH(6)) {
        PHASE_BEGIN
        unsigned* cnt = (unsigned*)(ws + WS_CNT);
        { Gemm g{P_H, (const bf16_t*)(ws + WS_W1), DM, DM, DM}; Sched S; S.init(ML / 256, DFF / 256, G, bid, 5, 0);
          EpiPlain<1> E{P_ACT, DFF, cnt};
          gemm_phase<EpiPlain<1>, true, true>(lds, g, S, E); }
        const int rem = (128 + (ML / 256) * (DFF / 256)) % G;
        if (rem != 0 && bid >= rem) {
            if (threadIdx.x == 0) { unsigned sp = 0; while (__hip_atomic_load(cnt, __ATOMIC_RELAXED, __HIP_MEMORY_SCOPE_AGENT) < 128u) { __builtin_amdgcn_s_sleep(4); if (++sp > (1u << 22)) break; }
                __builtin_amdgcn_fence(__ATOMIC_ACQUIRE, "agent"); asm volatile("s_waitcnt vmcnt(0)" ::: "memory"); }
            __syncthreads();
            Gemm g{P_ACT, (const bf16_t*)(ws + WS_W2), DFF, DFF, 1024}; Sched S; S.init(8, 4 * 4, G - rem, bid - rem, 2, 1024);
            EpiSlabCtx E{P_SLAB, 1024};
            gemm_phase<EpiSlabCtx, true, true>(lds, g, S, E);
        }
    }
    xcd_barrier(xbar);
    if (PH(7)) {
        PHASE_BEGIN
        { Gemm g{P_ACT, (const bf16_t*)(ws + WS_W2), DFF, DFF, DFF}; Sched S; S.init(ML / 256, DM / 256, G, bid);
          EpiPlain<0> E{P_H, DM};
          gemm_phase<EpiPlain<0>, true, true>(lds, g, S, E); }
        if ((128 + (ML / 256) * (DFF / 256)) % G == 0) {
          Gemm g{P_ACT, (const bf16_t*)(ws + WS_W2), DFF, DFF, 1024}; Sched S; S.init(8, 4 * 4, G, bid, 2, 1024);
          EpiSlabCtx E{P_SLAB, 1024};
          gemm_phase<EpiSlabCtx, true, true>(lds, g, S, E); }
    }
    xcd_barrier(xbar);
    if (PH(8)) { PHASE_BEGIN row_phase<true, true, true, true>(kp->out, P_CTXRES, kp->out, P_CTXRES, P_H, P_SLAB, P_H, G0 + 3 * DM, G1, P_MOD0, 5, P_MOD1, 0, 1, MT, gw, ngw, lane); }
    xcd_barrier(xbar);
    if (PH(9)) {
        PHASE_BEGIN
        Gemm g{P_H, (const bf16_t*)(ws + WS_WIN), DM, DM, DM}; Sched S; S.init(MT / 256, DRNN / 256, G, bid, 4, 0);
        EpiInProj E{P_RPRE, (bf16_t*)(ws + WS_CTXRES)};
        gemm_phase<EpiInProj, true, true>(lds, g, S, E);
    }
    xcd_barrier(xbar);
    REP_BEGIN(10)
    if (PH(10)) { PHASE_BEGIN conv_phase(P_RPRE, P_U, kp->conv_w, kp->conv_b, gtid, nthreads);
        u32x4* cz = (u32x4*)(ws + WS_CARRY); for (int idx = gtid; idx < 1440 * 128 * 8 / 16; idx += nthreads) cz[idx] = (u32x4){0u, 0u, 0u, 0u}; }
    xcd_barrier(xbar);
    REP_END
    if (PH(11)) {
        PHASE_BEGIN
        Gemm g{P_U, (const bf16_t*)(ws + WS_WG), DRNN, 256, 256}; Sched S; S.init(1, 1, G, bid, 3, 0);
        EpiGatesScan E{P_U, P_RECF, P_RECB, kp->b_a, kp->b_i, (const float*)(ws + WS_NLS), (unsigned long long*)(ws + WS_CARRY)};
        gemm_phase<EpiGatesScan, true, true>(lds, g, S, E);
    }
    xcd_barrier(xbar);
    if (PH(15)) {
        PHASE_BEGIN
        Gemm g{P_H, (const bf16_t*)(ws + WS_WIN), DM, DM, DM}; Sched S; S.init(ML / 256, 4, G, bid);
        EpiGateMul E{P_RECF, P_RECB};
        gemm_phase<EpiGateMul, true, true>(lds, g, S, E);
        {
            const bf16_t* GB = (const bf16_t*)(ws + WS_CTXRES); bf16_t* Z = P_RECF; const bf16_t* RB = P_RECB;
            for (int idx = gtid; idx < ML * 32; idx += nthreads) { const int row = idx >> 5, c8 = (idx & 31) * 8;
                const u32x4 gv = *(const u32x4*)(GB + (size_t)row * 256 + c8); const size_t o = (size_t)row * DRNN + 1024 + c8;
                const u32x4 fv = *(const u32x4*)(Z + o), bv = *(const u32x4*)(RB + o); u32x4 w;
                w.x = cvt_pk_bf16(bf_lo(gv.x) * (bf_lo(fv.x) + bf_lo(bv.x)), bf_hi(gv.x) * (bf_hi(fv.x) + bf_hi(bv.x)));
                w.y = cvt_pk_bf16(bf_lo(gv.y) * (bf_lo(fv.y) + bf_lo(bv.y)), bf_hi(gv.y) * (bf_hi(fv.y) + bf_hi(bv.y)));
                w.z = cvt_pk_bf16(bf_lo(gv.z) * (bf_lo(fv.z) + bf_lo(bv.z)), bf_hi(gv.z) * (bf_hi(fv.z) + bf_hi(bv.z)));
                w.w = cvt_pk_bf16(bf_lo(gv.w) * (bf_lo(fv.w) + bf_lo(bv.w)), bf_hi(gv.w) * (bf_hi(fv.w) + bf_hi(bv.w)));
                *(u32x4*)(Z + o) = w; }
        }
    }
    xcd_barrier(xbar);
    if (PH(16)) {
        PHASE_BEGIN
        Gemm g{P_RECF, (const bf16_t*)(ws + WS_WOUT), DRNN, DRNN, DRNN}; Sched S; S.init(ML / 256, DM / 256, G, bid);
        EpiPlain<0> E{P_H, DM};
        gemm_phase<EpiPlain<0>, true, true>(lds, g, S, E);
    }
    xcd_barrier(xbar);
    if (PH(17)) { PHASE_BEGIN row_phase<true, true, true, true>(kp->out, P_CTXRES, ws + WS_X3, P_CTXRES, P_H, nullptr, P_H, G1 + DM, G1 + 2 * DM, P_MOD1, 2, P_MOD1, 3, 4, ML, gw, ngw, lane); }
    xcd_barrier(xbar);
    if (PH(18)) {
        PHASE_BEGIN
        Gemm g{P_H, (const bf16_t*)(ws + WS_W1 + 16 * MiB), DM, DM, DM}; Sched S; S.init(ML / 256, DFF / 256, G, bid);
        EpiPlain<1> E{P_ACT, DFF};
        gemm_phase<EpiPlain<1>, true, true>(lds, g, S, E);
    }
    xcd_barrier(xbar);
    if (PH(19)) {
        PHASE_BEGIN
        Gemm g{P_ACT, (const bf16_t*)(ws + WS_W2 + 16 * MiB), DFF, DFF, DFF}; Sched S; S.init(ML / 256, DM / 256, G, bid);
        EpiPlain<0> E{P_H, DM};
        gemm_phase<EpiPlain<0>, true, true>(lds, g, S, E);
    }
    xcd_barrier(xbar);
    if (PH(20)) { PHASE_BEGIN row_phase<true, false, true, false>(ws + WS_X3, P_CTXRES, kp->out, P_CTXRES, P_H, nullptr, nullptr, G1 + 3 * DM, nullptr, P_MOD1, 5, nullptr, 0, 0, ML, gw, ngw, lane); }
}

extern "C" void kernel_launch(void* const* d_in, const int* in_sizes, int n_in, void* d_out, int out_size, void* d_ws, size_t ws_size, hipStream_t stream) {
    static int grid_blocks = 0;
    if (grid_blocks == 0) {
        if (n_in != 21 || ws_size < WS_END) { fprintf(stderr, "kernel_launch: unexpected n_in %d / ws_size %zu\n", n_in, ws_size); grid_blocks = -1; return; }
        int dev = 0, cus = 0, per_cu = 0;
        hipGetDevice(&dev);
        hipDeviceGetAttribute(&cus, hipDeviceAttributeMultiprocessorCount, dev);
        if (hipFuncSetAttribute((const void*)fwd_megakernel, hipFuncAttributeMaxDynamicSharedMemorySize, LDS_BYTES) != hipSuccess) { fprintf(stderr, "hipFuncSetAttribute failed\n"); grid_blocks = -1; return; }
        if (hipOccupancyMaxActiveBlocksPerMultiprocessor(&per_cu, (const void*)fwd_megakernel, 512, LDS_BYTES) != hipSuccess || per_cu < 1) { fprintf(stderr, "occupancy query failed (%d)\n", per_cu); (void)hipGetLastError(); per_cu = 1; }
        grid_blocks = cus * 1;
    }
    if (grid_blocks < 0) return;
    Params p{};
    p.x = (const float*)d_in[0]; p.c = (const float*)d_in[1]; p.ctx = (const float*)d_in[2]; p.c_ctx = (const float*)d_in[3];
    p.ada_w = (const float*)d_in[4]; p.ada_b = (const float*)d_in[5]; p.norm_g = (const float*)d_in[6]; p.mlp_w1 = (const float*)d_in[7]; p.mlp_w2 = (const float*)d_in[8];
    p.w_qkv = (const float*)d_in[9]; p.w_o = (const float*)d_in[10]; p.sink = (const float*)d_in[11];
    p.w_in = (const float*)d_in[12]; p.conv_w = (const float*)d_in[13]; p.conv_b = (const float*)d_in[14]; p.w_a = (const float*)d_in[15]; p.b_a = (const float*)d_in[16];
    p.w_i = (const float*)d_in[17]; p.b_i = (const float*)d_in[18]; p.lam = (const float*)d_in[19]; p.w_out = (const float*)d_in[20];
    p.out = (float*)d_out; p.ws = (unsigned char*)d_ws;
    if (hipMemsetAsync((unsigned char*)d_ws + WS_BAR, 0, XCD_BAR_WORDS * 4, stream) != hipSuccess) { fprintf(stderr, "memset of barrier words failed\n"); return; }
    void* args[] = {&p};
    hipError_t e = hipLaunchCooperativeKernel((const void*)fwd_megakernel, dim3(grid_blocks), dim3(512), args, LDS_BYTES, stream);
    if (e != hipSuccess) fprintf(stderr, "cooperative launch failed: %s (grid %d)\n", hipGetErrorString(e), grid_blocks);
}
```
